# Optimizing an MI355X kernel written in HIP

```python
import math
import jax
import jax.numpy as jnp
from jax import lax
import numpy as np

D_MODEL = 1024
BATCH = 16
SEQ = 256
DEPTH = 4
DEC_BATCH = 2
DEC_SEQ = 2048
PAST_LEN = 512

GRID_W = 64

N_MIXERS = 3
N_HYENA = (DEPTH + 2) // 3
N_MLA = (DEPTH + 1) // 3
N_RWKV = DEPTH // 3

DEEPNORM_ALPHA = (2.0 * DEPTH) ** 0.25
DEEPNORM_BETA = (8.0 * DEPTH) ** -0.25
LN_EPS = 1e-5
RMS_EPS = 1e-6

HY_WIDTH = D_MODEL
HY_BANDS = 16
HY_EMB = 1 + 2 * HY_BANDS
HY_FFN = 64
HY_DECAY_MIN = -math.log(1e-2) / 1.5
HY_DECAY_MAX = -math.log(1e-2) / 0.3

MLA_HEADS = 16
MLA_Q_RANK = 256
MLA_KV_RANK = 128
MLA_NOPE_DIM = 64
MLA_ROPE_DIM = 32
MLA_V_DIM = 64
ROPE_BASE = 10000.0
Q_BLOCK = 128

RW_HEAD_DIM = 64
RW_HEADS = D_MODEL // RW_HEAD_DIM
RW_DECAY_LORA = 64
RW_A_LORA = 64
RW_GN_EPS = 64e-5

kernel_name = 'hybrid_hyena_mla_rwkv7_diffusion_step'


def _layer_norm(x, g, b):
    xf = x.astype(jnp.float32)
    mu = jnp.mean(xf, -1, keepdims=True)
    var = jnp.mean(jnp.square(xf - mu), -1, keepdims=True)
    return ((xf - mu) * lax.rsqrt(var + LN_EPS) * g + b).astype(x.dtype)


def _rms_norm(x, g):
    xf = x.astype(jnp.float32)
    return (xf * lax.rsqrt(jnp.mean(xf * xf, -1, keepdims=True) + RMS_EPS) * g).astype(x.dtype)


def _neighbours(u):
    up = jnp.pad(u, ((0, 0), (1, 1), (0, 0)))
    return up[:, :-2], up[:, 2:]


def _modulation(cond, w, b):
    m = jax.nn.silu(cond) @ w + b
    return jnp.split(m, 3, axis=-1)


def _hyena_filter(L, w1, b1, w2, b2, w3, b3, freq, decay):
    pos = jnp.arange(L, dtype=jnp.float32)
    t = jnp.linspace(0.0, 1.0, L, dtype=jnp.float32)
    bands = jnp.linspace(1e-4, HY_BANDS - 1, HY_BANDS, dtype=jnp.float32)
    ang = (2.0 * math.pi / L) * pos[:, None] * bands[None, :]
    feat = jnp.concatenate([t[:, None], jnp.cos(ang), -jnp.sin(ang)], -1)
    hdn = jnp.sin(freq[0] * (feat @ w1 + b1))
    hdn = jnp.sin(freq[1] * (hdn @ w2 + b2))
    hf = (hdn @ w3 + b3).astype(jnp.float32).reshape(L, 2, HY_WIDTH)
    window = jnp.exp(-t[:, None, None] * jnp.abs(decay.astype(jnp.float32))[None])
    h = hf * window
    zero = jnp.zeros((1, HY_WIDTH), jnp.float32)
    return jnp.concatenate([h[:, 0], zero, h[:0:-1, 1]], 0)


def _hyena_mixer(h, w_in, conv_w, conv_b, w1, b1, w2, b2, w3, b3, freq, decay, skip, w_out):
    B, L, _ = h.shape
    u = h @ w_in
    u3, z = u[..., :3 * HY_WIDTH], u[..., 3 * HY_WIDTH:]
    prev, nxt = _neighbours(u3)
    u3 = prev * conv_w[0] + u3 * conv_w[1] + nxt * conv_w[2] + conv_b
    x0, x1, v = jnp.split(u3, 3, axis=-1)
    filt = _hyena_filter(L, w1, b1, w2, b2, w3, b3, freq, decay)
    v = v * x1
    vf = jnp.fft.rfft(v.astype(jnp.float32), n=2 * L, axis=1)
    kf = jnp.fft.rfft(filt, axis=0)
    y = jnp.fft.irfft(vf * kf[None], n=2 * L, axis=1)[:, :L].astype(h.dtype) + v * skip
    y = y * x0
    return (y * jax.nn.silu(z)) @ w_out


def _axial_rope_tables(rows):
    half = MLA_ROPE_DIM // 2
    inv = ROPE_BASE ** (-jnp.arange(0, half, 2, dtype=jnp.float32) / half)
    r = jnp.repeat(jnp.arange(rows, dtype=jnp.float32), GRID_W)
    col = jnp.tile(jnp.arange(GRID_W, dtype=jnp.float32), rows)
    ar, ac = r[:, None] * inv, col[:, None] * inv
    ang = jnp.concatenate([ar, ar, ac, ac], -1)
    return jnp.cos(ang), jnp.sin(ang)


def _rotate_half(x):
    a, b = jnp.split(x, 2, axis=-1)
    return jnp.concatenate([-b, a], -1)


def _apply_axial_rope(x, cos, sin):
    half = MLA_ROPE_DIM // 2
    rot = jnp.concatenate([_rotate_half(x[..., :half]), _rotate_half(x[..., half:])], -1)
    return (x.astype(jnp.float32) * cos + rot.astype(jnp.float32) * sin).astype(x.dtype)


def _mla_project(h, w_in, q_norm, kv_norm, w_q_up):
    B, L, _ = h.shape
    u = h @ w_in
    q_c, kv_c, k_pe, z = jnp.split(
        u, [MLA_Q_RANK, MLA_Q_RANK + MLA_KV_RANK, MLA_Q_RANK + MLA_KV_RANK + MLA_ROPE_DIM], axis=-1)
    q = (_rms_norm(q_c, q_norm) @ w_q_up).reshape(B, L, MLA_HEADS, MLA_NOPE_DIM + MLA_ROPE_DIM)
    ckv = _rms_norm(kv_c, kv_norm)
    return q[..., :MLA_NOPE_DIM], q[..., MLA_NOPE_DIM:], ckv, k_pe, z


def _mla_expand(ckv, w_kv_up):
    B, L, _ = ckv.shape
    kv = (ckv @ w_kv_up).reshape(B, L, MLA_HEADS, MLA_NOPE_DIM + MLA_V_DIM)
    return kv[..., :MLA_NOPE_DIM], kv[..., MLA_NOPE_DIM:]


def _mla_attend(q_nope, q_pe, k_nope, k_pe, v):
    B, Lq, H, _ = q_nope.shape
    nb = Lq // Q_BLOCK
    scale = (MLA_NOPE_DIM + MLA_ROPE_DIM) ** -0.5

    def blocks(a):
        return a.reshape(B, nb, Q_BLOCK, *a.shape[2:]).swapaxes(0, 1)

    def one(qb):
        qn, qp = qb
        s = jnp.einsum('bqhd,bkhd->bhqk', qn, k_nope) + jnp.einsum('bqhr,bkr->bhqk', qp, k_pe)
        p = jax.nn.softmax(s.astype(jnp.float32) * scale, axis=-1).astype(v.dtype)
        return jnp.einsum('bhqk,bkhd->bqhd', p, v)

    o = lax.map(one, (blocks(q_nope), blocks(q_pe)))
    return o.swapaxes(0, 1).reshape(B, Lq, H * MLA_V_DIM)


def _mla_context(h, w_in, q_norm, kv_norm, w_q_up, w_kv_up, w_out):
    q_nope, q_pe, ckv, k_pe, z = _mla_project(h, w_in, q_norm, kv_norm, w_q_up)
    k_nope, v = _mla_expand(ckv, w_kv_up)
    o = _mla_attend(q_nope, q_pe, k_nope, k_pe, v)
    return (o * jax.nn.silu(z)) @ w_out, ckv, k_pe


def _mla_latent(h, ctx_ckv, ctx_kpe, cos, sin, w_in, q_norm, kv_norm, w_q_up, w_kv_up, w_out):
    q_nope, q_pe, ckv, k_pe, z = _mla_project(h, w_in, q_norm, kv_norm, w_q_up)
    q_pe = _apply_axial_rope(q_pe, cos[:, None, :], sin[:, None, :])
    k_pe = _apply_axial_rope(k_pe, cos, sin)
    ckv_all = jnp.concatenate([ctx_ckv.astype(ckv.dtype), ckv], 1)
    kpe_all = jnp.concatenate([ctx_kpe.astype(k_pe.dtype), k_pe], 1)
    k_nope, v = _mla_expand(ckv_all, w_kv_up)
    o = _mla_attend(q_nope, q_pe, k_nope, kpe_all, v)
    return (o * jax.nn.silu(z)) @ w_out


def _rwkv_mixer(h, s0, mu, w_in, w0, w1, w2, a0, a1, a2, k_k, k_a, r_k, gn_g, gn_b, w_out):
    B, L, D = h.shape
    H, N = RW_HEADS, RW_HEAD_DIM
    f32 = jnp.float32
    prev, nxt = _neighbours(h)
    d = 0.5 * (prev + nxt) - h
    xs = h[None] + d[None] * mu[:, None, None, :]
    xr, xw, xk, xv, xa, xg = xs[0], xs[1], xs[2], xs[3], xs[4], xs[5]
    r, k, v, z = jnp.einsum('pbld,pde->pble', jnp.stack([xr, xk, xv, xg]), w_in)
    wl = w0[:, None, None, :] + jnp.einsum(
        'nblr,nrd->nbld', jnp.tanh(jnp.einsum('bld,ndr->nblr', xw, w1)), w2)
    decay = jnp.exp(-jnp.exp(-jax.nn.softplus(-wl.astype(f32)) - 0.5))
    a = jax.nn.sigmoid((a0[:, None, None, :] + jnp.einsum(
        'nblr,nrd->nbld', jnp.einsum('bld,ndr->nblr', xa, a1), a2)).astype(f32))

    def heads(t):
        return t.reshape(*t.shape[:-1], H, N)

    kf = k.astype(f32)
    kk = heads(kf * k_k)
    kk = kk * lax.rsqrt(jnp.sum(kk * kk, -1, keepdims=True) + 1e-12)
    kd = heads(kf[None] * (1.0 + (a - 1.0) * k_a))
    bd = kk[None] * heads(a)
    rh, vh = heads(r.astype(f32)), heads(v.astype(f32))

    def orient(t):
        return jnp.stack([t[0], t[1][:, ::-1]], 2).transpose(1, 0, 2, 3, 4)

    def both(t):
        return orient(jnp.broadcast_to(t, (2,) + t.shape))

    seq = (both(rh), orient(heads(decay)), orient(kd), both(vh), both(-kk), orient(bd))

    def step(S, inp):
        r_t, w_t, k_t, v_t, a_t, b_t = inp
        sa = jnp.einsum('bdhij,bdhj->bdhi', S, a_t)
        S = S * w_t[..., None, :] + sa[..., None] * b_t[..., None, :] + v_t[..., None] * k_t[..., None, :]
        return S, jnp.einsum('bdhij,bdhj->bdhi', S, r_t)

    s_fin, y = lax.scan(step, s0.astype(f32), seq)
    y = y.transpose(1, 0, 2, 3, 4)
    y = y[:, :, 0] + y[:, ::-1, 1]
    m = jnp.mean(y, -1, keepdims=True)
    var = jnp.mean(jnp.square(y - m), -1, keepdims=True)
    yn = (y - m) * lax.rsqrt(var + RW_GN_EPS) * gn_g.reshape(H, N) + gn_b.reshape(H, N)
    bonus = jnp.sum(jnp.sum(rh[None] * kd * r_k, -1, keepdims=True), 0) * vh
    o = (yn + bonus).reshape(B, L, D).astype(h.dtype)
    return (o * jax.nn.silu(z)) @ w_out, s_fin


def setup_inputs(seed: int = 0) -> dict:
    key = jax.random.key(seed)
    ks = iter(jax.random.split(key, 64))

    def nrm(shape, scale=1.0):
        return jax.random.normal(next(ks), shape, jnp.float32) * scale

    D = D_MODEL
    hqk = MLA_NOPE_DIM + MLA_ROPE_DIM
    mla_in = MLA_Q_RANK + MLA_KV_RANK + MLA_ROPE_DIM + MLA_HEADS * MLA_V_DIM
    hy_dec = jnp.linspace(HY_DECAY_MIN, HY_DECAY_MAX, HY_WIDTH, dtype=jnp.float32)
    return {
        'x_prompt': nrm((BATCH, SEQ, D)),
        'x_sample': nrm((DEC_BATCH, DEC_SEQ, D)),
        'cache_mla_ckv': nrm((DEC_BATCH, N_MLA, PAST_LEN, MLA_KV_RANK)),
        'cache_mla_kpe': nrm((DEC_BATCH, N_MLA, PAST_LEN, MLA_ROPE_DIM)),
        'state_rwkv': nrm((DEC_BATCH, N_RWKV, 2, RW_HEADS, RW_HEAD_DIM, RW_HEAD_DIM), 0.5),
        'c': nrm((DEC_BATCH, D)),
        'c_ctx': nrm((D,)),
        'mod_w': nrm((DEPTH, D, 3 * D), 0.5 * D ** -0.5),
        'mod_b': nrm((DEPTH, 3 * D), 0.02),
        'ln_g': 1.0 + nrm((DEPTH, D), 0.02),
        'ln_b': nrm((DEPTH, D), 0.02),
        'hy_w_in': nrm((N_HYENA, D, 4 * HY_WIDTH), D ** -0.5),
        'hy_conv_w': nrm((N_HYENA, 3, 3 * HY_WIDTH), 3 ** -0.5),
        'hy_conv_b': nrm((N_HYENA, 3 * HY_WIDTH), 0.02),
        'hy_ffn_w1': nrm((N_HYENA, HY_EMB, HY_FFN), HY_EMB ** -0.5),
        'hy_ffn_b1': nrm((N_HYENA, HY_FFN), 0.02),
        'hy_ffn_w2': nrm((N_HYENA, HY_FFN, HY_FFN), HY_FFN ** -0.5),
        'hy_ffn_b2': nrm((N_HYENA, HY_FFN), 0.02),
        'hy_ffn_w3': nrm((N_HYENA, HY_FFN, 2 * HY_WIDTH), HY_FFN ** -0.5),
        'hy_ffn_b3': nrm((N_HYENA, 2 * HY_WIDTH), 0.02),
        'hy_freq': 1.0 + nrm((N_HYENA, 2, HY_FFN), 0.1),
        'hy_decay': hy_dec[None, None, :] * (1.0 + nrm((N_HYENA, 2, HY_WIDTH), 0.05)),
        'hy_skip': nrm((N_HYENA, HY_WIDTH)),
        'hy_w_out': nrm((N_HYENA, HY_WIDTH, D), HY_WIDTH ** -0.5 * DEEPNORM_BETA),
        'mla_w_in': nrm((N_MLA, D, mla_in), D ** -0.5),
        'mla_q_norm': 1.0 + nrm((N_MLA, MLA_Q_RANK), 0.02),
        'mla_kv_norm': 1.0 + nrm((N_MLA, MLA_KV_RANK), 0.02),
        'mla_w_q_up': nrm((N_MLA, MLA_Q_RANK, MLA_HEADS * hqk), MLA_Q_RANK ** -0.5),
        'mla_w_kv_up': nrm((N_MLA, MLA_KV_RANK, MLA_HEADS * (MLA_NOPE_DIM + MLA_V_DIM)), MLA_KV_RANK ** -0.5),
        'mla_w_out': nrm((N_MLA, MLA_HEADS * MLA_V_DIM, D), (MLA_HEADS * MLA_V_DIM) ** -0.5 * DEEPNORM_BETA),
        'rw_mu': jax.random.uniform(next(ks), (N_RWKV, 6, D), jnp.float32),
        'rw_w_in': nrm((N_RWKV, 4, D, D), D ** -0.5),
        'rw_w0': jnp.linspace(-6.0, 1.0, D, dtype=jnp.float32)[None, None, :] + nrm((N_RWKV, 2, D), 0.1),
        'rw_w1': nrm((N_RWKV, 2, D, RW_DECAY_LORA), D ** -0.5),
        'rw_w2': nrm((N_RWKV, 2, RW_DECAY_LORA, D), 0.1 * RW_DECAY_LORA ** -0.5),
        'rw_a0': nrm((N_RWKV, 2, D), 0.1),
        'rw_a1': nrm((N_RWKV, 2, D, RW_A_LORA), D ** -0.5),
        'rw_a2': nrm((N_RWKV, 2, RW_A_LORA, D), 0.1 * RW_A_LORA ** -0.5),
        'rw_k_k': 0.85 + nrm((N_RWKV, D), 0.05),
        'rw_k_a': 1.0 + nrm((N_RWKV, D), 0.05),
        'rw_r_k': nrm((N_RWKV, RW_HEADS, RW_HEAD_DIM), 0.1),
        'rw_gn_g': 1.0 + nrm((N_RWKV, D), 0.02),
        'rw_gn_b': nrm((N_RWKV, D), 0.02),
        'rw_w_out': nrm((N_RWKV, D, D), D ** -0.5 * DEEPNORM_BETA),
    }


def reference(x_prompt, x_sample, cache_mla_ckv, cache_mla_kpe, state_rwkv, c, c_ctx,
              mod_w, mod_b, ln_g, ln_b,
              hy_w_in, hy_conv_w, hy_conv_b, hy_ffn_w1, hy_ffn_b1, hy_ffn_w2, hy_ffn_b2,
              hy_ffn_w3, hy_ffn_b3, hy_freq, hy_decay, hy_skip, hy_w_out,
              mla_w_in, mla_q_norm, mla_kv_norm, mla_w_q_up, mla_w_kv_up, mla_w_out,
              rw_mu, rw_w_in, rw_w0, rw_w1, rw_w2, rw_a0, rw_a1, rw_a2, rw_k_k, rw_k_a,
              rw_r_k, rw_gn_g, rw_gn_b, rw_w_out):
    rows = x_sample.shape[1] // GRID_W
    cos, sin = _axial_rope_tables(rows)
    xp, xs = x_prompt, x_sample
    new_ckv, new_kpe, new_rw = [], [], []
    for i in range(DEPTH):
        kind, j = i % N_MIXERS, i // N_MIXERS
        sh_p, sc_p, g_p = _modulation(c_ctx[None, None, :], mod_w[i], mod_b[i])
        sh_s, sc_s, g_s = _modulation(c[:, None, :], mod_w[i], mod_b[i])
        hp = xp * (1.0 + sc_p) + sh_p
        hs = xs * (1.0 + sc_s) + sh_s
        if kind == 0:
            hyp = (hy_w_in[j], hy_conv_w[j], hy_conv_b[j], hy_ffn_w1[j], hy_ffn_b1[j],
                   hy_ffn_w2[j], hy_ffn_b2[j], hy_ffn_w3[j], hy_ffn_b3[j], hy_freq[j],
                   hy_decay[j], hy_skip[j], hy_w_out[j])
            op = _hyena_mixer(hp, *hyp)
            os_ = _hyena_mixer(hs, *hyp)
        elif kind == 1:
            mp = (mla_w_in[j], mla_q_norm[j], mla_kv_norm[j], mla_w_q_up[j], mla_w_kv_up[j], mla_w_out[j])
            op, ckv, kpe = _mla_context(hp, *mp)
            os_ = _mla_latent(hs, cache_mla_ckv[:, j], cache_mla_kpe[:, j], cos, sin, *mp)
            new_ckv.append(ckv)
            new_kpe.append(kpe)
        else:
            rp = (rw_mu[j], rw_w_in[j], rw_w0[j], rw_w1[j], rw_w2[j], rw_a0[j], rw_a1[j], rw_a2[j],
                  rw_k_k[j], rw_k_a[j], rw_r_k[j], rw_gn_g[j], rw_gn_b[j], rw_w_out[j])
            s_zero = jnp.zeros((xp.shape[0], 2, RW_HEADS, RW_HEAD_DIM, RW_HEAD_DIM), jnp.float32)
            op, st = _rwkv_mixer(hp, s_zero, *rp)
            os_, _ = _rwkv_mixer(hs, state_rwkv[:, j], *rp)
            new_rw.append(st)
        xp = _layer_norm(DEEPNORM_ALPHA * xp + g_p * op, ln_g[i], ln_b[i])
        xs = _layer_norm(DEEPNORM_ALPHA * xs + g_s * os_, ln_g[i], ln_b[i])
    return (xp, xs, jnp.stack(new_ckv, 1), jnp.stack(new_kpe, 1), jnp.stack(new_rw, 1))
```

```cpp
#include <hip/hip_runtime.h>
#include <stdint.h>
#include <math.h>

namespace {

constexpr int D = 1024;
constexpr int NTOK = 8192;
constexpr int NPT = 4096;
constexpr int PAST = 512;
constexpr float ALPHA = 1.681792830507429f;
constexpr float LN_EPS = 1e-5f, RMS_EPS = 1e-6f, GN_EPS = 64e-5f;

struct P {
  const float *x_prompt, *x_sample, *cache_ckv, *cache_kpe, *state_rwkv, *c, *c_ctx;
  const float *mod_w, *mod_b, *ln_g, *ln_b;
  const float *hy_w_in, *hy_conv_w, *hy_conv_b, *hy_w1, *hy_b1, *hy_w2, *hy_b2, *hy_w3, *hy_b3, *hy_freq, *hy_decay, *hy_skip, *hy_w_out;
  const float *mla_w_in, *mla_q_norm, *mla_kv_norm, *mla_w_q_up, *mla_w_kv_up, *mla_w_out;
  const float *rw_mu, *rw_w_in, *rw_w0, *rw_w1, *rw_w2, *rw_a0, *rw_a1, *rw_a2, *rw_k_k, *rw_k_a, *rw_r_k, *rw_gn_g, *rw_gn_b, *rw_w_out;
  float* out;
  float* ws;
};

constexpr size_t OUT_Y = 0, OUT_CKV = 8388608, OUT_KPE = 8912896, OUT_ST = 9043968;

constexpr size_t SZ = (size_t)NTOK * D;
constexpr size_t WS_X = 0;
constexpr size_t WS_S1 = WS_X + SZ;
constexpr size_t WS_S4 = WS_S1 + SZ;
constexpr size_t WS_S2 = WS_S4 + SZ;
constexpr size_t WS_MISC = WS_S2 + 4 * SZ;
constexpr size_t MISC_MODS = 0;
constexpr size_t MISC_FILT = 65536;
constexpr size_t MISC_END = MISC_FILT + (size_t)2304 * 2048;

__device__ __forceinline__ float silu(float x) { return x / (1.f + expf(-x)); }
__device__ __forceinline__ float sigmoidf(float x) { return 1.f / (1.f + expf(-x)); }

__device__ __forceinline__ void tokinfo(int m, int& l, int& L, int& cond, int& m0) {
  if (m < NPT) { l = m & 255; L = 256; cond = 0; m0 = m & ~255; }
  else { int mm = m - NPT; l = mm & 2047; L = 2048; cond = 1 + (mm >> 11); m0 = NPT + (mm & ~2047); }
}

__global__ void k_mods(P p) {
  int idx = blockIdx.x * blockDim.x + threadIdx.x;
  if (idx >= 4 * 3 * 3072) return;
  int n = idx % 3072, g = (idx / 3072) % 3, i = idx / (3 * 3072);
  const float* cond = (g == 0) ? p.c_ctx : p.c + (size_t)(g - 1) * D;
  const float* w = p.mod_w + (size_t)i * D * 3072;
  float acc = 0.f;
  for (int k = 0; k < D; ++k) acc += silu(cond[k]) * w[(size_t)k * 3072 + n];
  p.ws[WS_MISC + MISC_MODS + idx] = acc + p.mod_b[i * 3072 + n];
}

__global__ void k_modulate(P p, const float* xa, const float* xb, float* H, int layer) {
  size_t idx = (size_t)blockIdx.x * blockDim.x + threadIdx.x;
  if (idx >= SZ) return;
  int m = (int)(idx >> 10), k = (int)(idx & 1023);
  int l, L, cond, m0; tokinfo(m, l, L, cond, m0);
  const float* md = p.ws + WS_MISC + MISC_MODS + (size_t)(layer * 3 + cond) * 3072;
  float x = (m < NPT) ? xa[idx] : xb[idx - (size_t)NPT * D];
  H[idx] = x * (1.f + md[1024 + k]) + md[k];
}

template <class AL, class EP>
__global__ void __launch_bounds__(256) k_gemm(AL al, const float* __restrict__ W, int ldw, int M, int N, int K, EP ep) {
  __shared__ float As[16][68];
  __shared__ float Bs[16][68];
  const int tx = threadIdx.x & 15, ty = threadIdx.x >> 4;
  const int m0 = blockIdx.y * 64, n0 = blockIdx.x * 64;
  float acc[4][4];
#pragma unroll
  for (int i = 0; i < 4; ++i)
#pragma unroll
    for (int j = 0; j < 4; ++j) acc[i][j] = 0.f;
  for (int k0 = 0; k0 < K; k0 += 16) {
#pragma unroll
    for (int i = 0; i < 4; ++i) {
      int e = threadIdx.x + i * 256; int mm = e >> 4, kk = e & 15;
      As[kk][mm] = (m0 + mm < M) ? al(m0 + mm, k0 + kk) : 0.f;
    }
#pragma unroll
    for (int i = 0; i < 4; ++i) {
      int e = threadIdx.x + i * 256; int kk = e >> 6, nn = e & 63;
      Bs[kk][nn] = (n0 + nn < N) ? W[(size_t)(k0 + kk) * ldw + n0 + nn] : 0.f;
    }
    __syncthreads();
#pragma unroll
    for (int kk = 0; kk < 16; ++kk) {
      float a[4], b[4];
#pragma unroll
      for (int i = 0; i < 4; ++i) { a[i] = As[kk][ty * 4 + i]; b[i] = Bs[kk][tx * 4 + i]; }
#pragma unroll
      for (int i = 0; i < 4; ++i)
#pragma unroll
        for (int j = 0; j < 4; ++j) acc[i][j] += a[i] * b[j];
    }
    __syncthreads();
  }
#pragma unroll
  for (int i = 0; i < 4; ++i)
#pragma unroll
    for (int j = 0; j < 4; ++j) {
      int m = m0 + ty * 4 + i, n = n0 + tx * 4 + j;
      if (m < M && n < N) ep(m, n, acc[i][j]);
    }
}

struct ALPlain { const float* A; long lda; __device__ float operator()(int m, int k) const { return A[(size_t)m * lda + k]; } };
struct EPPlain { float* C; long ldc; __device__ void operator()(int m, int n, float v) const { C[(size_t)m * ldc + n] = v; } };
struct EPTanh { float* C; long ldc; __device__ void operator()(int m, int n, float v) const { C[(size_t)m * ldc + n] = tanhf(v); } };
struct ALMix {
  const float* H; const float* mu;
  __device__ float operator()(int m, int k) const {
    int l, L, cond, m0; tokinfo(m, l, L, cond, m0);
    float h = H[(size_t)m * D + k];
    float pv = (l > 0) ? H[(size_t)(m - 1) * D + k] : 0.f;
    float nx = (l < L - 1) ? H[(size_t)(m + 1) * D + k] : 0.f;
    return h + (0.5f * (pv + nx) - h) * mu[k];
  }
};

template <class AL, class EP>
void gemm(hipStream_t s, AL al, const float* W, int ldw, int M, int N, int K, EP ep) {
  dim3 g((N + 63) / 64, (M + 63) / 64);
  hipLaunchKernelGGL((k_gemm<AL, EP>), g, dim3(256), 0, s, al, W, ldw, M, N, K, ep);
}

__global__ void __launch_bounds__(256) k_ln(P p, const float* xa, const float* xb, const float* O, float* Xn, int layer) {
  int m = blockIdx.x * 4 + (threadIdx.x >> 6), lane = threadIdx.x & 63;
  int l, L, cond, m0; tokinfo(m, l, L, cond, m0);
  const float* gate = p.ws + WS_MISC + MISC_MODS + (size_t)(layer * 3 + cond) * 3072 + 2048;
  const float* xr = (m < NPT) ? xa + (size_t)m * D : xb + (size_t)(m - NPT) * D;
  float v[16]; float s = 0.f;
#pragma unroll
  for (int i = 0; i < 16; ++i) { int k = lane + 64 * i; v[i] = ALPHA * xr[k] + gate[k] * O[(size_t)m * D + k]; s += v[i]; }
#pragma unroll
  for (int o = 1; o < 64; o <<= 1) s += __shfl_xor(s, o);
  float mu = s * (1.f / D), q = 0.f;
#pragma unroll
  for (int i = 0; i < 16; ++i) { v[i] -= mu; q += v[i] * v[i]; }
#pragma unroll
  for (int o = 1; o < 64; o <<= 1) q += __shfl_xor(q, o);
  float rs = rsqrtf(q * (1.f / D) + LN_EPS);
#pragma unroll
  for (int i = 0; i < 16; ++i) { int k = lane + 64 * i; Xn[(size_t)m * D + k] = v[i] * rs * p.ln_g[layer * D + k] + p.ln_b[layer * D + k]; }
}

__global__ void __launch_bounds__(256) k_hy_filter(P p, int j) {
  __shared__ float feat[33], h1[64], h2[64];
  int row = blockIdx.x; int L = row < 256 ? 256 : 2048; int l = row < 256 ? row : row - 256;
  int tid = threadIdx.x;
  float t = (float)l / (float)(L - 1);
  if (tid < 33) {
    float f;
    if (tid == 0) f = t;
    else {
      int b = (tid - 1) & 15;
      float band = 1e-4f + (float)b * ((15.f - 1e-4f) / 15.f);
      float ang = (6.283185307179586f / (float)L) * (float)l * band;
      f = (tid <= 16) ? cosf(ang) : -sinf(ang);
    }
    feat[tid] = f;
  }
  __syncthreads();
  if (tid < 64) {
    float a = p.hy_b1[j * 64 + tid];
    for (int f = 0; f < 33; ++f) a += feat[f] * p.hy_w1[((size_t)j * 33 + f) * 64 + tid];
    h1[tid] = sinf(p.hy_freq[(j * 2 + 0) * 64 + tid] * a);
  }
  __syncthreads();
  if (tid < 64) {
    float a = p.hy_b2[j * 64 + tid];
    for (int f = 0; f < 64; ++f) a += h1[f] * p.hy_w2[((size_t)j * 64 + f) * 64 + tid];
    h2[tid] = sinf(p.hy_freq[(j * 2 + 1) * 64 + tid] * a);
  }
  __syncthreads();
  for (int o = tid; o < 2048; o += 256) {
    float a = p.hy_b3[j * 2048 + o];
    for (int f = 0; f < 64; ++f) a += h2[f] * p.hy_w3[((size_t)j * 64 + f) * 2048 + o];
    float w = expf(-t * fabsf(p.hy_decay[(size_t)j * 2048 + o]));
    p.ws[WS_MISC + MISC_FILT + (size_t)row * 2048 + o] = a * w;
  }
}

__device__ __forceinline__ float conv3(const float* U, int m, int l, int L, int ch, const float* cw, const float* cb) {
  float cur = U[(size_t)m * 4096 + ch];
  float pv = (l > 0) ? U[(size_t)(m - 1) * 4096 + ch] : 0.f;
  float nx = (l < L - 1) ? U[(size_t)(m + 1) * 4096 + ch] : 0.f;
  return pv * cw[ch] + cur * cw[3072 + ch] + nx * cw[6144 + ch] + cb[ch];
}
__global__ void k_hy_vv(P p, const float* U, float* VV, int j) {
  size_t idx = (size_t)blockIdx.x * blockDim.x + threadIdx.x;
  if (idx >= SZ) return;
  int m = (int)(idx >> 10), c = (int)(idx & 1023);
  int l, L, cond, m0; tokinfo(m, l, L, cond, m0);
  const float* cw = p.hy_conv_w + (size_t)j * 3 * 3072; const float* cb = p.hy_conv_b + (size_t)j * 3072;
  float x1 = conv3(U, m, l, L, 1024 + c, cw, cb);
  float v = conv3(U, m, l, L, 2048 + c, cw, cb);
  VV[idx] = v * x1;
}
__global__ void k_hy_long(P p, const float* U, const float* VV, float* G, int j) {
  size_t idx = (size_t)blockIdx.x * blockDim.x + threadIdx.x;
  if (idx >= SZ) return;
  int m = (int)(idx >> 10), c = (int)(idx & 1023);
  int l, L, cond, m0; tokinfo(m, l, L, cond, m0);
  const float* F = p.ws + WS_MISC + MISC_FILT + (size_t)(L == 256 ? 0 : 256) * 2048;
  float acc = 0.f;
  for (int s = 0; s <= l; ++s) acc += VV[(size_t)(m0 + s) * D + c] * F[(size_t)(l - s) * 2048 + c];
  for (int s = l + 1; s < L; ++s) acc += VV[(size_t)(m0 + s) * D + c] * F[(size_t)(s - l) * 2048 + 1024 + c];
  const float* cw = p.hy_conv_w + (size_t)j * 3 * 3072; const float* cb = p.hy_conv_b + (size_t)j * 3072;
  float x0 = conv3(U, m, l, L, c, cw, cb);
  float z = U[(size_t)m * 4096 + 3072 + c];
  float y = (acc + VV[idx] * p.hy_skip[j * D + c]) * x0;
  G[idx] = y * silu(z);
}

__device__ __forceinline__ int kvrow(int m) { if (m < NPT) return m; int mm = m - NPT; return NPT + (mm >> 11) * 2560 + PAST + (mm & 2047); }
__device__ __forceinline__ void rope32(const float* x, float* o, int l) {
  int r = l >> 6, col = l & 63;
#pragma unroll
  for (int i = 0; i < 8; ++i) {
    float inv = powf(10000.f, -(float)(2 * i) / 16.f);
    float ar = (float)r * inv, ac = (float)col * inv;
    float cr = cosf(ar), sr = sinf(ar), cc = cosf(ac), sc = sinf(ac);
    o[i] = x[i] * cr - x[i + 8] * sr;
    o[i + 8] = x[i + 8] * cr + x[i] * sr;
    o[16 + i] = x[16 + i] * cc - x[24 + i] * sc;
    o[24 + i] = x[24 + i] * cc + x[16 + i] * sc;
  }
}
__global__ void __launch_bounds__(64) k_mla_extract(P p, const float* U2, float* QN, float* CKVALL, float* KPEALL, float* Z) {
  int m = blockIdx.x, lane = threadIdx.x;
  int l, L, cond, m0; tokinfo(m, l, L, cond, m0);
  const float* u = U2 + (size_t)m * 1440;
  float q[4], s = 0.f;
#pragma unroll
  for (int i = 0; i < 4; ++i) { q[i] = u[lane + 64 * i]; s += q[i] * q[i]; }
#pragma unroll
  for (int o = 1; o < 64; o <<= 1) s += __shfl_xor(s, o);
  float rs = rsqrtf(s * (1.f / 256.f) + RMS_EPS);
#pragma unroll
  for (int i = 0; i < 4; ++i) QN[(size_t)m * 256 + lane + 64 * i] = q[i] * rs * p.mla_q_norm[lane + 64 * i];
  float k0 = u[256 + lane], k1 = u[256 + 64 + lane];
  float s2 = k0 * k0 + k1 * k1;
#pragma unroll
  for (int o = 1; o < 64; o <<= 1) s2 += __shfl_xor(s2, o);
  float rs2 = rsqrtf(s2 * (1.f / 128.f) + RMS_EPS);
  float c0 = k0 * rs2 * p.mla_kv_norm[lane], c1 = k1 * rs2 * p.mla_kv_norm[64 + lane];
  int kr = kvrow(m);
  CKVALL[(size_t)kr * 128 + lane] = c0; CKVALL[(size_t)kr * 128 + 64 + lane] = c1;
  if (m < NPT) { p.out[OUT_CKV + (size_t)m * 128 + lane] = c0; p.out[OUT_CKV + (size_t)m * 128 + 64 + lane] = c1; }
  if (lane == 0) {
    float x[32], o[32];
#pragma unroll
    for (int i = 0; i < 32; ++i) x[i] = u[384 + i];
    if (m < NPT) {
#pragma unroll
      for (int i = 0; i < 32; ++i) { KPEALL[(size_t)kr * 32 + i] = x[i]; p.out[OUT_KPE + (size_t)m * 32 + i] = x[i]; }
    } else {
      rope32(x, o, l);
#pragma unroll
      for (int i = 0; i < 32; ++i) KPEALL[(size_t)kr * 32 + i] = o[i];
    }
  }
  for (int i = lane; i < 1024; i += 64) Z[(size_t)m * D + i] = u[416 + i];
}
__global__ void k_mla_cache(P p, float* CKVALL, float* KPEALL) {
  int idx = blockIdx.x * blockDim.x + threadIdx.x;
  if (idx >= 2 * PAST * 128) return;
  int d = idx & 127, pl = (idx >> 7) & 511, b = idx >> 16;
  int row = NPT + b * 2560 + pl;
  CKVALL[(size_t)row * 128 + d] = p.cache_ckv[idx];
  if (d < 32) KPEALL[(size_t)row * 32 + d] = p.cache_kpe[((size_t)b * PAST + pl) * 32 + d];
}
__global__ void k_rope_q(float* Q) {
  int idx = blockIdx.x * blockDim.x + threadIdx.x;
  if (idx >= 4096 * 16) return;
  int h = idx & 15, mm = idx >> 4; int m = NPT + mm; int l = mm & 2047;
  float* q = Q + (size_t)m * 1536 + h * 96 + 64;
  float x[32], o[32];
#pragma unroll
  for (int i = 0; i < 32; ++i) x[i] = q[i];
  rope32(x, o, l);
#pragma unroll
  for (int i = 0; i < 32; ++i) q[i] = o[i];
}
__global__ void __launch_bounds__(64) k_attn(const float* Q, const float* KV, const float* KPEALL, float* G) {
  int qi = blockIdx.x * 64 + threadIdx.x;
  int sh = blockIdx.y; int h = sh & 15, seq = sh >> 4;
  int L = seq < 16 ? 256 : 2048;
  if (qi >= L) return;
  int m = seq < 16 ? seq * 256 + qi : NPT + (seq - 16) * 2048 + qi;
  int kbase = seq < 16 ? seq * 256 : NPT + (seq - 16) * 2560;
  int nk = seq < 16 ? 256 : 2560;
  float q[96];
#pragma unroll
  for (int i = 0; i < 96; ++i) q[i] = Q[(size_t)m * 1536 + h * 96 + i];
  float acc[64];
#pragma unroll
  for (int i = 0; i < 64; ++i) acc[i] = 0.f;
  float mx = -1e30f, lsum = 0.f;
  const float scale = 0.10206207261596575f;
  for (int k = 0; k < nk; ++k) {
    const float* kv = KV + (size_t)(kbase + k) * 2048 + h * 128;
    const float* kp = KPEALL + (size_t)(kbase + k) * 32;
    float s = 0.f;
#pragma unroll
    for (int i = 0; i < 64; ++i) s += q[i] * kv[i];
#pragma unroll
    for (int i = 0; i < 32; ++i) s += q[64 + i] * kp[i];
    s *= scale;
    float mn = fmaxf(mx, s);
    float corr = expf(mx - mn), pe = expf(s - mn);
    lsum = lsum * corr + pe;
#pragma unroll
    for (int i = 0; i < 64; ++i) acc[i] = acc[i] * corr + pe * kv[64 + i];
    mx = mn;
  }
  float inv = 1.f / lsum;
#pragma unroll
  for (int i = 0; i < 64; ++i) { size_t o = (size_t)m * D + h * 64 + i; G[o] = acc[i] * inv * silu(G[o]); }
}

__global__ void __launch_bounds__(64) k_rw_scan(P p, const float* R, const float* K, const float* V, const float* HW, const float* HA, float* Y) {
  int id = blockIdx.x;
  int h = id & 15, dir = (id >> 4) & 1, seq = id >> 5;
  int lane = threadIdx.x;
  int L = seq < 16 ? 256 : 2048;
  int m0 = seq < 16 ? seq * 256 : NPT + (seq - 16) * 2048;
  int ch = h * 64 + lane;
  float S[64];
  if (seq < 16) {
#pragma unroll
    for (int j = 0; j < 64; ++j) S[j] = 0.f;
  } else {
    const float* s0 = p.state_rwkv + ((((size_t)(seq - 16) * 1 + 0) * 2 + dir) * 16 + h) * 4096 + (size_t)lane * 64;
#pragma unroll
    for (int j = 0; j < 64; ++j) S[j] = s0[j];
  }
  const float w0 = p.rw_w0[dir * D + ch], a0 = p.rw_a0[dir * D + ch];
  const float kkw = p.rw_k_k[ch], kaw = p.rw_k_a[ch];
  const float* w2 = p.rw_w2 + (size_t)dir * 64 * D + ch;
  const float* a2 = p.rw_a2 + (size_t)dir * 64 * D + ch;
  for (int st = 0; st < L; ++st) {
    int t = dir ? (L - 1 - st) : st;
    int m = m0 + t;
    float wl = w0, al = a0;
    const float* hw = HW + (size_t)m * 128 + dir * 64;
    const float* ha = HA + (size_t)m * 128 + dir * 64;
    for (int r = 0; r < 64; ++r) { wl += hw[r] * w2[(size_t)r * D]; al += ha[r] * a2[(size_t)r * D]; }
    float sp = (-wl > 20.f) ? -wl : log1pf(expf(-wl));
    float dec = expf(-expf(-sp - 0.5f));
    float a = sigmoidf(al);
    float k = K[(size_t)m * D + ch], r_ = R[(size_t)m * D + ch], v = V[(size_t)m * D + ch];
    float kk = k * kkw; float ss = kk * kk;
#pragma unroll
    for (int o = 1; o < 64; o <<= 1) ss += __shfl_xor(ss, o);
    kk *= rsqrtf(ss + 1e-12f);
    float kd = k * (1.f + (a - 1.f) * kaw);
    float bd = kk * a;
    float at = -kk;
    float sa = 0.f;
#pragma unroll
    for (int j = 0; j < 64; ++j) sa += S[j] * __shfl(at, j);
    float y = 0.f;
#pragma unroll
    for (int j = 0; j < 64; ++j) {
      float wj = __shfl(dec, j), bj = __shfl(bd, j), kj = __shfl(kd, j), rj = __shfl(r_, j);
      S[j] = S[j] * wj + sa * bj + v * kj;
      y += S[j] * rj;
    }
    atomicAdd(&Y[(size_t)m * D + ch], y);
  }
  if (seq < 16) {
    float* so = p.out + OUT_ST + ((((size_t)seq * 1 + 0) * 2 + dir) * 16 + h) * 4096 + (size_t)lane * 64;
#pragma unroll
    for (int j = 0; j < 64; ++j) so[j] = S[j];
  }
}
__global__ void __launch_bounds__(64) k_rw_post(P p, const float* R, const float* K, const float* V, const float* Z, const float* HA, const float* Y, float* G) {
  int m = blockIdx.x >> 4, h = blockIdx.x & 15, lane = threadIdx.x; int ch = h * 64 + lane;
  float y = Y[(size_t)m * D + ch];
  float s = y;
#pragma unroll
  for (int o = 1; o < 64; o <<= 1) s += __shfl_xor(s, o);
  float mu = s * (1.f / 64.f); float d = y - mu; float q = d * d;
#pragma unroll
  for (int o = 1; o < 64; o <<= 1) q += __shfl_xor(q, o);
  float yn = d * rsqrtf(q * (1.f / 64.f) + GN_EPS) * p.rw_gn_g[ch] + p.rw_gn_b[ch];
  float k = K[(size_t)m * D + ch], r_ = R[(size_t)m * D + ch], v = V[(size_t)m * D + ch];
  float bsum = 0.f;
  for (int dir = 0; dir < 2; ++dir) {
    float al = p.rw_a0[dir * D + ch];
    const float* ha = HA + (size_t)m * 128 + dir * 64;
    const float* a2 = p.rw_a2 + (size_t)dir * 64 * D + ch;
    for (int r = 0; r < 64; ++r) al += ha[r] * a2[(size_t)r * D];
    float a = sigmoidf(al);
    float kd = k * (1.f + (a - 1.f) * p.rw_k_a[ch]);
    bsum += r_ * kd * p.rw_r_k[ch];
  }
#pragma unroll
  for (int o = 1; o < 64; o <<= 1) bsum += __shfl_xor(bsum, o);
  float o_ = yn + bsum * v;
  G[(size_t)m * D + ch] = o_ * silu(Z[(size_t)m * D + ch]);
}

}

extern "C" void kernel_launch(void* const* d_in, const int* in_sizes, int n_in, void* d_out, int out_size, void* d_ws, size_t ws_size, hipStream_t stream) {
  P p{};
  const float** pp = (const float**)&p;
  for (int i = 0; i < 44; ++i) pp[i] = (const float*)d_in[i];
  p.out = (float*)d_out; p.ws = (float*)d_ws;
  float* ws = p.ws;
  float* X = ws + WS_X; float* S1 = ws + WS_S1; float* S4 = ws + WS_S4; float* S2 = ws + WS_S2;
  const int EB = (int)((SZ + 255) / 256);

  hipLaunchKernelGGL(k_mods, dim3((4 * 3 * 3072 + 255) / 256), dim3(256), 0, stream, p);

  for (int layer = 0; layer < 4; ++layer) {
    const int kind = layer % 3, j = layer / 3;
    const float* xa = (layer == 0) ? p.x_prompt : X;
    const float* xb = (layer == 0) ? p.x_sample : X + (size_t)NPT * D;
    float* Xn = (layer == 3) ? p.out + OUT_Y : X;
    hipLaunchKernelGGL(k_modulate, dim3(EB), dim3(256), 0, stream, p, xa, xb, S1, layer);
    if (kind == 0) {
      hipLaunchKernelGGL(k_hy_filter, dim3(2304), dim3(256), 0, stream, p, j);
      gemm(stream, ALPlain{S1, D}, p.hy_w_in + (size_t)j * D * 4096, 4096, NTOK, 4096, D, EPPlain{S2, 4096});
      hipLaunchKernelGGL(k_hy_vv, dim3(EB), dim3(256), 0, stream, p, S2, S1, j);
      hipLaunchKernelGGL(k_hy_long, dim3(EB), dim3(256), 0, stream, p, S2, S1, S4, j);
      gemm(stream, ALPlain{S4, D}, p.hy_w_out + (size_t)j * D * D, D, NTOK, D, D, EPPlain{S1, D});
    } else if (kind == 1) {
      float* U2 = S2;
      float* QN = S1;
      float* CKVALL = S1 + (size_t)NTOK * 256;
      float* KPEALL = CKVALL + (size_t)9216 * 128;
      float* Q = S2;
      float* KV = S2 + (size_t)NTOK * 1536;
      gemm(stream, ALPlain{S1, D}, p.mla_w_in, 1440, NTOK, 1440, D, EPPlain{U2, 1440});
      hipLaunchKernelGGL(k_mla_extract, dim3(NTOK), dim3(64), 0, stream, p, U2, QN, CKVALL, KPEALL, S4);
      hipLaunchKernelGGL(k_mla_cache, dim3((2 * PAST * 128 + 255) / 256), dim3(256), 0, stream, p, CKVALL, KPEALL);
      gemm(stream, ALPlain{QN, 256}, p.mla_w_q_up, 1536, NTOK, 1536, 256, EPPlain{Q, 1536});
      hipLaunchKernelGGL(k_rope_q, dim3((4096 * 16 + 255) / 256), dim3(256), 0, stream, Q);
      gemm(stream, ALPlain{CKVALL, 128}, p.mla_w_kv_up, 2048, 9216, 2048, 128, EPPlain{KV, 2048});
      hipLaunchKernelGGL(k_attn, dim3(32, 18 * 16), dim3(64), 0, stream, Q, KV, KPEALL, S4);
      gemm(stream, ALPlain{S4, D}, p.mla_w_out, D, NTOK, D, D, EPPlain{S1, D});
    } else {
      float* R = S2; float* K = S2 + SZ; float* V = S2 + 2 * SZ; float* Z = S2 + 3 * SZ;
      float* HW = S4; float* HA = S4 + (size_t)NTOK * 128;
      HW = ws + WS_MISC + MISC_END; HA = HW + (size_t)NTOK * 128;
      const float* mu = p.rw_mu;
      const float* win = p.rw_w_in;
      gemm(stream, ALMix{S1, mu + 0 * D}, win + 0 * (size_t)D * D, D, NTOK, D, D, EPPlain{R, D});
      gemm(stream, ALMix{S1, mu + 2 * D}, win + 1 * (size_t)D * D, D, NTOK, D, D, EPPlain{K, D});
      gemm(stream, ALMix{S1, mu + 3 * D}, win + 2 * (size_t)D * D, D, NTOK, D, D, EPPlain{V, D});
      gemm(stream, ALMix{S1, mu + 5 * D}, win + 3 * (size_t)D * D, D, NTOK, D, D, EPPlain{Z, D});
      for (int dir = 0; dir < 2; ++dir) {
        gemm(stream, ALMix{S1, mu + 1 * D}, p.rw_w1 + (size_t)dir * D * 64, 64, NTOK, 64, D, EPTanh{HW + dir * 64, 128});
        gemm(stream, ALMix{S1, mu + 4 * D}, p.rw_a1 + (size_t)dir * D * 64, 64, NTOK, 64, D, EPPlain{HA + dir * 64, 128});
      }
      hipMemsetAsync(S4, 0, SZ * sizeof(float), stream);
      hipLaunchKernelGGL(k_rw_scan, dim3(18 * 32), dim3(64), 0, stream, p, R, K, V, HW, HA, S4);
      hipLaunchKernelGGL(k_rw_post, dim3(NTOK * 16), dim3(64), 0, stream, p, R, K, V, Z, HA, S4, S4);
      gemm(stream, ALPlain{S4, D}, p.rw_w_out, D, NTOK, D, D, EPPlain{S1, D});
    }
    hipLaunchKernelGGL(k_ln, dim3(NTOK / 4), dim3(256), 0, stream, p, xa, xb, S1, Xn, layer);
  }
}
```

```cpp
#define MEGA_PHASES 16
#define NAIVE_FROM 4
#include <hip/hip_runtime.h>
#include <stdint.h>
#include <math.h>

namespace {

constexpr int D = 1024;
constexpr int NTOK = 8192;
constexpr int NPT = 4096;
constexpr int PAST = 512;
constexpr float ALPHA = 1.681792830507429f;
constexpr float LN_EPS = 1e-5f, RMS_EPS = 1e-6f, GN_EPS = 64e-5f;

struct P {
  const float *x_prompt, *x_sample, *cache_ckv, *cache_kpe, *state_rwkv, *c, *c_ctx;
  const float *mod_w, *mod_b, *ln_g, *ln_b;
  const float *hy_w_in, *hy_conv_w, *hy_conv_b, *hy_w1, *hy_b1, *hy_w2, *hy_b2, *hy_w3, *hy_b3, *hy_freq, *hy_decay, *hy_skip, *hy_w_out;
  const float *mla_w_in, *mla_q_norm, *mla_kv_norm, *mla_w_q_up, *mla_w_kv_up, *mla_w_out;
  const float *rw_mu, *rw_w_in, *rw_w0, *rw_w1, *rw_w2, *rw_a0, *rw_a1, *rw_a2, *rw_k_k, *rw_k_a, *rw_r_k, *rw_gn_g, *rw_gn_b, *rw_w_out;
  float* out;
  float* ws;
};

constexpr size_t OUT_Y = 0, OUT_CKV = 8388608, OUT_KPE = 8912896, OUT_ST = 9043968;

constexpr size_t SZ = (size_t)NTOK * D;
constexpr size_t WS_X = 0;
constexpr size_t WS_S1 = WS_X + SZ;
constexpr size_t WS_S4 = WS_S1 + SZ;
constexpr size_t WS_S2 = WS_S4 + SZ;
constexpr size_t WS_MISC = WS_S2 + 4 * SZ;
constexpr size_t MISC_MODS = 0;
constexpr size_t MISC_FILT = 65536;
constexpr size_t MISC_END = MISC_FILT + (size_t)2304 * 2048;

__device__ __forceinline__ float silu(float x) { return x / (1.f + expf(-x)); }
__device__ __forceinline__ float sigmoidf(float x) { return 1.f / (1.f + expf(-x)); }

__device__ __forceinline__ void tokinfo(int m, int& l, int& L, int& cond, int& m0) {
  if (m < NPT) { l = m & 255; L = 256; cond = 0; m0 = m & ~255; }
  else { int mm = m - NPT; l = mm & 2047; L = 2048; cond = 1 + (mm >> 11); m0 = NPT + (mm & ~2047); }
}

__global__ void k_mods(P p) {
  int idx = blockIdx.x * blockDim.x + threadIdx.x;
  if (idx >= 4 * 3 * 3072) return;
  int n = idx % 3072, g = (idx / 3072) % 3, i = idx / (3 * 3072);
  const float* cond = (g == 0) ? p.c_ctx : p.c + (size_t)(g - 1) * D;
  const float* w = p.mod_w + (size_t)i * D * 3072;
  float acc = 0.f;
  for (int k = 0; k < D; ++k) acc += silu(cond[k]) * w[(size_t)k * 3072 + n];
  p.ws[WS_MISC + MISC_MODS + idx] = acc + p.mod_b[i * 3072 + n];
}

__global__ void k_modulate(P p, const float* xa, const float* xb, float* H, int layer) {
  size_t idx = (size_t)blockIdx.x * blockDim.x + threadIdx.x;
  if (idx >= SZ) return;
  int m = (int)(idx >> 10), k = (int)(idx & 1023);
  int l, L, cond, m0; tokinfo(m, l, L, cond, m0);
  const float* md = p.ws + WS_MISC + MISC_MODS + (size_t)(layer * 3 + cond) * 3072;
  float x = (m < NPT) ? xa[idx] : xb[idx - (size_t)NPT * D];
  H[idx] = x * (1.f + md[1024 + k]) + md[k];
}

template <class AL, class EP>
__global__ void __launch_bounds__(256) k_gemm(AL al, const float* __restrict__ W, int ldw, int M, int N, int K, EP ep) {
  __shared__ float As[16][68];
  __shared__ float Bs[16][68];
  const int tx = threadIdx.x & 15, ty = threadIdx.x >> 4;
  const int m0 = blockIdx.y * 64, n0 = blockIdx.x * 64;
  float acc[4][4];
#pragma unroll
  for (int i = 0; i < 4; ++i)
#pragma unroll
    for (int j = 0; j < 4; ++j) acc[i][j] = 0.f;
  for (int k0 = 0; k0 < K; k0 += 16) {
#pragma unroll
    for (int i = 0; i < 4; ++i) {
      int e = threadIdx.x + i * 256; int mm = e >> 4, kk = e & 15;
      As[kk][mm] = (m0 + mm < M) ? al(m0 + mm, k0 + kk) : 0.f;
    }
#pragma unroll
    for (int i = 0; i < 4; ++i) {
      int e = threadIdx.x + i * 256; int kk = e >> 6, nn = e & 63;
      Bs[kk][nn] = (n0 + nn < N) ? W[(size_t)(k0 + kk) * ldw + n0 + nn] : 0.f;
    }
    __syncthreads();
#pragma unroll
    for (int kk = 0; kk < 16; ++kk) {
      float a[4], b[4];
#pragma unroll
      for (int i = 0; i < 4; ++i) { a[i] = As[kk][ty * 4 + i]; b[i] = Bs[kk][tx * 4 + i]; }
#pragma unroll
      for (int i = 0; i < 4; ++i)
#pragma unroll
        for (int j = 0; j < 4; ++j) acc[i][j] += a[i] * b[j];
    }
    __syncthreads();
  }
#pragma unroll
  for (int i = 0; i < 4; ++i)
#pragma unroll
    for (int j = 0; j < 4; ++j) {
      int m = m0 + ty * 4 + i, n = n0 + tx * 4 + j;
      if (m < M && n < N) ep(m, n, acc[i][j]);
    }
}

struct ALPlain { const float* A; long lda; __device__ float operator()(int m, int k) const { return A[(size_t)m * lda + k]; } };
struct EPPlain { float* C; long ldc; __device__ void operator()(int m, int n, float v) const { C[(size_t)m * ldc + n] = v; } };
struct EPTanh { float* C; long ldc; __device__ void operator()(int m, int n, float v) const { C[(size_t)m * ldc + n] = tanhf(v); } };
struct ALMix {
  const float* H; const float* mu;
  __device__ float operator()(int m, int k) const {
    int l, L, cond, m0; tokinfo(m, l, L, cond, m0);
    float h = H[(size_t)m * D + k];
    float pv = (l > 0) ? H[(size_t)(m - 1) * D + k] : 0.f;
    float nx = (l < L - 1) ? H[(size_t)(m + 1) * D + k] : 0.f;
    return h + (0.5f * (pv + nx) - h) * mu[k];
  }
};

template <class AL, class EP>
void gemm(hipStream_t s, AL al, const float* W, int ldw, int M, int N, int K, EP ep) {
  dim3 g((N + 63) / 64, (M + 63) / 64);
  hipLaunchKernelGGL((k_gemm<AL, EP>), g, dim3(256), 0, s, al, W, ldw, M, N, K, ep);
}

__global__ void __launch_bounds__(256) k_ln(P p, const float* xa, const float* xb, const float* O, float* Xn, int layer) {
  int m = blockIdx.x * 4 + (threadIdx.x >> 6), lane = threadIdx.x & 63;
  int l, L, cond, m0; tokinfo(m, l, L, cond, m0);
  const float* gate = p.ws + WS_MISC + MISC_MODS + (size_t)(layer * 3 + cond) * 3072 + 2048;
  const float* xr = (m < NPT) ? xa + (size_t)m * D : xb + (size_t)(m - NPT) * D;
  float v[16]; float s = 0.f;
#pragma unroll
  for (int i = 0; i < 16; ++i) { int k = lane + 64 * i; v[i] = ALPHA * xr[k] + gate[k] * O[(size_t)m * D + k]; s += v[i]; }
#pragma unroll
  for (int o = 1; o < 64; o <<= 1) s += __shfl_xor(s, o);
  float mu = s * (1.f / D), q = 0.f;
#pragma unroll
  for (int i = 0; i < 16; ++i) { v[i] -= mu; q += v[i] * v[i]; }
#pragma unroll
  for (int o = 1; o < 64; o <<= 1) q += __shfl_xor(q, o);
  float rs = rsqrtf(q * (1.f / D) + LN_EPS);
#pragma unroll
  for (int i = 0; i < 16; ++i) { int k = lane + 64 * i; Xn[(size_t)m * D + k] = v[i] * rs * p.ln_g[layer * D + k] + p.ln_b[layer * D + k]; }
}

__global__ void __launch_bounds__(256) k_hy_filter(P p, int j) {
  __shared__ float feat[33], h1[64], h2[64];
  int row = blockIdx.x; int L = row < 256 ? 256 : 2048; int l = row < 256 ? row : row - 256;
  int tid = threadIdx.x;
  float t = (float)l / (float)(L - 1);
  if (tid < 33) {
    float f;
    if (tid == 0) f = t;
    else {
      int b = (tid - 1) & 15;
      float band = 1e-4f + (float)b * ((15.f - 1e-4f) / 15.f);
      float ang = (6.283185307179586f / (float)L) * (float)l * band;
      f = (tid <= 16) ? cosf(ang) : -sinf(ang);
    }
    feat[tid] = f;
  }
  __syncthreads();
  if (tid < 64) {
    float a = p.hy_b1[j * 64 + tid];
    for (int f = 0; f < 33; ++f) a += feat[f] * p.hy_w1[((size_t)j * 33 + f) * 64 + tid];
    h1[tid] = sinf(p.hy_freq[(j * 2 + 0) * 64 + tid] * a);
  }
  __syncthreads();
  if (tid < 64) {
    float a = p.hy_b2[j * 64 + tid];
    for (int f = 0; f < 64; ++f) a += h1[f] * p.hy_w2[((size_t)j * 64 + f) * 64 + tid];
    h2[tid] = sinf(p.hy_freq[(j * 2 + 1) * 64 + tid] * a);
  }
  __syncthreads();
  for (int o = tid; o < 2048; o += 256) {
    float a = p.hy_b3[j * 2048 + o];
    for (int f = 0; f < 64; ++f) a += h2[f] * p.hy_w3[((size_t)j * 64 + f) * 2048 + o];
    float w = expf(-t * fabsf(p.hy_decay[(size_t)j * 2048 + o]));
    p.ws[WS_MISC + MISC_FILT + (size_t)row * 2048 + o] = a * w;
  }
}

__device__ __forceinline__ float conv3(const float* U, int m, int l, int L, int ch, const float* cw, const float* cb) {
  float cur = U[(size_t)m * 4096 + ch];
  float pv = (l > 0) ? U[(size_t)(m - 1) * 4096 + ch] : 0.f;
  float nx = (l < L - 1) ? U[(size_t)(m + 1) * 4096 + ch] : 0.f;
  return pv * cw[ch] + cur * cw[3072 + ch] + nx * cw[6144 + ch] + cb[ch];
}
__global__ void k_hy_vv(P p, const float* U, float* VV, int j) {
  size_t idx = (size_t)blockIdx.x * blockDim.x + threadIdx.x;
  if (idx >= SZ) return;
  int m = (int)(idx >> 10), c = (int)(idx & 1023);
  int l, L, cond, m0; tokinfo(m, l, L, cond, m0);
  const float* cw = p.hy_conv_w + (size_t)j * 3 * 3072; const float* cb = p.hy_conv_b + (size_t)j * 3072;
  float x1 = conv3(U, m, l, L, 1024 + c, cw, cb);
  float v = conv3(U, m, l, L, 2048 + c, cw, cb);
  VV[idx] = v * x1;
}
__global__ void k_hy_long(P p, const float* U, const float* VV, float* G, int j) {
  size_t idx = (size_t)blockIdx.x * blockDim.x + threadIdx.x;
  if (idx >= SZ) return;
  int m = (int)(idx >> 10), c = (int)(idx & 1023);
  int l, L, cond, m0; tokinfo(m, l, L, cond, m0);
  const float* F = p.ws + WS_MISC + MISC_FILT + (size_t)(L == 256 ? 0 : 256) * 2048;
  float acc = 0.f;
  for (int s = 0; s <= l; ++s) acc += VV[(size_t)(m0 + s) * D + c] * F[(size_t)(l - s) * 2048 + c];
  for (int s = l + 1; s < L; ++s) acc += VV[(size_t)(m0 + s) * D + c] * F[(size_t)(s - l) * 2048 + 1024 + c];
  const float* cw = p.hy_conv_w + (size_t)j * 3 * 3072; const float* cb = p.hy_conv_b + (size_t)j * 3072;
  float x0 = conv3(U, m, l, L, c, cw, cb);
  float z = U[(size_t)m * 4096 + 3072 + c];
  float y = (acc + VV[idx] * p.hy_skip[j * D + c]) * x0;
  G[idx] = y * silu(z);
}

__device__ __forceinline__ int kvrow(int m) { if (m < NPT) return m; int mm = m - NPT; return NPT + (mm >> 11) * 2560 + PAST + (mm & 2047); }
__device__ __forceinline__ void rope32(const float* x, float* o, int l) {
  int r = l >> 6, col = l & 63;
#pragma unroll
  for (int i = 0; i < 8; ++i) {
    float inv = powf(10000.f, -(float)(2 * i) / 16.f);
    float ar = (float)r * inv, ac = (float)col * inv;
    float cr = cosf(ar), sr = sinf(ar), cc = cosf(ac), sc = sinf(ac);
    o[i] = x[i] * cr - x[i + 8] * sr;
    o[i + 8] = x[i + 8] * cr + x[i] * sr;
    o[16 + i] = x[16 + i] * cc - x[24 + i] * sc;
    o[24 + i] = x[24 + i] * cc + x[16 + i] * sc;
  }
}
__global__ void __launch_bounds__(64) k_mla_extract(P p, const float* U2, float* QN, float* CKVALL, float* KPEALL, float* Z) {
  int m = blockIdx.x, lane = threadIdx.x;
  int l, L, cond, m0; tokinfo(m, l, L, cond, m0);
  const float* u = U2 + (size_t)m * 1440;
  float q[4], s = 0.f;
#pragma unroll
  for (int i = 0; i < 4; ++i) { q[i] = u[lane + 64 * i]; s += q[i] * q[i]; }
#pragma unroll
  for (int o = 1; o < 64; o <<= 1) s += __shfl_xor(s, o);
  float rs = rsqrtf(s * (1.f / 256.f) + RMS_EPS);
#pragma unroll
  for (int i = 0; i < 4; ++i) QN[(size_t)m * 256 + lane + 64 * i] = q[i] * rs * p.mla_q_norm[lane + 64 * i];
  float k0 = u[256 + lane], k1 = u[256 + 64 + lane];
  float s2 = k0 * k0 + k1 * k1;
#pragma unroll
  for (int o = 1; o < 64; o <<= 1) s2 += __shfl_xor(s2, o);
  float rs2 = rsqrtf(s2 * (1.f / 128.f) + RMS_EPS);
  float c0 = k0 * rs2 * p.mla_kv_norm[lane], c1 = k1 * rs2 * p.mla_kv_norm[64 + lane];
  int kr = kvrow(m);
  CKVALL[(size_t)kr * 128 + lane] = c0; CKVALL[(size_t)kr * 128 + 64 + lane] = c1;
  if (m < NPT) { p.out[OUT_CKV + (size_t)m * 128 + lane] = c0; p.out[OUT_CKV + (size_t)m * 128 + 64 + lane] = c1; }
  if (lane == 0) {
    float x[32], o[32];
#pragma unroll
    for (int i = 0; i < 32; ++i) x[i] = u[384 + i];
    if (m < NPT) {
#pragma unroll
      for (int i = 0; i < 32; ++i) { KPEALL[(size_t)kr * 32 + i] = x[i]; p.out[OUT_KPE + (size_t)m * 32 + i] = x[i]; }
    } else {
      rope32(x, o, l);
#pragma unroll
      for (int i = 0; i < 32; ++i) KPEALL[(size_t)kr * 32 + i] = o[i];
    }
  }
  for (int i = lane; i < 1024; i += 64) Z[(size_t)m * D + i] = u[416 + i];
}
__global__ void k_mla_cache(P p, float* CKVALL, float* KPEALL) {
  int idx = blockIdx.x * blockDim.x + threadIdx.x;
  if (idx >= 2 * PAST * 128) return;
  int d = idx & 127, pl = (idx >> 7) & 511, b = idx >> 16;
  int row = NPT + b * 2560 + pl;
  CKVALL[(size_t)row * 128 + d] = p.cache_ckv[idx];
  if (d < 32) KPEALL[(size_t)row * 32 + d] = p.cache_kpe[((size_t)b * PAST + pl) * 32 + d];
}
__global__ void k_rope_q(float* Q) {
  int idx = blockIdx.x * blockDim.x + threadIdx.x;
  if (idx >= 4096 * 16) return;
  int h = idx & 15, mm = idx >> 4; int m = NPT + mm; int l = mm & 2047;
  float* q = Q + (size_t)m * 1536 + h * 96 + 64;
  float x[32], o[32];
#pragma unroll
  for (int i = 0; i < 32; ++i) x[i] = q[i];
  rope32(x, o, l);
#pragma unroll
  for (int i = 0; i < 32; ++i) q[i] = o[i];
}
__global__ void __launch_bounds__(64) k_attn(const float* Q, const float* KV, const float* KPEALL, float* G) {
  int qi = blockIdx.x * 64 + threadIdx.x;
  int sh = blockIdx.y; int h = sh & 15, seq = sh >> 4;
  int L = seq < 16 ? 256 : 2048;
  if (qi >= L) return;
  int m = seq < 16 ? seq * 256 + qi : NPT + (seq - 16) * 2048 + qi;
  int kbase = seq < 16 ? seq * 256 : NPT + (seq - 16) * 2560;
  int nk = seq < 16 ? 256 : 2560;
  float q[96];
#pragma unroll
  for (int i = 0; i < 96; ++i) q[i] = Q[(size_t)m * 1536 + h * 96 + i];
  float acc[64];
#pragma unroll
  for (int i = 0; i < 64; ++i) acc[i] = 0.f;
  float mx = -1e30f, lsum = 0.f;
  const float scale = 0.10206207261596575f;
  for (int k = 0; k < nk; ++k) {
    const float* kv = KV + (size_t)(kbase + k) * 2048 + h * 128;
    const float* kp = KPEALL + (size_t)(kbase + k) * 32;
    float s = 0.f;
#pragma unroll
    for (int i = 0; i < 64; ++i) s += q[i] * kv[i];
#pragma unroll
    for (int i = 0; i < 32; ++i) s += q[64 + i] * kp[i];
    s *= scale;
    float mn = fmaxf(mx, s);
    float corr = expf(mx - mn), pe = expf(s - mn);
    lsum = lsum * corr + pe;
#pragma unroll
    for (int i = 0; i < 64; ++i) acc[i] = acc[i] * corr + pe * kv[64 + i];
    mx = mn;
  }
  float inv = 1.f / lsum;
#pragma unroll
  for (int i = 0; i < 64; ++i) { size_t o = (size_t)m * D + h * 64 + i; G[o] = acc[i] * inv * silu(G[o]); }
}

__global__ void __launch_bounds__(64) k_rw_scan(P p, const float* R, const float* K, const float* V, const float* HW, const float* HA, float* Y) {
  int id = blockIdx.x;
  int h = id & 15, dir = (id >> 4) & 1, seq = id >> 5;
  int lane = threadIdx.x;
  int L = seq < 16 ? 256 : 2048;
  int m0 = seq < 16 ? seq * 256 : NPT + (seq - 16) * 2048;
  int ch = h * 64 + lane;
  float S[64];
  if (seq < 16) {
#pragma unroll
    for (int j = 0; j < 64; ++j) S[j] = 0.f;
  } else {
    const float* s0 = p.state_rwkv + ((((size_t)(seq - 16) * 1 + 0) * 2 + dir) * 16 + h) * 4096 + (size_t)lane * 64;
#pragma unroll
    for (int j = 0; j < 64; ++j) S[j] = s0[j];
  }
  const float w0 = p.rw_w0[dir * D + ch], a0 = p.rw_a0[dir * D + ch];
  const float kkw = p.rw_k_k[ch], kaw = p.rw_k_a[ch];
  const float* w2 = p.rw_w2 + (size_t)dir * 64 * D + ch;
  const float* a2 = p.rw_a2 + (size_t)dir * 64 * D + ch;
  for (int st = 0; st < L; ++st) {
    int t = dir ? (L - 1 - st) : st;
    int m = m0 + t;
    float wl = w0, al = a0;
    const float* hw = HW + (size_t)m * 128 + dir * 64;
    const float* ha = HA + (size_t)m * 128 + dir * 64;
    for (int r = 0; r < 64; ++r) { wl += hw[r] * w2[(size_t)r * D]; al += ha[r] * a2[(size_t)r * D]; }
    float sp = (-wl > 20.f) ? -wl : log1pf(expf(-wl));
    float dec = expf(-expf(-sp - 0.5f));
    float a = sigmoidf(al);
    float k = K[(size_t)m * D + ch], r_ = R[(size_t)m * D + ch], v = V[(size_t)m * D + ch];
    float kk = k * kkw; float ss = kk * kk;
#pragma unroll
    for (int o = 1; o < 64; o <<= 1) ss += __shfl_xor(ss, o);
    kk *= rsqrtf(ss + 1e-12f);
    float kd = k * (1.f + (a - 1.f) * kaw);
    float bd = kk * a;
    float at = -kk;
    float sa = 0.f;
#pragma unroll
    for (int j = 0; j < 64; ++j) sa += S[j] * __shfl(at, j);
    float y = 0.f;
#pragma unroll
    for (int j = 0; j < 64; ++j) {
      float wj = __shfl(dec, j), bj = __shfl(bd, j), kj = __shfl(kd, j), rj = __shfl(r_, j);
      S[j] = S[j] * wj + sa * bj + v * kj;
      y += S[j] * rj;
    }
    atomicAdd(&Y[(size_t)m * D + ch], y);
  }
  if (seq < 16) {
    float* so = p.out + OUT_ST + ((((size_t)seq * 1 + 0) * 2 + dir) * 16 + h) * 4096 + (size_t)lane * 64;
#pragma unroll
    for (int j = 0; j < 64; ++j) so[j] = S[j];
  }
}
__global__ void __launch_bounds__(64) k_rw_post(P p, const float* R, const float* K, const float* V, const float* Z, const float* HA, const float* Y, float* G) {
  int m = blockIdx.x >> 4, h = blockIdx.x & 15, lane = threadIdx.x; int ch = h * 64 + lane;
  float y = Y[(size_t)m * D + ch];
  float s = y;
#pragma unroll
  for (int o = 1; o < 64; o <<= 1) s += __shfl_xor(s, o);
  float mu = s * (1.f / 64.f); float d = y - mu; float q = d * d;
#pragma unroll
  for (int o = 1; o < 64; o <<= 1) q += __shfl_xor(q, o);
  float yn = d * rsqrtf(q * (1.f / 64.f) + GN_EPS) * p.rw_gn_g[ch] + p.rw_gn_b[ch];
  float k = K[(size_t)m * D + ch], r_ = R[(size_t)m * D + ch], v = V[(size_t)m * D + ch];
  float bsum = 0.f;
  for (int dir = 0; dir < 2; ++dir) {
    float al = p.rw_a0[dir * D + ch];
    const float* ha = HA + (size_t)m * 128 + dir * 64;
    const float* a2 = p.rw_a2 + (size_t)dir * 64 * D + ch;
    for (int r = 0; r < 64; ++r) al += ha[r] * a2[(size_t)r * D];
    float a = sigmoidf(al);
    float kd = k * (1.f + (a - 1.f) * p.rw_k_a[ch]);
    bsum += r_ * kd * p.rw_r_k[ch];
  }
#pragma unroll
  for (int o = 1; o < 64; o <<= 1) bsum += __shfl_xor(bsum, o);
  float o_ = yn + bsum * v;
  G[(size_t)m * D + ch] = o_ * silu(Z[(size_t)m * D + ch]);
}

typedef unsigned short bf16_t;
namespace pg8 {
#define PG8_LAS __attribute__((address_space(3)))
typedef unsigned short bf16_t;
typedef short bf16x8 __attribute__((ext_vector_type(8)));
typedef float f32x4 __attribute__((ext_vector_type(4)));
typedef unsigned u32x4 __attribute__((ext_vector_type(4)));
constexpr int BM = 256, BK = 64, HALF = 128, HTB = HALF * BK * 2  , STAGE_BYTES = 8 * HTB, NXCD = 8, WGM = 8;

__host__ __device__ __forceinline__ int lds_byte(int r, int c) { const int st = (r >> 4) * 2 + (c >> 5), rr = r & 15, cc = c & 31, ob = rr * 64 + cc * 2; return st * 1024 + (ob ^ (((ob >> 9) & 1) << 5)); }
__host__ __device__ __forceinline__ void stage_rc(int b, int& R, int& C) { const int st = b / 1024, sb = b % 1024, swz = sb ^ (((sb >> 9) & 1) << 5); R = (st >> 1) * 16 + swz / 64; C = (st & 1) * 32 + (swz % 64) / 2; }
__host__ __device__ __forceinline__ int perm32(int rho) { const int n = rho >> 4, i = rho & 15; return 8 * (i >> 2) + 4 * n + (i & 3); }

struct Unit { int pm, pn; };
struct Gemm { const bf16_t* A; const bf16_t* Bt; int M, N, K; };

struct StaticOrder {
    int nM, nN, nwg, G, c;
    __host__ __device__ void init(int M, int N, int G_, int c_) { nM = M / BM; nN = N / BM; nwg = nM * nN; G = G_; c = c_; }
    __host__ __device__ bool next(int i, Unit& u) const {
        const long L = (long)i * G + c; if (L >= nwg) return false;
        int wgid = (int)L; { const int q = nwg / NXCD, r = nwg % NXCD, xcd = wgid % NXCD, off = wgid / NXCD; wgid = (xcd < r ? xcd * (q + 1) : r * (q + 1) + (xcd - r) * q) + off; }
        const int nig = WGM * nN, gid = wgid / nig, fm = gid * WGM, gsz = (nM - fm) < WGM ? (nM - fm) : WGM;
        u.pm = fm + ((wgid % nig) % gsz); u.pn = (wgid % nig) / gsz; return true;
    }
    __device__ __forceinline__ void a_ready(const Unit&) const {}
    __device__ __forceinline__ void done(const Unit&) const {}
};
__device__ __forceinline__ unsigned cvt_pk_bf16(float lo, float hi) { unsigned r; asm volatile("v_cvt_pk_bf16_f32 %0, %1, %2" : "=v"(r) : "v"(lo), "v"(hi)); return r; }
typedef float f32x2 __attribute__((ext_vector_type(2)));
template <int ACT  > struct EpiBf16 {
    static constexpr bool PERM = true, AFTER_DRAIN = false; static_assert(ACT == 0 || ACT == 1, "EpiBf16: ACT is 0 (none) or 1 (gelu_pk)");
    bf16_t* O; int ldc; const float* bias; int split_cols; size_t split_stride; float scale0;
    __device__ __forceinline__ void operator()(const f32x4 (&acc)[2][2][4][2], const Unit& u, int wr, int wc, int fr, int fq) const {
        const int row0 = u.pm * BM + wr * 64 + fr; int colt = u.pn * BM; bf16_t* base = O;
        float sc = 1.f; if (split_cols) { const int t = colt / split_cols; base += (size_t)t * split_stride; colt -= t * split_cols; if (t == 0) sc = scale0; }
        const int col0 = colt + wc * 32 + 8 * fq, bcol0 = u.pn * BM + wc * 32 + 8 * fq;
        f32x4 bv[2][2];
#pragma unroll
        for (int bj = 0; bj < 2; ++bj)
#pragma unroll
            for (int n = 0; n < 2; ++n) bv[bj][n] = bias ? *(const f32x4*)(bias + bcol0 + bj * HALF + 4 * n) : (f32x4){0.f, 0.f, 0.f, 0.f};
#pragma unroll
        for (int ai = 0; ai < 2; ++ai)
#pragma unroll
            for (int m = 0; m < 4; ++m) { bf16_t* rowp = base + (size_t)(row0 + ai * HALF + m * 16) * ldc + col0;
#pragma unroll
                for (int bj = 0; bj < 2; ++bj) { f32x4 v0 = acc[ai][bj][m][0] + bv[bj][0], v1 = acc[ai][bj][m][1] + bv[bj][1];
                    v0 = v0 * sc; v1 = v1 * sc; u32x4 w; w.x = cvt_pk_bf16(v0[0], v0[1]); w.y = cvt_pk_bf16(v0[2], v0[3]); w.z = cvt_pk_bf16(v1[0], v1[1]); w.w = cvt_pk_bf16(v1[2], v1[3]);
                    *(u32x4*)(rowp + bj * HALF) = w; } }
    }
};
template <class Epi, class Sched, bool ALIGN_EPI = false, bool SP2 = false>
__device__ __forceinline__ void gemm_phase(PG8_LAS unsigned char* lds, const Gemm g, const Sched& S, const Epi& E) {
    const int tid = threadIdx.x, wid = __builtin_amdgcn_readfirstlane(tid >> 6), lane = tid & 63, wr = wid >> 2, wc = wid & 3, fr = lane & 15, fq = lane >> 4;
    const int K = g.K, nt = K / BK;
    unsigned voffA[2], voffB[2];
#pragma unroll
    for (int i = 0; i < 2; ++i) { int R, C; stage_rc(tid * 16 + i * 8192, R, C); const int Rb = Epi::PERM ? ((R & ~31) + perm32(R & 31)) : R;
        voffA[i] = (unsigned)(R * K + C) * 2u; voffB[i] = (unsigned)(Rb * K + C) * 2u; }
    const size_t kstep = (size_t)(BK * 2);
    const size_t hstep = (size_t)HALF * K * 2;
    const size_t tstep = 2 * hstep;
    const unsigned ldsw = (unsigned)wid * 1024u;
    const int aoff = lds_byte(wr * 64 + fr, fq * 8), boff = lds_byte(wc * 32 + fr, fq * 8);
#define PG8_SA(b, h) (((b) * 2 + (h)) * HTB)
#define PG8_SB(b, h) ((4 + (b) * 2 + (h)) * HTB)
#define PG8_STAGE(bufoff, gbase, voff) do { _Pragma("unroll") for (int _i = 0; _i < 2; ++_i) \
        __builtin_amdgcn_global_load_lds((const unsigned*)((const char*)(gbase) + (voff)[_i]), (PG8_LAS unsigned*)(lds + (bufoff) + ldsw + _i * 8192), 16, 0, 0); } while (0)
#define PG8_LDA(dst, b, h) do { _Pragma("unroll") for (int m = 0; m < 4; ++m) _Pragma("unroll") for (int k = 0; k < 2; ++k) dst[m][k] = *(const PG8_LAS bf16x8*)(lds + PG8_SA(b, h) + aoff + m * 2048 + k * 1024); } while (0)
#define PG8_LDB(dst, b, h) do { _Pragma("unroll") for (int n = 0; n < 2; ++n) _Pragma("unroll") for (int k = 0; k < 2; ++k) dst[n][k] = *(const PG8_LAS bf16x8*)(lds + PG8_SB(b, h) + boff + n * 2048 + k * 1024); } while (0)
#define PG8_MMA(ai, bj, At, Bt) do { __builtin_amdgcn_s_setprio(1); _Pragma("unroll") for (int m = 0; m < 4; ++m) _Pragma("unroll") for (int n = 0; n < 2; ++n) _Pragma("unroll") for (int k = 0; k < 2; ++k) \
        acc[ai][bj][m][n] = __builtin_amdgcn_mfma_f32_16x16x32_bf16(Bt[n][k], At[m][k], acc[ai][bj][m][n], 0, 0, 0); __builtin_amdgcn_s_setprio(0); } while (0)
#define PG8_WAIT_V(n) asm volatile("s_waitcnt vmcnt(" #n ")" ::: "memory")
#define PG8_WAIT_L(n) asm volatile("s_waitcnt lgkmcnt(" #n ")" ::: "memory")
#define PG8_BAR __builtin_amdgcn_s_barrier()
#define PG8_SCHED __builtin_amdgcn_sched_barrier(0)
    Unit cur, nxt; int ui = 0;
    if (!S.next(0, cur)) return;
    f32x4 acc[2][2][4][2];
#pragma unroll
    for (int a = 0; a < 2; ++a)
#pragma unroll
        for (int b = 0; b < 2; ++b)
#pragma unroll
            for (int m = 0; m < 4; ++m)
#pragma unroll
                for (int n = 0; n < 2; ++n) acc[a][b][m][n] = (f32x4){0.f, 0.f, 0.f, 0.f};
    bf16x8 At[4][2], B0[2][2], B1[2][2];
    const char* cA = (const char*)g.A + (size_t)cur.pm * tstep; const char* cB = (const char*)g.Bt + (size_t)cur.pn * tstep;
    S.a_ready(cur);
    if constexpr (SP2) {
        PG8_STAGE(PG8_SB(0, 0), cB, voffB); PG8_STAGE(PG8_SB(0, 1), cB + hstep, voffB); PG8_STAGE(PG8_SA(0, 0), cA, voffA); PG8_STAGE(PG8_SA(0, 1), cA + hstep, voffA);
        if (wr == 1) PG8_BAR;
        PG8_WAIT_V(2); PG8_BAR;
        PG8_STAGE(PG8_SB(1, 0), cB + kstep, voffB); PG8_STAGE(PG8_SA(1, 0), cA + kstep, voffA); PG8_STAGE(PG8_SB(1, 1), cB + hstep + kstep, voffB);
        PG8_WAIT_V(6); PG8_BAR;
    } else {
        PG8_STAGE(PG8_SB(0, 0), cB, voffB); PG8_STAGE(PG8_SA(0, 0), cA, voffA); PG8_STAGE(PG8_SB(0, 1), cB + hstep, voffB); PG8_STAGE(PG8_SA(0, 1), cA + hstep, voffA);
        if (wr == 1) PG8_BAR;
        PG8_WAIT_V(4); PG8_BAR;
        PG8_STAGE(PG8_SB(1, 0), cB + kstep, voffB); PG8_STAGE(PG8_SA(1, 0), cA + kstep, voffA); PG8_STAGE(PG8_SB(1, 1), cB + hstep + kstep, voffB);
        PG8_WAIT_V(6); PG8_BAR;
    }
    for (;;) {
        const bool has_next = S.next(ui + 1, nxt);
        const char* nA = has_next ? (const char*)g.A + (size_t)nxt.pm * tstep : cA; const char* nB = has_next ? (const char*)g.Bt + (size_t)nxt.pn * tstep : cB;
        for (int t = 0; t < nt; t += 2) {
            const bool last = (t == nt - 2);
            const char* a1 = cA + (size_t)(t + 1) * kstep;
            const char* a2 = last ? nA : cA + (size_t)(t + 2) * kstep; const char* b2 = last ? nB : cB + (size_t)(t + 2) * kstep;
            const char* a3 = a2 + kstep; const char* b3 = b2 + kstep;
            if (last && has_next) S.a_ready(nxt);
            if constexpr (SP2) {
            PG8_LDB(B0, 0, 0); PG8_LDB(B1, 0, 1); PG8_SCHED; PG8_LDA(At, 0, 0); PG8_STAGE(PG8_SA(1, 1), a1 + hstep, voffA);
            PG8_WAIT_V(8); PG8_WAIT_L(0); PG8_BAR; PG8_MMA(0, 0, At, B0); PG8_MMA(0, 1, At, B1); PG8_BAR; PG8_SCHED;
            PG8_LDA(At, 0, 1); PG8_STAGE(PG8_SB(0, 0), b2, voffB); PG8_STAGE(PG8_SB(0, 1), b2 + hstep, voffB); PG8_STAGE(PG8_SA(0, 0), a2, voffA);
            PG8_WAIT_V(8); PG8_WAIT_L(0); PG8_BAR; PG8_MMA(1, 0, At, B0); PG8_MMA(1, 1, At, B1); PG8_BAR; PG8_SCHED;
            PG8_LDB(B0, 1, 0); PG8_LDB(B1, 1, 1); PG8_SCHED; PG8_LDA(At, 1, 0); PG8_STAGE(PG8_SA(0, 1), a2 + hstep, voffA);
            PG8_WAIT_V(8); PG8_WAIT_L(0); PG8_BAR; PG8_MMA(0, 0, At, B0); PG8_MMA(0, 1, At, B1); PG8_BAR; PG8_SCHED;
            PG8_LDA(At, 1, 1); PG8_STAGE(PG8_SB(1, 0), b3, voffB); PG8_STAGE(PG8_SB(1, 1), b3 + hstep, voffB); PG8_STAGE(PG8_SA(1, 0), a3, voffA);
            PG8_WAIT_V(8); PG8_WAIT_L(0); PG8_BAR; PG8_MMA(1, 0, At, B0); PG8_MMA(1, 1, At, B1); PG8_BAR; PG8_SCHED;
            } else {
            PG8_LDB(B0, 0, 0); PG8_SCHED; PG8_LDA(At, 0, 0); PG8_STAGE(PG8_SA(1, 1), a1 + hstep, voffA);
            PG8_WAIT_L(8); PG8_BAR; PG8_WAIT_L(0); PG8_MMA(0, 0, At, B0); PG8_BAR; PG8_SCHED;
            PG8_LDB(B1, 0, 1); PG8_STAGE(PG8_SB(0, 0), b2, voffB);
            PG8_BAR; PG8_WAIT_L(0); PG8_MMA(0, 1, At, B1); PG8_BAR;
            PG8_LDA(At, 0, 1); PG8_STAGE(PG8_SA(0, 0), a2, voffA);
            PG8_BAR; PG8_WAIT_L(0); PG8_MMA(1, 0, At, B0); PG8_BAR; PG8_SCHED;
            PG8_STAGE(PG8_SB(0, 1), b2 + hstep, voffB);
            PG8_WAIT_V(6); PG8_BAR; PG8_MMA(1, 1, At, B1); PG8_BAR;
            PG8_LDB(B0, 1, 0); PG8_SCHED; PG8_LDA(At, 1, 0); PG8_STAGE(PG8_SA(0, 1), a2 + hstep, voffA);
            PG8_WAIT_L(8); PG8_BAR; PG8_WAIT_L(0); PG8_MMA(0, 0, At, B0); PG8_BAR; PG8_SCHED;
            PG8_LDB(B1, 1, 1); PG8_STAGE(PG8_SB(1, 0), b3, voffB);
            PG8_BAR; PG8_WAIT_L(0); PG8_MMA(0, 1, At, B1); PG8_BAR;
            PG8_LDA(At, 1, 1); PG8_STAGE(PG8_SA(1, 0), a3, voffA);
            PG8_BAR; PG8_WAIT_L(0); PG8_MMA(1, 0, At, B0); PG8_BAR; PG8_SCHED;
            PG8_STAGE(PG8_SB(1, 1), b3 + hstep, voffB);
            PG8_WAIT_V(6); PG8_BAR; PG8_MMA(1, 1, At, B1); PG8_BAR;
            }
        }
        if constexpr (ALIGN_EPI) { if (wr == 0) PG8_BAR; }
        if constexpr (!Epi::AFTER_DRAIN) { E(acc, cur, wr, wc, fr, fq); S.done(cur); }
        if (!has_next) break;
#pragma unroll
        for (int a = 0; a < 2; ++a)
#pragma unroll
            for (int b = 0; b < 2; ++b)
#pragma unroll
                for (int m = 0; m < 4; ++m)
#pragma unroll
                    for (int n = 0; n < 2; ++n) acc[a][b][m][n] = (f32x4){0.f, 0.f, 0.f, 0.f};
        cur = nxt; cA = nA; cB = nB; ++ui;
        if constexpr (ALIGN_EPI) { if (wr == 1) PG8_BAR; }
    }
    PG8_WAIT_V(0);
    if constexpr (!ALIGN_EPI) { if (wr == 0) PG8_BAR; }
    PG8_BAR;
    if constexpr (Epi::AFTER_DRAIN) { E.fused(acc, cur, wr, wc, fr, fq, lds, wid, lane); S.done(cur); }
#undef PG8_SA
#undef PG8_SB
#undef PG8_STAGE
#undef PG8_LDA
#undef PG8_LDB
#undef PG8_MMA
#undef PG8_WAIT_V
#undef PG8_WAIT_L
#undef PG8_BAR
#undef PG8_SCHED
}
}
#define GAS __attribute__((address_space(1)))
#define LAS __attribute__((address_space(3)))
typedef unsigned short bf16;
typedef unsigned v4u __attribute__((ext_vector_type(4)));
typedef float f32x4 __attribute__((ext_vector_type(4)));
typedef short bf16x8 __attribute__((ext_vector_type(8)));
typedef GAS unsigned gu32;
typedef GAS unsigned long long gu64;
#define RLX_AGENT __ATOMIC_RELAXED, __HIP_MEMORY_SCOPE_AGENT
#define LDS_WAIT() asm volatile("s_waitcnt lgkmcnt(0)" ::: "memory")
#define VM_WAIT() asm volatile("s_waitcnt vmcnt(0)" ::: "memory")
__device__ __forceinline__ unsigned long long rt() { return __builtin_amdgcn_s_memrealtime(); }
__device__ __forceinline__ unsigned f2bf(float f) { unsigned u = __builtin_bit_cast(unsigned, f); return (u + 0x7fffu + ((u >> 16) & 1u)) >> 16; }
__device__ __forceinline__ unsigned pk2(float lo, float hi) { return f2bf(lo) | (f2bf(hi) << 16); }

#define XB_TMO      128
#define XB_XCNT(j)  (256  + 64 * (j))
#define XB_XSUB(j)  (1280 + 64 * (j))
#define XB_XGEN(j)  (2304 + 64 * (j))
#define XB_TOP      3328
#define XB_TOPGEN   3392
#define XCD_BAR_WORDS 3456
#define XB_SPIN_CAP (1u << 18)

__device__ __forceinline__ unsigned xb_ld(unsigned* p)              { return __hip_atomic_load(p, __ATOMIC_RELAXED, __HIP_MEMORY_SCOPE_AGENT); }
__device__ __forceinline__ unsigned xb_add(unsigned* p, unsigned v) { return __hip_atomic_fetch_add(p, v, __ATOMIC_RELAXED, __HIP_MEMORY_SCOPE_AGENT); }
__device__ __forceinline__ unsigned xb_xcc_id() { return (unsigned)__builtin_amdgcn_s_getreg((3 << 11) | 20) & 0xFu; }
#define XB_SPIN(cond, bar) do { unsigned _sp = 0; while (cond) { __builtin_amdgcn_s_sleep(1); \
    if ((++_sp & 255u) == 0u) { if (xb_ld(&(bar)[XB_TMO])) break; if (_sp > XB_SPIN_CAP) { atomicAdd(&(bar)[XB_TMO], 1u); break; } } } } while (0)

struct XcdBarrier {
    unsigned* bar; unsigned x;
    volatile LAS unsigned* st;
};

__device__ __forceinline__ XcdBarrier xcd_barrier_post(unsigned* bar, volatile LAS unsigned* st) {
    XcdBarrier b; b.bar = bar; b.x = xb_xcc_id(); b.st = st;
    if (threadIdx.x == 0) (void)xb_add(&bar[XB_XCNT(b.x)], 1u);
    return b;
}
__device__ __forceinline__ void xcd_barrier_complete(unsigned* bar, unsigned x, unsigned& nloc, unsigned& nx) {
    const unsigned G = gridDim.x * gridDim.y * gridDim.z;
    unsigned sum, cnt, mine, sp = 0u;
    for (;;) {
        sum = 0u; cnt = 0u; mine = 0u;
#pragma unroll
        for (unsigned j = 0; j < 16; ++j) { const unsigned c = xb_ld(&bar[XB_XCNT(j)]); sum += c; cnt += (c > 0u) ? 1u : 0u; mine = (j == x) ? c : mine; }
        if (sum == G) break;
        __builtin_amdgcn_s_sleep(1);
        if ((++sp & 255u) == 0u) { if (xb_ld(&bar[XB_TMO])) break; if (sp > XB_SPIN_CAP) { atomicAdd(&bar[XB_TMO], 1u); break; } }
    }
    nloc = mine > 0u ? mine : 1u; nx = cnt > 0u ? cnt : 1u;
}

__device__ __forceinline__ void xcd_barrier(const XcdBarrier& b) {
    asm volatile("s_waitcnt vmcnt(0)" ::: "memory");
    __syncthreads();
    if (threadIdx.x == 0) {
        unsigned* bar = b.bar;
        __builtin_amdgcn_s_waitcnt(0);
        unsigned nloc = b.st[0], nx = b.st[1];
        if (nloc == 0u) { xcd_barrier_complete(bar, b.x, nloc, nx); b.st[0] = nloc; b.st[1] = nx; }
        const unsigned old = xb_add(&bar[XB_XSUB(b.x)], 1u);
        const unsigned gen = old / nloc;
        if (old + 1u == (gen + 1u) * nloc) {
            __builtin_amdgcn_fence(__ATOMIC_RELEASE, "agent");
            asm volatile("s_waitcnt vmcnt(0)" ::: "memory");
            const unsigned og = xb_add(&bar[XB_TOP], 1u);
            const unsigned tg = og / nx;
            if (og + 1u == (tg + 1u) * nx) xb_add(&bar[XB_TOPGEN], 1u);
            else XB_SPIN(xb_ld(&bar[XB_TOPGEN]) == tg, bar);
            __builtin_amdgcn_fence(__ATOMIC_ACQUIRE, "agent");
            xb_add(&bar[XB_XGEN(b.x)], 1u);
            asm volatile("s_waitcnt vmcnt(0)" ::: "memory");
        } else {
            XB_SPIN(xb_ld(&bar[XB_XGEN(b.x)]) == gen, bar);
            __builtin_amdgcn_fence(__ATOMIC_ACQUIRE, "agent");
            asm volatile("s_waitcnt vmcnt(0)" ::: "memory");
        }
    }
    __syncthreads();
}
typedef __attribute__((address_space(1))) float GASF;
struct PG {
  const GASF *x_prompt, *x_sample, *cache_ckv, *cache_kpe, *state_rwkv, *c, *c_ctx;
  const GASF *mod_w, *mod_b, *ln_g, *ln_b;
  const GASF *hy_w_in, *hy_conv_w, *hy_conv_b, *hy_w1, *hy_b1, *hy_w2, *hy_b2, *hy_w3, *hy_b3, *hy_freq, *hy_decay, *hy_skip, *hy_w_out;
  const GASF *mla_w_in, *mla_q_norm, *mla_kv_norm, *mla_w_q_up, *mla_w_kv_up, *mla_w_out;
  const GASF *rw_mu, *rw_w_in, *rw_w0, *rw_w1, *rw_w2, *rw_a0, *rw_a1, *rw_a2, *rw_k_k, *rw_k_a, *rw_r_k, *rw_gn_g, *rw_gn_b, *rw_w_out;
  GASF* out;
  GASF* ws;
};
namespace mk {
typedef float f32x16 __attribute__((ext_vector_type(16)));
typedef short v4i16_t __attribute__((ext_vector_type(4)));
typedef unsigned u32x4 __attribute__((ext_vector_type(4)));
typedef unsigned u32x2 __attribute__((ext_vector_type(2)));
typedef unsigned short u16;

constexpr size_t MiB = 1u << 20;
constexpr size_t M_X = 0, M_HB = 32 * MiB, M_GB = 48 * MiB, M_UT = 64 * MiB, M_SCR2 = 128 * MiB, M_WTS = 192 * MiB, M_FILT = 230 * MiB;
constexpr size_t M_HDN2 = 248 * MiB + 512 * 1024, M_MODP = 250 * MiB, M_MODS = 254 * MiB, M_CTL = 255 * MiB;
constexpr size_t W_HYIN = M_WTS, W_HYOUT = M_WTS + 16 * MiB, W_MLAIN = M_WTS + 20 * MiB, W_QUP = M_WTS + 23 * MiB, W_KVUP = M_WTS + 24 * MiB,
                 W_MLAOUT = M_WTS + 25 * MiB, W_RWIN = M_WTS + 27 * MiB, W_LORA1 = M_WTS + 35 * MiB, W_RWOUT = M_WTS + 36 * MiB;
constexpr size_t M_QN = M_SCR2, M_CKVALL = M_SCR2 + 4 * MiB, M_KPEB = M_SCR2 + 7 * MiB, M_SZB = M_SCR2 + 8 * MiB, M_Q = M_UT, M_KN = M_UT + 24 * MiB, M_V = M_UT + 42 * MiB;
constexpr int FILT_CH = 4640;
constexpr int LDS_BYTES = 163840, MISC_OFF = LDS_BYTES - 512, PTAB_OFF = LDS_BYTES - 1024;

__device__ __forceinline__ float bf2f(unsigned v) { return __builtin_bit_cast(float, v << 16); }
__device__ __forceinline__ unsigned f2bf_(float f) { unsigned u = __builtin_bit_cast(unsigned, f); return (u + 0x7fffu + ((u >> 16) & 1u)) >> 16; }
__device__ __forceinline__ unsigned pk2_(float lo, float hi) { return f2bf_(lo) | (f2bf_(hi) << 16); }
__device__ __forceinline__ v4i16_t vtr(LAS const unsigned char* p) { return __builtin_amdgcn_ds_read_tr16_b64_v4i16((LAS v4i16_t*)p); }
__device__ __forceinline__ float wsum(float v) {
#pragma unroll
  for (int o = 1; o < 64; o <<= 1) v += __shfl_xor(v, o);
  return v;
}
__device__ __forceinline__ const GASF* xrow_in(const LAS PG& p, int layer, const unsigned char* ws, int m) {
  if (layer == 0) return (m < NPT) ? p.x_prompt + (size_t)m * D : p.x_sample + (size_t)(m - NPT) * D;
  return (const GASF*)(ws + M_X) + (size_t)m * D;
}

__device__ __forceinline__ void tr_item(const GASF* W, int K, int N, bf16_t* WT, int kind, int row_off, int remap416, LAS float* scr, int item, int lane) {
  const int nblk = N / 32, kb = item / nblk, nb = item % nblk, k0 = 64 * kb, n0 = 32 * nb;
#pragma unroll 8
  for (int i = 0; i < 32; ++i) { const int kk = 2 * i + (lane >> 5); scr[kk * 33 + (lane & 31)] = W[(size_t)(k0 + kk) * N + n0 + (lane & 31)]; }
  asm volatile("s_waitcnt lgkmcnt(0)" ::: "memory");
  const int c = lane & 7;
#pragma unroll
  for (int jj = 0; jj < 4; ++jj) {
    const int n = (lane >> 3) + 8 * jj; LAS const float* s = scr + (8 * c) * 33 + n;
    u32x4 o; o.x = pk2_(s[0 * 33], s[1 * 33]); o.y = pk2_(s[2 * 33], s[3 * 33]); o.z = pk2_(s[4 * 33], s[5 * 33]); o.w = pk2_(s[6 * 33], s[7 * 33]);
    const int ng = n0 + n + row_off;
    if (kind == 0) {
      *(u32x4*)(WT + (size_t)ng * K + k0 + 8 * c) = o;
    } else {
      const int k8 = (k0 >> 3) + c;
      const size_t ci = ((size_t)((ng >> 5) * 64 + (k8 >> 1))) * 64 + (ng & 31) + 32 * (k8 & 1);
      *(u32x4*)(WT + ci * 8) = o;
    }
  }
  asm volatile("s_waitcnt lgkmcnt(0)" ::: "memory");
}

__device__ __forceinline__ void phase_p0a(const LAS PG& p, unsigned char* ws, LAS unsigned char* lds, int tid, int lane, int wave, int bid, int G) {
  LAS float* SC = (LAS float*)lds;
  for (int i = tid; i < 3072; i += 512) { const int g = i >> 10, k = i & 1023; const float c = (g == 0) ? p.c_ctx[k] : p.c[(g - 1) * 1024 + k]; SC[i] = silu(c); }
  __syncthreads();
  for (int it = bid; it < 192; it += G) {
    const int kc = it & 7, cc = (it >> 3) % 6, i = it / 48;
    const int n = cc * 512 + tid;
    const GASF* w = p.mod_w + ((size_t)i * 1024 + kc * 128) * 3072 + n;
    float a0 = 0.f, a1 = 0.f, a2 = 0.f;
#pragma unroll 8
    for (int k = 0; k < 128; ++k) { const float wv = w[(size_t)k * 3072]; const int kk = kc * 128 + k; a0 += SC[kk] * wv; a1 += SC[1024 + kk] * wv; a2 += SC[2048 + kk] * wv; }
    float* mp = (float*)(ws + M_MODP) + (size_t)kc * 36864 + (size_t)i * 9216 + n;
    mp[0] = a0; mp[3072] = a1; mp[6144] = a2;
  }
  __syncthreads();
  for (int i = bid * 512 + tid; i < 2 * PAST * 128 / 8; i += G * 512) {
    const int d8 = i & 15, pl = (i >> 4) & 511, b = i >> 13;
    const f32x4* src = (const f32x4*)(p.cache_ckv + ((size_t)(b * PAST + pl)) * 128 + d8 * 8);
    const f32x4 x0 = src[0], x1 = src[1];
    u32x4 o; o.x = pk2_(x0.x, x0.y); o.y = pk2_(x0.z, x0.w); o.z = pk2_(x1.x, x1.y); o.w = pk2_(x1.z, x1.w);
    *(u32x4*)((bf16_t*)(ws + M_CKVALL) + ((size_t)(NPT + b * 2560 + pl)) * 128 + d8 * 8) = o;
    if (d8 < 4) {
      const f32x4* s2 = (const f32x4*)(p.cache_kpe + ((size_t)(b * PAST + pl)) * 32 + d8 * 8);
      const f32x4 y0 = s2[0], y1 = s2[1];
      u32x4 o2; o2.x = pk2_(y0.x, y0.y); o2.y = pk2_(y0.z, y0.w); o2.z = pk2_(y1.x, y1.y); o2.w = pk2_(y1.z, y1.w);
      *(u32x4*)((bf16_t*)(ws + M_KPEB) + ((size_t)(NPT + b * 2560 + pl)) * 32 + d8 * 8) = o2;
    }
  }
  LAS float* scr = (LAS float*)(lds + wave * 8448);
  const int gw = bid * 8 + wave, NGW = G * 8;
  constexpr int I_HYIN = 16 * 128, I_SQ = 16 * 32, I_MLAIN = 16 * 45, I_QUP = 4 * 48, I_KVUP = 2 * 64, I_LORA = 16 * 2;
  constexpr int NTR = 2 * I_HYIN + 2 * I_SQ + I_MLAIN + I_QUP + I_KVUP + I_SQ + 4 * I_SQ + 4 * I_LORA + I_SQ;
  constexpr int NHD = 2 * 2304;
  for (int it = gw; it < NTR + NHD; it += NGW) {
    int r = it;
    if (r < NTR) {
      if (r < 2 * I_HYIN) { const int j = r / I_HYIN; tr_item(p.hy_w_in + (size_t)j * D * 4096, 1024, 4096, (bf16_t*)(ws + W_HYIN + (size_t)j * 8 * MiB), 0, 0, 0, scr, r % I_HYIN, lane); continue; } r -= 2 * I_HYIN;
      if (r < 2 * I_SQ) { const int j = r / I_SQ; tr_item(p.hy_w_out + (size_t)j * D * D, 1024, 1024, (bf16_t*)(ws + W_HYOUT + (size_t)j * 2 * MiB), 1, 0, 0, scr, r % I_SQ, lane); continue; } r -= 2 * I_SQ;
      if (r < I_MLAIN) { const int nb = r % 45; if (nb < 13) tr_item(p.mla_w_in, 1024, 1440, (bf16_t*)(ws + W_MLAIN), 1, 0, 0, scr, r, lane);
        else tr_item(p.mla_w_in, 1024, 1440, (bf16_t*)(ws + W_MLAIN + MiB), 0, -416, 0, scr, r, lane); continue; } r -= I_MLAIN;
      if (r < I_QUP) { tr_item(p.mla_w_q_up, 256, 1536, (bf16_t*)(ws + W_QUP), 0, 0, 0, scr, r, lane); continue; } r -= I_QUP;
      if (r < I_KVUP) { tr_item(p.mla_w_kv_up, 128, 2048, (bf16_t*)(ws + W_KVUP), 0, 0, 0, scr, r, lane); continue; } r -= I_KVUP;
      if (r < I_SQ) { tr_item(p.mla_w_out, 1024, 1024, (bf16_t*)(ws + W_MLAOUT), 1, 0, 0, scr, r, lane); continue; } r -= I_SQ;
      if (r < 4 * I_SQ) { const int q = r / I_SQ; tr_item(p.rw_w_in + (size_t)q * D * D, 1024, 1024, (bf16_t*)(ws + W_RWIN + (size_t)q * 2 * MiB), 0, 0, 0, scr, r % I_SQ, lane); continue; } r -= 4 * I_SQ;
      if (r < 4 * I_LORA) { const int q = r / I_LORA; const GASF* src = (q < 2) ? p.rw_w1 + (size_t)q * D * 64 : p.rw_a1 + (size_t)(q - 2) * D * 64;
        tr_item(src, 1024, 64, (bf16_t*)(ws + W_LORA1), 1, q * 64, 0, scr, r % I_LORA, lane); continue; } r -= 4 * I_LORA;
      tr_item(p.rw_w_out, 1024, 1024, (bf16_t*)(ws + W_RWOUT), 1, 0, 0, scr, r, lane);
    } else {
      r -= NTR;
      const int j = r / 2304, row = r % 2304;
      const int L = row < 256 ? 256 : 2048, l = row < 256 ? row : row - 256;
      const float t = (float)l / (float)(L - 1);
      float feat = 0.f;
      if (lane == 0) feat = t;
      else if (lane < 33) {
        const int b = (lane - 1) & 15;
        const float band = 1e-4f + (float)b * ((15.f - 1e-4f) / 15.f);
        const float ang = (6.283185307179586f / (float)L) * (float)l * band;
        feat = (lane <= 16) ? cosf(ang) : -sinf(ang);
      }
      float a = p.hy_b1[j * 64 + lane];
      for (int f = 0; f < 33; ++f) a += __shfl(feat, f) * p.hy_w1[((size_t)j * 33 + f) * 64 + lane];
      const float h1 = sinf(p.hy_freq[(j * 2 + 0) * 64 + lane] * a);
      float a2 = p.hy_b2[j * 64 + lane];
      for (int f = 0; f < 64; ++f) a2 += __shfl(h1, f) * p.hy_w2[((size_t)j * 64 + f) * 64 + lane];
      const float h2 = sinf(p.hy_freq[(j * 2 + 1) * 64 + lane] * a2);
      ((float*)(ws + M_HDN2))[(size_t)r * 64 + lane] = h2;
    }
  }
}

__device__ __forceinline__ void phase_p0b(const LAS PG& p, unsigned char* ws, LAS unsigned char* lds, int tid, int lane, int wave, int bid, int G) {
  const float* MP = (const float*)(ws + M_MODP);
  float* MODS = (float*)(ws + M_MODS);
  for (int idx = bid * 512 + tid; idx < 36864; idx += G * 512) {
    float s = p.mod_b[(idx / 9216) * 3072 + (idx % 3072)];
#pragma unroll
    for (int kc = 0; kc < 8; ++kc) s += MP[(size_t)kc * 36864 + idx];
    MODS[idx] = s;
  }
  LAS float* ML = (LAS float*)lds;
  for (int e = tid; e < 6144; e += 512) {
    const int g = e >> 11, r = e & 2047; const int idx = g * 3072 + r;
    float s = p.mod_b[r];
#pragma unroll
    for (int kc = 0; kc < 8; ++kc) s += MP[(size_t)kc * 36864 + idx];
    ML[e] = s;
  }
  __syncthreads();
  bf16_t* HB = (bf16_t*)(ws + M_HB);
#ifndef NO_H0
  for (int m = bid * 8 + wave; m < NTOK; m += G * 8) {
    int l, L, cond, m0; tokinfo(m, l, L, cond, m0);
    const GAS f32x4* xr = (const GAS f32x4*)xrow_in(p, 0, ws, m);
    LAS const float* sh = ML + cond * 2048; LAS const float* sc = sh + 1024;
#pragma unroll
    for (int i = 0; i < 4; ++i) {
      const int k = 4 * lane + 256 * i; const f32x4 x = xr[lane + 64 * i];
      u32x2 o; o.x = pk2_(x.x * (1.f + sc[k]) + sh[k], x.y * (1.f + sc[k + 1]) + sh[k + 1]); o.y = pk2_(x.z * (1.f + sc[k + 2]) + sh[k + 2], x.w * (1.f + sc[k + 3]) + sh[k + 3]);
      *(u32x2*)(HB + (size_t)m * D + k) = o;
    }
  }
#endif
  __syncthreads();
#ifndef NO_FG
  LAS float* hs = (LAS float*)(lds + wave * 2048);
  const int gw = bid * 8 + wave, NGW = G * 8;
  const float* HD = (const float*)(ws + M_HDN2);
  bf16_t* FILT = (bf16_t*)(ws + M_FILT);
  for (int it = gw; it < 2 * 2 * 16 * 290; it += NGW) {
    const int qq = it % 290, cch = (it / 290) & 15, dir = (it / (290 * 16)) & 1, j = it / (290 * 32);
    const int set = qq < 33 ? 0 : 1, qi = set ? qq - 33 : qq, L = set ? 2048 : 256, row0 = set ? 256 : 0;
    const int c = cch * 64 + lane, o = dir * 1024 + c;
    asm volatile("s_waitcnt lgkmcnt(0)" ::: "memory");
#pragma unroll
    for (int e = 0; e < 8; ++e) {
      const int lag = dir ? 8 * qi + e : 8 * qi - e;
      const bool ok = dir ? (lag >= 1 && lag <= L - 1) : (lag >= 0 && lag <= L - 1);
      hs[e * 64 + lane] = ok ? HD[((size_t)j * 2304 + row0 + lag) * 64 + lane] : 0.f;
    }
    asm volatile("s_waitcnt lgkmcnt(0)" ::: "memory");
    float acc[8];
    const float b3 = p.hy_b3[j * 2048 + o];
#pragma unroll
    for (int e = 0; e < 8; ++e) acc[e] = b3;
    const GASF* w3 = p.hy_w3 + (size_t)j * 64 * 2048 + o;
#pragma unroll 2
    for (int m4 = 0; m4 < 16; ++m4) {
      const float w0 = w3[(size_t)(4 * m4 + 0) * 2048], w1 = w3[(size_t)(4 * m4 + 1) * 2048], w2 = w3[(size_t)(4 * m4 + 2) * 2048], w3v = w3[(size_t)(4 * m4 + 3) * 2048];
#pragma unroll
      for (int e = 0; e < 8; ++e) {
        const f32x4 h4 = *(LAS const f32x4*)(hs + e * 64 + 4 * m4);
        acc[e] += h4.x * w0 + h4.y * w1 + h4.z * w2 + h4.w * w3v;
      }
    }
    const float dec = fabsf(p.hy_decay[(size_t)j * 2048 + o]);
    const float skip = p.hy_skip[j * D + c];
    unsigned vb[8];
#pragma unroll
    for (int e = 0; e < 8; ++e) {
      const int lag = dir ? 8 * qi + e : 8 * qi - e;
      const bool ok = dir ? (lag >= 1 && lag <= L - 1) : (lag >= 0 && lag <= L - 1);
      const float t = (float)lag / (float)(L - 1);
      float v = acc[e] * expf(-t * dec);
      if (!dir && lag == 0) v += skip;
      vb[e] = ok ? f2bf_(v) : 0u;
    }
    bf16_t* dst = FILT + ((size_t)(j * 1024 + c)) * FILT_CH + (set ? 528 : 0) + (dir ? 8 * qi : -8 * qi) + L + 8;
    if (qi != 0) {
      u32x4 ov; ov.x = vb[0] | (vb[1] << 16); ov.y = vb[2] | (vb[3] << 16); ov.z = vb[4] | (vb[5] << 16); ov.w = vb[6] | (vb[7] << 16);
      *(u32x4*)dst = ov;
    } else if (!dir) {
      dst[0] = (bf16_t)vb[0];
    } else {
#pragma unroll
      for (int e = 1; e < 8; ++e) dst[e] = (bf16_t)vb[e];
    }
  }
#endif
}
constexpr int FK_S = 0, FK_P = 65920, VBS = 74368, VBP = 91776, VB_END = 118400, E_OFF = 118400, SCR_S = 0, SCR_P = 65536;
__device__ __forceinline__ float conv3e(float pv, float cur, float nx, float w0, float w1, float w2, float b) { return pv * w0 + cur * w1 + nx * w2 + b; }

__device__ __forceinline__ void phase_hy_conv(const LAS PG& p, unsigned char* ws, LAS unsigned char* lds, int j, int tid, int lane, int wave, int bid, int G) {
  const bf16_t* UT = (const bf16_t*)(ws + M_UT);
  bf16_t* GT = (bf16_t*)(ws + M_GB);
  const bf16_t* FILT = (const bf16_t*)(ws + M_FILT);
  const int r = lane & 31, h = lane >> 5, rho = (-r) & 7;
  for (int c = bid; c < 1024; c += G) {
    __syncthreads();
    for (int i = tid; i < (VB_END - VBS) / 16; i += 512) *(LAS u32x4*)(lds + VBS + i * 16) = (u32x4){0u, 0u, 0u, 0u};
    __syncthreads();
    {
      const GASF* cw = p.hy_conv_w + (size_t)j * 3 * 3072; const GASF* cb = p.hy_conv_b + (size_t)j * 3072;
      const float a0 = cw[c], a1 = cw[3072 + c], a2 = cw[6144 + c], ab = cb[c];
      const float b0 = cw[1024 + c], b1 = cw[3072 + 1024 + c], b2 = cw[6144 + 1024 + c], bb = cb[1024 + c];
      const float v0 = cw[2048 + c], v1 = cw[3072 + 2048 + c], v2 = cw[6144 + 2048 + c], vbb = cb[2048 + c];
      for (int ch = tid; ch < 1024; ch += 512) {
        const int tok = ch * 8;
        int l, L; unsigned dst;
        if (tok < NPT) { l = tok & 255; L = 256; const int chunk = 32 + (l >> 3); dst = VBP + (tok >> 8) * 1664 + (chunk + (chunk >> 4)) * 16; }
        else { const int mm = tok - NPT; l = mm & 2047; L = 2048; const int chunk = 128 + (l >> 3); dst = VBS + (mm >> 11) * 8704 + (chunk + (chunk >> 4)) * 16; }
        const bf16_t* r0 = UT + (size_t)c * 8192 + tok; const bf16_t* r1 = r0 + (size_t)1024 * 8192; const bf16_t* r2 = r0 + (size_t)2048 * 8192; const bf16_t* r3 = r0 + (size_t)3072 * 8192;
        const u32x4 X0 = *(const u32x4*)r0, X1 = *(const u32x4*)r1, XV = *(const u32x4*)r2, XZ = *(const u32x4*)r3;
        const bool hp = l > 0, hn = (l + 8) < L;
        const float p0 = hp ? bf2f(r0[-1]) : 0.f, p1 = hp ? bf2f(r1[-1]) : 0.f, p2 = hp ? bf2f(r2[-1]) : 0.f;
        const float n0 = hn ? bf2f(r0[8]) : 0.f, n1 = hn ? bf2f(r1[8]) : 0.f, n2 = hn ? bf2f(r2[8]) : 0.f;
        float x0[10], x1[10], xv[10], z[8];
        x0[0] = p0; x1[0] = p1; xv[0] = p2; x0[9] = n0; x1[9] = n1; xv[9] = n2;
#pragma unroll
        for (int e = 0; e < 4; ++e) {
          x0[1 + 2 * e] = bf2f(X0[e] & 0xffffu); x0[2 + 2 * e] = bf2f(X0[e] >> 16);
          x1[1 + 2 * e] = bf2f(X1[e] & 0xffffu); x1[2 + 2 * e] = bf2f(X1[e] >> 16);
          xv[1 + 2 * e] = bf2f(XV[e] & 0xffffu); xv[2 + 2 * e] = bf2f(XV[e] >> 16);
          z[2 * e] = bf2f(XZ[e] & 0xffffu); z[2 * e + 1] = bf2f(XZ[e] >> 16);
        }
        float vv[8], ev[8];
#pragma unroll
        for (int e = 0; e < 8; ++e) {
          const float c0 = conv3e(x0[e], x0[e + 1], x0[e + 2], a0, a1, a2, ab);
          const float c1 = conv3e(x1[e], x1[e + 1], x1[e + 2], b0, b1, b2, bb);
          const float cv = conv3e(xv[e], xv[e + 1], xv[e + 2], v0, v1, v2, vbb);
          vv[e] = cv * c1; ev[e] = c0 * silu(z[e]);
        }
        u32x4 o; o.x = pk2_(vv[0], vv[1]); o.y = pk2_(vv[2], vv[3]); o.z = pk2_(vv[4], vv[5]); o.w = pk2_(vv[6], vv[7]);
        *(LAS u32x4*)(lds + dst) = o;
        *(LAS f32x4*)(lds + E_OFF + tok * 4) = (f32x4){ev[0], ev[1], ev[2], ev[3]};
        *(LAS f32x4*)(lds + E_OFF + tok * 4 + 16) = (f32x4){ev[4], ev[5], ev[6], ev[7]};
      }
      const bf16_t* Rc = FILT + ((size_t)(j * 1024 + c)) * FILT_CH;
      for (int gi = tid; gi < 515 + 66; gi += 512) {
        const bool smp = gi < 515; const int gq = smp ? gi : gi - 515; const int LEN = smp ? 4112 : 528;
        const bf16_t* Rg = Rc + (smp ? 528 : 0); const int idx0 = 8 * gq + 8;
        u32x4 lo = (u32x4){0u, 0u, 0u, 0u}, hi = (u32x4){0u, 0u, 0u, 0u};
        if (idx0 + 8 <= LEN) lo = *(const u32x4*)(Rg + idx0);
        if (idx0 + 16 <= LEN) hi = *(const u32x4*)(Rg + idx0 + 8);
        const unsigned d0 = lo.x, d1 = lo.y, d2 = lo.z, d3 = lo.w, d4 = hi.x, d5 = hi.y, d6 = hi.z, d7 = hi.w;
        LAS unsigned char* dstp = lds + (smp ? FK_S : FK_P) + gq * 128;
#define AB(hi_, lo_) __builtin_amdgcn_alignbit(hi_, lo_, 16)
        *(LAS u32x4*)(dstp + 0) = (u32x4){d0, d1, d2, d3};
        *(LAS u32x4*)(dstp + 16) = (u32x4){AB(d1, d0), AB(d2, d1), AB(d3, d2), AB(d4, d3)};
        *(LAS u32x4*)(dstp + 32) = (u32x4){d1, d2, d3, d4};
        *(LAS u32x4*)(dstp + 48) = (u32x4){AB(d2, d1), AB(d3, d2), AB(d4, d3), AB(d5, d4)};
        *(LAS u32x4*)(dstp + 64) = (u32x4){d2, d3, d4, d5};
        *(LAS u32x4*)(dstp + 80) = (u32x4){AB(d3, d2), AB(d4, d3), AB(d5, d4), AB(d6, d5)};
        *(LAS u32x4*)(dstp + 96) = (u32x4){d3, d4, d5, d6};
        *(LAS u32x4*)(dstp + 112) = (u32x4){AB(d4, d3), AB(d5, d4), AB(d6, d5), AB(d7, d6)};
#undef AB
      }
    }
    __syncthreads();
    f32x16 s0, s1, pr;
#pragma unroll
    for (int i = 0; i < 16; ++i) { s0[i] = 0.f; s1[i] = 0.f; pr[i] = 0.f; }
    {
      const int ahalf = wave & 1, dq = wave >> 1;
      const int a = ahalf * 32 + r;
      const int n0 = (ahalf ? -64 : -128) + 48 * dq, cnt = (dq == 3) ? 47 : 48;
      for (int s = 0; s < cnt; ++s) {
        const int n = n0 + s;
        const int e0 = 8 * h - r - 16 * n; const int q = (e0 - rho) >> 3;
        const bf16x8 af = *(LAS const bf16x8*)(lds + FK_S + ((q + 256) * 8 + rho) * 16);
        const int qb = 128 + h + 4 * a - 2 * n; const int pb = qb + (qb >> 4);
        const bf16x8 b0 = *(LAS const bf16x8*)(lds + VBS + pb * 16);
        const bf16x8 b1 = *(LAS const bf16x8*)(lds + VBS + 8704 + pb * 16);
        s0 = __builtin_amdgcn_mfma_f32_32x32x16_bf16(af, b0, s0, 0, 0, 0);
        s1 = __builtin_amdgcn_mfma_f32_32x32x16_bf16(af, b1, s1, 0, 0, 0);
      }
    }
    {
      const int ntile = wave & 3, dh = wave >> 2;
      const int batch = 4 * ntile + (r >> 3), a = r & 7;
      const int n0 = dh ? 0 : -16, cnt = dh ? 15 : 16;
      for (int s = 0; s < cnt; ++s) {
        const int n = n0 + s;
        const int e0 = 8 * h - r - 16 * n; const int q = (e0 - rho) >> 3;
        const bf16x8 af = *(LAS const bf16x8*)(lds + FK_P + ((q + 32) * 8 + rho) * 16);
        const int qb = 32 + h + 4 * a - 2 * n; const int pb = qb + (qb >> 4);
        const bf16x8 b0 = *(LAS const bf16x8*)(lds + VBP + batch * 1664 + pb * 16);
        pr = __builtin_amdgcn_mfma_f32_32x32x16_bf16(af, b0, pr, 0, 0, 0);
      }
    }
    __syncthreads();
    {
      const int ahalf = wave & 1, dq = wave >> 1;
#pragma unroll
      for (int g = 0; g < 4; ++g) {
        const int off = (r * 32 + 8 * g + 4 * h) * 4;
        *(LAS f32x4*)(lds + SCR_S + (((ahalf * 2 + 0) * 4 + dq) * 1024) * 4 + off) = (f32x4){s0[4 * g], s0[4 * g + 1], s0[4 * g + 2], s0[4 * g + 3]};
        *(LAS f32x4*)(lds + SCR_S + (((ahalf * 2 + 1) * 4 + dq) * 1024) * 4 + off) = (f32x4){s1[4 * g], s1[4 * g + 1], s1[4 * g + 2], s1[4 * g + 3]};
        *(LAS f32x4*)(lds + SCR_P + (((wave & 3) * 2 + (wave >> 2)) * 1024) * 4 + off) = (f32x4){pr[4 * g], pr[4 * g + 1], pr[4 * g + 2], pr[4 * g + 3]};
      }
    }
    __syncthreads();
    {
      {
        const int o = tid * 8; const int b = o >> 11, t = o & 2047; const int a = t >> 5, rr = t & 31; const int tile = (a >> 5) * 2 + b, col = a & 31;
        f32x4 y0 = (f32x4){0.f, 0.f, 0.f, 0.f}, y1 = y0;
#pragma unroll
        for (int dq = 0; dq < 4; ++dq) {
          LAS const unsigned char* sp = lds + SCR_S + (((tile * 4 + dq) * 1024) + col * 32 + rr) * 4;
          y0 += *(LAS const f32x4*)sp; y1 += *(LAS const f32x4*)(sp + 16);
        }
        const int token = NPT + o;
        const f32x4 e0 = *(LAS const f32x4*)(lds + E_OFF + token * 4), e1 = *(LAS const f32x4*)(lds + E_OFF + token * 4 + 16);
        u32x4 ov; ov.x = pk2_(y0.x * e0.x, y0.y * e0.y); ov.y = pk2_(y0.z * e0.z, y0.w * e0.w); ov.z = pk2_(y1.x * e1.x, y1.y * e1.y); ov.w = pk2_(y1.z * e1.z, y1.w * e1.w);
        *(u32x4*)(GT + (size_t)c * 8192 + token) = ov;
      }
      {
        const int o = tid * 8; const int batch = o >> 8, t = o & 255; const int ntile = batch >> 2, col = (batch & 3) * 8 + (t >> 5), rr = t & 31;
        f32x4 y0 = (f32x4){0.f, 0.f, 0.f, 0.f}, y1 = y0;
#pragma unroll
        for (int dh = 0; dh < 2; ++dh) {
          LAS const unsigned char* sp = lds + SCR_P + (((ntile * 2 + dh) * 1024) + col * 32 + rr) * 4;
          y0 += *(LAS const f32x4*)sp; y1 += *(LAS const f32x4*)(sp + 16);
        }
        const int token = o;
        const f32x4 e0 = *(LAS const f32x4*)(lds + E_OFF + token * 4), e1 = *(LAS const f32x4*)(lds + E_OFF + token * 4 + 16);
        u32x4 ov; ov.x = pk2_(y0.x * e0.x, y0.y * e0.y); ov.y = pk2_(y0.z * e0.z, y0.w * e0.w); ov.z = pk2_(y1.x * e1.x, y1.y * e1.y); ov.w = pk2_(y1.z * e1.z, y1.w * e1.w);
        *(u32x4*)(GT + (size_t)c * 8192 + token) = ov;
      }
    }
  }
}

template <int MODE>
__device__ __forceinline__ void phase_out_ln(const LAS PG& p, unsigned char* ws, LAS unsigned char* lds, int layer, const bf16_t* Wf, int tid, int lane, int wave, int bid, int G) {
  const bf16_t* GA = (const bf16_t*)(ws + M_GB);
  const float* MODS = (const float*)(ws + M_MODS);
  const int h = lane >> 5;
  for (int tile = bid; tile < NTOK / 32; tile += G) {
    const int t0 = tile * 32;
    __syncthreads();
    constexpr bool CHM = (MODE == 1);
    if (MODE == 2) {
      const int tok = tid >> 4, hd = tid & 15, m = t0 + tok;
      const size_t gi = (size_t)m * D + hd * 64;
      const f32x4* yf = (const f32x4*)((const float*)(ws + M_UT) + gi); const f32x4* yb = (const f32x4*)((const float*)(ws + M_UT + 32 * MiB) + gi);
      float s = 0.f, q = 0.f;
#pragma unroll 4
      for (int i = 0; i < 16; ++i) { const f32x4 y = yf[i] + yb[i]; s += (y.x + y.y) + (y.z + y.w); q += (y.x * y.x + y.y * y.y) + (y.z * y.z + y.w * y.w); }
      const float mu = s * (1.f / 64.f);
      const float rstd = rsqrtf(fmaxf(q * (1.f / 64.f) - mu * mu, 0.f) + GN_EPS);
      const float* BON = (const float*)(ws + M_GB + 8 * MiB);
      const float bon = BON[(size_t)m * 16 + hd] + BON[((size_t)NTOK + m) * 16 + hd];
      const bf16_t* vv = (const bf16_t*)(ws + M_SCR2 + 32 * MiB) + gi; const bf16_t* sz = (const bf16_t*)(ws + M_SCR2 + 48 * MiB) + gi;
#pragma unroll 2
      for (int i = 0; i < 8; ++i) {
        const u32x4 v4 = *(const u32x4*)(vv + 8 * i), z4 = *(const u32x4*)(sz + 8 * i);
        const f32x4 g0 = *(const f32x4*)(p.rw_gn_g + hd * 64 + 8 * i), g1 = *(const f32x4*)(p.rw_gn_g + hd * 64 + 8 * i + 4);
        const f32x4 b0 = *(const f32x4*)(p.rw_gn_b + hd * 64 + 8 * i), b1 = *(const f32x4*)(p.rw_gn_b + hd * 64 + 8 * i + 4);
        const f32x4 y0 = yf[2 * i] + yb[2 * i] - mu, y1 = yf[2 * i + 1] + yb[2 * i + 1] - mu;
        const f32x4 ya = y0 * rstd * g0 + b0, yb2 = y1 * rstd * g1 + b1;
        u32x4 o;
        o.x = pk2_((ya.x + bon * bf2f(v4.x & 0xffffu)) * bf2f(z4.x & 0xffffu), (ya.y + bon * bf2f(v4.x >> 16)) * bf2f(z4.x >> 16));
        o.y = pk2_((ya.z + bon * bf2f(v4.y & 0xffffu)) * bf2f(z4.y & 0xffffu), (ya.w + bon * bf2f(v4.y >> 16)) * bf2f(z4.y >> 16));
        o.z = pk2_((yb2.x + bon * bf2f(v4.z & 0xffffu)) * bf2f(z4.z & 0xffffu), (yb2.y + bon * bf2f(v4.z >> 16)) * bf2f(z4.z >> 16));
        o.w = pk2_((yb2.z + bon * bf2f(v4.w & 0xffffu)) * bf2f(z4.w & 0xffffu), (yb2.w + bon * bf2f(v4.w >> 16)) * bf2f(z4.w >> 16));
        *(LAS u32x4*)(lds + ((hd * 8 + i) * 32 + tok) * 16) = o;
      }
    } else {
#pragma unroll
    for (int i = 0; i < 8; ++i) {
      const int idx = tid + 512 * i;
      if (CHM) { const int c = idx >> 2, part = idx & 3; *(LAS u32x4*)(lds + c * 64 + part * 16) = *(const u32x4*)(GA + (size_t)c * 8192 + t0 + 8 * part); }
      else { const int tok = idx >> 7, k8 = idx & 127; *(LAS u32x4*)(lds + (k8 * 32 + tok) * 16) = *(const u32x4*)(GA + (size_t)(t0 + tok) * D + 8 * k8); }
    }
    }
    __syncthreads();
    f32x16 acc[4];
#pragma unroll
    for (int nt = 0; nt < 4; ++nt)
#pragma unroll
      for (int i = 0; i < 16; ++i) acc[nt][i] = 0.f;
    const bf16_t* wf = Wf + ((size_t)(wave * 4) * 64 * 64 + lane) * 8;
    const int aoffT = ((h * 32) + (lane & 31)) * 16;
    const int aoffC = (8 * h + ((lane & 15) >> 2)) * 64 + 32 * ((lane >> 4) & 1) + 8 * (lane & 3);
#pragma unroll 4
    for (int ks = 0; ks < 64; ++ks) {
      bf16x8 af;
      if (CHM) {
        const v4i16_t lo = vtr(lds + aoffC + ks * 1024), hi = vtr(lds + aoffC + ks * 1024 + 256);
        af = (bf16x8){lo[0], lo[1], lo[2], lo[3], hi[0], hi[1], hi[2], hi[3]};
      } else {
        af = *(LAS const bf16x8*)(lds + aoffT + ks * 1024);
      }
#pragma unroll
      for (int nt = 0; nt < 4; ++nt) {
        const bf16x8 bfr = *(const bf16x8*)(wf + ((size_t)(nt * 64 + ks) * 64) * 8);
        acc[nt] = __builtin_amdgcn_mfma_f32_32x32x16_bf16(af, bfr, acc[nt], 0, 0, 0);
      }
    }
    __syncthreads();
#pragma unroll
    for (int nt = 0; nt < 4; ++nt)
#pragma unroll
      for (int i = 0; i < 16; ++i) {
        const int row = (i & 3) + 8 * (i >> 2) + 4 * h;
        *(LAS float*)(lds + (row * 1028 + (wave * 4 + nt) * 32 + (lane & 31)) * 4) = acc[nt][i];
      }
    __syncthreads();
#pragma unroll 1
    for (int i = 0; i < 4; ++i) {
      const int row = wave * 4 + i, m = t0 + row;
      int l, L, cond, m0; tokinfo(m, l, L, cond, m0);
      const float* gate = MODS + (size_t)(layer * 3 + cond) * 3072 + 2048;
      const GAS f32x4* xr = (const GAS f32x4*)xrow_in(p, layer, ws, m);
      f32x4 v[4]; float s = 0.f;
#pragma unroll
      for (int q = 0; q < 4; ++q) {
        const int k = 4 * lane + 256 * q;
        const f32x4 o = *(LAS const f32x4*)(lds + (row * 1028 + k) * 4);
        const f32x4 x = xr[lane + 64 * q]; const f32x4 g = *(const f32x4*)(gate + k);
        v[q] = ALPHA * x + g * o; s += (v[q].x + v[q].y) + (v[q].z + v[q].w);
      }
      const float mu = wsum(s) * (1.f / D); float qq = 0.f;
#pragma unroll
      for (int q = 0; q < 4; ++q) { v[q] = v[q] - mu; qq += (v[q].x * v[q].x + v[q].y * v[q].y) + (v[q].z * v[q].z + v[q].w * v[q].w); }
      const float rs = rsqrtf(wsum(qq) * (1.f / D) + LN_EPS);
      GASF* xo = (layer == 3) ? p.out + OUT_Y + (size_t)m * D : (GASF*)(ws + M_X) + (size_t)m * D;
      const float* nmod = MODS + (size_t)((layer + 1) * 3 + cond) * 3072;
      bf16_t* HB = (bf16_t*)(ws + M_HB) + (size_t)m * D;
#pragma unroll
      for (int q = 0; q < 4; ++q) {
        const int k = 4 * lane + 256 * q;
        const f32x4 lg = *(const f32x4*)(p.ln_g + layer * D + k), lb = *(const f32x4*)(p.ln_b + layer * D + k);
        const f32x4 y = v[q] * rs * lg + lb;
        *(GAS f32x4*)(xo + k) = y;
        if (layer < 3) {
          const f32x4 sh = *(const f32x4*)(nmod + k), sc = *(const f32x4*)(nmod + 1024 + k);
          u32x2 o; o.x = pk2_(y.x * (1.f + sc.x) + sh.x, y.y * (1.f + sc.y) + sh.y); o.y = pk2_(y.z * (1.f + sc.z) + sh.z, y.w * (1.f + sc.w) + sh.w);
          *(u32x2*)(HB + k) = o;
        }
      }
    }
  }
}

__device__ __forceinline__ int kvrow_(int m) { if (m < NPT) return m; const int mm = m - NPT; return NPT + (mm >> 11) * 2560 + PAST + (mm & 2047); }

struct EpiSilu {
  static constexpr bool PERM = true, AFTER_DRAIN = false;
  bf16_t* O; int ldc;
  __device__ __forceinline__ void operator()(const f32x4 (&acc)[2][2][4][2], const pg8::Unit& u, int wr, int wc, int fr, int fq) const {
    const int row0 = u.pm * 256 + wr * 64 + fr, col0 = u.pn * 256 + wc * 32 + 8 * fq;
#pragma unroll
    for (int ai = 0; ai < 2; ++ai)
#pragma unroll
      for (int m = 0; m < 4; ++m) {
        bf16_t* rowp = O + (size_t)(row0 + ai * 128 + m * 16) * ldc + col0;
#pragma unroll
        for (int bj = 0; bj < 2; ++bj) {
          const f32x4 v0 = acc[ai][bj][m][0], v1 = acc[ai][bj][m][1];
          u32x4 w; w.x = pk2_(silu(v0[0]), silu(v0[1])); w.y = pk2_(silu(v0[2]), silu(v0[3])); w.z = pk2_(silu(v1[0]), silu(v1[1])); w.w = pk2_(silu(v1[2]), silu(v1[3]));
          *(u32x4*)(rowp + bj * 128) = w;
        }
      }
  }
};
struct EpiKV {
  static constexpr bool PERM = true, AFTER_DRAIN = false;
  bf16_t* Kn; bf16_t* V;
  __device__ __forceinline__ void operator()(const f32x4 (&acc)[2][2][4][2], const pg8::Unit& u, int wr, int wc, int fr, int fq) const {
    const int row0 = u.pm * 256 + wr * 64 + fr;
    const int d = wc * 32 + 8 * fq;
    bf16_t* base = (d < 64 ? Kn : V) + (d & 63);
#pragma unroll
    for (int ai = 0; ai < 2; ++ai)
#pragma unroll
      for (int m = 0; m < 4; ++m) {
        const size_t row = (size_t)(row0 + ai * 128 + m * 16);
#pragma unroll
        for (int bj = 0; bj < 2; ++bj) {
          const int h = u.pn * 2 + bj;
          const f32x4 v0 = acc[ai][bj][m][0], v1 = acc[ai][bj][m][1];
          u32x4 w; w.x = pk2_(v0[0], v0[1]); w.y = pk2_(v0[2], v0[3]); w.z = pk2_(v1[0], v1[1]); w.w = pk2_(v1[2], v1[3]);
          *(u32x4*)(base + row * 1024 + h * 64) = w;
        }
      }
  }
};

__device__ __forceinline__ void mla_in_small_tile(const LAS PG& p, unsigned char* ws, LAS unsigned char* lds, int tile, int tid, int lane, int wave) {
  const bf16_t* HB = (const bf16_t*)(ws + M_HB);
  const bf16_t* Wf = (const bf16_t*)(ws + W_MLAIN);
  const int h = lane >> 5, t0 = tile * 32;
  constexpr int RB = 65536;
  __syncthreads();
#pragma unroll
  for (int i = 0; i < 8; ++i) {
    const int idx = tid + 512 * i; const int tok = idx >> 7, k8 = idx & 127;
    *(LAS u32x4*)(lds + (k8 * 32 + tok) * 16) = *(const u32x4*)(HB + (size_t)(t0 + tok) * D + 8 * k8);
  }
  __syncthreads();
  f32x16 acc[2];
#pragma unroll
  for (int nt = 0; nt < 2; ++nt)
#pragma unroll
    for (int i = 0; i < 16; ++i) acc[nt][i] = 0.f;
  const int aoffT = ((h * 32) + (lane & 31)) * 16;
  const int nt0 = wave * 2;
  const bool two = (nt0 + 1) < 13;
  if (nt0 < 13) {
    const bf16_t* wf = Wf + ((size_t)nt0 * 64 * 64 + lane) * 8;
#pragma unroll 4
    for (int ks = 0; ks < 64; ++ks) {
      const bf16x8 af = *(LAS const bf16x8*)(lds + aoffT + ks * 1024);
      const bf16x8 b0 = *(const bf16x8*)(wf + ((size_t)ks * 64) * 8);
      acc[0] = __builtin_amdgcn_mfma_f32_32x32x16_bf16(af, b0, acc[0], 0, 0, 0);
      if (two) {
        const bf16x8 b1 = *(const bf16x8*)(wf + ((size_t)(64 + ks) * 64) * 8);
        acc[1] = __builtin_amdgcn_mfma_f32_32x32x16_bf16(af, b1, acc[1], 0, 0, 0);
      }
    }
#pragma unroll
    for (int nt = 0; nt < 2; ++nt)
      if (nt == 0 || two)
#pragma unroll
        for (int i = 0; i < 16; ++i) {
          const int row = (i & 3) + 8 * (i >> 2) + 4 * h;
          *(LAS float*)(lds + RB + (row * 420 + (nt0 + nt) * 32 + (lane & 31)) * 4) = acc[nt][i];
        }
  }
  __syncthreads();
#pragma unroll 1
  for (int i = 0; i < 4; ++i) {
    const int row = wave * 4 + i, m = t0 + row;
    int l, L, cond, m0; tokinfo(m, l, L, cond, m0);
    LAS const float* rb = (LAS const float*)(lds + RB + row * 420 * 4);
    const f32x4 q = *(LAS const f32x4*)(rb + 4 * lane);
    const float rs = rsqrtf(wsum(q.x * q.x + q.y * q.y + q.z * q.z + q.w * q.w) * (1.f / 256.f) + RMS_EPS);
    const f32x4 g = *(const f32x4*)(p.mla_q_norm + 4 * lane);
    u32x2 qo; qo.x = pk2_(q.x * rs * g.x, q.y * rs * g.y); qo.y = pk2_(q.z * rs * g.z, q.w * rs * g.w);
    *(u32x2*)((bf16_t*)(ws + M_QN) + (size_t)m * 256 + 4 * lane) = qo;
    const float k0 = rb[256 + 2 * lane], k1 = rb[256 + 2 * lane + 1];
    const float rs2 = rsqrtf(wsum(k0 * k0 + k1 * k1) * (1.f / 128.f) + RMS_EPS);
    const float c0 = k0 * rs2 * p.mla_kv_norm[2 * lane], c1 = k1 * rs2 * p.mla_kv_norm[2 * lane + 1];
    const int kr = kvrow_(m);
    *(unsigned*)((bf16_t*)(ws + M_CKVALL) + (size_t)kr * 128 + 2 * lane) = pk2_(c0, c1);
    if (m < NPT) { p.out[OUT_CKV + (size_t)m * 128 + 2 * lane] = c0; p.out[OUT_CKV + (size_t)m * 128 + 2 * lane + 1] = c1; }
    const float x = rb[384 + (lane & 31)];
    const float partner = __shfl_xor(x, 8);
    float o = x;
    if (m >= NPT) {
      const int d = lane & 31, jj = d & 7;
      const float inv = exp2f(-(float)(2 * jj) * (13.287712379549449f / 16.f));
      const float pos = (d < 16) ? (float)(l >> 6) : (float)(l & 63);
      const float ang = pos * inv; const float cs = cosf(ang), sn = sinf(ang);
      o = (d & 8) ? x * cs + partner * sn : x * cs - partner * sn;
    }
    if (lane < 32) {
      ((bf16_t*)(ws + M_KPEB))[(size_t)kr * 32 + lane] = (bf16_t)f2bf_(o);
      if (m < NPT) p.out[OUT_KPE + (size_t)m * 32 + lane] = x;
    }
  }
}

constexpr int AT_KB = 12288, AT_VB = 8192, AT_BUF = AT_KB + AT_VB, AT_WS = 2 * AT_BUF, AT_ST = AT_WS + 8 * 256;
__device__ __forceinline__ int crow_(int r, int hi) { return (r & 3) + 8 * (r >> 2) + 4 * hi; }
__device__ __forceinline__ unsigned cvtpk(float lo, float hi) { return pk2_(lo, hi); }

__device__ __forceinline__ void attn_unit(const unsigned char* ws, LAS unsigned char* lds, int seq, int hd, int qb, bf16_t* Gout, int tid, int lane, int wave) {
  const bf16_t* Q = (const bf16_t*)(ws + M_Q); const bf16_t* Kn = (const bf16_t*)(ws + M_KN); const bf16_t* Vv = (const bf16_t*)(ws + M_V);
  const bf16_t* KP = (const bf16_t*)(ws + M_KPEB); const bf16_t* SZ = (const bf16_t*)(ws + M_SZB);
  const int r32 = lane & 31, hi = lane >> 5;
  const bool smp = seq >= 16;
  const int mq0 = smp ? NPT + (seq - 16) * 2048 + qb * 256 : seq * 256;
  const int kbase = smp ? NPT + (seq - 16) * 2560 : seq * 256;
  const int NT = smp ? 40 : 4;
  const float C2 = 0.10206207261596575f * 1.4426950408889634f;
  bf16x8 qr[6];
  {
    const int m = mq0 + wave * 32 + r32;
    const bf16_t* qp = Q + (size_t)m * 1536 + hd * 96;
    const int l = smp ? ((m - NPT) & 2047) : 0;
#pragma unroll
    for (int d0 = 0; d0 < 6; ++d0) {
      const u32x4 own = *(const u32x4*)(qp + 16 * d0 + 8 * hi);
      float f[8];
#pragma unroll
      for (int e = 0; e < 4; ++e) { f[2 * e] = bf2f(own[e] & 0xffffu); f[2 * e + 1] = bf2f(own[e] >> 16); }
      if (d0 >= 4 && smp) {
        const u32x4 oth = *(const u32x4*)(qp + 16 * d0 + 8 * (1 - hi));
        const float pos = (d0 == 4) ? (float)(l >> 6) : (float)(l & 63);
#pragma unroll
        for (int e = 0; e < 8; ++e) {
          const float pf = bf2f((e & 1) ? (oth[e >> 1] >> 16) : (oth[e >> 1] & 0xffffu));
          const float inv = exp2f(-(float)(2 * e) * (13.287712379549449f / 16.f));
          const float ang = pos * inv; const float cs = cosf(ang), sn = sinf(ang);
          f[e] = hi ? f[e] * cs + pf * sn : f[e] * cs - pf * sn;
        }
      }
      u32x4 o; o.x = pk2_(f[0] * C2, f[1] * C2); o.y = pk2_(f[2] * C2, f[3] * C2); o.z = pk2_(f[4] * C2, f[5] * C2); o.w = pk2_(f[6] * C2, f[7] * C2);
      qr[d0] = __builtin_bit_cast(bf16x8, o);
    }
  }
  const bf16_t* vsrc = Vv + (size_t)(kbase + 16 * (wave & 3) + (lane >> 2)) * 1024 + hd * 64 + (wave >> 2) * 32 + (lane & 3) * 8;
  const int kc0 = tid >> 6, key0 = tid & 63;
  const bf16_t* ksrc0 = Kn + (size_t)(kbase + key0) * 1024 + hd * 64 + 8 * kc0;
  const bool k2 = tid < 256;
  const bf16_t* ksrc1 = KP + (size_t)(kbase + key0) * 32 + 8 * (tid >> 6);
  u32x4 rv, rk0, rk1 = (u32x4){0u, 0u, 0u, 0u};
#define AT_LOAD(t) do { rv = *(const u32x4*)(vsrc + (size_t)(t) * 64 * 1024); rk0 = *(const u32x4*)(ksrc0 + (size_t)(t) * 64 * 1024); if (k2) rk1 = *(const u32x4*)(ksrc1 + (size_t)(t) * 64 * 32); } while (0)
#define AT_STORE(b) do { LAS unsigned char* bb = lds + (b) * AT_BUF; *(LAS u32x4*)(bb + tid * 16) = rk0; if (k2) *(LAS u32x4*)(bb + 8192 + tid * 16) = rk1; *(LAS u32x4*)(bb + AT_KB + tid * 16) = rv; } while (0)
  __syncthreads();
  AT_LOAD(0); AT_STORE(0);
  __syncthreads();
  LAS float* wsf = (LAS float*)(lds + AT_WS + wave * 256);
  f32x16 o0, o1;
#pragma unroll
  for (int i = 0; i < 16; ++i) { o0[i] = 0.f; o1[i] = 0.f; }
  float mrun = -1e30f, lrun = 0.f;
  const int vboff = ((lane >> 4) & 1) * 32 + (lane & 3) * 8 + (4 * hi + ((lane & 15) >> 2)) * 64;
  for (int t = 0; t < NT; ++t) {
    const int cur = t & 1;
    if (t + 1 < NT) AT_LOAD(t + 1);
    LAS const unsigned char* kb = lds + cur * AT_BUF + hi * 1024 + r32 * 16;
    f32x16 p0, p1;
#pragma unroll
    for (int i = 0; i < 16; ++i) { p0[i] = 0.f; p1[i] = 0.f; }
#pragma unroll
    for (int d0 = 0; d0 < 6; ++d0) {
      const bf16x8 a0 = *(LAS const bf16x8*)(kb + d0 * 2048), a1 = *(LAS const bf16x8*)(kb + d0 * 2048 + 512);
      p0 = __builtin_amdgcn_mfma_f32_32x32x16_bf16(a0, qr[d0], p0, 0, 0, 0);
      p1 = __builtin_amdgcn_mfma_f32_32x32x16_bf16(a1, qr[d0], p1, 0, 0, 0);
    }
    float rm = p0[0];
#pragma unroll
    for (int i = 1; i < 16; ++i) rm = fmaxf(rm, p0[i]);
#pragma unroll
    for (int i = 0; i < 16; ++i) rm = fmaxf(rm, p1[i]);
    rm = fmaxf(rm, __shfl_xor(rm, 32));
    const float mnew = fmaxf(mrun, rm);
    const float alpha = exp2f(mrun - mnew);
    mrun = mnew;
    float ps = 0.f;
#pragma unroll
    for (int i = 0; i < 16; ++i) { p0[i] = exp2f(p0[i] - mnew); p1[i] = exp2f(p1[i] - mnew); ps += p0[i] + p1[i]; }
    lrun = lrun * alpha + ps;
    if (hi == 0) wsf[r32] = alpha;
    asm volatile("s_waitcnt lgkmcnt(0)" ::: "memory");
#pragma unroll
    for (int i = 0; i < 16; ++i) { const float al = wsf[crow_(i, hi)]; o0[i] *= al; o1[i] *= al; }
    u32x4 w0, w1, w2, w3;
    w0.x = cvtpk(p0[0], p0[1]); w0.y = cvtpk(p0[2], p0[3]); w0.z = cvtpk(p0[4], p0[5]); w0.w = cvtpk(p0[6], p0[7]);
    w1.x = cvtpk(p0[8], p0[9]); w1.y = cvtpk(p0[10], p0[11]); w1.z = cvtpk(p0[12], p0[13]); w1.w = cvtpk(p0[14], p0[15]);
    w2.x = cvtpk(p1[0], p1[1]); w2.y = cvtpk(p1[2], p1[3]); w2.z = cvtpk(p1[4], p1[5]); w2.w = cvtpk(p1[6], p1[7]);
    w3.x = cvtpk(p1[8], p1[9]); w3.y = cvtpk(p1[10], p1[11]); w3.z = cvtpk(p1[12], p1[13]); w3.w = cvtpk(p1[14], p1[15]);
    const bf16x8 pa0 = __builtin_bit_cast(bf16x8, w0), pa1 = __builtin_bit_cast(bf16x8, w1), pa2 = __builtin_bit_cast(bf16x8, w2), pa3 = __builtin_bit_cast(bf16x8, w3);
    LAS const unsigned char* vb = lds + cur * AT_BUF + AT_KB + vboff;
#define AT_PV(O_, D0) do { \
      const v4i16_t l0 = vtr(vb + (D0) * 4096), h0 = vtr(vb + (D0) * 4096 + 512), l1 = vtr(vb + (D0) * 4096 + 1024), h1 = vtr(vb + (D0) * 4096 + 1024 + 512); \
      const v4i16_t l2 = vtr(vb + (D0) * 4096 + 2048), h2 = vtr(vb + (D0) * 4096 + 2048 + 512), l3 = vtr(vb + (D0) * 4096 + 3072), h3 = vtr(vb + (D0) * 4096 + 3072 + 512); \
      O_ = __builtin_amdgcn_mfma_f32_32x32x16_bf16(pa0, ((bf16x8){l0[0], l0[1], l0[2], l0[3], h0[0], h0[1], h0[2], h0[3]}), O_, 0, 0, 0); \
      O_ = __builtin_amdgcn_mfma_f32_32x32x16_bf16(pa1, ((bf16x8){l1[0], l1[1], l1[2], l1[3], h1[0], h1[1], h1[2], h1[3]}), O_, 0, 0, 0); \
      O_ = __builtin_amdgcn_mfma_f32_32x32x16_bf16(pa2, ((bf16x8){l2[0], l2[1], l2[2], l2[3], h2[0], h2[1], h2[2], h2[3]}), O_, 0, 0, 0); \
      O_ = __builtin_amdgcn_mfma_f32_32x32x16_bf16(pa3, ((bf16x8){l3[0], l3[1], l3[2], l3[3], h3[0], h3[1], h3[2], h3[3]}), O_, 0, 0, 0); } while (0)
    AT_PV(o0, 0); AT_PV(o1, 1);
#undef AT_PV
    if (t + 1 < NT) AT_STORE(cur ^ 1);
    __syncthreads();
  }
#undef AT_LOAD
#undef AT_STORE
  lrun += __shfl_xor(lrun, 32);
  if (hi == 0) wsf[32 + r32] = 1.f / lrun;
  asm volatile("s_waitcnt lgkmcnt(0)" ::: "memory");
  LAS bf16_t* stg = (LAS bf16_t*)(lds + AT_ST + wave * 4096);
#pragma unroll
  for (int i = 0; i < 16; ++i) {
    const int orow = crow_(i, hi); const float rl = wsf[32 + orow];
    stg[orow * 64 + r32] = (bf16_t)f2bf_(o0[i] * rl);
    stg[orow * 64 + 32 + r32] = (bf16_t)f2bf_(o1[i] * rl);
  }
  asm volatile("s_waitcnt lgkmcnt(0)" ::: "memory");
#pragma unroll
  for (int i = 0; i < 4; ++i) {
    const int row = i * 8 + (lane >> 3), ch = lane & 7;
    const u32x4 ov = *(LAS const u32x4*)(stg + row * 64 + ch * 8);
    const size_t gi = (size_t)(mq0 + wave * 32 + row) * D + hd * 64 + ch * 8;
    const u32x4 zv = *(const u32x4*)(SZ + gi);
    u32x4 res;
#pragma unroll
    for (int e = 0; e < 4; ++e) res[e] = pk2_(bf2f(ov[e] & 0xffffu) * bf2f(zv[e] & 0xffffu), bf2f(ov[e] >> 16) * bf2f(zv[e] >> 16));
    *(u32x4*)(Gout + gi) = res;
  }
}
constexpr size_t M_XMIX = M_UT;
constexpr size_t M_YF = M_UT, M_YB = M_UT + 32 * MiB;
constexpr size_t M_RB = M_SCR2, M_KB = M_SCR2 + 16 * MiB, M_VB = M_SCR2 + 32 * MiB, M_SZR = M_SCR2 + 48 * MiB;
constexpr size_t M_HWA = M_GB;
constexpr size_t M_BON = M_GB + 8 * MiB;

__device__ __forceinline__ void phase_rw_mix(const LAS PG& p, unsigned char* ws, int tid, int bid, int G) {
  const bf16_t* HB = (const bf16_t*)(ws + M_HB);
  bf16_t* XM = (bf16_t*)(ws + M_XMIX);
  for (int i = bid * 512 + tid; i < NTOK * 128; i += G * 512) {
    const int m = i >> 7, k8 = i & 127;
    int l, L, cond, m0; tokinfo(m, l, L, cond, m0);
    const u32x4 hc = *(const u32x4*)(HB + (size_t)m * D + 8 * k8);
    u32x4 hp = (u32x4){0u, 0u, 0u, 0u}, hn = hp;
    if (l > 0) hp = *(const u32x4*)(HB + (size_t)(m - 1) * D + 8 * k8);
    if (l < L - 1) hn = *(const u32x4*)(HB + (size_t)(m + 1) * D + 8 * k8);
    float h[8], d[8];
#pragma unroll
    for (int e = 0; e < 4; ++e) {
      h[2 * e] = bf2f(hc[e] & 0xffffu); h[2 * e + 1] = bf2f(hc[e] >> 16);
      d[2 * e] = 0.5f * (bf2f(hp[e] & 0xffffu) + bf2f(hn[e] & 0xffffu)) - h[2 * e];
      d[2 * e + 1] = 0.5f * (bf2f(hp[e] >> 16) + bf2f(hn[e] >> 16)) - h[2 * e + 1];
    }
#pragma unroll
    for (int q = 0; q < 4; ++q) {
      const int mi = (q == 0) ? 0 : (q == 1) ? 2 : (q == 2) ? 3 : 5;
      const f32x4 u0 = *(const f32x4*)(p.rw_mu + mi * D + 8 * k8), u1 = *(const f32x4*)(p.rw_mu + mi * D + 8 * k8 + 4);
      u32x4 o; o.x = pk2_(h[0] + d[0] * u0.x, h[1] + d[1] * u0.y); o.y = pk2_(h[2] + d[2] * u0.z, h[3] + d[3] * u0.w);
      o.z = pk2_(h[4] + d[4] * u1.x, h[5] + d[5] * u1.y); o.w = pk2_(h[6] + d[6] * u1.z, h[7] + d[7] * u1.w);
      *(u32x4*)(XM + (size_t)q * NTOK * D + (size_t)m * D + 8 * k8) = o;
    }
  }
}

__device__ __forceinline__ void rw_lora_tile(const LAS PG& p, unsigned char* ws, LAS unsigned char* lds, int tile, int tid, int lane, int wave) {
  const bf16_t* HB = (const bf16_t*)(ws + M_HB);
  const bf16_t* Wf = (const bf16_t*)(ws + W_LORA1);
  const int h = lane >> 5, t0 = tile * 32;
  __syncthreads();
#pragma unroll 2
  for (int i = 0; i < 8; ++i) {
    const int idx = tid + 512 * i; const int tok = idx >> 7, k8 = idx & 127; const int m = t0 + tok;
    int l, L, cond, m0; tokinfo(m, l, L, cond, m0);
    const u32x4 hc = *(const u32x4*)(HB + (size_t)m * D + 8 * k8);
    u32x4 hp = (u32x4){0u, 0u, 0u, 0u}, hn = hp;
    if (l > 0) hp = *(const u32x4*)(HB + (size_t)(m - 1) * D + 8 * k8);
    if (l < L - 1) hn = *(const u32x4*)(HB + (size_t)(m + 1) * D + 8 * k8);
    float hh[8], d[8];
#pragma unroll
    for (int e = 0; e < 4; ++e) {
      hh[2 * e] = bf2f(hc[e] & 0xffffu); hh[2 * e + 1] = bf2f(hc[e] >> 16);
      d[2 * e] = 0.5f * (bf2f(hp[e] & 0xffffu) + bf2f(hn[e] & 0xffffu)) - hh[2 * e];
      d[2 * e + 1] = 0.5f * (bf2f(hp[e] >> 16) + bf2f(hn[e] >> 16)) - hh[2 * e + 1];
    }
#pragma unroll
    for (int q = 0; q < 2; ++q) {
      const int mi = q ? 4 : 1;
      const f32x4 u0 = *(const f32x4*)(p.rw_mu + mi * D + 8 * k8), u1 = *(const f32x4*)(p.rw_mu + mi * D + 8 * k8 + 4);
      u32x4 o; o.x = pk2_(hh[0] + d[0] * u0.x, hh[1] + d[1] * u0.y); o.y = pk2_(hh[2] + d[2] * u0.z, hh[3] + d[3] * u0.w);
      o.z = pk2_(hh[4] + d[4] * u1.x, hh[5] + d[5] * u1.y); o.w = pk2_(hh[6] + d[6] * u1.z, hh[7] + d[7] * u1.w);
      *(LAS u32x4*)(lds + q * 65536 + (k8 * 32 + tok) * 16) = o;
    }
  }
  __syncthreads();
  f32x16 acc;
#pragma unroll
  for (int i = 0; i < 16; ++i) acc[i] = 0.f;
  const int aoff = (wave >> 2) * 65536 + ((h * 32) + (lane & 31)) * 16;
  const bf16_t* wf = Wf + ((size_t)wave * 64 * 64 + lane) * 8;
#pragma unroll 4
  for (int ks = 0; ks < 64; ++ks) {
    const bf16x8 af = *(LAS const bf16x8*)(lds + aoff + ks * 1024);
    const bf16x8 b0 = *(const bf16x8*)(wf + ((size_t)ks * 64) * 8);
    acc = __builtin_amdgcn_mfma_f32_32x32x16_bf16(af, b0, acc, 0, 0, 0);
  }
  float* HWA = (float*)(ws + M_HWA);
#pragma unroll
  for (int i = 0; i < 16; ++i) {
    const int row = (i & 3) + 8 * (i >> 2) + 4 * h;
    const float v = (wave < 4) ? tanhf(acc[i]) : acc[i];
    HWA[(size_t)(t0 + row) * 256 + wave * 32 + (lane & 31)] = v;
  }
}

#define DPP_ADD(v, CTRL) ((v) + __builtin_bit_cast(float, __builtin_amdgcn_mov_dpp(__builtin_bit_cast(int, (v)), (CTRL), 0xF, 0xF, true)))
__device__ __forceinline__ float allred4(float v) { v = DPP_ADD(v, 0xB1); v = DPP_ADD(v, 0x4E); return v; }
__device__ __forceinline__ float allred16(float v) { v = DPP_ADD(v, 0xB1); v = DPP_ADD(v, 0x4E); v = DPP_ADD(v, 0x141); v = DPP_ADD(v, 0x140); return v; }

constexpr int SC_PS = 0, SC_PP = 24576, SC_RAW = 49152, SC_YS = 65536, SC_YP = 66560;

struct ChainC {
  int seq, dir, hd, m0, L;
  bf16x8 bw[2];
  float bias[4];
  float kk0, kk1, ka0, ka1, rk0, rk1;
};
__device__ __forceinline__ void chain_load(const LAS PG& p, ChainC& c, int seq, int dir, int hd, int lane, int wave, int tid) {
  c.seq = seq; c.dir = dir; c.hd = hd; c.L = seq < 16 ? 256 : 2048; c.m0 = seq < 16 ? seq * 256 : NPT + (seq - 16) * 2048;
  const int which = wave >> 2, ntile = wave & 3;
  const GASF* W2 = (which ? p.rw_a2 : p.rw_w2) + (size_t)dir * 64 * D + hd * 64 + 16 * ntile + (lane & 15);
#pragma unroll
  for (int ks = 0; ks < 2; ++ks) {
    const int k0 = 32 * ks + 8 * (lane >> 4);
    u32x4 o; o.x = pk2_(W2[(size_t)(k0 + 0) * D], W2[(size_t)(k0 + 1) * D]); o.y = pk2_(W2[(size_t)(k0 + 2) * D], W2[(size_t)(k0 + 3) * D]);
    o.z = pk2_(W2[(size_t)(k0 + 4) * D], W2[(size_t)(k0 + 5) * D]); o.w = pk2_(W2[(size_t)(k0 + 6) * D], W2[(size_t)(k0 + 7) * D]);
    c.bw[ks] = __builtin_bit_cast(bf16x8, o);
  }
  const float bb = (which ? p.rw_a0 : p.rw_w0)[dir * D + hd * 64 + 16 * ntile + (lane & 15)];
  c.bias[0] = bb; c.bias[1] = bb; c.bias[2] = bb; c.bias[3] = bb;
  const int ch = hd * 64 + 2 * (tid & 31);
  c.kk0 = p.rw_k_k[ch]; c.kk1 = p.rw_k_k[ch + 1]; c.ka0 = p.rw_k_a[ch]; c.ka1 = p.rw_k_a[ch + 1]; c.rk0 = p.rw_r_k[ch]; c.rk1 = p.rw_r_k[ch + 1];
}
__device__ __forceinline__ int chain_tok(const ChainC& c, int step) { return c.m0 + (c.dir ? (c.L - 1 - step) : step); }

__device__ __forceinline__ void prep_mfma(const unsigned char* ws, LAS unsigned char* lds, const ChainC& c, int s0, int rawoff, int lane, int wave) {
  const int which = wave >> 2, ntile = wave & 3;
  const float* HWA = (const float*)(ws + M_HWA);
  const int m = chain_tok(c, s0 + (lane & 15));
  f32x4 acc = (f32x4){c.bias[0], c.bias[1], c.bias[2], c.bias[3]};
#pragma unroll
  for (int ks = 0; ks < 2; ++ks) {
    const float* src = HWA + (size_t)m * 256 + which * 128 + c.dir * 64 + 32 * ks + 8 * (lane >> 4);
    const f32x4 x0 = *(const f32x4*)src, x1 = *(const f32x4*)(src + 4);
    u32x4 o; o.x = pk2_(x0.x, x0.y); o.y = pk2_(x0.z, x0.w); o.z = pk2_(x1.x, x1.y); o.w = pk2_(x1.z, x1.w);
    acc = __builtin_amdgcn_mfma_f32_16x16x32_bf16(__builtin_bit_cast(bf16x8, o), c.bw[ks], acc, 0, 0, 0);
  }
  LAS float* raw = (LAS float*)(lds + rawoff + which * 4096);
#pragma unroll
  for (int r = 0; r < 4; ++r) raw[(4 * (lane >> 4) + r) * 64 + 16 * ntile + (lane & 15)] = acc[r];
}
__device__ __forceinline__ void prep_elem(unsigned char* ws, LAS unsigned char* lds, const ChainC& c, int s0, int rawoff, int poff, int tid) {
  const int t = tid >> 5, cp = tid & 31;
  const int m = chain_tok(c, s0 + t);
  const size_t gi = (size_t)m * D + c.hd * 64 + 2 * cp;
  const unsigned kr = *(const unsigned*)((const bf16_t*)(ws + M_KB) + gi), rr = *(const unsigned*)((const bf16_t*)(ws + M_RB) + gi), vr = *(const unsigned*)((const bf16_t*)(ws + M_VB) + gi);
  const float k0 = bf2f(kr & 0xffffu), k1 = bf2f(kr >> 16), r0 = bf2f(rr & 0xffffu), r1 = bf2f(rr >> 16), v0 = bf2f(vr & 0xffffu), v1 = bf2f(vr >> 16);
  LAS const float* raw = (LAS const float*)(lds + rawoff);
  const float wl0 = raw[t * 64 + 2 * cp], wl1 = raw[t * 64 + 2 * cp + 1], al0 = raw[1024 + t * 64 + 2 * cp], al1 = raw[1024 + t * 64 + 2 * cp + 1];
  const float sp0 = (-wl0 > 20.f) ? -wl0 : log1pf(expf(-wl0)), sp1 = (-wl1 > 20.f) ? -wl1 : log1pf(expf(-wl1));
  const float dec0 = expf(-expf(-sp0 - 0.5f)), dec1 = expf(-expf(-sp1 - 0.5f));
  const float a0 = sigmoidf(al0), a1 = sigmoidf(al1);
  float kq0 = k0 * c.kk0, kq1 = k1 * c.kk1;
  float ss = kq0 * kq0 + kq1 * kq1;
#pragma unroll
  for (int o = 1; o < 32; o <<= 1) ss += __shfl_xor(ss, o);
  const float rn = rsqrtf(ss + 1e-12f);
  kq0 *= rn; kq1 *= rn;
  const float kd0 = k0 * (1.f + (a0 - 1.f) * c.ka0), kd1 = k1 * (1.f + (a1 - 1.f) * c.ka1);
  float bon = r0 * kd0 * c.rk0 + r1 * kd1 * c.rk1;
#pragma unroll
  for (int o = 1; o < 32; o <<= 1) bon += __shfl_xor(bon, o);
  if (cp == 0) ((float*)(ws + M_BON))[((size_t)c.dir * NTOK + m) * 16 + c.hd] = bon;
  LAS float* pb = (LAS float*)(lds + poff) + t * 64 + 2 * cp;
  pb[0] = dec0; pb[1] = dec1;
  pb[1024] = -kq0; pb[1025] = -kq1;
  pb[2048] = kq0 * a0; pb[2049] = kq1 * a1;
  pb[3072] = kd0; pb[3073] = kd1;
  pb[4096] = r0; pb[4097] = r1;
  pb[5120] = v0; pb[5121] = v1;
}

__device__ __forceinline__ void phase_rw_scan(const LAS PG& p, unsigned char* ws, LAS unsigned char* lds, int tid, int lane, int wave, int bid, int G) {
  for (int item = bid; item < 256; item += G) {
    const int sc = item >> 2, qt = item & 3;
    ChainC cs; chain_load(p, cs, 16 + (sc >> 5), (sc >> 4) & 1, sc & 15, lane, wave, tid);
    ChainC cp_;
    float* YS_out = (float*)(ws + (cs.dir ? M_YB : M_YF));
    const int srow = 16 * qt + 4 * (wave & 3) + (lane >> 4), scg = lane & 15;
    f32x4 Ss = (f32x4){0.f, 0.f, 0.f, 0.f};
    if (wave < 4) Ss = *(const f32x4*)(p.state_rwkv + ((((size_t)(cs.seq - 16)) * 2 + cs.dir) * 16 + cs.hd) * 4096 + (size_t)srow * 64 + 4 * scg);
    const int prow = 16 * (wave & 3) + (lane >> 2), pcq = lane & 3;
    f32x4 Sp0, Sp1, Sp2, Sp3;
    for (int c = 0; c < 128; ++c) {
      const int pe = c >> 6, pc = 2 * item + pe;
      if ((c & 63) == 0) {
        chain_load(p, cp_, pc >> 5, (pc >> 4) & 1, pc & 15, lane, wave, tid);
        Sp0 = (f32x4){0.f, 0.f, 0.f, 0.f}; Sp1 = Sp0; Sp2 = Sp0; Sp3 = Sp0;
      }
      const bool pprep = (c & 3) == 0;
      prep_mfma(ws, lds, cs, 16 * c, SC_RAW, lane, wave);
      if (pprep) prep_mfma(ws, lds, cp_, 4 * (c & 63), SC_RAW + 8192, lane, wave);
      __syncthreads();
      prep_elem(ws, lds, cs, 16 * c, SC_RAW, SC_PS, tid);
      if (pprep) prep_elem(ws, lds, cp_, 4 * (c & 63), SC_RAW + 8192, SC_PP, tid);
      __syncthreads();
      if (wave < 4) {
        LAS const float* ps = (LAS const float*)(lds + SC_PS);
#pragma unroll 4
        for (int t = 0; t < 16; ++t) {
          const f32x4 w4 = *(LAS const f32x4*)(ps + t * 64 + 4 * scg), a4 = *(LAS const f32x4*)(ps + 1024 + t * 64 + 4 * scg);
          const f32x4 b4 = *(LAS const f32x4*)(ps + 2048 + t * 64 + 4 * scg), k4 = *(LAS const f32x4*)(ps + 3072 + t * 64 + 4 * scg);
          const f32x4 r4 = *(LAS const f32x4*)(ps + 4096 + t * 64 + 4 * scg);
          const float vi = ps[5120 + t * 64 + srow];
          float sa = Ss.x * a4.x + Ss.y * a4.y + Ss.z * a4.z + Ss.w * a4.w;
          sa = allred16(sa);
          Ss.x = Ss.x * w4.x + (sa * b4.x + vi * k4.x); Ss.y = Ss.y * w4.y + (sa * b4.y + vi * k4.y);
          Ss.z = Ss.z * w4.z + (sa * b4.z + vi * k4.z); Ss.w = Ss.w * w4.w + (sa * b4.w + vi * k4.w);
          float y = Ss.x * r4.x + Ss.y * r4.y + Ss.z * r4.z + Ss.w * r4.w;
          y = allred16(y);
          if (scg == 0) ((LAS float*)(lds + SC_YS))[t * 16 + 4 * (wave & 3) + (lane >> 4)] = y;
        }
      } else {
        LAS const float* pp = (LAS const float*)(lds + SC_PP);
#pragma unroll 1
        for (int s = 0; s < 4; ++s) {
          const int t = 4 * (c & 3) + s;
          const float vi = pp[5120 + t * 64 + prow];
          LAS const float* q = pp + t * 64 + 16 * pcq;
          float sa = 0.f;
#define SA4(S_, O_) { const f32x4 a4 = *(LAS const f32x4*)(q + 1024 + (O_)); sa += S_.x * a4.x + S_.y * a4.y + S_.z * a4.z + S_.w * a4.w; }
          SA4(Sp0, 0) SA4(Sp1, 4) SA4(Sp2, 8) SA4(Sp3, 12)
#undef SA4
          sa = allred4(sa);
          float y = 0.f;
#define UP4(S_, O_) { const f32x4 w4 = *(LAS const f32x4*)(q + (O_)), b4 = *(LAS const f32x4*)(q + 2048 + (O_)), k4 = *(LAS const f32x4*)(q + 3072 + (O_)), r4 = *(LAS const f32x4*)(q + 4096 + (O_)); \
            S_.x = S_.x * w4.x + (sa * b4.x + vi * k4.x); S_.y = S_.y * w4.y + (sa * b4.y + vi * k4.y); S_.z = S_.z * w4.z + (sa * b4.z + vi * k4.z); S_.w = S_.w * w4.w + (sa * b4.w + vi * k4.w); \
            y += S_.x * r4.x + S_.y * r4.y + S_.z * r4.z + S_.w * r4.w; }
          UP4(Sp0, 0) UP4(Sp1, 4) UP4(Sp2, 8) UP4(Sp3, 12)
#undef UP4
          y = allred4(y);
          if (pcq == 0) ((LAS float*)(lds + SC_YP))[s * 64 + prow] = y;
        }
        if ((c & 63) == 63) {
          GASF* so = p.out + OUT_ST + ((((size_t)cp_.seq) * 2 + cp_.dir) * 16 + cp_.hd) * 4096 + (size_t)prow * 64 + 16 * pcq;
          *(GAS f32x4*)so = Sp0; *(GAS f32x4*)(so + 4) = Sp1; *(GAS f32x4*)(so + 8) = Sp2; *(GAS f32x4*)(so + 12) = Sp3;
        }
      }
      __syncthreads();
      if (tid < 256) {
        const int t = tid >> 4, row = tid & 15;
        const int m = chain_tok(cs, 16 * c + t);
        YS_out[(size_t)m * D + cs.hd * 64 + 16 * qt + row] = ((LAS const float*)(lds + SC_YS))[t * 16 + row];
      } else {
        const int pt = tid - 256; const int s = pt >> 6, row = pt & 63;
        const int m = chain_tok(cp_, 4 * (c & 63) + s);
        float* YP_out = (float*)(ws + (cp_.dir ? M_YB : M_YF));
        YP_out[(size_t)m * D + cp_.hd * 64 + row] = ((LAS const float*)(lds + SC_YP))[s * 64 + row];
      }
    }
  }
}
__device__ __forceinline__ int opq(int x) { asm volatile("" : "+v"(x)); return x; }
struct MArgs { P p; int ph_lo, ph_hi; };
__global__ void __launch_bounds__(512, 2) mega(MArgs a) {
  extern __shared__ __attribute__((aligned(16))) unsigned char lds_raw[];
  LAS unsigned char* lds = (LAS unsigned char*)lds_raw;
  const int tid = threadIdx.x, lane = tid & 63, wave = __builtin_amdgcn_readfirstlane(tid >> 6);
  const int G = gridDim.x, bid = blockIdx.x;
  unsigned char* ws = (unsigned char*)a.p.ws;
  if (tid == 0) {
    LAS PG* t = (LAS PG*)(lds + PTAB_OFF);
    t->x_prompt = (decltype(t->x_prompt))a.p.x_prompt;
    t->x_sample = (decltype(t->x_sample))a.p.x_sample;
    t->cache_ckv = (decltype(t->cache_ckv))a.p.cache_ckv;
    t->cache_kpe = (decltype(t->cache_kpe))a.p.cache_kpe;
    t->state_rwkv = (decltype(t->state_rwkv))a.p.state_rwkv;
    t->c = (decltype(t->c))a.p.c;
    t->c_ctx = (decltype(t->c_ctx))a.p.c_ctx;
    t->mod_w = (decltype(t->mod_w))a.p.mod_w;
    t->mod_b = (decltype(t->mod_b))a.p.mod_b;
    t->ln_g = (decltype(t->ln_g))a.p.ln_g;
    t->ln_b = (decltype(t->ln_b))a.p.ln_b;
    t->hy_w_in = (decltype(t->hy_w_in))a.p.hy_w_in;
    t->hy_conv_w = (decltype(t->hy_conv_w))a.p.hy_conv_w;
    t->hy_conv_b = (decltype(t->hy_conv_b))a.p.hy_conv_b;
    t->hy_w1 = (decltype(t->hy_w1))a.p.hy_w1;
    t->hy_b1 = (decltype(t->hy_b1))a.p.hy_b1;
    t->hy_w2 = (decltype(t->hy_w2))a.p.hy_w2;
    t->hy_b2 = (decltype(t->hy_b2))a.p.hy_b2;
    t->hy_w3 = (decltype(t->hy_w3))a.p.hy_w3;
    t->hy_b3 = (decltype(t->hy_b3))a.p.hy_b3;
    t->hy_freq = (decltype(t->hy_freq))a.p.hy_freq;
    t->hy_decay = (decltype(t->hy_decay))a.p.hy_decay;
    t->hy_skip = (decltype(t->hy_skip))a.p.hy_skip;
    t->hy_w_out = (decltype(t->hy_w_out))a.p.hy_w_out;
    t->mla_w_in = (decltype(t->mla_w_in))a.p.mla_w_in;
    t->mla_q_norm = (decltype(t->mla_q_norm))a.p.mla_q_norm;
    t->mla_kv_norm = (decltype(t->mla_kv_norm))a.p.mla_kv_norm;
    t->mla_w_q_up = (decltype(t->mla_w_q_up))a.p.mla_w_q_up;
    t->mla_w_kv_up = (decltype(t->mla_w_kv_up))a.p.mla_w_kv_up;
    t->mla_w_out = (decltype(t->mla_w_out))a.p.mla_w_out;
    t->rw_mu = (decltype(t->rw_mu))a.p.rw_mu;
    t->rw_w_in = (decltype(t->rw_w_in))a.p.rw_w_in;
    t->rw_w0 = (decltype(t->rw_w0))a.p.rw_w0;
    t->rw_w1 = (decltype(t->rw_w1))a.p.rw_w1;
    t->rw_w2 = (decltype(t->rw_w2))a.p.rw_w2;
    t->rw_a0 = (decltype(t->rw_a0))a.p.rw_a0;
    t->rw_a1 = (decltype(t->rw_a1))a.p.rw_a1;
    t->rw_a2 = (decltype(t->rw_a2))a.p.rw_a2;
    t->rw_k_k = (decltype(t->rw_k_k))a.p.rw_k_k;
    t->rw_k_a = (decltype(t->rw_k_a))a.p.rw_k_a;
    t->rw_r_k = (decltype(t->rw_r_k))a.p.rw_r_k;
    t->rw_gn_g = (decltype(t->rw_gn_g))a.p.rw_gn_g;
    t->rw_gn_b = (decltype(t->rw_gn_b))a.p.rw_gn_b;
    t->rw_w_out = (decltype(t->rw_w_out))a.p.rw_w_out;
    t->out = (decltype(t->out))a.p.out;
    t->ws = (decltype(t->ws))a.p.ws;
  }
  const LAS PG& p = *(const LAS PG*)(lds + PTAB_OFF);
  volatile LAS unsigned* MISC = (volatile LAS unsigned*)(lds + MISC_OFF);
  for (int u = tid; u < 128; u += 512) ((LAS unsigned*)(lds + MISC_OFF))[u] = 0u;
  __syncthreads();
  const int lo = a.ph_lo, hi = a.ph_hi;
  XcdBarrier bar; bar.bar = (unsigned*)(ws + M_CTL); bar.x = 0; bar.st = nullptr;
  if (hi - lo > 1) bar = xcd_barrier_post((unsigned*)(ws + M_CTL), MISC + 8);
#ifndef PH_MASK
#define PH_MASK 0xffffffffu
#endif
#define IN(k) (((PH_MASK >> (k)) & 1u) && lo <= (k) && (k) < hi)
#define SEAM(k) do { if (IN(k) && IN((k) + 1)) xcd_barrier(bar); } while (0)
  if (IN(0)) { phase_p0a(p, ws, lds, opq(tid), opq(lane), wave, bid, G); } SEAM(0);
  if (IN(1)) { phase_p0b(p, ws, lds, opq(tid), opq(lane), wave, bid, G); } SEAM(1);
  if (IN(2)) {
    pg8::Gemm g{(const pg8::bf16_t*)(ws + W_HYIN), (const pg8::bf16_t*)(ws + M_HB), 4096, 8192, 1024};
    pg8::StaticOrder S; S.init(4096, 8192, G, bid);
    pg8::EpiBf16<0> E{(pg8::bf16_t*)(ws + M_UT), 8192, nullptr, 0, 0, 1.f};
    pg8::gemm_phase<pg8::EpiBf16<0>, pg8::StaticOrder, true, true>(lds, g, S, E);
  } SEAM(2);
  if (IN(3)) { phase_hy_conv(p, ws, lds, 0, opq(tid), opq(lane), wave, bid, G); } SEAM(3);
  if (IN(4)) { phase_out_ln<1>(p, ws, lds, 0, (const bf16_t*)(ws + W_HYOUT), opq(tid), opq(lane), wave, bid, G); } SEAM(4);
  if (IN(5)) {
    pg8::Gemm g{(const pg8::bf16_t*)(ws + M_HB), (const pg8::bf16_t*)(ws + W_MLAIN + MiB), 8192, 1024, 1024};
    pg8::StaticOrder S; S.init(8192, 1024, G, bid);
    EpiSilu E{(bf16_t*)(ws + M_SZB), 1024};
    pg8::gemm_phase<EpiSilu, pg8::StaticOrder, true, true>(lds, g, S, E);
    if (G == 256) { if (bid >= 128) for (int tile = bid - 128; tile < 256; tile += 128) mla_in_small_tile(p, ws, lds, tile, opq(tid), opq(lane), wave); }
    else for (int tile = bid; tile < 256; tile += G) mla_in_small_tile(p, ws, lds, tile, opq(tid), opq(lane), wave);
  } SEAM(5);
  if (IN(6)) {
    { pg8::Gemm g{(const pg8::bf16_t*)(ws + M_QN), (const pg8::bf16_t*)(ws + W_QUP), 8192, 1536, 256};
      pg8::StaticOrder S; S.init(8192, 1536, G, bid);
      pg8::EpiBf16<0> E{(pg8::bf16_t*)(ws + M_Q), 1536, nullptr, 0, 0, 1.f};
      pg8::gemm_phase<pg8::EpiBf16<0>, pg8::StaticOrder, true, true>(lds, g, S, E); }
    { pg8::Gemm g{(const pg8::bf16_t*)(ws + M_CKVALL), (const pg8::bf16_t*)(ws + W_KVUP), 9216, 2048, 128};
      pg8::StaticOrder S; S.init(9216, 2048, G, (bid + G - 192 % G) % G);
      EpiKV E{(bf16_t*)(ws + M_KN), (bf16_t*)(ws + M_V)};
      pg8::gemm_phase<EpiKV, pg8::StaticOrder, true, true>(lds, g, S, E); }
  } SEAM(6);
  if (IN(7)) {
    for (int u = bid; u < 512; u += G) {
      int seq, hd, qb;
      if (u < 256) { seq = 16 + (u >> 7); hd = (u >> 3) & 15; qb = u & 7; } else { const int uu = u - 256; seq = uu >> 4; hd = uu & 15; qb = 0; }
      attn_unit(ws, lds, seq, hd, qb, (bf16_t*)(ws + M_GB), opq(tid), opq(lane), wave);
    }
  } SEAM(7);
  if (IN(8)) { phase_out_ln<0>(p, ws, lds, 1, (const bf16_t*)(ws + W_MLAOUT), opq(tid), opq(lane), wave, bid, G); } SEAM(8);
  if (IN(9)) { phase_rw_mix(p, ws, opq(tid), bid, G); } SEAM(9);
  if (IN(10)) {
#pragma unroll 1
    for (int q = 0; q < 4; ++q) {
      pg8::Gemm g{(const pg8::bf16_t*)(ws + M_XMIX + (size_t)q * 16 * MiB), (const pg8::bf16_t*)(ws + W_RWIN + (size_t)q * 2 * MiB), 8192, 1024, 1024};
      pg8::StaticOrder S; S.init(8192, 1024, G, (bid + (q & 1) * (G / 2)) % G);
      if (q < 3) { pg8::EpiBf16<0> E{(pg8::bf16_t*)(ws + M_SCR2 + (size_t)q * 16 * MiB), 1024, nullptr, 0, 0, 1.f}; pg8::gemm_phase<pg8::EpiBf16<0>, pg8::StaticOrder, true, true>(lds, g, S, E); }
      else { EpiSilu E{(bf16_t*)(ws + M_SZR), 1024}; pg8::gemm_phase<EpiSilu, pg8::StaticOrder, true, true>(lds, g, S, E); }
    }
    for (int tile = bid; tile < 256; tile += G) rw_lora_tile(p, ws, lds, tile, opq(tid), opq(lane), wave);
  } SEAM(10);
  if (IN(11)) { phase_rw_scan(p, ws, lds, opq(tid), opq(lane), wave, bid, G); } SEAM(11);
  if (IN(12)) { phase_out_ln<2>(p, ws, lds, 2, (const bf16_t*)(ws + W_RWOUT), opq(tid), opq(lane), wave, bid, G); } SEAM(12);
  if (IN(13)) {
    pg8::Gemm g{(const pg8::bf16_t*)(ws + W_HYIN + 8 * MiB), (const pg8::bf16_t*)(ws + M_HB), 4096, 8192, 1024};
    pg8::StaticOrder S; S.init(4096, 8192, G, bid);
    pg8::EpiBf16<0> E{(pg8::bf16_t*)(ws + M_UT), 8192, nullptr, 0, 0, 1.f};
    pg8::gemm_phase<pg8::EpiBf16<0>, pg8::StaticOrder, true, true>(lds, g, S, E);
  } SEAM(13);
  if (IN(14)) { phase_hy_conv(p, ws, lds, 1, opq(tid), opq(lane), wave, bid, G); } SEAM(14);
  if (IN(15)) { phase_out_ln<1>(p, ws, lds, 3, (const bf16_t*)(ws + W_HYOUT + 2 * MiB), opq(tid), opq(lane), wave, bid, G); }
#undef IN
#undef SEAM
}
}
}

extern "C" void kernel_launch(void* const* d_in, const int* in_sizes, int n_in, void* d_out, int out_size, void* d_ws, size_t ws_size, hipStream_t stream) {
  P p{};
  const float** pp = (const float**)&p;
  for (int i = 0; i < 44; ++i) pp[i] = (const float*)d_in[i];
  p.out = (float*)d_out; p.ws = (float*)d_ws;
  float* ws = p.ws;
  static int grid = 0;
  if (grid == 0) {
    int dev = 0, cus = 0;
    (void)hipGetDevice(&dev); (void)hipDeviceGetAttribute(&cus, hipDeviceAttributeMultiprocessorCount, dev);
    (void)hipFuncSetAttribute((const void*)mk::mega, hipFuncAttributeMaxDynamicSharedMemorySize, mk::LDS_BYTES);
    grid = cus > 0 ? cus : 256;
  }
  (void)hipMemsetAsync((char*)d_ws + mk::M_CTL, 0, 65536, stream);
  mk::MArgs a{}; a.p = p; a.ph_lo = 0; a.ph_hi = MEGA_PHASES;
  hipLaunchKernelGGL(mk::mega, dim3(grid), dim3(512), mk::LDS_BYTES, stream, a);

  float* X = ws + WS_X; float* S1 = ws + WS_S1; float* S4 = ws + WS_S4; float* S2 = ws + WS_S2;
  const int EB = (int)((SZ + 255) / 256);
  if (NAIVE_FROM < 4) hipLaunchKernelGGL(k_mods, dim3((4 * 3 * 3072 + 255) / 256), dim3(256), 0, stream, p);
  for (int layer = NAIVE_FROM; layer < 4; ++layer) {
    const int kind = layer % 3, j = layer / 3;
    const float* xa = (layer == 0) ? p.x_prompt : X;
    const float* xb = (layer == 0) ? p.x_sample : X + (size_t)NPT * D;
    float* Xn = (layer == 3) ? p.out + OUT_Y : X;
    hipLaunchKernelGGL(k_modulate, dim3(EB), dim3(256), 0, stream, p, xa, xb, S1, layer);
    if (kind == 0) {
      hipLaunchKernelGGL(k_hy_filter, dim3(2304), dim3(256), 0, stream, p, j);
      gemm(stream, ALPlain{S1, D}, p.hy_w_in + (size_t)j * D * 4096, 4096, NTOK, 4096, D, EPPlain{S2, 4096});
      hipLaunchKernelGGL(k_hy_vv, dim3(EB), dim3(256), 0, stream, p, S2, S1, j);
      hipLaunchKernelGGL(k_hy_long, dim3(EB), dim3(256), 0, stream, p, S2, S1, S4, j);
      gemm(stream, ALPlain{S4, D}, p.hy_w_out + (size_t)j * D * D, D, NTOK, D, D, EPPlain{S1, D});
    } else if (kind == 1) {
      float* U2 = S2; float* QN = S1; float* CKVALL = S1 + (size_t)NTOK * 256; float* KPEALL = CKVALL + (size_t)9216 * 128;
      float* Q = S2; float* KV = S2 + (size_t)NTOK * 1536;
      gemm(stream, ALPlain{S1, D}, p.mla_w_in, 1440, NTOK, 1440, D, EPPlain{U2, 1440});
      hipLaunchKernelGGL(k_mla_extract, dim3(NTOK), dim3(64), 0, stream, p, U2, QN, CKVALL, KPEALL, S4);
      hipLaunchKernelGGL(k_mla_cache, dim3((2 * PAST * 128 + 255) / 256), dim3(256), 0, stream, p, CKVALL, KPEALL);
      gemm(stream, ALPlain{QN, 256}, p.mla_w_q_up, 1536, NTOK, 1536, 256, EPPlain{Q, 1536});
      hipLaunchKernelGGL(k_rope_q, dim3((4096 * 16 + 255) / 256), dim3(256), 0, stream, Q);
      gemm(stream, ALPlain{CKVALL, 128}, p.mla_w_kv_up, 2048, 9216, 2048, 128, EPPlain{KV, 2048});
      hipLaunchKernelGGL(k_attn, dim3(32, 18 * 16), dim3(64), 0, stream, Q, KV, KPEALL, S4);
      gemm(stream, ALPlain{S4, D}, p.mla_w_out, D, NTOK, D, D, EPPlain{S1, D});
    } else {
      float* R = S2; float* K = S2 + SZ; float* V = S2 + 2 * SZ; float* Z = S2 + 3 * SZ;
      float* HW = ws + WS_MISC + MISC_END; float* HA = HW + (size_t)NTOK * 128;
      const float* mu = p.rw_mu; const float* win = p.rw_w_in;
      gemm(stream, ALMix{S1, mu + 0 * D}, win + 0 * (size_t)D * D, D, NTOK, D, D, EPPlain{R, D});
      gemm(stream, ALMix{S1, mu + 2 * D}, win + 1 * (size_t)D * D, D, NTOK, D, D, EPPlain{K, D});
      gemm(stream, ALMix{S1, mu + 3 * D}, win + 2 * (size_t)D * D, D, NTOK, D, D, EPPlain{V, D});
      gemm(stream, ALMix{S1, mu + 5 * D}, win + 3 * (size_t)D * D, D, NTOK, D, D, EPPlain{Z, D});
      for (int dir = 0; dir < 2; ++dir) {
        gemm(stream, ALMix{S1, mu + 1 * D}, p.rw_w1 + (size_t)dir * D * 64, 64, NTOK, 64, D, EPTanh{HW + dir * 64, 128});
        gemm(stream, ALMix{S1, mu + 4 * D}, p.rw_a1 + (size_t)dir * D * 64, 64, NTOK, 64, D, EPPlain{HA + dir * 64, 128});
      }
      (void)hipMemsetAsync(S4, 0, SZ * sizeof(float), stream);
      hipLaunchKernelGGL(k_rw_scan, dim3(18 * 32), dim3(64), 0, stream, p, R, K, V, HW, HA, S4);
      hipLaunchKernelGGL(k_rw_post, dim3(NTOK * 16), dim3(64), 0, stream, p, R, K, V, Z, HA, S4, S4);
      gemm(stream, ALPlain{S4, D}, p.rw_w_out, D, NTOK, D, D, EPPlain{S1, D});
    }
    hipLaunchKernelGGL(k_ln, dim3(NTOK / 4), dim3(256), 0, stream, p, xa, xb, S1, Xn, layer);
  }
}
```

```cpp
#define MEGA_PHASES 16
#define NAIVE_FROM 4
#define RPT_MASK 0x0u
#include <hip/hip_runtime.h>
#include <stdint.h>
#include <math.h>

namespace {

constexpr int D = 1024;
constexpr int NTOK = 8192;
constexpr int NPT = 4096;
constexpr int PAST = 512;
constexpr float ALPHA = 1.681792830507429f;
constexpr float LN_EPS = 1e-5f, RMS_EPS = 1e-6f, GN_EPS = 64e-5f;

struct P {
  const float *x_prompt, *x_sample, *cache_ckv, *cache_kpe, *state_rwkv, *c, *c_ctx;
  const float *mod_w, *mod_b, *ln_g, *ln_b;
  const float *hy_w_in, *hy_conv_w, *hy_conv_b, *hy_w1, *hy_b1, *hy_w2, *hy_b2, *hy_w3, *hy_b3, *hy_freq, *hy_decay, *hy_skip, *hy_w_out;
  const float *mla_w_in, *mla_q_norm, *mla_kv_norm, *mla_w_q_up, *mla_w_kv_up, *mla_w_out;
  const float *rw_mu, *rw_w_in, *rw_w0, *rw_w1, *rw_w2, *rw_a0, *rw_a1, *rw_a2, *rw_k_k, *rw_k_a, *rw_r_k, *rw_gn_g, *rw_gn_b, *rw_w_out;
  float* out;
  float* ws;
};

constexpr size_t OUT_Y = 0, OUT_CKV = 8388608, OUT_KPE = 8912896, OUT_ST = 9043968;

constexpr size_t SZ = (size_t)NTOK * D;
constexpr size_t WS_X = 0;
constexpr size_t WS_S1 = WS_X + SZ;
constexpr size_t WS_S4 = WS_S1 + SZ;
constexpr size_t WS_S2 = WS_S4 + SZ;
constexpr size_t WS_MISC = WS_S2 + 4 * SZ;
constexpr size_t MISC_MODS = 0;
constexpr size_t MISC_FILT = 65536;
constexpr size_t MISC_END = MISC_FILT + (size_t)2304 * 2048;

__device__ __forceinline__ float silu(float x) { return x / (1.f + expf(-x)); }
__device__ __forceinline__ float sigmoidf(float x) { return 1.f / (1.f + expf(-x)); }

__device__ __forceinline__ void tokinfo(int m, int& l, int& L, int& cond, int& m0) {
  if (m < NPT) { l = m & 255; L = 256; cond = 0; m0 = m & ~255; }
  else { int mm = m - NPT; l = mm & 2047; L = 2048; cond = 1 + (mm >> 11); m0 = NPT + (mm & ~2047); }
}

__global__ void k_mods(P p) {
  int idx = blockIdx.x * blockDim.x + threadIdx.x;
  if (idx >= 4 * 3 * 3072) return;
  int n = idx % 3072, g = (idx / 3072) % 3, i = idx / (3 * 3072);
  const float* cond = (g == 0) ? p.c_ctx : p.c + (size_t)(g - 1) * D;
  const float* w = p.mod_w + (size_t)i * D * 3072;
  float acc = 0.f;
  for (int k = 0; k < D; ++k) acc += silu(cond[k]) * w[(size_t)k * 3072 + n];
  p.ws[WS_MISC + MISC_MODS + idx] = acc + p.mod_b[i * 3072 + n];
}

__global__ void k_modulate(P p, const float* xa, const float* xb, float* H, int layer) {
  size_t idx = (size_t)blockIdx.x * blockDim.x + threadIdx.x;
  if (idx >= SZ) return;
  int m = (int)(idx >> 10), k = (int)(idx & 1023);
  int l, L, cond, m0; tokinfo(m, l, L, cond, m0);
  const float* md = p.ws + WS_MISC + MISC_MODS + (size_t)(layer * 3 + cond) * 3072;
  float x = (m < NPT) ? xa[idx] : xb[idx - (size_t)NPT * D];
  H[idx] = x * (1.f + md[1024 + k]) + md[k];
}

template <class AL, class EP>
__global__ void __launch_bounds__(256) k_gemm(AL al, const float* __restrict__ W, int ldw, int M, int N, int K, EP ep) {
  __shared__ float As[16][68];
  __shared__ float Bs[16][68];
  const int tx = threadIdx.x & 15, ty = threadIdx.x >> 4;
  const int m0 = blockIdx.y * 64, n0 = blockIdx.x * 64;
  float acc[4][4];
#pragma unroll
  for (int i = 0; i < 4; ++i)
#pragma unroll
    for (int j = 0; j < 4; ++j) acc[i][j] = 0.f;
  for (int k0 = 0; k0 < K; k0 += 16) {
#pragma unroll
    for (int i = 0; i < 4; ++i) {
      int e = threadIdx.x + i * 256; int mm = e >> 4, kk = e & 15;
      As[kk][mm] = (m0 + mm < M) ? al(m0 + mm, k0 + kk) : 0.f;
    }
#pragma unroll
    for (int i = 0; i < 4; ++i) {
      int e = threadIdx.x + i * 256; int kk = e >> 6, nn = e & 63;
      Bs[kk][nn] = (n0 + nn < N) ? W[(size_t)(k0 + kk) * ldw + n0 + nn] : 0.f;
    }
    __syncthreads();
#pragma unroll
    for (int kk = 0; kk < 16; ++kk) {
      float a[4], b[4];
#pragma unroll
      for (int i = 0; i < 4; ++i) { a[i] = As[kk][ty * 4 + i]; b[i] = Bs[kk][tx * 4 + i]; }
#pragma unroll
      for (int i = 0; i < 4; ++i)
#pragma unroll
        for (int j = 0; j < 4; ++j) acc[i][j] += a[i] * b[j];
    }
    __syncthreads();
  }
#pragma unroll
  for (int i = 0; i < 4; ++i)
#pragma unroll
    for (int j = 0; j < 4; ++j) {
      int m = m0 + ty * 4 + i, n = n0 + tx * 4 + j;
      if (m < M && n < N) ep(m, n, acc[i][j]);
    }
}

struct ALPlain { const float* A; long lda; __device__ float operator()(int m, int k) const { return A[(size_t)m * lda + k]; } };
struct EPPlain { float* C; long ldc; __device__ void operator()(int m, int n, float v) const { C[(size_t)m * ldc + n] = v; } };
struct EPTanh { float* C; long ldc; __device__ void operator()(int m, int n, float v) const { C[(size_t)m * ldc + n] = tanhf(v); } };
struct ALMix {
  const float* H; const float* mu;
  __device__ float operator()(int m, int k) const {
    int l, L, cond, m0; tokinfo(m, l, L, cond, m0);
    float h = H[(size_t)m * D + k];
    float pv = (l > 0) ? H[(size_t)(m - 1) * D + k] : 0.f;
    float nx = (l < L - 1) ? H[(size_t)(m + 1) * D + k] : 0.f;
    return h + (0.5f * (pv + nx) - h) * mu[k];
  }
};

template <class AL, class EP>
void gemm(hipStream_t s, AL al, const float* W, int ldw, int M, int N, int K, EP ep) {
  dim3 g((N + 63) / 64, (M + 63) / 64);
  hipLaunchKernelGGL((k_gemm<AL, EP>), g, dim3(256), 0, s, al, W, ldw, M, N, K, ep);
}

__global__ void __launch_bounds__(256) k_ln(P p, const float* xa, const float* xb, const float* O, float* Xn, int layer) {
  int m = blockIdx.x * 4 + (threadIdx.x >> 6), lane = threadIdx.x & 63;
  int l, L, cond, m0; tokinfo(m, l, L, cond, m0);
  const float* gate = p.ws + WS_MISC + MISC_MODS + (size_t)(layer * 3 + cond) * 3072 + 2048;
  const float* xr = (m < NPT) ? xa + (size_t)m * D : xb + (size_t)(m - NPT) * D;
  float v[16]; float s = 0.f;
#pragma unroll
  for (int i = 0; i < 16; ++i) { int k = lane + 64 * i; v[i] = ALPHA * xr[k] + gate[k] * O[(size_t)m * D + k]; s += v[i]; }
#pragma unroll
  for (int o = 1; o < 64; o <<= 1) s += __shfl_xor(s, o);
  float mu = s * (1.f / D), q = 0.f;
#pragma unroll
  for (int i = 0; i < 16; ++i) { v[i] -= mu; q += v[i] * v[i]; }
#pragma unroll
  for (int o = 1; o < 64; o <<= 1) q += __shfl_xor(q, o);
  float rs = rsqrtf(q * (1.f / D) + LN_EPS);
#pragma unroll
  for (int i = 0; i < 16; ++i) { int k = lane + 64 * i; Xn[(size_t)m * D + k] = v[i] * rs * p.ln_g[layer * D + k] + p.ln_b[layer * D + k]; }
}

__global__ void __launch_bounds__(256) k_hy_filter(P p, int j) {
  __shared__ float feat[33], h1[64], h2[64];
  int row = blockIdx.x; int L = row < 256 ? 256 : 2048; int l = row < 256 ? row : row - 256;
  int tid = threadIdx.x;
  float t = (float)l / (float)(L - 1);
  if (tid < 33) {
    float f;
    if (tid == 0) f = t;
    else {
      int b = (tid - 1) & 15;
      float band = 1e-4f + (float)b * ((15.f - 1e-4f) / 15.f);
      float ang = (6.283185307179586f / (float)L) * (float)l * band;
      f = (tid <= 16) ? cosf(ang) : -sinf(ang);
    }
    feat[tid] = f;
  }
  __syncthreads();
  if (tid < 64) {
    float a = p.hy_b1[j * 64 + tid];
    for (int f = 0; f < 33; ++f) a += feat[f] * p.hy_w1[((size_t)j * 33 + f) * 64 + tid];
    h1[tid] = sinf(p.hy_freq[(j * 2 + 0) * 64 + tid] * a);
  }
  __syncthreads();
  if (tid < 64) {
    float a = p.hy_b2[j * 64 + tid];
    for (int f = 0; f < 64; ++f) a += h1[f] * p.hy_w2[((size_t)j * 64 + f) * 64 + tid];
    h2[tid] = sinf(p.hy_freq[(j * 2 + 1) * 64 + tid] * a);
  }
  __syncthreads();
  for (int o = tid; o < 2048; o += 256) {
    float a = p.hy_b3[j * 2048 + o];
    for (int f = 0; f < 64; ++f) a += h2[f] * p.hy_w3[((size_t)j * 64 + f) * 2048 + o];
    float w = expf(-t * fabsf(p.hy_decay[(size_t)j * 2048 + o]));
    p.ws[WS_MISC + MISC_FILT + (size_t)row * 2048 + o] = a * w;
  }
}

__device__ __forceinline__ float conv3(const float* U, int m, int l, int L, int ch, const float* cw, const float* cb) {
  float cur = U[(size_t)m * 4096 + ch];
  float pv = (l > 0) ? U[(size_t)(m - 1) * 4096 + ch] : 0.f;
  float nx = (l < L - 1) ? U[(size_t)(m + 1) * 4096 + ch] : 0.f;
  return pv * cw[ch] + cur * cw[3072 + ch] + nx * cw[6144 + ch] + cb[ch];
}
__global__ void k_hy_vv(P p, const float* U, float* VV, int j) {
  size_t idx = (size_t)blockIdx.x * blockDim.x + threadIdx.x;
  if (idx >= SZ) return;
  int m = (int)(idx >> 10), c = (int)(idx & 1023);
  int l, L, cond, m0; tokinfo(m, l, L, cond, m0);
  const float* cw = p.hy_conv_w + (size_t)j * 3 * 3072; const float* cb = p.hy_conv_b + (size_t)j * 3072;
  float x1 = conv3(U, m, l, L, 1024 + c, cw, cb);
  float v = conv3(U, m, l, L, 2048 + c, cw, cb);
  VV[idx] = v * x1;
}
__global__ void k_hy_long(P p, const float* U, const float* VV, float* G, int j) {
  size_t idx = (size_t)blockIdx.x * blockDim.x + threadIdx.x;
  if (idx >= SZ) return;
  int m = (int)(idx >> 10), c = (int)(idx & 1023);
  int l, L, cond, m0; tokinfo(m, l, L, cond, m0);
  const float* F = p.ws + WS_MISC + MISC_FILT + (size_t)(L == 256 ? 0 : 256) * 2048;
  float acc = 0.f;
  for (int s = 0; s <= l; ++s) acc += VV[(size_t)(m0 + s) * D + c] * F[(size_t)(l - s) * 2048 + c];
  for (int s = l + 1; s < L; ++s) acc += VV[(size_t)(m0 + s) * D + c] * F[(size_t)(s - l) * 2048 + 1024 + c];
  const float* cw = p.hy_conv_w + (size_t)j * 3 * 3072; const float* cb = p.hy_conv_b + (size_t)j * 3072;
  float x0 = conv3(U, m, l, L, c, cw, cb);
  float z = U[(size_t)m * 4096 + 3072 + c];
  float y = (acc + VV[idx] * p.hy_skip[j * D + c]) * x0;
  G[idx] = y * silu(z);
}

__device__ __forceinline__ int kvrow(int m) { if (m < NPT) return m; int mm = m - NPT; return NPT + (mm >> 11) * 2560 + PAST + (mm & 2047); }
__device__ __forceinline__ void rope32(const float* x, float* o, int l) {
  int r = l >> 6, col = l & 63;
#pragma unroll
  for (int i = 0; i < 8; ++i) {
    float inv = powf(10000.f, -(float)(2 * i) / 16.f);
    float ar = (float)r * inv, ac = (float)col * inv;
    float cr = cosf(ar), sr = sinf(ar), cc = cosf(ac), sc = sinf(ac);
    o[i] = x[i] * cr - x[i + 8] * sr;
    o[i + 8] = x[i + 8] * cr + x[i] * sr;
    o[16 + i] = x[16 + i] * cc - x[24 + i] * sc;
    o[24 + i] = x[24 + i] * cc + x[16 + i] * sc;
  }
}
__global__ void __launch_bounds__(64) k_mla_extract(P p, const float* U2, float* QN, float* CKVALL, float* KPEALL, float* Z) {
  int m = blockIdx.x, lane = threadIdx.x;
  int l, L, cond, m0; tokinfo(m, l, L, cond, m0);
  const float* u = U2 + (size_t)m * 1440;
  float q[4], s = 0.f;
#pragma unroll
  for (int i = 0; i < 4; ++i) { q[i] = u[lane + 64 * i]; s += q[i] * q[i]; }
#pragma unroll
  for (int o = 1; o < 64; o <<= 1) s += __shfl_xor(s, o);
  float rs = rsqrtf(s * (1.f / 256.f) + RMS_EPS);
#pragma unroll
  for (int i = 0; i < 4; ++i) QN[(size_t)m * 256 + lane + 64 * i] = q[i] * rs * p.mla_q_norm[lane + 64 * i];
  float k0 = u[256 + lane], k1 = u[256 + 64 + lane];
  float s2 = k0 * k0 + k1 * k1;
#pragma unroll
  for (int o = 1; o < 64; o <<= 1) s2 += __shfl_xor(s2, o);
  float rs2 = rsqrtf(s2 * (1.f / 128.f) + RMS_EPS);
  float c0 = k0 * rs2 * p.mla_kv_norm[lane], c1 = k1 * rs2 * p.mla_kv_norm[64 + lane];
  int kr = kvrow(m);
  CKVALL[(size_t)kr * 128 + lane] = c0; CKVALL[(size_t)kr * 128 + 64 + lane] = c1;
  if (m < NPT) { p.out[OUT_CKV + (size_t)m * 128 + lane] = c0; p.out[OUT_CKV + (size_t)m * 128 + 64 + lane] = c1; }
  if (lane == 0) {
    float x[32], o[32];
#pragma unroll
    for (int i = 0; i < 32; ++i) x[i] = u[384 + i];
    if (m < NPT) {
#pragma unroll
      for (int i = 0; i < 32; ++i) { KPEALL[(size_t)kr * 32 + i] = x[i]; p.out[OUT_KPE + (size_t)m * 32 + i] = x[i]; }
    } else {
      rope32(x, o, l);
#pragma unroll
      for (int i = 0; i < 32; ++i) KPEALL[(size_t)kr * 32 + i] = o[i];
    }
  }
  for (int i = lane; i < 1024; i += 64) Z[(size_t)m * D + i] = u[416 + i];
}
__global__ void k_mla_cache(P p, float* CKVALL, float* KPEALL) {
  int idx = blockIdx.x * blockDim.x + threadIdx.x;
  if (idx >= 2 * PAST * 128) return;
  int d = idx & 127, pl = (idx >> 7) & 511, b = idx >> 16;
  int row = NPT + b * 2560 + pl;
  CKVALL[(size_t)row * 128 + d] = p.cache_ckv[idx];
  if (d < 32) KPEALL[(size_t)row * 32 + d] = p.cache_kpe[((size_t)b * PAST + pl) * 32 + d];
}
__global__ void k_rope_q(float* Q) {
  int idx = blockIdx.x * blockDim.x + threadIdx.x;
  if (idx >= 4096 * 16) return;
  int h = idx & 15, mm = idx >> 4; int m = NPT + mm; int l = mm & 2047;
  float* q = Q + (size_t)m * 1536 + h * 96 + 64;
  float x[32], o[32];
#pragma unroll
  for (int i = 0; i < 32; ++i) x[i] = q[i];
  rope32(x, o, l);
#pragma unroll
  for (int i = 0; i < 32; ++i) q[i] = o[i];
}
__global__ void __launch_bounds__(64) k_attn(const float* Q, const float* KV, const float* KPEALL, float* G) {
  int qi = blockIdx.x * 64 + threadIdx.x;
  int sh = blockIdx.y; int h = sh & 15, seq = sh >> 4;
  int L = seq < 16 ? 256 : 2048;
  if (qi >= L) return;
  int m = seq < 16 ? seq * 256 + qi : NPT + (seq - 16) * 2048 + qi;
  int kbase = seq < 16 ? seq * 256 : NPT + (seq - 16) * 2560;
  int nk = seq < 16 ? 256 : 2560;
  float q[96];
#pragma unroll
  for (int i = 0; i < 96; ++i) q[i] = Q[(size_t)m * 1536 + h * 96 + i];
  float acc[64];
#pragma unroll
  for (int i = 0; i < 64; ++i) acc[i] = 0.f;
  float mx = -1e30f, lsum = 0.f;
  const float scale = 0.10206207261596575f;
  for (int k = 0; k < nk; ++k) {
    const float* kv = KV + (size_t)(kbase + k) * 2048 + h * 128;
    const float* kp = KPEALL + (size_t)(kbase + k) * 32;
    float s = 0.f;
#pragma unroll
    for (int i = 0; i < 64; ++i) s += q[i] * kv[i];
#pragma unroll
    for (int i = 0; i < 32; ++i) s += q[64 + i] * kp[i];
    s *= scale;
    float mn = fmaxf(mx, s);
    float corr = expf(mx - mn), pe = expf(s - mn);
    lsum = lsum * corr + pe;
#pragma unroll
    for (int i = 0; i < 64; ++i) acc[i] = acc[i] * corr + pe * kv[64 + i];
    mx = mn;
  }
  float inv = 1.f / lsum;
#pragma unroll
  for (int i = 0; i < 64; ++i) { size_t o = (size_t)m * D + h * 64 + i; G[o] = acc[i] * inv * silu(G[o]); }
}

__global__ void __launch_bounds__(64) k_rw_scan(P p, const float* R, const float* K, const float* V, const float* HW, const float* HA, float* Y) {
  int id = blockIdx.x;
  int h = id & 15, dir = (id >> 4) & 1, seq = id >> 5;
  int lane = threadIdx.x;
  int L = seq < 16 ? 256 : 2048;
  int m0 = seq < 16 ? seq * 256 : NPT + (seq - 16) * 2048;
  int ch = h * 64 + lane;
  float S[64];
  if (seq < 16) {
#pragma unroll
    for (int j = 0; j < 64; ++j) S[j] = 0.f;
  } else {
    const float* s0 = p.state_rwkv + ((((size_t)(seq - 16) * 1 + 0) * 2 + dir) * 16 + h) * 4096 + (size_t)lane * 64;
#pragma unroll
    for (int j = 0; j < 64; ++j) S[j] = s0[j];
  }
  const float w0 = p.rw_w0[dir * D + ch], a0 = p.rw_a0[dir * D + ch];
  const float kkw = p.rw_k_k[ch], kaw = p.rw_k_a[ch];
  const float* w2 = p.rw_w2 + (size_t)dir * 64 * D + ch;
  const float* a2 = p.rw_a2 + (size_t)dir * 64 * D + ch;
  for (int st = 0; st < L; ++st) {
    int t = dir ? (L - 1 - st) : st;
    int m = m0 + t;
    float wl = w0, al = a0;
    const float* hw = HW + (size_t)m * 128 + dir * 64;
    const float* ha = HA + (size_t)m * 128 + dir * 64;
    for (int r = 0; r < 64; ++r) { wl += hw[r] * w2[(size_t)r * D]; al += ha[r] * a2[(size_t)r * D]; }
    float sp = (-wl > 20.f) ? -wl : log1pf(expf(-wl));
    float dec = expf(-expf(-sp - 0.5f));
    float a = sigmoidf(al);
    float k = K[(size_t)m * D + ch], r_ = R[(size_t)m * D + ch], v = V[(size_t)m * D + ch];
    float kk = k * kkw; float ss = kk * kk;
#pragma unroll
    for (int o = 1; o < 64; o <<= 1) ss += __shfl_xor(ss, o);
    kk *= rsqrtf(ss + 1e-12f);
    float kd = k * (1.f + (a - 1.f) * kaw);
    float bd = kk * a;
    float at = -kk;
    float sa = 0.f;
#pragma unroll
    for (int j = 0; j < 64; ++j) sa += S[j] * __shfl(at, j);
    float y = 0.f;
#pragma unroll
    for (int j = 0; j < 64; ++j) {
      float wj = __shfl(dec, j), bj = __shfl(bd, j), kj = __shfl(kd, j), rj = __shfl(r_, j);
      S[j] = S[j] * wj + sa * bj + v * kj;
      y += S[j] * rj;
    }
    atomicAdd(&Y[(size_t)m * D + ch], y);
  }
  if (seq < 16) {
    float* so = p.out + OUT_ST + ((((size_t)seq * 1 + 0) * 2 + dir) * 16 + h) * 4096 + (size_t)lane * 64;
#pragma unroll
    for (int j = 0; j < 64; ++j) so[j] = S[j];
  }
}
__global__ void __launch_bounds__(64) k_rw_post(P p, const float* R, const float* K, const float* V, const float* Z, const float* HA, const float* Y, float* G) {
  int m = blockIdx.x >> 4, h = blockIdx.x & 15, lane = threadIdx.x; int ch = h * 64 + lane;
  float y = Y[(size_t)m * D + ch];
  float s = y;
#pragma unroll
  for (int o = 1; o < 64; o <<= 1) s += __shfl_xor(s, o);
  float mu = s * (1.f / 64.f); float d = y - mu; float q = d * d;
#pragma unroll
  for (int o = 1; o < 64; o <<= 1) q += __shfl_xor(q, o);
  float yn = d * rsqrtf(q * (1.f / 64.f) + GN_EPS) * p.rw_gn_g[ch] + p.rw_gn_b[ch];
  float k = K[(size_t)m * D + ch], r_ = R[(size_t)m * D + ch], v = V[(size_t)m * D + ch];
  float bsum = 0.f;
  for (int dir = 0; dir < 2; ++dir) {
    float al = p.rw_a0[dir * D + ch];
    const float* ha = HA + (size_t)m * 128 + dir * 64;
    const float* a2 = p.rw_a2 + (size_t)dir * 64 * D + ch;
    for (int r = 0; r < 64; ++r) al += ha[r] * a2[(size_t)r * D];
    float a = sigmoidf(al);
    float kd = k * (1.f + (a - 1.f) * p.rw_k_a[ch]);
    bsum += r_ * kd * p.rw_r_k[ch];
  }
#pragma unroll
  for (int o = 1; o < 64; o <<= 1) bsum += __shfl_xor(bsum, o);
  float o_ = yn + bsum * v;
  G[(size_t)m * D + ch] = o_ * silu(Z[(size_t)m * D + ch]);
}

typedef unsigned short bf16_t;
namespace pg8 {
#define PG8_LAS __attribute__((address_space(3)))
typedef unsigned short bf16_t;
typedef short bf16x8 __attribute__((ext_vector_type(8)));
typedef float f32x4 __attribute__((ext_vector_type(4)));
typedef unsigned u32x4 __attribute__((ext_vector_type(4)));
constexpr int BM = 256, BK = 64, HALF = 128, HTB = HALF * BK * 2  , STAGE_BYTES = 8 * HTB, NXCD = 8, WGM = 8;

__host__ __device__ __forceinline__ int lds_byte(int r, int c) { const int st = (r >> 4) * 2 + (c >> 5), rr = r & 15, cc = c & 31, ob = rr * 64 + cc * 2; return st * 1024 + (ob ^ (((ob >> 9) & 1) << 5)); }
__host__ __device__ __forceinline__ void stage_rc(int b, int& R, int& C) { const int st = b / 1024, sb = b % 1024, swz = sb ^ (((sb >> 9) & 1) << 5); R = (st >> 1) * 16 + swz / 64; C = (st & 1) * 32 + (swz % 64) / 2; }
__host__ __device__ __forceinline__ int perm32(int rho) { const int n = rho >> 4, i = rho & 15; return 8 * (i >> 2) + 4 * n + (i & 3); }

struct Unit { int pm, pn; };
struct Gemm { const bf16_t* A; const bf16_t* Bt; int M, N, K; };

struct StaticOrder {
    int nM, nN, nwg, G, c;
    __host__ __device__ void init(int M, int N, int G_, int c_) { nM = M / BM; nN = N / BM; nwg = nM * nN; G = G_; c = c_; }
    __host__ __device__ bool next(int i, Unit& u) const {
        const long L = (long)i * G + c; if (L >= nwg) return false;
        int wgid = (int)L; { const int q = nwg / NXCD, r = nwg % NXCD, xcd = wgid % NXCD, off = wgid / NXCD; wgid = (xcd < r ? xcd * (q + 1) : r * (q + 1) + (xcd - r) * q) + off; }
        const int nig = WGM * nN, gid = wgid / nig, fm = gid * WGM, gsz = (nM - fm) < WGM ? (nM - fm) : WGM;
        u.pm = fm + ((wgid % nig) % gsz); u.pn = (wgid % nig) / gsz; return true;
    }
    __device__ __forceinline__ void a_ready(const Unit&) const {}
    __device__ __forceinline__ void done(const Unit&) const {}
};
__device__ __forceinline__ unsigned cvt_pk_bf16(float lo, float hi) { unsigned r; asm volatile("v_cvt_pk_bf16_f32 %0, %1, %2" : "=v"(r) : "v"(lo), "v"(hi)); return r; }
typedef float f32x2 __attribute__((ext_vector_type(2)));
template <int ACT  > struct EpiBf16 {
    static constexpr bool PERM = true, AFTER_DRAIN = false; static_assert(ACT == 0 || ACT == 1, "EpiBf16: ACT is 0 (none) or 1 (gelu_pk)");
    bf16_t* O; int ldc; const float* bias; int split_cols; size_t split_stride; float scale0;
    __device__ __forceinline__ void operator()(const f32x4 (&acc)[2][2][4][2], const Unit& u, int wr, int wc, int fr, int fq) const {
        const int row0 = u.pm * BM + wr * 64 + fr; int colt = u.pn * BM; bf16_t* base = O;
        float sc = 1.f; if (split_cols) { const int t = colt / split_cols; base += (size_t)t * split_stride; colt -= t * split_cols; if (t == 0) sc = scale0; }
        const int col0 = colt + wc * 32 + 8 * fq, bcol0 = u.pn * BM + wc * 32 + 8 * fq;
        f32x4 bv[2][2];
#pragma unroll
        for (int bj = 0; bj < 2; ++bj)
#pragma unroll
            for (int n = 0; n < 2; ++n) bv[bj][n] = bias ? *(const f32x4*)(bias + bcol0 + bj * HALF + 4 * n) : (f32x4){0.f, 0.f, 0.f, 0.f};
#pragma unroll
        for (int ai = 0; ai < 2; ++ai)
#pragma unroll
            for (int m = 0; m < 4; ++m) { bf16_t* rowp = base + (size_t)(row0 + ai * HALF + m * 16) * ldc + col0;
#pragma unroll
                for (int bj = 0; bj < 2; ++bj) { f32x4 v0 = acc[ai][bj][m][0] + bv[bj][0], v1 = acc[ai][bj][m][1] + bv[bj][1];
                    v0 = v0 * sc; v1 = v1 * sc; u32x4 w; w.x = cvt_pk_bf16(v0[0], v0[1]); w.y = cvt_pk_bf16(v0[2], v0[3]); w.z = cvt_pk_bf16(v1[0], v1[1]); w.w = cvt_pk_bf16(v1[2], v1[3]);
                    *(u32x4*)(rowp + bj * HALF) = w; } }
    }
};
template <class Epi, class Sched, bool ALIGN_EPI = false, bool SP2 = false>
__device__ __forceinline__ void gemm_phase(PG8_LAS unsigned char* lds, const Gemm g, const Sched& S, const Epi& E) {
    const int tid = threadIdx.x, wid = __builtin_amdgcn_readfirstlane(tid >> 6), lane = tid & 63, wr = wid >> 2, wc = wid & 3, fr = lane & 15, fq = lane >> 4;
    const int K = g.K, nt = K / BK;
    unsigned voffA[2], voffB[2];
#pragma unroll
    for (int i = 0; i < 2; ++i) { int R, C; stage_rc(tid * 16 + i * 8192, R, C); const int Rb = Epi::PERM ? ((R & ~31) + perm32(R & 31)) : R;
        voffA[i] = (unsigned)(R * K + C) * 2u; voffB[i] = (unsigned)(Rb * K + C) * 2u; }
    const size_t kstep = (size_t)(BK * 2);
    const size_t hstep = (size_t)HALF * K * 2;
    const size_t tstep = 2 * hstep;
    const unsigned ldsw = (unsigned)wid * 1024u;
    const int aoff = lds_byte(wr * 64 + fr, fq * 8), boff = lds_byte(wc * 32 + fr, fq * 8);
#define PG8_SA(b, h) (((b) * 2 + (h)) * HTB)
#define PG8_SB(b, h) ((4 + (b) * 2 + (h)) * HTB)
#define PG8_STAGE(bufoff, gbase, voff) do { _Pragma("unroll") for (int _i = 0; _i < 2; ++_i) \
        __builtin_amdgcn_global_load_lds((const unsigned*)((const char*)(gbase) + (voff)[_i]), (PG8_LAS unsigned*)(lds + (bufoff) + ldsw + _i * 8192), 16, 0, 0); } while (0)
#define PG8_LDA(dst, b, h) do { _Pragma("unroll") for (int m = 0; m < 4; ++m) _Pragma("unroll") for (int k = 0; k < 2; ++k) dst[m][k] = *(const PG8_LAS bf16x8*)(lds + PG8_SA(b, h) + aoff + m * 2048 + k * 1024); } while (0)
#define PG8_LDB(dst, b, h) do { _Pragma("unroll") for (int n = 0; n < 2; ++n) _Pragma("unroll") for (int k = 0; k < 2; ++k) dst[n][k] = *(const PG8_LAS bf16x8*)(lds + PG8_SB(b, h) + boff + n * 2048 + k * 1024); } while (0)
#define PG8_MMA(ai, bj, At, Bt) do { __builtin_amdgcn_s_setprio(1); _Pragma("unroll") for (int m = 0; m < 4; ++m) _Pragma("unroll") for (int n = 0; n < 2; ++n) _Pragma("unroll") for (int k = 0; k < 2; ++k) \
        acc[ai][bj][m][n] = __builtin_amdgcn_mfma_f32_16x16x32_bf16(Bt[n][k], At[m][k], acc[ai][bj][m][n], 0, 0, 0); __builtin_amdgcn_s_setprio(0); } while (0)
#define PG8_WAIT_V(n) asm volatile("s_waitcnt vmcnt(" #n ")" ::: "memory")
#define PG8_WAIT_L(n) asm volatile("s_waitcnt lgkmcnt(" #n ")" ::: "memory")
#define PG8_BAR __builtin_amdgcn_s_barrier()
#define PG8_SCHED __builtin_amdgcn_sched_barrier(0)
    Unit cur, nxt; int ui = 0;
    if (!S.next(0, cur)) return;
    f32x4 acc[2][2][4][2];
#pragma unroll
    for (int a = 0; a < 2; ++a)
#pragma unroll
        for (int b = 0; b < 2; ++b)
#pragma unroll
            for (int m = 0; m < 4; ++m)
#pragma unroll
                for (int n = 0; n < 2; ++n) acc[a][b][m][n] = (f32x4){0.f, 0.f, 0.f, 0.f};
    bf16x8 At[4][2], B0[2][2], B1[2][2];
    const char* cA = (const char*)g.A + (size_t)cur.pm * tstep; const char* cB = (const char*)g.Bt + (size_t)cur.pn * tstep;
    S.a_ready(cur);
    if constexpr (SP2) {
        PG8_STAGE(PG8_SB(0, 0), cB, voffB); PG8_STAGE(PG8_SB(0, 1), cB + hstep, voffB); PG8_STAGE(PG8_SA(0, 0), cA, voffA); PG8_STAGE(PG8_SA(0, 1), cA + hstep, voffA);
        if (wr == 1) PG8_BAR;
        PG8_WAIT_V(2); PG8_BAR;
        PG8_STAGE(PG8_SB(1, 0), cB + kstep, voffB); PG8_STAGE(PG8_SA(1, 0), cA + kstep, voffA); PG8_STAGE(PG8_SB(1, 1), cB + hstep + kstep, voffB);
        PG8_WAIT_V(6); PG8_BAR;
    } else {
        PG8_STAGE(PG8_SB(0, 0), cB, voffB); PG8_STAGE(PG8_SA(0, 0), cA, voffA); PG8_STAGE(PG8_SB(0, 1), cB + hstep, voffB); PG8_STAGE(PG8_SA(0, 1), cA + hstep, voffA);
        if (wr == 1) PG8_BAR;
        PG8_WAIT_V(4); PG8_BAR;
        PG8_STAGE(PG8_SB(1, 0), cB + kstep, voffB); PG8_STAGE(PG8_SA(1, 0), cA + kstep, voffA); PG8_STAGE(PG8_SB(1, 1), cB + hstep + kstep, voffB);
        PG8_WAIT_V(6); PG8_BAR;
    }
    for (;;) {
        const bool has_next = S.next(ui + 1, nxt);
        const char* nA = has_next ? (const char*)g.A + (size_t)nxt.pm * tstep : cA; const char* nB = has_next ? (const char*)g.Bt + (size_t)nxt.pn * tstep : cB;
        for (int t = 0; t < nt; t += 2) {
            const bool last = (t == nt - 2);
            const char* a1 = cA + (size_t)(t + 1) * kstep;
            const char* a2 = last ? nA : cA + (size_t)(t + 2) * kstep; const char* b2 = last ? nB : cB + (size_t)(t + 2) * kstep;
            const char* a3 = a2 + kstep; const char* b3 = b2 + kstep;
            if (last && has_next) S.a_ready(nxt);
            if constexpr (SP2) {
            PG8_LDB(B0, 0, 0); PG8_LDB(B1, 0, 1); PG8_SCHED; PG8_LDA(At, 0, 0); PG8_STAGE(PG8_SA(1, 1), a1 + hstep, voffA);
            PG8_WAIT_V(8); PG8_WAIT_L(0); PG8_BAR; PG8_MMA(0, 0, At, B0); PG8_MMA(0, 1, At, B1); PG8_BAR; PG8_SCHED;
            PG8_LDA(At, 0, 1); PG8_STAGE(PG8_SB(0, 0), b2, voffB); PG8_STAGE(PG8_SB(0, 1), b2 + hstep, voffB); PG8_STAGE(PG8_SA(0, 0), a2, voffA);
            PG8_WAIT_V(8); PG8_WAIT_L(0); PG8_BAR; PG8_MMA(1, 0, At, B0); PG8_MMA(1, 1, At, B1); PG8_BAR; PG8_SCHED;
            PG8_LDB(B0, 1, 0); PG8_LDB(B1, 1, 1); PG8_SCHED; PG8_LDA(At, 1, 0); PG8_STAGE(PG8_SA(0, 1), a2 + hstep, voffA);
            PG8_WAIT_V(8); PG8_WAIT_L(0); PG8_BAR; PG8_MMA(0, 0, At, B0); PG8_MMA(0, 1, At, B1); PG8_BAR; PG8_SCHED;
            PG8_LDA(At, 1, 1); PG8_STAGE(PG8_SB(1, 0), b3, voffB); PG8_STAGE(PG8_SB(1, 1), b3 + hstep, voffB); PG8_STAGE(PG8_SA(1, 0), a3, voffA);
            PG8_WAIT_V(8); PG8_WAIT_L(0); PG8_BAR; PG8_MMA(1, 0, At, B0); PG8_MMA(1, 1, At, B1); PG8_BAR; PG8_SCHED;
            } else {
            PG8_LDB(B0, 0, 0); PG8_SCHED; PG8_LDA(At, 0, 0); PG8_STAGE(PG8_SA(1, 1), a1 + hstep, voffA);
            PG8_WAIT_L(8); PG8_BAR; PG8_WAIT_L(0); PG8_MMA(0, 0, At, B0); PG8_BAR; PG8_SCHED;
            PG8_LDB(B1, 0, 1); PG8_STAGE(PG8_SB(0, 0), b2, voffB);
            PG8_BAR; PG8_WAIT_L(0); PG8_MMA(0, 1, At, B1); PG8_BAR;
            PG8_LDA(At, 0, 1); PG8_STAGE(PG8_SA(0, 0), a2, voffA);
            PG8_BAR; PG8_WAIT_L(0); PG8_MMA(1, 0, At, B0); PG8_BAR; PG8_SCHED;
            PG8_STAGE(PG8_SB(0, 1), b2 + hstep, voffB);
            PG8_WAIT_V(6); PG8_BAR; PG8_MMA(1, 1, At, B1); PG8_BAR;
            PG8_LDB(B0, 1, 0); PG8_SCHED; PG8_LDA(At, 1, 0); PG8_STAGE(PG8_SA(0, 1), a2 + hstep, voffA);
            PG8_WAIT_L(8); PG8_BAR; PG8_WAIT_L(0); PG8_MMA(0, 0, At, B0); PG8_BAR; PG8_SCHED;
            PG8_LDB(B1, 1, 1); PG8_STAGE(PG8_SB(1, 0), b3, voffB);
            PG8_BAR; PG8_WAIT_L(0); PG8_MMA(0, 1, At, B1); PG8_BAR;
            PG8_LDA(At, 1, 1); PG8_STAGE(PG8_SA(1, 0), a3, voffA);
            PG8_BAR; PG8_WAIT_L(0); PG8_MMA(1, 0, At, B0); PG8_BAR; PG8_SCHED;
            PG8_STAGE(PG8_SB(1, 1), b3 + hstep, voffB);
            PG8_WAIT_V(6); PG8_BAR; PG8_MMA(1, 1, At, B1); PG8_BAR;
            }
        }
        if constexpr (ALIGN_EPI) { if (wr == 0) PG8_BAR; }
        if constexpr (!Epi::AFTER_DRAIN) { E(acc, cur, wr, wc, fr, fq); S.done(cur); }
        if (!has_next) break;
#pragma unroll
        for (int a = 0; a < 2; ++a)
#pragma unroll
            for (int b = 0; b < 2; ++b)
#pragma unroll
                for (int m = 0; m < 4; ++m)
#pragma unroll
                    for (int n = 0; n < 2; ++n) acc[a][b][m][n] = (f32x4){0.f, 0.f, 0.f, 0.f};
        cur = nxt; cA = nA; cB = nB; ++ui;
        if constexpr (ALIGN_EPI) { if (wr == 1) PG8_BAR; }
    }
    PG8_WAIT_V(0);
    if constexpr (!ALIGN_EPI) { if (wr == 0) PG8_BAR; }
    PG8_BAR;
    if constexpr (Epi::AFTER_DRAIN) { E.fused(acc, cur, wr, wc, fr, fq, lds, wid, lane); S.done(cur); }
#undef PG8_SA
#undef PG8_SB
#undef PG8_STAGE
#undef PG8_LDA
#undef PG8_LDB
#undef PG8_MMA
#undef PG8_WAIT_V
#undef PG8_WAIT_L
#undef PG8_BAR
#undef PG8_SCHED
}
}
#define GAS __attribute__((address_space(1)))
#define LAS __attribute__((address_space(3)))
typedef unsigned short bf16;
typedef unsigned v4u __attribute__((ext_vector_type(4)));
typedef float f32x4 __attribute__((ext_vector_type(4)));
typedef short bf16x8 __attribute__((ext_vector_type(8)));
typedef GAS unsigned gu32;
typedef GAS unsigned long long gu64;
#define RLX_AGENT __ATOMIC_RELAXED, __HIP_MEMORY_SCOPE_AGENT
#define LDS_WAIT() asm volatile("s_waitcnt lgkmcnt(0)" ::: "memory")
#define VM_WAIT() asm volatile("s_waitcnt vmcnt(0)" ::: "memory")
__device__ __forceinline__ unsigned long long rt() { return __builtin_amdgcn_s_memrealtime(); }
__device__ __forceinline__ unsigned f2bf(float f) { unsigned u = __builtin_bit_cast(unsigned, f); return (u + 0x7fffu + ((u >> 16) & 1u)) >> 16; }
__device__ __forceinline__ unsigned pk2(float lo, float hi) { return f2bf(lo) | (f2bf(hi) << 16); }

#define XB_TMO      128
#define XB_XCNT(j)  (256  + 64 * (j))
#define XB_XSUB(j)  (1280 + 64 * (j))
#define XB_XGEN(j)  (2304 + 64 * (j))
#define XB_TOP      3328
#define XB_TOPGEN   3392
#define XCD_BAR_WORDS 3456
#define XB_SPIN_CAP (1u << 18)

__device__ __forceinline__ unsigned xb_ld(unsigned* p)              { return __hip_atomic_load(p, __ATOMIC_RELAXED, __HIP_MEMORY_SCOPE_AGENT); }
__device__ __forceinline__ unsigned xb_add(unsigned* p, unsigned v) { return __hip_atomic_fetch_add(p, v, __ATOMIC_RELAXED, __HIP_MEMORY_SCOPE_AGENT); }
__device__ __forceinline__ unsigned xb_xcc_id() { return (unsigned)__builtin_amdgcn_s_getreg((3 << 11) | 20) & 0xFu; }
#define XB_SPIN(cond, bar) do { unsigned _sp = 0; while (cond) { __builtin_amdgcn_s_sleep(1); \
    if ((++_sp & 255u) == 0u) { if (xb_ld(&(bar)[XB_TMO])) break; if (_sp > XB_SPIN_CAP) { atomicAdd(&(bar)[XB_TMO], 1u); break; } } } } while (0)

struct XcdBarrier {
    unsigned* bar; unsigned x;
    volatile LAS unsigned* st;
};

__device__ __forceinline__ XcdBarrier xcd_barrier_post(unsigned* bar, volatile LAS unsigned* st) {
    XcdBarrier b; b.bar = bar; b.x = xb_xcc_id(); b.st = st;
    if (threadIdx.x == 0) (void)xb_add(&bar[XB_XCNT(b.x)], 1u);
    return b;
}
__device__ __forceinline__ void xcd_barrier_complete(unsigned* bar, unsigned x, unsigned& nloc, unsigned& nx) {
    const unsigned G = gridDim.x * gridDim.y * gridDim.z;
    unsigned sum, cnt, mine, sp = 0u;
    for (;;) {
        sum = 0u; cnt = 0u; mine = 0u;
#pragma unroll
        for (unsigned j = 0; j < 16; ++j) { const unsigned c = xb_ld(&bar[XB_XCNT(j)]); sum += c; cnt += (c > 0u) ? 1u : 0u; mine = (j == x) ? c : mine; }
        if (sum == G) break;
        __builtin_amdgcn_s_sleep(1);
        if ((++sp & 255u) == 0u) { if (xb_ld(&bar[XB_TMO])) break; if (sp > XB_SPIN_CAP) { atomicAdd(&bar[XB_TMO], 1u); break; } }
    }
    nloc = mine > 0u ? mine : 1u; nx = cnt > 0u ? cnt : 1u;
}

__device__ __forceinline__ void xcd_barrier(const XcdBarrier& b) {
    asm volatile("s_waitcnt vmcnt(0)" ::: "memory");
    __syncthreads();
    if (threadIdx.x == 0) {
        unsigned* bar = b.bar;
        __builtin_amdgcn_s_waitcnt(0);
        unsigned nloc = b.st[0], nx = b.st[1];
        if (nloc == 0u) { xcd_barrier_complete(bar, b.x, nloc, nx); b.st[0] = nloc; b.st[1] = nx; }
        const unsigned old = xb_add(&bar[XB_XSUB(b.x)], 1u);
        const unsigned gen = old / nloc;
        if (old + 1u == (gen + 1u) * nloc) {
            __builtin_amdgcn_fence(__ATOMIC_RELEASE, "agent");
            asm volatile("s_waitcnt vmcnt(0)" ::: "memory");
            const unsigned og = xb_add(&bar[XB_TOP], 1u);
            const unsigned tg = og / nx;
            if (og + 1u == (tg + 1u) * nx) xb_add(&bar[XB_TOPGEN], 1u);
            else XB_SPIN(xb_ld(&bar[XB_TOPGEN]) == tg, bar);
            __builtin_amdgcn_fence(__ATOMIC_ACQUIRE, "agent");
            xb_add(&bar[XB_XGEN(b.x)], 1u);
            asm volatile("s_waitcnt vmcnt(0)" ::: "memory");
        } else {
            XB_SPIN(xb_ld(&bar[XB_XGEN(b.x)]) == gen, bar);
            __builtin_amdgcn_fence(__ATOMIC_ACQUIRE, "agent");
            asm volatile("s_waitcnt vmcnt(0)" ::: "memory");
        }
    }
    __syncthreads();
}
typedef __attribute__((address_space(1))) float GASF;
struct PG {
  const GASF *x_prompt, *x_sample, *cache_ckv, *cache_kpe, *state_rwkv, *c, *c_ctx;
  const GASF *mod_w, *mod_b, *ln_g, *ln_b;
  const GASF *hy_w_in, *hy_conv_w, *hy_conv_b, *hy_w1, *hy_b1, *hy_w2, *hy_b2, *hy_w3, *hy_b3, *hy_freq, *hy_decay, *hy_skip, *hy_w_out;
  const GASF *mla_w_in, *mla_q_norm, *mla_kv_norm, *mla_w_q_up, *mla_w_kv_up, *mla_w_out;
  const GASF *rw_mu, *rw_w_in, *rw_w0, *rw_w1, *rw_w2, *rw_a0, *rw_a1, *rw_a2, *rw_k_k, *rw_k_a, *rw_r_k, *rw_gn_g, *rw_gn_b, *rw_w_out;
  GASF* out;
  GASF* ws;
};
namespace mk {
typedef float f32x16 __attribute__((ext_vector_type(16)));
typedef short v4i16_t __attribute__((ext_vector_type(4)));
typedef unsigned u32x4 __attribute__((ext_vector_type(4)));
typedef unsigned u32x2 __attribute__((ext_vector_type(2)));
typedef unsigned short u16;

constexpr size_t MiB = 1u << 20;
constexpr size_t M_X = 0, M_HB = 32 * MiB, M_GB = 48 * MiB, M_UT = 64 * MiB, M_SCR2 = 128 * MiB, M_WTS = 192 * MiB, M_FILT = 230 * MiB;
constexpr size_t M_HDN2 = 248 * MiB + 512 * 1024, M_MODP = 250 * MiB, M_MODS = 254 * MiB, M_CTL = 255 * MiB;
constexpr size_t W_HYIN = M_WTS, W_HYOUT = M_WTS + 16 * MiB, W_MLAIN = M_WTS + 20 * MiB, W_QUP = M_WTS + 23 * MiB, W_KVUP = M_WTS + 24 * MiB,
                 W_MLAOUT = M_WTS + 25 * MiB, W_RWIN = M_WTS + 27 * MiB, W_LORA1 = M_WTS + 35 * MiB, W_RWOUT = M_WTS + 36 * MiB;
constexpr size_t M_QN = M_SCR2, M_CKVALL = M_SCR2 + 4 * MiB, M_KPEB = M_SCR2 + 7 * MiB, M_SZB = M_SCR2 + 8 * MiB, M_Q = M_UT, M_KN = M_UT + 24 * MiB, M_V = M_UT + 42 * MiB;
constexpr int FILT_CH = 4640;
constexpr int LDS_BYTES = 163840, MISC_OFF = LDS_BYTES - 512, PTAB_OFF = LDS_BYTES - 1024;

__device__ __forceinline__ float bf2f(unsigned v) { return __builtin_bit_cast(float, v << 16); }
typedef float f32x2_t __attribute__((ext_vector_type(2))); typedef __bf16 bf16x2_t __attribute__((ext_vector_type(2)));
__device__ __forceinline__ unsigned pk2_(float lo, float hi) { const f32x2_t v = {lo, hi}; const bf16x2_t b = __builtin_convertvector(v, bf16x2_t); return __builtin_bit_cast(unsigned, b); }
__device__ __forceinline__ unsigned f2bf_(float f) { return pk2_(f, 0.f) & 0xffffu; }
__device__ __forceinline__ v4i16_t vtr(LAS const unsigned char* p) { return __builtin_amdgcn_ds_read_tr16_b64_v4i16((LAS v4i16_t*)p); }
template <class T> __device__ __forceinline__ T* uni(T* p) {
  const unsigned long long v = (unsigned long long)p;
  const unsigned lo = __builtin_amdgcn_readfirstlane((unsigned)v), hi = __builtin_amdgcn_readfirstlane((unsigned)(v >> 32));
  return (T*)(((unsigned long long)hi << 32) | lo);
}
__device__ __forceinline__ float wsum(float v) {
#pragma unroll
  for (int o = 1; o < 64; o <<= 1) v += __shfl_xor(v, o);
  return v;
}
__device__ __forceinline__ const GASF* xrow_in(const LAS PG& p, int layer, const unsigned char* ws, int m) {
  if (layer == 0) return (m < NPT) ? p.x_prompt + (size_t)m * D : p.x_sample + (size_t)(m - NPT) * D;
  if (layer == 2) return p.out + OUT_Y + (size_t)m * D;
  return (const GASF*)(ws + M_X) + (size_t)m * D;
}

__device__ __forceinline__ void tr_item(const GASF* W, int K, int N, bf16_t* WT, int kind, int row_off, int remap416, LAS float* scr, int item, int lane) {
  const int nblk = N / 32, kb = item / nblk, nb = item % nblk, k0 = 64 * kb, n0 = 32 * nb;
#pragma unroll 8
  for (int i = 0; i < 32; ++i) { const int kk = 2 * i + (lane >> 5); scr[kk * 33 + (lane & 31)] = W[(size_t)(k0 + kk) * N + n0 + (lane & 31)]; }
  asm volatile("s_waitcnt lgkmcnt(0)" ::: "memory");
  const int c = lane & 7;
#pragma unroll
  for (int jj = 0; jj < 4; ++jj) {
    const int n = (lane >> 3) + 8 * jj; LAS const float* s = scr + (8 * c) * 33 + n;
    u32x4 o; o.x = pk2_(s[0 * 33], s[1 * 33]); o.y = pk2_(s[2 * 33], s[3 * 33]); o.z = pk2_(s[4 * 33], s[5 * 33]); o.w = pk2_(s[6 * 33], s[7 * 33]);
    const int ng = n0 + n + row_off;
    if (kind == 0) {
      *(u32x4*)(WT + (size_t)ng * K + k0 + 8 * c) = o;
    } else {
      const int k8 = (k0 >> 3) + c;
      const size_t ci = ((size_t)((ng >> 5) * 64 + (k8 >> 1))) * 64 + (ng & 31) + 32 * (k8 & 1);
      *(u32x4*)(WT + ci * 8) = o;
    }
  }
  asm volatile("s_waitcnt lgkmcnt(0)" ::: "memory");
}

__device__ __forceinline__ void phase_p0a(const LAS PG& p, unsigned char* ws, LAS unsigned char* lds, int tid, int lane, int wave, int bid, int G) {
  LAS float* SC = (LAS float*)lds;
  for (int i = tid; i < 3072; i += 512) { const int g = i >> 10, k = i & 1023; const float c = (g == 0) ? p.c_ctx[k] : p.c[(g - 1) * 1024 + k]; SC[i] = silu(c); }
  __syncthreads();
  for (int it = bid; it < 192; it += G) {
    const int kc = it & 7, cc = (it >> 3) % 6, i = it / 48;
    const int n = cc * 512 + tid;
    const GASF* w = p.mod_w + ((size_t)i * 1024 + kc * 128) * 3072 + n;
    float a0 = 0.f, a1 = 0.f, a2 = 0.f;
#pragma unroll 8
    for (int k = 0; k < 128; ++k) { const float wv = w[(size_t)k * 3072]; const int kk = kc * 128 + k; a0 += SC[kk] * wv; a1 += SC[1024 + kk] * wv; a2 += SC[2048 + kk] * wv; }
    float* mp = (float*)(ws + M_MODP) + (size_t)kc * 36864 + (size_t)i * 9216 + n;
    mp[0] = a0; mp[3072] = a1; mp[6144] = a2;
  }
  __syncthreads();
  for (int i = bid * 512 + tid; i < 2 * PAST * 128 / 8; i += G * 512) {
    const int d8 = i & 15, pl = (i >> 4) & 511, b = i >> 13;
    const f32x4* src = (const f32x4*)(p.cache_ckv + ((size_t)(b * PAST + pl)) * 128 + d8 * 8);
    const f32x4 x0 = src[0], x1 = src[1];
    u32x4 o; o.x = pk2_(x0.x, x0.y); o.y = pk2_(x0.z, x0.w); o.z = pk2_(x1.x, x1.y); o.w = pk2_(x1.z, x1.w);
    *(u32x4*)((bf16_t*)(ws + M_CKVALL) + ((size_t)(NPT + b * 2560 + pl)) * 128 + d8 * 8) = o;
    if (d8 < 4) {
      const f32x4* s2 = (const f32x4*)(p.cache_kpe + ((size_t)(b * PAST + pl)) * 32 + d8 * 8);
      const f32x4 y0 = s2[0], y1 = s2[1];
      u32x4 o2; o2.x = pk2_(y0.x, y0.y); o2.y = pk2_(y0.z, y0.w); o2.z = pk2_(y1.x, y1.y); o2.w = pk2_(y1.z, y1.w);
      *(u32x4*)((bf16_t*)(ws + M_KPEB) + ((size_t)(NPT + b * 2560 + pl)) * 32 + d8 * 8) = o2;
    }
  }
  LAS float* scr = (LAS float*)(lds + wave * 16384);
  const int gw = bid * 8 + wave, NGW = G * 8;
  constexpr int I_HYIN = 16 * 128, I_SQ = 16 * 32, I_MLAIN = 16 * 45, I_QUP = 4 * 48, I_KVUP = 2 * 64, I_LORA = 16 * 2;
  constexpr int NTR = 2 * I_HYIN + 2 * I_SQ + I_MLAIN + I_QUP + I_KVUP + I_SQ + 4 * I_SQ + 4 * I_LORA + I_SQ;
  constexpr int NHD = 2 * 144;
  for (int it = gw; it < NTR + NHD; it += NGW) {
    int r = it;
    if (r < NTR) {
      if (r < 2 * I_HYIN) { const int j = r / I_HYIN; tr_item(p.hy_w_in + (size_t)j * D * 4096, 1024, 4096, (bf16_t*)(ws + W_HYIN + (size_t)j * 8 * MiB), 0, 0, 0, scr, r % I_HYIN, lane); continue; } r -= 2 * I_HYIN;
      if (r < 2 * I_SQ) { const int j = r / I_SQ; tr_item(p.hy_w_out + (size_t)j * D * D, 1024, 1024, (bf16_t*)(ws + W_HYOUT + (size_t)j * 2 * MiB), 1, 0, 0, scr, r % I_SQ, lane); continue; } r -= 2 * I_SQ;
      if (r < I_MLAIN) { const int nb = r % 45; if (nb < 13) tr_item(p.mla_w_in, 1024, 1440, (bf16_t*)(ws + W_MLAIN), 1, 0, 0, scr, r, lane);
        else tr_item(p.mla_w_in, 1024, 1440, (bf16_t*)(ws + W_MLAIN + MiB), 0, -416, 0, scr, r, lane); continue; } r -= I_MLAIN;
      if (r < I_QUP) { tr_item(p.mla_w_q_up, 256, 1536, (bf16_t*)(ws + W_QUP), 0, 0, 0, scr, r, lane); continue; } r -= I_QUP;
      if (r < I_KVUP) { tr_item(p.mla_w_kv_up, 128, 2048, (bf16_t*)(ws + W_KVUP), 0, 0, 0, scr, r, lane); continue; } r -= I_KVUP;
      if (r < I_SQ) { tr_item(p.mla_w_out, 1024, 1024, (bf16_t*)(ws + W_MLAOUT), 1, 0, 0, scr, r, lane); continue; } r -= I_SQ;
      if (r < 4 * I_SQ) { const int q = r / I_SQ; tr_item(p.rw_w_in + (size_t)q * D * D, 1024, 1024, (bf16_t*)(ws + W_RWIN + (size_t)q * 2 * MiB), 0, 0, 0, scr, r % I_SQ, lane); continue; } r -= 4 * I_SQ;
      if (r < 4 * I_LORA) { const int q = r / I_LORA; const GASF* src = (q < 2) ? p.rw_w1 + (size_t)q * D * 64 : p.rw_a1 + (size_t)(q - 2) * D * 64;
        tr_item(src, 1024, 64, (bf16_t*)(ws + W_LORA1), 1, q * 64, 0, scr, r % I_LORA, lane); continue; } r -= 4 * I_LORA;
      tr_item(p.rw_w_out, 1024, 1024, (bf16_t*)(ws + W_RWOUT), 1, 0, 0, scr, r, lane);
    } else {
      r -= NTR;
      const int j = r / 144, row0 = (r % 144) * 16;
      float w1c[33];
      {
        const GASF* w1b = p.hy_w1 + (size_t)j * 33 * 64 + lane; const GASF* w2b = p.hy_w2 + (size_t)j * 64 * 64 + lane;
        asm volatile("s_waitcnt lgkmcnt(0)" ::: "memory");
#pragma unroll 8
        for (int f = 0; f < 33; ++f) { scr[f * 64 + lane] = *w1b; w1b += 64; }
        asm volatile("s_waitcnt lgkmcnt(0)" ::: "memory");
#pragma unroll
        for (int f = 0; f < 33; ++f) w1c[f] = scr[f * 64 + lane];
        asm volatile("s_waitcnt lgkmcnt(0)" ::: "memory");
#pragma unroll 8
        for (int f = 0; f < 64; ++f) { scr[f * 64 + lane] = *w2b; w2b += 64; }
        asm volatile("s_waitcnt lgkmcnt(0)" ::: "memory");
      }
      const float b1 = p.hy_b1[j * 64 + lane], b2 = p.hy_b2[j * 64 + lane], f0 = p.hy_freq[(j * 2 + 0) * 64 + lane], f1 = p.hy_freq[(j * 2 + 1) * 64 + lane];
#pragma unroll 1
      for (int rr = 0; rr < 16; ++rr) {
        const int row = row0 + rr;
        const int L = row < 256 ? 256 : 2048, l = row < 256 ? row : row - 256;
        const float t = (float)l / (float)(L - 1);
        float feat = 0.f;
        if (lane == 0) feat = t;
        else if (lane < 33) {
          const int b = (lane - 1) & 15;
          const float band = 1e-4f + (float)b * ((15.f - 1e-4f) / 15.f);
          const float ang = (6.283185307179586f / (float)L) * (float)l * band;
          feat = (lane <= 16) ? cosf(ang) : -sinf(ang);
        }
        float a = b1;
#pragma unroll
        for (int f = 0; f < 33; ++f) a += __shfl(feat, f) * w1c[f];
        const float h1 = sinf(f0 * a);
        float a2 = b2;
#pragma unroll 8
        for (int f = 0; f < 64; ++f) a2 += __shfl(h1, f) * scr[f * 64 + lane];
        const float h2 = sinf(f1 * a2);
        ((float*)(ws + M_HDN2))[((size_t)j * 2304 + row) * 64 + lane] = h2;
      }
    }
  }
}

__device__ __forceinline__ void phase_p0b(const LAS PG& p, unsigned char* ws, LAS unsigned char* lds, int tid, int lane, int wave, int bid, int G) {
  const float* MP = (const float*)(ws + M_MODP);
  float* MODS = (float*)(ws + M_MODS);
  for (int idx = bid * 512 + tid; idx < 36864; idx += G * 512) {
    float s = p.mod_b[(idx / 9216) * 3072 + (idx % 3072)];
#pragma unroll
    for (int kc = 0; kc < 8; ++kc) s += MP[(size_t)kc * 36864 + idx];
    MODS[idx] = s;
  }
  LAS float* ML = (LAS float*)lds;
  for (int e = tid; e < 6144; e += 512) {
    const int g = e >> 11, r = e & 2047; const int idx = g * 3072 + r;
    float s = p.mod_b[r];
#pragma unroll
    for (int kc = 0; kc < 8; ++kc) s += MP[(size_t)kc * 36864 + idx];
    ML[e] = s;
  }
  __syncthreads();
  bf16_t* HB = (bf16_t*)(ws + M_HB);
#ifndef NO_H0
  for (int m = bid * 8 + wave; m < NTOK; m += G * 8) {
    int l, L, cond, m0; tokinfo(m, l, L, cond, m0);
    const GAS f32x4* xr = (const GAS f32x4*)xrow_in(p, 0, ws, m);
    LAS const float* sh = ML + cond * 2048; LAS const float* sc = sh + 1024;
#pragma unroll
    for (int i = 0; i < 4; ++i) {
      const int k = 4 * lane + 256 * i; const f32x4 x = xr[lane + 64 * i];
      u32x2 o; o.x = pk2_(x.x * (1.f + sc[k]) + sh[k], x.y * (1.f + sc[k + 1]) + sh[k + 1]); o.y = pk2_(x.z * (1.f + sc[k + 2]) + sh[k + 2], x.w * (1.f + sc[k + 3]) + sh[k + 3]);
      *(u32x2*)(HB + (size_t)m * D + k) = o;
    }
  }
#endif
  __syncthreads();
#ifndef NO_FG
  LAS float* hs = (LAS float*)(lds + wave * 2048);
  const int gw = bid * 8 + wave, NGW = G * 8;
  const float* HD = (const float*)(ws + M_HDN2);
  bf16_t* FILT = (bf16_t*)(ws + M_FILT);
  for (int wslot = gw; wslot < 64 * 32; wslot += NGW) {
    const int combo = wslot & 63, sub = wslot >> 6;
    const int cch = combo & 15, dir = (combo >> 4) & 1, j = combo >> 5;
    const int c = cch * 64 + lane, o = dir * 1024 + c;
    LAS float* w3s = (LAS float*)(lds + 16384 + wave * 16384);
    {
      const GASF* w3 = p.hy_w3 + ((size_t)j * 64 * 2048 + dir * 1024 + cch * 64 + lane);
      asm volatile("s_waitcnt lgkmcnt(0)" ::: "memory");
#pragma unroll 8
      for (int m = 0; m < 64; ++m) { w3s[m * 64 + lane] = *w3; w3 += 2048; }
      asm volatile("s_waitcnt lgkmcnt(0)" ::: "memory");
    }
    const float b3 = p.hy_b3[j * 2048 + o];
    const float dec = fabsf(p.hy_decay[(size_t)j * 2048 + o]);
    const float skip = p.hy_skip[j * D + c];
#pragma unroll 1
    for (int qq = sub; qq < 290; qq += 32) {
    const int set = qq < 33 ? 0 : 1, qi = set ? qq - 33 : qq, L = set ? 2048 : 256, row0 = set ? 256 : 0;
    asm volatile("s_waitcnt lgkmcnt(0)" ::: "memory");
#pragma unroll
    for (int e = 0; e < 8; ++e) {
      const int lag = dir ? 8 * qi + e : 8 * qi - e;
      const bool ok = dir ? (lag >= 1 && lag <= L - 1) : (lag >= 0 && lag <= L - 1);
      hs[e * 64 + lane] = ok ? HD[((size_t)j * 2304 + row0 + lag) * 64 + lane] : 0.f;
    }
    asm volatile("s_waitcnt lgkmcnt(0)" ::: "memory");
    float acc[8];
#pragma unroll
    for (int e = 0; e < 8; ++e) acc[e] = b3;
#pragma unroll 2
    for (int m4 = 0; m4 < 16; ++m4) {
      const float w0 = w3s[(4 * m4 + 0) * 64 + lane], w1 = w3s[(4 * m4 + 1) * 64 + lane], w2 = w3s[(4 * m4 + 2) * 64 + lane], w3v = w3s[(4 * m4 + 3) * 64 + lane];
#pragma unroll
      for (int e = 0; e < 8; ++e) {
        const f32x4 h4 = *(LAS const f32x4*)(hs + e * 64 + 4 * m4);
        acc[e] += h4.x * w0 + h4.y * w1 + h4.z * w2 + h4.w * w3v;
      }
    }
    unsigned vb[8];
#pragma unroll
    for (int e = 0; e < 8; ++e) {
      const int lag = dir ? 8 * qi + e : 8 * qi - e;
      const bool ok = dir ? (lag >= 1 && lag <= L - 1) : (lag >= 0 && lag <= L - 1);
      const float t = (float)lag / (float)(L - 1);
      float v = acc[e] * expf(-t * dec);
      if (!dir && lag == 0) v += skip;
      vb[e] = ok ? f2bf_(v) : 0u;
    }
    bf16_t* dst = FILT + ((size_t)(j * 1024 + c)) * FILT_CH + (set ? 528 : 0) + (dir ? 8 * qi : -8 * qi) + L + 8;
    if (qi != 0) {
      u32x4 ov; ov.x = vb[0] | (vb[1] << 16); ov.y = vb[2] | (vb[3] << 16); ov.z = vb[4] | (vb[5] << 16); ov.w = vb[6] | (vb[7] << 16);
      *(u32x4*)dst = ov;
    } else if (!dir) {
      dst[0] = (bf16_t)vb[0];
    } else {
#pragma unroll
      for (int e = 1; e < 8; ++e) dst[e] = (bf16_t)vb[e];
    }
    }
  }
#endif
}
constexpr int FK_S = 0, FK_P = 65920, VBS = 74368, VBP = 91776, VB_END = 118400, E_OFF = 118400, SCR_S = 0, SCR_P = 65536;
__device__ __forceinline__ float conv3e(float pv, float cur, float nx, float w0, float w1, float w2, float b) { return pv * w0 + cur * w1 + nx * w2 + b; }

__device__ __forceinline__ void phase_hy_conv(const LAS PG& p, unsigned char* ws, LAS unsigned char* lds, int j, int tid, int lane, int wave, int bid, int G) {
  const bf16_t* UT = (const bf16_t*)(ws + M_UT);
  bf16_t* GT = (bf16_t*)(ws + M_GB);
  const bf16_t* FILT = (const bf16_t*)(ws + M_FILT);
  const int r = lane & 31, h = lane >> 5, rho = (-r) & 7;
  for (int c = bid; c < 1024; c += G) {
    __syncthreads();
    for (int i = tid; i < (VB_END - VBS) / 16; i += 512) *(LAS u32x4*)(lds + VBS + i * 16) = (u32x4){0u, 0u, 0u, 0u};
    __syncthreads();
    {
      const GASF* cw = p.hy_conv_w + (size_t)j * 3 * 3072; const GASF* cb = p.hy_conv_b + (size_t)j * 3072;
      const float a0 = cw[c], a1 = cw[3072 + c], a2 = cw[6144 + c], ab = cb[c];
      const float b0 = cw[1024 + c], b1 = cw[3072 + 1024 + c], b2 = cw[6144 + 1024 + c], bb = cb[1024 + c];
      const float v0 = cw[2048 + c], v1 = cw[3072 + 2048 + c], v2 = cw[6144 + 2048 + c], vbb = cb[2048 + c];
      for (int ch = tid; ch < 1024; ch += 512) {
        const int tok = ch * 8;
        int l, L; unsigned dst;
        if (tok < NPT) { l = tok & 255; L = 256; const int chunk = 32 + (l >> 3); dst = VBP + (tok >> 8) * 1664 + (chunk + (chunk >> 4)) * 16; }
        else { const int mm = tok - NPT; l = mm & 2047; L = 2048; const int chunk = 128 + (l >> 3); dst = VBS + (mm >> 11) * 8704 + (chunk + (chunk >> 4)) * 16; }
        const bf16_t* r0 = UT + (size_t)c * 8192 + tok; const bf16_t* r1 = r0 + (size_t)1024 * 8192; const bf16_t* r2 = r0 + (size_t)2048 * 8192; const bf16_t* r3 = r0 + (size_t)3072 * 8192;
        const u32x4 X0 = *(const u32x4*)r0, X1 = *(const u32x4*)r1, XV = *(const u32x4*)r2, XZ = *(const u32x4*)r3;
        const bool hp = l > 0, hn = (l + 8) < L;
        const float p0 = hp ? bf2f(r0[-1]) : 0.f, p1 = hp ? bf2f(r1[-1]) : 0.f, p2 = hp ? bf2f(r2[-1]) : 0.f;
        const float n0 = hn ? bf2f(r0[8]) : 0.f, n1 = hn ? bf2f(r1[8]) : 0.f, n2 = hn ? bf2f(r2[8]) : 0.f;
        float x0[10], x1[10], xv[10], z[8];
        x0[0] = p0; x1[0] = p1; xv[0] = p2; x0[9] = n0; x1[9] = n1; xv[9] = n2;
#pragma unroll
        for (int e = 0; e < 4; ++e) {
          x0[1 + 2 * e] = bf2f(X0[e] & 0xffffu); x0[2 + 2 * e] = bf2f(X0[e] >> 16);
          x1[1 + 2 * e] = bf2f(X1[e] & 0xffffu); x1[2 + 2 * e] = bf2f(X1[e] >> 16);
          xv[1 + 2 * e] = bf2f(XV[e] & 0xffffu); xv[2 + 2 * e] = bf2f(XV[e] >> 16);
          z[2 * e] = bf2f(XZ[e] & 0xffffu); z[2 * e + 1] = bf2f(XZ[e] >> 16);
        }
        float vv[8], ev[8];
#pragma unroll
        for (int e = 0; e < 8; ++e) {
          const float c0 = conv3e(x0[e], x0[e + 1], x0[e + 2], a0, a1, a2, ab);
          const float c1 = conv3e(x1[e], x1[e + 1], x1[e + 2], b0, b1, b2, bb);
          const float cv = conv3e(xv[e], xv[e + 1], xv[e + 2], v0, v1, v2, vbb);
          vv[e] = cv * c1; ev[e] = c0 * silu(z[e]);
        }
        u32x4 o; o.x = pk2_(vv[0], vv[1]); o.y = pk2_(vv[2], vv[3]); o.z = pk2_(vv[4], vv[5]); o.w = pk2_(vv[6], vv[7]);
        *(LAS u32x4*)(lds + dst) = o;
        *(LAS f32x4*)(lds + E_OFF + tok * 4) = (f32x4){ev[0], ev[1], ev[2], ev[3]};
        *(LAS f32x4*)(lds + E_OFF + tok * 4 + 16) = (f32x4){ev[4], ev[5], ev[6], ev[7]};
      }
      const bf16_t* Rc = FILT + ((size_t)(j * 1024 + c)) * FILT_CH;
      for (int gi = tid; gi < 515 + 66; gi += 512) {
        const bool smp = gi < 515; const int gq = smp ? gi : gi - 515; const int LEN = smp ? 4112 : 528;
        const bf16_t* Rg = Rc + (smp ? 528 : 0); const int idx0 = 8 * gq + 8;
        u32x4 lo = (u32x4){0u, 0u, 0u, 0u}, hi = (u32x4){0u, 0u, 0u, 0u};
        if (idx0 + 8 <= LEN) lo = *(const u32x4*)(Rg + idx0);
        if (idx0 + 16 <= LEN) hi = *(const u32x4*)(Rg + idx0 + 8);
        const unsigned d0 = lo.x, d1 = lo.y, d2 = lo.z, d3 = lo.w, d4 = hi.x, d5 = hi.y, d6 = hi.z, d7 = hi.w;
        LAS unsigned char* dstp = lds + (smp ? FK_S : FK_P) + gq * 128;
#define AB(hi_, lo_) __builtin_amdgcn_alignbit(hi_, lo_, 16)
        *(LAS u32x4*)(dstp + 0) = (u32x4){d0, d1, d2, d3};
        *(LAS u32x4*)(dstp + 16) = (u32x4){AB(d1, d0), AB(d2, d1), AB(d3, d2), AB(d4, d3)};
        *(LAS u32x4*)(dstp + 32) = (u32x4){d1, d2, d3, d4};
        *(LAS u32x4*)(dstp + 48) = (u32x4){AB(d2, d1), AB(d3, d2), AB(d4, d3), AB(d5, d4)};
        *(LAS u32x4*)(dstp + 64) = (u32x4){d2, d3, d4, d5};
        *(LAS u32x4*)(dstp + 80) = (u32x4){AB(d3, d2), AB(d4, d3), AB(d5, d4), AB(d6, d5)};
        *(LAS u32x4*)(dstp + 96) = (u32x4){d3, d4, d5, d6};
        *(LAS u32x4*)(dstp + 112) = (u32x4){AB(d4, d3), AB(d5, d4), AB(d6, d5), AB(d7, d6)};
#undef AB
      }
    }
    __syncthreads();
    f32x16 s0, s1, pr;
#pragma unroll
    for (int i = 0; i < 16; ++i) { s0[i] = 0.f; s1[i] = 0.f; pr[i] = 0.f; }
    {
      const int ahalf = wave & 1, dq = wave >> 1;
      const int a = ahalf * 32 + r;
      const int n0 = (ahalf ? -64 : -128) + 48 * dq, cnt = (dq == 3) ? 47 : 48;
      for (int s = 0; s < cnt; ++s) {
        const int n = n0 + s;
        const int e0 = 8 * h - r - 16 * n; const int q = (e0 - rho) >> 3;
        const bf16x8 af = *(LAS const bf16x8*)(lds + FK_S + ((q + 256) * 8 + rho) * 16);
        const int qb = 128 + h + 4 * a - 2 * n; const int pb = qb + (qb >> 4);
        const bf16x8 b0 = *(LAS const bf16x8*)(lds + VBS + pb * 16);
        const bf16x8 b1 = *(LAS const bf16x8*)(lds + VBS + 8704 + pb * 16);
        s0 = __builtin_amdgcn_mfma_f32_32x32x16_bf16(af, b0, s0, 0, 0, 0);
        s1 = __builtin_amdgcn_mfma_f32_32x32x16_bf16(af, b1, s1, 0, 0, 0);
      }
    }
    {
      const int ntile = wave & 3, dh = wave >> 2;
      const int batch = 4 * ntile + (r >> 3), a = r & 7;
      const int n0 = dh ? 0 : -16, cnt = dh ? 15 : 16;
      for (int s = 0; s < cnt; ++s) {
        const int n = n0 + s;
        const int e0 = 8 * h - r - 16 * n; const int q = (e0 - rho) >> 3;
        const bf16x8 af = *(LAS const bf16x8*)(lds + FK_P + ((q + 32) * 8 + rho) * 16);
        const int qb = 32 + h + 4 * a - 2 * n; const int pb = qb + (qb >> 4);
        const bf16x8 b0 = *(LAS const bf16x8*)(lds + VBP + batch * 1664 + pb * 16);
        pr = __builtin_amdgcn_mfma_f32_32x32x16_bf16(af, b0, pr, 0, 0, 0);
      }
    }
    __syncthreads();
    {
      const int ahalf = wave & 1, dq = wave >> 1;
#pragma unroll
      for (int g = 0; g < 4; ++g) {
        const int off = (r * 32 + 8 * g + 4 * h) * 4;
        *(LAS f32x4*)(lds + SCR_S + (((ahalf * 2 + 0) * 4 + dq) * 1024) * 4 + off) = (f32x4){s0[4 * g], s0[4 * g + 1], s0[4 * g + 2], s0[4 * g + 3]};
        *(LAS f32x4*)(lds + SCR_S + (((ahalf * 2 + 1) * 4 + dq) * 1024) * 4 + off) = (f32x4){s1[4 * g], s1[4 * g + 1], s1[4 * g + 2], s1[4 * g + 3]};
        *(LAS f32x4*)(lds + SCR_P + (((wave & 3) * 2 + (wave >> 2)) * 1024) * 4 + off) = (f32x4){pr[4 * g], pr[4 * g + 1], pr[4 * g + 2], pr[4 * g + 3]};
      }
    }
    __syncthreads();
    {
      {
        const int o = tid * 8; const int b = o >> 11, t = o & 2047; const int a = t >> 5, rr = t & 31; const int tile = (a >> 5) * 2 + b, col = a & 31;
        f32x4 y0 = (f32x4){0.f, 0.f, 0.f, 0.f}, y1 = y0;
#pragma unroll
        for (int dq = 0; dq < 4; ++dq) {
          LAS const unsigned char* sp = lds + SCR_S + (((tile * 4 + dq) * 1024) + col * 32 + rr) * 4;
          y0 += *(LAS const f32x4*)sp; y1 += *(LAS const f32x4*)(sp + 16);
        }
        const int token = NPT + o;
        const f32x4 e0 = *(LAS const f32x4*)(lds + E_OFF + token * 4), e1 = *(LAS const f32x4*)(lds + E_OFF + token * 4 + 16);
        u32x4 ov; ov.x = pk2_(y0.x * e0.x, y0.y * e0.y); ov.y = pk2_(y0.z * e0.z, y0.w * e0.w); ov.z = pk2_(y1.x * e1.x, y1.y * e1.y); ov.w = pk2_(y1.z * e1.z, y1.w * e1.w);
        *(u32x4*)(GT + (size_t)c * 8192 + token) = ov;
      }
      {
        const int o = tid * 8; const int batch = o >> 8, t = o & 255; const int ntile = batch >> 2, col = (batch & 3) * 8 + (t >> 5), rr = t & 31;
        f32x4 y0 = (f32x4){0.f, 0.f, 0.f, 0.f}, y1 = y0;
#pragma unroll
        for (int dh = 0; dh < 2; ++dh) {
          LAS const unsigned char* sp = lds + SCR_P + (((ntile * 2 + dh) * 1024) + col * 32 + rr) * 4;
          y0 += *(LAS const f32x4*)sp; y1 += *(LAS const f32x4*)(sp + 16);
        }
        const int token = o;
        const f32x4 e0 = *(LAS const f32x4*)(lds + E_OFF + token * 4), e1 = *(LAS const f32x4*)(lds + E_OFF + token * 4 + 16);
        u32x4 ov; ov.x = pk2_(y0.x * e0.x, y0.y * e0.y); ov.y = pk2_(y0.z * e0.z, y0.w * e0.w); ov.z = pk2_(y1.x * e1.x, y1.y * e1.y); ov.w = pk2_(y1.z * e1.z, y1.w * e1.w);
        *(u32x4*)(GT + (size_t)c * 8192 + token) = ov;
      }
    }
  }
}

template <int MODE>
__device__ __forceinline__ void phase_out_ln(const LAS PG& p, unsigned char* ws, LAS unsigned char* lds, int layer, const bf16_t* Wf, int tid, int lane, int wave, int bid, int G) {
  const bf16_t* GA = (const bf16_t*)(ws + M_GB);
  const float* MODS = (const float*)(ws + M_MODS);
  const int h = lane >> 5;
  for (int tile = bid; tile < NTOK / 32; tile += G) {
    const int t0 = tile * 32;
    __syncthreads();
    constexpr bool CHM = (MODE == 1);
    if (MODE == 2) {
      const float* BON = (const float*)(ws + M_GB + 8 * MiB);
#pragma unroll 4
      for (int it = 0; it < 64; ++it) {
        const int pr = wave * 64 + it; const int tok = pr >> 4, hd = pr & 15, m = t0 + tok;
        const size_t gi = (size_t)m * D + hd * 64 + lane;
        const float y = ((const float*)(ws + M_UT))[gi] + ((const float*)(ws + M_UT + 32 * MiB))[gi];
        const float mu = wsum(y) * (1.f / 64.f);
        const float d = y - mu;
        const float rstd = rsqrtf(wsum(d * d) * (1.f / 64.f) + GN_EPS);
        const f32x4 bo0 = *(const f32x4*)(BON + ((size_t)m * 16 + hd) * 4), bo1 = *(const f32x4*)(BON + (((size_t)NTOK + m) * 16 + hd) * 4);
        const float bon = ((bo0.x + bo0.y) + (bo0.z + bo0.w)) + ((bo1.x + bo1.y) + (bo1.z + bo1.w));
        const float v = bf2f(((const bf16_t*)(ws + M_SCR2 + 32 * MiB))[gi]), z = bf2f(((const bf16_t*)(ws + M_SCR2 + 48 * MiB))[gi]);
        const float o = (d * rstd * p.rw_gn_g[hd * 64 + lane] + p.rw_gn_b[hd * 64 + lane] + bon * v) * z;
        *(LAS bf16_t*)(lds + ((hd * 8 + (lane >> 3)) * 32 + tok) * 16 + (lane & 7) * 2) = (bf16_t)f2bf_(o);
      }
    } else {
#pragma unroll
    for (int i = 0; i < 8; ++i) {
      const int idx = tid + 512 * i;
      if (CHM) { const int c = idx >> 2, part = idx & 3; *(LAS u32x4*)(lds + c * 64 + part * 16) = *(const u32x4*)(GA + (size_t)c * 8192 + t0 + 8 * part); }
      else { const int tok = idx >> 7, k8 = idx & 127; *(LAS u32x4*)(lds + (k8 * 32 + tok) * 16) = *(const u32x4*)(GA + (size_t)(t0 + tok) * D + 8 * k8); }
    }
    }
    __syncthreads();
    f32x16 acc[4];
#pragma unroll
    for (int nt = 0; nt < 4; ++nt)
#pragma unroll
      for (int i = 0; i < 16; ++i) acc[nt][i] = 0.f;
    const bf16_t* wf = Wf + ((size_t)(wave * 4) * 64 * 64 + lane) * 8;
    const int aoffT = ((h * 32) + (lane & 31)) * 16;
    const int aoffC = (8 * h + ((lane & 15) >> 2)) * 64 + 32 * ((lane >> 4) & 1) + 8 * (lane & 3);
#pragma unroll 4
    for (int ks = 0; ks < 64; ++ks) {
      bf16x8 af;
      if (CHM) {
        const v4i16_t lo = vtr(lds + aoffC + ks * 1024), hi = vtr(lds + aoffC + ks * 1024 + 256);
        af = (bf16x8){lo[0], lo[1], lo[2], lo[3], hi[0], hi[1], hi[2], hi[3]};
      } else {
        af = *(LAS const bf16x8*)(lds + aoffT + ks * 1024);
      }
#pragma unroll
      for (int nt = 0; nt < 4; ++nt) {
        const bf16x8 bfr = *(const bf16x8*)(wf + ((size_t)(nt * 64 + ks) * 64) * 8);
        acc[nt] = __builtin_amdgcn_mfma_f32_32x32x16_bf16(af, bfr, acc[nt], 0, 0, 0);
      }
    }
    __syncthreads();
#pragma unroll
    for (int nt = 0; nt < 4; ++nt)
#pragma unroll
      for (int i = 0; i < 16; ++i) {
        const int row = (i & 3) + 8 * (i >> 2) + 4 * h;
        *(LAS float*)(lds + (row * 1028 + (wave * 4 + nt) * 32 + (lane & 31)) * 4) = acc[nt][i];
      }
    __syncthreads();
#pragma unroll 1
    for (int i = 0; i < 4; ++i) {
      const int row = wave * 4 + i, m = t0 + row;
      int l, L, cond, m0; tokinfo(m, l, L, cond, m0);
      const float* gate = MODS + (size_t)(layer * 3 + cond) * 3072 + 2048;
      const GAS f32x4* xr = (const GAS f32x4*)xrow_in(p, layer, ws, m);
      f32x4 v[4]; float s = 0.f;
#pragma unroll
      for (int q = 0; q < 4; ++q) {
        const int k = 4 * lane + 256 * q;
        const f32x4 o = *(LAS const f32x4*)(lds + (row * 1028 + k) * 4);
        const f32x4 x = xr[lane + 64 * q]; const f32x4 g = *(const f32x4*)(gate + k);
        v[q] = ALPHA * x + g * o; s += (v[q].x + v[q].y) + (v[q].z + v[q].w);
      }
      const float mu = wsum(s) * (1.f / D); float qq = 0.f;
#pragma unroll
      for (int q = 0; q < 4; ++q) { v[q] = v[q] - mu; qq += (v[q].x * v[q].x + v[q].y * v[q].y) + (v[q].z * v[q].z + v[q].w * v[q].w); }
      const float rs = rsqrtf(wsum(qq) * (1.f / D) + LN_EPS);
      GASF* xo = (layer & 1) ? p.out + OUT_Y + (size_t)m * D : (GASF*)(ws + M_X) + (size_t)m * D;
      const float* nmod = MODS + (size_t)((layer + 1) * 3 + cond) * 3072;
      bf16_t* HB = (bf16_t*)(ws + M_HB) + (size_t)m * D;
#pragma unroll
      for (int q = 0; q < 4; ++q) {
        const int k = 4 * lane + 256 * q;
        const f32x4 lg = *(const f32x4*)(p.ln_g + layer * D + k), lb = *(const f32x4*)(p.ln_b + layer * D + k);
        const f32x4 y = v[q] * rs * lg + lb;
        *(GAS f32x4*)(xo + k) = y;
        if (layer < 3) {
          const f32x4 sh = *(const f32x4*)(nmod + k), sc = *(const f32x4*)(nmod + 1024 + k);
          u32x2 o; o.x = pk2_(y.x * (1.f + sc.x) + sh.x, y.y * (1.f + sc.y) + sh.y); o.y = pk2_(y.z * (1.f + sc.z) + sh.z, y.w * (1.f + sc.w) + sh.w);
          *(u32x2*)(HB + k) = o;
        }
      }
    }
  }
}

__device__ __forceinline__ int kvrow_(int m) { if (m < NPT) return m; const int mm = m - NPT; return NPT + (mm >> 11) * 2560 + PAST + (mm & 2047); }

struct EpiSilu {
  static constexpr bool PERM = true, AFTER_DRAIN = false;
  bf16_t* O; int ldc;
  __device__ __forceinline__ void operator()(const f32x4 (&acc)[2][2][4][2], const pg8::Unit& u, int wr, int wc, int fr, int fq) const {
    const int row0 = u.pm * 256 + wr * 64 + fr, col0 = u.pn * 256 + wc * 32 + 8 * fq;
#pragma unroll
    for (int ai = 0; ai < 2; ++ai)
#pragma unroll
      for (int m = 0; m < 4; ++m) {
        bf16_t* rowp = O + (size_t)(row0 + ai * 128 + m * 16) * ldc + col0;
#pragma unroll
        for (int bj = 0; bj < 2; ++bj) {
          const f32x4 v0 = acc[ai][bj][m][0], v1 = acc[ai][bj][m][1];
          u32x4 w; w.x = pk2_(silu(v0[0]), silu(v0[1])); w.y = pk2_(silu(v0[2]), silu(v0[3])); w.z = pk2_(silu(v1[0]), silu(v1[1])); w.w = pk2_(silu(v1[2]), silu(v1[3]));
          *(u32x4*)(rowp + bj * 128) = w;
        }
      }
  }
};
struct EpiKV {
  static constexpr bool PERM = true, AFTER_DRAIN = false;
  bf16_t* Kn; bf16_t* V;
  __device__ __forceinline__ void operator()(const f32x4 (&acc)[2][2][4][2], const pg8::Unit& u, int wr, int wc, int fr, int fq) const {
    const int row0 = u.pm * 256 + wr * 64 + fr;
    const int d = wc * 32 + 8 * fq;
    bf16_t* base = (d < 64 ? Kn : V) + (d & 63);
#pragma unroll
    for (int ai = 0; ai < 2; ++ai)
#pragma unroll
      for (int m = 0; m < 4; ++m) {
        const size_t row = (size_t)(row0 + ai * 128 + m * 16);
#pragma unroll
        for (int bj = 0; bj < 2; ++bj) {
          const int h = u.pn * 2 + bj;
          const f32x4 v0 = acc[ai][bj][m][0], v1 = acc[ai][bj][m][1];
          u32x4 w; w.x = pg8::cvt_pk_bf16(v0[0], v0[1]); w.y = pg8::cvt_pk_bf16(v0[2], v0[3]); w.z = pg8::cvt_pk_bf16(v1[0], v1[1]); w.w = pg8::cvt_pk_bf16(v1[2], v1[3]);
          *(u32x4*)(base + row * 1024 + h * 64) = w;
        }
      }
  }
};

__device__ __forceinline__ void mla_in_small_tile(const LAS PG& p, unsigned char* ws, LAS unsigned char* lds, int tile, int tid, int lane, int wave) {
  const bf16_t* HB = (const bf16_t*)(ws + M_HB);
  const bf16_t* Wf = (const bf16_t*)(ws + W_MLAIN);
  const int h = lane >> 5, t0 = tile * 32;
  constexpr int RB = 65536;
  __syncthreads();
#pragma unroll
  for (int i = 0; i < 8; ++i) {
    const int idx = tid + 512 * i; const int tok = idx >> 7, k8 = idx & 127;
    *(LAS u32x4*)(lds + (k8 * 32 + tok) * 16) = *(const u32x4*)(HB + (size_t)(t0 + tok) * D + 8 * k8);
  }
  __syncthreads();
  f32x16 acc[2];
#pragma unroll
  for (int nt = 0; nt < 2; ++nt)
#pragma unroll
    for (int i = 0; i < 16; ++i) acc[nt][i] = 0.f;
  const int aoffT = ((h * 32) + (lane & 31)) * 16;
  const int nt0 = wave * 2;
  const bool two = (nt0 + 1) < 13;
  if (nt0 < 13) {
    const bf16_t* wf = Wf + ((size_t)nt0 * 64 * 64 + lane) * 8;
#pragma unroll 8
    for (int ks = 0; ks < 64; ++ks) {
      const bf16x8 af = *(LAS const bf16x8*)(lds + aoffT + ks * 1024);
      const bf16x8 b0 = *(const bf16x8*)(wf + ((size_t)ks * 64) * 8);
      acc[0] = __builtin_amdgcn_mfma_f32_32x32x16_bf16(af, b0, acc[0], 0, 0, 0);
      if (two) {
        const bf16x8 b1 = *(const bf16x8*)(wf + ((size_t)(64 + ks) * 64) * 8);
        acc[1] = __builtin_amdgcn_mfma_f32_32x32x16_bf16(af, b1, acc[1], 0, 0, 0);
      }
    }
#pragma unroll
    for (int nt = 0; nt < 2; ++nt)
      if (nt == 0 || two)
#pragma unroll
        for (int i = 0; i < 16; ++i) {
          const int row = (i & 3) + 8 * (i >> 2) + 4 * h;
          *(LAS float*)(lds + RB + (row * 420 + (nt0 + nt) * 32 + (lane & 31)) * 4) = acc[nt][i];
        }
  }
  __syncthreads();
#pragma unroll 1
  for (int i = 0; i < 4; ++i) {
    const int row = wave * 4 + i, m = t0 + row;
    int l, L, cond, m0; tokinfo(m, l, L, cond, m0);
    LAS const float* rb = (LAS const float*)(lds + RB + row * 420 * 4);
    const f32x4 q = *(LAS const f32x4*)(rb + 4 * lane);
    const float rs = rsqrtf(wsum(q.x * q.x + q.y * q.y + q.z * q.z + q.w * q.w) * (1.f / 256.f) + RMS_EPS);
    const f32x4 g = *(const f32x4*)(p.mla_q_norm + 4 * lane);
    u32x2 qo; qo.x = pk2_(q.x * rs * g.x, q.y * rs * g.y); qo.y = pk2_(q.z * rs * g.z, q.w * rs * g.w);
    *(u32x2*)((bf16_t*)(ws + M_QN) + (size_t)m * 256 + 4 * lane) = qo;
    const float k0 = rb[256 + 2 * lane], k1 = rb[256 + 2 * lane + 1];
    const float rs2 = rsqrtf(wsum(k0 * k0 + k1 * k1) * (1.f / 128.f) + RMS_EPS);
    const float c0 = k0 * rs2 * p.mla_kv_norm[2 * lane], c1 = k1 * rs2 * p.mla_kv_norm[2 * lane + 1];
    const int kr = kvrow_(m);
    *(unsigned*)((bf16_t*)(ws + M_CKVALL) + (size_t)kr * 128 + 2 * lane) = pk2_(c0, c1);
    if (m < NPT) { p.out[OUT_CKV + (size_t)m * 128 + 2 * lane] = c0; p.out[OUT_CKV + (size_t)m * 128 + 2 * lane + 1] = c1; }
    const float x = rb[384 + (lane & 31)];
    const float partner = __shfl_xor(x, 8);
    float o = x;
    if (m >= NPT) {
      const int d = lane & 31, jj = d & 7;
      const float inv = exp2f(-(float)(2 * jj) * (13.287712379549449f / 16.f));
      const float pos = (d < 16) ? (float)(l >> 6) : (float)(l & 63);
      const float ang = pos * inv; const float cs = cosf(ang), sn = sinf(ang);
      o = (d & 8) ? x * cs + partner * sn : x * cs - partner * sn;
    }
    if (lane < 32) {
      ((bf16_t*)(ws + M_KPEB))[(size_t)kr * 32 + lane] = (bf16_t)f2bf_(o);
      if (m < NPT) p.out[OUT_KPE + (size_t)m * 32 + lane] = x;
    }
  }
}

constexpr int AT_KB = 12288, AT_VB = 8192, AT_BUF = AT_KB + AT_VB, AT_WS = 2 * AT_BUF, AT_ST = AT_WS + 8 * 256;
__device__ __forceinline__ int crow_(int r, int hi) { return (r & 3) + 8 * (r >> 2) + 4 * hi; }
__device__ __forceinline__ unsigned cvtpk(float lo, float hi) { return pk2_(lo, hi); }

__device__ __forceinline__ void attn_unit(const unsigned char* ws, LAS unsigned char* lds, int seq, int hd, int qb, bf16_t* Gout, int tid, int lane, int wave) {
  const bf16_t* Q = (const bf16_t*)(ws + M_Q); const bf16_t* Kn = (const bf16_t*)(ws + M_KN); const bf16_t* Vv = (const bf16_t*)(ws + M_V);
  const bf16_t* KP = (const bf16_t*)(ws + M_KPEB); const bf16_t* SZ = (const bf16_t*)(ws + M_SZB);
  const int r32 = lane & 31, hi = lane >> 5;
  const bool smp = seq >= 16;
  const int mq0 = smp ? NPT + (seq - 16) * 2048 + qb * 256 : seq * 256;
  const int kbase = smp ? NPT + (seq - 16) * 2560 : seq * 256;
  const int NT = smp ? 40 : 4;
  const float C2 = 0.10206207261596575f * 1.4426950408889634f;
  bf16x8 qr[6];
  {
    const int m = mq0 + wave * 32 + r32;
    const bf16_t* qp = Q + (size_t)m * 1536 + hd * 96;
    const int l = smp ? ((m - NPT) & 2047) : 0;
#pragma unroll
    for (int d0 = 0; d0 < 6; ++d0) {
      const u32x4 own = *(const u32x4*)(qp + 16 * d0 + 8 * hi);
      float f[8];
#pragma unroll
      for (int e = 0; e < 4; ++e) { f[2 * e] = bf2f(own[e] & 0xffffu); f[2 * e + 1] = bf2f(own[e] >> 16); }
      if (d0 >= 4 && smp) {
        const u32x4 oth = *(const u32x4*)(qp + 16 * d0 + 8 * (1 - hi));
        const float pos = (d0 == 4) ? (float)(l >> 6) : (float)(l & 63);
#pragma unroll
        for (int e = 0; e < 8; ++e) {
          const float pf = bf2f((e & 1) ? (oth[e >> 1] >> 16) : (oth[e >> 1] & 0xffffu));
          const float inv = exp2f(-(float)(2 * e) * (13.287712379549449f / 16.f));
          const float ang = pos * inv; const float cs = cosf(ang), sn = sinf(ang);
          f[e] = hi ? f[e] * cs + pf * sn : f[e] * cs - pf * sn;
        }
      }
      u32x4 o; o.x = pk2_(f[0] * C2, f[1] * C2); o.y = pk2_(f[2] * C2, f[3] * C2); o.z = pk2_(f[4] * C2, f[5] * C2); o.w = pk2_(f[6] * C2, f[7] * C2);
      qr[d0] = __builtin_bit_cast(bf16x8, o);
    }
  }
  const bf16_t* vsrc = Vv + (size_t)(kbase + 16 * (wave & 3) + (lane >> 2)) * 1024 + hd * 64 + (wave >> 2) * 32 + (lane & 3) * 8;
  const int kc0 = tid >> 6, key0 = tid & 63;
  const bf16_t* ksrc0 = Kn + (size_t)(kbase + key0) * 1024 + hd * 64 + 8 * kc0;
  const bool k2 = tid < 256;
  const bf16_t* ksrc1 = KP + (size_t)(kbase + key0) * 32 + 8 * (tid >> 6);
  u32x4 rv, rk0, rk1 = (u32x4){0u, 0u, 0u, 0u};
#define AT_LOAD(t) do { rv = *(const u32x4*)(vsrc + (size_t)(t) * 64 * 1024); rk0 = *(const u32x4*)(ksrc0 + (size_t)(t) * 64 * 1024); if (k2) rk1 = *(const u32x4*)(ksrc1 + (size_t)(t) * 64 * 32); } while (0)
#define AT_STORE(b) do { LAS unsigned char* bb = lds + (b) * AT_BUF; *(LAS u32x4*)(bb + tid * 16) = rk0; if (k2) *(LAS u32x4*)(bb + 8192 + tid * 16) = rk1; *(LAS u32x4*)(bb + AT_KB + tid * 16) = rv; } while (0)
  __syncthreads();
  AT_LOAD(0); AT_STORE(0);
  __syncthreads();
  LAS float* wsf = (LAS float*)(lds + AT_WS + wave * 256);
  f32x16 o0, o1;
#pragma unroll
  for (int i = 0; i < 16; ++i) { o0[i] = 0.f; o1[i] = 0.f; }
  float mrun = -1e30f, lrun = 0.f;
  const int vboff = ((lane >> 4) & 1) * 32 + (lane & 3) * 8 + (4 * hi + ((lane & 15) >> 2)) * 64;
  for (int t = 0; t < NT; ++t) {
    const int cur = t & 1;
    if (t + 1 < NT) AT_LOAD(t + 1);
    LAS const unsigned char* kb = lds + cur * AT_BUF + hi * 1024 + r32 * 16;
    f32x16 p0, p1;
#pragma unroll
    for (int i = 0; i < 16; ++i) { p0[i] = 0.f; p1[i] = 0.f; }
#pragma unroll
    for (int d0 = 0; d0 < 6; ++d0) {
      const bf16x8 a0 = *(LAS const bf16x8*)(kb + d0 * 2048), a1 = *(LAS const bf16x8*)(kb + d0 * 2048 + 512);
      p0 = __builtin_amdgcn_mfma_f32_32x32x16_bf16(a0, qr[d0], p0, 0, 0, 0);
      p1 = __builtin_amdgcn_mfma_f32_32x32x16_bf16(a1, qr[d0], p1, 0, 0, 0);
    }
    float rm = p0[0];
#pragma unroll
    for (int i = 1; i < 16; ++i) rm = fmaxf(rm, p0[i]);
#pragma unroll
    for (int i = 0; i < 16; ++i) rm = fmaxf(rm, p1[i]);
    rm = fmaxf(rm, __shfl_xor(rm, 32));
    const float mnew = fmaxf(mrun, rm);
    const float alpha = exp2f(mrun - mnew);
    mrun = mnew;
    float ps = 0.f;
#pragma unroll
    for (int i = 0; i < 16; ++i) { p0[i] = exp2f(p0[i] - mnew); p1[i] = exp2f(p1[i] - mnew); ps += p0[i] + p1[i]; }
    lrun = lrun * alpha + ps;
    if (hi == 0) wsf[r32] = alpha;
    asm volatile("s_waitcnt lgkmcnt(0)" ::: "memory");
#pragma unroll
    for (int i = 0; i < 16; ++i) { const float al = wsf[crow_(i, hi)]; o0[i] *= al; o1[i] *= al; }
    u32x4 w0, w1, w2, w3;
    w0.x = cvtpk(p0[0], p0[1]); w0.y = cvtpk(p0[2], p0[3]); w0.z = cvtpk(p0[4], p0[5]); w0.w = cvtpk(p0[6], p0[7]);
    w1.x = cvtpk(p0[8], p0[9]); w1.y = cvtpk(p0[10], p0[11]); w1.z = cvtpk(p0[12], p0[13]); w1.w = cvtpk(p0[14], p0[15]);
    w2.x = cvtpk(p1[0], p1[1]); w2.y = cvtpk(p1[2], p1[3]); w2.z = cvtpk(p1[4], p1[5]); w2.w = cvtpk(p1[6], p1[7]);
    w3.x = cvtpk(p1[8], p1[9]); w3.y = cvtpk(p1[10], p1[11]); w3.z = cvtpk(p1[12], p1[13]); w3.w = cvtpk(p1[14], p1[15]);
    const bf16x8 pa0 = __builtin_bit_cast(bf16x8, w0), pa1 = __builtin_bit_cast(bf16x8, w1), pa2 = __builtin_bit_cast(bf16x8, w2), pa3 = __builtin_bit_cast(bf16x8, w3);
    LAS const unsigned char* vb = lds + cur * AT_BUF + AT_KB + vboff;
#define AT_PV(O_, D0) do { \
      const v4i16_t l0 = vtr(vb + (D0) * 4096), h0 = vtr(vb + (D0) * 4096 + 512), l1 = vtr(vb + (D0) * 4096 + 1024), h1 = vtr(vb + (D0) * 4096 + 1024 + 512); \
      const v4i16_t l2 = vtr(vb + (D0) * 4096 + 2048), h2 = vtr(vb + (D0) * 4096 + 2048 + 512), l3 = vtr(vb + (D0) * 4096 + 3072), h3 = vtr(vb + (D0) * 4096 + 3072 + 512); \
      O_ = __builtin_amdgcn_mfma_f32_32x32x16_bf16(pa0, ((bf16x8){l0[0], l0[1], l0[2], l0[3], h0[0], h0[1], h0[2], h0[3]}), O_, 0, 0, 0); \
      O_ = __builtin_amdgcn_mfma_f32_32x32x16_bf16(pa1, ((bf16x8){l1[0], l1[1], l1[2], l1[3], h1[0], h1[1], h1[2], h1[3]}), O_, 0, 0, 0); \
      O_ = __builtin_amdgcn_mfma_f32_32x32x16_bf16(pa2, ((bf16x8){l2[0], l2[1], l2[2], l2[3], h2[0], h2[1], h2[2], h2[3]}), O_, 0, 0, 0); \
      O_ = __builtin_amdgcn_mfma_f32_32x32x16_bf16(pa3, ((bf16x8){l3[0], l3[1], l3[2], l3[3], h3[0], h3[1], h3[2], h3[3]}), O_, 0, 0, 0); } while (0)
    AT_PV(o0, 0); AT_PV(o1, 1);
#undef AT_PV
    if (t + 1 < NT) AT_STORE(cur ^ 1);
    __syncthreads();
  }
#undef AT_LOAD
#undef AT_STORE
  lrun += __shfl_xor(lrun, 32);
  if (hi == 0) wsf[32 + r32] = 1.f / lrun;
  asm volatile("s_waitcnt lgkmcnt(0)" ::: "memory");
  LAS bf16_t* stg = (LAS bf16_t*)(lds + AT_ST + wave * 4096);
#pragma unroll
  for (int i = 0; i < 16; ++i) {
    const int orow = crow_(i, hi); const float rl = wsf[32 + orow];
    stg[orow * 64 + r32] = (bf16_t)f2bf_(o0[i] * rl);
    stg[orow * 64 + 32 + r32] = (bf16_t)f2bf_(o1[i] * rl);
  }
  asm volatile("s_waitcnt lgkmcnt(0)" ::: "memory");
#pragma unroll
  for (int i = 0; i < 4; ++i) {
    const int row = i * 8 + (lane >> 3), ch = lane & 7;
    const u32x4 ov = *(LAS const u32x4*)(stg + row * 64 + ch * 8);
    const size_t gi = (size_t)(mq0 + wave * 32 + row) * D + hd * 64 + ch * 8;
    const u32x4 zv = *(const u32x4*)(SZ + gi);
    u32x4 res;
#pragma unroll
    for (int e = 0; e < 4; ++e) res[e] = pk2_(bf2f(ov[e] & 0xffffu) * bf2f(zv[e] & 0xffffu), bf2f(ov[e] >> 16) * bf2f(zv[e] >> 16));
    *(u32x4*)(Gout + gi) = res;
  }
}
constexpr size_t M_XMIX = M_UT;
constexpr size_t M_YF = M_UT, M_YB = M_UT + 32 * MiB;
constexpr size_t M_RB = M_SCR2, M_KB = M_SCR2 + 16 * MiB, M_VB = M_SCR2 + 32 * MiB, M_SZR = M_SCR2 + 48 * MiB;
constexpr size_t M_HWA = M_GB;
constexpr size_t M_BON = M_GB + 8 * MiB;

__device__ __forceinline__ void phase_rw_mix(const LAS PG& p, unsigned char* ws, int tid, int bid, int G) {
  const bf16_t* HB = (const bf16_t*)(ws + M_HB);
  bf16_t* XM = (bf16_t*)(ws + M_XMIX);
  for (int i = bid * 512 + tid; i < NTOK * 128; i += G * 512) {
    const int m = i >> 7, k8 = i & 127;
    int l, L, cond, m0; tokinfo(m, l, L, cond, m0);
    const u32x4 hc = *(const u32x4*)(HB + (size_t)m * D + 8 * k8);
    u32x4 hp = (u32x4){0u, 0u, 0u, 0u}, hn = hp;
    if (l > 0) hp = *(const u32x4*)(HB + (size_t)(m - 1) * D + 8 * k8);
    if (l < L - 1) hn = *(const u32x4*)(HB + (size_t)(m + 1) * D + 8 * k8);
    float h[8], d[8];
#pragma unroll
    for (int e = 0; e < 4; ++e) {
      h[2 * e] = bf2f(hc[e] & 0xffffu); h[2 * e + 1] = bf2f(hc[e] >> 16);
      d[2 * e] = 0.5f * (bf2f(hp[e] & 0xffffu) + bf2f(hn[e] & 0xffffu)) - h[2 * e];
      d[2 * e + 1] = 0.5f * (bf2f(hp[e] >> 16) + bf2f(hn[e] >> 16)) - h[2 * e + 1];
    }
#pragma unroll
    for (int q = 0; q < 4; ++q) {
      const int mi = (q == 0) ? 0 : (q == 1) ? 2 : (q == 2) ? 3 : 5;
      const f32x4 u0 = *(const f32x4*)(p.rw_mu + mi * D + 8 * k8), u1 = *(const f32x4*)(p.rw_mu + mi * D + 8 * k8 + 4);
      u32x4 o; o.x = pk2_(h[0] + d[0] * u0.x, h[1] + d[1] * u0.y); o.y = pk2_(h[2] + d[2] * u0.z, h[3] + d[3] * u0.w);
      o.z = pk2_(h[4] + d[4] * u1.x, h[5] + d[5] * u1.y); o.w = pk2_(h[6] + d[6] * u1.z, h[7] + d[7] * u1.w);
      *(u32x4*)(XM + (size_t)q * NTOK * D + (size_t)m * D + 8 * k8) = o;
    }
  }
}

__device__ __forceinline__ void rw_lora_tile(const LAS PG& p, unsigned char* ws, LAS unsigned char* lds, int tile, int tid, int lane, int wave) {
  const bf16_t* HB = (const bf16_t*)(ws + M_HB);
  const bf16_t* Wf = (const bf16_t*)(ws + W_LORA1);
  const int h = lane >> 5, t0 = tile * 32;
  __syncthreads();
#pragma unroll 2
  for (int i = 0; i < 8; ++i) {
    const int idx = tid + 512 * i; const int tok = idx >> 7, k8 = idx & 127; const int m = t0 + tok;
    int l, L, cond, m0; tokinfo(m, l, L, cond, m0);
    const u32x4 hc = *(const u32x4*)(HB + (size_t)m * D + 8 * k8);
    u32x4 hp = (u32x4){0u, 0u, 0u, 0u}, hn = hp;
    if (l > 0) hp = *(const u32x4*)(HB + (size_t)(m - 1) * D + 8 * k8);
    if (l < L - 1) hn = *(const u32x4*)(HB + (size_t)(m + 1) * D + 8 * k8);
    float hh[8], d[8];
#pragma unroll
    for (int e = 0; e < 4; ++e) {
      hh[2 * e] = bf2f(hc[e] & 0xffffu); hh[2 * e + 1] = bf2f(hc[e] >> 16);
      d[2 * e] = 0.5f * (bf2f(hp[e] & 0xffffu) + bf2f(hn[e] & 0xffffu)) - hh[2 * e];
      d[2 * e + 1] = 0.5f * (bf2f(hp[e] >> 16) + bf2f(hn[e] >> 16)) - hh[2 * e + 1];
    }
#pragma unroll
    for (int q = 0; q < 2; ++q) {
      const int mi = q ? 4 : 1;
      const f32x4 u0 = *(const f32x4*)(p.rw_mu + mi * D + 8 * k8), u1 = *(const f32x4*)(p.rw_mu + mi * D + 8 * k8 + 4);
      u32x4 o; o.x = pk2_(hh[0] + d[0] * u0.x, hh[1] + d[1] * u0.y); o.y = pk2_(hh[2] + d[2] * u0.z, hh[3] + d[3] * u0.w);
      o.z = pk2_(hh[4] + d[4] * u1.x, hh[5] + d[5] * u1.y); o.w = pk2_(hh[6] + d[6] * u1.z, hh[7] + d[7] * u1.w);
      *(LAS u32x4*)(lds + q * 65536 + (k8 * 32 + tok) * 16) = o;
    }
  }
  __syncthreads();
  f32x16 acc;
#pragma unroll
  for (int i = 0; i < 16; ++i) acc[i] = 0.f;
  const int aoff = (wave >> 2) * 65536 + ((h * 32) + (lane & 31)) * 16;
  const bf16_t* wf = Wf + ((size_t)wave * 64 * 64 + lane) * 8;
#pragma unroll 4
  for (int ks = 0; ks < 64; ++ks) {
    const bf16x8 af = *(LAS const bf16x8*)(lds + aoff + ks * 1024);
    const bf16x8 b0 = *(const bf16x8*)(wf + ((size_t)ks * 64) * 8);
    acc = __builtin_amdgcn_mfma_f32_32x32x16_bf16(af, b0, acc, 0, 0, 0);
  }
  bf16_t* HWA = (bf16_t*)(ws + M_HWA);
#pragma unroll
  for (int i = 0; i < 16; ++i) {
    const int row = (i & 3) + 8 * (i >> 2) + 4 * h;
    const float v = (wave < 4) ? tanhf(acc[i]) : acc[i];
    HWA[(size_t)(t0 + row) * 256 + wave * 32 + (lane & 31)] = (bf16_t)f2bf_(v);
  }
}

#define DPP_ADD(v, CTRL) ((v) + __builtin_bit_cast(float, __builtin_amdgcn_mov_dpp(__builtin_bit_cast(int, (v)), (CTRL), 0xF, 0xF, true)))
__device__ __forceinline__ float allred4(float v) { v = DPP_ADD(v, 0xB1); v = DPP_ADD(v, 0x4E); return v; }
__device__ __forceinline__ float allred16(float v) { v = DPP_ADD(v, 0xB1); v = DPP_ADD(v, 0x4E); v = DPP_ADD(v, 0x141); v = DPP_ADD(v, 0x140); return v; }

__device__ __forceinline__ float fma_s(float a, float b, float c) { float d; asm("v_fma_f32 %0, %1, %2, %3" : "=v"(d) : "v"(a), "v"(b), "v"(c)); return d; }
__device__ __forceinline__ float mul_s(float a, float b) { float d; asm("v_mul_f32_e32 %0, %1, %2" : "=v"(d) : "v"(a), "v"(b)); return d; }
__device__ __forceinline__ float add_s(float a, float b) { float d; asm("v_add_f32_e32 %0, %1, %2" : "=v"(d) : "v"(a), "v"(b)); return d; }
#define DPPADD_(NAME, CTRL) __device__ __forceinline__ float NAME(float s) { float d; asm("s_nop 1\n\tv_add_f32_dpp %0, %1, %1 " CTRL " row_mask:0xf bank_mask:0xf bound_ctrl:1" : "=v"(d) : "v"(s)); return d; }
DPPADD_(dpp_x1, "quad_perm:[1,0,3,2]")
DPPADD_(dpp_x2, "quad_perm:[2,3,0,1]")
DPPADD_(dpp_hm, "row_half_mirror")
DPPADD_(dpp_rm, "row_mirror")
__device__ __forceinline__ float ar4(float v) { return dpp_x2(dpp_x1(v)); }
__device__ __forceinline__ float ar16(float v) { return dpp_rm(dpp_hm(dpp_x2(dpp_x1(v)))); }
__device__ __forceinline__ float dot4_s(const f32x4& s, const f32x4& a) { return add_s(fma_s(s.y, a.y, mul_s(s.x, a.x)), fma_s(s.w, a.w, mul_s(s.z, a.z))); }
__device__ __forceinline__ void upd4_s(f32x4& s, const f32x4& w, const f32x4& b, const f32x4& k, float sa, float vi) {
  s.x = fma_s(s.x, w.x, fma_s(sa, b.x, mul_s(vi, k.x))); s.y = fma_s(s.y, w.y, fma_s(sa, b.y, mul_s(vi, k.y)));
  s.z = fma_s(s.z, w.z, fma_s(sa, b.z, mul_s(vi, k.z))); s.w = fma_s(s.w, w.w, fma_s(sa, b.w, mul_s(vi, k.w)));
}
constexpr int PB_BYTES = 24832;
constexpr int SC_PS0 = 0, SC_PP0 = 2 * PB_BYTES;

constexpr int SC_FR = 4 * PB_BYTES;
__device__ __forceinline__ u32x4 ld_bfrag(const GASF* W2, int ks, int lane) {
  const int k0 = 32 * ks + 8 * (lane >> 4);
  u32x4 o; o.x = pk2_(W2[(size_t)(k0 + 0) * D], W2[(size_t)(k0 + 1) * D]); o.y = pk2_(W2[(size_t)(k0 + 2) * D], W2[(size_t)(k0 + 3) * D]);
  o.z = pk2_(W2[(size_t)(k0 + 4) * D], W2[(size_t)(k0 + 5) * D]); o.w = pk2_(W2[(size_t)(k0 + 6) * D], W2[(size_t)(k0 + 7) * D]);
  return o;
}
struct ChId { int dir, hd, m0, L, froff; };
__device__ __forceinline__ ChId chid(int slot, int seq, int dir, int hd, int lane, int ntile) {
  ChId c; c.dir = dir; c.hd = hd; c.L = seq < 16 ? 256 : 2048; c.m0 = seq < 16 ? seq * 256 : NPT + (seq - 16) * 2048;
  c.froff = SC_FR + ((slot * 4 + ntile) * 6) * 1024 + lane * 16; return c;
}
__device__ __forceinline__ void prepc_load(const LAS PG& p, LAS unsigned char* lds, int froff, int dir, int hd, int lane, int ntile) {
  const int ch = hd * 64 + 16 * ntile + (lane & 15);
  const GASF* W2 = p.rw_w2 + (size_t)dir * 64 * D + ch; const GASF* A2 = p.rw_a2 + (size_t)dir * 64 * D + ch;
  *(LAS u32x4*)(lds + froff) = ld_bfrag(W2, 0, lane); __builtin_amdgcn_sched_barrier(0);
  *(LAS u32x4*)(lds + froff + 1024) = ld_bfrag(W2, 1, lane); __builtin_amdgcn_sched_barrier(0);
  *(LAS u32x4*)(lds + froff + 2048) = ld_bfrag(A2, 0, lane); __builtin_amdgcn_sched_barrier(0);
  *(LAS u32x4*)(lds + froff + 3072) = ld_bfrag(A2, 1, lane); __builtin_amdgcn_sched_barrier(0);
  LAS float* cn = (LAS float*)(lds + (froff - lane * 16) + 4096) + lane;
  cn[0] = p.rw_w0[dir * D + ch]; cn[64] = p.rw_a0[dir * D + ch]; cn[128] = p.rw_k_k[ch]; cn[192] = p.rw_k_a[ch]; cn[256] = p.rw_r_k[ch];
}
struct PrepIn { u32x4 hw[2], ha[2]; unsigned kr[4], rr[4], vr[4]; };
__device__ __forceinline__ int ctok(int m0, int L, int dir, int step) { return m0 + (dir ? (L - 1 - step) : step); }
__device__ __forceinline__ void prep_fetch(const unsigned char* ws, int c_m0, int c_L, int c_dir, int c_hd, int s0, int lane, int ntile, PrepIn& in) {
  const bf16_t* HWA = (const bf16_t*)(ws + M_HWA);
  const int m = ctok(c_m0, c_L, c_dir, s0 + (lane & 15));
  const bf16_t* src = HWA + (size_t)m * 256 + c_dir * 64 + 8 * (lane >> 4);
  in.hw[0] = *(const u32x4*)(src); in.hw[1] = *(const u32x4*)(src + 32);
  in.ha[0] = *(const u32x4*)(src + 128); in.ha[1] = *(const u32x4*)(src + 160);
#pragma unroll
  for (int r = 0; r < 4; ++r) {
    const int mt = ctok(c_m0, c_L, c_dir, s0 + 4 * (lane >> 4) + r);
    const size_t gi = (size_t)mt * D + c_hd * 64 + 16 * ntile + (lane & 15);
    in.kr[r] = ((const bf16_t*)(ws + M_KB))[gi]; in.rr[r] = ((const bf16_t*)(ws + M_RB))[gi]; in.vr[r] = ((const bf16_t*)(ws + M_VB))[gi];
  }
}
__device__ __forceinline__ bf16x8 pack8(const f32x4& a, const f32x4& b) { u32x4 o; o.x = pk2_(a.x, a.y); o.y = pk2_(a.z, a.w); o.z = pk2_(b.x, b.y); o.w = pk2_(b.z, b.w); return __builtin_bit_cast(bf16x8, o); }
__device__ __forceinline__ void prep_finish(unsigned char* ws, LAS unsigned char* lds, int c_m0, int c_L, int c_dir, int c_hd, int c_froff, int s0, int pboff, int lane, int ntile, const PrepIn& in) {
  LAS const float* cn = (LAS const float*)(lds + (c_froff - lane * 16) + 4096) + lane;
  const float c_biasw = cn[0], c_biasa = cn[64], c_kkc = cn[128], c_kac = cn[192], c_rkc = cn[256];
  f32x4 aw = (f32x4){c_biasw, c_biasw, c_biasw, c_biasw}, aa = (f32x4){c_biasa, c_biasa, c_biasa, c_biasa};
  aw = __builtin_amdgcn_mfma_f32_16x16x32_bf16(__builtin_bit_cast(bf16x8, in.hw[0]), *(LAS const bf16x8*)(lds + c_froff), aw, 0, 0, 0);
  aw = __builtin_amdgcn_mfma_f32_16x16x32_bf16(__builtin_bit_cast(bf16x8, in.hw[1]), *(LAS const bf16x8*)(lds + c_froff + 1024), aw, 0, 0, 0);
  aa = __builtin_amdgcn_mfma_f32_16x16x32_bf16(__builtin_bit_cast(bf16x8, in.ha[0]), *(LAS const bf16x8*)(lds + c_froff + 2048), aa, 0, 0, 0);
  aa = __builtin_amdgcn_mfma_f32_16x16x32_bf16(__builtin_bit_cast(bf16x8, in.ha[1]), *(LAS const bf16x8*)(lds + c_froff + 3072), aa, 0, 0, 0);
  LAS float* pb = (LAS float*)(lds + pboff);
  const int col = lane & 15, rg = lane >> 4, chl = 16 * ntile + col;
#pragma unroll
  for (int r = 0; r < 4; ++r) {
    const int t = 4 * rg + r;
    const float sig = __builtin_amdgcn_rcpf(1.f + __expf(-aw[r]));
    const float dec = __expf(-0.6065306597126334f * sig);
    const float a = __builtin_amdgcn_rcpf(1.f + __expf(-aa[r]));
    const float k = bf2f(in.kr[r]), rv = bf2f(in.rr[r]), v = bf2f(in.vr[r]);
    const float kq = k * c_kkc;
    const float ssq = ar16(kq * kq);
    const float kd = k * (1.f + (a - 1.f) * c_kac);
    const float bon = ar16(rv * kd * c_rkc);
    pb[t * 64 + chl] = dec; pb[1024 + t * 64 + chl] = -kq; pb[2048 + t * 64 + chl] = kq * a; pb[3072 + t * 64 + chl] = kd; pb[4096 + t * 64 + chl] = rv; pb[5120 + t * 64 + chl] = v;
    if (col == 0) {
      pb[6144 + t * 4 + ntile] = ssq;
      const int mt = ctok(c_m0, c_L, c_dir, s0 + t);
      ((float*)(ws + M_BON))[(((size_t)c_dir * NTOK + mt) * 16 + c_hd) * 4 + ntile] = bon;
    }
  }
}

#define LDS_BARRIER() asm volatile("s_waitcnt lgkmcnt(0)\n\ts_barrier" ::: "memory")
__device__ __forceinline__ void phase_rw_scan(const LAS PG& p, unsigned char* ws, LAS unsigned char* lds, int tid, int lane, int wave, int bid, int G) {
  for (int item = bid; item < 256; item += G) {
    const int sc = item >> 2, qt = item & 3;
    const int s_seq = 16 + (sc >> 5), s_dir = (sc >> 4) & 1, s_hd = sc & 15, s_m0 = NPT + (s_seq - 16) * 2048;
    __syncthreads();
    if (wave < 4) {
      __builtin_amdgcn_s_setprio(2);
      float* Yo = (float*)(ws + (s_dir ? M_YB : M_YF));
      const int srow = 16 * qt + 4 * wave + (lane >> 4), scg = lane & 15;
      f32x4 Ss = *(const GAS f32x4*)(p.state_rwkv + ((((size_t)(s_seq - 16)) * 2 + s_dir) * 16 + s_hd) * 4096 + (size_t)srow * 64 + 4 * scg);
      __syncthreads();
      for (int c = 0; c < 128; ++c) {
        LAS const float* ps = (LAS const float*)(lds + SC_PS0 + (c & 1) * PB_BYTES);
        float rn2v;
        { const f32x4 q4 = *(LAS const f32x4*)(ps + 6144 + (lane & 15) * 4); rn2v = __builtin_amdgcn_rcpf((q4.x + q4.y) + (q4.z + q4.w) + 1e-12f); }
        float yk[16];
#pragma unroll
        for (int t = 0; t < 16; ++t) {
          const f32x4 w4 = *(LAS const f32x4*)(ps + t * 64 + 4 * scg), a4 = *(LAS const f32x4*)(ps + 1024 + t * 64 + 4 * scg);
          const f32x4 b4 = *(LAS const f32x4*)(ps + 2048 + t * 64 + 4 * scg), k4 = *(LAS const f32x4*)(ps + 3072 + t * 64 + 4 * scg);
          const f32x4 r4 = *(LAS const f32x4*)(ps + 4096 + t * 64 + 4 * scg);
          const float vi = ps[5120 + t * 64 + srow];
          const float rn2 = __builtin_bit_cast(float, __builtin_amdgcn_readlane(__builtin_bit_cast(int, rn2v), t));
          const float sa = ar16(dot4_s(Ss, a4)) * rn2;
          upd4_s(Ss, w4, b4, k4, sa, vi);
          yk[t] = ar16(dot4_s(Ss, r4));
        }
        if (scg == 0) {
          const int mfirst = ctok(s_m0, 2048, s_dir, 16 * c);
          float* yp = Yo + (size_t)mfirst * D + s_hd * 64 + srow;
          const long stride = s_dir ? -(long)D : (long)D;
#pragma unroll
          for (int t = 0; t < 16; ++t) yp[t * stride] = yk[t];
        }
        LDS_BARRIER();
      }
      __builtin_amdgcn_s_setprio(0);
    } else {
      const int nt = wave - 4;
      const int s_fr = SC_FR + ((0 * 4 + nt) * 6) * 1024 + lane * 16;
      prepc_load(p, lds, s_fr, s_dir, s_hd, lane, nt);
      int pc = 2 * item;
      const int q_fr = SC_FR + ((1 * 4 + nt) * 6) * 1024 + lane * 16;
      prepc_load(p, lds, q_fr, (pc >> 4) & 1, pc & 15, lane, nt);
      int r_seq = pc >> 5, r_dir = (pc >> 4) & 1, r_hd = pc & 15;
      int q_seq = pc >> 5, q_dir = (pc >> 4) & 1, q_hd = pc & 15;
      PrepIn in_s, in_p;
      prep_fetch(ws, s_m0, 2048, s_dir, s_hd, 0, lane, nt, in_s); prep_fetch(ws, r_seq * 256, 256, r_dir, r_hd, 0, lane, nt, in_p);
      prep_finish(ws, lds, s_m0, 2048, s_dir, s_hd, s_fr, 0, SC_PS0, lane, nt, in_s); prep_finish(ws, lds, r_seq * 256, 256, r_dir, r_hd, q_fr, 0, SC_PP0, lane, nt, in_p);
      const int prow = 16 * nt + (lane >> 2), pcq = lane & 3;
      f32x4 Sp0 = (f32x4){0.f, 0.f, 0.f, 0.f}, Sp1 = Sp0, Sp2 = Sp0, Sp3 = Sp0;
      __syncthreads();
      for (int c = 0; c < 128; ++c) {
        const bool more_s = (c + 1) < 128;
        const bool pgrp = ((c & 3) == 0) && (c + 4 < 128);
        if (more_s) prep_fetch(ws, s_m0, 2048, s_dir, s_hd, 16 * (c + 1), lane, nt, in_s);
        if (pgrp) {
          if (c == 60) { pc = 2 * item + 1; r_seq = pc >> 5; r_dir = (pc >> 4) & 1; r_hd = pc & 15; prepc_load(p, lds, q_fr, r_dir, r_hd, lane, nt); }
          prep_fetch(ws, r_seq * 256, 256, r_dir, r_hd, 4 * ((c + 4) & 63), lane, nt, in_p);
        }
        if (c == 64) { q_seq = r_seq; q_dir = r_dir; q_hd = r_hd; Sp0 = (f32x4){0.f, 0.f, 0.f, 0.f}; Sp1 = Sp0; Sp2 = Sp0; Sp3 = Sp0; }
        {
          LAS const float* pp = (LAS const float*)(lds + SC_PP0 + ((c >> 2) & 1) * PB_BYTES);
          float* Yp = (float*)(ws + (q_dir ? M_YB : M_YF));
          float rn2v;
          { const f32x4 q4 = *(LAS const f32x4*)(pp + 6144 + (lane & 15) * 4); rn2v = __builtin_amdgcn_rcpf((q4.x + q4.y) + (q4.z + q4.w) + 1e-12f); }
#pragma unroll 2
          for (int s = 0; s < 4; ++s) {
            const int t = 4 * (c & 3) + s;
            const float vi = pp[5120 + t * 64 + prow];
            const float rn2 = __builtin_bit_cast(float, __builtin_amdgcn_readlane(__builtin_bit_cast(int, rn2v), t));
            LAS const float* q = pp + t * 64 + 16 * pcq;
            const f32x4 a0 = *(LAS const f32x4*)(q + 1024), a1 = *(LAS const f32x4*)(q + 1028), a2 = *(LAS const f32x4*)(q + 1032), a3 = *(LAS const f32x4*)(q + 1036);
            const float sa = ar4(add_s(add_s(dot4_s(Sp0, a0), dot4_s(Sp1, a1)), add_s(dot4_s(Sp2, a2), dot4_s(Sp3, a3)))) * rn2;
            float y0, y1, y2, y3;
#define UP4(S_, O_, Y_) { const f32x4 w4 = *(LAS const f32x4*)(q + (O_)), b4 = *(LAS const f32x4*)(q + 2048 + (O_)), k4 = *(LAS const f32x4*)(q + 3072 + (O_)), r4 = *(LAS const f32x4*)(q + 4096 + (O_)); \
              upd4_s(S_, w4, b4, k4, sa, vi); Y_ = dot4_s(S_, r4); }
            UP4(Sp0, 0, y0) UP4(Sp1, 4, y1) UP4(Sp2, 8, y2) UP4(Sp3, 12, y3)
#undef UP4
            const float y = ar4(add_s(add_s(y0, y1), add_s(y2, y3)));
            if (pcq == 0) Yp[(size_t)ctok(q_seq * 256, 256, q_dir, 4 * (c & 63) + s) * D + q_hd * 64 + prow] = y;
          }
          if ((c & 63) == 63) {
            GASF* so = p.out + OUT_ST + ((((size_t)q_seq) * 2 + q_dir) * 16 + q_hd) * 4096 + (size_t)prow * 64 + 16 * pcq;
            *(GAS f32x4*)so = Sp0; *(GAS f32x4*)(so + 4) = Sp1; *(GAS f32x4*)(so + 8) = Sp2; *(GAS f32x4*)(so + 12) = Sp3;
          }
        }
        if (more_s) prep_finish(ws, lds, s_m0, 2048, s_dir, s_hd, s_fr, 16 * (c + 1), SC_PS0 + ((c + 1) & 1) * PB_BYTES, lane, nt, in_s);
        if (pgrp) prep_finish(ws, lds, r_seq * 256, 256, r_dir, r_hd, q_fr, 4 * ((c + 4) & 63), SC_PP0 + (((c >> 2) + 1) & 1) * PB_BYTES, lane, nt, in_p);
        LDS_BARRIER();
      }
    }
  }
}
constexpr int CK_OPS = 20992;
constexpr int CK_MX = 3 * CK_OPS;
constexpr int CK_SCR = CK_MX + 2 * 8192;
constexpr int CK_SSQ = CK_SCR + 6144;
constexpr int CK_FR = CK_SSQ + 1024;

__device__ __forceinline__ unsigned short bfr(float f) { return (unsigned short)f2bf_(f); }
__device__ __forceinline__ bf16x8 cvt8(const f32x16& a, int s) {
  u32x4 o; o.x = pk2_(a[8 * s + 0], a[8 * s + 1]); o.y = pk2_(a[8 * s + 2], a[8 * s + 3]); o.z = pk2_(a[8 * s + 4], a[8 * s + 5]); o.w = pk2_(a[8 * s + 6], a[8 * s + 7]);
  return __builtin_bit_cast(bf16x8, o);
}
__device__ __forceinline__ bf16x8 ldA_perm(LAS const unsigned char* base, int ld, int row, int k0, int hi) {
  const u32x2 lo = *(LAS const u32x2*)(base + (row * ld + k0 + 4 * hi) * 2), hh = *(LAS const u32x2*)(base + (row * ld + k0 + 8 + 4 * hi) * 2);
  u32x4 o; o.x = lo.x; o.y = lo.y; o.z = hh.x; o.w = hh.y; return __builtin_bit_cast(bf16x8, o);
}
__device__ __forceinline__ bf16x8 ldT_perm(LAS const unsigned char* base, int ld, int k0, int c0, int lane) {
  const int hi = lane >> 5;
  LAS const unsigned char* a = base + ((k0 + 4 * hi + ((lane & 15) >> 2)) * ld + c0 + 16 * ((lane >> 4) & 1) + 4 * (lane & 3)) * 2;
  const v4i16_t lo = vtr(a), hh = vtr(a + 8 * ld * 2);
  return (bf16x8){lo[0], lo[1], lo[2], lo[3], hh[0], hh[1], hh[2], hh[3]};
}
#define MFMA32(A_, B_, C_) __builtin_amdgcn_mfma_f32_32x32x16_bf16((A_), (B_), (C_), 0, 0, 0)

struct CkChain { int seq, dir, hd, m0, L, nch; };
__device__ __forceinline__ CkChain ck_chain(int id) {
  CkChain c;
  if (id < 64) { c.seq = 16 + (id >> 5); c.dir = (id >> 4) & 1; c.hd = id & 15; c.L = 2048; c.m0 = NPT + (c.seq - 16) * 2048; }
  else { const int p = id - 64; c.seq = p >> 5; c.dir = (p >> 4) & 1; c.hd = p & 15; c.L = 256; c.m0 = c.seq * 256; }
  c.nch = c.L / 32; return c;
}

__device__ __forceinline__ void ck_run_chain(const LAS PG& p, unsigned char* ws, LAS unsigned char* lds, const CkChain ch, int lane, int wave) {
  const int hi = lane >> 5, r32 = lane & 31;
  float* Yo = (float*)(ws + (ch.dir ? M_YB : M_YF));
  const int NK = ch.nch + 3;
  if (wave >= 4) {
    float rw_dec[8], rw_al[8], rw_kq[8], rw_kd[8], rw_r[8], rw_v[8];
    u32x4 pf_hw[4], pf_ha[4]; unsigned pf_k[8], pf_r[8], pf_v[8];
    const int nt = wave - 4, col = lane & 15, g = lane >> 4;
    const int froff = CK_FR + nt * 6144 + lane * 16;
#pragma unroll
    for (int i = 0; i < 8; ++i) { rw_dec[i] = 1.f; rw_al[i] = 0.f; rw_kq[i] = 0.f; rw_kd[i] = 0.f; rw_r[i] = 0.f; rw_v[i] = 0.f; }
#define CK_FETCH(KC) do { const int s0_ = 32 * (KC); \
    _Pragma("unroll") for (int mt = 0; mt < 2; ++mt) { \
      const unsigned m_ = (unsigned)ctok(ch.m0, ch.L, ch.dir, s0_ + 16 * mt + col); \
      const unsigned so_ = m_ * 256u + (unsigned)(ch.dir * 64 + 8 * g); \
      const bf16_t* hwa_ = (const bf16_t*)(ws + M_HWA); \
      pf_hw[2 * mt] = *(const u32x4*)(hwa_ + so_); pf_hw[2 * mt + 1] = *(const u32x4*)(hwa_ + (so_ + 32u)); \
      pf_ha[2 * mt] = *(const u32x4*)(hwa_ + (so_ + 128u)); pf_ha[2 * mt + 1] = *(const u32x4*)(hwa_ + (so_ + 160u)); \
      const int tk0_ = ctok(ch.m0, ch.L, ch.dir, s0_ + 16 * mt + 4 * g); const int dstep_ = ch.dir ? -1 : 1; \
      _Pragma("unroll") for (int r = 0; r < 4; ++r) { \
        const unsigned gi_ = (unsigned)(tk0_ + r * dstep_) * (unsigned)D + (unsigned)(ch.hd * 64 + 16 * nt + col); \
        pf_k[4 * mt + r] = ((const bf16_t*)(ws + M_KB))[gi_]; pf_r[4 * mt + r] = ((const bf16_t*)(ws + M_RB))[gi_]; pf_v[4 * mt + r] = ((const bf16_t*)(ws + M_VB))[gi_]; } } } while (0)
    prepc_load(p, lds, froff, ch.dir, ch.hd, lane, nt);
    CK_FETCH(0);
    LDS_BARRIER();
    for (int k = 0; k < NK; ++k) {
      LAS const float* cn = (LAS const float*)(lds + (froff - lane * 16) + 4096) + lane;
      if (k >= 1 && k <= ch.nch) {
        LAS unsigned char* ob = lds + ((k - 1) % 3) * CK_OPS;
        LAS const float* sq = (LAS const float*)(lds + CK_SSQ + ((k - 1) & 1) * 512);
        float cp[8];
        cp[0] = rw_dec[0]; cp[1] = cp[0] * rw_dec[1]; cp[2] = cp[1] * rw_dec[2]; cp[3] = cp[2] * rw_dec[3];
        cp[4] = rw_dec[4]; cp[5] = cp[4] * rw_dec[5]; cp[6] = cp[5] * rw_dec[6]; cp[7] = cp[6] * rw_dec[7];
        float E0, E1;
        {
          float t0 = cp[3], t1 = cp[7];
          float x0 = __shfl(t0, (lane + 48) & 63), x1 = __shfl(t1, (lane + 48) & 63); if (g < 1) { x0 = 1.f; x1 = 1.f; }
          float i0 = t0 * x0, i1 = t1 * x1;
          float y0 = __shfl(i0, (lane + 32) & 63), y1 = __shfl(i1, (lane + 32) & 63); if (g < 2) { y0 = 1.f; y1 = 1.f; }
          i0 *= y0; i1 *= y1;
          float e0 = __shfl(i0, (lane + 48) & 63), e1 = __shfl(i1, (lane + 48) & 63); if (g < 1) { e0 = 1.f; e1 = 1.f; }
          const float T0 = __shfl(i0, col + 48);
          E0 = e0; E1 = T0 * e1;
        }
#pragma unroll
        for (int e = 0; e < 8; ++e) {
          const int mt = e >> 2, r = e & 3, t = 16 * mt + 4 * g + r;
          const f32x4 q4 = *(LAS const f32x4*)(sq + t * 4);
          const float rn = rsqrtf((q4.x + q4.y) + (q4.z + q4.w) + 1e-12f);
          const float Eb = mt ? E1 : E0;
          const float Wt = Eb * cp[e], Wp = (r == 0) ? Eb : Eb * cp[e - 1];
          const float iw = __builtin_amdgcn_rcpf(Wt);
          const float kqn = rw_kq[e] * rn;
          LAS unsigned short* o16 = (LAS unsigned short*)ob + t * 64 + 16 * nt + col;
          o16[0] = bfr(-Wp * kqn);
          o16[2048] = bfr(kqn * rw_al[e] * iw);
          o16[4096] = bfr(rw_kd[e] * iw);
          o16[6144] = bfr(Wt * rw_r[e]);
          o16[8192] = bfr(rw_v[e]);
          if (t == 31) ((LAS float*)(ob + 20480))[16 * nt + col] = Wt;
        }
      }
      if (k < ch.nch) {
        const float c_biasw = cn[0], c_biasa = cn[64], c_kkc = cn[128], c_kac = cn[192], c_rkc = cn[256];
        LAS float* sq = (LAS float*)(lds + CK_SSQ + (k & 1) * 512);
#pragma unroll
        for (int mt = 0; mt < 2; ++mt) {
          f32x4 aw = (f32x4){c_biasw, c_biasw, c_biasw, c_biasw}, aa = (f32x4){c_biasa, c_biasa, c_biasa, c_biasa};
          aw = __builtin_amdgcn_mfma_f32_16x16x32_bf16(__builtin_bit_cast(bf16x8, pf_hw[2 * mt]), *(LAS const bf16x8*)(lds + froff), aw, 0, 0, 0);
          aw = __builtin_amdgcn_mfma_f32_16x16x32_bf16(__builtin_bit_cast(bf16x8, pf_hw[2 * mt + 1]), *(LAS const bf16x8*)(lds + froff + 1024), aw, 0, 0, 0);
          aa = __builtin_amdgcn_mfma_f32_16x16x32_bf16(__builtin_bit_cast(bf16x8, pf_ha[2 * mt]), *(LAS const bf16x8*)(lds + froff + 2048), aa, 0, 0, 0);
          aa = __builtin_amdgcn_mfma_f32_16x16x32_bf16(__builtin_bit_cast(bf16x8, pf_ha[2 * mt + 1]), *(LAS const bf16x8*)(lds + froff + 3072), aa, 0, 0, 0);
          float sq4[4], bn4[4];
#pragma unroll
          for (int r = 0; r < 4; ++r) {
            const int e = 4 * mt + r;
            const float sig = __builtin_amdgcn_rcpf(1.f + __expf(-aw[r]));
            rw_dec[e] = __expf(-0.6065306597126334f * sig);
            const float a = __builtin_amdgcn_rcpf(1.f + __expf(-aa[r]));
            rw_al[e] = a;
            const float kv = bf2f(pf_k[e]), rv = bf2f(pf_r[e]);
            rw_r[e] = rv; rw_v[e] = bf2f(pf_v[e]);
            const float kq = kv * c_kkc; rw_kq[e] = kq;
            const float kd = kv * (1.f + (a - 1.f) * c_kac); rw_kd[e] = kd;
            sq4[r] = kq * kq; bn4[r] = rv * kd * c_rkc;
          }
#define CK_DPP(v, CTRL) __builtin_bit_cast(float, __builtin_amdgcn_update_dpp(0, __builtin_bit_cast(int, (v)), (CTRL), 0xF, 0xF, true))
#pragma unroll
          for (int r = 0; r < 4; ++r) { sq4[r] += CK_DPP(sq4[r], 0xB1); bn4[r] += CK_DPP(bn4[r], 0xB1); }
#pragma unroll
          for (int r = 0; r < 4; ++r) { sq4[r] += CK_DPP(sq4[r], 0x4E); bn4[r] += CK_DPP(bn4[r], 0x4E); }
#pragma unroll
          for (int r = 0; r < 4; ++r) { sq4[r] += CK_DPP(sq4[r], 0x141); bn4[r] += CK_DPP(bn4[r], 0x141); }
#pragma unroll
          for (int r = 0; r < 4; ++r) { sq4[r] += CK_DPP(sq4[r], 0x140); bn4[r] += CK_DPP(bn4[r], 0x140); }
#undef CK_DPP
          if (col == 0) {
            float* bo = (float*)(ws + M_BON);
#pragma unroll
            for (int r = 0; r < 4; ++r) {
              const int t = 16 * mt + 4 * g + r;
              sq[t * 4 + nt] = sq4[r];
              const unsigned mtk = (unsigned)ctok(ch.m0, ch.L, ch.dir, 32 * k + t);
              bo[(((unsigned)ch.dir * NTOK + mtk) * 16u + (unsigned)ch.hd) * 4u + (unsigned)nt] = bn4[r];
            }
          }
        }
        if (k + 1 < ch.nch) CK_FETCH(k + 1);
      }
      LDS_BARRIER();
    }
#undef CK_FETCH
  } else if (wave >= 2) {
    LDS_BARRIER();
    for (int k = 0; k < NK; ++k) {
      if (k >= 2 && k <= ch.nch + 1) {
        LAS const unsigned char* ob = lds + ((k - 2) % 3) * CK_OPS;
        LAS unsigned char* mx = lds + CK_MX + ((k - 2) & 1) * 8192;
#define CK_PROD(ACC, AOFF, BOFF) do { _Pragma("unroll") for (int i_ = 0; i_ < 16; ++i_) ACC[i_] = 0.f; \
          _Pragma("unroll") for (int ks = 0; ks < 4; ++ks) { \
            const bf16x8 af_ = *(LAS const bf16x8*)(ob + (AOFF) + (r32 * 64 + 16 * ks + 8 * hi) * 2), bf_ = *(LAS const bf16x8*)(ob + (BOFF) + (r32 * 64 + 16 * ks + 8 * hi) * 2); \
            ACC = MFMA32(af_, bf_, ACC); } } while (0)
#define CK_STORE_T(ACC, DST, STRICT) do { _Pragma("unroll") for (int q_ = 0; q_ < 4; ++q_) { \
            float v_[4]; _Pragma("unroll") for (int x_ = 0; x_ < 4; ++x_) { const int s_ = 8 * q_ + 4 * hi + x_; const bool keep_ = (STRICT) ? (s_ < r32) : (s_ <= r32); v_[x_] = keep_ ? ACC[4 * q_ + x_] : 0.f; ACC[4 * q_ + x_] = v_[x_]; } \
            u32x2 w_; w_.x = pk2_(v_[0], v_[1]); w_.y = pk2_(v_[2], v_[3]); *(LAS u32x2*)((DST) + (r32 * 32 + 8 * q_ + 4 * hi) * 2) = w_; } } while (0)
        f32x16 acc;
        if (wave == 3) {
          CK_PROD(acc, 8192, 0);     CK_STORE_T(acc, mx + 0, true);
          CK_PROD(acc, 4096, 12288); CK_STORE_T(acc, mx + 2048, false);
          CK_PROD(acc, 8192, 12288); CK_STORE_T(acc, mx + 4096, false);
        } else {
          LAS unsigned char* sc = lds + CK_SCR;
          f32x16 Q, Pm;
          CK_PROD(Q, 4096, 0);
          CK_STORE_T(Q, sc + 2048, true);
#define CK_STORE_R(ACC, DST) do { _Pragma("unroll") for (int i_ = 0; i_ < 16; ++i_) ((LAS unsigned short*)(DST))[crow_(i_, hi) * 32 + r32] = bfr(ACC[i_]); } while (0)
          CK_STORE_R(Q, sc + 0);
#pragma unroll
          for (int i = 0; i < 16; ++i) Pm[i] = Q[i] + ((crow_(i, hi) == r32) ? 1.f : 0.f);
          CK_STORE_R(Pm, sc + 4096);
          asm volatile("s_waitcnt lgkmcnt(0)" ::: "memory");
#define CK_MM(ACC, AOFF, BTOFF) do { _Pragma("unroll") for (int ks = 0; ks < 2; ++ks) { \
            const bf16x8 af_ = *(LAS const bf16x8*)(sc + (AOFF) + (r32 * 32 + 16 * ks + 8 * hi) * 2), bf_ = *(LAS const bf16x8*)(sc + (BTOFF) + (r32 * 32 + 16 * ks + 8 * hi) * 2); \
            ACC = MFMA32(af_, bf_, ACC); } } while (0)
#pragma unroll 1
          for (int it = 0; it < 4; ++it) {
            f32x16 Q2;
#pragma unroll
            for (int i = 0; i < 16; ++i) Q2[i] = 0.f;
            CK_MM(Q2, 0, 2048);
            asm volatile("s_waitcnt lgkmcnt(0)" ::: "memory");
            CK_STORE_R(Q2, sc + 0);
#pragma unroll
            for (int q = 0; q < 4; ++q) { u32x2 w; w.x = pk2_(Q2[4 * q], Q2[4 * q + 1]); w.y = pk2_(Q2[4 * q + 2], Q2[4 * q + 3]); *(LAS u32x2*)(sc + 2048 + (r32 * 32 + 8 * q + 4 * hi) * 2) = w; }
            asm volatile("s_waitcnt lgkmcnt(0)" ::: "memory");
            CK_MM(Pm, 4096, 2048);
            asm volatile("s_waitcnt lgkmcnt(0)" ::: "memory");
            if (it < 3) { CK_STORE_R(Pm, sc + 4096); asm volatile("s_waitcnt lgkmcnt(0)" ::: "memory"); }
          }
#pragma unroll
          for (int q = 0; q < 4; ++q) { u32x2 w; w.x = pk2_(Pm[4 * q], Pm[4 * q + 1]); w.y = pk2_(Pm[4 * q + 2], Pm[4 * q + 3]); *(LAS u32x2*)(mx + 6144 + (r32 * 32 + 8 * q + 4 * hi) * 2) = w; }
        }
      }
      LDS_BARRIER();
    }
  } else {
    f32x16 St0, St1;
#pragma unroll
    for (int i = 0; i < 16; ++i) { St0[i] = 0.f; St1[i] = 0.f; }
    if (ch.L == 2048) {
      const GASF* s0 = p.state_rwkv + ((((size_t)(ch.seq - 16)) * 2 + ch.dir) * 16 + ch.hd) * 4096 + (size_t)(32 * wave + r32) * 64;
#pragma unroll
      for (int q = 0; q < 4; ++q) {
        const f32x4 a = *(const GAS f32x4*)(s0 + 8 * q + 4 * hi), b = *(const GAS f32x4*)(s0 + 32 + 8 * q + 4 * hi);
        St0[4 * q] = a.x; St0[4 * q + 1] = a.y; St0[4 * q + 2] = a.z; St0[4 * q + 3] = a.w;
        St1[4 * q] = b.x; St1[4 * q + 1] = b.y; St1[4 * q + 2] = b.z; St1[4 * q + 3] = b.w;
      }
    }
    LDS_BARRIER();
    for (int k = 0; k < NK; ++k) {
      if (k >= 3) {
        const int kc = k - 3, ih = wave;
        LAS const unsigned char* ob = lds + (kc % 3) * CK_OPS;
        LAS const unsigned char* mx = lds + CK_MX + (kc & 1) * 8192;
        const bf16x8 s00 = cvt8(St0, 0), s01 = cvt8(St0, 1), s10 = cvt8(St1, 0), s11 = cvt8(St1, 1);
        const bf16x8 v0 = ldT_perm(ob + 16384, 64, 0, 32 * ih, lane), v1 = ldT_perm(ob + 16384, 64, 16, 32 * ih, lane);
        f32x16 G, U, Y;
#pragma unroll
        for (int i = 0; i < 16; ++i) { G[i] = 0.f; U[i] = 0.f; Y[i] = 0.f; }
        G = MFMA32(ldA_perm(ob + 0, 64, r32, 0, hi), s00, G);  G = MFMA32(ldA_perm(ob + 0, 64, r32, 16, hi), s01, G);
        G = MFMA32(ldA_perm(ob + 0, 64, r32, 32, hi), s10, G); G = MFMA32(ldA_perm(ob + 0, 64, r32, 48, hi), s11, G);
        G = MFMA32(ldA_perm(mx + 0, 32, r32, 0, hi), v0, G);   G = MFMA32(ldA_perm(mx + 0, 32, r32, 16, hi), v1, G);
        const bf16x8 g0 = cvt8(G, 0), g1 = cvt8(G, 1);
        U = MFMA32(ldA_perm(mx + 6144, 32, r32, 0, hi), g0, U); U = MFMA32(ldA_perm(mx + 6144, 32, r32, 16, hi), g1, U);
        const bf16x8 u0 = cvt8(U, 0), u1 = cvt8(U, 1);
        Y = MFMA32(ldA_perm(ob + 12288, 64, r32, 0, hi), s00, Y);  Y = MFMA32(ldA_perm(ob + 12288, 64, r32, 16, hi), s01, Y);
        Y = MFMA32(ldA_perm(ob + 12288, 64, r32, 32, hi), s10, Y); Y = MFMA32(ldA_perm(ob + 12288, 64, r32, 48, hi), s11, Y);
        Y = MFMA32(ldA_perm(mx + 2048, 32, r32, 0, hi), u0, Y);    Y = MFMA32(ldA_perm(mx + 2048, 32, r32, 16, hi), u1, Y);
        Y = MFMA32(ldA_perm(mx + 4096, 32, r32, 0, hi), v0, Y);    Y = MFMA32(ldA_perm(mx + 4096, 32, r32, 16, hi), v1, Y);
        St0 = MFMA32(ldT_perm(ob + 4096, 64, 0, 0, lane), u0, St0);  St0 = MFMA32(ldT_perm(ob + 4096, 64, 16, 0, lane), u1, St0);
        St0 = MFMA32(ldT_perm(ob + 8192, 64, 0, 0, lane), v0, St0);  St0 = MFMA32(ldT_perm(ob + 8192, 64, 16, 0, lane), v1, St0);
        St1 = MFMA32(ldT_perm(ob + 4096, 64, 0, 32, lane), u0, St1); St1 = MFMA32(ldT_perm(ob + 4096, 64, 16, 32, lane), u1, St1);
        St1 = MFMA32(ldT_perm(ob + 8192, 64, 0, 32, lane), v0, St1); St1 = MFMA32(ldT_perm(ob + 8192, 64, 16, 32, lane), v1, St1);
        LAS const float* wt = (LAS const float*)(ob + 20480);
#pragma unroll
        for (int q = 0; q < 4; ++q) {
          const f32x4 w0 = *(LAS const f32x4*)(wt + 8 * q + 4 * hi), w1 = *(LAS const f32x4*)(wt + 32 + 8 * q + 4 * hi);
          St0[4 * q] *= w0.x; St0[4 * q + 1] *= w0.y; St0[4 * q + 2] *= w0.z; St0[4 * q + 3] *= w0.w;
          St1[4 * q] *= w1.x; St1[4 * q + 1] *= w1.y; St1[4 * q + 2] *= w1.z; St1[4 * q + 3] *= w1.w;
        }
        {
          const int tk0 = ctok(ch.m0, ch.L, ch.dir, 32 * kc); const int dstep = ch.dir ? -1 : 1;
          const unsigned cb = (unsigned)(ch.hd * 64 + 32 * ih + r32);
#pragma unroll
          for (int i = 0; i < 16; ++i) Yo[(unsigned)(tk0 + crow_(i, hi) * dstep) * (unsigned)D + cb] = Y[i];
        }
      }
      LDS_BARRIER();
    }
    if (ch.L == 256) {
    GASF* so = p.out + OUT_ST + ((((size_t)ch.seq) * 2 + ch.dir) * 16 + ch.hd) * 4096 + (size_t)(32 * wave + r32) * 64;
#pragma unroll
    for (int q = 0; q < 4; ++q) {
      *(GAS f32x4*)(so + 8 * q + 4 * hi) = (f32x4){St0[4 * q], St0[4 * q + 1], St0[4 * q + 2], St0[4 * q + 3]};
      *(GAS f32x4*)(so + 32 + 8 * q + 4 * hi) = (f32x4){St1[4 * q], St1[4 * q + 1], St1[4 * q + 2], St1[4 * q + 3]};
    }
  }
  }
}

__device__ __forceinline__ void phase_rw_scan_ck(const LAS PG& p, unsigned char* ws, LAS unsigned char* lds, int tid, int lane, int wave, int bid, int G) {
  if (G >= 128) {
    if (bid < 64) { __syncthreads(); ck_run_chain(p, ws, lds, ck_chain(bid), lane, wave); }
    else { const int nb = G - 64; for (int pc = bid - 64; pc < 512; pc += nb) { __syncthreads(); ck_run_chain(p, ws, lds, ck_chain(64 + pc), lane, wave); } }
  } else {
    for (int id = bid; id < 576; id += G) { __syncthreads(); ck_run_chain(p, ws, lds, ck_chain(id), lane, wave); }
  }
}
__device__ __forceinline__ int opq(int x) { asm volatile("" : "+v"(x)); return x; }
#ifndef RPT_MASK
#define RPT_MASK 0u
#endif
struct MArgs { P p; int ph_lo, ph_hi; };
__global__ void __launch_bounds__(512, 2) mega(MArgs a) {
  extern __shared__ __attribute__((aligned(16))) unsigned char lds_raw[];
  LAS unsigned char* lds = (LAS unsigned char*)lds_raw;
  const int tid = threadIdx.x, lane = tid & 63, wave = __builtin_amdgcn_readfirstlane(tid >> 6);
  const int G = gridDim.x, bid = blockIdx.x;
  unsigned char* ws = (unsigned char*)a.p.ws;
  if (tid == 0) {
    LAS PG* t = (LAS PG*)(lds + PTAB_OFF);
    t->x_prompt = (decltype(t->x_prompt))a.p.x_prompt;
    t->x_sample = (decltype(t->x_sample))a.p.x_sample;
    t->cache_ckv = (decltype(t->cache_ckv))a.p.cache_ckv;
    t->cache_kpe = (decltype(t->cache_kpe))a.p.cache_kpe;
    t->state_rwkv = (decltype(t->state_rwkv))a.p.state_rwkv;
    t->c = (decltype(t->c))a.p.c;
    t->c_ctx = (decltype(t->c_ctx))a.p.c_ctx;
    t->mod_w = (decltype(t->mod_w))a.p.mod_w;
    t->mod_b = (decltype(t->mod_b))a.p.mod_b;
    t->ln_g = (decltype(t->ln_g))a.p.ln_g;
    t->ln_b = (decltype(t->ln_b))a.p.ln_b;
    t->hy_w_in = (decltype(t->hy_w_in))a.p.hy_w_in;
    t->hy_conv_w = (decltype(t->hy_conv_w))a.p.hy_conv_w;
    t->hy_conv_b = (decltype(t->hy_conv_b))a.p.hy_conv_b;
    t->hy_w1 = (decltype(t->hy_w1))a.p.hy_w1;
    t->hy_b1 = (decltype(t->hy_b1))a.p.hy_b1;
    t->hy_w2 = (decltype(t->hy_w2))a.p.hy_w2;
    t->hy_b2 = (decltype(t->hy_b2))a.p.hy_b2;
    t->hy_w3 = (decltype(t->hy_w3))a.p.hy_w3;
    t->hy_b3 = (decltype(t->hy_b3))a.p.hy_b3;
    t->hy_freq = (decltype(t->hy_freq))a.p.hy_freq;
    t->hy_decay = (decltype(t->hy_decay))a.p.hy_decay;
    t->hy_skip = (decltype(t->hy_skip))a.p.hy_skip;
    t->hy_w_out = (decltype(t->hy_w_out))a.p.hy_w_out;
    t->mla_w_in = (decltype(t->mla_w_in))a.p.mla_w_in;
    t->mla_q_norm = (decltype(t->mla_q_norm))a.p.mla_q_norm;
    t->mla_kv_norm = (decltype(t->mla_kv_norm))a.p.mla_kv_norm;
    t->mla_w_q_up = (decltype(t->mla_w_q_up))a.p.mla_w_q_up;
    t->mla_w_kv_up = (decltype(t->mla_w_kv_up))a.p.mla_w_kv_up;
    t->mla_w_out = (decltype(t->mla_w_out))a.p.mla_w_out;
    t->rw_mu = (decltype(t->rw_mu))a.p.rw_mu;
    t->rw_w_in = (decltype(t->rw_w_in))a.p.rw_w_in;
    t->rw_w0 = (decltype(t->rw_w0))a.p.rw_w0;
    t->rw_w1 = (decltype(t->rw_w1))a.p.rw_w1;
    t->rw_w2 = (decltype(t->rw_w2))a.p.rw_w2;
    t->rw_a0 = (decltype(t->rw_a0))a.p.rw_a0;
    t->rw_a1 = (decltype(t->rw_a1))a.p.rw_a1;
    t->rw_a2 = (decltype(t->rw_a2))a.p.rw_a2;
    t->rw_k_k = (decltype(t->rw_k_k))a.p.rw_k_k;
    t->rw_k_a = (decltype(t->rw_k_a))a.p.rw_k_a;
    t->rw_r_k = (decltype(t->rw_r_k))a.p.rw_r_k;
    t->rw_gn_g = (decltype(t->rw_gn_g))a.p.rw_gn_g;
    t->rw_gn_b = (decltype(t->rw_gn_b))a.p.rw_gn_b;
    t->rw_w_out = (decltype(t->rw_w_out))a.p.rw_w_out;
    t->out = (decltype(t->out))a.p.out;
    t->ws = (decltype(t->ws))a.p.ws;
  }
  const LAS PG& p = *(const LAS PG*)(lds + PTAB_OFF);
  volatile LAS unsigned* MISC = (volatile LAS unsigned*)(lds + MISC_OFF);
  for (int u = tid; u < 128; u += 512) ((LAS unsigned*)(lds + MISC_OFF))[u] = 0u;
  __syncthreads();
  const int lo = a.ph_lo, hi = a.ph_hi;
  XcdBarrier bar; bar.bar = (unsigned*)(ws + M_CTL); bar.x = 0; bar.st = nullptr;
  if (hi - lo > 1 || RPT_MASK) bar = xcd_barrier_post((unsigned*)(ws + M_CTL), MISC + 8);
#ifndef PH_MASK
#define PH_MASK 0xffffffffu
#endif
#define IN(k) (((PH_MASK >> (k)) & 1u) && lo <= (k) && (k) < hi)
#define SEAM(k) do { if (IN(k) && IN((k) + 1)) xcd_barrier(bar); } while (0)
  if (IN(0)) { { phase_p0a(p, ws, lds, opq(tid), opq(lane), wave, bid, G); } if ((RPT_MASK >> 0) & 1u) { xcd_barrier(bar); { phase_p0a(p, ws, lds, opq(tid), opq(lane), wave, bid, G); } } } SEAM(0);
  if (IN(1)) { { phase_p0b(p, ws, lds, opq(tid), opq(lane), wave, bid, G); } if ((RPT_MASK >> 1) & 1u) { xcd_barrier(bar); { phase_p0b(p, ws, lds, opq(tid), opq(lane), wave, bid, G); } } } SEAM(1);
  if (IN(2)) { {
    pg8::Gemm g{(const pg8::bf16_t*)(ws + W_HYIN), (const pg8::bf16_t*)(ws + M_HB), 4096, 8192, 1024};
    pg8::StaticOrder S; S.init(4096, 8192, G, bid);
    pg8::EpiBf16<0> E{(pg8::bf16_t*)(ws + M_UT), 8192, nullptr, 0, 0, 1.f};
    pg8::gemm_phase<pg8::EpiBf16<0>, pg8::StaticOrder, true, true>(lds, g, S, E); } if ((RPT_MASK >> 2) & 1u) { xcd_barrier(bar); {
    pg8::Gemm g{(const pg8::bf16_t*)(ws + W_HYIN), (const pg8::bf16_t*)(ws + M_HB), 4096, 8192, 1024};
    pg8::StaticOrder S; S.init(4096, 8192, G, bid);
    pg8::EpiBf16<0> E{(pg8::bf16_t*)(ws + M_UT), 8192, nullptr, 0, 0, 1.f};
    pg8::gemm_phase<pg8::EpiBf16<0>, pg8::StaticOrder, true, true>(lds, g, S, E); } } } SEAM(2);
  if (IN(3)) { { phase_hy_conv(p, ws, lds, 0, opq(tid), opq(lane), wave, bid, G); } if ((RPT_MASK >> 3) & 1u) { xcd_barrier(bar); { phase_hy_conv(p, ws, lds, 0, opq(tid), opq(lane), wave, bid, G); } } } SEAM(3);
  if (IN(4)) { { phase_out_ln<1>(p, ws, lds, 0, (const bf16_t*)(ws + W_HYOUT), opq(tid), opq(lane), wave, bid, G); } if ((RPT_MASK >> 4) & 1u) { xcd_barrier(bar); { phase_out_ln<1>(p, ws, lds, 0, (const bf16_t*)(ws + W_HYOUT), opq(tid), opq(lane), wave, bid, G); } } } SEAM(4);
  if (IN(5)) { {
    pg8::Gemm g{(const pg8::bf16_t*)(ws + M_HB), (const pg8::bf16_t*)(ws + W_MLAIN + MiB), 8192, 1024, 1024};
    pg8::StaticOrder S; S.init(8192, 1024, G, bid);
    EpiSilu E{(bf16_t*)(ws + M_SZB), 1024};
    pg8::gemm_phase<EpiSilu, pg8::StaticOrder, true, true>(lds, g, S, E);
    if (G == 256) { if (bid >= 128) for (int tile = bid - 128; tile < 256; tile += 128) mla_in_small_tile(p, ws, lds, tile, opq(tid), opq(lane), wave); }
    else for (int tile = bid; tile < 256; tile += G) mla_in_small_tile(p, ws, lds, tile, opq(tid), opq(lane), wave); } if ((RPT_MASK >> 5) & 1u) { xcd_barrier(bar); {
    pg8::Gemm g{(const pg8::bf16_t*)(ws + M_HB), (const pg8::bf16_t*)(ws + W_MLAIN + MiB), 8192, 1024, 1024};
    pg8::StaticOrder S; S.init(8192, 1024, G, bid);
    EpiSilu E{(bf16_t*)(ws + M_SZB), 1024};
    pg8::gemm_phase<EpiSilu, pg8::StaticOrder, true, true>(lds, g, S, E);
    if (G == 256) { if (bid >= 128) for (int tile = bid - 128; tile < 256; tile += 128) mla_in_small_tile(p, ws, lds, tile, opq(tid), opq(lane), wave); }
    else for (int tile = bid; tile < 256; tile += G) mla_in_small_tile(p, ws, lds, tile, opq(tid), opq(lane), wave); } } } SEAM(5);
  if (IN(6)) { {
    { pg8::Gemm g{(const pg8::bf16_t*)(ws + M_QN), (const pg8::bf16_t*)(ws + W_QUP), 8192, 1536, 256};
      pg8::StaticOrder S; S.init(8192, 1536, G, bid);
      pg8::EpiBf16<0> E{(pg8::bf16_t*)(ws + M_Q), 1536, nullptr, 0, 0, 1.f};
      pg8::gemm_phase<pg8::EpiBf16<0>, pg8::StaticOrder, true, true>(lds, g, S, E); }
    { pg8::Gemm g{(const pg8::bf16_t*)(ws + M_CKVALL), (const pg8::bf16_t*)(ws + W_KVUP), 9216, 2048, 128};
      pg8::StaticOrder S; S.init(9216, 2048, G, (bid + G - 192 % G) % G);
      EpiKV E{(bf16_t*)(ws + M_KN), (bf16_t*)(ws + M_V)};
      pg8::gemm_phase<EpiKV, pg8::StaticOrder, true, true>(lds, g, S, E); } } if ((RPT_MASK >> 6) & 1u) { xcd_barrier(bar); {
    { pg8::Gemm g{(const pg8::bf16_t*)(ws + M_QN), (const pg8::bf16_t*)(ws + W_QUP), 8192, 1536, 256};
      pg8::StaticOrder S; S.init(8192, 1536, G, bid);
      pg8::EpiBf16<0> E{(pg8::bf16_t*)(ws + M_Q), 1536, nullptr, 0, 0, 1.f};
      pg8::gemm_phase<pg8::EpiBf16<0>, pg8::StaticOrder, true, true>(lds, g, S, E); }
    { pg8::Gemm g{(const pg8::bf16_t*)(ws + M_CKVALL), (const pg8::bf16_t*)(ws + W_KVUP), 9216, 2048, 128};
      pg8::StaticOrder S; S.init(9216, 2048, G, (bid + G - 192 % G) % G);
      EpiKV E{(bf16_t*)(ws + M_KN), (bf16_t*)(ws + M_V)};
      pg8::gemm_phase<EpiKV, pg8::StaticOrder, true, true>(lds, g, S, E); } } } } SEAM(6);
  if (IN(7)) { {
    for (int u = bid; u < 512; u += G) {
      int seq, hd, qb;
      if (u < 256) { seq = 16 + (u >> 7); hd = (u >> 3) & 15; qb = u & 7; } else { const int uu = u - 256; seq = uu >> 4; hd = uu & 15; qb = 0; }
      attn_unit(ws, lds, seq, hd, qb, (bf16_t*)(ws + M_GB), opq(tid), opq(lane), wave);
    } } if ((RPT_MASK >> 7) & 1u) { xcd_barrier(bar); {
    for (int u = bid; u < 512; u += G) {
      int seq, hd, qb;
      if (u < 256) { seq = 16 + (u >> 7); hd = (u >> 3) & 15; qb = u & 7; } else { const int uu = u - 256; seq = uu >> 4; hd = uu & 15; qb = 0; }
      attn_unit(ws, lds, seq, hd, qb, (bf16_t*)(ws + M_GB), opq(tid), opq(lane), wave);
    } } } } SEAM(7);
  if (IN(8)) { { phase_out_ln<0>(p, ws, lds, 1, (const bf16_t*)(ws + W_MLAOUT), opq(tid), opq(lane), wave, bid, G); } if ((RPT_MASK >> 8) & 1u) { xcd_barrier(bar); { phase_out_ln<0>(p, ws, lds, 1, (const bf16_t*)(ws + W_MLAOUT), opq(tid), opq(lane), wave, bid, G); } } } SEAM(8);
  if (IN(9)) { { phase_rw_mix(p, ws, opq(tid), bid, G); } if ((RPT_MASK >> 9) & 1u) { xcd_barrier(bar); { phase_rw_mix(p, ws, opq(tid), bid, G); } } } SEAM(9);
  if (IN(10)) { {
#pragma unroll 1
    for (int q = 0; q < 4; ++q) {
      pg8::Gemm g{(const pg8::bf16_t*)(ws + M_XMIX + (size_t)q * 16 * MiB), (const pg8::bf16_t*)(ws + W_RWIN + (size_t)q * 2 * MiB), 8192, 1024, 1024};
      pg8::StaticOrder S; S.init(8192, 1024, G, (bid + (q & 1) * (G / 2)) % G);
      if (q < 3) { pg8::EpiBf16<0> E{(pg8::bf16_t*)(ws + M_SCR2 + (size_t)q * 16 * MiB), 1024, nullptr, 0, 0, 1.f}; pg8::gemm_phase<pg8::EpiBf16<0>, pg8::StaticOrder, true, true>(lds, g, S, E); }
      else { EpiSilu E{(bf16_t*)(ws + M_SZR), 1024}; pg8::gemm_phase<EpiSilu, pg8::StaticOrder, true, true>(lds, g, S, E); }
    }
    for (int tile = bid; tile < 256; tile += G) rw_lora_tile(p, ws, lds, tile, opq(tid), opq(lane), wave); } if ((RPT_MASK >> 10) & 1u) { xcd_barrier(bar); {
#pragma unroll 1
    for (int q = 0; q < 4; ++q) {
      pg8::Gemm g{(const pg8::bf16_t*)(ws + M_XMIX + (size_t)q * 16 * MiB), (const pg8::bf16_t*)(ws + W_RWIN + (size_t)q * 2 * MiB), 8192, 1024, 1024};
      pg8::StaticOrder S; S.init(8192, 1024, G, (bid + (q & 1) * (G / 2)) % G);
      if (q < 3) { pg8::EpiBf16<0> E{(pg8::bf16_t*)(ws + M_SCR2 + (size_t)q * 16 * MiB), 1024, nullptr, 0, 0, 1.f}; pg8::gemm_phase<pg8::EpiBf16<0>, pg8::StaticOrder, true, true>(lds, g, S, E); }
      else { EpiSilu E{(bf16_t*)(ws + M_SZR), 1024}; pg8::gemm_phase<EpiSilu, pg8::StaticOrder, true, true>(lds, g, S, E); }
    }
    for (int tile = bid; tile < 256; tile += G) rw_lora_tile(p, ws, lds, tile, opq(tid), opq(lane), wave); } } } SEAM(10);
  if (IN(11)) { { phase_rw_scan_ck(p, ws, lds, opq(tid), opq(lane), wave, bid, G); } if ((RPT_MASK >> 11) & 1u) { xcd_barrier(bar); { phase_rw_scan_ck(p, ws, lds, opq(tid), opq(lane), wave, bid, G); } } } SEAM(11);
  if (IN(12)) { { phase_out_ln<2>(p, ws, lds, 2, (const bf16_t*)(ws + W_RWOUT), opq(tid), opq(lane), wave, bid, G); } if ((RPT_MASK >> 12) & 1u) { xcd_barrier(bar); { phase_out_ln<2>(p, ws, lds, 2, (const bf16_t*)(ws + W_RWOUT), opq(tid), opq(lane), wave, bid, G); } } } SEAM(12);
  if (IN(13)) { {
    pg8::Gemm g{(const pg8::bf16_t*)(ws + W_HYIN + 8 * MiB), (const pg8::bf16_t*)(ws + M_HB), 4096, 8192, 1024};
    pg8::StaticOrder S; S.init(4096, 8192, G, bid);
    pg8::EpiBf16<0> E{(pg8::bf16_t*)(ws + M_UT), 8192, nullptr, 0, 0, 1.f};
    pg8::gemm_phase<pg8::EpiBf16<0>, pg8::StaticOrder, true, true>(lds, g, S, E); } if ((RPT_MASK >> 13) & 1u) { xcd_barrier(bar); {
    pg8::Gemm g{(const pg8::bf16_t*)(ws + W_HYIN + 8 * MiB), (const pg8::bf16_t*)(ws + M_HB), 4096, 8192, 1024};
    pg8::StaticOrder S; S.init(4096, 8192, G, bid);
    pg8::EpiBf16<0> E{(pg8::bf16_t*)(ws + M_UT), 8192, nullptr, 0, 0, 1.f};
    pg8::gemm_phase<pg8::EpiBf16<0>, pg8::StaticOrder, true, true>(lds, g, S, E); } } } SEAM(13);
  if (IN(14)) { { phase_hy_conv(p, ws, lds, 1, opq(tid), opq(lane), wave, bid, G); } if ((RPT_MASK >> 14) & 1u) { xcd_barrier(bar); { phase_hy_conv(p, ws, lds, 1, opq(tid), opq(lane), wave, bid, G); } } } SEAM(14);
  if (IN(15)) { { phase_out_ln<1>(p, ws, lds, 3, (const bf16_t*)(ws + W_HYOUT + 2 * MiB), opq(tid), opq(lane), wave, bid, G); } if ((RPT_MASK >> 15) & 1u) { xcd_barrier(bar); { phase_out_ln<1>(p, ws, lds, 3, (const bf16_t*)(ws + W_HYOUT + 2 * MiB), opq(tid), opq(lane), wave, bid, G); } } }
#undef IN
#undef SEAM
}
}
}

extern "C" void kernel_launch(void* const* d_in, const int* in_sizes, int n_in, void* d_out, int out_size, void* d_ws, size_t ws_size, hipStream_t stream) {
  P p{};
  const float** pp = (const float**)&p;
  for (int i = 0; i < 44; ++i) pp[i] = (const float*)d_in[i];
  p.out = (float*)d_out; p.ws = (float*)d_ws;
  float* ws = p.ws;
  static int grid = 0;
  if (grid == 0) {
    int dev = 0, cus = 0;
    (void)hipGetDevice(&dev); (void)hipDeviceGetAttribute(&cus, hipDeviceAttributeMultiprocessorCount, dev);
    (void)hipFuncSetAttribute((const void*)mk::mega, hipFuncAttributeMaxDynamicSharedMemorySize, mk::LDS_BYTES);
    grid = cus > 0 ? cus : 256;
  }
  (void)hipMemsetAsync((char*)d_ws + mk::M_CTL, 0, 65536, stream);
  mk::MArgs a{}; a.p = p; a.ph_lo = 0; a.ph_hi = MEGA_PHASES;
  hipLaunchKernelGGL(mk::mega, dim3(grid), dim3(512), mk::LDS_BYTES, stream, a);

  float* X = ws + WS_X; float* S1 = ws + WS_S1; float* S4 = ws + WS_S4; float* S2 = ws + WS_S2;
  const int EB = (int)((SZ + 255) / 256);
  if (NAIVE_FROM < 4) hipLaunchKernelGGL(k_mods, dim3((4 * 3 * 3072 + 255) / 256), dim3(256), 0, stream, p);
  for (int layer = NAIVE_FROM; layer < 4; ++layer) {
    const int kind = layer % 3, j = layer / 3;
    const float* xa = (layer == 0) ? p.x_prompt : X;
    const float* xb = (layer == 0) ? p.x_sample : X + (size_t)NPT * D;
    float* Xn = (layer == 3) ? p.out + OUT_Y : X;
    hipLaunchKernelGGL(k_modulate, dim3(EB), dim3(256), 0, stream, p, xa, xb, S1, layer);
    if (kind == 0) {
      hipLaunchKernelGGL(k_hy_filter, dim3(2304), dim3(256), 0, stream, p, j);
      gemm(stream, ALPlain{S1, D}, p.hy_w_in + (size_t)j * D * 4096, 4096, NTOK, 4096, D, EPPlain{S2, 4096});
      hipLaunchKernelGGL(k_hy_vv, dim3(EB), dim3(256), 0, stream, p, S2, S1, j);
      hipLaunchKernelGGL(k_hy_long, dim3(EB), dim3(256), 0, stream, p, S2, S1, S4, j);
      gemm(stream, ALPlain{S4, D}, p.hy_w_out + (size_t)j * D * D, D, NTOK, D, D, EPPlain{S1, D});
    } else if (kind == 1) {
      float* U2 = S2; float* QN = S1; float* CKVALL = S1 + (size_t)NTOK * 256; float* KPEALL = CKVALL + (size_t)9216 * 128;
      float* Q = S2; float* KV = S2 + (size_t)NTOK * 1536;
      gemm(stream, ALPlain{S1, D}, p.mla_w_in, 1440, NTOK, 1440, D, EPPlain{U2, 1440});
      hipLaunchKernelGGL(k_mla_extract, dim3(NTOK), dim3(64), 0, stream, p, U2, QN, CKVALL, KPEALL, S4);
      hipLaunchKernelGGL(k_mla_cache, dim3((2 * PAST * 128 + 255) / 256), dim3(256), 0, stream, p, CKVALL, KPEALL);
      gemm(stream, ALPlain{QN, 256}, p.mla_w_q_up, 1536, NTOK, 1536, 256, EPPlain{Q, 1536});
      hipLaunchKernelGGL(k_rope_q, dim3((4096 * 16 + 255) / 256), dim3(256), 0, stream, Q);
      gemm(stream, ALPlain{CKVALL, 128}, p.mla_w_kv_up, 2048, 9216, 2048, 128, EPPlain{KV, 2048});
      hipLaunchKernelGGL(k_attn, dim3(32, 18 * 16), dim3(64), 0, stream, Q, KV, KPEALL, S4);
      gemm(stream, ALPlain{S4, D}, p.mla_w_out, D, NTOK, D, D, EPPlain{S1, D});
    } else {
      float* R = S2; float* K = S2 + SZ; float* V = S2 + 2 * SZ; float* Z = S2 + 3 * SZ;
      float* HW = ws + WS_MISC + MISC_END; float* HA = HW + (size_t)NTOK * 128;
      const float* mu = p.rw_mu; const float* win = p.rw_w_in;
      gemm(stream, ALMix{S1, mu + 0 * D}, win + 0 * (size_t)D * D, D, NTOK, D, D, EPPlain{R, D});
      gemm(stream, ALMix{S1, mu + 2 * D}, win + 1 * (size_t)D * D, D, NTOK, D, D, EPPlain{K, D});
      gemm(stream, ALMix{S1, mu + 3 * D}, win + 2 * (size_t)D * D, D, NTOK, D, D, EPPlain{V, D});
      gemm(stream, ALMix{S1, mu + 5 * D}, win + 3 * (size_t)D * D, D, NTOK, D, D, EPPlain{Z, D});
      for (int dir = 0; dir < 2; ++dir) {
        gemm(stream, ALMix{S1, mu + 1 * D}, p.rw_w1 + (size_t)dir * D * 64, 64, NTOK, 64, D, EPTanh{HW + dir * 64, 128});
        gemm(stream, ALMix{S1, mu + 4 * D}, p.rw_a1 + (size_t)dir * D * 64, 64, NTOK, 64, D, EPPlain{HA + dir * 64, 128});
      }
      (void)hipMemsetAsync(S4, 0, SZ * sizeof(float), stream);
      hipLaunchKernelGGL(k_rw_scan, dim3(18 * 32), dim3(64), 0, stream, p, R, K, V, HW, HA, S4);
      hipLaunchKernelGGL(k_rw_post, dim3(NTOK * 16), dim3(64), 0, stream, p, R, K, V, Z, HA, S4, S4);
      gemm(stream, ALPlain{S4, D}, p.rw_w_out, D, NTOK, D, D, EPPlain{S1, D});
    }
    hipLaunchKernelGGL(k_ln, dim3(NTOK / 4), dim3(256), 0, stream, p, xa, xb, S1, Xn, layer);
  }
}
```

```cpp
#define MEGA_PHASES 16
#define NAIVE_FROM 4
#define RPT_MASK 0x0u
#include <hip/hip_runtime.h>
#include <stdint.h>
#include <math.h>

namespace {

constexpr int D = 1024;
constexpr int NTOK = 8192;
constexpr int NPT = 4096;
constexpr int PAST = 512;
constexpr float ALPHA = 1.681792830507429f;
constexpr float LN_EPS = 1e-5f, RMS_EPS = 1e-6f, GN_EPS = 64e-5f;

struct P {
  const float *x_prompt, *x_sample, *cache_ckv, *cache_kpe, *state_rwkv, *c, *c_ctx;
  const float *mod_w, *mod_b, *ln_g, *ln_b;
  const float *hy_w_in, *hy_conv_w, *hy_conv_b, *hy_w1, *hy_b1, *hy_w2, *hy_b2, *hy_w3, *hy_b3, *hy_freq, *hy_decay, *hy_skip, *hy_w_out;
  const float *mla_w_in, *mla_q_norm, *mla_kv_norm, *mla_w_q_up, *mla_w_kv_up, *mla_w_out;
  const float *rw_mu, *rw_w_in, *rw_w0, *rw_w1, *rw_w2, *rw_a0, *rw_a1, *rw_a2, *rw_k_k, *rw_k_a, *rw_r_k, *rw_gn_g, *rw_gn_b, *rw_w_out;
  float* out;
  float* ws;
};

constexpr size_t OUT_Y = 0, OUT_CKV = 8388608, OUT_KPE = 8912896, OUT_ST = 9043968;

constexpr size_t SZ = (size_t)NTOK * D;
constexpr size_t WS_X = 0;
constexpr size_t WS_S1 = WS_X + SZ;
constexpr size_t WS_S4 = WS_S1 + SZ;
constexpr size_t WS_S2 = WS_S4 + SZ;
constexpr size_t WS_MISC = WS_S2 + 4 * SZ;
constexpr size_t MISC_MODS = 0;
constexpr size_t MISC_FILT = 65536;
constexpr size_t MISC_END = MISC_FILT + (size_t)2304 * 2048;

__device__ __forceinline__ float silu(float x) { return x / (1.f + expf(-x)); }
__device__ __forceinline__ float sigmoidf(float x) { return 1.f / (1.f + expf(-x)); }

__device__ __forceinline__ void tokinfo(int m, int& l, int& L, int& cond, int& m0) {
  if (m < NPT) { l = m & 255; L = 256; cond = 0; m0 = m & ~255; }
  else { int mm = m - NPT; l = mm & 2047; L = 2048; cond = 1 + (mm >> 11); m0 = NPT + (mm & ~2047); }
}

__global__ void k_mods(P p) {
  int idx = blockIdx.x * blockDim.x + threadIdx.x;
  if (idx >= 4 * 3 * 3072) return;
  int n = idx % 3072, g = (idx / 3072) % 3, i = idx / (3 * 3072);
  const float* cond = (g == 0) ? p.c_ctx : p.c + (size_t)(g - 1) * D;
  const float* w = p.mod_w + (size_t)i * D * 3072;
  float acc = 0.f;
  for (int k = 0; k < D; ++k) acc += silu(cond[k]) * w[(size_t)k * 3072 + n];
  p.ws[WS_MISC + MISC_MODS + idx] = acc + p.mod_b[i * 3072 + n];
}

__global__ void k_modulate(P p, const float* xa, const float* xb, float* H, int layer) {
  size_t idx = (size_t)blockIdx.x * blockDim.x + threadIdx.x;
  if (idx >= SZ) return;
  int m = (int)(idx >> 10), k = (int)(idx & 1023);
  int l, L, cond, m0; tokinfo(m, l, L, cond, m0);
  const float* md = p.ws + WS_MISC + MISC_MODS + (size_t)(layer * 3 + cond) * 3072;
  float x = (m < NPT) ? xa[idx] : xb[idx - (size_t)NPT * D];
  H[idx] = x * (1.f + md[1024 + k]) + md[k];
}

template <class AL, class EP>
__global__ void __launch_bounds__(256) k_gemm(AL al, const float* __restrict__ W, int ldw, int M, int N, int K, EP ep) {
  __shared__ float As[16][68];
  __shared__ float Bs[16][68];
  const int tx = threadIdx.x & 15, ty = threadIdx.x >> 4;
  const int m0 = blockIdx.y * 64, n0 = blockIdx.x * 64;
  float acc[4][4];
#pragma unroll
  for (int i = 0; i < 4; ++i)
#pragma unroll
    for (int j = 0; j < 4; ++j) acc[i][j] = 0.f;
  for (int k0 = 0; k0 < K; k0 += 16) {
#pragma unroll
    for (int i = 0; i < 4; ++i) {
      int e = threadIdx.x + i * 256; int mm = e >> 4, kk = e & 15;
      As[kk][mm] = (m0 + mm < M) ? al(m0 + mm, k0 + kk) : 0.f;
    }
#pragma unroll
    for (int i = 0; i < 4; ++i) {
      int e = threadIdx.x + i * 256; int kk = e >> 6, nn = e & 63;
      Bs[kk][nn] = (n0 + nn < N) ? W[(size_t)(k0 + kk) * ldw + n0 + nn] : 0.f;
    }
    __syncthreads();
#pragma unroll
    for (int kk = 0; kk < 16; ++kk) {
      float a[4], b[4];
#pragma unroll
      for (int i = 0; i < 4; ++i) { a[i] = As[kk][ty * 4 + i]; b[i] = Bs[kk][tx * 4 + i]; }
#pragma unroll
      for (int i = 0; i < 4; ++i)
#pragma unroll
        for (int j = 0; j < 4; ++j) acc[i][j] += a[i] * b[j];
    }
    __syncthreads();
  }
#pragma unroll
  for (int i = 0; i < 4; ++i)
#pragma unroll
    for (int j = 0; j < 4; ++j) {
      int m = m0 + ty * 4 + i, n = n0 + tx * 4 + j;
      if (m < M && n < N) ep(m, n, acc[i][j]);
    }
}

struct ALPlain { const float* A; long lda; __device__ float operator()(int m, int k) const { return A[(size_t)m * lda + k]; } };
struct EPPlain { float* C; long ldc; __device__ void operator()(int m, int n, float v) const { C[(size_t)m * ldc + n] = v; } };
struct EPTanh { float* C; long ldc; __device__ void operator()(int m, int n, float v) const { C[(size_t)m * ldc + n] = tanhf(v); } };
struct ALMix {
  const float* H; const float* mu;
  __device__ float operator()(int m, int k) const {
    int l, L, cond, m0; tokinfo(m, l, L, cond, m0);
    float h = H[(size_t)m * D + k];
    float pv = (l > 0) ? H[(size_t)(m - 1) * D + k] : 0.f;
    float nx = (l < L - 1) ? H[(size_t)(m + 1) * D + k] : 0.f;
    return h + (0.5f * (pv + nx) - h) * mu[k];
  }
};

template <class AL, class EP>
void gemm(hipStream_t s, AL al, const float* W, int ldw, int M, int N, int K, EP ep) {
  dim3 g((N + 63) / 64, (M + 63) / 64);
  hipLaunchKernelGGL((k_gemm<AL, EP>), g, dim3(256), 0, s, al, W, ldw, M, N, K, ep);
}

__global__ void __launch_bounds__(256) k_ln(P p, const float* xa, const float* xb, const float* O, float* Xn, int layer) {
  int m = blockIdx.x * 4 + (threadIdx.x >> 6), lane = threadIdx.x & 63;
  int l, L, cond, m0; tokinfo(m, l, L, cond, m0);
  const float* gate = p.ws + WS_MISC + MISC_MODS + (size_t)(layer * 3 + cond) * 3072 + 2048;
  const float* xr = (m < NPT) ? xa + (size_t)m * D : xb + (size_t)(m - NPT) * D;
  float v[16]; float s = 0.f;
#pragma unroll
  for (int i = 0; i < 16; ++i) { int k = lane + 64 * i; v[i] = ALPHA * xr[k] + gate[k] * O[(size_t)m * D + k]; s += v[i]; }
#pragma unroll
  for (int o = 1; o < 64; o <<= 1) s += __shfl_xor(s, o);
  float mu = s * (1.f / D), q = 0.f;
#pragma unroll
  for (int i = 0; i < 16; ++i) { v[i] -= mu; q += v[i] * v[i]; }
#pragma unroll
  for (int o = 1; o < 64; o <<= 1) q += __shfl_xor(q, o);
  float rs = rsqrtf(q * (1.f / D) + LN_EPS);
#pragma unroll
  for (int i = 0; i < 16; ++i) { int k = lane + 64 * i; Xn[(size_t)m * D + k] = v[i] * rs * p.ln_g[layer * D + k] + p.ln_b[layer * D + k]; }
}

__global__ void __launch_bounds__(256) k_hy_filter(P p, int j) {
  __shared__ float feat[33], h1[64], h2[64];
  int row = blockIdx.x; int L = row < 256 ? 256 : 2048; int l = row < 256 ? row : row - 256;
  int tid = threadIdx.x;
  float t = (float)l / (float)(L - 1);
  if (tid < 33) {
    float f;
    if (tid == 0) f = t;
    else {
      int b = (tid - 1) & 15;
      float band = 1e-4f + (float)b * ((15.f - 1e-4f) / 15.f);
      float ang = (6.283185307179586f / (float)L) * (float)l * band;
      f = (tid <= 16) ? cosf(ang) : -sinf(ang);
    }
    feat[tid] = f;
  }
  __syncthreads();
  if (tid < 64) {
    float a = p.hy_b1[j * 64 + tid];
    for (int f = 0; f < 33; ++f) a += feat[f] * p.hy_w1[((size_t)j * 33 + f) * 64 + tid];
    h1[tid] = sinf(p.hy_freq[(j * 2 + 0) * 64 + tid] * a);
  }
  __syncthreads();
  if (tid < 64) {
    float a = p.hy_b2[j * 64 + tid];
    for (int f = 0; f < 64; ++f) a += h1[f] * p.hy_w2[((size_t)j * 64 + f) * 64 + tid];
    h2[tid] = sinf(p.hy_freq[(j * 2 + 1) * 64 + tid] * a);
  }
  __syncthreads();
  for (int o = tid; o < 2048; o += 256) {
    float a = p.hy_b3[j * 2048 + o];
    for (int f = 0; f < 64; ++f) a += h2[f] * p.hy_w3[((size_t)j * 64 + f) * 2048 + o];
    float w = expf(-t * fabsf(p.hy_decay[(size_t)j * 2048 + o]));
    p.ws[WS_MISC + MISC_FILT + (size_t)row * 2048 + o] = a * w;
  }
}

__device__ __forceinline__ float conv3(const float* U, int m, int l, int L, int ch, const float* cw, const float* cb) {
  float cur = U[(size_t)m * 4096 + ch];
  float pv = (l > 0) ? U[(size_t)(m - 1) * 4096 + ch] : 0.f;
  float nx = (l < L - 1) ? U[(size_t)(m + 1) * 4096 + ch] : 0.f;
  return pv * cw[ch] + cur * cw[3072 + ch] + nx * cw[6144 + ch] + cb[ch];
}
__global__ void k_hy_vv(P p, const float* U, float* VV, int j) {
  size_t idx = (size_t)blockIdx.x * blockDim.x + threadIdx.x;
  if (idx >= SZ) return;
  int m = (int)(idx >> 10), c = (int)(idx & 1023);
  int l, L, cond, m0; tokinfo(m, l, L, cond, m0);
  const float* cw = p.hy_conv_w + (size_t)j * 3 * 3072; const float* cb = p.hy_conv_b + (size_t)j * 3072;
  float x1 = conv3(U, m, l, L, 1024 + c, cw, cb);
  float v = conv3(U, m, l, L, 2048 + c, cw, cb);
  VV[idx] = v * x1;
}
__global__ void k_hy_long(P p, const float* U, const float* VV, float* G, int j) {
  size_t idx = (size_t)blockIdx.x * blockDim.x + threadIdx.x;
  if (idx >= SZ) return;
  int m = (int)(idx >> 10), c = (int)(idx & 1023);
  int l, L, cond, m0; tokinfo(m, l, L, cond, m0);
  const float* F = p.ws + WS_MISC + MISC_FILT + (size_t)(L == 256 ? 0 : 256) * 2048;
  float acc = 0.f;
  for (int s = 0; s <= l; ++s) acc += VV[(size_t)(m0 + s) * D + c] * F[(size_t)(l - s) * 2048 + c];
  for (int s = l + 1; s < L; ++s) acc += VV[(size_t)(m0 + s) * D + c] * F[(size_t)(s - l) * 2048 + 1024 + c];
  const float* cw = p.hy_conv_w + (size_t)j * 3 * 3072; const float* cb = p.hy_conv_b + (size_t)j * 3072;
  float x0 = conv3(U, m, l, L, c, cw, cb);
  float z = U[(size_t)m * 4096 + 3072 + c];
  float y = (acc + VV[idx] * p.hy_skip[j * D + c]) * x0;
  G[idx] = y * silu(z);
}

__device__ __forceinline__ int kvrow(int m) { if (m < NPT) return m; int mm = m - NPT; return NPT + (mm >> 11) * 2560 + PAST + (mm & 2047); }
__device__ __forceinline__ void rope32(const float* x, float* o, int l) {
  int r = l >> 6, col = l & 63;
#pragma unroll
  for (int i = 0; i < 8; ++i) {
    float inv = powf(10000.f, -(float)(2 * i) / 16.f);
    float ar = (float)r * inv, ac = (float)col * inv;
    float cr = cosf(ar), sr = sinf(ar), cc = cosf(ac), sc = sinf(ac);
    o[i] = x[i] * cr - x[i + 8] * sr;
    o[i + 8] = x[i + 8] * cr + x[i] * sr;
    o[16 + i] = x[16 + i] * cc - x[24 + i] * sc;
    o[24 + i] = x[24 + i] * cc + x[16 + i] * sc;
  }
}
__global__ void __launch_bounds__(64) k_mla_extract(P p, const float* U2, float* QN, float* CKVALL, float* KPEALL, float* Z) {
  int m = blockIdx.x, lane = threadIdx.x;
  int l, L, cond, m0; tokinfo(m, l, L, cond, m0);
  const float* u = U2 + (size_t)m * 1440;
  float q[4], s = 0.f;
#pragma unroll
  for (int i = 0; i < 4; ++i) { q[i] = u[lane + 64 * i]; s += q[i] * q[i]; }
#pragma unroll
  for (int o = 1; o < 64; o <<= 1) s += __shfl_xor(s, o);
  float rs = rsqrtf(s * (1.f / 256.f) + RMS_EPS);
#pragma unroll
  for (int i = 0; i < 4; ++i) QN[(size_t)m * 256 + lane + 64 * i] = q[i] * rs * p.mla_q_norm[lane + 64 * i];
  float k0 = u[256 + lane], k1 = u[256 + 64 + lane];
  float s2 = k0 * k0 + k1 * k1;
#pragma unroll
  for (int o = 1; o < 64; o <<= 1) s2 += __shfl_xor(s2, o);
  float rs2 = rsqrtf(s2 * (1.f / 128.f) + RMS_EPS);
  float c0 = k0 * rs2 * p.mla_kv_norm[lane], c1 = k1 * rs2 * p.mla_kv_norm[64 + lane];
  int kr = kvrow(m);
  CKVALL[(size_t)kr * 128 + lane] = c0; CKVALL[(size_t)kr * 128 + 64 + lane] = c1;
  if (m < NPT) { p.out[OUT_CKV + (size_t)m * 128 + lane] = c0; p.out[OUT_CKV + (size_t)m * 128 + 64 + lane] = c1; }
  if (lane == 0) {
    float x[32], o[32];
#pragma unroll
    for (int i = 0; i < 32; ++i) x[i] = u[384 + i];
    if (m < NPT) {
#pragma unroll
      for (int i = 0; i < 32; ++i) { KPEALL[(size_t)kr * 32 + i] = x[i]; p.out[OUT_KPE + (size_t)m * 32 + i] = x[i]; }
    } else {
      rope32(x, o, l);
#pragma unroll
      for (int i = 0; i < 32; ++i) KPEALL[(size_t)kr * 32 + i] = o[i];
    }
  }
  for (int i = lane; i < 1024; i += 64) Z[(size_t)m * D + i] = u[416 + i];
}
__global__ void k_mla_cache(P p, float* CKVALL, float* KPEALL) {
  int idx = blockIdx.x * blockDim.x + threadIdx.x;
  if (idx >= 2 * PAST * 128) return;
  int d = idx & 127, pl = (idx >> 7) & 511, b = idx >> 16;
  int row = NPT + b * 2560 + pl;
  CKVALL[(size_t)row * 128 + d] = p.cache_ckv[idx];
  if (d < 32) KPEALL[(size_t)row * 32 + d] = p.cache_kpe[((size_t)b * PAST + pl) * 32 + d];
}
__global__ void k_rope_q(float* Q) {
  int idx = blockIdx.x * blockDim.x + threadIdx.x;
  if (idx >= 4096 * 16) return;
  int h = idx & 15, mm = idx >> 4; int m = NPT + mm; int l = mm & 2047;
  float* q = Q + (size_t)m * 1536 + h * 96 + 64;
  float x[32], o[32];
#pragma unroll
  for (int i = 0; i < 32; ++i) x[i] = q[i];
  rope32(x, o, l);
#pragma unroll
  for (int i = 0; i < 32; ++i) q[i] = o[i];
}
__global__ void __launch_bounds__(64) k_attn(const float* Q, const float* KV, const float* KPEALL, float* G) {
  int qi = blockIdx.x * 64 + threadIdx.x;
  int sh = blockIdx.y; int h = sh & 15, seq = sh >> 4;
  int L = seq < 16 ? 256 : 2048;
  if (qi >= L) return;
  int m = seq < 16 ? seq * 256 + qi : NPT + (seq - 16) * 2048 + qi;
  int kbase = seq < 16 ? seq * 256 : NPT + (seq - 16) * 2560;
  int nk = seq < 16 ? 256 : 2560;
  float q[96];
#pragma unroll
  for (int i = 0; i < 96; ++i) q[i] = Q[(size_t)m * 1536 + h * 96 + i];
  float acc[64];
#pragma unroll
  for (int i = 0; i < 64; ++i) acc[i] = 0.f;
  float mx = -1e30f, lsum = 0.f;
  const float scale = 0.10206207261596575f;
  for (int k = 0; k < nk; ++k) {
    const float* kv = KV + (size_t)(kbase + k) * 2048 + h * 128;
    const float* kp = KPEALL + (size_t)(kbase + k) * 32;
    float s = 0.f;
#pragma unroll
    for (int i = 0; i < 64; ++i) s += q[i] * kv[i];
#pragma unroll
    for (int i = 0; i < 32; ++i) s += q[64 + i] * kp[i];
    s *= scale;
    float mn = fmaxf(mx, s);
    float corr = expf(mx - mn), pe = expf(s - mn);
    lsum = lsum * corr + pe;
#pragma unroll
    for (int i = 0; i < 64; ++i) acc[i] = acc[i] * corr + pe * kv[64 + i];
    mx = mn;
  }
  float inv = 1.f / lsum;
#pragma unroll
  for (int i = 0; i < 64; ++i) { size_t o = (size_t)m * D + h * 64 + i; G[o] = acc[i] * inv * silu(G[o]); }
}

__global__ void __launch_bounds__(64) k_rw_scan(P p, const float* R, const float* K, const float* V, const float* HW, const float* HA, float* Y) {
  int id = blockIdx.x;
  int h = id & 15, dir = (id >> 4) & 1, seq = id >> 5;
  int lane = threadIdx.x;
  int L = seq < 16 ? 256 : 2048;
  int m0 = seq < 16 ? seq * 256 : NPT + (seq - 16) * 2048;
  int ch = h * 64 + lane;
  float S[64];
  if (seq < 16) {
#pragma unroll
    for (int j = 0; j < 64; ++j) S[j] = 0.f;
  } else {
    const float* s0 = p.state_rwkv + ((((size_t)(seq - 16) * 1 + 0) * 2 + dir) * 16 + h) * 4096 + (size_t)lane * 64;
#pragma unroll
    for (int j = 0; j < 64; ++j) S[j] = s0[j];
  }
  const float w0 = p.rw_w0[dir * D + ch], a0 = p.rw_a0[dir * D + ch];
  const float kkw = p.rw_k_k[ch], kaw = p.rw_k_a[ch];
  const float* w2 = p.rw_w2 + (size_t)dir * 64 * D + ch;
  const float* a2 = p.rw_a2 + (size_t)dir * 64 * D + ch;
  for (int st = 0; st < L; ++st) {
    int t = dir ? (L - 1 - st) : st;
    int m = m0 + t;
    float wl = w0, al = a0;
    const float* hw = HW + (size_t)m * 128 + dir * 64;
    const float* ha = HA + (size_t)m * 128 + dir * 64;
    for (int r = 0; r < 64; ++r) { wl += hw[r] * w2[(size_t)r * D]; al += ha[r] * a2[(size_t)r * D]; }
    float sp = (-wl > 20.f) ? -wl : log1pf(expf(-wl));
    float dec = expf(-expf(-sp - 0.5f));
    float a = sigmoidf(al);
    float k = K[(size_t)m * D + ch], r_ = R[(size_t)m * D + ch], v = V[(size_t)m * D + ch];
    float kk = k * kkw; float ss = kk * kk;
#pragma unroll
    for (int o = 1; o < 64; o <<= 1) ss += __shfl_xor(ss, o);
    kk *= rsqrtf(ss + 1e-12f);
    float kd = k * (1.f + (a - 1.f) * kaw);
    float bd = kk * a;
    float at = -kk;
    float sa = 0.f;
#pragma unroll
    for (int j = 0; j < 64; ++j) sa += S[j] * __shfl(at, j);
    float y = 0.f;
#pragma unroll
    for (int j = 0; j < 64; ++j) {
      float wj = __shfl(dec, j), bj = __shfl(bd, j), kj = __shfl(kd, j), rj = __shfl(r_, j);
      S[j] = S[j] * wj + sa * bj + v * kj;
      y += S[j] * rj;
    }
    atomicAdd(&Y[(size_t)m * D + ch], y);
  }
  if (seq < 16) {
    float* so = p.out + OUT_ST + ((((size_t)seq * 1 + 0) * 2 + dir) * 16 + h) * 4096 + (size_t)lane * 64;
#pragma unroll
    for (int j = 0; j < 64; ++j) so[j] = S[j];
  }
}
__global__ void __launch_bounds__(64) k_rw_post(P p, const float* R, const float* K, const float* V, const float* Z, const float* HA, const float* Y, float* G) {
  int m = blockIdx.x >> 4, h = blockIdx.x & 15, lane = threadIdx.x; int ch = h * 64 + lane;
  float y = Y[(size_t)m * D + ch];
  float s = y;
#pragma unroll
  for (int o = 1; o < 64; o <<= 1) s += __shfl_xor(s, o);
  float mu = s * (1.f / 64.f); float d = y - mu; float q = d * d;
#pragma unroll
  for (int o = 1; o < 64; o <<= 1) q += __shfl_xor(q, o);
  float yn = d * rsqrtf(q * (1.f / 64.f) + GN_EPS) * p.rw_gn_g[ch] + p.rw_gn_b[ch];
  float k = K[(size_t)m * D + ch], r_ = R[(size_t)m * D + ch], v = V[(size_t)m * D + ch];
  float bsum = 0.f;
  for (int dir = 0; dir < 2; ++dir) {
    float al = p.rw_a0[dir * D + ch];
    const float* ha = HA + (size_t)m * 128 + dir * 64;
    const float* a2 = p.rw_a2 + (size_t)dir * 64 * D + ch;
    for (int r = 0; r < 64; ++r) al += ha[r] * a2[(size_t)r * D];
    float a = sigmoidf(al);
    float kd = k * (1.f + (a - 1.f) * p.rw_k_a[ch]);
    bsum += r_ * kd * p.rw_r_k[ch];
  }
#pragma unroll
  for (int o = 1; o < 64; o <<= 1) bsum += __shfl_xor(bsum, o);
  float o_ = yn + bsum * v;
  G[(size_t)m * D + ch] = o_ * silu(Z[(size_t)m * D + ch]);
}

typedef unsigned short bf16_t;
namespace pg8 {
#define PG8_LAS __attribute__((address_space(3)))
typedef unsigned short bf16_t;
typedef short bf16x8 __attribute__((ext_vector_type(8)));
typedef float f32x4 __attribute__((ext_vector_type(4)));
typedef unsigned u32x4 __attribute__((ext_vector_type(4)));
constexpr int BM = 256, BK = 64, HALF = 128, HTB = HALF * BK * 2  , STAGE_BYTES = 8 * HTB, NXCD = 8, WGM = 8;

__host__ __device__ __forceinline__ int lds_byte(int r, int c) { const int st = (r >> 4) * 2 + (c >> 5), rr = r & 15, cc = c & 31, ob = rr * 64 + cc * 2; return st * 1024 + (ob ^ (((ob >> 9) & 1) << 5)); }
__host__ __device__ __forceinline__ void stage_rc(int b, int& R, int& C) { const int st = b / 1024, sb = b % 1024, swz = sb ^ (((sb >> 9) & 1) << 5); R = (st >> 1) * 16 + swz / 64; C = (st & 1) * 32 + (swz % 64) / 2; }
__host__ __device__ __forceinline__ int perm32(int rho) { const int n = rho >> 4, i = rho & 15; return 8 * (i >> 2) + 4 * n + (i & 3); }

struct Unit { int pm, pn; };
struct Gemm { const bf16_t* A; const bf16_t* Bt; int M, N, K; };

struct StaticOrder {
    int nM, nN, nwg, G, c;
    __host__ __device__ void init(int M, int N, int G_, int c_) { nM = M / BM; nN = N / BM; nwg = nM * nN; G = G_; c = c_; }
    __host__ __device__ bool next(int i, Unit& u) const {
        const long L = (long)i * G + c; if (L >= nwg) return false;
        int wgid = (int)L; { const int q = nwg / NXCD, r = nwg % NXCD, xcd = wgid % NXCD, off = wgid / NXCD; wgid = (xcd < r ? xcd * (q + 1) : r * (q + 1) + (xcd - r) * q) + off; }
        const int nig = WGM * nN, gid = wgid / nig, fm = gid * WGM, gsz = (nM - fm) < WGM ? (nM - fm) : WGM;
        u.pm = fm + ((wgid % nig) % gsz); u.pn = (wgid % nig) / gsz; return true;
    }
    __device__ __forceinline__ void a_ready(const Unit&) const {}
    __device__ __forceinline__ void done(const Unit&) const {}
};
__device__ __forceinline__ unsigned cvt_pk_bf16(float lo, float hi) { unsigned r; asm volatile("v_cvt_pk_bf16_f32 %0, %1, %2" : "=v"(r) : "v"(lo), "v"(hi)); return r; }
typedef float f32x2 __attribute__((ext_vector_type(2)));
template <int ACT  > struct EpiBf16 {
    static constexpr bool PERM = true, AFTER_DRAIN = false; static_assert(ACT == 0 || ACT == 1, "EpiBf16: ACT is 0 (none) or 1 (gelu_pk)");
    bf16_t* O; int ldc; const float* bias; int split_cols; size_t split_stride; float scale0;
    __device__ __forceinline__ void operator()(const f32x4 (&acc)[2][2][4][2], const Unit& u, int wr, int wc, int fr, int fq) const {
        const int row0 = u.pm * BM + wr * 64 + fr; int colt = u.pn * BM; bf16_t* base = O;
        float sc = 1.f; if (split_cols) { const int t = colt / split_cols; base += (size_t)t * split_stride; colt -= t * split_cols; if (t == 0) sc = scale0; }
        const int col0 = colt + wc * 32 + 8 * fq, bcol0 = u.pn * BM + wc * 32 + 8 * fq;
        f32x4 bv[2][2];
#pragma unroll
        for (int bj = 0; bj < 2; ++bj)
#pragma unroll
            for (int n = 0; n < 2; ++n) bv[bj][n] = bias ? *(const f32x4*)(bias + bcol0 + bj * HALF + 4 * n) : (f32x4){0.f, 0.f, 0.f, 0.f};
#pragma unroll
        for (int ai = 0; ai < 2; ++ai)
#pragma unroll
            for (int m = 0; m < 4; ++m) { bf16_t* rowp = base + (size_t)(row0 + ai * HALF + m * 16) * ldc + col0;
#pragma unroll
                for (int bj = 0; bj < 2; ++bj) { f32x4 v0 = acc[ai][bj][m][0] + bv[bj][0], v1 = acc[ai][bj][m][1] + bv[bj][1];
                    v0 = v0 * sc; v1 = v1 * sc; u32x4 w; w.x = cvt_pk_bf16(v0[0], v0[1]); w.y = cvt_pk_bf16(v0[2], v0[3]); w.z = cvt_pk_bf16(v1[0], v1[1]); w.w = cvt_pk_bf16(v1[2], v1[3]);
                    *(u32x4*)(rowp + bj * HALF) = w; } }
    }
};
template <class Epi, class Sched, bool ALIGN_EPI = false, bool SP2 = false>
__device__ __forceinline__ void gemm_phase(PG8_LAS unsigned char* lds, const Gemm g, const Sched& S, const Epi& E) {
    const int tid = threadIdx.x, wid = __builtin_amdgcn_readfirstlane(tid >> 6), lane = tid & 63, wr = wid >> 2, wc = wid & 3, fr = lane & 15, fq = lane >> 4;
    const int K = g.K, nt = K / BK;
    unsigned voffA[2], voffB[2];
#pragma unroll
    for (int i = 0; i < 2; ++i) { int R, C; stage_rc(tid * 16 + i * 8192, R, C); const int Rb = Epi::PERM ? ((R & ~31) + perm32(R & 31)) : R;
        voffA[i] = (unsigned)(R * K + C) * 2u; voffB[i] = (unsigned)(Rb * K + C) * 2u; }
    const size_t kstep = (size_t)(BK * 2);
    const size_t hstep = (size_t)HALF * K * 2;
    const size_t tstep = 2 * hstep;
    const unsigned ldsw = (unsigned)wid * 1024u;
    const int aoff = lds_byte(wr * 64 + fr, fq * 8), boff = lds_byte(wc * 32 + fr, fq * 8);
#define PG8_SA(b, h) (((b) * 2 + (h)) * HTB)
#define PG8_SB(b, h) ((4 + (b) * 2 + (h)) * HTB)
#define PG8_STAGE(bufoff, gbase, voff) do { _Pragma("unroll") for (int _i = 0; _i < 2; ++_i) \
        __builtin_amdgcn_global_load_lds((const unsigned*)((const char*)(gbase) + (voff)[_i]), (PG8_LAS unsigned*)(lds + (bufoff) + ldsw + _i * 8192), 16, 0, 0); } while (0)
#define PG8_LDA(dst, b, h) do { _Pragma("unroll") for (int m = 0; m < 4; ++m) _Pragma("unroll") for (int k = 0; k < 2; ++k) dst[m][k] = *(const PG8_LAS bf16x8*)(lds + PG8_SA(b, h) + aoff + m * 2048 + k * 1024); } while (0)
#define PG8_LDB(dst, b, h) do { _Pragma("unroll") for (int n = 0; n < 2; ++n) _Pragma("unroll") for (int k = 0; k < 2; ++k) dst[n][k] = *(const PG8_LAS bf16x8*)(lds + PG8_SB(b, h) + boff + n * 2048 + k * 1024); } while (0)
#define PG8_MMA(ai, bj, At, Bt) do { __builtin_amdgcn_s_setprio(1); _Pragma("unroll") for (int m = 0; m < 4; ++m) _Pragma("unroll") for (int n = 0; n < 2; ++n) _Pragma("unroll") for (int k = 0; k < 2; ++k) \
        acc[ai][bj][m][n] = __builtin_amdgcn_mfma_f32_16x16x32_bf16(Bt[n][k], At[m][k], acc[ai][bj][m][n], 0, 0, 0); __builtin_amdgcn_s_setprio(0); } while (0)
#define PG8_WAIT_V(n) asm volatile("s_waitcnt vmcnt(" #n ")" ::: "memory")
#define PG8_WAIT_L(n) asm volatile("s_waitcnt lgkmcnt(" #n ")" ::: "memory")
#define PG8_BAR __builtin_amdgcn_s_barrier()
#define PG8_SCHED __builtin_amdgcn_sched_barrier(0)
    Unit cur, nxt; int ui = 0;
    if (!S.next(0, cur)) return;
    f32x4 acc[2][2][4][2];
#pragma unroll
    for (int a = 0; a < 2; ++a)
#pragma unroll
        for (int b = 0; b < 2; ++b)
#pragma unroll
            for (int m = 0; m < 4; ++m)
#pragma unroll
                for (int n = 0; n < 2; ++n) acc[a][b][m][n] = (f32x4){0.f, 0.f, 0.f, 0.f};
    bf16x8 At[4][2], B0[2][2], B1[2][2];
    const char* cA = (const char*)g.A + (size_t)cur.pm * tstep; const char* cB = (const char*)g.Bt + (size_t)cur.pn * tstep;
    S.a_ready(cur);
    if constexpr (SP2) {
        PG8_STAGE(PG8_SB(0, 0), cB, voffB); PG8_STAGE(PG8_SB(0, 1), cB + hstep, voffB); PG8_STAGE(PG8_SA(0, 0), cA, voffA); PG8_STAGE(PG8_SA(0, 1), cA + hstep, voffA);
        if (wr == 1) PG8_BAR;
        PG8_WAIT_V(2); PG8_BAR;
        PG8_STAGE(PG8_SB(1, 0), cB + kstep, voffB); PG8_STAGE(PG8_SA(1, 0), cA + kstep, voffA); PG8_STAGE(PG8_SB(1, 1), cB + hstep + kstep, voffB);
        PG8_WAIT_V(6); PG8_BAR;
    } else {
        PG8_STAGE(PG8_SB(0, 0), cB, voffB); PG8_STAGE(PG8_SA(0, 0), cA, voffA); PG8_STAGE(PG8_SB(0, 1), cB + hstep, voffB); PG8_STAGE(PG8_SA(0, 1), cA + hstep, voffA);
        if (wr == 1) PG8_BAR;
        PG8_WAIT_V(4); PG8_BAR;
        PG8_STAGE(PG8_SB(1, 0), cB + kstep, voffB); PG8_STAGE(PG8_SA(1, 0), cA + kstep, voffA); PG8_STAGE(PG8_SB(1, 1), cB + hstep + kstep, voffB);
        PG8_WAIT_V(6); PG8_BAR;
    }
    for (;;) {
        const bool has_next = S.next(ui + 1, nxt);
        const char* nA = has_next ? (const char*)g.A + (size_t)nxt.pm * tstep : cA; const char* nB = has_next ? (const char*)g.Bt + (size_t)nxt.pn * tstep : cB;
        for (int t = 0; t < nt; t += 2) {
            const bool last = (t == nt - 2);
            const char* a1 = cA + (size_t)(t + 1) * kstep;
            const char* a2 = last ? nA : cA + (size_t)(t + 2) * kstep; const char* b2 = last ? nB : cB + (size_t)(t + 2) * kstep;
            const char* a3 = a2 + kstep; const char* b3 = b2 + kstep;
            if (last && has_next) S.a_ready(nxt);
            if constexpr (SP2) {
            PG8_LDB(B0, 0, 0); PG8_LDB(B1, 0, 1); PG8_SCHED; PG8_LDA(At, 0, 0); PG8_STAGE(PG8_SA(1, 1), a1 + hstep, voffA);
            PG8_WAIT_V(8); PG8_WAIT_L(0); PG8_BAR; PG8_MMA(0, 0, At, B0); PG8_MMA(0, 1, At, B1); PG8_BAR; PG8_SCHED;
            PG8_LDA(At, 0, 1); PG8_STAGE(PG8_SB(0, 0), b2, voffB); PG8_STAGE(PG8_SB(0, 1), b2 + hstep, voffB); PG8_STAGE(PG8_SA(0, 0), a2, voffA);
            PG8_WAIT_V(8); PG8_WAIT_L(0); PG8_BAR; PG8_MMA(1, 0, At, B0); PG8_MMA(1, 1, At, B1); PG8_BAR; PG8_SCHED;
            PG8_LDB(B0, 1, 0); PG8_LDB(B1, 1, 1); PG8_SCHED; PG8_LDA(At, 1, 0); PG8_STAGE(PG8_SA(0, 1), a2 + hstep, voffA);
            PG8_WAIT_V(8); PG8_WAIT_L(0); PG8_BAR; PG8_MMA(0, 0, At, B0); PG8_MMA(0, 1, At, B1); PG8_BAR; PG8_SCHED;
            PG8_LDA(At, 1, 1); PG8_STAGE(PG8_SB(1, 0), b3, voffB); PG8_STAGE(PG8_SB(1, 1), b3 + hstep, voffB); PG8_STAGE(PG8_SA(1, 0), a3, voffA);
            PG8_WAIT_V(8); PG8_WAIT_L(0); PG8_BAR; PG8_MMA(1, 0, At, B0); PG8_MMA(1, 1, At, B1); PG8_BAR; PG8_SCHED;
            } else {
            PG8_LDB(B0, 0, 0); PG8_SCHED; PG8_LDA(At, 0, 0); PG8_STAGE(PG8_SA(1, 1), a1 + hstep, voffA);
            PG8_WAIT_L(8); PG8_BAR; PG8_WAIT_L(0); PG8_MMA(0, 0, At, B0); PG8_BAR; PG8_SCHED;
            PG8_LDB(B1, 0, 1); PG8_STAGE(PG8_SB(0, 0), b2, voffB);
            PG8_BAR; PG8_WAIT_L(0); PG8_MMA(0, 1, At, B1); PG8_BAR;
            PG8_LDA(At, 0, 1); PG8_STAGE(PG8_SA(0, 0), a2, voffA);
            PG8_BAR; PG8_WAIT_L(0); PG8_MMA(1, 0, At, B0); PG8_BAR; PG8_SCHED;
            PG8_STAGE(PG8_SB(0, 1), b2 + hstep, voffB);
            PG8_WAIT_V(6); PG8_BAR; PG8_MMA(1, 1, At, B1); PG8_BAR;
            PG8_LDB(B0, 1, 0); PG8_SCHED; PG8_LDA(At, 1, 0); PG8_STAGE(PG8_SA(0, 1), a2 + hstep, voffA);
            PG8_WAIT_L(8); PG8_BAR; PG8_WAIT_L(0); PG8_MMA(0, 0, At, B0); PG8_BAR; PG8_SCHED;
            PG8_LDB(B1, 1, 1); PG8_STAGE(PG8_SB(1, 0), b3, voffB);
            PG8_BAR; PG8_WAIT_L(0); PG8_MMA(0, 1, At, B1); PG8_BAR;
            PG8_LDA(At, 1, 1); PG8_STAGE(PG8_SA(1, 0), a3, voffA);
            PG8_BAR; PG8_WAIT_L(0); PG8_MMA(1, 0, At, B0); PG8_BAR; PG8_SCHED;
            PG8_STAGE(PG8_SB(1, 1), b3 + hstep, voffB);
            PG8_WAIT_V(6); PG8_BAR; PG8_MMA(1, 1, At, B1); PG8_BAR;
            }
        }
        if constexpr (ALIGN_EPI) { if (wr == 0) PG8_BAR; }
        if constexpr (!Epi::AFTER_DRAIN) { E(acc, cur, wr, wc, fr, fq); S.done(cur); }
        if (!has_next) break;
#pragma unroll
        for (int a = 0; a < 2; ++a)
#pragma unroll
            for (int b = 0; b < 2; ++b)
#pragma unroll
                for (int m = 0; m < 4; ++m)
#pragma unroll
                    for (int n = 0; n < 2; ++n) acc[a][b][m][n] = (f32x4){0.f, 0.f, 0.f, 0.f};
        cur = nxt; cA = nA; cB = nB; ++ui;
        if constexpr (ALIGN_EPI) { if (wr == 1) PG8_BAR; }
    }
    PG8_WAIT_V(0);
    if constexpr (!ALIGN_EPI) { if (wr == 0) PG8_BAR; }
    PG8_BAR;
    if constexpr (Epi::AFTER_DRAIN) { E.fused(acc, cur, wr, wc, fr, fq, lds, wid, lane); S.done(cur); }
#undef PG8_SA
#undef PG8_SB
#undef PG8_STAGE
#undef PG8_LDA
#undef PG8_LDB
#undef PG8_MMA
#undef PG8_WAIT_V
#undef PG8_WAIT_L
#undef PG8_BAR
#undef PG8_SCHED
}
}
#define GAS __attribute__((address_space(1)))
#define LAS __attribute__((address_space(3)))
typedef unsigned short bf16;
typedef unsigned v4u __attribute__((ext_vector_type(4)));
typedef float f32x4 __attribute__((ext_vector_type(4)));
typedef short bf16x8 __attribute__((ext_vector_type(8)));
typedef GAS unsigned gu32;
typedef GAS unsigned long long gu64;
#define RLX_AGENT __ATOMIC_RELAXED, __HIP_MEMORY_SCOPE_AGENT
#define LDS_WAIT() asm volatile("s_waitcnt lgkmcnt(0)" ::: "memory")
#define VM_WAIT() asm volatile("s_waitcnt vmcnt(0)" ::: "memory")
__device__ __forceinline__ unsigned long long rt() { return __builtin_amdgcn_s_memrealtime(); }
__device__ __forceinline__ unsigned f2bf(float f) { unsigned u = __builtin_bit_cast(unsigned, f); return (u + 0x7fffu + ((u >> 16) & 1u)) >> 16; }
__device__ __forceinline__ unsigned pk2(float lo, float hi) { return f2bf(lo) | (f2bf(hi) << 16); }

#define XB_TMO      128
#define XB_XCNT(j)  (256  + 64 * (j))
#define XB_XSUB(j)  (1280 + 64 * (j))
#define XB_XGEN(j)  (2304 + 64 * (j))
#define XB_TOP      3328
#define XB_TOPGEN   3392
#define XCD_BAR_WORDS 3456
#define XB_SPIN_CAP (1u << 18)

__device__ __forceinline__ unsigned xb_ld(unsigned* p)              { return __hip_atomic_load(p, __ATOMIC_RELAXED, __HIP_MEMORY_SCOPE_AGENT); }
__device__ __forceinline__ unsigned xb_add(unsigned* p, unsigned v) { return __hip_atomic_fetch_add(p, v, __ATOMIC_RELAXED, __HIP_MEMORY_SCOPE_AGENT); }
__device__ __forceinline__ unsigned xb_xcc_id() { return (unsigned)__builtin_amdgcn_s_getreg((3 << 11) | 20) & 0xFu; }
#define XB_SPIN(cond, bar) do { unsigned _sp = 0; while (cond) { __builtin_amdgcn_s_sleep(1); \
    if ((++_sp & 255u) == 0u) { if (xb_ld(&(bar)[XB_TMO])) break; if (_sp > XB_SPIN_CAP) { atomicAdd(&(bar)[XB_TMO], 1u); break; } } } } while (0)

struct XcdBarrier {
    unsigned* bar; unsigned x;
    volatile LAS unsigned* st;
};

__device__ __forceinline__ XcdBarrier xcd_barrier_post(unsigned* bar, volatile LAS unsigned* st) {
    XcdBarrier b; b.bar = bar; b.x = xb_xcc_id(); b.st = st;
    if (threadIdx.x == 0) (void)xb_add(&bar[XB_XCNT(b.x)], 1u);
    return b;
}
__device__ __forceinline__ void xcd_barrier_complete(unsigned* bar, unsigned x, unsigned& nloc, unsigned& nx) {
    const unsigned G = gridDim.x * gridDim.y * gridDim.z;
    unsigned sum, cnt, mine, sp = 0u;
    for (;;) {
        sum = 0u; cnt = 0u; mine = 0u;
#pragma unroll
        for (unsigned j = 0; j < 16; ++j) { const unsigned c = xb_ld(&bar[XB_XCNT(j)]); sum += c; cnt += (c > 0u) ? 1u : 0u; mine = (j == x) ? c : mine; }
        if (sum == G) break;
        __builtin_amdgcn_s_sleep(1);
        if ((++sp & 255u) == 0u) { if (xb_ld(&bar[XB_TMO])) break; if (sp > XB_SPIN_CAP) { atomicAdd(&bar[XB_TMO], 1u); break; } }
    }
    nloc = mine > 0u ? mine : 1u; nx = cnt > 0u ? cnt : 1u;
}

__device__ __forceinline__ void xcd_barrier(const XcdBarrier& b) {
    asm volatile("s_waitcnt vmcnt(0)" ::: "memory");
    __syncthreads();
    if (threadIdx.x == 0) {
        unsigned* bar = b.bar;
        __builtin_amdgcn_s_waitcnt(0);
        unsigned nloc = b.st[0], nx = b.st[1];
        if (nloc == 0u) { xcd_barrier_complete(bar, b.x, nloc, nx); b.st[0] = nloc; b.st[1] = nx; }
        const unsigned old = xb_add(&bar[XB_XSUB(b.x)], 1u);
        const unsigned gen = old / nloc;
        if (old + 1u == (gen + 1u) * nloc) {
            __builtin_amdgcn_fence(__ATOMIC_RELEASE, "agent");
            asm volatile("s_waitcnt vmcnt(0)" ::: "memory");
            const unsigned og = xb_add(&bar[XB_TOP], 1u);
            const unsigned tg = og / nx;
            if (og + 1u == (tg + 1u) * nx) xb_add(&bar[XB_TOPGEN], 1u);
            else XB_SPIN(xb_ld(&bar[XB_TOPGEN]) == tg, bar);
            __builtin_amdgcn_fence(__ATOMIC_ACQUIRE, "agent");
            xb_add(&bar[XB_XGEN(b.x)], 1u);
            asm volatile("s_waitcnt vmcnt(0)" ::: "memory");
        } else {
            XB_SPIN(xb_ld(&bar[XB_XGEN(b.x)]) == gen, bar);
            __builtin_amdgcn_fence(__ATOMIC_ACQUIRE, "agent");
            asm volatile("s_waitcnt vmcnt(0)" ::: "memory");
        }
    }
    __syncthreads();
}
typedef __attribute__((address_space(1))) float GASF;
struct PG {
  const GASF *x_prompt, *x_sample, *cache_ckv, *cache_kpe, *state_rwkv, *c, *c_ctx;
  const GASF *mod_w, *mod_b, *ln_g, *ln_b;
  const GASF *hy_w_in, *hy_conv_w, *hy_conv_b, *hy_w1, *hy_b1, *hy_w2, *hy_b2, *hy_w3, *hy_b3, *hy_freq, *hy_decay, *hy_skip, *hy_w_out;
  const GASF *mla_w_in, *mla_q_norm, *mla_kv_norm, *mla_w_q_up, *mla_w_kv_up, *mla_w_out;
  const GASF *rw_mu, *rw_w_in, *rw_w0, *rw_w1, *rw_w2, *rw_a0, *rw_a1, *rw_a2, *rw_k_k, *rw_k_a, *rw_r_k, *rw_gn_g, *rw_gn_b, *rw_w_out;
  GASF* out;
  GASF* ws;
};
namespace mk {
typedef float f32x16 __attribute__((ext_vector_type(16)));
typedef short v4i16_t __attribute__((ext_vector_type(4)));
typedef unsigned u32x4 __attribute__((ext_vector_type(4)));
typedef unsigned u32x2 __attribute__((ext_vector_type(2)));
typedef unsigned short u16;

constexpr size_t MiB = 1u << 20;
constexpr size_t M_X = 0, M_HB = 32 * MiB, M_GB = 48 * MiB, M_UT = 64 * MiB, M_SCR2 = 128 * MiB, M_WTS = 192 * MiB, M_FILT = 230 * MiB;
constexpr size_t M_HDN2 = 248 * MiB + 512 * 1024, M_MODP = 250 * MiB, M_MODS = 254 * MiB, M_CTL = 255 * MiB;
constexpr size_t W_HYIN = M_WTS, W_HYOUT = M_WTS + 16 * MiB, W_MLAIN = M_WTS + 20 * MiB, W_QUP = M_WTS + 23 * MiB, W_KVUP = M_WTS + 24 * MiB,
                 W_MLAOUT = M_WTS + 25 * MiB, W_RWIN = M_WTS + 27 * MiB, W_LORA1 = M_WTS + 35 * MiB, W_RWOUT = M_WTS + 36 * MiB;
constexpr size_t M_U2S = M_SCR2 + 24 * MiB;
constexpr size_t M_QN = M_SCR2, M_CKVALL = M_SCR2 + 4 * MiB, M_KPEB = M_SCR2 + 7 * MiB, M_SZB = M_SCR2 + 8 * MiB, M_Q = M_UT, M_KN = M_UT + 24 * MiB, M_V = M_UT + 42 * MiB;
constexpr int FILT_CH = 4640;
constexpr int LDS_BYTES = 163840, MISC_OFF = LDS_BYTES - 512, PTAB_OFF = LDS_BYTES - 1024;

__device__ __forceinline__ float bf2f(unsigned v) { return __builtin_bit_cast(float, v << 16); }
typedef float f32x2_t __attribute__((ext_vector_type(2))); typedef __bf16 bf16x2_t __attribute__((ext_vector_type(2)));
__device__ __forceinline__ unsigned pk2_(float lo, float hi) { const f32x2_t v = {lo, hi}; const bf16x2_t b = __builtin_convertvector(v, bf16x2_t); return __builtin_bit_cast(unsigned, b); }
__device__ __forceinline__ unsigned f2bf_(float f) { return pk2_(f, 0.f) & 0xffffu; }
__device__ __forceinline__ v4i16_t vtr(LAS const unsigned char* p) { return __builtin_amdgcn_ds_read_tr16_b64_v4i16((LAS v4i16_t*)p); }
template <class T> __device__ __forceinline__ T* uni(T* p) {
  const unsigned long long v = (unsigned long long)p;
  const unsigned lo = __builtin_amdgcn_readfirstlane((unsigned)v), hi = __builtin_amdgcn_readfirstlane((unsigned)(v >> 32));
  return (T*)(((unsigned long long)hi << 32) | lo);
}
__device__ __forceinline__ float wsum(float v) {
#pragma unroll
  for (int o = 1; o < 64; o <<= 1) v += __shfl_xor(v, o);
  return v;
}
__device__ __forceinline__ const GASF* xrow_in(const LAS PG& p, int layer, const unsigned char* ws, int m) {
  if (layer == 0) return (m < NPT) ? p.x_prompt + (size_t)m * D : p.x_sample + (size_t)(m - NPT) * D;
  if (layer == 2) return p.out + OUT_Y + (size_t)m * D;
  return (const GASF*)(ws + M_X) + (size_t)m * D;
}

__device__ __forceinline__ void tr_item(const GASF* W, int K, int N, bf16_t* WT, int kind, int row_off, int remap416, LAS float* scr, int item, int lane) {
  const int nblk = N / 32, kb = item / nblk, nb = item % nblk, k0 = 64 * kb, n0 = 32 * nb;
  {
    const GAS f32x4* src = (const GAS f32x4*)(W + (size_t)(k0 + (lane >> 3)) * N + n0 + 4 * (lane & 7));
    f32x4 v[8];
#pragma unroll
    for (int i = 0; i < 8; ++i) v[i] = src[(size_t)i * 2 * N];
#pragma unroll
    for (int i = 0; i < 8; ++i) { LAS float* d = scr + (8 * i + (lane >> 3)) * 33 + 4 * (lane & 7); d[0] = v[i].x; d[1] = v[i].y; d[2] = v[i].z; d[3] = v[i].w; }
  }
  asm volatile("s_waitcnt lgkmcnt(0)" ::: "memory");
  const int c = lane & 7;
#pragma unroll
  for (int jj = 0; jj < 4; ++jj) {
    const int n = (lane >> 3) + 8 * jj; LAS const float* s = scr + (8 * c) * 33 + n;
    u32x4 o; o.x = pk2_(s[0 * 33], s[1 * 33]); o.y = pk2_(s[2 * 33], s[3 * 33]); o.z = pk2_(s[4 * 33], s[5 * 33]); o.w = pk2_(s[6 * 33], s[7 * 33]);
    const int ng = n0 + n + row_off;
    if (kind == 0) {
      *(u32x4*)(WT + (size_t)ng * K + k0 + 8 * c) = o;
    } else {
      const int k8 = (k0 >> 3) + c;
      const size_t ci = ((size_t)((ng >> 5) * 64 + (k8 >> 1))) * 64 + (ng & 31) + 32 * (k8 & 1);
      *(u32x4*)(WT + ci * 8) = o;
    }
  }
  asm volatile("s_waitcnt lgkmcnt(0)" ::: "memory");
}

__device__ __forceinline__ void phase_p0a(const LAS PG& p, unsigned char* ws, LAS unsigned char* lds, int tid, int lane, int wave, int bid, int G) {
  LAS float* SC = (LAS float*)lds;
  for (int i = tid; i < 3072; i += 512) { const int g = i >> 10, k = i & 1023; const float c = (g == 0) ? p.c_ctx[k] : p.c[(g - 1) * 1024 + k]; SC[i] = silu(c); }
  __syncthreads();
  LAS float* RED = (LAS float*)lds + 3072;
  for (int it = bid; it < 96; it += G) {
    const int kc = it & 7, cc = (it >> 3) % 3, i = it / 24;
    const int c4 = tid & 255, kh = tid >> 8;
    const int n = cc * 1024 + 4 * c4;
    const GAS f32x4* w = (const GAS f32x4*)(p.mod_w + ((size_t)i * 1024 + kc * 128 + kh * 64) * 3072 + n);
    f32x4 a0 = (f32x4){0.f, 0.f, 0.f, 0.f}, a1 = a0, a2 = a0;
#pragma unroll 8
    for (int k = 0; k < 64; ++k) { const f32x4 wv = w[(size_t)k * 768]; const int kk = kc * 128 + kh * 64 + k; a0 += SC[kk] * wv; a1 += SC[1024 + kk] * wv; a2 += SC[2048 + kk] * wv; }
    if (kh == 1) { LAS f32x4* r = (LAS f32x4*)(RED + c4 * 12); r[0] = a0; r[1] = a1; r[2] = a2; }
    __syncthreads();
    if (kh == 0) {
      LAS const f32x4* r = (LAS const f32x4*)(RED + c4 * 12);
      float* mp = (float*)(ws + M_MODP) + (size_t)kc * 36864 + (size_t)i * 9216 + n;
      *(f32x4*)mp = a0 + r[0]; *(f32x4*)(mp + 3072) = a1 + r[1]; *(f32x4*)(mp + 6144) = a2 + r[2];
    }
    __syncthreads();
  }
  __syncthreads();
  for (int i = bid * 512 + tid; i < 12288; i += G * 512) *(u32x4*)(ws + W_MLAIN + (size_t)416 * 2048 + (size_t)i * 16) = (u32x4){0u, 0u, 0u, 0u};
  for (int i = bid * 512 + tid; i < 2 * PAST * 128 / 8; i += G * 512) {
    const int d8 = i & 15, pl = (i >> 4) & 511, b = i >> 13;
    const f32x4* src = (const f32x4*)(p.cache_ckv + ((size_t)(b * PAST + pl)) * 128 + d8 * 8);
    const f32x4 x0 = src[0], x1 = src[1];
    u32x4 o; o.x = pk2_(x0.x, x0.y); o.y = pk2_(x0.z, x0.w); o.z = pk2_(x1.x, x1.y); o.w = pk2_(x1.z, x1.w);
    *(u32x4*)((bf16_t*)(ws + M_CKVALL) + ((size_t)(NPT + b * 2560 + pl)) * 128 + d8 * 8) = o;
    if (d8 < 4) {
      const f32x4* s2 = (const f32x4*)(p.cache_kpe + ((size_t)(b * PAST + pl)) * 32 + d8 * 8);
      const f32x4 y0 = s2[0], y1 = s2[1];
      u32x4 o2; o2.x = pk2_(y0.x, y0.y); o2.y = pk2_(y0.z, y0.w); o2.z = pk2_(y1.x, y1.y); o2.w = pk2_(y1.z, y1.w);
      *(u32x4*)((bf16_t*)(ws + M_KPEB) + ((size_t)(NPT + b * 2560 + pl)) * 32 + d8 * 8) = o2;
    }
  }
  LAS float* scr = (LAS float*)(lds + wave * 16384);
  const int gw = bid * 8 + wave, NGW = G * 8;
  constexpr int I_HYIN = 16 * 128, I_SQ = 16 * 32, I_MLAIN = 16 * 45, I_QUP = 4 * 48, I_KVUP = 2 * 64, I_LORA = 16 * 2;
  constexpr int NTR = 2 * I_HYIN + 2 * I_SQ + I_MLAIN + I_QUP + I_KVUP + I_SQ + 4 * I_SQ + 4 * I_LORA + I_SQ;
  constexpr int NHD = 2 * 144;
  for (int it = gw; it < NTR + NHD; it += NGW) {
    int r = it;
    if (r < NTR) {
      if (r < 2 * I_HYIN) { const int j = r / I_HYIN; tr_item(p.hy_w_in + (size_t)j * D * 4096, 1024, 4096, (bf16_t*)(ws + W_HYIN + (size_t)j * 8 * MiB), 0, 0, 0, scr, r % I_HYIN, lane); continue; } r -= 2 * I_HYIN;
      if (r < 2 * I_SQ) { const int j = r / I_SQ; tr_item(p.hy_w_out + (size_t)j * D * D, 1024, 1024, (bf16_t*)(ws + W_HYOUT + (size_t)j * 2 * MiB), 1, 0, 0, scr, r % I_SQ, lane); continue; } r -= 2 * I_SQ;
      if (r < I_MLAIN) { const int nb = r % 45; if (nb < 13) tr_item(p.mla_w_in, 1024, 1440, (bf16_t*)(ws + W_MLAIN), 0, 0, 0, scr, r, lane);
        else tr_item(p.mla_w_in, 1024, 1440, (bf16_t*)(ws + W_MLAIN + MiB), 0, -416, 0, scr, r, lane); continue; } r -= I_MLAIN;
      if (r < I_QUP) { tr_item(p.mla_w_q_up, 256, 1536, (bf16_t*)(ws + W_QUP), 0, 0, 0, scr, r, lane); continue; } r -= I_QUP;
      if (r < I_KVUP) { tr_item(p.mla_w_kv_up, 128, 2048, (bf16_t*)(ws + W_KVUP), 0, 0, 0, scr, r, lane); continue; } r -= I_KVUP;
      if (r < I_SQ) { tr_item(p.mla_w_out, 1024, 1024, (bf16_t*)(ws + W_MLAOUT), 1, 0, 0, scr, r, lane); continue; } r -= I_SQ;
      if (r < 4 * I_SQ) { const int q = r / I_SQ; tr_item(p.rw_w_in + (size_t)q * D * D, 1024, 1024, (bf16_t*)(ws + W_RWIN + (size_t)q * 2 * MiB), 0, 0, 0, scr, r % I_SQ, lane); continue; } r -= 4 * I_SQ;
      if (r < 4 * I_LORA) { const int q = r / I_LORA; const GASF* src = (q < 2) ? p.rw_w1 + (size_t)q * D * 64 : p.rw_a1 + (size_t)(q - 2) * D * 64;
        tr_item(src, 1024, 64, (bf16_t*)(ws + W_LORA1), 1, q * 64, 0, scr, r % I_LORA, lane); continue; } r -= 4 * I_LORA;
      tr_item(p.rw_w_out, 1024, 1024, (bf16_t*)(ws + W_RWOUT), 1, 0, 0, scr, r, lane);
    } else {
      r -= NTR;
      const int j = r / 144, row0 = (r % 144) * 16;
      float w1c[33];
      {
        const GASF* w1b = p.hy_w1 + (size_t)j * 33 * 64 + lane; const GASF* w2b = p.hy_w2 + (size_t)j * 64 * 64 + lane;
        asm volatile("s_waitcnt lgkmcnt(0)" ::: "memory");
#pragma unroll 8
        for (int f = 0; f < 33; ++f) { scr[f * 64 + lane] = *w1b; w1b += 64; }
        asm volatile("s_waitcnt lgkmcnt(0)" ::: "memory");
#pragma unroll
        for (int f = 0; f < 33; ++f) w1c[f] = scr[f * 64 + lane];
        asm volatile("s_waitcnt lgkmcnt(0)" ::: "memory");
#pragma unroll 8
        for (int f = 0; f < 64; ++f) { scr[f * 64 + lane] = *w2b; w2b += 64; }
        asm volatile("s_waitcnt lgkmcnt(0)" ::: "memory");
      }
      const float b1 = p.hy_b1[j * 64 + lane], b2 = p.hy_b2[j * 64 + lane], f0 = p.hy_freq[(j * 2 + 0) * 64 + lane], f1 = p.hy_freq[(j * 2 + 1) * 64 + lane];
#pragma unroll 1
      for (int rr = 0; rr < 16; ++rr) {
        const int row = row0 + rr;
        const int L = row < 256 ? 256 : 2048, l = row < 256 ? row : row - 256;
        const float t = (float)l / (float)(L - 1);
        float feat = 0.f;
        if (lane == 0) feat = t;
        else if (lane < 33) {
          const int b = (lane - 1) & 15;
          const float band = 1e-4f + (float)b * ((15.f - 1e-4f) / 15.f);
          const float ang = (6.283185307179586f / (float)L) * (float)l * band;
          feat = (lane <= 16) ? cosf(ang) : -sinf(ang);
        }
        float a = b1;
#pragma unroll
        for (int f = 0; f < 33; ++f) a += __shfl(feat, f) * w1c[f];
        const float h1 = sinf(f0 * a);
        float a2 = b2;
#pragma unroll 8
        for (int f = 0; f < 64; ++f) a2 += __shfl(h1, f) * scr[f * 64 + lane];
        const float h2 = sinf(f1 * a2);
        ((float*)(ws + M_HDN2))[((size_t)j * 2304 + row) * 64 + lane] = h2;
      }
    }
  }
}

__device__ __forceinline__ void phase_p0b(const LAS PG& p, unsigned char* ws, LAS unsigned char* lds, int tid, int lane, int wave, int bid, int G) {
  const float* MP = (const float*)(ws + M_MODP);
  float* MODS = (float*)(ws + M_MODS);
  for (int idx = bid * 512 + tid; idx < 36864; idx += G * 512) {
    float s = p.mod_b[(idx / 9216) * 3072 + (idx % 3072)];
#pragma unroll
    for (int kc = 0; kc < 8; ++kc) s += MP[(size_t)kc * 36864 + idx];
    MODS[idx] = s;
  }
  LAS float* ML = (LAS float*)lds;
  for (int e = tid; e < 6144; e += 512) {
    const int g = e >> 11, r = e & 2047; const int idx = g * 3072 + r;
    float s = p.mod_b[r];
#pragma unroll
    for (int kc = 0; kc < 8; ++kc) s += MP[(size_t)kc * 36864 + idx];
    ML[e] = s;
  }
  __syncthreads();
  bf16_t* HB = (bf16_t*)(ws + M_HB);
#ifndef NO_H0
  for (int m = bid * 8 + wave; m < NTOK; m += G * 8) {
    int l, L, cond, m0; tokinfo(m, l, L, cond, m0);
    const GAS f32x4* xr = (const GAS f32x4*)xrow_in(p, 0, ws, m);
    LAS const float* sh = ML + cond * 2048; LAS const float* sc = sh + 1024;
#pragma unroll
    for (int i = 0; i < 4; ++i) {
      const int k = 4 * lane + 256 * i; const f32x4 x = xr[lane + 64 * i];
      u32x2 o; o.x = pk2_(x.x * (1.f + sc[k]) + sh[k], x.y * (1.f + sc[k + 1]) + sh[k + 1]); o.y = pk2_(x.z * (1.f + sc[k + 2]) + sh[k + 2], x.w * (1.f + sc[k + 3]) + sh[k + 3]);
      *(u32x2*)(HB + (size_t)m * D + k) = o;
    }
  }
#endif
  __syncthreads();
#ifndef NO_FG
  LAS float* hs = (LAS float*)(lds + wave * 2048);
  const int gw = bid * 8 + wave, NGW = G * 8;
  const float* HD = (const float*)(ws + M_HDN2);
  bf16_t* FILT = (bf16_t*)(ws + M_FILT);
  for (int wslot = gw; wslot < 64 * 32; wslot += NGW) {
    const int combo = wslot & 63, sub = wslot >> 6;
    const int cch = combo & 15, dir = (combo >> 4) & 1, j = combo >> 5;
    const int c = cch * 64 + lane, o = dir * 1024 + c;
    LAS float* w3s = (LAS float*)(lds + 16384 + wave * 16384);
    {
      const GASF* w3 = p.hy_w3 + ((size_t)j * 64 * 2048 + dir * 1024 + cch * 64 + lane);
      asm volatile("s_waitcnt lgkmcnt(0)" ::: "memory");
#pragma unroll 8
      for (int m = 0; m < 64; ++m) { w3s[m * 64 + lane] = *w3; w3 += 2048; }
      asm volatile("s_waitcnt lgkmcnt(0)" ::: "memory");
    }
    const float b3 = p.hy_b3[j * 2048 + o];
    const float dec = fabsf(p.hy_decay[(size_t)j * 2048 + o]);
    const float skip = p.hy_skip[j * D + c];
#pragma unroll 1
    for (int qq = sub; qq < 290; qq += 32) {
    const int set = qq < 33 ? 0 : 1, qi = set ? qq - 33 : qq, L = set ? 2048 : 256, row0 = set ? 256 : 0;
    asm volatile("s_waitcnt lgkmcnt(0)" ::: "memory");
#pragma unroll
    for (int e = 0; e < 8; ++e) {
      const int lag = dir ? 8 * qi + e : 8 * qi - e;
      const bool ok = dir ? (lag >= 1 && lag <= L - 1) : (lag >= 0 && lag <= L - 1);
      hs[e * 64 + lane] = ok ? HD[((size_t)j * 2304 + row0 + lag) * 64 + lane] : 0.f;
    }
    asm volatile("s_waitcnt lgkmcnt(0)" ::: "memory");
    float acc[8];
#pragma unroll
    for (int e = 0; e < 8; ++e) acc[e] = b3;
#pragma unroll 2
    for (int m4 = 0; m4 < 16; ++m4) {
      const float w0 = w3s[(4 * m4 + 0) * 64 + lane], w1 = w3s[(4 * m4 + 1) * 64 + lane], w2 = w3s[(4 * m4 + 2) * 64 + lane], w3v = w3s[(4 * m4 + 3) * 64 + lane];
#pragma unroll
      for (int e = 0; e < 8; ++e) {
        const f32x4 h4 = *(LAS const f32x4*)(hs + e * 64 + 4 * m4);
        acc[e] += h4.x * w0 + h4.y * w1 + h4.z * w2 + h4.w * w3v;
      }
    }
    unsigned vb[8];
#pragma unroll
    for (int e = 0; e < 8; ++e) {
      const int lag = dir ? 8 * qi + e : 8 * qi - e;
      const bool ok = dir ? (lag >= 1 && lag <= L - 1) : (lag >= 0 && lag <= L - 1);
      const float t = (float)lag / (float)(L - 1);
      float v = acc[e] * expf(-t * dec);
      if (!dir && lag == 0) v += skip;
      vb[e] = ok ? f2bf_(v) : 0u;
    }
    bf16_t* dst = FILT + ((size_t)(j * 1024 + c)) * FILT_CH + (set ? 528 : 0) + (dir ? 8 * qi : -8 * qi) + L + 8;
    if (qi != 0) {
      u32x4 ov; ov.x = vb[0] | (vb[1] << 16); ov.y = vb[2] | (vb[3] << 16); ov.z = vb[4] | (vb[5] << 16); ov.w = vb[6] | (vb[7] << 16);
      *(u32x4*)dst = ov;
    } else if (!dir) {
      dst[0] = (bf16_t)vb[0];
    } else {
#pragma unroll
      for (int e = 1; e < 8; ++e) dst[e] = (bf16_t)vb[e];
    }
    }
  }
#endif
}
constexpr int FK_S = 0, FK_P = 65920, VBS = 74368, VBP = 91776, VB_END = 118400, E_OFF = 118400, SCR_S = 0, SCR_P = 65536;
__device__ __forceinline__ float conv3e(float pv, float cur, float nx, float w0, float w1, float w2, float b) { return pv * w0 + cur * w1 + nx * w2 + b; }

__device__ __forceinline__ void phase_hy_conv(const LAS PG& p, unsigned char* ws, LAS unsigned char* lds, int j, int tid, int lane, int wave, int bid, int G) {
  const bf16_t* UT = (const bf16_t*)(ws + M_UT);
  bf16_t* GT = (bf16_t*)(ws + M_GB);
  const bf16_t* FILT = (const bf16_t*)(ws + M_FILT);
  const int r = lane & 31, h = lane >> 5, rho = (-r) & 7;
  for (int c = bid; c < 1024; c += G) {
    __syncthreads();
    for (int i = tid; i < (VB_END - VBS) / 16; i += 512) *(LAS u32x4*)(lds + VBS + i * 16) = (u32x4){0u, 0u, 0u, 0u};
    __syncthreads();
    {
      const GASF* cw = p.hy_conv_w + (size_t)j * 3 * 3072; const GASF* cb = p.hy_conv_b + (size_t)j * 3072;
      const float a0 = cw[c], a1 = cw[3072 + c], a2 = cw[6144 + c], ab = cb[c];
      const float b0 = cw[1024 + c], b1 = cw[3072 + 1024 + c], b2 = cw[6144 + 1024 + c], bb = cb[1024 + c];
      const float v0 = cw[2048 + c], v1 = cw[3072 + 2048 + c], v2 = cw[6144 + 2048 + c], vbb = cb[2048 + c];
      for (int ch = tid; ch < 1024; ch += 512) {
        const int tok = ch * 8;
        int l, L; unsigned dst;
        if (tok < NPT) { l = tok & 255; L = 256; const int chunk = 32 + (l >> 3); dst = VBP + (tok >> 8) * 1664 + (chunk + (chunk >> 4)) * 16; }
        else { const int mm = tok - NPT; l = mm & 2047; L = 2048; const int chunk = 128 + (l >> 3); dst = VBS + (mm >> 11) * 8704 + (chunk + (chunk >> 4)) * 16; }
        const bf16_t* r0 = UT + (size_t)c * 8192 + tok; const bf16_t* r1 = r0 + (size_t)1024 * 8192; const bf16_t* r2 = r0 + (size_t)2048 * 8192; const bf16_t* r3 = r0 + (size_t)3072 * 8192;
        const u32x4 X0 = *(const u32x4*)r0, X1 = *(const u32x4*)r1, XV = *(const u32x4*)r2, XZ = *(const u32x4*)r3;
        const bool hp = l > 0, hn = (l + 8) < L;
        const float p0 = hp ? bf2f(r0[-1]) : 0.f, p1 = hp ? bf2f(r1[-1]) : 0.f, p2 = hp ? bf2f(r2[-1]) : 0.f;
        const float n0 = hn ? bf2f(r0[8]) : 0.f, n1 = hn ? bf2f(r1[8]) : 0.f, n2 = hn ? bf2f(r2[8]) : 0.f;
        float x0[10], x1[10], xv[10], z[8];
        x0[0] = p0; x1[0] = p1; xv[0] = p2; x0[9] = n0; x1[9] = n1; xv[9] = n2;
#pragma unroll
        for (int e = 0; e < 4; ++e) {
          x0[1 + 2 * e] = bf2f(X0[e] & 0xffffu); x0[2 + 2 * e] = bf2f(X0[e] >> 16);
          x1[1 + 2 * e] = bf2f(X1[e] & 0xffffu); x1[2 + 2 * e] = bf2f(X1[e] >> 16);
          xv[1 + 2 * e] = bf2f(XV[e] & 0xffffu); xv[2 + 2 * e] = bf2f(XV[e] >> 16);
          z[2 * e] = bf2f(XZ[e] & 0xffffu); z[2 * e + 1] = bf2f(XZ[e] >> 16);
        }
        float vv[8], ev[8];
#pragma unroll
        for (int e = 0; e < 8; ++e) {
          const float c0 = conv3e(x0[e], x0[e + 1], x0[e + 2], a0, a1, a2, ab);
          const float c1 = conv3e(x1[e], x1[e + 1], x1[e + 2], b0, b1, b2, bb);
          const float cv = conv3e(xv[e], xv[e + 1], xv[e + 2], v0, v1, v2, vbb);
          vv[e] = cv * c1; ev[e] = c0 * silu(z[e]);
        }
        u32x4 o; o.x = pk2_(vv[0], vv[1]); o.y = pk2_(vv[2], vv[3]); o.z = pk2_(vv[4], vv[5]); o.w = pk2_(vv[6], vv[7]);
        *(LAS u32x4*)(lds + dst) = o;
        *(LAS f32x4*)(lds + E_OFF + tok * 4) = (f32x4){ev[0], ev[1], ev[2], ev[3]};
        *(LAS f32x4*)(lds + E_OFF + tok * 4 + 16) = (f32x4){ev[4], ev[5], ev[6], ev[7]};
      }
      const bf16_t* Rc = FILT + ((size_t)(j * 1024 + c)) * FILT_CH;
      for (int gi = tid; gi < 515 + 66; gi += 512) {
        const bool smp = gi < 515; const int gq = smp ? gi : gi - 515; const int LEN = smp ? 4112 : 528;
        const bf16_t* Rg = Rc + (smp ? 528 : 0); const int idx0 = 8 * gq + 8;
        u32x4 lo = (u32x4){0u, 0u, 0u, 0u}, hi = (u32x4){0u, 0u, 0u, 0u};
        if (idx0 + 8 <= LEN) lo = *(const u32x4*)(Rg + idx0);
        if (idx0 + 16 <= LEN) hi = *(const u32x4*)(Rg + idx0 + 8);
        const unsigned d0 = lo.x, d1 = lo.y, d2 = lo.z, d3 = lo.w, d4 = hi.x, d5 = hi.y, d6 = hi.z, d7 = hi.w;
        LAS unsigned char* dstp = lds + (smp ? FK_S : FK_P) + gq * 128;
#define AB(hi_, lo_) __builtin_amdgcn_alignbit(hi_, lo_, 16)
        *(LAS u32x4*)(dstp + 0) = (u32x4){d0, d1, d2, d3};
        *(LAS u32x4*)(dstp + 16) = (u32x4){AB(d1, d0), AB(d2, d1), AB(d3, d2), AB(d4, d3)};
        *(LAS u32x4*)(dstp + 32) = (u32x4){d1, d2, d3, d4};
        *(LAS u32x4*)(dstp + 48) = (u32x4){AB(d2, d1), AB(d3, d2), AB(d4, d3), AB(d5, d4)};
        *(LAS u32x4*)(dstp + 64) = (u32x4){d2, d3, d4, d5};
        *(LAS u32x4*)(dstp + 80) = (u32x4){AB(d3, d2), AB(d4, d3), AB(d5, d4), AB(d6, d5)};
        *(LAS u32x4*)(dstp + 96) = (u32x4){d3, d4, d5, d6};
        *(LAS u32x4*)(dstp + 112) = (u32x4){AB(d4, d3), AB(d5, d4), AB(d6, d5), AB(d7, d6)};
#undef AB
      }
    }
    __syncthreads();
    f32x16 s0, s1, pr;
#pragma unroll
    for (int i = 0; i < 16; ++i) { s0[i] = 0.f; s1[i] = 0.f; pr[i] = 0.f; }
    {
      const int ahalf = wave & 1, dq = wave >> 1;
      const int a = ahalf * 32 + r;
      const int n0 = (ahalf ? -64 : -128) + 48 * dq, cnt = (dq == 3) ? 47 : 48;
      for (int s = 0; s < cnt; ++s) {
        const int n = n0 + s;
        const int e0 = 8 * h - r - 16 * n; const int q = (e0 - rho) >> 3;
        const bf16x8 af = *(LAS const bf16x8*)(lds + FK_S + ((q + 256) * 8 + rho) * 16);
        const int qb = 128 + h + 4 * a - 2 * n; const int pb = qb + (qb >> 4);
        const bf16x8 b0 = *(LAS const bf16x8*)(lds + VBS + pb * 16);
        const bf16x8 b1 = *(LAS const bf16x8*)(lds + VBS + 8704 + pb * 16);
        s0 = __builtin_amdgcn_mfma_f32_32x32x16_bf16(af, b0, s0, 0, 0, 0);
        s1 = __builtin_amdgcn_mfma_f32_32x32x16_bf16(af, b1, s1, 0, 0, 0);
      }
    }
    {
      const int ntile = wave & 3, dh = wave >> 2;
      const int batch = 4 * ntile + (r >> 3), a = r & 7;
      const int n0 = dh ? 0 : -16, cnt = dh ? 15 : 16;
      for (int s = 0; s < cnt; ++s) {
        const int n = n0 + s;
        const int e0 = 8 * h - r - 16 * n; const int q = (e0 - rho) >> 3;
        const bf16x8 af = *(LAS const bf16x8*)(lds + FK_P + ((q + 32) * 8 + rho) * 16);
        const int qb = 32 + h + 4 * a - 2 * n; const int pb = qb + (qb >> 4);
        const bf16x8 b0 = *(LAS const bf16x8*)(lds + VBP + batch * 1664 + pb * 16);
        pr = __builtin_amdgcn_mfma_f32_32x32x16_bf16(af, b0, pr, 0, 0, 0);
      }
    }
    __syncthreads();
    {
      const int ahalf = wave & 1, dq = wave >> 1;
#pragma unroll
      for (int g = 0; g < 4; ++g) {
        const int off = (r * 32 + 8 * g + 4 * h) * 4;
        *(LAS f32x4*)(lds + SCR_S + (((ahalf * 2 + 0) * 4 + dq) * 1024) * 4 + off) = (f32x4){s0[4 * g], s0[4 * g + 1], s0[4 * g + 2], s0[4 * g + 3]};
        *(LAS f32x4*)(lds + SCR_S + (((ahalf * 2 + 1) * 4 + dq) * 1024) * 4 + off) = (f32x4){s1[4 * g], s1[4 * g + 1], s1[4 * g + 2], s1[4 * g + 3]};
        *(LAS f32x4*)(lds + SCR_P + (((wave & 3) * 2 + (wave >> 2)) * 1024) * 4 + off) = (f32x4){pr[4 * g], pr[4 * g + 1], pr[4 * g + 2], pr[4 * g + 3]};
      }
    }
    __syncthreads();
    {
      {
        const int o = tid * 8; const int b = o >> 11, t = o & 2047; const int a = t >> 5, rr = t & 31; const int tile = (a >> 5) * 2 + b, col = a & 31;
        f32x4 y0 = (f32x4){0.f, 0.f, 0.f, 0.f}, y1 = y0;
#pragma unroll
        for (int dq = 0; dq < 4; ++dq) {
          LAS const unsigned char* sp = lds + SCR_S + (((tile * 4 + dq) * 1024) + col * 32 + rr) * 4;
          y0 += *(LAS const f32x4*)sp; y1 += *(LAS const f32x4*)(sp + 16);
        }
        const int token = NPT + o;
        const f32x4 e0 = *(LAS const f32x4*)(lds + E_OFF + token * 4), e1 = *(LAS const f32x4*)(lds + E_OFF + token * 4 + 16);
        u32x4 ov; ov.x = pk2_(y0.x * e0.x, y0.y * e0.y); ov.y = pk2_(y0.z * e0.z, y0.w * e0.w); ov.z = pk2_(y1.x * e1.x, y1.y * e1.y); ov.w = pk2_(y1.z * e1.z, y1.w * e1.w);
        *(u32x4*)(GT + (size_t)c * 8192 + token) = ov;
      }
      {
        const int o = tid * 8; const int batch = o >> 8, t = o & 255; const int ntile = batch >> 2, col = (batch & 3) * 8 + (t >> 5), rr = t & 31;
        f32x4 y0 = (f32x4){0.f, 0.f, 0.f, 0.f}, y1 = y0;
#pragma unroll
        for (int dh = 0; dh < 2; ++dh) {
          LAS const unsigned char* sp = lds + SCR_P + (((ntile * 2 + dh) * 1024) + col * 32 + rr) * 4;
          y0 += *(LAS const f32x4*)sp; y1 += *(LAS const f32x4*)(sp + 16);
        }
        const int token = o;
        const f32x4 e0 = *(LAS const f32x4*)(lds + E_OFF + token * 4), e1 = *(LAS const f32x4*)(lds + E_OFF + token * 4 + 16);
        u32x4 ov; ov.x = pk2_(y0.x * e0.x, y0.y * e0.y); ov.y = pk2_(y0.z * e0.z, y0.w * e0.w); ov.z = pk2_(y1.x * e1.x, y1.y * e1.y); ov.w = pk2_(y1.z * e1.z, y1.w * e1.w);
        *(u32x4*)(GT + (size_t)c * 8192 + token) = ov;
      }
    }
  }
}

template <int MODE>
__device__ __forceinline__ void phase_out_ln(const LAS PG& p, unsigned char* ws, LAS unsigned char* lds, int layer, const bf16_t* Wf, int tid, int lane, int wave, int bid, int G) {
  const bf16_t* GA = (const bf16_t*)(ws + M_GB);
  const float* MODS = (const float*)(ws + M_MODS);
  const int h = lane >> 5;
  for (int tile = bid; tile < NTOK / 32; tile += G) {
    const int t0 = tile * 32;
    __syncthreads();
    constexpr bool CHM = (MODE == 1);
    if (MODE == 2) {
      const float* BON = (const float*)(ws + M_GB + 8 * MiB);
      const int sub = lane >> 4, c4 = lane & 15;
#pragma unroll 2
      for (int it = 0; it < 16; ++it) {
        const int pr = wave * 64 + it * 4 + sub; const int tok = pr >> 4, hd = pr & 15, m = t0 + tok;
        const unsigned gi = (unsigned)m * (unsigned)D + (unsigned)(hd * 64 + 4 * c4);
        const f32x4 y = *(const f32x4*)((const float*)(ws + M_UT) + gi) + *(const f32x4*)((const float*)(ws + M_UT + 32 * MiB) + gi);
        float s1 = (y.x + y.y) + (y.z + y.w);
        s1 += __builtin_bit_cast(float, __builtin_amdgcn_update_dpp(0, __builtin_bit_cast(int, s1), 0xB1, 0xF, 0xF, true));
        s1 += __builtin_bit_cast(float, __builtin_amdgcn_update_dpp(0, __builtin_bit_cast(int, s1), 0x4E, 0xF, 0xF, true));
        s1 += __builtin_bit_cast(float, __builtin_amdgcn_update_dpp(0, __builtin_bit_cast(int, s1), 0x141, 0xF, 0xF, true));
        s1 += __builtin_bit_cast(float, __builtin_amdgcn_update_dpp(0, __builtin_bit_cast(int, s1), 0x140, 0xF, 0xF, true));
        const float mu = s1 * (1.f / 64.f);
        const f32x4 d = y - mu;
        float s2 = (d.x * d.x + d.y * d.y) + (d.z * d.z + d.w * d.w);
        s2 += __builtin_bit_cast(float, __builtin_amdgcn_update_dpp(0, __builtin_bit_cast(int, s2), 0xB1, 0xF, 0xF, true));
        s2 += __builtin_bit_cast(float, __builtin_amdgcn_update_dpp(0, __builtin_bit_cast(int, s2), 0x4E, 0xF, 0xF, true));
        s2 += __builtin_bit_cast(float, __builtin_amdgcn_update_dpp(0, __builtin_bit_cast(int, s2), 0x141, 0xF, 0xF, true));
        s2 += __builtin_bit_cast(float, __builtin_amdgcn_update_dpp(0, __builtin_bit_cast(int, s2), 0x140, 0xF, 0xF, true));
        const float rstd = rsqrtf(s2 * (1.f / 64.f) + GN_EPS);
        const f32x4 bo0 = *(const f32x4*)(BON + ((unsigned)m * 16u + (unsigned)hd) * 4u), bo1 = *(const f32x4*)(BON + (((unsigned)NTOK + (unsigned)m) * 16u + (unsigned)hd) * 4u);
        const float bon = ((bo0.x + bo0.y) + (bo0.z + bo0.w)) + ((bo1.x + bo1.y) + (bo1.z + bo1.w));
        const u32x2 v2 = *(const u32x2*)((const bf16_t*)(ws + M_SCR2 + 32 * MiB) + gi), z2 = *(const u32x2*)((const bf16_t*)(ws + M_SCR2 + 48 * MiB) + gi);
        const f32x4 gg = *(const GAS f32x4*)(p.rw_gn_g + hd * 64 + 4 * c4), gb = *(const GAS f32x4*)(p.rw_gn_b + hd * 64 + 4 * c4);
        const f32x4 yn = d * rstd * gg + gb;
        u32x2 o;
        o.x = pk2_((yn.x + bon * bf2f(v2.x & 0xffffu)) * bf2f(z2.x & 0xffffu), (yn.y + bon * bf2f(v2.x >> 16)) * bf2f(z2.x >> 16));
        o.y = pk2_((yn.z + bon * bf2f(v2.y & 0xffffu)) * bf2f(z2.y & 0xffffu), (yn.w + bon * bf2f(v2.y >> 16)) * bf2f(z2.y >> 16));
        *(LAS u32x2*)(lds + ((hd * 8 + (c4 >> 1)) * 32 + tok) * 16 + (c4 & 1) * 8) = o;
      }
    } else {
#pragma unroll
    for (int i = 0; i < 8; ++i) {
      const int idx = tid + 512 * i;
      if (CHM) { const int c = idx >> 2, part = idx & 3; *(LAS u32x4*)(lds + c * 64 + part * 16) = *(const u32x4*)(GA + (size_t)c * 8192 + t0 + 8 * part); }
      else { const int tok = idx >> 7, k8 = idx & 127; *(LAS u32x4*)(lds + (k8 * 32 + tok) * 16) = *(const u32x4*)(GA + (size_t)(t0 + tok) * D + 8 * k8); }
    }
    }
    __syncthreads();
    f32x16 acc[4];
#pragma unroll
    for (int nt = 0; nt < 4; ++nt)
#pragma unroll
      for (int i = 0; i < 16; ++i) acc[nt][i] = 0.f;
    const bf16_t* wf = Wf + ((size_t)(wave * 4) * 64 * 64 + lane) * 8;
    const int aoffT = ((h * 32) + (lane & 31)) * 16;
    const int aoffC = (8 * h + ((lane & 15) >> 2)) * 64 + 32 * ((lane >> 4) & 1) + 8 * (lane & 3);
#pragma unroll 4
    for (int ks = 0; ks < 64; ++ks) {
      bf16x8 af;
      if (CHM) {
        const v4i16_t lo = vtr(lds + aoffC + ks * 1024), hi = vtr(lds + aoffC + ks * 1024 + 256);
        af = (bf16x8){lo[0], lo[1], lo[2], lo[3], hi[0], hi[1], hi[2], hi[3]};
      } else {
        af = *(LAS const bf16x8*)(lds + aoffT + ks * 1024);
      }
#pragma unroll
      for (int nt = 0; nt < 4; ++nt) {
        const bf16x8 bfr = *(const bf16x8*)(wf + ((size_t)(nt * 64 + ks) * 64) * 8);
        acc[nt] = __builtin_amdgcn_mfma_f32_32x32x16_bf16(af, bfr, acc[nt], 0, 0, 0);
      }
    }
    __syncthreads();
#pragma unroll
    for (int nt = 0; nt < 4; ++nt)
#pragma unroll
      for (int i = 0; i < 16; ++i) {
        const int row = (i & 3) + 8 * (i >> 2) + 4 * h;
        *(LAS float*)(lds + (row * 1028 + (wave * 4 + nt) * 32 + (lane & 31)) * 4) = acc[nt][i];
      }
    __syncthreads();
#pragma unroll 1
    for (int i = 0; i < 4; ++i) {
      const int row = wave * 4 + i, m = t0 + row;
      int l, L, cond, m0; tokinfo(m, l, L, cond, m0);
      const float* gate = MODS + (size_t)(layer * 3 + cond) * 3072 + 2048;
      const GAS f32x4* xr = (const GAS f32x4*)xrow_in(p, layer, ws, m);
      f32x4 v[4]; float s = 0.f;
#pragma unroll
      for (int q = 0; q < 4; ++q) {
        const int k = 4 * lane + 256 * q;
        const f32x4 o = *(LAS const f32x4*)(lds + (row * 1028 + k) * 4);
        const f32x4 x = xr[lane + 64 * q]; const f32x4 g = *(const f32x4*)(gate + k);
        v[q] = ALPHA * x + g * o; s += (v[q].x + v[q].y) + (v[q].z + v[q].w);
      }
      const float mu = wsum(s) * (1.f / D); float qq = 0.f;
#pragma unroll
      for (int q = 0; q < 4; ++q) { v[q] = v[q] - mu; qq += (v[q].x * v[q].x + v[q].y * v[q].y) + (v[q].z * v[q].z + v[q].w * v[q].w); }
      const float rs = rsqrtf(wsum(qq) * (1.f / D) + LN_EPS);
      GASF* xo = (layer & 1) ? p.out + OUT_Y + (size_t)m * D : (GASF*)(ws + M_X) + (size_t)m * D;
      const float* nmod = MODS + (size_t)((layer + 1) * 3 + cond) * 3072;
      bf16_t* HB = (bf16_t*)(ws + M_HB) + (size_t)m * D;
#pragma unroll
      for (int q = 0; q < 4; ++q) {
        const int k = 4 * lane + 256 * q;
        const f32x4 lg = *(const f32x4*)(p.ln_g + layer * D + k), lb = *(const f32x4*)(p.ln_b + layer * D + k);
        const f32x4 y = v[q] * rs * lg + lb;
        *(GAS f32x4*)(xo + k) = y;
        if (layer < 3) {
          const f32x4 sh = *(const f32x4*)(nmod + k), sc = *(const f32x4*)(nmod + 1024 + k);
          u32x2 o; o.x = pk2_(y.x * (1.f + sc.x) + sh.x, y.y * (1.f + sc.y) + sh.y); o.y = pk2_(y.z * (1.f + sc.z) + sh.z, y.w * (1.f + sc.w) + sh.w);
          *(u32x2*)(HB + k) = o;
        }
      }
    }
  }
}

__device__ __forceinline__ int kvrow_(int m) { if (m < NPT) return m; const int mm = m - NPT; return NPT + (mm >> 11) * 2560 + PAST + (mm & 2047); }

struct EpiSilu {
  static constexpr bool PERM = true, AFTER_DRAIN = false;
  bf16_t* O; int ldc;
  __device__ __forceinline__ void operator()(const f32x4 (&acc)[2][2][4][2], const pg8::Unit& u, int wr, int wc, int fr, int fq) const {
    const int row0 = u.pm * 256 + wr * 64 + fr, col0 = u.pn * 256 + wc * 32 + 8 * fq;
#pragma unroll
    for (int ai = 0; ai < 2; ++ai)
#pragma unroll
      for (int m = 0; m < 4; ++m) {
        bf16_t* rowp = O + (size_t)(row0 + ai * 128 + m * 16) * ldc + col0;
#pragma unroll
        for (int bj = 0; bj < 2; ++bj) {
          const f32x4 v0 = acc[ai][bj][m][0], v1 = acc[ai][bj][m][1];
          u32x4 w; w.x = pk2_(silu(v0[0]), silu(v0[1])); w.y = pk2_(silu(v0[2]), silu(v0[3])); w.z = pk2_(silu(v1[0]), silu(v1[1])); w.w = pk2_(silu(v1[2]), silu(v1[3]));
          *(u32x4*)(rowp + bj * 128) = w;
        }
      }
  }
};
struct EpiF32 {
  static constexpr bool PERM = true, AFTER_DRAIN = false;
  float* O; int ldc;
  __device__ __forceinline__ void operator()(const f32x4 (&acc)[2][2][4][2], const pg8::Unit& u, int wr, int wc, int fr, int fq) const {
    const int row0 = u.pm * 256 + wr * 64 + fr, col0 = u.pn * 256 + wc * 32 + 8 * fq;
#pragma unroll
    for (int ai = 0; ai < 2; ++ai)
#pragma unroll
      for (int m = 0; m < 4; ++m) {
        float* rowp = O + (size_t)(row0 + ai * 128 + m * 16) * ldc + col0;
#pragma unroll
        for (int bj = 0; bj < 2; ++bj) { *(f32x4*)(rowp + bj * 128) = acc[ai][bj][m][0]; *(f32x4*)(rowp + bj * 128 + 4) = acc[ai][bj][m][1]; }
      }
  }
};
struct EpiKV {
  static constexpr bool PERM = true, AFTER_DRAIN = false;
  bf16_t* Kn; bf16_t* V;
  __device__ __forceinline__ void operator()(const f32x4 (&acc)[2][2][4][2], const pg8::Unit& u, int wr, int wc, int fr, int fq) const {
    const int row0 = u.pm * 256 + wr * 64 + fr;
    const int d = wc * 32 + 8 * fq;
    bf16_t* base = (d < 64 ? Kn : V) + (d & 63);
#pragma unroll
    for (int ai = 0; ai < 2; ++ai)
#pragma unroll
      for (int m = 0; m < 4; ++m) {
        const size_t row = (size_t)(row0 + ai * 128 + m * 16);
#pragma unroll
        for (int bj = 0; bj < 2; ++bj) {
          const int h = u.pn * 2 + bj;
          const f32x4 v0 = acc[ai][bj][m][0], v1 = acc[ai][bj][m][1];
          u32x4 w; w.x = pg8::cvt_pk_bf16(v0[0], v0[1]); w.y = pg8::cvt_pk_bf16(v0[2], v0[3]); w.z = pg8::cvt_pk_bf16(v1[0], v1[1]); w.w = pg8::cvt_pk_bf16(v1[2], v1[3]);
          *(u32x4*)(base + row * 1024 + h * 64) = w;
        }
      }
  }
};

__device__ __forceinline__ void phase_mla_rows(const LAS PG& p, unsigned char* ws, int lane, int wave, int bid, int G) {
  const float* U2S = (const float*)(ws + M_U2S);
  for (int m = bid * 8 + wave; m < NTOK; m += G * 8) {
    int l, L, cond, m0; tokinfo(m, l, L, cond, m0);
    const float* rb = U2S + (size_t)m * 512;
    const f32x4 q = *(const f32x4*)(rb + 4 * lane);
    const float rs = rsqrtf(wsum(q.x * q.x + q.y * q.y + q.z * q.z + q.w * q.w) * (1.f / 256.f) + RMS_EPS);
    const f32x4 g = *(const GAS f32x4*)(p.mla_q_norm + 4 * lane);
    u32x2 qo; qo.x = pk2_(q.x * rs * g.x, q.y * rs * g.y); qo.y = pk2_(q.z * rs * g.z, q.w * rs * g.w);
    *(u32x2*)((bf16_t*)(ws + M_QN) + (size_t)m * 256 + 4 * lane) = qo;
    const float k0 = rb[256 + 2 * lane], k1 = rb[256 + 2 * lane + 1];
    const float rs2 = rsqrtf(wsum(k0 * k0 + k1 * k1) * (1.f / 128.f) + RMS_EPS);
    const float c0 = k0 * rs2 * p.mla_kv_norm[2 * lane], c1 = k1 * rs2 * p.mla_kv_norm[2 * lane + 1];
    const int kr = kvrow_(m);
    *(unsigned*)((bf16_t*)(ws + M_CKVALL) + (size_t)kr * 128 + 2 * lane) = pk2_(c0, c1);
    if (m < NPT) { p.out[OUT_CKV + (size_t)m * 128 + 2 * lane] = c0; p.out[OUT_CKV + (size_t)m * 128 + 2 * lane + 1] = c1; }
    const float x = rb[384 + (lane & 31)];
    const float partner = __shfl_xor(x, 8);
    float o = x;
    if (m >= NPT) {
      const int d = lane & 31, jj = d & 7;
      const float inv = exp2f(-(float)(2 * jj) * (13.287712379549449f / 16.f));
      const float pos = (d < 16) ? (float)(l >> 6) : (float)(l & 63);
      const float ang = pos * inv; const float cs = cosf(ang), sn = sinf(ang);
      o = (d & 8) ? x * cs + partner * sn : x * cs - partner * sn;
    }
    if (lane < 32) {
      ((bf16_t*)(ws + M_KPEB))[(size_t)kr * 32 + lane] = (bf16_t)f2bf_(o);
      if (m < NPT) p.out[OUT_KPE + (size_t)m * 32 + lane] = x;
    }
  }
}

constexpr int AT_KB = 12288, AT_VB = 8192, AT_BUF = AT_KB + AT_VB, AT_WS = 2 * AT_BUF, AT_ST = AT_WS + 8 * 256;
__device__ __forceinline__ int crow_(int r, int hi) { return (r & 3) + 8 * (r >> 2) + 4 * hi; }
__device__ __forceinline__ unsigned cvtpk(float lo, float hi) { return pk2_(lo, hi); }

__device__ __forceinline__ void attn_unit(const unsigned char* ws, LAS unsigned char* lds, int seq, int hd, int qb, bf16_t* Gout, int tid, int lane, int wave) {
  const bf16_t* Q = (const bf16_t*)(ws + M_Q); const bf16_t* Kn = (const bf16_t*)(ws + M_KN); const bf16_t* Vv = (const bf16_t*)(ws + M_V);
  const bf16_t* KP = (const bf16_t*)(ws + M_KPEB); const bf16_t* SZ = (const bf16_t*)(ws + M_SZB);
  const int r32 = lane & 31, hi = lane >> 5;
  const bool smp = seq >= 16;
  const int mq0 = smp ? NPT + (seq - 16) * 2048 + qb * 256 : seq * 256;
  const int kbase = smp ? NPT + (seq - 16) * 2560 : seq * 256;
  const int NT = smp ? 40 : 4;
  const float C2 = 0.10206207261596575f * 1.4426950408889634f;
  bf16x8 qr[6];
  {
    const int m = mq0 + wave * 32 + r32;
    const bf16_t* qp = Q + (size_t)m * 1536 + hd * 96;
    const int l = smp ? ((m - NPT) & 2047) : 0;
#pragma unroll
    for (int d0 = 0; d0 < 6; ++d0) {
      const u32x4 own = *(const u32x4*)(qp + 16 * d0 + 8 * hi);
      float f[8];
#pragma unroll
      for (int e = 0; e < 4; ++e) { f[2 * e] = bf2f(own[e] & 0xffffu); f[2 * e + 1] = bf2f(own[e] >> 16); }
      if (d0 >= 4 && smp) {
        const u32x4 oth = *(const u32x4*)(qp + 16 * d0 + 8 * (1 - hi));
        const float pos = (d0 == 4) ? (float)(l >> 6) : (float)(l & 63);
#pragma unroll
        for (int e = 0; e < 8; ++e) {
          const float pf = bf2f((e & 1) ? (oth[e >> 1] >> 16) : (oth[e >> 1] & 0xffffu));
          const float inv = exp2f(-(float)(2 * e) * (13.287712379549449f / 16.f));
          const float ang = pos * inv; const float cs = cosf(ang), sn = sinf(ang);
          f[e] = hi ? f[e] * cs + pf * sn : f[e] * cs - pf * sn;
        }
      }
      u32x4 o; o.x = pk2_(f[0] * C2, f[1] * C2); o.y = pk2_(f[2] * C2, f[3] * C2); o.z = pk2_(f[4] * C2, f[5] * C2); o.w = pk2_(f[6] * C2, f[7] * C2);
      qr[d0] = __builtin_bit_cast(bf16x8, o);
    }
  }
  const bf16_t* vsrc = Vv + (size_t)(kbase + 16 * (wave & 3) + (lane >> 2)) * 1024 + hd * 64 + (wave >> 2) * 32 + (lane & 3) * 8;
  const int kc0 = tid >> 6, key0 = tid & 63;
  const bf16_t* ksrc0 = Kn + (size_t)(kbase + key0) * 1024 + hd * 64 + 8 * kc0;
  const bool k2 = tid < 256;
  const bf16_t* ksrc1 = KP + (size_t)(kbase + key0) * 32 + 8 * (tid >> 6);
  u32x4 rv, rk0, rk1 = (u32x4){0u, 0u, 0u, 0u};
#define AT_LOAD(t) do { rv = *(const u32x4*)(vsrc + (size_t)(t) * 64 * 1024); rk0 = *(const u32x4*)(ksrc0 + (size_t)(t) * 64 * 1024); if (k2) rk1 = *(const u32x4*)(ksrc1 + (size_t)(t) * 64 * 32); } while (0)
#define AT_STORE(b) do { LAS unsigned char* bb = lds + (b) * AT_BUF; *(LAS u32x4*)(bb + tid * 16) = rk0; if (k2) *(LAS u32x4*)(bb + 8192 + tid * 16) = rk1; *(LAS u32x4*)(bb + AT_KB + tid * 16) = rv; } while (0)
  __syncthreads();
  AT_LOAD(0); AT_STORE(0);
  __syncthreads();
  LAS float* wsf = (LAS float*)(lds + AT_WS + wave * 256);
  f32x16 o0, o1;
#pragma unroll
  for (int i = 0; i < 16; ++i) { o0[i] = 0.f; o1[i] = 0.f; }
  float mrun = -1e30f, lrun = 0.f;
  const int vboff = ((lane >> 4) & 1) * 32 + (lane & 3) * 8 + (4 * hi + ((lane & 15) >> 2)) * 64;
  for (int t = 0; t < NT; ++t) {
    const int cur = t & 1;
    if (t + 1 < NT) AT_LOAD(t + 1);
    LAS const unsigned char* kb = lds + cur * AT_BUF + hi * 1024 + r32 * 16;
    f32x16 p0, p1;
#pragma unroll
    for (int i = 0; i < 16; ++i) { p0[i] = 0.f; p1[i] = 0.f; }
#pragma unroll
    for (int d0 = 0; d0 < 6; ++d0) {
      const bf16x8 a0 = *(LAS const bf16x8*)(kb + d0 * 2048), a1 = *(LAS const bf16x8*)(kb + d0 * 2048 + 512);
      p0 = __builtin_amdgcn_mfma_f32_32x32x16_bf16(a0, qr[d0], p0, 0, 0, 0);
      p1 = __builtin_amdgcn_mfma_f32_32x32x16_bf16(a1, qr[d0], p1, 0, 0, 0);
    }
    float rm = p0[0];
#pragma unroll
    for (int i = 1; i < 16; ++i) rm = fmaxf(rm, p0[i]);
#pragma unroll
    for (int i = 0; i < 16; ++i) rm = fmaxf(rm, p1[i]);
    rm = fmaxf(rm, __shfl_xor(rm, 32));
    if (__any(rm > mrun + 8.f)) {
      const float mnew = fmaxf(mrun, rm);
      const float alpha = __builtin_amdgcn_exp2f(mrun - mnew);
      mrun = mnew;
      lrun *= alpha;
      if (hi == 0) wsf[r32] = alpha;
      asm volatile("s_waitcnt lgkmcnt(0)" ::: "memory");
#pragma unroll
      for (int i = 0; i < 16; ++i) { const float al = wsf[crow_(i, hi)]; o0[i] *= al; o1[i] *= al; }
    }
    float ps = 0.f;
#pragma unroll
    for (int i = 0; i < 16; ++i) { p0[i] = __builtin_amdgcn_exp2f(p0[i] - mrun); p1[i] = __builtin_amdgcn_exp2f(p1[i] - mrun); ps += p0[i] + p1[i]; }
    lrun += ps;
    u32x4 w0, w1, w2, w3;
    w0.x = cvtpk(p0[0], p0[1]); w0.y = cvtpk(p0[2], p0[3]); w0.z = cvtpk(p0[4], p0[5]); w0.w = cvtpk(p0[6], p0[7]);
    w1.x = cvtpk(p0[8], p0[9]); w1.y = cvtpk(p0[10], p0[11]); w1.z = cvtpk(p0[12], p0[13]); w1.w = cvtpk(p0[14], p0[15]);
    w2.x = cvtpk(p1[0], p1[1]); w2.y = cvtpk(p1[2], p1[3]); w2.z = cvtpk(p1[4], p1[5]); w2.w = cvtpk(p1[6], p1[7]);
    w3.x = cvtpk(p1[8], p1[9]); w3.y = cvtpk(p1[10], p1[11]); w3.z = cvtpk(p1[12], p1[13]); w3.w = cvtpk(p1[14], p1[15]);
    const bf16x8 pa0 = __builtin_bit_cast(bf16x8, w0), pa1 = __builtin_bit_cast(bf16x8, w1), pa2 = __builtin_bit_cast(bf16x8, w2), pa3 = __builtin_bit_cast(bf16x8, w3);
    LAS const unsigned char* vb = lds + cur * AT_BUF + AT_KB + vboff;
#define AT_PV(O_, D0) do { \
      const v4i16_t l0 = vtr(vb + (D0) * 4096), h0 = vtr(vb + (D0) * 4096 + 512), l1 = vtr(vb + (D0) * 4096 + 1024), h1 = vtr(vb + (D0) * 4096 + 1024 + 512); \
      const v4i16_t l2 = vtr(vb + (D0) * 4096 + 2048), h2 = vtr(vb + (D0) * 4096 + 2048 + 512), l3 = vtr(vb + (D0) * 4096 + 3072), h3 = vtr(vb + (D0) * 4096 + 3072 + 512); \
      O_ = __builtin_amdgcn_mfma_f32_32x32x16_bf16(pa0, ((bf16x8){l0[0], l0[1], l0[2], l0[3], h0[0], h0[1], h0[2], h0[3]}), O_, 0, 0, 0); \
      O_ = __builtin_amdgcn_mfma_f32_32x32x16_bf16(pa1, ((bf16x8){l1[0], l1[1], l1[2], l1[3], h1[0], h1[1], h1[2], h1[3]}), O_, 0, 0, 0); \
      O_ = __builtin_amdgcn_mfma_f32_32x32x16_bf16(pa2, ((bf16x8){l2[0], l2[1], l2[2], l2[3], h2[0], h2[1], h2[2], h2[3]}), O_, 0, 0, 0); \
      O_ = __builtin_amdgcn_mfma_f32_32x32x16_bf16(pa3, ((bf16x8){l3[0], l3[1], l3[2], l3[3], h3[0], h3[1], h3[2], h3[3]}), O_, 0, 0, 0); } while (0)
    AT_PV(o0, 0); AT_PV(o1, 1);
#undef AT_PV
    if (t + 1 < NT) AT_STORE(cur ^ 1);
    __syncthreads();
  }
#undef AT_LOAD
#undef AT_STORE
  lrun += __shfl_xor(lrun, 32);
  if (hi == 0) wsf[32 + r32] = 1.f / lrun;
  asm volatile("s_waitcnt lgkmcnt(0)" ::: "memory");
  LAS bf16_t* stg = (LAS bf16_t*)(lds + AT_ST + wave * 4096);
#pragma unroll
  for (int i = 0; i < 16; ++i) {
    const int orow = crow_(i, hi); const float rl = wsf[32 + orow];
    stg[orow * 64 + r32] = (bf16_t)f2bf_(o0[i] * rl);
    stg[orow * 64 + 32 + r32] = (bf16_t)f2bf_(o1[i] * rl);
  }
  asm volatile("s_waitcnt lgkmcnt(0)" ::: "memory");
#pragma unroll
  for (int i = 0; i < 4; ++i) {
    const int row = i * 8 + (lane >> 3), ch = lane & 7;
    const u32x4 ov = *(LAS const u32x4*)(stg + row * 64 + ch * 8);
    const size_t gi = (size_t)(mq0 + wave * 32 + row) * D + hd * 64 + ch * 8;
    const u32x4 zv = *(const u32x4*)(SZ + gi);
    u32x4 res;
#pragma unroll
    for (int e = 0; e < 4; ++e) res[e] = pk2_(bf2f(ov[e] & 0xffffu) * bf2f(zv[e] & 0xffffu), bf2f(ov[e] >> 16) * bf2f(zv[e] >> 16));
    *(u32x4*)(Gout + gi) = res;
  }
}
constexpr size_t M_XMIX = M_UT;
constexpr size_t M_YF = M_UT, M_YB = M_UT + 32 * MiB;
constexpr size_t M_RB = M_SCR2, M_KB = M_SCR2 + 16 * MiB, M_VB = M_SCR2 + 32 * MiB, M_SZR = M_SCR2 + 48 * MiB;
constexpr size_t M_HWA = M_GB;
constexpr size_t M_BON = M_GB + 8 * MiB;

__device__ __forceinline__ void phase_rw_mix(const LAS PG& p, unsigned char* ws, int tid, int bid, int G) {
  const bf16_t* HB = (const bf16_t*)(ws + M_HB);
  bf16_t* XM = (bf16_t*)(ws + M_XMIX);
  for (int i = bid * 512 + tid; i < NTOK * 128; i += G * 512) {
    const int m = i >> 7, k8 = i & 127;
    int l, L, cond, m0; tokinfo(m, l, L, cond, m0);
    const u32x4 hc = *(const u32x4*)(HB + (size_t)m * D + 8 * k8);
    u32x4 hp = (u32x4){0u, 0u, 0u, 0u}, hn = hp;
    if (l > 0) hp = *(const u32x4*)(HB + (size_t)(m - 1) * D + 8 * k8);
    if (l < L - 1) hn = *(const u32x4*)(HB + (size_t)(m + 1) * D + 8 * k8);
    float h[8], d[8];
#pragma unroll
    for (int e = 0; e < 4; ++e) {
      h[2 * e] = bf2f(hc[e] & 0xffffu); h[2 * e + 1] = bf2f(hc[e] >> 16);
      d[2 * e] = 0.5f * (bf2f(hp[e] & 0xffffu) + bf2f(hn[e] & 0xffffu)) - h[2 * e];
      d[2 * e + 1] = 0.5f * (bf2f(hp[e] >> 16) + bf2f(hn[e] >> 16)) - h[2 * e + 1];
    }
#pragma unroll
    for (int q = 0; q < 4; ++q) {
      const int mi = (q == 0) ? 0 : (q == 1) ? 2 : (q == 2) ? 3 : 5;
      const f32x4 u0 = *(const f32x4*)(p.rw_mu + mi * D + 8 * k8), u1 = *(const f32x4*)(p.rw_mu + mi * D + 8 * k8 + 4);
      u32x4 o; o.x = pk2_(h[0] + d[0] * u0.x, h[1] + d[1] * u0.y); o.y = pk2_(h[2] + d[2] * u0.z, h[3] + d[3] * u0.w);
      o.z = pk2_(h[4] + d[4] * u1.x, h[5] + d[5] * u1.y); o.w = pk2_(h[6] + d[6] * u1.z, h[7] + d[7] * u1.w);
      *(u32x4*)(XM + (size_t)q * NTOK * D + (size_t)m * D + 8 * k8) = o;
    }
  }
}

__device__ __forceinline__ void rw_lora_tile(const LAS PG& p, unsigned char* ws, LAS unsigned char* lds, int tile, int tid, int lane, int wave) {
  const bf16_t* HB = (const bf16_t*)(ws + M_HB);
  const bf16_t* Wf = (const bf16_t*)(ws + W_LORA1);
  const int h = lane >> 5, t0 = tile * 32;
  __syncthreads();
#pragma unroll 2
  for (int i = 0; i < 8; ++i) {
    const int idx = tid + 512 * i; const int tok = idx >> 7, k8 = idx & 127; const int m = t0 + tok;
    int l, L, cond, m0; tokinfo(m, l, L, cond, m0);
    const u32x4 hc = *(const u32x4*)(HB + (size_t)m * D + 8 * k8);
    u32x4 hp = (u32x4){0u, 0u, 0u, 0u}, hn = hp;
    if (l > 0) hp = *(const u32x4*)(HB + (size_t)(m - 1) * D + 8 * k8);
    if (l < L - 1) hn = *(const u32x4*)(HB + (size_t)(m + 1) * D + 8 * k8);
    float hh[8], d[8];
#pragma unroll
    for (int e = 0; e < 4; ++e) {
      hh[2 * e] = bf2f(hc[e] & 0xffffu); hh[2 * e + 1] = bf2f(hc[e] >> 16);
      d[2 * e] = 0.5f * (bf2f(hp[e] & 0xffffu) + bf2f(hn[e] & 0xffffu)) - hh[2 * e];
      d[2 * e + 1] = 0.5f * (bf2f(hp[e] >> 16) + bf2f(hn[e] >> 16)) - hh[2 * e + 1];
    }
#pragma unroll
    for (int q = 0; q < 2; ++q) {
      const int mi = q ? 4 : 1;
      const f32x4 u0 = *(const f32x4*)(p.rw_mu + mi * D + 8 * k8), u1 = *(const f32x4*)(p.rw_mu + mi * D + 8 * k8 + 4);
      u32x4 o; o.x = pk2_(hh[0] + d[0] * u0.x, hh[1] + d[1] * u0.y); o.y = pk2_(hh[2] + d[2] * u0.z, hh[3] + d[3] * u0.w);
      o.z = pk2_(hh[4] + d[4] * u1.x, hh[5] + d[5] * u1.y); o.w = pk2_(hh[6] + d[6] * u1.z, hh[7] + d[7] * u1.w);
      *(LAS u32x4*)(lds + q * 65536 + (k8 * 32 + tok) * 16) = o;
    }
  }
  __syncthreads();
  f32x16 acc;
#pragma unroll
  for (int i = 0; i < 16; ++i) acc[i] = 0.f;
  const int aoff = (wave >> 2) * 65536 + ((h * 32) + (lane & 31)) * 16;
  const bf16_t* wf = Wf + ((size_t)wave * 64 * 64 + lane) * 8;
#pragma unroll 4
  for (int ks = 0; ks < 64; ++ks) {
    const bf16x8 af = *(LAS const bf16x8*)(lds + aoff + ks * 1024);
    const bf16x8 b0 = *(const bf16x8*)(wf + ((size_t)ks * 64) * 8);
    acc = __builtin_amdgcn_mfma_f32_32x32x16_bf16(af, b0, acc, 0, 0, 0);
  }
  bf16_t* HWA = (bf16_t*)(ws + M_HWA);
#pragma unroll
  for (int i = 0; i < 16; ++i) {
    const int row = (i & 3) + 8 * (i >> 2) + 4 * h;
    const float v = (wave < 4) ? tanhf(acc[i]) : acc[i];
    HWA[(size_t)(t0 + row) * 256 + wave * 32 + (lane & 31)] = (bf16_t)f2bf_(v);
  }
}

#define DPP_ADD(v, CTRL) ((v) + __builtin_bit_cast(float, __builtin_amdgcn_mov_dpp(__builtin_bit_cast(int, (v)), (CTRL), 0xF, 0xF, true)))
__device__ __forceinline__ float allred4(float v) { v = DPP_ADD(v, 0xB1); v = DPP_ADD(v, 0x4E); return v; }
__device__ __forceinline__ float allred16(float v) { v = DPP_ADD(v, 0xB1); v = DPP_ADD(v, 0x4E); v = DPP_ADD(v, 0x141); v = DPP_ADD(v, 0x140); return v; }

__device__ __forceinline__ float fma_s(float a, float b, float c) { float d; asm("v_fma_f32 %0, %1, %2, %3" : "=v"(d) : "v"(a), "v"(b), "v"(c)); return d; }
__device__ __forceinline__ float mul_s(float a, float b) { float d; asm("v_mul_f32_e32 %0, %1, %2" : "=v"(d) : "v"(a), "v"(b)); return d; }
__device__ __forceinline__ float add_s(float a, float b) { float d; asm("v_add_f32_e32 %0, %1, %2" : "=v"(d) : "v"(a), "v"(b)); return d; }
#define DPPADD_(NAME, CTRL) __device__ __forceinline__ float NAME(float s) { float d; asm("s_nop 1\n\tv_add_f32_dpp %0, %1, %1 " CTRL " row_mask:0xf bank_mask:0xf bound_ctrl:1" : "=v"(d) : "v"(s)); return d; }
DPPADD_(dpp_x1, "quad_perm:[1,0,3,2]")
DPPADD_(dpp_x2, "quad_perm:[2,3,0,1]")
DPPADD_(dpp_hm, "row_half_mirror")
DPPADD_(dpp_rm, "row_mirror")
__device__ __forceinline__ float ar4(float v) { return dpp_x2(dpp_x1(v)); }
__device__ __forceinline__ float ar16(float v) { return dpp_rm(dpp_hm(dpp_x2(dpp_x1(v)))); }
__device__ __forceinline__ float dot4_s(const f32x4& s, const f32x4& a) { return add_s(fma_s(s.y, a.y, mul_s(s.x, a.x)), fma_s(s.w, a.w, mul_s(s.z, a.z))); }
__device__ __forceinline__ void upd4_s(f32x4& s, const f32x4& w, const f32x4& b, const f32x4& k, float sa, float vi) {
  s.x = fma_s(s.x, w.x, fma_s(sa, b.x, mul_s(vi, k.x))); s.y = fma_s(s.y, w.y, fma_s(sa, b.y, mul_s(vi, k.y)));
  s.z = fma_s(s.z, w.z, fma_s(sa, b.z, mul_s(vi, k.z))); s.w = fma_s(s.w, w.w, fma_s(sa, b.w, mul_s(vi, k.w)));
}
constexpr int PB_BYTES = 24832;
constexpr int SC_PS0 = 0, SC_PP0 = 2 * PB_BYTES;

constexpr int SC_FR = 4 * PB_BYTES;
__device__ __forceinline__ u32x4 ld_bfrag(const GASF* W2, int ks, int lane) {
  const int k0 = 32 * ks + 8 * (lane >> 4);
  u32x4 o; o.x = pk2_(W2[(size_t)(k0 + 0) * D], W2[(size_t)(k0 + 1) * D]); o.y = pk2_(W2[(size_t)(k0 + 2) * D], W2[(size_t)(k0 + 3) * D]);
  o.z = pk2_(W2[(size_t)(k0 + 4) * D], W2[(size_t)(k0 + 5) * D]); o.w = pk2_(W2[(size_t)(k0 + 6) * D], W2[(size_t)(k0 + 7) * D]);
  return o;
}
struct ChId { int dir, hd, m0, L, froff; };
__device__ __forceinline__ ChId chid(int slot, int seq, int dir, int hd, int lane, int ntile) {
  ChId c; c.dir = dir; c.hd = hd; c.L = seq < 16 ? 256 : 2048; c.m0 = seq < 16 ? seq * 256 : NPT + (seq - 16) * 2048;
  c.froff = SC_FR + ((slot * 4 + ntile) * 6) * 1024 + lane * 16; return c;
}
__device__ __forceinline__ void prepc_load(const LAS PG& p, LAS unsigned char* lds, int froff, int dir, int hd, int lane, int ntile) {
  const int ch = hd * 64 + 16 * ntile + (lane & 15);
  const GASF* W2 = p.rw_w2 + (size_t)dir * 64 * D + ch; const GASF* A2 = p.rw_a2 + (size_t)dir * 64 * D + ch;
  *(LAS u32x4*)(lds + froff) = ld_bfrag(W2, 0, lane); __builtin_amdgcn_sched_barrier(0);
  *(LAS u32x4*)(lds + froff + 1024) = ld_bfrag(W2, 1, lane); __builtin_amdgcn_sched_barrier(0);
  *(LAS u32x4*)(lds + froff + 2048) = ld_bfrag(A2, 0, lane); __builtin_amdgcn_sched_barrier(0);
  *(LAS u32x4*)(lds + froff + 3072) = ld_bfrag(A2, 1, lane); __builtin_amdgcn_sched_barrier(0);
  LAS float* cn = (LAS float*)(lds + (froff - lane * 16) + 4096) + lane;
  cn[0] = p.rw_w0[dir * D + ch]; cn[64] = p.rw_a0[dir * D + ch]; cn[128] = p.rw_k_k[ch]; cn[192] = p.rw_k_a[ch]; cn[256] = p.rw_r_k[ch];
}
struct PrepIn { u32x4 hw[2], ha[2]; unsigned kr[4], rr[4], vr[4]; };
__device__ __forceinline__ int ctok(int m0, int L, int dir, int step) { return m0 + (dir ? (L - 1 - step) : step); }
__device__ __forceinline__ void prep_fetch(const unsigned char* ws, int c_m0, int c_L, int c_dir, int c_hd, int s0, int lane, int ntile, PrepIn& in) {
  const bf16_t* HWA = (const bf16_t*)(ws + M_HWA);
  const int m = ctok(c_m0, c_L, c_dir, s0 + (lane & 15));
  const bf16_t* src = HWA + (size_t)m * 256 + c_dir * 64 + 8 * (lane >> 4);
  in.hw[0] = *(const u32x4*)(src); in.hw[1] = *(const u32x4*)(src + 32);
  in.ha[0] = *(const u32x4*)(src + 128); in.ha[1] = *(const u32x4*)(src + 160);
#pragma unroll
  for (int r = 0; r < 4; ++r) {
    const int mt = ctok(c_m0, c_L, c_dir, s0 + 4 * (lane >> 4) + r);
    const size_t gi = (size_t)mt * D + c_hd * 64 + 16 * ntile + (lane & 15);
    in.kr[r] = ((const bf16_t*)(ws + M_KB))[gi]; in.rr[r] = ((const bf16_t*)(ws + M_RB))[gi]; in.vr[r] = ((const bf16_t*)(ws + M_VB))[gi];
  }
}
__device__ __forceinline__ bf16x8 pack8(const f32x4& a, const f32x4& b) { u32x4 o; o.x = pk2_(a.x, a.y); o.y = pk2_(a.z, a.w); o.z = pk2_(b.x, b.y); o.w = pk2_(b.z, b.w); return __builtin_bit_cast(bf16x8, o); }
__device__ __forceinline__ void prep_finish(unsigned char* ws, LAS unsigned char* lds, int c_m0, int c_L, int c_dir, int c_hd, int c_froff, int s0, int pboff, int lane, int ntile, const PrepIn& in) {
  LAS const float* cn = (LAS const float*)(lds + (c_froff - lane * 16) + 4096) + lane;
  const float c_biasw = cn[0], c_biasa = cn[64], c_kkc = cn[128], c_kac = cn[192], c_rkc = cn[256];
  f32x4 aw = (f32x4){c_biasw, c_biasw, c_biasw, c_biasw}, aa = (f32x4){c_biasa, c_biasa, c_biasa, c_biasa};
  aw = __builtin_amdgcn_mfma_f32_16x16x32_bf16(__builtin_bit_cast(bf16x8, in.hw[0]), *(LAS const bf16x8*)(lds + c_froff), aw, 0, 0, 0);
  aw = __builtin_amdgcn_mfma_f32_16x16x32_bf16(__builtin_bit_cast(bf16x8, in.hw[1]), *(LAS const bf16x8*)(lds + c_froff + 1024), aw, 0, 0, 0);
  aa = __builtin_amdgcn_mfma_f32_16x16x32_bf16(__builtin_bit_cast(bf16x8, in.ha[0]), *(LAS const bf16x8*)(lds + c_froff + 2048), aa, 0, 0, 0);
  aa = __builtin_amdgcn_mfma_f32_16x16x32_bf16(__builtin_bit_cast(bf16x8, in.ha[1]), *(LAS const bf16x8*)(lds + c_froff + 3072), aa, 0, 0, 0);
  LAS float* pb = (LAS float*)(lds + pboff);
  const int col = lane & 15, rg = lane >> 4, chl = 16 * ntile + col;
#pragma unroll
  for (int r = 0; r < 4; ++r) {
    const int t = 4 * rg + r;
    const float sig = __builtin_amdgcn_rcpf(1.f + __expf(-aw[r]));
    const float dec = __expf(-0.6065306597126334f * sig);
    const float a = __builtin_amdgcn_rcpf(1.f + __expf(-aa[r]));
    const float k = bf2f(in.kr[r]), rv = bf2f(in.rr[r]), v = bf2f(in.vr[r]);
    const float kq = k * c_kkc;
    const float ssq = ar16(kq * kq);
    const float kd = k * (1.f + (a - 1.f) * c_kac);
    const float bon = ar16(rv * kd * c_rkc);
    pb[t * 64 + chl] = dec; pb[1024 + t * 64 + chl] = -kq; pb[2048 + t * 64 + chl] = kq * a; pb[3072 + t * 64 + chl] = kd; pb[4096 + t * 64 + chl] = rv; pb[5120 + t * 64 + chl] = v;
    if (col == 0) {
      pb[6144 + t * 4 + ntile] = ssq;
      const int mt = ctok(c_m0, c_L, c_dir, s0 + t);
      ((float*)(ws + M_BON))[(((size_t)c_dir * NTOK + mt) * 16 + c_hd) * 4 + ntile] = bon;
    }
  }
}

#define LDS_BARRIER() asm volatile("s_waitcnt lgkmcnt(0)\n\ts_barrier" ::: "memory")
__device__ __forceinline__ void phase_rw_scan(const LAS PG& p, unsigned char* ws, LAS unsigned char* lds, int tid, int lane, int wave, int bid, int G) {
  for (int item = bid; item < 256; item += G) {
    const int sc = item >> 2, qt = item & 3;
    const int s_seq = 16 + (sc >> 5), s_dir = (sc >> 4) & 1, s_hd = sc & 15, s_m0 = NPT + (s_seq - 16) * 2048;
    __syncthreads();
    if (wave < 4) {
      __builtin_amdgcn_s_setprio(2);
      float* Yo = (float*)(ws + (s_dir ? M_YB : M_YF));
      const int srow = 16 * qt + 4 * wave + (lane >> 4), scg = lane & 15;
      f32x4 Ss = *(const GAS f32x4*)(p.state_rwkv + ((((size_t)(s_seq - 16)) * 2 + s_dir) * 16 + s_hd) * 4096 + (size_t)srow * 64 + 4 * scg);
      __syncthreads();
      for (int c = 0; c < 128; ++c) {
        LAS const float* ps = (LAS const float*)(lds + SC_PS0 + (c & 1) * PB_BYTES);
        float rn2v;
        { const f32x4 q4 = *(LAS const f32x4*)(ps + 6144 + (lane & 15) * 4); rn2v = __builtin_amdgcn_rcpf((q4.x + q4.y) + (q4.z + q4.w) + 1e-12f); }
        float yk[16];
#pragma unroll
        for (int t = 0; t < 16; ++t) {
          const f32x4 w4 = *(LAS const f32x4*)(ps + t * 64 + 4 * scg), a4 = *(LAS const f32x4*)(ps + 1024 + t * 64 + 4 * scg);
          const f32x4 b4 = *(LAS const f32x4*)(ps + 2048 + t * 64 + 4 * scg), k4 = *(LAS const f32x4*)(ps + 3072 + t * 64 + 4 * scg);
          const f32x4 r4 = *(LAS const f32x4*)(ps + 4096 + t * 64 + 4 * scg);
          const float vi = ps[5120 + t * 64 + srow];
          const float rn2 = __builtin_bit_cast(float, __builtin_amdgcn_readlane(__builtin_bit_cast(int, rn2v), t));
          const float sa = ar16(dot4_s(Ss, a4)) * rn2;
          upd4_s(Ss, w4, b4, k4, sa, vi);
          yk[t] = ar16(dot4_s(Ss, r4));
        }
        if (scg == 0) {
          const int mfirst = ctok(s_m0, 2048, s_dir, 16 * c);
          float* yp = Yo + (size_t)mfirst * D + s_hd * 64 + srow;
          const long stride = s_dir ? -(long)D : (long)D;
#pragma unroll
          for (int t = 0; t < 16; ++t) yp[t * stride] = yk[t];
        }
        LDS_BARRIER();
      }
      __builtin_amdgcn_s_setprio(0);
    } else {
      const int nt = wave - 4;
      const int s_fr = SC_FR + ((0 * 4 + nt) * 6) * 1024 + lane * 16;
      prepc_load(p, lds, s_fr, s_dir, s_hd, lane, nt);
      int pc = 2 * item;
      const int q_fr = SC_FR + ((1 * 4 + nt) * 6) * 1024 + lane * 16;
      prepc_load(p, lds, q_fr, (pc >> 4) & 1, pc & 15, lane, nt);
      int r_seq = pc >> 5, r_dir = (pc >> 4) & 1, r_hd = pc & 15;
      int q_seq = pc >> 5, q_dir = (pc >> 4) & 1, q_hd = pc & 15;
      PrepIn in_s, in_p;
      prep_fetch(ws, s_m0, 2048, s_dir, s_hd, 0, lane, nt, in_s); prep_fetch(ws, r_seq * 256, 256, r_dir, r_hd, 0, lane, nt, in_p);
      prep_finish(ws, lds, s_m0, 2048, s_dir, s_hd, s_fr, 0, SC_PS0, lane, nt, in_s); prep_finish(ws, lds, r_seq * 256, 256, r_dir, r_hd, q_fr, 0, SC_PP0, lane, nt, in_p);
      const int prow = 16 * nt + (lane >> 2), pcq = lane & 3;
      f32x4 Sp0 = (f32x4){0.f, 0.f, 0.f, 0.f}, Sp1 = Sp0, Sp2 = Sp0, Sp3 = Sp0;
      __syncthreads();
      for (int c = 0; c < 128; ++c) {
        const bool more_s = (c + 1) < 128;
        const bool pgrp = ((c & 3) == 0) && (c + 4 < 128);
        if (more_s) prep_fetch(ws, s_m0, 2048, s_dir, s_hd, 16 * (c + 1), lane, nt, in_s);
        if (pgrp) {
          if (c == 60) { pc = 2 * item + 1; r_seq = pc >> 5; r_dir = (pc >> 4) & 1; r_hd = pc & 15; prepc_load(p, lds, q_fr, r_dir, r_hd, lane, nt); }
          prep_fetch(ws, r_seq * 256, 256, r_dir, r_hd, 4 * ((c + 4) & 63), lane, nt, in_p);
        }
        if (c == 64) { q_seq = r_seq; q_dir = r_dir; q_hd = r_hd; Sp0 = (f32x4){0.f, 0.f, 0.f, 0.f}; Sp1 = Sp0; Sp2 = Sp0; Sp3 = Sp0; }
        {
          LAS const float* pp = (LAS const float*)(lds + SC_PP0 + ((c >> 2) & 1) * PB_BYTES);
          float* Yp = (float*)(ws + (q_dir ? M_YB : M_YF));
          float rn2v;
          { const f32x4 q4 = *(LAS const f32x4*)(pp + 6144 + (lane & 15) * 4); rn2v = __builtin_amdgcn_rcpf((q4.x + q4.y) + (q4.z + q4.w) + 1e-12f); }
#pragma unroll 2
          for (int s = 0; s < 4; ++s) {
            const int t = 4 * (c & 3) + s;
            const float vi = pp[5120 + t * 64 + prow];
            const float rn2 = __builtin_bit_cast(float, __builtin_amdgcn_readlane(__builtin_bit_cast(int, rn2v), t));
            LAS const float* q = pp + t * 64 + 16 * pcq;
            const f32x4 a0 = *(LAS const f32x4*)(q + 1024), a1 = *(LAS const f32x4*)(q + 1028), a2 = *(LAS const f32x4*)(q + 1032), a3 = *(LAS const f32x4*)(q + 1036);
            const float sa = ar4(add_s(add_s(dot4_s(Sp0, a0), dot4_s(Sp1, a1)), add_s(dot4_s(Sp2, a2), dot4_s(Sp3, a3)))) * rn2;
            float y0, y1, y2, y3;
#define UP4(S_, O_, Y_) { const f32x4 w4 = *(LAS const f32x4*)(q + (O_)), b4 = *(LAS const f32x4*)(q + 2048 + (O_)), k4 = *(LAS const f32x4*)(q + 3072 + (O_)), r4 = *(LAS const f32x4*)(q + 4096 + (O_)); \
              upd4_s(S_, w4, b4, k4, sa, vi); Y_ = dot4_s(S_, r4); }
            UP4(Sp0, 0, y0) UP4(Sp1, 4, y1) UP4(Sp2, 8, y2) UP4(Sp3, 12, y3)
#undef UP4
            const float y = ar4(add_s(add_s(y0, y1), add_s(y2, y3)));
            if (pcq == 0) Yp[(size_t)ctok(q_seq * 256, 256, q_dir, 4 * (c & 63) + s) * D + q_hd * 64 + prow] = y;
          }
          if ((c & 63) == 63) {
            GASF* so = p.out + OUT_ST + ((((size_t)q_seq) * 2 + q_dir) * 16 + q_hd) * 4096 + (size_t)prow * 64 + 16 * pcq;
            *(GAS f32x4*)so = Sp0; *(GAS f32x4*)(so + 4) = Sp1; *(GAS f32x4*)(so + 8) = Sp2; *(GAS f32x4*)(so + 12) = Sp3;
          }
        }
        if (more_s) prep_finish(ws, lds, s_m0, 2048, s_dir, s_hd, s_fr, 16 * (c + 1), SC_PS0 + ((c + 1) & 1) * PB_BYTES, lane, nt, in_s);
        if (pgrp) prep_finish(ws, lds, r_seq * 256, 256, r_dir, r_hd, q_fr, 4 * ((c + 4) & 63), SC_PP0 + (((c >> 2) + 1) & 1) * PB_BYTES, lane, nt, in_p);
        LDS_BARRIER();
      }
    }
  }
}
constexpr int CK_OPS = 20992;
constexpr int CK_MX = 3 * CK_OPS;
constexpr int CK_SCR = CK_MX + 2 * 8192;
constexpr int CK_SSQ = CK_SCR + 6144;
constexpr int CK_FR = CK_SSQ + 1024;
constexpr int CK_IN = CK_FR + 4 * 6144;
constexpr int CK_INS = 20992;

__device__ __forceinline__ unsigned short bfr(float f) { return (unsigned short)f2bf_(f); }
__device__ __forceinline__ bf16x8 cvt8(const f32x16& a, int s) {
  u32x4 o; o.x = pk2_(a[8 * s + 0], a[8 * s + 1]); o.y = pk2_(a[8 * s + 2], a[8 * s + 3]); o.z = pk2_(a[8 * s + 4], a[8 * s + 5]); o.w = pk2_(a[8 * s + 6], a[8 * s + 7]);
  return __builtin_bit_cast(bf16x8, o);
}
__device__ __forceinline__ bf16x8 ldA_perm(LAS const unsigned char* base, int ld, int row, int k0, int hi) {
  const u32x2 lo = *(LAS const u32x2*)(base + (row * ld + k0 + 4 * hi) * 2), hh = *(LAS const u32x2*)(base + (row * ld + k0 + 8 + 4 * hi) * 2);
  u32x4 o; o.x = lo.x; o.y = lo.y; o.z = hh.x; o.w = hh.y; return __builtin_bit_cast(bf16x8, o);
}
__device__ __forceinline__ bf16x8 ldT_perm(LAS const unsigned char* base, int ld, int k0, int c0, int lane) {
  const int hi = lane >> 5;
  LAS const unsigned char* a = base + ((k0 + 4 * hi + ((lane & 15) >> 2)) * ld + c0 + 16 * ((lane >> 4) & 1) + 4 * (lane & 3)) * 2;
  const v4i16_t lo = vtr(a), hh = vtr(a + 8 * ld * 2);
  return (bf16x8){lo[0], lo[1], lo[2], lo[3], hh[0], hh[1], hh[2], hh[3]};
}
__device__ __forceinline__ bf16x8 ldT_nat(LAS const unsigned char* base, int ld, int k0, int c0, int lane) {
  const int hi = lane >> 5;
  LAS const unsigned char* a = base + ((k0 + 8 * hi + ((lane & 15) >> 2)) * ld + c0 + 16 * ((lane >> 4) & 1) + 4 * (lane & 3)) * 2;
  const v4i16_t lo = vtr(a), hh = vtr(a + 4 * ld * 2);
  return (bf16x8){lo[0], lo[1], lo[2], lo[3], hh[0], hh[1], hh[2], hh[3]};
}
__device__ __forceinline__ int opq5(int x) { asm volatile("" : "+v"(x)); return x; }
#define MFMA32(A_, B_, C_) __builtin_amdgcn_mfma_f32_32x32x16_bf16((A_), (B_), (C_), 0, 0, 0)

struct CkChain { int seq, dir, hd, m0, L, nch; };
__device__ __forceinline__ CkChain ck_chain(int id) {
  CkChain c;
  if (id < 64) { c.seq = 16 + (id >> 5); c.dir = (id >> 4) & 1; c.hd = id & 15; c.L = 2048; c.m0 = NPT + (c.seq - 16) * 2048; }
  else { const int p = id - 64; c.seq = p >> 5; c.dir = (p >> 4) & 1; c.hd = p & 15; c.L = 256; c.m0 = c.seq * 256; }
  c.nch = c.L / 32; return c;
}

__device__ __forceinline__ void ck_run_chain(const LAS PG& p, unsigned char* ws, LAS unsigned char* lds, const CkChain ch, int lane_in, int wave) {
  const int lane = lane_in;
  const int hi = lane >> 5, r32 = lane & 31;
  float* Yo = (float*)(ws + (ch.dir ? M_YB : M_YF));
  const int NK = ch.nch + 3;
#define CK_PROD(ACC, AOFF, BOFF) do { _Pragma("unroll") for (int i_ = 0; i_ < 16; ++i_) ACC[i_] = 0.f; \
          _Pragma("unroll") for (int ks = 0; ks < 4; ++ks) { \
            const bf16x8 af_ = *(LAS const bf16x8*)(ob + (AOFF) + (r32 * 64 + 16 * ks + 8 * hi) * 2), bf_ = *(LAS const bf16x8*)(ob + (BOFF) + (r32 * 64 + 16 * ks + 8 * hi) * 2); \
            ACC = MFMA32(af_, bf_, ACC); } } while (0)
#define CK_STORE_T(ACC, DST, STRICT) do { _Pragma("unroll") for (int q_ = 0; q_ < 4; ++q_) { \
            float v_[4]; _Pragma("unroll") for (int x_ = 0; x_ < 4; ++x_) { const int s_ = 8 * q_ + 4 * hi + x_; const bool keep_ = (STRICT) ? (s_ < r32) : (s_ <= r32); v_[x_] = keep_ ? ACC[4 * q_ + x_] : 0.f; ACC[4 * q_ + x_] = v_[x_]; } \
            u32x2 w_; w_.x = pk2_(v_[0], v_[1]); w_.y = pk2_(v_[2], v_[3]); *(LAS u32x2*)((DST) + (r32 * 32 + 8 * q_ + 4 * hi) * 2) = w_; } } while (0)
#define CK_STORE_TN(ACC, DST) do { _Pragma("unroll") for (int q_ = 0; q_ < 4; ++q_) { u32x2 w_; w_.x = pk2_(ACC[4 * q_], ACC[4 * q_ + 1]); w_.y = pk2_(ACC[4 * q_ + 2], ACC[4 * q_ + 3]); \
            *(LAS u32x2*)((DST) + (r32 * 32 + 8 * q_ + 4 * hi) * 2) = w_; } } while (0)
  if (wave >= 4) {
    float rw_dec[8], rw_al[8], rw_kq[8], rw_kd[8], rw_r[8], rw_v[8];
    const int nt = wave - 4, col = lane & 15, g = lane >> 4;
    const int froff = CK_FR + nt * 6144 + lane * 16;
#pragma unroll
    for (int i = 0; i < 8; ++i) { rw_dec[i] = 1.f; rw_al[i] = 0.f; rw_kq[i] = 0.f; rw_kd[i] = 0.f; rw_r[i] = 0.f; rw_v[i] = 0.f; }
    prepc_load(p, lds, froff, ch.dir, ch.hd, lane, nt);
    const int pb_e = (4 * g * 64 + 16 * nt + col) * 2;
    const int pb_h = col * 272 + 16 * g;
    const int pb_sq = (16 * g) * 4, pb_sqw = (16 * g + nt) * 4;
    const int dstep = ch.dir ? -1 : 1;
    LDS_BARRIER();
    for (int k = 0; k < NK; ++k) {
      LAS const float* cn = (LAS const float*)(lds + (froff - lane * 16) + 4096) + lane;
      if (k >= 1 && k <= ch.nch) {
        LAS unsigned char* ob = lds + ((k - 1) % 3) * CK_OPS;
        LAS const float* sq = (LAS const float*)(lds + CK_SSQ + ((k - 1) & 1) * 512);
        float cp[8];
        cp[0] = rw_dec[0]; cp[1] = cp[0] * rw_dec[1]; cp[2] = cp[1] * rw_dec[2]; cp[3] = cp[2] * rw_dec[3];
        cp[4] = rw_dec[4]; cp[5] = cp[4] * rw_dec[5]; cp[6] = cp[5] * rw_dec[6]; cp[7] = cp[6] * rw_dec[7];
        float E0, E1;
        {
          float t0 = cp[3], t1 = cp[7];
          float x0 = __shfl(t0, (lane + 48) & 63), x1 = __shfl(t1, (lane + 48) & 63); if (g < 1) { x0 = 1.f; x1 = 1.f; }
          float i0 = t0 * x0, i1 = t1 * x1;
          float y0 = __shfl(i0, (lane + 32) & 63), y1 = __shfl(i1, (lane + 32) & 63); if (g < 2) { y0 = 1.f; y1 = 1.f; }
          i0 *= y0; i1 *= y1;
          float e0 = __shfl(i0, (lane + 48) & 63), e1 = __shfl(i1, (lane + 48) & 63); if (g < 1) { e0 = 1.f; e1 = 1.f; }
          const float T0 = __shfl(i0, col + 48);
          E0 = e0; E1 = T0 * e1;
        }
#pragma unroll
        for (int e = 0; e < 8; ++e) {
          const int mt = e >> 2, r = e & 3;
          const f32x4 q4 = *(LAS const f32x4*)((LAS const unsigned char*)sq + pb_sq + (16 * mt + r) * 16);
          const float rn = rsqrtf((q4.x + q4.y) + (q4.z + q4.w) + 1e-12f);
          const float Eb = mt ? E1 : E0;
          const float Wt = Eb * cp[e], Wp = (r == 0) ? Eb : Eb * cp[e - 1];
          const float iw = __builtin_amdgcn_rcpf(Wt);
          const float kqn = rw_kq[e] * rn;
          LAS unsigned short* o16 = (LAS unsigned short*)(ob + pb_e + (16 * mt + r) * 128);
          o16[0] = bfr(-Wp * kqn);
          o16[2048] = bfr(kqn * rw_al[e] * iw);
          o16[4096] = bfr(rw_kd[e] * iw);
          o16[6144] = bfr(Wt * rw_r[e]);
          o16[8192] = bfr(rw_v[e]);
          if (e == 7 && g == 3) ((LAS float*)(ob + 20480))[16 * nt + col] = Wt;
        }
      }
      if (k < ch.nch) {
        const float c_biasw = cn[0], c_biasa = cn[64], c_kkc = cn[128], c_kac = cn[192], c_rkc = cn[256];
        LAS float* sq = (LAS float*)(lds + CK_SSQ + (k & 1) * 512);
        LAS const unsigned char* in = lds + CK_IN + (k & 1) * CK_INS;
#pragma unroll
        for (int mt = 0; mt < 2; ++mt) {
          f32x4 aw = (f32x4){c_biasw, c_biasw, c_biasw, c_biasw}, aa = (f32x4){c_biasa, c_biasa, c_biasa, c_biasa};
          LAS const unsigned char* hrow = in + 12288 + pb_h + 16 * mt * 272;
          aw = __builtin_amdgcn_mfma_f32_16x16x32_bf16(*(LAS const bf16x8*)(hrow), *(LAS const bf16x8*)(lds + froff), aw, 0, 0, 0);
          aw = __builtin_amdgcn_mfma_f32_16x16x32_bf16(*(LAS const bf16x8*)(hrow + 64), *(LAS const bf16x8*)(lds + froff + 1024), aw, 0, 0, 0);
          aa = __builtin_amdgcn_mfma_f32_16x16x32_bf16(*(LAS const bf16x8*)(hrow + 128), *(LAS const bf16x8*)(lds + froff + 2048), aa, 0, 0, 0);
          aa = __builtin_amdgcn_mfma_f32_16x16x32_bf16(*(LAS const bf16x8*)(hrow + 192), *(LAS const bf16x8*)(lds + froff + 3072), aa, 0, 0, 0);
          unsigned pf_k[8], pf_r[8], pf_v[8];
#pragma unroll
          for (int r = 0; r < 4; ++r) {
            LAS const unsigned short* e16 = (LAS const unsigned short*)(in + pb_e + (16 * mt + r) * 128);
            pf_k[4 * mt + r] = e16[0]; pf_r[4 * mt + r] = e16[2048]; pf_v[4 * mt + r] = e16[4096];
          }
          float sq4[4], bn4[4];
#pragma unroll
          for (int r = 0; r < 4; ++r) {
            const int e = 4 * mt + r;
            const float sig = __builtin_amdgcn_rcpf(1.f + __expf(-aw[r]));
            rw_dec[e] = __expf(-0.6065306597126334f * sig);
            const float a = __builtin_amdgcn_rcpf(1.f + __expf(-aa[r]));
            rw_al[e] = a;
            const float kv = bf2f(pf_k[e]), rv = bf2f(pf_r[e]);
            rw_r[e] = rv; rw_v[e] = bf2f(pf_v[e]);
            const float kq = kv * c_kkc; rw_kq[e] = kq;
            const float kd = kv * (1.f + (a - 1.f) * c_kac); rw_kd[e] = kd;
            sq4[r] = kq * kq; bn4[r] = rv * kd * c_rkc;
          }
#define CK_DPP(v, CTRL) __builtin_bit_cast(float, __builtin_amdgcn_update_dpp(0, __builtin_bit_cast(int, (v)), (CTRL), 0xF, 0xF, true))
#pragma unroll
          for (int r = 0; r < 4; ++r) { sq4[r] += CK_DPP(sq4[r], 0xB1); bn4[r] += CK_DPP(bn4[r], 0xB1); }
#pragma unroll
          for (int r = 0; r < 4; ++r) { sq4[r] += CK_DPP(sq4[r], 0x4E); bn4[r] += CK_DPP(bn4[r], 0x4E); }
#pragma unroll
          for (int r = 0; r < 4; ++r) { sq4[r] += CK_DPP(sq4[r], 0x141); bn4[r] += CK_DPP(bn4[r], 0x141); }
#pragma unroll
          for (int r = 0; r < 4; ++r) { sq4[r] += CK_DPP(sq4[r], 0x140); bn4[r] += CK_DPP(bn4[r], 0x140); }
#undef CK_DPP
          if (col == 0) {
            float* bo = (float*)(ws + M_BON) + ((((unsigned)ch.dir * NTOK + (unsigned)ctok(ch.m0, ch.L, ch.dir, 32 * k + 16 * mt + 4 * g)) * 16u + (unsigned)ch.hd) * 4u + (unsigned)nt);
#pragma unroll
            for (int r = 0; r < 4; ++r) {
              *(LAS float*)((LAS unsigned char*)sq + pb_sqw + (16 * mt + r) * 16) = sq4[r];
              bo[r * dstep * 64] = bn4[r];
            }
          }
        }
      }
      LDS_BARRIER();
    }
  } else if (wave == 3) {
    u32x4 ld_k[4], ld_r[4], ld_v[4], ld_h[8];
#define CK_LOAD(KC) do { const int s0_ = 32 * (KC); \
      _Pragma("unroll") for (int i_ = 0; i_ < 4; ++i_) { const int id_ = lane + 64 * i_; const int t_ = id_ >> 3, c8_ = id_ & 7; \
        const unsigned gi_ = (unsigned)ctok(ch.m0, ch.L, ch.dir, s0_ + t_) * (unsigned)D + (unsigned)(ch.hd * 64 + 8 * c8_); \
        ld_k[i_] = *(const u32x4*)((const bf16_t*)(ws + M_KB) + gi_); ld_r[i_] = *(const u32x4*)((const bf16_t*)(ws + M_RB) + gi_); ld_v[i_] = *(const u32x4*)((const bf16_t*)(ws + M_VB) + gi_); } \
      _Pragma("unroll") for (int i_ = 0; i_ < 8; ++i_) { const int id_ = lane + 64 * i_; const int t_ = id_ >> 4, c8_ = id_ & 15; \
        const unsigned go_ = (unsigned)ctok(ch.m0, ch.L, ch.dir, s0_ + t_) * 256u + (unsigned)((c8_ >> 3) * 128 + ch.dir * 64 + 8 * (c8_ & 7)); \
        ld_h[i_] = *(const u32x4*)((const bf16_t*)(ws + M_HWA) + go_); } } while (0)
#define CK_PUT(BUF) do { LAS unsigned char* in_ = lds + CK_IN + (BUF) * CK_INS; \
      _Pragma("unroll") for (int i_ = 0; i_ < 4; ++i_) { const int id_ = lane + 64 * i_; \
        *(LAS u32x4*)(in_ + id_ * 16) = ld_k[i_]; *(LAS u32x4*)(in_ + 4096 + id_ * 16) = ld_r[i_]; *(LAS u32x4*)(in_ + 8192 + id_ * 16) = ld_v[i_]; } \
      _Pragma("unroll") for (int i_ = 0; i_ < 8; ++i_) { const int id_ = lane + 64 * i_; const int t_ = id_ >> 4, c8_ = id_ & 15; \
        *(LAS u32x4*)(in_ + 12288 + t_ * 272 + c8_ * 16) = ld_h[i_]; } } while (0)
    CK_LOAD(0); CK_PUT(0);
    if (ch.nch > 1) CK_LOAD(1);
    LDS_BARRIER();
    for (int k = 0; k < NK; ++k) {
      if (k + 1 < ch.nch) CK_PUT((k + 1) & 1);
      if (k + 2 < ch.nch) CK_LOAD(k + 2);
      if (k >= 2 && k <= ch.nch + 1) {
        const int lane_o = opq5(lane); const int r32 = lane_o & 31, hi = lane_o >> 5;
        LAS const unsigned char* ob = lds + ((k - 2) % 3) * CK_OPS;
        LAS unsigned char* mx = lds + CK_MX + ((k - 2) & 1) * 8192;
        f32x16 acc;
        CK_PROD(acc, 8192, 0);     CK_STORE_T(acc, mx + 0, true);
        CK_PROD(acc, 4096, 12288); CK_STORE_T(acc, mx + 2048, false);
        CK_PROD(acc, 8192, 12288); CK_STORE_T(acc, mx + 4096, false);
      }
      LDS_BARRIER();
    }
#undef CK_LOAD
#undef CK_PUT
  } else if (wave == 2) {
    LDS_BARRIER();
    for (int k = 0; k < NK; ++k) {
      if (k >= 2 && k <= ch.nch + 1) {
        const int lane_o = opq5(lane); const int r32 = lane_o & 31, hi = lane_o >> 5;
        LAS const unsigned char* ob = lds + ((k - 2) % 3) * CK_OPS;
        LAS unsigned char* mx = lds + CK_MX + ((k - 2) & 1) * 8192;
        LAS unsigned char* sc = lds + CK_SCR;
        f32x16 Q, Pm;
        CK_PROD(Q, 4096, 0);
        CK_STORE_T(Q, sc + 2048, true);
#pragma unroll
        for (int i = 0; i < 16; ++i) Pm[i] = Q[i] + ((crow_(i, hi) == r32) ? 1.f : 0.f);
        CK_STORE_TN(Pm, sc + 4096);
        asm volatile("s_waitcnt lgkmcnt(0)" ::: "memory");
#define CK_MM(ACC, Z1T, Z2T) do { _Pragma("unroll") for (int ks = 0; ks < 2; ++ks) { \
          const bf16x8 af_ = ldT_nat(sc + (Z1T), 32, 16 * ks, 0, lane_o), bf_ = *(LAS const bf16x8*)(sc + (Z2T) + (r32 * 32 + 16 * ks + 8 * hi) * 2); \
          ACC = MFMA32(af_, bf_, ACC); } } while (0)
#pragma unroll 1
        for (int it = 0; it < 4; ++it) {
          f32x16 Q2;
#pragma unroll
          for (int i = 0; i < 16; ++i) Q2[i] = 0.f;
          CK_MM(Q2, 2048, 2048);
          asm volatile("s_waitcnt lgkmcnt(0)" ::: "memory");
          CK_STORE_TN(Q2, sc + 2048);
          asm volatile("s_waitcnt lgkmcnt(0)" ::: "memory");
          CK_MM(Pm, 4096, 2048);
          asm volatile("s_waitcnt lgkmcnt(0)" ::: "memory");
          if (it < 3) { CK_STORE_TN(Pm, sc + 4096); asm volatile("s_waitcnt lgkmcnt(0)" ::: "memory"); }
        }
        CK_STORE_TN(Pm, mx + 6144);
#undef CK_MM
      }
      LDS_BARRIER();
    }
  } else {
    f32x16 St0, St1;
#pragma unroll
    for (int i = 0; i < 16; ++i) { St0[i] = 0.f; St1[i] = 0.f; }
    if (ch.L == 2048) {
      const GASF* s0 = p.state_rwkv + ((((size_t)(ch.seq - 16)) * 2 + ch.dir) * 16 + ch.hd) * 4096 + (size_t)(32 * wave + r32) * 64;
#pragma unroll
      for (int q = 0; q < 4; ++q) {
        const f32x4 a = *(const GAS f32x4*)(s0 + 8 * q + 4 * hi), b = *(const GAS f32x4*)(s0 + 32 + 8 * q + 4 * hi);
        St0[4 * q] = a.x; St0[4 * q + 1] = a.y; St0[4 * q + 2] = a.z; St0[4 * q + 3] = a.w;
        St1[4 * q] = b.x; St1[4 * q + 1] = b.y; St1[4 * q + 2] = b.z; St1[4 * q + 3] = b.w;
      }
    }
    LDS_BARRIER();
    for (int k = 0; k < NK; ++k) {
      const int lane = opq5(lane_in); const int hi = lane >> 5, r32 = lane & 31;
      if (k >= 3) {
        const int kc = k - 3, ih = wave;
        LAS const unsigned char* ob = lds + (kc % 3) * CK_OPS;
        LAS const unsigned char* mx = lds + CK_MX + (kc & 1) * 8192;
        const bf16x8 s00 = cvt8(St0, 0), s01 = cvt8(St0, 1), s10 = cvt8(St1, 0), s11 = cvt8(St1, 1);
        const bf16x8 v0 = ldT_perm(ob + 16384, 64, 0, 32 * ih, lane), v1 = ldT_perm(ob + 16384, 64, 16, 32 * ih, lane);
        f32x16 G, U, Y;
#pragma unroll
        for (int i = 0; i < 16; ++i) { G[i] = 0.f; U[i] = 0.f; Y[i] = 0.f; }
        G = MFMA32(ldA_perm(ob + 0, 64, r32, 0, hi), s00, G);  G = MFMA32(ldA_perm(ob + 0, 64, r32, 16, hi), s01, G);
        G = MFMA32(ldA_perm(ob + 0, 64, r32, 32, hi), s10, G); G = MFMA32(ldA_perm(ob + 0, 64, r32, 48, hi), s11, G);
        G = MFMA32(ldA_perm(mx + 0, 32, r32, 0, hi), v0, G);   G = MFMA32(ldA_perm(mx + 0, 32, r32, 16, hi), v1, G);
        const bf16x8 g0 = cvt8(G, 0), g1 = cvt8(G, 1);
        U = MFMA32(ldA_perm(mx + 6144, 32, r32, 0, hi), g0, U); U = MFMA32(ldA_perm(mx + 6144, 32, r32, 16, hi), g1, U);
        const bf16x8 u0 = cvt8(U, 0), u1 = cvt8(U, 1);
        Y = MFMA32(ldA_perm(ob + 12288, 64, r32, 0, hi), s00, Y);  Y = MFMA32(ldA_perm(ob + 12288, 64, r32, 16, hi), s01, Y);
        Y = MFMA32(ldA_perm(ob + 12288, 64, r32, 32, hi), s10, Y); Y = MFMA32(ldA_perm(ob + 12288, 64, r32, 48, hi), s11, Y);
        Y = MFMA32(ldA_perm(mx + 2048, 32, r32, 0, hi), u0, Y);    Y = MFMA32(ldA_perm(mx + 2048, 32, r32, 16, hi), u1, Y);
        Y = MFMA32(ldA_perm(mx + 4096, 32, r32, 0, hi), v0, Y);    Y = MFMA32(ldA_perm(mx + 4096, 32, r32, 16, hi), v1, Y);
        St0 = MFMA32(ldT_perm(ob + 4096, 64, 0, 0, lane), u0, St0);  St0 = MFMA32(ldT_perm(ob + 4096, 64, 16, 0, lane), u1, St0);
        St0 = MFMA32(ldT_perm(ob + 8192, 64, 0, 0, lane), v0, St0);  St0 = MFMA32(ldT_perm(ob + 8192, 64, 16, 0, lane), v1, St0);
        St1 = MFMA32(ldT_perm(ob + 4096, 64, 0, 32, lane), u0, St1); St1 = MFMA32(ldT_perm(ob + 4096, 64, 16, 32, lane), u1, St1);
        St1 = MFMA32(ldT_perm(ob + 8192, 64, 0, 32, lane), v0, St1); St1 = MFMA32(ldT_perm(ob + 8192, 64, 16, 32, lane), v1, St1);
        LAS const float* wt = (LAS const float*)(ob + 20480);
#pragma unroll
        for (int q = 0; q < 4; ++q) {
          const f32x4 w0 = *(LAS const f32x4*)(wt + 8 * q + 4 * hi), w1 = *(LAS const f32x4*)(wt + 32 + 8 * q + 4 * hi);
          St0[4 * q] *= w0.x; St0[4 * q + 1] *= w0.y; St0[4 * q + 2] *= w0.z; St0[4 * q + 3] *= w0.w;
          St1[4 * q] *= w1.x; St1[4 * q + 1] *= w1.y; St1[4 * q + 2] *= w1.z; St1[4 * q + 3] *= w1.w;
        }
        {
          const int tk0 = ctok(ch.m0, ch.L, ch.dir, 32 * kc); const int dstep = ch.dir ? -1 : 1;
          const unsigned cb = (unsigned)(ch.hd * 64 + 32 * ih + r32);
#pragma unroll
          for (int i = 0; i < 16; ++i) Yo[(unsigned)(tk0 + crow_(i, hi) * dstep) * (unsigned)D + cb] = Y[i];
        }
      }
      LDS_BARRIER();
    }
    if (ch.L == 256) {
    GASF* so = p.out + OUT_ST + ((((size_t)ch.seq) * 2 + ch.dir) * 16 + ch.hd) * 4096 + (size_t)(32 * wave + r32) * 64;
#pragma unroll
    for (int q = 0; q < 4; ++q) {
      *(GAS f32x4*)(so + 8 * q + 4 * hi) = (f32x4){St0[4 * q], St0[4 * q + 1], St0[4 * q + 2], St0[4 * q + 3]};
      *(GAS f32x4*)(so + 32 + 8 * q + 4 * hi) = (f32x4){St1[4 * q], St1[4 * q + 1], St1[4 * q + 2], St1[4 * q + 3]};
    }
  }
  }
}

__device__ __forceinline__ void phase_rw_scan_ck(const LAS PG& p, unsigned char* ws, LAS unsigned char* lds, int tid, int lane, int wave, int bid, int G) {
  if (G >= 128) {
    if (bid < 64) { __syncthreads(); ck_run_chain(p, ws, lds, ck_chain(bid), lane, wave); }
    else { const int nb = G - 64; for (int pc = bid - 64; pc < 512; pc += nb) { __syncthreads(); ck_run_chain(p, ws, lds, ck_chain(64 + pc), lane, wave); } }
  } else {
    for (int id = bid; id < 576; id += G) { __syncthreads(); ck_run_chain(p, ws, lds, ck_chain(id), lane, wave); }
  }
}
__device__ __forceinline__ int opq(int x) { asm volatile("" : "+v"(x)); return x; }
#ifndef RPT_MASK
#define RPT_MASK 0u
#endif
struct MArgs { P p; int ph_lo, ph_hi; };
__global__ void __launch_bounds__(512, 2) mega(MArgs a) {
  extern __shared__ __attribute__((aligned(16))) unsigned char lds_raw[];
  LAS unsigned char* lds = (LAS unsigned char*)lds_raw;
  const int tid = threadIdx.x, lane = tid & 63, wave = __builtin_amdgcn_readfirstlane(tid >> 6);
  const int G = gridDim.x, bid = blockIdx.x;
  unsigned char* ws = (unsigned char*)a.p.ws;
  if (tid == 0) {
    LAS PG* t = (LAS PG*)(lds + PTAB_OFF);
    t->x_prompt = (decltype(t->x_prompt))a.p.x_prompt;
    t->x_sample = (decltype(t->x_sample))a.p.x_sample;
    t->cache_ckv = (decltype(t->cache_ckv))a.p.cache_ckv;
    t->cache_kpe = (decltype(t->cache_kpe))a.p.cache_kpe;
    t->state_rwkv = (decltype(t->state_rwkv))a.p.state_rwkv;
    t->c = (decltype(t->c))a.p.c;
    t->c_ctx = (decltype(t->c_ctx))a.p.c_ctx;
    t->mod_w = (decltype(t->mod_w))a.p.mod_w;
    t->mod_b = (decltype(t->mod_b))a.p.mod_b;
    t->ln_g = (decltype(t->ln_g))a.p.ln_g;
    t->ln_b = (decltype(t->ln_b))a.p.ln_b;
    t->hy_w_in = (decltype(t->hy_w_in))a.p.hy_w_in;
    t->hy_conv_w = (decltype(t->hy_conv_w))a.p.hy_conv_w;
    t->hy_conv_b = (decltype(t->hy_conv_b))a.p.hy_conv_b;
    t->hy_w1 = (decltype(t->hy_w1))a.p.hy_w1;
    t->hy_b1 = (decltype(t->hy_b1))a.p.hy_b1;
    t->hy_w2 = (decltype(t->hy_w2))a.p.hy_w2;
    t->hy_b2 = (decltype(t->hy_b2))a.p.hy_b2;
    t->hy_w3 = (decltype(t->hy_w3))a.p.hy_w3;
    t->hy_b3 = (decltype(t->hy_b3))a.p.hy_b3;
    t->hy_freq = (decltype(t->hy_freq))a.p.hy_freq;
    t->hy_decay = (decltype(t->hy_decay))a.p.hy_decay;
    t->hy_skip = (decltype(t->hy_skip))a.p.hy_skip;
    t->hy_w_out = (decltype(t->hy_w_out))a.p.hy_w_out;
    t->mla_w_in = (decltype(t->mla_w_in))a.p.mla_w_in;
    t->mla_q_norm = (decltype(t->mla_q_norm))a.p.mla_q_norm;
    t->mla_kv_norm = (decltype(t->mla_kv_norm))a.p.mla_kv_norm;
    t->mla_w_q_up = (decltype(t->mla_w_q_up))a.p.mla_w_q_up;
    t->mla_w_kv_up = (decltype(t->mla_w_kv_up))a.p.mla_w_kv_up;
    t->mla_w_out = (decltype(t->mla_w_out))a.p.mla_w_out;
    t->rw_mu = (decltype(t->rw_mu))a.p.rw_mu;
    t->rw_w_in = (decltype(t->rw_w_in))a.p.rw_w_in;
    t->rw_w0 = (decltype(t->rw_w0))a.p.rw_w0;
    t->rw_w1 = (decltype(t->rw_w1))a.p.rw_w1;
    t->rw_w2 = (decltype(t->rw_w2))a.p.rw_w2;
    t->rw_a0 = (decltype(t->rw_a0))a.p.rw_a0;
    t->rw_a1 = (decltype(t->rw_a1))a.p.rw_a1;
    t->rw_a2 = (decltype(t->rw_a2))a.p.rw_a2;
    t->rw_k_k = (decltype(t->rw_k_k))a.p.rw_k_k;
    t->rw_k_a = (decltype(t->rw_k_a))a.p.rw_k_a;
    t->rw_r_k = (decltype(t->rw_r_k))a.p.rw_r_k;
    t->rw_gn_g = (decltype(t->rw_gn_g))a.p.rw_gn_g;
    t->rw_gn_b = (decltype(t->rw_gn_b))a.p.rw_gn_b;
    t->rw_w_out = (decltype(t->rw_w_out))a.p.rw_w_out;
    t->out = (decltype(t->out))a.p.out;
    t->ws = (decltype(t->ws))a.p.ws;
  }
  const LAS PG& p = *(const LAS PG*)(lds + PTAB_OFF);
  volatile LAS unsigned* MISC = (volatile LAS unsigned*)(lds + MISC_OFF);
  for (int u = tid; u < 128; u += 512) ((LAS unsigned*)(lds + MISC_OFF))[u] = 0u;
  __syncthreads();
  const int lo = a.ph_lo, hi = a.ph_hi;
  XcdBarrier bar; bar.bar = (unsigned*)(ws + M_CTL); bar.x = 0; bar.st = nullptr;
  if (hi - lo > 0 || RPT_MASK) bar = xcd_barrier_post((unsigned*)(ws + M_CTL), MISC + 8);
#ifndef PH_MASK
#define PH_MASK 0xffffffffu
#endif
#ifndef TP_PHASE
#define TP_PHASE -1
#endif
#ifndef TP_MULT
#define TP_MULT 4
#endif
  unsigned long long tp0 = 0ull, tp1 = 0ull;
#define IN(k) (((PH_MASK >> (k)) & 1u) && lo <= (k) && (k) < hi)
#define SEAM(k) do { if (IN(k) && IN((k) + 1)) xcd_barrier(bar); if ((k) + 1 == TP_PHASE) tp0 = __builtin_amdgcn_s_memrealtime(); if ((k) == TP_PHASE) tp1 = __builtin_amdgcn_s_memrealtime(); } while (0)
  if (IN(0)) { { phase_p0a(p, ws, lds, opq((int)threadIdx.x), (opq((int)threadIdx.x) & 63), wave, bid, G); } if ((RPT_MASK >> 0) & 1u) { xcd_barrier(bar); { phase_p0a(p, ws, lds, opq((int)threadIdx.x), (opq((int)threadIdx.x) & 63), wave, bid, G); } } } SEAM(0);
  if (IN(1)) { { phase_p0b(p, ws, lds, opq((int)threadIdx.x), (opq((int)threadIdx.x) & 63), wave, bid, G); } if ((RPT_MASK >> 1) & 1u) { xcd_barrier(bar); { phase_p0b(p, ws, lds, opq((int)threadIdx.x), (opq((int)threadIdx.x) & 63), wave, bid, G); } } } SEAM(1);
  if (IN(2)) { {
    pg8::Gemm g{(const pg8::bf16_t*)(ws + W_HYIN), (const pg8::bf16_t*)(ws + M_HB), 4096, 8192, 1024};
    pg8::StaticOrder S; S.init(4096, 8192, G, bid);
    pg8::EpiBf16<0> E{(pg8::bf16_t*)(ws + M_UT), 8192, nullptr, 0, 0, 1.f};
    pg8::gemm_phase<pg8::EpiBf16<0>, pg8::StaticOrder, true, true>(lds, g, S, E); } if ((RPT_MASK >> 2) & 1u) { xcd_barrier(bar); {
    pg8::Gemm g{(const pg8::bf16_t*)(ws + W_HYIN), (const pg8::bf16_t*)(ws + M_HB), 4096, 8192, 1024};
    pg8::StaticOrder S; S.init(4096, 8192, G, bid);
    pg8::EpiBf16<0> E{(pg8::bf16_t*)(ws + M_UT), 8192, nullptr, 0, 0, 1.f};
    pg8::gemm_phase<pg8::EpiBf16<0>, pg8::StaticOrder, true, true>(lds, g, S, E); } } } SEAM(2);
  if (IN(3)) { { phase_hy_conv(p, ws, lds, 0, opq((int)threadIdx.x), (opq((int)threadIdx.x) & 63), wave, bid, G); } if ((RPT_MASK >> 3) & 1u) { xcd_barrier(bar); { phase_hy_conv(p, ws, lds, 0, opq((int)threadIdx.x), (opq((int)threadIdx.x) & 63), wave, bid, G); } } } SEAM(3);
  if (IN(4)) { { phase_out_ln<1>(p, ws, lds, 0, (const bf16_t*)(ws + W_HYOUT), opq((int)threadIdx.x), (opq((int)threadIdx.x) & 63), wave, bid, G); } if ((RPT_MASK >> 4) & 1u) { xcd_barrier(bar); { phase_out_ln<1>(p, ws, lds, 0, (const bf16_t*)(ws + W_HYOUT), opq((int)threadIdx.x), (opq((int)threadIdx.x) & 63), wave, bid, G); } } } SEAM(4);
  if (IN(5)) { {
    pg8::Gemm g{(const pg8::bf16_t*)(ws + M_HB), (const pg8::bf16_t*)(ws + W_MLAIN + MiB), 8192, 1024, 1024};
    pg8::StaticOrder S; S.init(8192, 1024, G, bid);
    EpiSilu E{(bf16_t*)(ws + M_SZB), 1024};
    pg8::gemm_phase<EpiSilu, pg8::StaticOrder, true, true>(lds, g, S, E);
    { pg8::Gemm g2{(const pg8::bf16_t*)(ws + M_HB), (const pg8::bf16_t*)(ws + W_MLAIN), 8192, 512, 1024};
      pg8::StaticOrder S2; S2.init(8192, 512, G, (bid + G - 128 % G) % G);
      EpiF32 E2{(float*)(ws + M_U2S), 512};
      pg8::gemm_phase<EpiF32, pg8::StaticOrder, true, true>(lds, g2, S2, E2); } } if ((RPT_MASK >> 5) & 1u) { xcd_barrier(bar); {
    pg8::Gemm g{(const pg8::bf16_t*)(ws + M_HB), (const pg8::bf16_t*)(ws + W_MLAIN + MiB), 8192, 1024, 1024};
    pg8::StaticOrder S; S.init(8192, 1024, G, bid);
    EpiSilu E{(bf16_t*)(ws + M_SZB), 1024};
    pg8::gemm_phase<EpiSilu, pg8::StaticOrder, true, true>(lds, g, S, E);
    { pg8::Gemm g2{(const pg8::bf16_t*)(ws + M_HB), (const pg8::bf16_t*)(ws + W_MLAIN), 8192, 512, 1024};
      pg8::StaticOrder S2; S2.init(8192, 512, G, (bid + G - 128 % G) % G);
      EpiF32 E2{(float*)(ws + M_U2S), 512};
      pg8::gemm_phase<EpiF32, pg8::StaticOrder, true, true>(lds, g2, S2, E2); } } } } SEAM(5);
  if (IN(6)) { { phase_mla_rows(p, ws, (opq((int)threadIdx.x) & 63), wave, bid, G); xcd_barrier(bar); } {
    { pg8::Gemm g{(const pg8::bf16_t*)(ws + M_QN), (const pg8::bf16_t*)(ws + W_QUP), 8192, 1536, 256};
      pg8::StaticOrder S; S.init(8192, 1536, G, bid);
      pg8::EpiBf16<0> E{(pg8::bf16_t*)(ws + M_Q), 1536, nullptr, 0, 0, 1.f};
      pg8::gemm_phase<pg8::EpiBf16<0>, pg8::StaticOrder, true, true>(lds, g, S, E); }
    { pg8::Gemm g{(const pg8::bf16_t*)(ws + M_CKVALL), (const pg8::bf16_t*)(ws + W_KVUP), 9216, 2048, 128};
      pg8::StaticOrder S; S.init(9216, 2048, G, (bid + G - 192 % G) % G);
      EpiKV E{(bf16_t*)(ws + M_KN), (bf16_t*)(ws + M_V)};
      pg8::gemm_phase<EpiKV, pg8::StaticOrder, true, true>(lds, g, S, E); } } if ((RPT_MASK >> 6) & 1u) { xcd_barrier(bar); { phase_mla_rows(p, ws, (opq((int)threadIdx.x) & 63), wave, bid, G); xcd_barrier(bar); } {
    { pg8::Gemm g{(const pg8::bf16_t*)(ws + M_QN), (const pg8::bf16_t*)(ws + W_QUP), 8192, 1536, 256};
      pg8::StaticOrder S; S.init(8192, 1536, G, bid);
      pg8::EpiBf16<0> E{(pg8::bf16_t*)(ws + M_Q), 1536, nullptr, 0, 0, 1.f};
      pg8::gemm_phase<pg8::EpiBf16<0>, pg8::StaticOrder, true, true>(lds, g, S, E); }
    { pg8::Gemm g{(const pg8::bf16_t*)(ws + M_CKVALL), (const pg8::bf16_t*)(ws + W_KVUP), 9216, 2048, 128};
      pg8::StaticOrder S; S.init(9216, 2048, G, (bid + G - 192 % G) % G);
      EpiKV E{(bf16_t*)(ws + M_KN), (bf16_t*)(ws + M_V)};
      pg8::gemm_phase<EpiKV, pg8::StaticOrder, true, true>(lds, g, S, E); } } } } SEAM(6);
  if (IN(7)) { {
    for (int u = bid; u < 512; u += G) {
      int seq, hd, qb;
      if (u < 256) { seq = 16 + (u >> 7); hd = (u >> 3) & 15; qb = u & 7; } else { const int uu = u - 256; seq = uu >> 4; hd = uu & 15; qb = 0; }
      attn_unit(ws, lds, seq, hd, qb, (bf16_t*)(ws + M_GB), opq((int)threadIdx.x), (opq((int)threadIdx.x) & 63), wave);
    } } if ((RPT_MASK >> 7) & 1u) { xcd_barrier(bar); {
    for (int u = bid; u < 512; u += G) {
      int seq, hd, qb;
      if (u < 256) { seq = 16 + (u >> 7); hd = (u >> 3) & 15; qb = u & 7; } else { const int uu = u - 256; seq = uu >> 4; hd = uu & 15; qb = 0; }
      attn_unit(ws, lds, seq, hd, qb, (bf16_t*)(ws + M_GB), opq((int)threadIdx.x), (opq((int)threadIdx.x) & 63), wave);
    } } } } SEAM(7);
  if (IN(8)) { { phase_out_ln<0>(p, ws, lds, 1, (const bf16_t*)(ws + W_MLAOUT), opq((int)threadIdx.x), (opq((int)threadIdx.x) & 63), wave, bid, G); } if ((RPT_MASK >> 8) & 1u) { xcd_barrier(bar); { phase_out_ln<0>(p, ws, lds, 1, (const bf16_t*)(ws + W_MLAOUT), opq((int)threadIdx.x), (opq((int)threadIdx.x) & 63), wave, bid, G); } } } SEAM(8);
  if (IN(9)) { { phase_rw_mix(p, ws, opq((int)threadIdx.x), bid, G); } if ((RPT_MASK >> 9) & 1u) { xcd_barrier(bar); { phase_rw_mix(p, ws, opq((int)threadIdx.x), bid, G); } } } SEAM(9);
  if (IN(10)) { {
#pragma unroll 1
    for (int q = 0; q < 4; ++q) {
      pg8::Gemm g{(const pg8::bf16_t*)(ws + M_XMIX + (size_t)q * 16 * MiB), (const pg8::bf16_t*)(ws + W_RWIN + (size_t)q * 2 * MiB), 8192, 1024, 1024};
      pg8::StaticOrder S; S.init(8192, 1024, G, (bid + (q & 1) * (G / 2)) % G);
      if (q < 3) { pg8::EpiBf16<0> E{(pg8::bf16_t*)(ws + M_SCR2 + (size_t)q * 16 * MiB), 1024, nullptr, 0, 0, 1.f}; pg8::gemm_phase<pg8::EpiBf16<0>, pg8::StaticOrder, true, true>(lds, g, S, E); }
      else { EpiSilu E{(bf16_t*)(ws + M_SZR), 1024}; pg8::gemm_phase<EpiSilu, pg8::StaticOrder, true, true>(lds, g, S, E); }
    }
    for (int tile = bid; tile < 256; tile += G) rw_lora_tile(p, ws, lds, tile, opq((int)threadIdx.x), (opq((int)threadIdx.x) & 63), wave); } if ((RPT_MASK >> 10) & 1u) { xcd_barrier(bar); {
#pragma unroll 1
    for (int q = 0; q < 4; ++q) {
      pg8::Gemm g{(const pg8::bf16_t*)(ws + M_XMIX + (size_t)q * 16 * MiB), (const pg8::bf16_t*)(ws + W_RWIN + (size_t)q * 2 * MiB), 8192, 1024, 1024};
      pg8::StaticOrder S; S.init(8192, 1024, G, (bid + (q & 1) * (G / 2)) % G);
      if (q < 3) { pg8::EpiBf16<0> E{(pg8::bf16_t*)(ws + M_SCR2 + (size_t)q * 16 * MiB), 1024, nullptr, 0, 0, 1.f}; pg8::gemm_phase<pg8::EpiBf16<0>, pg8::StaticOrder, true, true>(lds, g, S, E); }
      else { EpiSilu E{(bf16_t*)(ws + M_SZR), 1024}; pg8::gemm_phase<EpiSilu, pg8::StaticOrder, true, true>(lds, g, S, E); }
    }
    for (int tile = bid; tile < 256; tile += G) rw_lora_tile(p, ws, lds, tile, opq((int)threadIdx.x), (opq((int)threadIdx.x) & 63), wave); } } } SEAM(10);
  if (IN(11)) { { phase_rw_scan_ck(p, ws, lds, opq((int)threadIdx.x), (opq((int)threadIdx.x) & 63), wave, bid, G); } if ((RPT_MASK >> 11) & 1u) { xcd_barrier(bar); { phase_rw_scan_ck(p, ws, lds, opq((int)threadIdx.x), (opq((int)threadIdx.x) & 63), wave, bid, G); } } } SEAM(11);
  if (IN(12)) { { phase_out_ln<2>(p, ws, lds, 2, (const bf16_t*)(ws + W_RWOUT), opq((int)threadIdx.x), (opq((int)threadIdx.x) & 63), wave, bid, G); } if ((RPT_MASK >> 12) & 1u) { xcd_barrier(bar); { phase_out_ln<2>(p, ws, lds, 2, (const bf16_t*)(ws + W_RWOUT), opq((int)threadIdx.x), (opq((int)threadIdx.x) & 63), wave, bid, G); } } } SEAM(12);
  if (IN(13)) { {
    pg8::Gemm g{(const pg8::bf16_t*)(ws + W_HYIN + 8 * MiB), (const pg8::bf16_t*)(ws + M_HB), 4096, 8192, 1024};
    pg8::StaticOrder S; S.init(4096, 8192, G, bid);
    pg8::EpiBf16<0> E{(pg8::bf16_t*)(ws + M_UT), 8192, nullptr, 0, 0, 1.f};
    pg8::gemm_phase<pg8::EpiBf16<0>, pg8::StaticOrder, true, true>(lds, g, S, E); } if ((RPT_MASK >> 13) & 1u) { xcd_barrier(bar); {
    pg8::Gemm g{(const pg8::bf16_t*)(ws + W_HYIN + 8 * MiB), (const pg8::bf16_t*)(ws + M_HB), 4096, 8192, 1024};
    pg8::StaticOrder S; S.init(4096, 8192, G, bid);
    pg8::EpiBf16<0> E{(pg8::bf16_t*)(ws + M_UT), 8192, nullptr, 0, 0, 1.f};
    pg8::gemm_phase<pg8::EpiBf16<0>, pg8::StaticOrder, true, true>(lds, g, S, E); } } } SEAM(13);
  if (IN(14)) { { phase_hy_conv(p, ws, lds, 1, opq((int)threadIdx.x), (opq((int)threadIdx.x) & 63), wave, bid, G); } if ((RPT_MASK >> 14) & 1u) { xcd_barrier(bar); { phase_hy_conv(p, ws, lds, 1, opq((int)threadIdx.x), (opq((int)threadIdx.x) & 63), wave, bid, G); } } } SEAM(14);
  if (IN(15)) { { phase_out_ln<1>(p, ws, lds, 3, (const bf16_t*)(ws + W_HYOUT + 2 * MiB), opq((int)threadIdx.x), (opq((int)threadIdx.x) & 63), wave, bid, G); } if ((RPT_MASK >> 15) & 1u) { xcd_barrier(bar); { phase_out_ln<1>(p, ws, lds, 3, (const bf16_t*)(ws + W_HYOUT + 2 * MiB), opq((int)threadIdx.x), (opq((int)threadIdx.x) & 63), wave, bid, G); } } }
  if (TP_PHASE >= 0 && bid == 0) { if (TP_PHASE == 15) tp1 = __builtin_amdgcn_s_memrealtime(); const unsigned long long dl = (tp1 - tp0) * TP_MULT; const unsigned long long ts = __builtin_amdgcn_s_memrealtime(); while (__builtin_amdgcn_s_memrealtime() - ts < dl) __builtin_amdgcn_s_sleep(8); }
#undef IN
#undef SEAM
}
}
}

extern "C" void kernel_launch(void* const* d_in, const int* in_sizes, int n_in, void* d_out, int out_size, void* d_ws, size_t ws_size, hipStream_t stream) {
  P p{};
  const float** pp = (const float**)&p;
  for (int i = 0; i < 44; ++i) pp[i] = (const float*)d_in[i];
  p.out = (float*)d_out; p.ws = (float*)d_ws;
  float* ws = p.ws;
  static int grid = 0;
  if (grid == 0) {
    int dev = 0, cus = 0;
    (void)hipGetDevice(&dev); (void)hipDeviceGetAttribute(&cus, hipDeviceAttributeMultiprocessorCount, dev);
    (void)hipFuncSetAttribute((const void*)mk::mega, hipFuncAttributeMaxDynamicSharedMemorySize, mk::LDS_BYTES);
    grid = cus > 0 ? cus : 256;
  }
  (void)hipMemsetAsync((char*)d_ws + mk::M_CTL, 0, 65536, stream);
  mk::MArgs a{}; a.p = p; a.ph_lo = 0; a.ph_hi = MEGA_PHASES;
  hipLaunchKernelGGL(mk::mega, dim3(grid), dim3(512), mk::LDS_BYTES, stream, a);

  float* X = ws + WS_X; float* S1 = ws + WS_S1; float* S4 = ws + WS_S4; float* S2 = ws + WS_S2;
  const int EB = (int)((SZ + 255) / 256);
  if (NAIVE_FROM < 4) hipLaunchKernelGGL(k_mods, dim3((4 * 3 * 3072 + 255) / 256), dim3(256), 0, stream, p);
  for (int layer = NAIVE_FROM; layer < 4; ++layer) {
    const int kind = layer % 3, j = layer / 3;
    const float* xa = (layer == 0) ? p.x_prompt : X;
    const float* xb = (layer == 0) ? p.x_sample : X + (size_t)NPT * D;
    float* Xn = (layer == 3) ? p.out + OUT_Y : X;
    hipLaunchKernelGGL(k_modulate, dim3(EB), dim3(256), 0, stream, p, xa, xb, S1, layer);
    if (kind == 0) {
      hipLaunchKernelGGL(k_hy_filter, dim3(2304), dim3(256), 0, stream, p, j);
      gemm(stream, ALPlain{S1, D}, p.hy_w_in + (size_t)j * D * 4096, 4096, NTOK, 4096, D, EPPlain{S2, 4096});
      hipLaunchKernelGGL(k_hy_vv, dim3(EB), dim3(256), 0, stream, p, S2, S1, j);
      hipLaunchKernelGGL(k_hy_long, dim3(EB), dim3(256), 0, stream, p, S2, S1, S4, j);
      gemm(stream, ALPlain{S4, D}, p.hy_w_out + (size_t)j * D * D, D, NTOK, D, D, EPPlain{S1, D});
    } else if (kind == 1) {
      float* U2 = S2; float* QN = S1; float* CKVALL = S1 + (size_t)NTOK * 256; float* KPEALL = CKVALL + (size_t)9216 * 128;
      float* Q = S2; float* KV = S2 + (size_t)NTOK * 1536;
      gemm(stream, ALPlain{S1, D}, p.mla_w_in, 1440, NTOK, 1440, D, EPPlain{U2, 1440});
      hipLaunchKernelGGL(k_mla_extract, dim3(NTOK), dim3(64), 0, stream, p, U2, QN, CKVALL, KPEALL, S4);
      hipLaunchKernelGGL(k_mla_cache, dim3((2 * PAST * 128 + 255) / 256), dim3(256), 0, stream, p, CKVALL, KPEALL);
      gemm(stream, ALPlain{QN, 256}, p.mla_w_q_up, 1536, NTOK, 1536, 256, EPPlain{Q, 1536});
      hipLaunchKernelGGL(k_rope_q, dim3((4096 * 16 + 255) / 256), dim3(256), 0, stream, Q);
      gemm(stream, ALPlain{CKVALL, 128}, p.mla_w_kv_up, 2048, 9216, 2048, 128, EPPlain{KV, 2048});
      hipLaunchKernelGGL(k_attn, dim3(32, 18 * 16), dim3(64), 0, stream, Q, KV, KPEALL, S4);
      gemm(stream, ALPlain{S4, D}, p.mla_w_out, D, NTOK, D, D, EPPlain{S1, D});
    } else {
      float* R = S2; float* K = S2 + SZ; float* V = S2 + 2 * SZ; float* Z = S2 + 3 * SZ;
      float* HW = ws + WS_MISC + MISC_END; float* HA = HW + (size_t)NTOK * 128;
      const float* mu = p.rw_mu; const float* win = p.rw_w_in;
      gemm(stream, ALMix{S1, mu + 0 * D}, win + 0 * (size_t)D * D, D, NTOK, D, D, EPPlain{R, D});
      gemm(stream, ALMix{S1, mu + 2 * D}, win + 1 * (size_t)D * D, D, NTOK, D, D, EPPlain{K, D});
      gemm(stream, ALMix{S1, mu + 3 * D}, win + 2 * (size_t)D * D, D, NTOK, D, D, EPPlain{V, D});
      gemm(stream, ALMix{S1, mu + 5 * D}, win + 3 * (size_t)D * D, D, NTOK, D, D, EPPlain{Z, D});
      for (int dir = 0; dir < 2; ++dir) {
        gemm(stream, ALMix{S1, mu + 1 * D}, p.rw_w1 + (size_t)dir * D * 64, 64, NTOK, 64, D, EPTanh{HW + dir * 64, 128});
        gemm(stream, ALMix{S1, mu + 4 * D}, p.rw_a1 + (size_t)dir * D * 64, 64, NTOK, 64, D, EPPlain{HA + dir * 64, 128});
      }
      (void)hipMemsetAsync(S4, 0, SZ * sizeof(float), stream);
      hipLaunchKernelGGL(k_rw_scan, dim3(18 * 32), dim3(64), 0, stream, p, R, K, V, HW, HA, S4);
      hipLaunchKernelGGL(k_rw_post, dim3(NTOK * 16), dim3(64), 0, stream, p, R, K, V, Z, HA, S4, S4);
      gemm(stream, ALPlain{S4, D}, p.rw_w_out, D, NTOK, D, D, EPPlain{S1, D});
    }
    hipLaunchKernelGGL(k_ln, dim3(NTOK / 4), dim3(256), 0, stream, p, xa, xb, S1, Xn, layer);
  }
}
```

```cpp
#define MEGA_PHASES 16
#define NAIVE_FROM 4
#define RPT_MASK 0x0u
#include <hip/hip_runtime.h>
#include <stdint.h>
#include <math.h>

namespace {

constexpr int D = 1024;
constexpr int NTOK = 8192;
constexpr int NPT = 4096;
constexpr int PAST = 512;
constexpr float ALPHA = 1.681792830507429f;
constexpr float LN_EPS = 1e-5f, RMS_EPS = 1e-6f, GN_EPS = 64e-5f;

struct P {
  const float *x_prompt, *x_sample, *cache_ckv, *cache_kpe, *state_rwkv, *c, *c_ctx;
  const float *mod_w, *mod_b, *ln_g, *ln_b;
  const float *hy_w_in, *hy_conv_w, *hy_conv_b, *hy_w1, *hy_b1, *hy_w2, *hy_b2, *hy_w3, *hy_b3, *hy_freq, *hy_decay, *hy_skip, *hy_w_out;
  const float *mla_w_in, *mla_q_norm, *mla_kv_norm, *mla_w_q_up, *mla_w_kv_up, *mla_w_out;
  const float *rw_mu, *rw_w_in, *rw_w0, *rw_w1, *rw_w2, *rw_a0, *rw_a1, *rw_a2, *rw_k_k, *rw_k_a, *rw_r_k, *rw_gn_g, *rw_gn_b, *rw_w_out;
  float* out;
  float* ws;
};

constexpr size_t OUT_Y = 0, OUT_CKV = 8388608, OUT_KPE = 8912896, OUT_ST = 9043968;

constexpr size_t SZ = (size_t)NTOK * D;
constexpr size_t WS_X = 0;
constexpr size_t WS_S1 = WS_X + SZ;
constexpr size_t WS_S4 = WS_S1 + SZ;
constexpr size_t WS_S2 = WS_S4 + SZ;
constexpr size_t WS_MISC = WS_S2 + 4 * SZ;
constexpr size_t MISC_MODS = 0;
constexpr size_t MISC_FILT = 65536;
constexpr size_t MISC_END = MISC_FILT + (size_t)2304 * 2048;

__device__ __forceinline__ float silu(float x) { return x / (1.f + expf(-x)); }
__device__ __forceinline__ float sigmoidf(float x) { return 1.f / (1.f + expf(-x)); }

__device__ __forceinline__ void tokinfo(int m, int& l, int& L, int& cond, int& m0) {
  if (m < NPT) { l = m & 255; L = 256; cond = 0; m0 = m & ~255; }
  else { int mm = m - NPT; l = mm & 2047; L = 2048; cond = 1 + (mm >> 11); m0 = NPT + (mm & ~2047); }
}

__global__ void k_mods(P p) {
  int idx = blockIdx.x * blockDim.x + threadIdx.x;
  if (idx >= 4 * 3 * 3072) return;
  int n = idx % 3072, g = (idx / 3072) % 3, i = idx / (3 * 3072);
  const float* cond = (g == 0) ? p.c_ctx : p.c + (size_t)(g - 1) * D;
  const float* w = p.mod_w + (size_t)i * D * 3072;
  float acc = 0.f;
  for (int k = 0; k < D; ++k) acc += silu(cond[k]) * w[(size_t)k * 3072 + n];
  p.ws[WS_MISC + MISC_MODS + idx] = acc + p.mod_b[i * 3072 + n];
}

__global__ void k_modulate(P p, const float* xa, const float* xb, float* H, int layer) {
  size_t idx = (size_t)blockIdx.x * blockDim.x + threadIdx.x;
  if (idx >= SZ) return;
  int m = (int)(idx >> 10), k = (int)(idx & 1023);
  int l, L, cond, m0; tokinfo(m, l, L, cond, m0);
  const float* md = p.ws + WS_MISC + MISC_MODS + (size_t)(layer * 3 + cond) * 3072;
  float x = (m < NPT) ? xa[idx] : xb[idx - (size_t)NPT * D];
  H[idx] = x * (1.f + md[1024 + k]) + md[k];
}

template <class AL, class EP>
__global__ void __launch_bounds__(256) k_gemm(AL al, const float* __restrict__ W, int ldw, int M, int N, int K, EP ep) {
  __shared__ float As[16][68];
  __shared__ float Bs[16][68];
  const int tx = threadIdx.x & 15, ty = threadIdx.x >> 4;
  const int m0 = blockIdx.y * 64, n0 = blockIdx.x * 64;
  float acc[4][4];
#pragma unroll
  for (int i = 0; i < 4; ++i)
#pragma unroll
    for (int j = 0; j < 4; ++j) acc[i][j] = 0.f;
  for (int k0 = 0; k0 < K; k0 += 16) {
#pragma unroll
    for (int i = 0; i < 4; ++i) {
      int e = threadIdx.x + i * 256; int mm = e >> 4, kk = e & 15;
      As[kk][mm] = (m0 + mm < M) ? al(m0 + mm, k0 + kk) : 0.f;
    }
#pragma unroll
    for (int i = 0; i < 4; ++i) {
      int e = threadIdx.x + i * 256; int kk = e >> 6, nn = e & 63;
      Bs[kk][nn] = (n0 + nn < N) ? W[(size_t)(k0 + kk) * ldw + n0 + nn] : 0.f;
    }
    __syncthreads();
#pragma unroll
    for (int kk = 0; kk < 16; ++kk) {
      float a[4], b[4];
#pragma unroll
      for (int i = 0; i < 4; ++i) { a[i] = As[kk][ty * 4 + i]; b[i] = Bs[kk][tx * 4 + i]; }
#pragma unroll
      for (int i = 0; i < 4; ++i)
#pragma unroll
        for (int j = 0; j < 4; ++j) acc[i][j] += a[i] * b[j];
    }
    __syncthreads();
  }
#pragma unroll
  for (int i = 0; i < 4; ++i)
#pragma unroll
    for (int j = 0; j < 4; ++j) {
      int m = m0 + ty * 4 + i, n = n0 + tx * 4 + j;
      if (m < M && n < N) ep(m, n, acc[i][j]);
    }
}

struct ALPlain { const float* A; long lda; __device__ float operator()(int m, int k) const { return A[(size_t)m * lda + k]; } };
struct EPPlain { float* C; long ldc; __device__ void operator()(int m, int n, float v) const { C[(size_t)m * ldc + n] = v; } };
struct EPTanh { float* C; long ldc; __device__ void operator()(int m, int n, float v) const { C[(size_t)m * ldc + n] = tanhf(v); } };
struct ALMix {
  const float* H; const float* mu;
  __device__ float operator()(int m, int k) const {
    int l, L, cond, m0; tokinfo(m, l, L, cond, m0);
    float h = H[(size_t)m * D + k];
    float pv = (l > 0) ? H[(size_t)(m - 1) * D + k] : 0.f;
    float nx = (l < L - 1) ? H[(size_t)(m + 1) * D + k] : 0.f;
    return h + (0.5f * (pv + nx) - h) * mu[k];
  }
};

template <class AL, class EP>
void gemm(hipStream_t s, AL al, const float* W, int ldw, int M, int N, int K, EP ep) {
  dim3 g((N + 63) / 64, (M + 63) / 64);
  hipLaunchKernelGGL((k_gemm<AL, EP>), g, dim3(256), 0, s, al, W, ldw, M, N, K, ep);
}

__global__ void __launch_bounds__(256) k_ln(P p, const float* xa, const float* xb, const float* O, float* Xn, int layer) {
  int m = blockIdx.x * 4 + (threadIdx.x >> 6), lane = threadIdx.x & 63;
  int l, L, cond, m0; tokinfo(m, l, L, cond, m0);
  const float* gate = p.ws + WS_MISC + MISC_MODS + (size_t)(layer * 3 + cond) * 3072 + 2048;
  const float* xr = (m < NPT) ? xa + (size_t)m * D : xb + (size_t)(m - NPT) * D;
  float v[16]; float s = 0.f;
#pragma unroll
  for (int i = 0; i < 16; ++i) { int k = lane + 64 * i; v[i] = ALPHA * xr[k] + gate[k] * O[(size_t)m * D + k]; s += v[i]; }
#pragma unroll
  for (int o = 1; o < 64; o <<= 1) s += __shfl_xor(s, o);
  float mu = s * (1.f / D), q = 0.f;
#pragma unroll
  for (int i = 0; i < 16; ++i) { v[i] -= mu; q += v[i] * v[i]; }
#pragma unroll
  for (int o = 1; o < 64; o <<= 1) q += __shfl_xor(q, o);
  float rs = rsqrtf(q * (1.f / D) + LN_EPS);
#pragma unroll
  for (int i = 0; i < 16; ++i) { int k = lane + 64 * i; Xn[(size_t)m * D + k] = v[i] * rs * p.ln_g[layer * D + k] + p.ln_b[layer * D + k]; }
}

__global__ void __launch_bounds__(256) k_hy_filter(P p, int j) {
  __shared__ float feat[33], h1[64], h2[64];
  int row = blockIdx.x; int L = row < 256 ? 256 : 2048; int l = row < 256 ? row : row - 256;
  int tid = threadIdx.x;
  float t = (float)l / (float)(L - 1);
  if (tid < 33) {
    float f;
    if (tid == 0) f = t;
    else {
      int b = (tid - 1) & 15;
      float band = 1e-4f + (float)b * ((15.f - 1e-4f) / 15.f);
      float ang = (6.283185307179586f / (float)L) * (float)l * band;
      f = (tid <= 16) ? cosf(ang) : -sinf(ang);
    }
    feat[tid] = f;
  }
  __syncthreads();
  if (tid < 64) {
    float a = p.hy_b1[j * 64 + tid];
    for (int f = 0; f < 33; ++f) a += feat[f] * p.hy_w1[((size_t)j * 33 + f) * 64 + tid];
    h1[tid] = sinf(p.hy_freq[(j * 2 + 0) * 64 + tid] * a);
  }
  __syncthreads();
  if (tid < 64) {
    float a = p.hy_b2[j * 64 + tid];
    for (int f = 0; f < 64; ++f) a += h1[f] * p.hy_w2[((size_t)j * 64 + f) * 64 + tid];
    h2[tid] = sinf(p.hy_freq[(j * 2 + 1) * 64 + tid] * a);
  }
  __syncthreads();
  for (int o = tid; o < 2048; o += 256) {
    float a = p.hy_b3[j * 2048 + o];
    for (int f = 0; f < 64; ++f) a += h2[f] * p.hy_w3[((size_t)j * 64 + f) * 2048 + o];
    float w = expf(-t * fabsf(p.hy_decay[(size_t)j * 2048 + o]));
    p.ws[WS_MISC + MISC_FILT + (size_t)row * 2048 + o] = a * w;
  }
}

__device__ __forceinline__ float conv3(const float* U, int m, int l, int L, int ch, const float* cw, const float* cb) {
  float cur = U[(size_t)m * 4096 + ch];
  float pv = (l > 0) ? U[(size_t)(m - 1) * 4096 + ch] : 0.f;
  float nx = (l < L - 1) ? U[(size_t)(m + 1) * 4096 + ch] : 0.f;
  return pv * cw[ch] + cur * cw[3072 + ch] + nx * cw[6144 + ch] + cb[ch];
}
__global__ void k_hy_vv(P p, const float* U, float* VV, int j) {
  size_t idx = (size_t)blockIdx.x * blockDim.x + threadIdx.x;
  if (idx >= SZ) return;
  int m = (int)(idx >> 10), c = (int)(idx & 1023);
  int l, L, cond, m0; tokinfo(m, l, L, cond, m0);
  const float* cw = p.hy_conv_w + (size_t)j * 3 * 3072; const float* cb = p.hy_conv_b + (size_t)j * 3072;
  float x1 = conv3(U, m, l, L, 1024 + c, cw, cb);
  float v = conv3(U, m, l, L, 2048 + c, cw, cb);
  VV[idx] = v * x1;
}
__global__ void k_hy_long(P p, const float* U, const float* VV, float* G, int j) {
  size_t idx = (size_t)blockIdx.x * blockDim.x + threadIdx.x;
  if (idx >= SZ) return;
  int m = (int)(idx >> 10), c = (int)(idx & 1023);
  int l, L, cond, m0; tokinfo(m, l, L, cond, m0);
  const float* F = p.ws + WS_MISC + MISC_FILT + (size_t)(L == 256 ? 0 : 256) * 2048;
  float acc = 0.f;
  for (int s = 0; s <= l; ++s) acc += VV[(size_t)(m0 + s) * D + c] * F[(size_t)(l - s) * 2048 + c];
  for (int s = l + 1; s < L; ++s) acc += VV[(size_t)(m0 + s) * D + c] * F[(size_t)(s - l) * 2048 + 1024 + c];
  const float* cw = p.hy_conv_w + (size_t)j * 3 * 3072; const float* cb = p.hy_conv_b + (size_t)j * 3072;
  float x0 = conv3(U, m, l, L, c, cw, cb);
  float z = U[(size_t)m * 4096 + 3072 + c];
  float y = (acc + VV[idx] * p.hy_skip[j * D + c]) * x0;
  G[idx] = y * silu(z);
}

__device__ __forceinline__ int kvrow(int m) { if (m < NPT) return m; int mm = m - NPT; return NPT + (mm >> 11) * 2560 + PAST + (mm & 2047); }
__device__ __forceinline__ void rope32(const float* x, float* o, int l) {
  int r = l >> 6, col = l & 63;
#pragma unroll
  for (int i = 0; i < 8; ++i) {
    float inv = powf(10000.f, -(float)(2 * i) / 16.f);
    float ar = (float)r * inv, ac = (float)col * inv;
    float cr = cosf(ar), sr = sinf(ar), cc = cosf(ac), sc = sinf(ac);
    o[i] = x[i] * cr - x[i + 8] * sr;
    o[i + 8] = x[i + 8] * cr + x[i] * sr;
    o[16 + i] = x[16 + i] * cc - x[24 + i] * sc;
    o[24 + i] = x[24 + i] * cc + x[16 + i] * sc;
  }
}
__global__ void __launch_bounds__(64) k_mla_extract(P p, const float* U2, float* QN, float* CKVALL, float* KPEALL, float* Z) {
  int m = blockIdx.x, lane = threadIdx.x;
  int l, L, cond, m0; tokinfo(m, l, L, cond, m0);
  const float* u = U2 + (size_t)m * 1440;
  float q[4], s = 0.f;
#pragma unroll
  for (int i = 0; i < 4; ++i) { q[i] = u[lane + 64 * i]; s += q[i] * q[i]; }
#pragma unroll
  for (int o = 1; o < 64; o <<= 1) s += __shfl_xor(s, o);
  float rs = rsqrtf(s * (1.f / 256.f) + RMS_EPS);
#pragma unroll
  for (int i = 0; i < 4; ++i) QN[(size_t)m * 256 + lane + 64 * i] = q[i] * rs * p.mla_q_norm[lane + 64 * i];
  float k0 = u[256 + lane], k1 = u[256 + 64 + lane];
  float s2 = k0 * k0 + k1 * k1;
#pragma unroll
  for (int o = 1; o < 64; o <<= 1) s2 += __shfl_xor(s2, o);
  float rs2 = rsqrtf(s2 * (1.f / 128.f) + RMS_EPS);
  float c0 = k0 * rs2 * p.mla_kv_norm[lane], c1 = k1 * rs2 * p.mla_kv_norm[64 + lane];
  int kr = kvrow(m);
  CKVALL[(size_t)kr * 128 + lane] = c0; CKVALL[(size_t)kr * 128 + 64 + lane] = c1;
  if (m < NPT) { p.out[OUT_CKV + (size_t)m * 128 + lane] = c0; p.out[OUT_CKV + (size_t)m * 128 + 64 + lane] = c1; }
  if (lane == 0) {
    float x[32], o[32];
#pragma unroll
    for (int i = 0; i < 32; ++i) x[i] = u[384 + i];
    if (m < NPT) {
#pragma unroll
      for (int i = 0; i < 32; ++i) { KPEALL[(size_t)kr * 32 + i] = x[i]; p.out[OUT_KPE + (size_t)m * 32 + i] = x[i]; }
    } else {
      rope32(x, o, l);
#pragma unroll
      for (int i = 0; i < 32; ++i) KPEALL[(size_t)kr * 32 + i] = o[i];
    }
  }
  for (int i = lane; i < 1024; i += 64) Z[(size_t)m * D + i] = u[416 + i];
}
__global__ void k_mla_cache(P p, float* CKVALL, float* KPEALL) {
  int idx = blockIdx.x * blockDim.x + threadIdx.x;
  if (idx >= 2 * PAST * 128) return;
  int d = idx & 127, pl = (idx >> 7) & 511, b = idx >> 16;
  int row = NPT + b * 2560 + pl;
  CKVALL[(size_t)row * 128 + d] = p.cache_ckv[idx];
  if (d < 32) KPEALL[(size_t)row * 32 + d] = p.cache_kpe[((size_t)b * PAST + pl) * 32 + d];
}
__global__ void k_rope_q(float* Q) {
  int idx = blockIdx.x * blockDim.x + threadIdx.x;
  if (idx >= 4096 * 16) return;
  int h = idx & 15, mm = idx >> 4; int m = NPT + mm; int l = mm & 2047;
  float* q = Q + (size_t)m * 1536 + h * 96 + 64;
  float x[32], o[32];
#pragma unroll
  for (int i = 0; i < 32; ++i) x[i] = q[i];
  rope32(x, o, l);
#pragma unroll
  for (int i = 0; i < 32; ++i) q[i] = o[i];
}
__global__ void __launch_bounds__(64) k_attn(const float* Q, const float* KV, const float* KPEALL, float* G) {
  int qi = blockIdx.x * 64 + threadIdx.x;
  int sh = blockIdx.y; int h = sh & 15, seq = sh >> 4;
  int L = seq < 16 ? 256 : 2048;
  if (qi >= L) return;
  int m = seq < 16 ? seq * 256 + qi : NPT + (seq - 16) * 2048 + qi;
  int kbase = seq < 16 ? seq * 256 : NPT + (seq - 16) * 2560;
  int nk = seq < 16 ? 256 : 2560;
  float q[96];
#pragma unroll
  for (int i = 0; i < 96; ++i) q[i] = Q[(size_t)m * 1536 + h * 96 + i];
  float acc[64];
#pragma unroll
  for (int i = 0; i < 64; ++i) acc[i] = 0.f;
  float mx = -1e30f, lsum = 0.f;
  const float scale = 0.10206207261596575f;
  for (int k = 0; k < nk; ++k) {
    const float* kv = KV + (size_t)(kbase + k) * 2048 + h * 128;
    const float* kp = KPEALL + (size_t)(kbase + k) * 32;
    float s = 0.f;
#pragma unroll
    for (int i = 0; i < 64; ++i) s += q[i] * kv[i];
#pragma unroll
    for (int i = 0; i < 32; ++i) s += q[64 + i] * kp[i];
    s *= scale;
    float mn = fmaxf(mx, s);
    float corr = expf(mx - mn), pe = expf(s - mn);
    lsum = lsum * corr + pe;
#pragma unroll
    for (int i = 0; i < 64; ++i) acc[i] = acc[i] * corr + pe * kv[64 + i];
    mx = mn;
  }
  float inv = 1.f / lsum;
#pragma unroll
  for (int i = 0; i < 64; ++i) { size_t o = (size_t)m * D + h * 64 + i; G[o] = acc[i] * inv * silu(G[o]); }
}

__global__ void __launch_bounds__(64) k_rw_scan(P p, const float* R, const float* K, const float* V, const float* HW, const float* HA, float* Y) {
  int id = blockIdx.x;
  int h = id & 15, dir = (id >> 4) & 1, seq = id >> 5;
  int lane = threadIdx.x;
  int L = seq < 16 ? 256 : 2048;
  int m0 = seq < 16 ? seq * 256 : NPT + (seq - 16) * 2048;
  int ch = h * 64 + lane;
  float S[64];
  if (seq < 16) {
#pragma unroll
    for (int j = 0; j < 64; ++j) S[j] = 0.f;
  } else {
    const float* s0 = p.state_rwkv + ((((size_t)(seq - 16) * 1 + 0) * 2 + dir) * 16 + h) * 4096 + (size_t)lane * 64;
#pragma unroll
    for (int j = 0; j < 64; ++j) S[j] = s0[j];
  }
  const float w0 = p.rw_w0[dir * D + ch], a0 = p.rw_a0[dir * D + ch];
  const float kkw = p.rw_k_k[ch], kaw = p.rw_k_a[ch];
  const float* w2 = p.rw_w2 + (size_t)dir * 64 * D + ch;
  const float* a2 = p.rw_a2 + (size_t)dir * 64 * D + ch;
  for (int st = 0; st < L; ++st) {
    int t = dir ? (L - 1 - st) : st;
    int m = m0 + t;
    float wl = w0, al = a0;
    const float* hw = HW + (size_t)m * 128 + dir * 64;
    const float* ha = HA + (size_t)m * 128 + dir * 64;
    for (int r = 0; r < 64; ++r) { wl += hw[r] * w2[(size_t)r * D]; al += ha[r] * a2[(size_t)r * D]; }
    float sp = (-wl > 20.f) ? -wl : log1pf(expf(-wl));
    float dec = expf(-expf(-sp - 0.5f));
    float a = sigmoidf(al);
    float k = K[(size_t)m * D + ch], r_ = R[(size_t)m * D + ch], v = V[(size_t)m * D + ch];
    float kk = k * kkw; float ss = kk * kk;
#pragma unroll
    for (int o = 1; o < 64; o <<= 1) ss += __shfl_xor(ss, o);
    kk *= rsqrtf(ss + 1e-12f);
    float kd = k * (1.f + (a - 1.f) * kaw);
    float bd = kk * a;
    float at = -kk;
    float sa = 0.f;
#pragma unroll
    for (int j = 0; j < 64; ++j) sa += S[j] * __shfl(at, j);
    float y = 0.f;
#pragma unroll
    for (int j = 0; j < 64; ++j) {
      float wj = __shfl(dec, j), bj = __shfl(bd, j), kj = __shfl(kd, j), rj = __shfl(r_, j);
      S[j] = S[j] * wj + sa * bj + v * kj;
      y += S[j] * rj;
    }
    atomicAdd(&Y[(size_t)m * D + ch], y);
  }
  if (seq < 16) {
    float* so = p.out + OUT_ST + ((((size_t)seq * 1 + 0) * 2 + dir) * 16 + h) * 4096 + (size_t)lane * 64;
#pragma unroll
    for (int j = 0; j < 64; ++j) so[j] = S[j];
  }
}
__global__ void __launch_bounds__(64) k_rw_post(P p, const float* R, const float* K, const float* V, const float* Z, const float* HA, const float* Y, float* G) {
  int m = blockIdx.x >> 4, h = blockIdx.x & 15, lane = threadIdx.x; int ch = h * 64 + lane;
  float y = Y[(size_t)m * D + ch];
  float s = y;
#pragma unroll
  for (int o = 1; o < 64; o <<= 1) s += __shfl_xor(s, o);
  float mu = s * (1.f / 64.f); float d = y - mu; float q = d * d;
#pragma unroll
  for (int o = 1; o < 64; o <<= 1) q += __shfl_xor(q, o);
  float yn = d * rsqrtf(q * (1.f / 64.f) + GN_EPS) * p.rw_gn_g[ch] + p.rw_gn_b[ch];
  float k = K[(size_t)m * D + ch], r_ = R[(size_t)m * D + ch], v = V[(size_t)m * D + ch];
  float bsum = 0.f;
  for (int dir = 0; dir < 2; ++dir) {
    float al = p.rw_a0[dir * D + ch];
    const float* ha = HA + (size_t)m * 128 + dir * 64;
    const float* a2 = p.rw_a2 + (size_t)dir * 64 * D + ch;
    for (int r = 0; r < 64; ++r) al += ha[r] * a2[(size_t)r * D];
    float a = sigmoidf(al);
    float kd = k * (1.f + (a - 1.f) * p.rw_k_a[ch]);
    bsum += r_ * kd * p.rw_r_k[ch];
  }
#pragma unroll
  for (int o = 1; o < 64; o <<= 1) bsum += __shfl_xor(bsum, o);
  float o_ = yn + bsum * v;
  G[(size_t)m * D + ch] = o_ * silu(Z[(size_t)m * D + ch]);
}

typedef unsigned short bf16_t;
namespace pg8 {
#define PG8_LAS __attribute__((address_space(3)))
typedef unsigned short bf16_t;
typedef short bf16x8 __attribute__((ext_vector_type(8)));
typedef float f32x4 __attribute__((ext_vector_type(4)));
typedef unsigned u32x4 __attribute__((ext_vector_type(4)));
constexpr int BM = 256, BK = 64, HALF = 128, HTB = HALF * BK * 2  , STAGE_BYTES = 8 * HTB, NXCD = 8, WGM = 8;

__host__ __device__ __forceinline__ int lds_byte(int r, int c) { const int st = (r >> 4) * 2 + (c >> 5), rr = r & 15, cc = c & 31, ob = rr * 64 + cc * 2; return st * 1024 + (ob ^ (((ob >> 9) & 1) << 5)); }
__host__ __device__ __forceinline__ void stage_rc(int b, int& R, int& C) { const int st = b / 1024, sb = b % 1024, swz = sb ^ (((sb >> 9) & 1) << 5); R = (st >> 1) * 16 + swz / 64; C = (st & 1) * 32 + (swz % 64) / 2; }
__host__ __device__ __forceinline__ int perm32(int rho) { const int n = rho >> 4, i = rho & 15; return 8 * (i >> 2) + 4 * n + (i & 3); }

struct Unit { int pm, pn; };
struct Gemm { const bf16_t* A; const bf16_t* Bt; int M, N, K; };

struct StaticOrder {
    int nM, nN, nwg, G, c;
    __host__ __device__ void init(int M, int N, int G_, int c_) { nM = M / BM; nN = N / BM; nwg = nM * nN; G = G_; c = c_; }
    __host__ __device__ bool next(int i, Unit& u) const {
        const long L = (long)i * G + c; if (L >= nwg) return false;
        int wgid = (int)L; { const int q = nwg / NXCD, r = nwg % NXCD, xcd = wgid % NXCD, off = wgid / NXCD; wgid = (xcd < r ? xcd * (q + 1) : r * (q + 1) + (xcd - r) * q) + off; }
        const int nig = WGM * nN, gid = wgid / nig, fm = gid * WGM, gsz = (nM - fm) < WGM ? (nM - fm) : WGM;
        u.pm = fm + ((wgid % nig) % gsz); u.pn = (wgid % nig) / gsz; return true;
    }
    __device__ __forceinline__ void a_ready(const Unit&) const {}
    __device__ __forceinline__ void done(const Unit&) const {}
};
__device__ __forceinline__ unsigned cvt_pk_bf16(float lo, float hi) { unsigned r; asm volatile("v_cvt_pk_bf16_f32 %0, %1, %2" : "=v"(r) : "v"(lo), "v"(hi)); return r; }
typedef float f32x2 __attribute__((ext_vector_type(2)));
template <int ACT  > struct EpiBf16 {
    static constexpr bool PERM = true, AFTER_DRAIN = false; static_assert(ACT == 0 || ACT == 1, "EpiBf16: ACT is 0 (none) or 1 (gelu_pk)");
    bf16_t* O; int ldc; const float* bias; int split_cols; size_t split_stride; float scale0;
    __device__ __forceinline__ void operator()(const f32x4 (&acc)[2][2][4][2], const Unit& u, int wr, int wc, int fr, int fq) const {
        const int row0 = u.pm * BM + wr * 64 + fr; int colt = u.pn * BM; bf16_t* base = O;
        float sc = 1.f; if (split_cols) { const int t = colt / split_cols; base += (size_t)t * split_stride; colt -= t * split_cols; if (t == 0) sc = scale0; }
        const int col0 = colt + wc * 32 + 8 * fq, bcol0 = u.pn * BM + wc * 32 + 8 * fq;
        f32x4 bv[2][2];
#pragma unroll
        for (int bj = 0; bj < 2; ++bj)
#pragma unroll
            for (int n = 0; n < 2; ++n) bv[bj][n] = bias ? *(const f32x4*)(bias + bcol0 + bj * HALF + 4 * n) : (f32x4){0.f, 0.f, 0.f, 0.f};
#pragma unroll
        for (int ai = 0; ai < 2; ++ai)
#pragma unroll
            for (int m = 0; m < 4; ++m) { bf16_t* rowp = base + (size_t)(row0 + ai * HALF + m * 16) * ldc + col0;
#pragma unroll
                for (int bj = 0; bj < 2; ++bj) { f32x4 v0 = acc[ai][bj][m][0] + bv[bj][0], v1 = acc[ai][bj][m][1] + bv[bj][1];
                    v0 = v0 * sc; v1 = v1 * sc; u32x4 w; w.x = cvt_pk_bf16(v0[0], v0[1]); w.y = cvt_pk_bf16(v0[2], v0[3]); w.z = cvt_pk_bf16(v1[0], v1[1]); w.w = cvt_pk_bf16(v1[2], v1[3]);
                    *(u32x4*)(rowp + bj * HALF) = w; } }
    }
};
template <class Epi, class Sched, bool ALIGN_EPI = false, bool SP2 = false>
__device__ __forceinline__ void gemm_phase(PG8_LAS unsigned char* lds, const Gemm g, const Sched& S, const Epi& E) {
    const int tid = threadIdx.x, wid = __builtin_amdgcn_readfirstlane(tid >> 6), lane = tid & 63, wr = wid >> 2, wc = wid & 3, fr = lane & 15, fq = lane >> 4;
    const int K = g.K, nt = K / BK;
    unsigned voffA[2], voffB[2];
#pragma unroll
    for (int i = 0; i < 2; ++i) { int R, C; stage_rc(tid * 16 + i * 8192, R, C); const int Rb = Epi::PERM ? ((R & ~31) + perm32(R & 31)) : R;
        voffA[i] = (unsigned)(R * K + C) * 2u; voffB[i] = (unsigned)(Rb * K + C) * 2u; }
    const size_t kstep = (size_t)(BK * 2);
    const size_t hstep = (size_t)HALF * K * 2;
    const size_t tstep = 2 * hstep;
    const unsigned ldsw = (unsigned)wid * 1024u;
    const int aoff = lds_byte(wr * 64 + fr, fq * 8), boff = lds_byte(wc * 32 + fr, fq * 8);
#define PG8_SA(b, h) (((b) * 2 + (h)) * HTB)
#define PG8_SB(b, h) ((4 + (b) * 2 + (h)) * HTB)
#define PG8_STAGE(bufoff, gbase, voff) do { _Pragma("unroll") for (int _i = 0; _i < 2; ++_i) \
        __builtin_amdgcn_global_load_lds((const unsigned*)((const char*)(gbase) + (voff)[_i]), (PG8_LAS unsigned*)(lds + (bufoff) + ldsw + _i * 8192), 16, 0, 0); } while (0)
#define PG8_LDA(dst, b, h) do { _Pragma("unroll") for (int m = 0; m < 4; ++m) _Pragma("unroll") for (int k = 0; k < 2; ++k) dst[m][k] = *(const PG8_LAS bf16x8*)(lds + PG8_SA(b, h) + aoff + m * 2048 + k * 1024); } while (0)
#define PG8_LDB(dst, b, h) do { _Pragma("unroll") for (int n = 0; n < 2; ++n) _Pragma("unroll") for (int k = 0; k < 2; ++k) dst[n][k] = *(const PG8_LAS bf16x8*)(lds + PG8_SB(b, h) + boff + n * 2048 + k * 1024); } while (0)
#define PG8_MMA(ai, bj, At, Bt) do { __builtin_amdgcn_s_setprio(1); _Pragma("unroll") for (int m = 0; m < 4; ++m) _Pragma("unroll") for (int n = 0; n < 2; ++n) _Pragma("unroll") for (int k = 0; k < 2; ++k) \
        acc[ai][bj][m][n] = __builtin_amdgcn_mfma_f32_16x16x32_bf16(Bt[n][k], At[m][k], acc[ai][bj][m][n], 0, 0, 0); __builtin_amdgcn_s_setprio(0); } while (0)
#define PG8_WAIT_V(n) asm volatile("s_waitcnt vmcnt(" #n ")" ::: "memory")
#define PG8_WAIT_L(n) asm volatile("s_waitcnt lgkmcnt(" #n ")" ::: "memory")
#define PG8_BAR __builtin_amdgcn_s_barrier()
#define PG8_SCHED __builtin_amdgcn_sched_barrier(0)
    Unit cur, nxt; int ui = 0;
    if (!S.next(0, cur)) return;
    f32x4 acc[2][2][4][2];
#pragma unroll
    for (int a = 0; a < 2; ++a)
#pragma unroll
        for (int b = 0; b < 2; ++b)
#pragma unroll
            for (int m = 0; m < 4; ++m)
#pragma unroll
                for (int n = 0; n < 2; ++n) acc[a][b][m][n] = (f32x4){0.f, 0.f, 0.f, 0.f};
    bf16x8 At[4][2], B0[2][2], B1[2][2];
    const char* cA = (const char*)g.A + (size_t)cur.pm * tstep; const char* cB = (const char*)g.Bt + (size_t)cur.pn * tstep;
    S.a_ready(cur);
    if constexpr (SP2) {
        PG8_STAGE(PG8_SB(0, 0), cB, voffB); PG8_STAGE(PG8_SB(0, 1), cB + hstep, voffB); PG8_STAGE(PG8_SA(0, 0), cA, voffA); PG8_STAGE(PG8_SA(0, 1), cA + hstep, voffA);
        if (wr == 1) PG8_BAR;
        PG8_WAIT_V(2); PG8_BAR;
        PG8_STAGE(PG8_SB(1, 0), cB + kstep, voffB); PG8_STAGE(PG8_SA(1, 0), cA + kstep, voffA); PG8_STAGE(PG8_SB(1, 1), cB + hstep + kstep, voffB);
        PG8_WAIT_V(6); PG8_BAR;
    } else {
        PG8_STAGE(PG8_SB(0, 0), cB, voffB); PG8_STAGE(PG8_SA(0, 0), cA, voffA); PG8_STAGE(PG8_SB(0, 1), cB + hstep, voffB); PG8_STAGE(PG8_SA(0, 1), cA + hstep, voffA);
        if (wr == 1) PG8_BAR;
        PG8_WAIT_V(4); PG8_BAR;
        PG8_STAGE(PG8_SB(1, 0), cB + kstep, voffB); PG8_STAGE(PG8_SA(1, 0), cA + kstep, voffA); PG8_STAGE(PG8_SB(1, 1), cB + hstep + kstep, voffB);
        PG8_WAIT_V(6); PG8_BAR;
    }
    for (;;) {
        const bool has_next = S.next(ui + 1, nxt);
        const char* nA = has_next ? (const char*)g.A + (size_t)nxt.pm * tstep : cA; const char* nB = has_next ? (const char*)g.Bt + (size_t)nxt.pn * tstep : cB;
        for (int t = 0; t < nt; t += 2) {
            const bool last = (t == nt - 2);
            const char* a1 = cA + (size_t)(t + 1) * kstep;
            const char* a2 = last ? nA : cA + (size_t)(t + 2) * kstep; const char* b2 = last ? nB : cB + (size_t)(t + 2) * kstep;
            const char* a3 = a2 + kstep; const char* b3 = b2 + kstep;
            if (last && has_next) S.a_ready(nxt);
            if constexpr (SP2) {
            PG8_LDB(B0, 0, 0); PG8_LDB(B1, 0, 1); PG8_SCHED; PG8_LDA(At, 0, 0); PG8_STAGE(PG8_SA(1, 1), a1 + hstep, voffA);
            PG8_WAIT_V(8); PG8_WAIT_L(0); PG8_BAR; PG8_MMA(0, 0, At, B0); PG8_MMA(0, 1, At, B1); PG8_BAR; PG8_SCHED;
            PG8_LDA(At, 0, 1); PG8_STAGE(PG8_SB(0, 0), b2, voffB); PG8_STAGE(PG8_SB(0, 1), b2 + hstep, voffB); PG8_STAGE(PG8_SA(0, 0), a2, voffA);
            PG8_WAIT_V(8); PG8_WAIT_L(0); PG8_BAR; PG8_MMA(1, 0, At, B0); PG8_MMA(1, 1, At, B1); PG8_BAR; PG8_SCHED;
            PG8_LDB(B0, 1, 0); PG8_LDB(B1, 1, 1); PG8_SCHED; PG8_LDA(At, 1, 0); PG8_STAGE(PG8_SA(0, 1), a2 + hstep, voffA);
            PG8_WAIT_V(8); PG8_WAIT_L(0); PG8_BAR; PG8_MMA(0, 0, At, B0); PG8_MMA(0, 1, At, B1); PG8_BAR; PG8_SCHED;
            PG8_LDA(At, 1, 1); PG8_STAGE(PG8_SB(1, 0), b3, voffB); PG8_STAGE(PG8_SB(1, 1), b3 + hstep, voffB); PG8_STAGE(PG8_SA(1, 0), a3, voffA);
            PG8_WAIT_V(8); PG8_WAIT_L(0); PG8_BAR; PG8_MMA(1, 0, At, B0); PG8_MMA(1, 1, At, B1); PG8_BAR; PG8_SCHED;
            } else {
            PG8_LDB(B0, 0, 0); PG8_SCHED; PG8_LDA(At, 0, 0); PG8_STAGE(PG8_SA(1, 1), a1 + hstep, voffA);
            PG8_WAIT_L(8); PG8_BAR; PG8_WAIT_L(0); PG8_MMA(0, 0, At, B0); PG8_BAR; PG8_SCHED;
            PG8_LDB(B1, 0, 1); PG8_STAGE(PG8_SB(0, 0), b2, voffB);
            PG8_BAR; PG8_WAIT_L(0); PG8_MMA(0, 1, At, B1); PG8_BAR;
            PG8_LDA(At, 0, 1); PG8_STAGE(PG8_SA(0, 0), a2, voffA);
            PG8_BAR; PG8_WAIT_L(0); PG8_MMA(1, 0, At, B0); PG8_BAR; PG8_SCHED;
            PG8_STAGE(PG8_SB(0, 1), b2 + hstep, voffB);
            PG8_WAIT_V(6); PG8_BAR; PG8_MMA(1, 1, At, B1); PG8_BAR;
            PG8_LDB(B0, 1, 0); PG8_SCHED; PG8_LDA(At, 1, 0); PG8_STAGE(PG8_SA(0, 1), a2 + hstep, voffA);
            PG8_WAIT_L(8); PG8_BAR; PG8_WAIT_L(0); PG8_MMA(0, 0, At, B0); PG8_BAR; PG8_SCHED;
            PG8_LDB(B1, 1, 1); PG8_STAGE(PG8_SB(1, 0), b3, voffB);
            PG8_BAR; PG8_WAIT_L(0); PG8_MMA(0, 1, At, B1); PG8_BAR;
            PG8_LDA(At, 1, 1); PG8_STAGE(PG8_SA(1, 0), a3, voffA);
            PG8_BAR; PG8_WAIT_L(0); PG8_MMA(1, 0, At, B0); PG8_BAR; PG8_SCHED;
            PG8_STAGE(PG8_SB(1, 1), b3 + hstep, voffB);
            PG8_WAIT_V(6); PG8_BAR; PG8_MMA(1, 1, At, B1); PG8_BAR;
            }
        }
        if constexpr (ALIGN_EPI) { if (wr == 0) PG8_BAR; }
        if constexpr (!Epi::AFTER_DRAIN) { E(acc, cur, wr, wc, fr, fq); S.done(cur); }
        if (!has_next) break;
#pragma unroll
        for (int a = 0; a < 2; ++a)
#pragma unroll
            for (int b = 0; b < 2; ++b)
#pragma unroll
                for (int m = 0; m < 4; ++m)
#pragma unroll
                    for (int n = 0; n < 2; ++n) acc[a][b][m][n] = (f32x4){0.f, 0.f, 0.f, 0.f};
        cur = nxt; cA = nA; cB = nB; ++ui;
        if constexpr (ALIGN_EPI) { if (wr == 1) PG8_BAR; }
    }
    PG8_WAIT_V(0);
    if constexpr (!ALIGN_EPI) { if (wr == 0) PG8_BAR; }
    PG8_BAR;
    if constexpr (Epi::AFTER_DRAIN) { E.fused(acc, cur, wr, wc, fr, fq, lds, wid, lane); S.done(cur); }
#undef PG8_SA
#undef PG8_SB
#undef PG8_STAGE
#undef PG8_LDA
#undef PG8_LDB
#undef PG8_MMA
#undef PG8_WAIT_V
#undef PG8_WAIT_L
#undef PG8_BAR
#undef PG8_SCHED
}
}
#define GAS __attribute__((address_space(1)))
#define LAS __attribute__((address_space(3)))
typedef unsigned short bf16;
typedef unsigned v4u __attribute__((ext_vector_type(4)));
typedef float f32x4 __attribute__((ext_vector_type(4)));
typedef short bf16x8 __attribute__((ext_vector_type(8)));
typedef GAS unsigned gu32;
typedef GAS unsigned long long gu64;
#define RLX_AGENT __ATOMIC_RELAXED, __HIP_MEMORY_SCOPE_AGENT
#define LDS_WAIT() asm volatile("s_waitcnt lgkmcnt(0)" ::: "memory")
#define VM_WAIT() asm volatile("s_waitcnt vmcnt(0)" ::: "memory")
__device__ __forceinline__ unsigned long long rt() { return __builtin_amdgcn_s_memrealtime(); }
__device__ __forceinline__ unsigned f2bf(float f) { unsigned u = __builtin_bit_cast(unsigned, f); return (u + 0x7fffu + ((u >> 16) & 1u)) >> 16; }
__device__ __forceinline__ unsigned pk2(float lo, float hi) { return f2bf(lo) | (f2bf(hi) << 16); }

#define XB_TMO      128
#define XB_XCNT(j)  (256  + 64 * (j))
#define XB_XSUB(j)  (1280 + 64 * (j))
#define XB_XGEN(j)  (2304 + 64 * (j))
#define XB_TOP      3328
#define XB_TOPGEN   3392
#define XCD_BAR_WORDS 3456
#define XB_SPIN_CAP (1u << 18)

__device__ __forceinline__ unsigned xb_ld(unsigned* p)              { return __hip_atomic_load(p, __ATOMIC_RELAXED, __HIP_MEMORY_SCOPE_AGENT); }
__device__ __forceinline__ unsigned xb_add(unsigned* p, unsigned v) { return __hip_atomic_fetch_add(p, v, __ATOMIC_RELAXED, __HIP_MEMORY_SCOPE_AGENT); }
__device__ __forceinline__ unsigned xb_xcc_id() { return (unsigned)__builtin_amdgcn_s_getreg((3 << 11) | 20) & 0xFu; }
#define XB_SPIN(cond, bar) do { unsigned _sp = 0; while (cond) { __builtin_amdgcn_s_sleep(1); \
    if ((++_sp & 255u) == 0u) { if (xb_ld(&(bar)[XB_TMO])) break; if (_sp > XB_SPIN_CAP) { atomicAdd(&(bar)[XB_TMO], 1u); break; } } } } while (0)

struct XcdBarrier {
    unsigned* bar; unsigned x;
    volatile LAS unsigned* st;
};

__device__ __forceinline__ XcdBarrier xcd_barrier_post(unsigned* bar, volatile LAS unsigned* st) {
    XcdBarrier b; b.bar = bar; b.x = xb_xcc_id(); b.st = st;
    if (threadIdx.x == 0) (void)xb_add(&bar[XB_XCNT(b.x)], 1u);
    return b;
}
__device__ __forceinline__ void xcd_barrier_complete(unsigned* bar, unsigned x, unsigned& nloc, unsigned& nx) {
    const unsigned G = gridDim.x * gridDim.y * gridDim.z;
    unsigned sum, cnt, mine, sp = 0u;
    for (;;) {
        sum = 0u; cnt = 0u; mine = 0u;
#pragma unroll
        for (unsigned j = 0; j < 16; ++j) { const unsigned c = xb_ld(&bar[XB_XCNT(j)]); sum += c; cnt += (c > 0u) ? 1u : 0u; mine = (j == x) ? c : mine; }
        if (sum == G) break;
        __builtin_amdgcn_s_sleep(1);
        if ((++sp & 255u) == 0u) { if (xb_ld(&bar[XB_TMO])) break; if (sp > XB_SPIN_CAP) { atomicAdd(&bar[XB_TMO], 1u); break; } }
    }
    nloc = mine > 0u ? mine : 1u; nx = cnt > 0u ? cnt : 1u;
}

__device__ __forceinline__ void xcd_barrier(const XcdBarrier& b) {
    asm volatile("s_waitcnt vmcnt(0)" ::: "memory");
    __syncthreads();
    if (threadIdx.x == 0) {
        unsigned* bar = b.bar;
        __builtin_amdgcn_s_waitcnt(0);
        unsigned nloc = b.st[0], nx = b.st[1];
        if (nloc == 0u) { xcd_barrier_complete(bar, b.x, nloc, nx); b.st[0] = nloc; b.st[1] = nx; }
        const unsigned old = xb_add(&bar[XB_XSUB(b.x)], 1u);
        const unsigned gen = old / nloc;
        if (old + 1u == (gen + 1u) * nloc) {
            __builtin_amdgcn_fence(__ATOMIC_RELEASE, "agent");
            asm volatile("s_waitcnt vmcnt(0)" ::: "memory");
            const unsigned og = xb_add(&bar[XB_TOP], 1u);
            const unsigned tg = og / nx;
            if (og + 1u == (tg + 1u) * nx) xb_add(&bar[XB_TOPGEN], 1u);
            else XB_SPIN(xb_ld(&bar[XB_TOPGEN]) == tg, bar);
            __builtin_amdgcn_fence(__ATOMIC_ACQUIRE, "agent");
            xb_add(&bar[XB_XGEN(b.x)], 1u);
            asm volatile("s_waitcnt vmcnt(0)" ::: "memory");
        } else {
            XB_SPIN(xb_ld(&bar[XB_XGEN(b.x)]) == gen, bar);
            __builtin_amdgcn_fence(__ATOMIC_ACQUIRE, "agent");
            asm volatile("s_waitcnt vmcnt(0)" ::: "memory");
        }
    }
    __syncthreads();
}
typedef __attribute__((address_space(1))) float GASF;
struct PG {
  const GASF *x_prompt, *x_sample, *cache_ckv, *cache_kpe, *state_rwkv, *c, *c_ctx;
  const GASF *mod_w, *mod_b, *ln_g, *ln_b;
  const GASF *hy_w_in, *hy_conv_w, *hy_conv_b, *hy_w1, *hy_b1, *hy_w2, *hy_b2, *hy_w3, *hy_b3, *hy_freq, *hy_decay, *hy_skip, *hy_w_out;
  const GASF *mla_w_in, *mla_q_norm, *mla_kv_norm, *mla_w_q_up, *mla_w_kv_up, *mla_w_out;
  const GASF *rw_mu, *rw_w_in, *rw_w0, *rw_w1, *rw_w2, *rw_a0, *rw_a1, *rw_a2, *rw_k_k, *rw_k_a, *rw_r_k, *rw_gn_g, *rw_gn_b, *rw_w_out;
  GASF* out;
  GASF* ws;
};
namespace mk {
typedef float f32x16 __attribute__((ext_vector_type(16)));
typedef short v4i16_t __attribute__((ext_vector_type(4)));
typedef unsigned u32x4 __attribute__((ext_vector_type(4)));
typedef unsigned u32x2 __attribute__((ext_vector_type(2)));
typedef unsigned short u16;

constexpr size_t MiB = 1u << 20;
constexpr size_t M_X = 0, M_HB = 32 * MiB, M_GB = 48 * MiB, M_UT = 64 * MiB, M_SCR2 = 128 * MiB, M_WTS = 192 * MiB, M_FILT = 230 * MiB;
constexpr size_t M_HDN2 = 248 * MiB + 512 * 1024, M_MODP = 250 * MiB, M_MODS = 254 * MiB, M_CTL = 255 * MiB;
constexpr size_t W_HYIN = M_WTS, W_HYOUT = M_WTS + 16 * MiB, W_MLAIN = M_WTS + 20 * MiB, W_QUP = M_WTS + 23 * MiB, W_KVUP = M_WTS + 24 * MiB,
                 W_MLAOUT = M_WTS + 25 * MiB, W_RWIN = M_WTS + 27 * MiB, W_LORA1 = M_WTS + 35 * MiB, W_RWOUT = M_WTS + 36 * MiB;
constexpr size_t M_U2S = M_SCR2 + 24 * MiB;
constexpr size_t M_QN = M_SCR2, M_CKVALL = M_SCR2 + 4 * MiB, M_KPEB = M_SCR2 + 7 * MiB, M_SZB = M_SCR2 + 8 * MiB, M_Q = M_UT, M_KN = M_UT + 24 * MiB, M_V = M_UT + 42 * MiB;
constexpr int FILT_CH = 4640;
constexpr int LDS_BYTES = 163840, MISC_OFF = LDS_BYTES - 512, PTAB_OFF = LDS_BYTES - 1024;

__device__ __forceinline__ float bf2f(unsigned v) { return __builtin_bit_cast(float, v << 16); }
typedef float f32x2_t __attribute__((ext_vector_type(2))); typedef __bf16 bf16x2_t __attribute__((ext_vector_type(2)));
__device__ __forceinline__ unsigned pk2_(float lo, float hi) { const f32x2_t v = {lo, hi}; const bf16x2_t b = __builtin_convertvector(v, bf16x2_t); return __builtin_bit_cast(unsigned, b); }
__device__ __forceinline__ unsigned f2bf_(float f) { return pk2_(f, 0.f) & 0xffffu; }
__device__ __forceinline__ v4i16_t vtr(LAS const unsigned char* p) { return __builtin_amdgcn_ds_read_tr16_b64_v4i16((LAS v4i16_t*)p); }
template <class T> __device__ __forceinline__ T* uni(T* p) {
  const unsigned long long v = (unsigned long long)p;
  const unsigned lo = __builtin_amdgcn_readfirstlane((unsigned)v), hi = __builtin_amdgcn_readfirstlane((unsigned)(v >> 32));
  return (T*)(((unsigned long long)hi << 32) | lo);
}
__device__ __forceinline__ float wsum(float v) {
#pragma unroll
  for (int o = 1; o < 64; o <<= 1) v += __shfl_xor(v, o);
  return v;
}
__device__ __forceinline__ const GASF* xrow_in(const LAS PG& p, int layer, const unsigned char* ws, int m) {
  if (layer == 0) return (m < NPT) ? p.x_prompt + (size_t)m * D : p.x_sample + (size_t)(m - NPT) * D;
  if (layer == 2) return p.out + OUT_Y + (size_t)m * D;
  return (const GASF*)(ws + M_X) + (size_t)m * D;
}

struct TrD { const GASF* W; bf16_t* WT; int K, N, kind, row_off, item; };
constexpr int I_HYIN = 16 * 128, I_SQ = 16 * 32, I_MLAIN = 16 * 45, I_QUP = 4 * 48, I_KVUP = 2 * 64, I_LORA = 16 * 2;
constexpr int NTR = 2 * I_HYIN + 2 * I_SQ + I_MLAIN + I_QUP + I_KVUP + I_SQ + 4 * I_SQ + 4 * I_LORA + I_SQ;
constexpr int NTR_DEF = I_HYIN + I_SQ + I_SQ;
constexpr int NTR_P0 = NTR - NTR_DEF;
__device__ __forceinline__ int tr_map_p0(int idx) { return idx < I_HYIN ? idx : (idx < I_HYIN + I_SQ ? 2 * I_HYIN + (idx - I_HYIN) : 2 * I_HYIN + 2 * I_SQ + (idx - I_HYIN - I_SQ)); }
__device__ __forceinline__ int tr_map_def(int idx) { return idx < I_HYIN ? I_HYIN + idx : (idx < I_HYIN + I_SQ ? 2 * I_HYIN + I_SQ + (idx - I_HYIN) : NTR - I_SQ + (idx - I_HYIN - I_SQ)); }
__device__ __forceinline__ TrD tr_decode(const LAS PG& p, unsigned char* ws, int r) {
  TrD d; d.kind = 0; d.row_off = 0; d.K = 1024; d.N = 1024;
  if (r < 2 * I_HYIN) { const int j = r / I_HYIN; d.W = p.hy_w_in + (size_t)j * D * 4096; d.N = 4096; d.WT = (bf16_t*)(ws + W_HYIN + (size_t)j * 8 * MiB); d.item = r % I_HYIN; return d; } r -= 2 * I_HYIN;
  if (r < 2 * I_SQ) { const int j = r / I_SQ; d.W = p.hy_w_out + (size_t)j * D * D; d.WT = (bf16_t*)(ws + W_HYOUT + (size_t)j * 2 * MiB); d.kind = 1; d.item = r % I_SQ; return d; } r -= 2 * I_SQ;
  if (r < I_MLAIN) { const int nb = r % 45; d.W = p.mla_w_in; d.N = 1440; d.item = r; if (nb < 13) d.WT = (bf16_t*)(ws + W_MLAIN); else { d.WT = (bf16_t*)(ws + W_MLAIN + MiB); d.row_off = -416; } return d; } r -= I_MLAIN;
  if (r < I_QUP) { d.W = p.mla_w_q_up; d.K = 256; d.N = 1536; d.WT = (bf16_t*)(ws + W_QUP); d.item = r; return d; } r -= I_QUP;
  if (r < I_KVUP) { d.W = p.mla_w_kv_up; d.K = 128; d.N = 2048; d.WT = (bf16_t*)(ws + W_KVUP); d.item = r; return d; } r -= I_KVUP;
  if (r < I_SQ) { d.W = p.mla_w_out; d.WT = (bf16_t*)(ws + W_MLAOUT); d.kind = 1; d.item = r; return d; } r -= I_SQ;
  if (r < 4 * I_SQ) { const int q = r / I_SQ; d.W = p.rw_w_in + (size_t)q * D * D; d.WT = (bf16_t*)(ws + W_RWIN + (size_t)q * 2 * MiB); d.item = r % I_SQ; return d; } r -= 4 * I_SQ;
  if (r < 4 * I_LORA) { const int q = r / I_LORA; d.W = (q < 2) ? p.rw_w1 + (size_t)q * D * 64 : p.rw_a1 + (size_t)(q - 2) * D * 64; d.N = 64; d.WT = (bf16_t*)(ws + W_LORA1); d.kind = 1; d.row_off = q * 64; d.item = r % I_LORA; return d; } r -= 4 * I_LORA;
  d.W = p.rw_w_out; d.WT = (bf16_t*)(ws + W_RWOUT); d.kind = 1; d.item = r; return d;
}
__device__ __forceinline__ void tr_load(const TrD& d, int lane, f32x4 (&v)[8]) {
  const int nblk = d.N / 32, kb = d.item / nblk, nb = d.item % nblk, k0 = 64 * kb, n0 = 32 * nb;
  const GAS f32x4* src = (const GAS f32x4*)(d.W + (size_t)(k0 + (lane >> 3)) * d.N + n0 + 4 * (lane & 7));
#pragma unroll
  for (int i = 0; i < 8; ++i) v[i] = src[(size_t)i * 2 * d.N];
}
__device__ __forceinline__ void tr_finish(const TrD& d, LAS float* scr, int lane, const f32x4 (&v)[8]) {
  const int nblk = d.N / 32, kb = d.item / nblk, nb = d.item % nblk, k0 = 64 * kb, n0 = 32 * nb, K = d.K;
#pragma unroll
  for (int i = 0; i < 8; ++i) { LAS float* dd = scr + (8 * i + (lane >> 3)) * 33 + 4 * (lane & 7); dd[0] = v[i].x; dd[1] = v[i].y; dd[2] = v[i].z; dd[3] = v[i].w; }
  asm volatile("s_waitcnt lgkmcnt(0)" ::: "memory");
  const int c = lane & 7;
#pragma unroll
  for (int jj = 0; jj < 4; ++jj) {
    const int n = (lane >> 3) + 8 * jj; LAS const float* s = scr + (8 * c) * 33 + n;
    u32x4 o; o.x = pk2_(s[0 * 33], s[1 * 33]); o.y = pk2_(s[2 * 33], s[3 * 33]); o.z = pk2_(s[4 * 33], s[5 * 33]); o.w = pk2_(s[6 * 33], s[7 * 33]);
    const int ng = n0 + n + d.row_off;
    if (d.kind == 0) {
      *(u32x4*)(d.WT + (size_t)ng * K + k0 + 8 * c) = o;
    } else {
      const int k8 = (k0 >> 3) + c;
      const size_t ci = ((size_t)((ng >> 5) * 64 + (k8 >> 1))) * 64 + (ng & 31) + 32 * (k8 & 1);
      *(u32x4*)(d.WT + ci * 8) = o;
    }
  }
  asm volatile("s_waitcnt lgkmcnt(0)" ::: "memory");
}
template <bool DEF>
__device__ __forceinline__ void tr_run(const LAS PG& p, unsigned char* ws, LAS float* scr, int lane, int first, int stride, int n) {
  for (int it = first; it < n; it += 2 * stride) {
    const TrD dA = tr_decode(p, ws, DEF ? tr_map_def(it) : tr_map_p0(it));
    f32x4 vA[8], vB[8];
    tr_load(dA, lane, vA);
    const bool hasB = (it + stride) < n;
    TrD dB = dA;
    if (hasB) { dB = tr_decode(p, ws, DEF ? tr_map_def(it + stride) : tr_map_p0(it + stride)); tr_load(dB, lane, vB); }
    tr_finish(dA, scr, lane, vA);
    if (hasB) tr_finish(dB, scr, lane, vB);
  }
}

__device__ __forceinline__ void phase_p0a(const LAS PG& p, unsigned char* ws, LAS unsigned char* lds, int tid, int lane, int wave, int bid, int G) {
  LAS float* SC = (LAS float*)lds;
  for (int i = tid; i < 3072; i += 512) { const int g = i >> 10, k = i & 1023; const float c = (g == 0) ? p.c_ctx[k] : p.c[(g - 1) * 1024 + k]; SC[i] = silu(c); }
  __syncthreads();
  LAS float* RED = (LAS float*)lds + 3072;
#ifdef MP_TWICE
  for (int rep_ = 0; rep_ < 2; ++rep_)
#endif
  for (int it = bid; it < 96; it += G) {
    const int kc = it & 7, cc = (it >> 3) % 3, i = it / 24;
    const int c4 = tid & 255, kh = tid >> 8;
    const int n = cc * 1024 + 4 * c4;
    const GAS f32x4* w = (const GAS f32x4*)(p.mod_w + ((size_t)i * 1024 + kc * 128 + kh * 64) * 3072 + n);
    f32x4 a0 = (f32x4){0.f, 0.f, 0.f, 0.f}, a1 = a0, a2 = a0;
#pragma unroll 8
    for (int k = 0; k < 64; ++k) { const f32x4 wv = w[(size_t)k * 768]; const int kk = kc * 128 + kh * 64 + k; a0 += SC[kk] * wv; a1 += SC[1024 + kk] * wv; a2 += SC[2048 + kk] * wv; }
    if (kh == 1) { LAS f32x4* r = (LAS f32x4*)(RED + c4 * 12); r[0] = a0; r[1] = a1; r[2] = a2; }
    __syncthreads();
    if (kh == 0) {
      LAS const f32x4* r = (LAS const f32x4*)(RED + c4 * 12);
      float* mp = (float*)(ws + M_MODP) + (size_t)kc * 36864 + (size_t)i * 9216 + n;
      *(f32x4*)mp = a0 + r[0]; *(f32x4*)(mp + 3072) = a1 + r[1]; *(f32x4*)(mp + 6144) = a2 + r[2];
    }
    __syncthreads();
  }
  __syncthreads();
  for (int i = bid * 512 + tid; i < 12288; i += G * 512) *(u32x4*)(ws + W_MLAIN + (size_t)416 * 2048 + (size_t)i * 16) = (u32x4){0u, 0u, 0u, 0u};
  for (int i = bid * 512 + tid; i < 2 * PAST * 128 / 8; i += G * 512) {
    const int d8 = i & 15, pl = (i >> 4) & 511, b = i >> 13;
    const f32x4* src = (const f32x4*)(p.cache_ckv + ((size_t)(b * PAST + pl)) * 128 + d8 * 8);
    const f32x4 x0 = src[0], x1 = src[1];
    u32x4 o; o.x = pk2_(x0.x, x0.y); o.y = pk2_(x0.z, x0.w); o.z = pk2_(x1.x, x1.y); o.w = pk2_(x1.z, x1.w);
    *(u32x4*)((bf16_t*)(ws + M_CKVALL) + ((size_t)(NPT + b * 2560 + pl)) * 128 + d8 * 8) = o;
    if (d8 < 4) {
      const f32x4* s2 = (const f32x4*)(p.cache_kpe + ((size_t)(b * PAST + pl)) * 32 + d8 * 8);
      const f32x4 y0 = s2[0], y1 = s2[1];
      u32x4 o2; o2.x = pk2_(y0.x, y0.y); o2.y = pk2_(y0.z, y0.w); o2.z = pk2_(y1.x, y1.y); o2.w = pk2_(y1.z, y1.w);
      *(u32x4*)((bf16_t*)(ws + M_KPEB) + ((size_t)(NPT + b * 2560 + pl)) * 32 + d8 * 8) = o2;
    }
  }
  LAS float* scr = (LAS float*)(lds + wave * 16384);
  const int gw = bid * 8 + wave, NGW = G * 8;
  tr_run<false>(p, ws, scr, lane, gw, NGW, NTR_P0);
#ifdef TR_TWICE
  tr_run<false>(p, ws, scr, lane, gw, NGW, NTR_P0);
#endif
  {
    __syncthreads();
    const int jh = (bid * 2 >= G) ? 1 : 0;
    LAS float* w1s = (LAS float*)(lds + 131072);
    LAS float* w2s = w1s + 33 * 64;
    for (int i = tid; i < 33 * 64; i += 512) w1s[i] = p.hy_w1[(size_t)jh * 33 * 64 + i];
    for (int i = tid; i < 64 * 64; i += 512) w2s[i] = p.hy_w2[(size_t)jh * 64 * 64 + i];
    __syncthreads();
    const float b1 = p.hy_b1[jh * 64 + lane], b2 = p.hy_b2[jh * 64 + lane], f0 = p.hy_freq[(jh * 2 + 0) * 64 + lane], f1 = p.hy_freq[(jh * 2 + 1) * 64 + lane];
    const int nbh = jh ? (G - (G + 1) / 2) : ((G + 1) / 2), bh = jh ? (bid - (G + 1) / 2) : bid;
    for (int row = bh * 8 + wave; row < 2304; row += nbh * 8) {
      const int L = row < 256 ? 256 : 2048, l = row < 256 ? row : row - 256;
      const float t = (float)l / (float)(L - 1);
      float feat = 0.f;
      if (lane == 0) feat = t;
      else if (lane < 33) {
        const int b = (lane - 1) & 15;
        const float band = 1e-4f + (float)b * ((15.f - 1e-4f) / 15.f);
        const float rev = ((float)l / (float)L) * band;
        const float fr = rev - floorf(rev);
        feat = (lane <= 16) ? __builtin_amdgcn_cosf(fr) : -__builtin_amdgcn_sinf(fr);
      }
      float a = b1;
#pragma unroll
      for (int f = 0; f < 33; ++f) a += __shfl(feat, f) * w1s[f * 64 + lane];
      const float x1 = f0 * a * 0.15915494309189535f;
      const float h1 = __builtin_amdgcn_sinf(x1 - floorf(x1));
      float a2 = b2;
#pragma unroll 16
      for (int f = 0; f < 64; ++f) a2 += __shfl(h1, f) * w2s[f * 64 + lane];
      const float x2 = f1 * a2 * 0.15915494309189535f;
      const float h2 = __builtin_amdgcn_sinf(x2 - floorf(x2));
      ((float*)(ws + M_HDN2))[((size_t)jh * 2304 + row) * 64 + lane] = h2;
    }
  }
}

__device__ __forceinline__ void phase_p0b(const LAS PG& p, unsigned char* ws, LAS unsigned char* lds, int tid, int lane, int wave, int bid, int G) {
  const float* MP = (const float*)(ws + M_MODP);
  float* MODS = (float*)(ws + M_MODS);
  for (int idx = bid * 512 + tid; idx < 36864; idx += G * 512) {
    float s = p.mod_b[(idx / 9216) * 3072 + (idx % 3072)];
#pragma unroll
    for (int kc = 0; kc < 8; ++kc) s += MP[(size_t)kc * 36864 + idx];
    MODS[idx] = s;
  }
  LAS float* ML = (LAS float*)lds;
  for (int e = tid; e < 6144; e += 512) {
    const int g = e >> 11, r = e & 2047; const int idx = g * 3072 + r;
    float s = p.mod_b[r];
#pragma unroll
    for (int kc = 0; kc < 8; ++kc) s += MP[(size_t)kc * 36864 + idx];
    ML[e] = s;
  }
  __syncthreads();
  bf16_t* HB = (bf16_t*)(ws + M_HB);
#ifndef NO_H0
#ifdef H0_TWICE
  for (int rep_ = 0; rep_ < 2; ++rep_)
#endif
  for (int m = bid * 8 + wave; m < NTOK; m += G * 8) {
    int l, L, cond, m0; tokinfo(m, l, L, cond, m0);
    const GAS f32x4* xr = (const GAS f32x4*)xrow_in(p, 0, ws, m);
    LAS const float* sh = ML + cond * 2048; LAS const float* sc = sh + 1024;
#pragma unroll
    for (int i = 0; i < 4; ++i) {
      const int k = 4 * lane + 256 * i; const f32x4 x = xr[lane + 64 * i];
      u32x2 o; o.x = pk2_(x.x * (1.f + sc[k]) + sh[k], x.y * (1.f + sc[k + 1]) + sh[k + 1]); o.y = pk2_(x.z * (1.f + sc[k + 2]) + sh[k + 2], x.w * (1.f + sc[k + 3]) + sh[k + 3]);
      *(u32x2*)(HB + (size_t)m * D + k) = o;
    }
  }
#endif
  __syncthreads();
#ifndef NO_FG
  const int gw = bid * 8 + wave, NGW = G * 8;
  const float* HD = (const float*)(ws + M_HDN2);
  bf16_t* FILT = (bf16_t*)(ws + M_FILT);
  const int r32 = lane & 31, hi = lane >> 5;
#ifdef FG_TWICE
  for (int rep_ = 0; rep_ < 2; ++rep_)
#endif
  for (int wslot = gw; wslot < 64 * 32; wslot += NGW) {
    const int combo = wslot & 63, sub = wslot >> 6;
    const int cch = combo & 15, dir = (combo >> 4) & 1, j = combo >> 5;
    LAS float* w3s = (LAS float*)(lds + 16384 + wave * 16384);
    {
      const GASF* w3 = p.hy_w3 + ((size_t)j * 64 * 2048 + dir * 1024 + cch * 64 + lane);
      asm volatile("s_waitcnt lgkmcnt(0)" ::: "memory");
#pragma unroll 8
      for (int m = 0; m < 64; ++m) { w3s[m * 64 + lane] = *w3; w3 += 2048; }
      asm volatile("s_waitcnt lgkmcnt(0)" ::: "memory");
    }
    bf16x8 bw[2][4];
    {
      LAS const float* wb = w3s + (8 * hi) * 64 + r32;
#pragma unroll
      for (int nt = 0; nt < 2; ++nt)
#pragma unroll
        for (int ks = 0; ks < 4; ++ks) {
          LAS const float* q = wb + (16 * ks) * 64 + 32 * nt;
          u32x4 o; o.x = pk2_(q[0], q[64]); o.y = pk2_(q[128], q[192]); o.z = pk2_(q[256], q[320]); o.w = pk2_(q[384], q[448]);
          bw[nt][ks] = __builtin_bit_cast(bf16x8, o);
        }
    }
    float cb3[2], cdec[2];
#pragma unroll
    for (int nt = 0; nt < 2; ++nt) { const int o = dir * 1024 + cch * 64 + 32 * nt + r32; cb3[nt] = p.hy_b3[j * 2048 + o]; cdec[nt] = fabsf(p.hy_decay[(size_t)j * 2048 + o]); }
#pragma unroll 1
    for (int it = sub; it < 72; it += 32) {
      const int set = it < 8 ? 0 : 1, b = set ? it - 8 : it, L = set ? 2048 : 256, row0 = set ? 256 : 0;
      const int lag0 = 32 * b + (dir ? 0 : 1);
      bf16x8 af[4];
      {
        const int lag = lag0 + r32; const bool ok = dir ? (lag >= 1) : (lag <= L - 1);
        const float* hrow = HD + ((size_t)j * 2304 + row0 + (ok ? lag : 0)) * 64 + 8 * hi;
#pragma unroll
        for (int ks = 0; ks < 4; ++ks) {
          f32x4 x0 = *(const f32x4*)(hrow + 16 * ks), x1 = *(const f32x4*)(hrow + 16 * ks + 4);
          if (!ok) { x0 = (f32x4){0.f, 0.f, 0.f, 0.f}; x1 = x0; }
          u32x4 o; o.x = pk2_(x0.x, x0.y); o.y = pk2_(x0.z, x0.w); o.z = pk2_(x1.x, x1.y); o.w = pk2_(x1.z, x1.w);
          af[ks] = __builtin_bit_cast(bf16x8, o);
        }
      }
      const float tinv = 1.f / (float)(L - 1);
#pragma unroll
      for (int nt = 0; nt < 2; ++nt) {
        f32x16 acc;
#pragma unroll
        for (int i = 0; i < 16; ++i) acc[i] = 0.f;
#pragma unroll
        for (int ks = 0; ks < 4; ++ks) acc = __builtin_amdgcn_mfma_f32_32x32x16_bf16(af[ks], bw[nt][ks], acc, 0, 0, 0);
        bf16_t* fch = FILT + ((size_t)(j * 1024 + cch * 64 + 32 * nt + r32)) * FILT_CH + (set ? 528 : 0) + L + 8;
#pragma unroll
        for (int q = 0; q < 4; ++q) {
          unsigned v[4];
#pragma unroll
          for (int x = 0; x < 4; ++x) {
            const int lag = lag0 + 8 * q + 4 * hi + x;
            const bool ok = dir ? (lag >= 1) : (lag <= L - 1);
            const float val = (acc[4 * q + x] + cb3[nt]) * __expf(-(float)lag * tinv * cdec[nt]);
            v[x] = ok ? f2bf_(val) : 0u;
          }
          if (dir) {
            const int i0 = lag0 + 8 * q + 4 * hi;
            if (i0 != 0) { u32x2 w; w.x = v[0] | (v[1] << 16); w.y = v[2] | (v[3] << 16); *(u32x2*)(fch + i0) = w; }
            else { fch[1] = (bf16_t)v[1]; fch[2] = (bf16_t)v[2]; fch[3] = (bf16_t)v[3]; }
          } else {
            const int i0 = -(lag0 + 8 * q + 4 * hi + 3);
            u32x2 w; w.x = v[3] | (v[2] << 16); w.y = v[1] | (v[0] << 16); *(u32x2*)(fch + i0) = w;
          }
        }
      }
    }
    if (sub == 0) {
      const int c = cch * 64 + lane, o = dir * 1024 + c;
#pragma unroll 1
      for (int set = 0; set < 2; ++set) {
        const int L = set ? 2048 : 256, row0 = set ? 256 : 0;
        bf16_t* fch = FILT + ((size_t)(j * 1024 + c)) * FILT_CH + (set ? 528 : 0) + L + 8;
        if (!dir) {
          const float* h0r = HD + ((size_t)j * 2304 + row0) * 64;
          float a = p.hy_b3[j * 2048 + o];
#pragma unroll 8
          for (int m = 0; m < 64; ++m) a += h0r[m] * w3s[m * 64 + lane];
          fch[0] = (bf16_t)f2bf_(a + p.hy_skip[j * D + c]);
        } else {
          *(u32x4*)(fch + L) = (u32x4){0u, 0u, 0u, 0u};
        }
      }
    }
  }
#endif
}
constexpr int FK_S = 0, FK_P = 65920, VBS = 74368, VBP = 91776, VB_END = 118400, E_OFF = 118400, SCR_S = 0, SCR_P = 65536;
__device__ __forceinline__ float conv3e(float pv, float cur, float nx, float w0, float w1, float w2, float b) { return pv * w0 + cur * w1 + nx * w2 + b; }

__device__ __forceinline__ void phase_hy_conv(const LAS PG& p, unsigned char* ws, LAS unsigned char* lds, int j, int tid, int lane, int wave, int bid, int G) {
  const bf16_t* UT = (const bf16_t*)(ws + M_UT);
  bf16_t* GT = (bf16_t*)(ws + M_GB);
  const bf16_t* FILT = (const bf16_t*)(ws + M_FILT);
  const int r = lane & 31, h = lane >> 5, rho = (-r) & 7;
  u32x4 fX0[2], fX1[2], fXV[2], fXZ[2]; unsigned fP[2][3], fN[2][3]; u32x4 fLo[2], fHi[2];
#define HC_FETCH(CH) do { const int c_ = (CH); \
    _Pragma("unroll") for (int u_ = 0; u_ < 2; ++u_) { const int tok_ = (tid + 512 * u_) * 8; \
      const int l_ = (tok_ < NPT) ? (tok_ & 255) : ((tok_ - NPT) & 2047); const int L_ = (tok_ < NPT) ? 256 : 2048; \
      const bf16_t* r0_ = UT + (size_t)c_ * 8192 + tok_; const bf16_t* r1_ = r0_ + (size_t)1024 * 8192; const bf16_t* r2_ = r0_ + (size_t)2048 * 8192; const bf16_t* r3_ = r0_ + (size_t)3072 * 8192; \
      fX0[u_] = *(const u32x4*)r0_; fX1[u_] = *(const u32x4*)r1_; fXV[u_] = *(const u32x4*)r2_; fXZ[u_] = *(const u32x4*)r3_; \
      const bool hp_ = l_ > 0, hn_ = (l_ + 8) < L_; \
      fP[u_][0] = hp_ ? (unsigned)r0_[-1] : 0u; fP[u_][1] = hp_ ? (unsigned)r1_[-1] : 0u; fP[u_][2] = hp_ ? (unsigned)r2_[-1] : 0u; \
      fN[u_][0] = hn_ ? (unsigned)r0_[8] : 0u; fN[u_][1] = hn_ ? (unsigned)r1_[8] : 0u; fN[u_][2] = hn_ ? (unsigned)r2_[8] : 0u; } \
    const bf16_t* Rc_ = FILT + ((size_t)(j * 1024 + c_)) * FILT_CH; \
    _Pragma("unroll") for (int u_ = 0; u_ < 2; ++u_) { const int gi_ = tid + 512 * u_; fLo[u_] = (u32x4){0u, 0u, 0u, 0u}; fHi[u_] = fLo[u_]; \
      if (gi_ < 515 + 66) { const bool smp_ = gi_ < 515; const int gq_ = smp_ ? gi_ : gi_ - 515; const int LEN_ = smp_ ? 4112 : 528; const bf16_t* Rg_ = Rc_ + (smp_ ? 528 : 0); const int idx0_ = 8 * gq_ + 8; \
        if (idx0_ + 8 <= LEN_) fLo[u_] = *(const u32x4*)(Rg_ + idx0_); if (idx0_ + 16 <= LEN_) fHi[u_] = *(const u32x4*)(Rg_ + idx0_ + 8); } } } while (0)
  if (bid < 1024) HC_FETCH(bid);
  for (int c = bid; c < 1024; c += G) {
    __syncthreads();
    for (int i = tid; i < (VB_END - VBS) / 16; i += 512) *(LAS u32x4*)(lds + VBS + i * 16) = (u32x4){0u, 0u, 0u, 0u};
    __syncthreads();
    {
      const GASF* cw = p.hy_conv_w + (size_t)j * 3 * 3072; const GASF* cb = p.hy_conv_b + (size_t)j * 3072;
      const float a0 = cw[c], a1 = cw[3072 + c], a2 = cw[6144 + c], ab = cb[c];
      const float b0 = cw[1024 + c], b1 = cw[3072 + 1024 + c], b2 = cw[6144 + 1024 + c], bb = cb[1024 + c];
      const float v0 = cw[2048 + c], v1 = cw[3072 + 2048 + c], v2 = cw[6144 + 2048 + c], vbb = cb[2048 + c];
#pragma unroll
      for (int u = 0; u < 2; ++u) {
        const int tok = (tid + 512 * u) * 8;
        unsigned dst;
        if (tok < NPT) { const int l = tok & 255; const int chunk = 32 + (l >> 3); dst = VBP + (tok >> 8) * 1664 + (chunk + (chunk >> 4)) * 16; }
        else { const int mm = tok - NPT; const int l = mm & 2047; const int chunk = 128 + (l >> 3); dst = VBS + (mm >> 11) * 8704 + (chunk + (chunk >> 4)) * 16; }
        const u32x4 X0 = fX0[u], X1 = fX1[u], XV = fXV[u], XZ = fXZ[u];
        float x0[10], x1[10], xv[10], z[8];
        x0[0] = bf2f(fP[u][0]); x1[0] = bf2f(fP[u][1]); xv[0] = bf2f(fP[u][2]); x0[9] = bf2f(fN[u][0]); x1[9] = bf2f(fN[u][1]); xv[9] = bf2f(fN[u][2]);
#pragma unroll
        for (int e = 0; e < 4; ++e) {
          x0[1 + 2 * e] = bf2f(X0[e] & 0xffffu); x0[2 + 2 * e] = bf2f(X0[e] >> 16);
          x1[1 + 2 * e] = bf2f(X1[e] & 0xffffu); x1[2 + 2 * e] = bf2f(X1[e] >> 16);
          xv[1 + 2 * e] = bf2f(XV[e] & 0xffffu); xv[2 + 2 * e] = bf2f(XV[e] >> 16);
          z[2 * e] = bf2f(XZ[e] & 0xffffu); z[2 * e + 1] = bf2f(XZ[e] >> 16);
        }
        float vv[8], ev[8];
#pragma unroll
        for (int e = 0; e < 8; ++e) {
          const float c0 = conv3e(x0[e], x0[e + 1], x0[e + 2], a0, a1, a2, ab);
          const float c1 = conv3e(x1[e], x1[e + 1], x1[e + 2], b0, b1, b2, bb);
          const float cv = conv3e(xv[e], xv[e + 1], xv[e + 2], v0, v1, v2, vbb);
          vv[e] = cv * c1; ev[e] = c0 * (z[e] * __builtin_amdgcn_rcpf(1.f + __expf(-z[e])));
        }
        u32x4 o; o.x = pk2_(vv[0], vv[1]); o.y = pk2_(vv[2], vv[3]); o.z = pk2_(vv[4], vv[5]); o.w = pk2_(vv[6], vv[7]);
        *(LAS u32x4*)(lds + dst) = o;
        *(LAS f32x4*)(lds + E_OFF + tok * 4) = (f32x4){ev[0], ev[1], ev[2], ev[3]};
        *(LAS f32x4*)(lds + E_OFF + tok * 4 + 16) = (f32x4){ev[4], ev[5], ev[6], ev[7]};
      }
#pragma unroll
      for (int u = 0; u < 2; ++u) {
        const int gi = tid + 512 * u;
        if (gi < 515 + 66) {
          const bool smp = gi < 515; const int gq = smp ? gi : gi - 515;
          const u32x4 lo = fLo[u], hi = fHi[u];
          const unsigned d0 = lo.x, d1 = lo.y, d2 = lo.z, d3 = lo.w, d4 = hi.x, d5 = hi.y, d6 = hi.z, d7 = hi.w;
          LAS unsigned char* dstp = lds + (smp ? FK_S : FK_P) + gq * 128;
#define AB(hi_, lo_) __builtin_amdgcn_alignbit(hi_, lo_, 16)
          *(LAS u32x4*)(dstp + 0) = (u32x4){d0, d1, d2, d3};
          *(LAS u32x4*)(dstp + 16) = (u32x4){AB(d1, d0), AB(d2, d1), AB(d3, d2), AB(d4, d3)};
          *(LAS u32x4*)(dstp + 32) = (u32x4){d1, d2, d3, d4};
          *(LAS u32x4*)(dstp + 48) = (u32x4){AB(d2, d1), AB(d3, d2), AB(d4, d3), AB(d5, d4)};
          *(LAS u32x4*)(dstp + 64) = (u32x4){d2, d3, d4, d5};
          *(LAS u32x4*)(dstp + 80) = (u32x4){AB(d3, d2), AB(d4, d3), AB(d5, d4), AB(d6, d5)};
          *(LAS u32x4*)(dstp + 96) = (u32x4){d3, d4, d5, d6};
          *(LAS u32x4*)(dstp + 112) = (u32x4){AB(d4, d3), AB(d5, d4), AB(d6, d5), AB(d7, d6)};
#undef AB
        }
      }
    }
    __syncthreads();
    if (c + G < 1024) HC_FETCH(c + G);
    f32x16 s0, s1, pr;
#pragma unroll
    for (int i = 0; i < 16; ++i) { s0[i] = 0.f; s1[i] = 0.f; pr[i] = 0.f; }
    {
      const int ahalf = wave & 1, dq = wave >> 1;
      const int a = ahalf * 32 + r;
      const int n0 = (ahalf ? -64 : -128) + 48 * dq, cnt = (dq == 3) ? 47 : 48;
      for (int s = 0; s < cnt; ++s) {
        const int n = n0 + s;
        const int e0 = 8 * h - r - 16 * n; const int q = (e0 - rho) >> 3;
        const bf16x8 af = *(LAS const bf16x8*)(lds + FK_S + ((q + 256) * 8 + rho) * 16);
        const int qb = 128 + h + 4 * a - 2 * n; const int pb = qb + (qb >> 4);
        const bf16x8 b0 = *(LAS const bf16x8*)(lds + VBS + pb * 16);
        const bf16x8 b1 = *(LAS const bf16x8*)(lds + VBS + 8704 + pb * 16);
        s0 = __builtin_amdgcn_mfma_f32_32x32x16_bf16(af, b0, s0, 0, 0, 0);
        s1 = __builtin_amdgcn_mfma_f32_32x32x16_bf16(af, b1, s1, 0, 0, 0);
      }
    }
    {
      const int ntile = wave & 3, dh = wave >> 2;
      const int batch = 4 * ntile + (r >> 3), a = r & 7;
      const int n0 = dh ? 0 : -16, cnt = dh ? 15 : 16;
      for (int s = 0; s < cnt; ++s) {
        const int n = n0 + s;
        const int e0 = 8 * h - r - 16 * n; const int q = (e0 - rho) >> 3;
        const bf16x8 af = *(LAS const bf16x8*)(lds + FK_P + ((q + 32) * 8 + rho) * 16);
        const int qb = 32 + h + 4 * a - 2 * n; const int pb = qb + (qb >> 4);
        const bf16x8 b0 = *(LAS const bf16x8*)(lds + VBP + batch * 1664 + pb * 16);
        pr = __builtin_amdgcn_mfma_f32_32x32x16_bf16(af, b0, pr, 0, 0, 0);
      }
    }
    __syncthreads();
    {
      const int ahalf = wave & 1, dq = wave >> 1;
#pragma unroll
      for (int g = 0; g < 4; ++g) {
        const int off = (r * 32 + 8 * g + 4 * h) * 4;
        *(LAS f32x4*)(lds + SCR_S + (((ahalf * 2 + 0) * 4 + dq) * 1024) * 4 + off) = (f32x4){s0[4 * g], s0[4 * g + 1], s0[4 * g + 2], s0[4 * g + 3]};
        *(LAS f32x4*)(lds + SCR_S + (((ahalf * 2 + 1) * 4 + dq) * 1024) * 4 + off) = (f32x4){s1[4 * g], s1[4 * g + 1], s1[4 * g + 2], s1[4 * g + 3]};
        *(LAS f32x4*)(lds + SCR_P + (((wave & 3) * 2 + (wave >> 2)) * 1024) * 4 + off) = (f32x4){pr[4 * g], pr[4 * g + 1], pr[4 * g + 2], pr[4 * g + 3]};
      }
    }
    __syncthreads();
    {
      {
        const int o = tid * 8; const int b = o >> 11, t = o & 2047; const int a = t >> 5, rr = t & 31; const int tile = (a >> 5) * 2 + b, col = a & 31;
        f32x4 y0 = (f32x4){0.f, 0.f, 0.f, 0.f}, y1 = y0;
#pragma unroll
        for (int dq = 0; dq < 4; ++dq) {
          LAS const unsigned char* sp = lds + SCR_S + (((tile * 4 + dq) * 1024) + col * 32 + rr) * 4;
          y0 += *(LAS const f32x4*)sp; y1 += *(LAS const f32x4*)(sp + 16);
        }
        const int token = NPT + o;
        const f32x4 e0 = *(LAS const f32x4*)(lds + E_OFF + token * 4), e1 = *(LAS const f32x4*)(lds + E_OFF + token * 4 + 16);
        u32x4 ov; ov.x = pk2_(y0.x * e0.x, y0.y * e0.y); ov.y = pk2_(y0.z * e0.z, y0.w * e0.w); ov.z = pk2_(y1.x * e1.x, y1.y * e1.y); ov.w = pk2_(y1.z * e1.z, y1.w * e1.w);
        *(u32x4*)(GT + (size_t)c * 8192 + token) = ov;
      }
      {
        const int o = tid * 8; const int batch = o >> 8, t = o & 255; const int ntile = batch >> 2, col = (batch & 3) * 8 + (t >> 5), rr = t & 31;
        f32x4 y0 = (f32x4){0.f, 0.f, 0.f, 0.f}, y1 = y0;
#pragma unroll
        for (int dh = 0; dh < 2; ++dh) {
          LAS const unsigned char* sp = lds + SCR_P + (((ntile * 2 + dh) * 1024) + col * 32 + rr) * 4;
          y0 += *(LAS const f32x4*)sp; y1 += *(LAS const f32x4*)(sp + 16);
        }
        const int token = o;
        const f32x4 e0 = *(LAS const f32x4*)(lds + E_OFF + token * 4), e1 = *(LAS const f32x4*)(lds + E_OFF + token * 4 + 16);
        u32x4 ov; ov.x = pk2_(y0.x * e0.x, y0.y * e0.y); ov.y = pk2_(y0.z * e0.z, y0.w * e0.w); ov.z = pk2_(y1.x * e1.x, y1.y * e1.y); ov.w = pk2_(y1.z * e1.z, y1.w * e1.w);
        *(u32x4*)(GT + (size_t)c * 8192 + token) = ov;
      }
    }
  }
}

template <int MODE>
__device__ __forceinline__ void phase_out_ln(const LAS PG& p, unsigned char* ws, LAS unsigned char* lds, int layer, const bf16_t* Wf, int tid, int lane, int wave, int bid, int G) {
  const bf16_t* GA = (const bf16_t*)(ws + M_GB);
  const float* MODS = (const float*)(ws + M_MODS);
  const int h = lane >> 5;
  for (int tile = bid; tile < NTOK / 32; tile += G) {
    const int t0 = tile * 32;
    __syncthreads();
    constexpr bool CHM = (MODE == 1);
    if (MODE == 2) {
      const float* BON = (const float*)(ws + M_GB + 8 * MiB);
      const int sub = lane >> 4, c4 = lane & 15;
#pragma unroll 2
      for (int it = 0; it < 16; ++it) {
        const int pr = wave * 64 + it * 4 + sub; const int tok = pr >> 4, hd = pr & 15, m = t0 + tok;
        const unsigned gi = (unsigned)m * (unsigned)D + (unsigned)(hd * 64 + 4 * c4);
        const f32x4 y = *(const f32x4*)((const float*)(ws + M_UT) + gi) + *(const f32x4*)((const float*)(ws + M_UT + 32 * MiB) + gi);
        float s1 = (y.x + y.y) + (y.z + y.w);
        s1 += __builtin_bit_cast(float, __builtin_amdgcn_update_dpp(0, __builtin_bit_cast(int, s1), 0xB1, 0xF, 0xF, true));
        s1 += __builtin_bit_cast(float, __builtin_amdgcn_update_dpp(0, __builtin_bit_cast(int, s1), 0x4E, 0xF, 0xF, true));
        s1 += __builtin_bit_cast(float, __builtin_amdgcn_update_dpp(0, __builtin_bit_cast(int, s1), 0x141, 0xF, 0xF, true));
        s1 += __builtin_bit_cast(float, __builtin_amdgcn_update_dpp(0, __builtin_bit_cast(int, s1), 0x140, 0xF, 0xF, true));
        const float mu = s1 * (1.f / 64.f);
        const f32x4 d = y - mu;
        float s2 = (d.x * d.x + d.y * d.y) + (d.z * d.z + d.w * d.w);
        s2 += __builtin_bit_cast(float, __builtin_amdgcn_update_dpp(0, __builtin_bit_cast(int, s2), 0xB1, 0xF, 0xF, true));
        s2 += __builtin_bit_cast(float, __builtin_amdgcn_update_dpp(0, __builtin_bit_cast(int, s2), 0x4E, 0xF, 0xF, true));
        s2 += __builtin_bit_cast(float, __builtin_amdgcn_update_dpp(0, __builtin_bit_cast(int, s2), 0x141, 0xF, 0xF, true));
        s2 += __builtin_bit_cast(float, __builtin_amdgcn_update_dpp(0, __builtin_bit_cast(int, s2), 0x140, 0xF, 0xF, true));
        const float rstd = rsqrtf(s2 * (1.f / 64.f) + GN_EPS);
        const f32x4 bo0 = *(const f32x4*)(BON + ((unsigned)m * 16u + (unsigned)hd) * 4u), bo1 = *(const f32x4*)(BON + (((unsigned)NTOK + (unsigned)m) * 16u + (unsigned)hd) * 4u);
        const float bon = ((bo0.x + bo0.y) + (bo0.z + bo0.w)) + ((bo1.x + bo1.y) + (bo1.z + bo1.w));
        const u32x2 v2 = *(const u32x2*)((const bf16_t*)(ws + M_SCR2 + 32 * MiB) + gi), z2 = *(const u32x2*)((const bf16_t*)(ws + M_SCR2 + 48 * MiB) + gi);
        const f32x4 gg = *(const GAS f32x4*)(p.rw_gn_g + hd * 64 + 4 * c4), gb = *(const GAS f32x4*)(p.rw_gn_b + hd * 64 + 4 * c4);
        const f32x4 yn = d * rstd * gg + gb;
        u32x2 o;
        o.x = pk2_((yn.x + bon * bf2f(v2.x & 0xffffu)) * bf2f(z2.x & 0xffffu), (yn.y + bon * bf2f(v2.x >> 16)) * bf2f(z2.x >> 16));
        o.y = pk2_((yn.z + bon * bf2f(v2.y & 0xffffu)) * bf2f(z2.y & 0xffffu), (yn.w + bon * bf2f(v2.y >> 16)) * bf2f(z2.y >> 16));
        *(LAS u32x2*)(lds + ((hd * 8 + (c4 >> 1)) * 32 + tok) * 16 + (c4 & 1) * 8) = o;
      }
    } else {
#pragma unroll
    for (int i = 0; i < 8; ++i) {
      const int idx = tid + 512 * i;
      if (CHM) { const int c = idx >> 2, part = idx & 3; *(LAS u32x4*)(lds + c * 64 + part * 16) = *(const u32x4*)(GA + (size_t)c * 8192 + t0 + 8 * part); }
      else { const int tok = idx >> 7, k8 = idx & 127; *(LAS u32x4*)(lds + (k8 * 32 + tok) * 16) = *(const u32x4*)(GA + (size_t)(t0 + tok) * D + 8 * k8); }
    }
    }
    __syncthreads();
    f32x16 acc[4];
#pragma unroll
    for (int nt = 0; nt < 4; ++nt)
#pragma unroll
      for (int i = 0; i < 16; ++i) acc[nt][i] = 0.f;
    const bf16_t* wf = Wf + ((size_t)(wave * 4) * 64 * 64 + lane) * 8;
    const int aoffT = ((h * 32) + (lane & 31)) * 16;
    const int aoffC = (8 * h + ((lane & 15) >> 2)) * 64 + 32 * ((lane >> 4) & 1) + 8 * (lane & 3);
#pragma unroll 4
    for (int ks = 0; ks < 64; ++ks) {
      bf16x8 af;
      if (CHM) {
        const v4i16_t lo = vtr(lds + aoffC + ks * 1024), hi = vtr(lds + aoffC + ks * 1024 + 256);
        af = (bf16x8){lo[0], lo[1], lo[2], lo[3], hi[0], hi[1], hi[2], hi[3]};
      } else {
        af = *(LAS const bf16x8*)(lds + aoffT + ks * 1024);
      }
#pragma unroll
      for (int nt = 0; nt < 4; ++nt) {
        const bf16x8 bfr = *(const bf16x8*)(wf + ((size_t)(nt * 64 + ks) * 64) * 8);
        acc[nt] = __builtin_amdgcn_mfma_f32_32x32x16_bf16(af, bfr, acc[nt], 0, 0, 0);
      }
    }
    __syncthreads();
#pragma unroll
    for (int nt = 0; nt < 4; ++nt)
#pragma unroll
      for (int i = 0; i < 16; ++i) {
        const int row = (i & 3) + 8 * (i >> 2) + 4 * h;
        *(LAS float*)(lds + (row * 1028 + (wave * 4 + nt) * 32 + (lane & 31)) * 4) = acc[nt][i];
      }
    __syncthreads();
#pragma unroll 1
    for (int i = 0; i < 4; ++i) {
      const int row = wave * 4 + i, m = t0 + row;
      int l, L, cond, m0; tokinfo(m, l, L, cond, m0);
      const float* gate = MODS + (size_t)(layer * 3 + cond) * 3072 + 2048;
      const GAS f32x4* xr = (const GAS f32x4*)xrow_in(p, layer, ws, m);
      f32x4 v[4]; float s = 0.f;
#pragma unroll
      for (int q = 0; q < 4; ++q) {
        const int k = 4 * lane + 256 * q;
        const f32x4 o = *(LAS const f32x4*)(lds + (row * 1028 + k) * 4);
        const f32x4 x = xr[lane + 64 * q]; const f32x4 g = *(const f32x4*)(gate + k);
        v[q] = ALPHA * x + g * o; s += (v[q].x + v[q].y) + (v[q].z + v[q].w);
      }
      const float mu = wsum(s) * (1.f / D); float qq = 0.f;
#pragma unroll
      for (int q = 0; q < 4; ++q) { v[q] = v[q] - mu; qq += (v[q].x * v[q].x + v[q].y * v[q].y) + (v[q].z * v[q].z + v[q].w * v[q].w); }
      const float rs = rsqrtf(wsum(qq) * (1.f / D) + LN_EPS);
      GASF* xo = (layer & 1) ? p.out + OUT_Y + (size_t)m * D : (GASF*)(ws + M_X) + (size_t)m * D;
      const float* nmod = MODS + (size_t)((layer + 1) * 3 + cond) * 3072;
      bf16_t* HB = (bf16_t*)(ws + M_HB) + (size_t)m * D;
#pragma unroll
      for (int q = 0; q < 4; ++q) {
        const int k = 4 * lane + 256 * q;
        const f32x4 lg = *(const f32x4*)(p.ln_g + layer * D + k), lb = *(const f32x4*)(p.ln_b + layer * D + k);
        const f32x4 y = v[q] * rs * lg + lb;
        *(GAS f32x4*)(xo + k) = y;
        if (layer < 3) {
          const f32x4 sh = *(const f32x4*)(nmod + k), sc = *(const f32x4*)(nmod + 1024 + k);
          u32x2 o; o.x = pk2_(y.x * (1.f + sc.x) + sh.x, y.y * (1.f + sc.y) + sh.y); o.y = pk2_(y.z * (1.f + sc.z) + sh.z, y.w * (1.f + sc.w) + sh.w);
          *(u32x2*)(HB + k) = o;
        }
      }
    }
  }
}

__device__ __forceinline__ int kvrow_(int m) { if (m < NPT) return m; const int mm = m - NPT; return NPT + (mm >> 11) * 2560 + PAST + (mm & 2047); }

struct EpiSilu {
  static constexpr bool PERM = true, AFTER_DRAIN = false;
  bf16_t* O; int ldc;
  __device__ __forceinline__ void operator()(const f32x4 (&acc)[2][2][4][2], const pg8::Unit& u, int wr, int wc, int fr, int fq) const {
    const int row0 = u.pm * 256 + wr * 64 + fr, col0 = u.pn * 256 + wc * 32 + 8 * fq;
#pragma unroll
    for (int ai = 0; ai < 2; ++ai)
#pragma unroll
      for (int m = 0; m < 4; ++m) {
        bf16_t* rowp = O + (size_t)(row0 + ai * 128 + m * 16) * ldc + col0;
#pragma unroll
        for (int bj = 0; bj < 2; ++bj) {
          const f32x4 v0 = acc[ai][bj][m][0], v1 = acc[ai][bj][m][1];
          u32x4 w; w.x = pk2_(silu(v0[0]), silu(v0[1])); w.y = pk2_(silu(v0[2]), silu(v0[3])); w.z = pk2_(silu(v1[0]), silu(v1[1])); w.w = pk2_(silu(v1[2]), silu(v1[3]));
          *(u32x4*)(rowp + bj * 128) = w;
        }
      }
  }
};
struct EpiF32 {
  static constexpr bool PERM = true, AFTER_DRAIN = false;
  float* O; int ldc;
  __device__ __forceinline__ void operator()(const f32x4 (&acc)[2][2][4][2], const pg8::Unit& u, int wr, int wc, int fr, int fq) const {
    const int row0 = u.pm * 256 + wr * 64 + fr, col0 = u.pn * 256 + wc * 32 + 8 * fq;
#pragma unroll
    for (int ai = 0; ai < 2; ++ai)
#pragma unroll
      for (int m = 0; m < 4; ++m) {
        float* rowp = O + (size_t)(row0 + ai * 128 + m * 16) * ldc + col0;
#pragma unroll
        for (int bj = 0; bj < 2; ++bj) { *(f32x4*)(rowp + bj * 128) = acc[ai][bj][m][0]; *(f32x4*)(rowp + bj * 128 + 4) = acc[ai][bj][m][1]; }
      }
  }
};
struct EpiKV {
  static constexpr bool PERM = true, AFTER_DRAIN = false;
  bf16_t* Kn; bf16_t* V;
  __device__ __forceinline__ void operator()(const f32x4 (&acc)[2][2][4][2], const pg8::Unit& u, int wr, int wc, int fr, int fq) const {
    const int row0 = u.pm * 256 + wr * 64 + fr;
    const int d = wc * 32 + 8 * fq;
    bf16_t* base = (d < 64 ? Kn : V) + (d & 63);
#pragma unroll
    for (int ai = 0; ai < 2; ++ai)
#pragma unroll
      for (int m = 0; m < 4; ++m) {
        const size_t row = (size_t)(row0 + ai * 128 + m * 16);
#pragma unroll
        for (int bj = 0; bj < 2; ++bj) {
          const int h = u.pn * 2 + bj;
          const f32x4 v0 = acc[ai][bj][m][0], v1 = acc[ai][bj][m][1];
          u32x4 w; w.x = pg8::cvt_pk_bf16(v0[0], v0[1]); w.y = pg8::cvt_pk_bf16(v0[2], v0[3]); w.z = pg8::cvt_pk_bf16(v1[0], v1[1]); w.w = pg8::cvt_pk_bf16(v1[2], v1[3]);
          *(u32x4*)(base + row * 1024 + h * 64) = w;
        }
      }
  }
};

__device__ __forceinline__ void phase_mla_rows(const LAS PG& p, unsigned char* ws, int lane, int wave, int bid, int G) {
  const float* U2S = (const float*)(ws + M_U2S);
  for (int m = bid * 8 + wave; m < NTOK; m += G * 8) {
    int l, L, cond, m0; tokinfo(m, l, L, cond, m0);
    const float* rb = U2S + (size_t)m * 512;
    const f32x4 q = *(const f32x4*)(rb + 4 * lane);
    const float rs = rsqrtf(wsum(q.x * q.x + q.y * q.y + q.z * q.z + q.w * q.w) * (1.f / 256.f) + RMS_EPS);
    const f32x4 g = *(const GAS f32x4*)(p.mla_q_norm + 4 * lane);
    u32x2 qo; qo.x = pk2_(q.x * rs * g.x, q.y * rs * g.y); qo.y = pk2_(q.z * rs * g.z, q.w * rs * g.w);
    *(u32x2*)((bf16_t*)(ws + M_QN) + (size_t)m * 256 + 4 * lane) = qo;
    const float k0 = rb[256 + 2 * lane], k1 = rb[256 + 2 * lane + 1];
    const float rs2 = rsqrtf(wsum(k0 * k0 + k1 * k1) * (1.f / 128.f) + RMS_EPS);
    const float c0 = k0 * rs2 * p.mla_kv_norm[2 * lane], c1 = k1 * rs2 * p.mla_kv_norm[2 * lane + 1];
    const int kr = kvrow_(m);
    *(unsigned*)((bf16_t*)(ws + M_CKVALL) + (size_t)kr * 128 + 2 * lane) = pk2_(c0, c1);
    if (m < NPT) { p.out[OUT_CKV + (size_t)m * 128 + 2 * lane] = c0; p.out[OUT_CKV + (size_t)m * 128 + 2 * lane + 1] = c1; }
    const float x = rb[384 + (lane & 31)];
    const float partner = __shfl_xor(x, 8);
    float o = x;
    if (m >= NPT) {
      const int d = lane & 31, jj = d & 7;
      const float inv = exp2f(-(float)(2 * jj) * (13.287712379549449f / 16.f));
      const float pos = (d < 16) ? (float)(l >> 6) : (float)(l & 63);
      const float ang = pos * inv; const float cs = cosf(ang), sn = sinf(ang);
      o = (d & 8) ? x * cs + partner * sn : x * cs - partner * sn;
    }
    if (lane < 32) {
      ((bf16_t*)(ws + M_KPEB))[(size_t)kr * 32 + lane] = (bf16_t)f2bf_(o);
      if (m < NPT) p.out[OUT_KPE + (size_t)m * 32 + lane] = x;
    }
  }
}

constexpr int AT_KB = 12288, AT_VB = 8192, AT_BUF = AT_KB + AT_VB, AT_WS = 2 * AT_BUF, AT_ST = AT_WS + 8 * 256;
__device__ __forceinline__ int crow_(int r, int hi) { return (r & 3) + 8 * (r >> 2) + 4 * hi; }
__device__ __forceinline__ unsigned cvtpk(float lo, float hi) { return pk2_(lo, hi); }

__device__ __forceinline__ void attn_unit(const unsigned char* ws, LAS unsigned char* lds, int seq, int hd, int qb, bf16_t* Gout, int tid, int lane, int wave) {
  const bf16_t* Q = (const bf16_t*)(ws + M_Q); const bf16_t* Kn = (const bf16_t*)(ws + M_KN); const bf16_t* Vv = (const bf16_t*)(ws + M_V);
  const bf16_t* KP = (const bf16_t*)(ws + M_KPEB); const bf16_t* SZ = (const bf16_t*)(ws + M_SZB);
  const int r32 = lane & 31, hi = lane >> 5;
  const bool smp = seq >= 16;
  const int mq0 = smp ? NPT + (seq - 16) * 2048 + qb * 256 : seq * 256;
  const int kbase = smp ? NPT + (seq - 16) * 2560 : seq * 256;
  const int NT = smp ? 40 : 4;
  const float C2 = 0.10206207261596575f * 1.4426950408889634f;
  bf16x8 qr[6];
  {
    const int m = mq0 + wave * 32 + r32;
    const bf16_t* qp = Q + (size_t)m * 1536 + hd * 96;
    const int l = smp ? ((m - NPT) & 2047) : 0;
#pragma unroll
    for (int d0 = 0; d0 < 6; ++d0) {
      const u32x4 own = *(const u32x4*)(qp + 16 * d0 + 8 * hi);
      float f[8];
#pragma unroll
      for (int e = 0; e < 4; ++e) { f[2 * e] = bf2f(own[e] & 0xffffu); f[2 * e + 1] = bf2f(own[e] >> 16); }
      if (d0 >= 4 && smp) {
        const u32x4 oth = *(const u32x4*)(qp + 16 * d0 + 8 * (1 - hi));
        const float pos = (d0 == 4) ? (float)(l >> 6) : (float)(l & 63);
#pragma unroll
        for (int e = 0; e < 8; ++e) {
          const float pf = bf2f((e & 1) ? (oth[e >> 1] >> 16) : (oth[e >> 1] & 0xffffu));
          const float inv = exp2f(-(float)(2 * e) * (13.287712379549449f / 16.f));
          const float ang = pos * inv; const float cs = cosf(ang), sn = sinf(ang);
          f[e] = hi ? f[e] * cs + pf * sn : f[e] * cs - pf * sn;
        }
      }
      u32x4 o; o.x = pk2_(f[0] * C2, f[1] * C2); o.y = pk2_(f[2] * C2, f[3] * C2); o.z = pk2_(f[4] * C2, f[5] * C2); o.w = pk2_(f[6] * C2, f[7] * C2);
      qr[d0] = __builtin_bit_cast(bf16x8, o);
    }
  }
  const bf16_t* vsrc = Vv + (size_t)(kbase + 16 * (wave & 3) + (lane >> 2)) * 1024 + hd * 64 + (wave >> 2) * 32 + (lane & 3) * 8;
  const int kc0 = tid >> 6, key0 = tid & 63;
  const bf16_t* ksrc0 = Kn + (size_t)(kbase + key0) * 1024 + hd * 64 + 8 * kc0;
  const bool k2 = tid < 256;
  const bf16_t* ksrc1 = KP + (size_t)(kbase + key0) * 32 + 8 * (tid >> 6);
  u32x4 rv, rk0, rk1 = (u32x4){0u, 0u, 0u, 0u};
#define AT_LOAD(t) do { rv = *(const u32x4*)(vsrc + (size_t)(t) * 64 * 1024); rk0 = *(const u32x4*)(ksrc0 + (size_t)(t) * 64 * 1024); if (k2) rk1 = *(const u32x4*)(ksrc1 + (size_t)(t) * 64 * 32); } while (0)
#define AT_STORE(b) do { LAS unsigned char* bb = lds + (b) * AT_BUF; *(LAS u32x4*)(bb + tid * 16) = rk0; if (k2) *(LAS u32x4*)(bb + 8192 + tid * 16) = rk1; *(LAS u32x4*)(bb + AT_KB + tid * 16) = rv; } while (0)
  __syncthreads();
  AT_LOAD(0); AT_STORE(0);
  __syncthreads();
  LAS float* wsf = (LAS float*)(lds + AT_WS + wave * 256);
  f32x16 o0, o1;
#pragma unroll
  for (int i = 0; i < 16; ++i) { o0[i] = 0.f; o1[i] = 0.f; }
  float mrun = -1e30f, lrun = 0.f;
  const int vboff = ((lane >> 4) & 1) * 32 + (lane & 3) * 8 + (4 * hi + ((lane & 15) >> 2)) * 64;
  for (int t = 0; t < NT; ++t) {
    const int cur = t & 1;
    if (t + 1 < NT) AT_LOAD(t + 1);
    LAS const unsigned char* kb = lds + cur * AT_BUF + hi * 1024 + r32 * 16;
    f32x16 p0, p1;
#pragma unroll
    for (int i = 0; i < 16; ++i) { p0[i] = 0.f; p1[i] = 0.f; }
#pragma unroll
    for (int d0 = 0; d0 < 6; ++d0) {
      const bf16x8 a0 = *(LAS const bf16x8*)(kb + d0 * 2048), a1 = *(LAS const bf16x8*)(kb + d0 * 2048 + 512);
      p0 = __builtin_amdgcn_mfma_f32_32x32x16_bf16(a0, qr[d0], p0, 0, 0, 0);
      p1 = __builtin_amdgcn_mfma_f32_32x32x16_bf16(a1, qr[d0], p1, 0, 0, 0);
    }
    float rm = p0[0];
#pragma unroll
    for (int i = 1; i < 16; ++i) rm = fmaxf(rm, p0[i]);
#pragma unroll
    for (int i = 0; i < 16; ++i) rm = fmaxf(rm, p1[i]);
    rm = fmaxf(rm, __shfl_xor(rm, 32));
    if (__any(rm > mrun + 8.f)) {
      const float mnew = fmaxf(mrun, rm);
      const float alpha = __builtin_amdgcn_exp2f(mrun - mnew);
      mrun = mnew;
      lrun *= alpha;
      if (hi == 0) wsf[r32] = alpha;
      asm volatile("s_waitcnt lgkmcnt(0)" ::: "memory");
#pragma unroll
      for (int i = 0; i < 16; ++i) { const float al = wsf[crow_(i, hi)]; o0[i] *= al; o1[i] *= al; }
    }
    float ps = 0.f;
#pragma unroll
    for (int i = 0; i < 16; ++i) { p0[i] = __builtin_amdgcn_exp2f(p0[i] - mrun); p1[i] = __builtin_amdgcn_exp2f(p1[i] - mrun); ps += p0[i] + p1[i]; }
    lrun += ps;
    u32x4 w0, w1, w2, w3;
    w0.x = cvtpk(p0[0], p0[1]); w0.y = cvtpk(p0[2], p0[3]); w0.z = cvtpk(p0[4], p0[5]); w0.w = cvtpk(p0[6], p0[7]);
    w1.x = cvtpk(p0[8], p0[9]); w1.y = cvtpk(p0[10], p0[11]); w1.z = cvtpk(p0[12], p0[13]); w1.w = cvtpk(p0[14], p0[15]);
    w2.x = cvtpk(p1[0], p1[1]); w2.y = cvtpk(p1[2], p1[3]); w2.z = cvtpk(p1[4], p1[5]); w2.w = cvtpk(p1[6], p1[7]);
    w3.x = cvtpk(p1[8], p1[9]); w3.y = cvtpk(p1[10], p1[11]); w3.z = cvtpk(p1[12], p1[13]); w3.w = cvtpk(p1[14], p1[15]);
    const bf16x8 pa0 = __builtin_bit_cast(bf16x8, w0), pa1 = __builtin_bit_cast(bf16x8, w1), pa2 = __builtin_bit_cast(bf16x8, w2), pa3 = __builtin_bit_cast(bf16x8, w3);
    LAS const unsigned char* vb = lds + cur * AT_BUF + AT_KB + vboff;
#define AT_PV(O_, D0) do { \
      const v4i16_t l0 = vtr(vb + (D0) * 4096), h0 = vtr(vb + (D0) * 4096 + 512), l1 = vtr(vb + (D0) * 4096 + 1024), h1 = vtr(vb + (D0) * 4096 + 1024 + 512); \
      const v4i16_t l2 = vtr(vb + (D0) * 4096 + 2048), h2 = vtr(vb + (D0) * 4096 + 2048 + 512), l3 = vtr(vb + (D0) * 4096 + 3072), h3 = vtr(vb + (D0) * 4096 + 3072 + 512); \
      O_ = __builtin_amdgcn_mfma_f32_32x32x16_bf16(pa0, ((bf16x8){l0[0], l0[1], l0[2], l0[3], h0[0], h0[1], h0[2], h0[3]}), O_, 0, 0, 0); \
      O_ = __builtin_amdgcn_mfma_f32_32x32x16_bf16(pa1, ((bf16x8){l1[0], l1[1], l1[2], l1[3], h1[0], h1[1], h1[2], h1[3]}), O_, 0, 0, 0); \
      O_ = __builtin_amdgcn_mfma_f32_32x32x16_bf16(pa2, ((bf16x8){l2[0], l2[1], l2[2], l2[3], h2[0], h2[1], h2[2], h2[3]}), O_, 0, 0, 0); \
      O_ = __builtin_amdgcn_mfma_f32_32x32x16_bf16(pa3, ((bf16x8){l3[0], l3[1], l3[2], l3[3], h3[0], h3[1], h3[2], h3[3]}), O_, 0, 0, 0); } while (0)
    AT_PV(o0, 0); AT_PV(o1, 1);
#undef AT_PV
    if (t + 1 < NT) AT_STORE(cur ^ 1);
    __syncthreads();
  }
#undef AT_LOAD
#undef AT_STORE
  lrun += __shfl_xor(lrun, 32);
  if (hi == 0) wsf[32 + r32] = 1.f / lrun;
  asm volatile("s_waitcnt lgkmcnt(0)" ::: "memory");
  LAS bf16_t* stg = (LAS bf16_t*)(lds + AT_ST + wave * 4096);
#pragma unroll
  for (int i = 0; i < 16; ++i) {
    const int orow = crow_(i, hi); const float rl = wsf[32 + orow];
    stg[orow * 64 + r32] = (bf16_t)f2bf_(o0[i] * rl);
    stg[orow * 64 + 32 + r32] = (bf16_t)f2bf_(o1[i] * rl);
  }
  asm volatile("s_waitcnt lgkmcnt(0)" ::: "memory");
#pragma unroll
  for (int i = 0; i < 4; ++i) {
    const int row = i * 8 + (lane >> 3), ch = lane & 7;
    const u32x4 ov = *(LAS const u32x4*)(stg + row * 64 + ch * 8);
    const size_t gi = (size_t)(mq0 + wave * 32 + row) * D + hd * 64 + ch * 8;
    const u32x4 zv = *(const u32x4*)(SZ + gi);
    u32x4 res;
#pragma unroll
    for (int e = 0; e < 4; ++e) res[e] = pk2_(bf2f(ov[e] & 0xffffu) * bf2f(zv[e] & 0xffffu), bf2f(ov[e] >> 16) * bf2f(zv[e] >> 16));
    *(u32x4*)(Gout + gi) = res;
  }
}
constexpr size_t M_XMIX = M_UT;
constexpr size_t M_YF = M_UT, M_YB = M_UT + 32 * MiB;
constexpr size_t M_RB = M_SCR2, M_KB = M_SCR2 + 16 * MiB, M_VB = M_SCR2 + 32 * MiB, M_SZR = M_SCR2 + 48 * MiB;
constexpr size_t M_HWA = M_GB;
constexpr size_t M_BON = M_GB + 8 * MiB;

__device__ __forceinline__ void phase_rw_mix(const LAS PG& p, unsigned char* ws, int tid, int bid, int G) {
  const bf16_t* HB = (const bf16_t*)(ws + M_HB);
  bf16_t* XM = (bf16_t*)(ws + M_XMIX);
  for (int i = bid * 512 + tid; i < NTOK * 128; i += G * 512) {
    const int m = i >> 7, k8 = i & 127;
    int l, L, cond, m0; tokinfo(m, l, L, cond, m0);
    const u32x4 hc = *(const u32x4*)(HB + (size_t)m * D + 8 * k8);
    u32x4 hp = (u32x4){0u, 0u, 0u, 0u}, hn = hp;
    if (l > 0) hp = *(const u32x4*)(HB + (size_t)(m - 1) * D + 8 * k8);
    if (l < L - 1) hn = *(const u32x4*)(HB + (size_t)(m + 1) * D + 8 * k8);
    float h[8], d[8];
#pragma unroll
    for (int e = 0; e < 4; ++e) {
      h[2 * e] = bf2f(hc[e] & 0xffffu); h[2 * e + 1] = bf2f(hc[e] >> 16);
      d[2 * e] = 0.5f * (bf2f(hp[e] & 0xffffu) + bf2f(hn[e] & 0xffffu)) - h[2 * e];
      d[2 * e + 1] = 0.5f * (bf2f(hp[e] >> 16) + bf2f(hn[e] >> 16)) - h[2 * e + 1];
    }
#pragma unroll
    for (int q = 0; q < 4; ++q) {
      const int mi = (q == 0) ? 0 : (q == 1) ? 2 : (q == 2) ? 3 : 5;
      const f32x4 u0 = *(const f32x4*)(p.rw_mu + mi * D + 8 * k8), u1 = *(const f32x4*)(p.rw_mu + mi * D + 8 * k8 + 4);
      u32x4 o; o.x = pk2_(h[0] + d[0] * u0.x, h[1] + d[1] * u0.y); o.y = pk2_(h[2] + d[2] * u0.z, h[3] + d[3] * u0.w);
      o.z = pk2_(h[4] + d[4] * u1.x, h[5] + d[5] * u1.y); o.w = pk2_(h[6] + d[6] * u1.z, h[7] + d[7] * u1.w);
      *(u32x4*)(XM + (size_t)q * NTOK * D + (size_t)m * D + 8 * k8) = o;
    }
  }
}

__device__ __forceinline__ void rw_lora_tile(const LAS PG& p, unsigned char* ws, LAS unsigned char* lds, int tile, int tid, int lane, int wave) {
  const bf16_t* HB = (const bf16_t*)(ws + M_HB);
  const bf16_t* Wf = (const bf16_t*)(ws + W_LORA1);
  const int h = lane >> 5, t0 = tile * 32;
  __syncthreads();
#pragma unroll 2
  for (int i = 0; i < 8; ++i) {
    const int idx = tid + 512 * i; const int tok = idx >> 7, k8 = idx & 127; const int m = t0 + tok;
    int l, L, cond, m0; tokinfo(m, l, L, cond, m0);
    const u32x4 hc = *(const u32x4*)(HB + (size_t)m * D + 8 * k8);
    u32x4 hp = (u32x4){0u, 0u, 0u, 0u}, hn = hp;
    if (l > 0) hp = *(const u32x4*)(HB + (size_t)(m - 1) * D + 8 * k8);
    if (l < L - 1) hn = *(const u32x4*)(HB + (size_t)(m + 1) * D + 8 * k8);
    float hh[8], d[8];
#pragma unroll
    for (int e = 0; e < 4; ++e) {
      hh[2 * e] = bf2f(hc[e] & 0xffffu); hh[2 * e + 1] = bf2f(hc[e] >> 16);
      d[2 * e] = 0.5f * (bf2f(hp[e] & 0xffffu) + bf2f(hn[e] & 0xffffu)) - hh[2 * e];
      d[2 * e + 1] = 0.5f * (bf2f(hp[e] >> 16) + bf2f(hn[e] >> 16)) - hh[2 * e + 1];
    }
#pragma unroll
    for (int q = 0; q < 2; ++q) {
      const int mi = q ? 4 : 1;
      const f32x4 u0 = *(const f32x4*)(p.rw_mu + mi * D + 8 * k8), u1 = *(const f32x4*)(p.rw_mu + mi * D + 8 * k8 + 4);
      u32x4 o; o.x = pk2_(hh[0] + d[0] * u0.x, hh[1] + d[1] * u0.y); o.y = pk2_(hh[2] + d[2] * u0.z, hh[3] + d[3] * u0.w);
      o.z = pk2_(hh[4] + d[4] * u1.x, hh[5] + d[5] * u1.y); o.w = pk2_(hh[6] + d[6] * u1.z, hh[7] + d[7] * u1.w);
      *(LAS u32x4*)(lds + q * 65536 + (k8 * 32 + tok) * 16) = o;
    }
  }
  __syncthreads();
  f32x16 acc;
#pragma unroll
  for (int i = 0; i < 16; ++i) acc[i] = 0.f;
  const int aoff = (wave >> 2) * 65536 + ((h * 32) + (lane & 31)) * 16;
  const bf16_t* wf = Wf + ((size_t)wave * 64 * 64 + lane) * 8;
#pragma unroll 4
  for (int ks = 0; ks < 64; ++ks) {
    const bf16x8 af = *(LAS const bf16x8*)(lds + aoff + ks * 1024);
    const bf16x8 b0 = *(const bf16x8*)(wf + ((size_t)ks * 64) * 8);
    acc = __builtin_amdgcn_mfma_f32_32x32x16_bf16(af, b0, acc, 0, 0, 0);
  }
  bf16_t* HWA = (bf16_t*)(ws + M_HWA);
#pragma unroll
  for (int i = 0; i < 16; ++i) {
    const int row = (i & 3) + 8 * (i >> 2) + 4 * h;
    const float v = (wave < 4) ? tanhf(acc[i]) : acc[i];
    HWA[(size_t)(t0 + row) * 256 + wave * 32 + (lane & 31)] = (bf16_t)f2bf_(v);
  }
}

#define DPP_ADD(v, CTRL) ((v) + __builtin_bit_cast(float, __builtin_amdgcn_mov_dpp(__builtin_bit_cast(int, (v)), (CTRL), 0xF, 0xF, true)))
__device__ __forceinline__ float allred4(float v) { v = DPP_ADD(v, 0xB1); v = DPP_ADD(v, 0x4E); return v; }
__device__ __forceinline__ float allred16(float v) { v = DPP_ADD(v, 0xB1); v = DPP_ADD(v, 0x4E); v = DPP_ADD(v, 0x141); v = DPP_ADD(v, 0x140); return v; }

__device__ __forceinline__ float fma_s(float a, float b, float c) { float d; asm("v_fma_f32 %0, %1, %2, %3" : "=v"(d) : "v"(a), "v"(b), "v"(c)); return d; }
__device__ __forceinline__ float mul_s(float a, float b) { float d; asm("v_mul_f32_e32 %0, %1, %2" : "=v"(d) : "v"(a), "v"(b)); return d; }
__device__ __forceinline__ float add_s(float a, float b) { float d; asm("v_add_f32_e32 %0, %1, %2" : "=v"(d) : "v"(a), "v"(b)); return d; }
#define DPPADD_(NAME, CTRL) __device__ __forceinline__ float NAME(float s) { float d; asm("s_nop 1\n\tv_add_f32_dpp %0, %1, %1 " CTRL " row_mask:0xf bank_mask:0xf bound_ctrl:1" : "=v"(d) : "v"(s)); return d; }
DPPADD_(dpp_x1, "quad_perm:[1,0,3,2]")
DPPADD_(dpp_x2, "quad_perm:[2,3,0,1]")
DPPADD_(dpp_hm, "row_half_mirror")
DPPADD_(dpp_rm, "row_mirror")
__device__ __forceinline__ float ar4(float v) { return dpp_x2(dpp_x1(v)); }
__device__ __forceinline__ float ar16(float v) { return dpp_rm(dpp_hm(dpp_x2(dpp_x1(v)))); }
__device__ __forceinline__ float dot4_s(const f32x4& s, const f32x4& a) { return add_s(fma_s(s.y, a.y, mul_s(s.x, a.x)), fma_s(s.w, a.w, mul_s(s.z, a.z))); }
__device__ __forceinline__ void upd4_s(f32x4& s, const f32x4& w, const f32x4& b, const f32x4& k, float sa, float vi) {
  s.x = fma_s(s.x, w.x, fma_s(sa, b.x, mul_s(vi, k.x))); s.y = fma_s(s.y, w.y, fma_s(sa, b.y, mul_s(vi, k.y)));
  s.z = fma_s(s.z, w.z, fma_s(sa, b.z, mul_s(vi, k.z))); s.w = fma_s(s.w, w.w, fma_s(sa, b.w, mul_s(vi, k.w)));
}
constexpr int PB_BYTES = 24832;
constexpr int SC_PS0 = 0, SC_PP0 = 2 * PB_BYTES;

constexpr int SC_FR = 4 * PB_BYTES;
__device__ __forceinline__ u32x4 ld_bfrag(const GASF* W2, int ks, int lane) {
  const int k0 = 32 * ks + 8 * (lane >> 4);
  u32x4 o; o.x = pk2_(W2[(size_t)(k0 + 0) * D], W2[(size_t)(k0 + 1) * D]); o.y = pk2_(W2[(size_t)(k0 + 2) * D], W2[(size_t)(k0 + 3) * D]);
  o.z = pk2_(W2[(size_t)(k0 + 4) * D], W2[(size_t)(k0 + 5) * D]); o.w = pk2_(W2[(size_t)(k0 + 6) * D], W2[(size_t)(k0 + 7) * D]);
  return o;
}
struct ChId { int dir, hd, m0, L, froff; };
__device__ __forceinline__ ChId chid(int slot, int seq, int dir, int hd, int lane, int ntile) {
  ChId c; c.dir = dir; c.hd = hd; c.L = seq < 16 ? 256 : 2048; c.m0 = seq < 16 ? seq * 256 : NPT + (seq - 16) * 2048;
  c.froff = SC_FR + ((slot * 4 + ntile) * 6) * 1024 + lane * 16; return c;
}
__device__ __forceinline__ void prepc_load(const LAS PG& p, LAS unsigned char* lds, int froff, int dir, int hd, int lane, int ntile) {
  const int ch = hd * 64 + 16 * ntile + (lane & 15);
  const GASF* W2 = p.rw_w2 + (size_t)dir * 64 * D + ch; const GASF* A2 = p.rw_a2 + (size_t)dir * 64 * D + ch;
  *(LAS u32x4*)(lds + froff) = ld_bfrag(W2, 0, lane); __builtin_amdgcn_sched_barrier(0);
  *(LAS u32x4*)(lds + froff + 1024) = ld_bfrag(W2, 1, lane); __builtin_amdgcn_sched_barrier(0);
  *(LAS u32x4*)(lds + froff + 2048) = ld_bfrag(A2, 0, lane); __builtin_amdgcn_sched_barrier(0);
  *(LAS u32x4*)(lds + froff + 3072) = ld_bfrag(A2, 1, lane); __builtin_amdgcn_sched_barrier(0);
  LAS float* cn = (LAS float*)(lds + (froff - lane * 16) + 4096) + lane;
  cn[0] = p.rw_w0[dir * D + ch]; cn[64] = p.rw_a0[dir * D + ch]; cn[128] = p.rw_k_k[ch]; cn[192] = p.rw_k_a[ch]; cn[256] = p.rw_r_k[ch];
}
struct PrepIn { u32x4 hw[2], ha[2]; unsigned kr[4], rr[4], vr[4]; };
__device__ __forceinline__ int ctok(int m0, int L, int dir, int step) { return m0 + (dir ? (L - 1 - step) : step); }
__device__ __forceinline__ void prep_fetch(const unsigned char* ws, int c_m0, int c_L, int c_dir, int c_hd, int s0, int lane, int ntile, PrepIn& in) {
  const bf16_t* HWA = (const bf16_t*)(ws + M_HWA);
  const int m = ctok(c_m0, c_L, c_dir, s0 + (lane & 15));
  const bf16_t* src = HWA + (size_t)m * 256 + c_dir * 64 + 8 * (lane >> 4);
  in.hw[0] = *(const u32x4*)(src); in.hw[1] = *(const u32x4*)(src + 32);
  in.ha[0] = *(const u32x4*)(src + 128); in.ha[1] = *(const u32x4*)(src + 160);
#pragma unroll
  for (int r = 0; r < 4; ++r) {
    const int mt = ctok(c_m0, c_L, c_dir, s0 + 4 * (lane >> 4) + r);
    const size_t gi = (size_t)mt * D + c_hd * 64 + 16 * ntile + (lane & 15);
    in.kr[r] = ((const bf16_t*)(ws + M_KB))[gi]; in.rr[r] = ((const bf16_t*)(ws + M_RB))[gi]; in.vr[r] = ((const bf16_t*)(ws + M_VB))[gi];
  }
}
__device__ __forceinline__ bf16x8 pack8(const f32x4& a, const f32x4& b) { u32x4 o; o.x = pk2_(a.x, a.y); o.y = pk2_(a.z, a.w); o.z = pk2_(b.x, b.y); o.w = pk2_(b.z, b.w); return __builtin_bit_cast(bf16x8, o); }
__device__ __forceinline__ void prep_finish(unsigned char* ws, LAS unsigned char* lds, int c_m0, int c_L, int c_dir, int c_hd, int c_froff, int s0, int pboff, int lane, int ntile, const PrepIn& in) {
  LAS const float* cn = (LAS const float*)(lds + (c_froff - lane * 16) + 4096) + lane;
  const float c_biasw = cn[0], c_biasa = cn[64], c_kkc = cn[128], c_kac = cn[192], c_rkc = cn[256];
  f32x4 aw = (f32x4){c_biasw, c_biasw, c_biasw, c_biasw}, aa = (f32x4){c_biasa, c_biasa, c_biasa, c_biasa};
  aw = __builtin_amdgcn_mfma_f32_16x16x32_bf16(__builtin_bit_cast(bf16x8, in.hw[0]), *(LAS const bf16x8*)(lds + c_froff), aw, 0, 0, 0);
  aw = __builtin_amdgcn_mfma_f32_16x16x32_bf16(__builtin_bit_cast(bf16x8, in.hw[1]), *(LAS const bf16x8*)(lds + c_froff + 1024), aw, 0, 0, 0);
  aa = __builtin_amdgcn_mfma_f32_16x16x32_bf16(__builtin_bit_cast(bf16x8, in.ha[0]), *(LAS const bf16x8*)(lds + c_froff + 2048), aa, 0, 0, 0);
  aa = __builtin_amdgcn_mfma_f32_16x16x32_bf16(__builtin_bit_cast(bf16x8, in.ha[1]), *(LAS const bf16x8*)(lds + c_froff + 3072), aa, 0, 0, 0);
  LAS float* pb = (LAS float*)(lds + pboff);
  const int col = lane & 15, rg = lane >> 4, chl = 16 * ntile + col;
#pragma unroll
  for (int r = 0; r < 4; ++r) {
    const int t = 4 * rg + r;
    const float sig = __builtin_amdgcn_rcpf(1.f + __expf(-aw[r]));
    const float dec = __expf(-0.6065306597126334f * sig);
    const float a = __builtin_amdgcn_rcpf(1.f + __expf(-aa[r]));
    const float k = bf2f(in.kr[r]), rv = bf2f(in.rr[r]), v = bf2f(in.vr[r]);
    const float kq = k * c_kkc;
    const float ssq = ar16(kq * kq);
    const float kd = k * (1.f + (a - 1.f) * c_kac);
    const float bon = ar16(rv * kd * c_rkc);
    pb[t * 64 + chl] = dec; pb[1024 + t * 64 + chl] = -kq; pb[2048 + t * 64 + chl] = kq * a; pb[3072 + t * 64 + chl] = kd; pb[4096 + t * 64 + chl] = rv; pb[5120 + t * 64 + chl] = v;
    if (col == 0) {
      pb[6144 + t * 4 + ntile] = ssq;
      const int mt = ctok(c_m0, c_L, c_dir, s0 + t);
      ((float*)(ws + M_BON))[(((size_t)c_dir * NTOK + mt) * 16 + c_hd) * 4 + ntile] = bon;
    }
  }
}

#define LDS_BARRIER() asm volatile("s_waitcnt lgkmcnt(0)\n\ts_barrier" ::: "memory")
__device__ __forceinline__ void phase_rw_scan(const LAS PG& p, unsigned char* ws, LAS unsigned char* lds, int tid, int lane, int wave, int bid, int G) {
  for (int item = bid; item < 256; item += G) {
    const int sc = item >> 2, qt = item & 3;
    const int s_seq = 16 + (sc >> 5), s_dir = (sc >> 4) & 1, s_hd = sc & 15, s_m0 = NPT + (s_seq - 16) * 2048;
    __syncthreads();
    if (wave < 4) {
      __builtin_amdgcn_s_setprio(2);
      float* Yo = (float*)(ws + (s_dir ? M_YB : M_YF));
      const int srow = 16 * qt + 4 * wave + (lane >> 4), scg = lane & 15;
      f32x4 Ss = *(const GAS f32x4*)(p.state_rwkv + ((((size_t)(s_seq - 16)) * 2 + s_dir) * 16 + s_hd) * 4096 + (size_t)srow * 64 + 4 * scg);
      __syncthreads();
      for (int c = 0; c < 128; ++c) {
        LAS const float* ps = (LAS const float*)(lds + SC_PS0 + (c & 1) * PB_BYTES);
        float rn2v;
        { const f32x4 q4 = *(LAS const f32x4*)(ps + 6144 + (lane & 15) * 4); rn2v = __builtin_amdgcn_rcpf((q4.x + q4.y) + (q4.z + q4.w) + 1e-12f); }
        float yk[16];
#pragma unroll
        for (int t = 0; t < 16; ++t) {
          const f32x4 w4 = *(LAS const f32x4*)(ps + t * 64 + 4 * scg), a4 = *(LAS const f32x4*)(ps + 1024 + t * 64 + 4 * scg);
          const f32x4 b4 = *(LAS const f32x4*)(ps + 2048 + t * 64 + 4 * scg), k4 = *(LAS const f32x4*)(ps + 3072 + t * 64 + 4 * scg);
          const f32x4 r4 = *(LAS const f32x4*)(ps + 4096 + t * 64 + 4 * scg);
          const float vi = ps[5120 + t * 64 + srow];
          const float rn2 = __builtin_bit_cast(float, __builtin_amdgcn_readlane(__builtin_bit_cast(int, rn2v), t));
          const float sa = ar16(dot4_s(Ss, a4)) * rn2;
          upd4_s(Ss, w4, b4, k4, sa, vi);
          yk[t] = ar16(dot4_s(Ss, r4));
        }
        if (scg == 0) {
          const int mfirst = ctok(s_m0, 2048, s_dir, 16 * c);
          float* yp = Yo + (size_t)mfirst * D + s_hd * 64 + srow;
          const long stride = s_dir ? -(long)D : (long)D;
#pragma unroll
          for (int t = 0; t < 16; ++t) yp[t * stride] = yk[t];
        }
        LDS_BARRIER();
      }
      __builtin_amdgcn_s_setprio(0);
    } else {
      const int nt = wave - 4;
      const int s_fr = SC_FR + ((0 * 4 + nt) * 6) * 1024 + lane * 16;
      prepc_load(p, lds, s_fr, s_dir, s_hd, lane, nt);
      int pc = 2 * item;
      const int q_fr = SC_FR + ((1 * 4 + nt) * 6) * 1024 + lane * 16;
      prepc_load(p, lds, q_fr, (pc >> 4) & 1, pc & 15, lane, nt);
      int r_seq = pc >> 5, r_dir = (pc >> 4) & 1, r_hd = pc & 15;
      int q_seq = pc >> 5, q_dir = (pc >> 4) & 1, q_hd = pc & 15;
      PrepIn in_s, in_p;
      prep_fetch(ws, s_m0, 2048, s_dir, s_hd, 0, lane, nt, in_s); prep_fetch(ws, r_seq * 256, 256, r_dir, r_hd, 0, lane, nt, in_p);
      prep_finish(ws, lds, s_m0, 2048, s_dir, s_hd, s_fr, 0, SC_PS0, lane, nt, in_s); prep_finish(ws, lds, r_seq * 256, 256, r_dir, r_hd, q_fr, 0, SC_PP0, lane, nt, in_p);
      const int prow = 16 * nt + (lane >> 2), pcq = lane & 3;
      f32x4 Sp0 = (f32x4){0.f, 0.f, 0.f, 0.f}, Sp1 = Sp0, Sp2 = Sp0, Sp3 = Sp0;
      __syncthreads();
      for (int c = 0; c < 128; ++c) {
        const bool more_s = (c + 1) < 128;
        const bool pgrp = ((c & 3) == 0) && (c + 4 < 128);
        if (more_s) prep_fetch(ws, s_m0, 2048, s_dir, s_hd, 16 * (c + 1), lane, nt, in_s);
        if (pgrp) {
          if (c == 60) { pc = 2 * item + 1; r_seq = pc >> 5; r_dir = (pc >> 4) & 1; r_hd = pc & 15; prepc_load(p, lds, q_fr, r_dir, r_hd, lane, nt); }
          prep_fetch(ws, r_seq * 256, 256, r_dir, r_hd, 4 * ((c + 4) & 63), lane, nt, in_p);
        }
        if (c == 64) { q_seq = r_seq; q_dir = r_dir; q_hd = r_hd; Sp0 = (f32x4){0.f, 0.f, 0.f, 0.f}; Sp1 = Sp0; Sp2 = Sp0; Sp3 = Sp0; }
        {
          LAS const float* pp = (LAS const float*)(lds + SC_PP0 + ((c >> 2) & 1) * PB_BYTES);
          float* Yp = (float*)(ws + (q_dir ? M_YB : M_YF));
          float rn2v;
          { const f32x4 q4 = *(LAS const f32x4*)(pp + 6144 + (lane & 15) * 4); rn2v = __builtin_amdgcn_rcpf((q4.x + q4.y) + (q4.z + q4.w) + 1e-12f); }
#pragma unroll 2
          for (int s = 0; s < 4; ++s) {
            const int t = 4 * (c & 3) + s;
            const float vi = pp[5120 + t * 64 + prow];
            const float rn2 = __builtin_bit_cast(float, __builtin_amdgcn_readlane(__builtin_bit_cast(int, rn2v), t));
            LAS const float* q = pp + t * 64 + 16 * pcq;
            const f32x4 a0 = *(LAS const f32x4*)(q + 1024), a1 = *(LAS const f32x4*)(q + 1028), a2 = *(LAS const f32x4*)(q + 1032), a3 = *(LAS const f32x4*)(q + 1036);
            const float sa = ar4(add_s(add_s(dot4_s(Sp0, a0), dot4_s(Sp1, a1)), add_s(dot4_s(Sp2, a2), dot4_s(Sp3, a3)))) * rn2;
            float y0, y1, y2, y3;
#define UP4(S_, O_, Y_) { const f32x4 w4 = *(LAS const f32x4*)(q + (O_)), b4 = *(LAS const f32x4*)(q + 2048 + (O_)), k4 = *(LAS const f32x4*)(q + 3072 + (O_)), r4 = *(LAS const f32x4*)(q + 4096 + (O_)); \
              upd4_s(S_, w4, b4, k4, sa, vi); Y_ = dot4_s(S_, r4); }
            UP4(Sp0, 0, y0) UP4(Sp1, 4, y1) UP4(Sp2, 8, y2) UP4(Sp3, 12, y3)
#undef UP4
            const float y = ar4(add_s(add_s(y0, y1), add_s(y2, y3)));
            if (pcq == 0) Yp[(size_t)ctok(q_seq * 256, 256, q_dir, 4 * (c & 63) + s) * D + q_hd * 64 + prow] = y;
          }
          if ((c & 63) == 63) {
            GASF* so = p.out + OUT_ST + ((((size_t)q_seq) * 2 + q_dir) * 16 + q_hd) * 4096 + (size_t)prow * 64 + 16 * pcq;
            *(GAS f32x4*)so = Sp0; *(GAS f32x4*)(so + 4) = Sp1; *(GAS f32x4*)(so + 8) = Sp2; *(GAS f32x4*)(so + 12) = Sp3;
          }
        }
        if (more_s) prep_finish(ws, lds, s_m0, 2048, s_dir, s_hd, s_fr, 16 * (c + 1), SC_PS0 + ((c + 1) & 1) * PB_BYTES, lane, nt, in_s);
        if (pgrp) prep_finish(ws, lds, r_seq * 256, 256, r_dir, r_hd, q_fr, 4 * ((c + 4) & 63), SC_PP0 + (((c >> 2) + 1) & 1) * PB_BYTES, lane, nt, in_p);
        LDS_BARRIER();
      }
    }
  }
}
constexpr int CK_OPS = 20992;
constexpr int CK_MX = 3 * CK_OPS;
constexpr int CK_SCR = CK_MX + 2 * 8192;
constexpr int CK_SSQ = CK_SCR + 6144;
constexpr int CK_FR = CK_SSQ + 1024;
constexpr int CK_IN = CK_FR + 4 * 6144;
constexpr int CK_INS = 20992;

__device__ __forceinline__ unsigned short bfr(float f) { return (unsigned short)f2bf_(f); }
__device__ __forceinline__ bf16x8 cvt8(const f32x16& a, int s) {
  u32x4 o; o.x = pk2_(a[8 * s + 0], a[8 * s + 1]); o.y = pk2_(a[8 * s + 2], a[8 * s + 3]); o.z = pk2_(a[8 * s + 4], a[8 * s + 5]); o.w = pk2_(a[8 * s + 6], a[8 * s + 7]);
  return __builtin_bit_cast(bf16x8, o);
}
__device__ __forceinline__ bf16x8 ldA_perm(LAS const unsigned char* base, int ld, int row, int k0, int hi) {
  const u32x2 lo = *(LAS const u32x2*)(base + (row * ld + k0 + 4 * hi) * 2), hh = *(LAS const u32x2*)(base + (row * ld + k0 + 8 + 4 * hi) * 2);
  u32x4 o; o.x = lo.x; o.y = lo.y; o.z = hh.x; o.w = hh.y; return __builtin_bit_cast(bf16x8, o);
}
__device__ __forceinline__ bf16x8 ldT_perm(LAS const unsigned char* base, int ld, int k0, int c0, int lane) {
  const int hi = lane >> 5;
  LAS const unsigned char* a = base + ((k0 + 4 * hi + ((lane & 15) >> 2)) * ld + c0 + 16 * ((lane >> 4) & 1) + 4 * (lane & 3)) * 2;
  const v4i16_t lo = vtr(a), hh = vtr(a + 8 * ld * 2);
  return (bf16x8){lo[0], lo[1], lo[2], lo[3], hh[0], hh[1], hh[2], hh[3]};
}
__device__ __forceinline__ bf16x8 ldT_nat(LAS const unsigned char* base, int ld, int k0, int c0, int lane) {
  const int hi = lane >> 5;
  LAS const unsigned char* a = base + ((k0 + 8 * hi + ((lane & 15) >> 2)) * ld + c0 + 16 * ((lane >> 4) & 1) + 4 * (lane & 3)) * 2;
  const v4i16_t lo = vtr(a), hh = vtr(a + 4 * ld * 2);
  return (bf16x8){lo[0], lo[1], lo[2], lo[3], hh[0], hh[1], hh[2], hh[3]};
}
__device__ __forceinline__ int opq5(int x) { asm volatile("" : "+v"(x)); return x; }
#define MFMA32(A_, B_, C_) __builtin_amdgcn_mfma_f32_32x32x16_bf16((A_), (B_), (C_), 0, 0, 0)

struct CkChain { int seq, dir, hd, m0, L, nch; };
__device__ __forceinline__ CkChain ck_chain(int id) {
  CkChain c;
  if (id < 64) { c.seq = 16 + (id >> 5); c.dir = (id >> 4) & 1; c.hd = id & 15; c.L = 2048; c.m0 = NPT + (c.seq - 16) * 2048; }
  else { const int p = id - 64; c.seq = p >> 5; c.dir = (p >> 4) & 1; c.hd = p & 15; c.L = 256; c.m0 = c.seq * 256; }
  c.nch = c.L / 32; return c;
}

__device__ __forceinline__ void ck_run_chain(const LAS PG& p, unsigned char* ws, LAS unsigned char* lds, const CkChain ch, int lane_in, int wave) {
  const int lane = lane_in;
  const int hi = lane >> 5, r32 = lane & 31;
  float* Yo = (float*)(ws + (ch.dir ? M_YB : M_YF));
  const int NK = ch.nch + 3;
#define CK_PROD(ACC, AOFF, BOFF) do { _Pragma("unroll") for (int i_ = 0; i_ < 16; ++i_) ACC[i_] = 0.f; \
          _Pragma("unroll") for (int ks = 0; ks < 4; ++ks) { \
            const bf16x8 af_ = *(LAS const bf16x8*)(ob + (AOFF) + (r32 * 64 + 16 * ks + 8 * hi) * 2), bf_ = *(LAS const bf16x8*)(ob + (BOFF) + (r32 * 64 + 16 * ks + 8 * hi) * 2); \
            ACC = MFMA32(af_, bf_, ACC); } } while (0)
#define CK_STORE_T(ACC, DST, STRICT) do { _Pragma("unroll") for (int q_ = 0; q_ < 4; ++q_) { \
            float v_[4]; _Pragma("unroll") for (int x_ = 0; x_ < 4; ++x_) { const int s_ = 8 * q_ + 4 * hi + x_; const bool keep_ = (STRICT) ? (s_ < r32) : (s_ <= r32); v_[x_] = keep_ ? ACC[4 * q_ + x_] : 0.f; ACC[4 * q_ + x_] = v_[x_]; } \
            u32x2 w_; w_.x = pk2_(v_[0], v_[1]); w_.y = pk2_(v_[2], v_[3]); *(LAS u32x2*)((DST) + (r32 * 32 + 8 * q_ + 4 * hi) * 2) = w_; } } while (0)
#define CK_STORE_TN(ACC, DST) do { _Pragma("unroll") for (int q_ = 0; q_ < 4; ++q_) { u32x2 w_; w_.x = pk2_(ACC[4 * q_], ACC[4 * q_ + 1]); w_.y = pk2_(ACC[4 * q_ + 2], ACC[4 * q_ + 3]); \
            *(LAS u32x2*)((DST) + (r32 * 32 + 8 * q_ + 4 * hi) * 2) = w_; } } while (0)
  if (wave >= 4) {
    float rw_dec[8], rw_al[8], rw_kq[8], rw_kd[8], rw_r[8], rw_v[8];
    const int nt = wave - 4, col = lane & 15, g = lane >> 4;
    const int froff = CK_FR + nt * 6144 + lane * 16;
#pragma unroll
    for (int i = 0; i < 8; ++i) { rw_dec[i] = 1.f; rw_al[i] = 0.f; rw_kq[i] = 0.f; rw_kd[i] = 0.f; rw_r[i] = 0.f; rw_v[i] = 0.f; }
    prepc_load(p, lds, froff, ch.dir, ch.hd, lane, nt);
    const int pb_e = (4 * g * 64 + 16 * nt + col) * 2;
    const int pb_h = col * 272 + 16 * g;
    const int pb_sq = (16 * g) * 4, pb_sqw = (16 * g + nt) * 4;
    const int dstep = ch.dir ? -1 : 1;
    LDS_BARRIER();
    for (int k = 0; k < NK; ++k) {
      LAS const float* cn = (LAS const float*)(lds + (froff - lane * 16) + 4096) + lane;
      if (k >= 1 && k <= ch.nch) {
        LAS unsigned char* ob = lds + ((k - 1) % 3) * CK_OPS;
        LAS const float* sq = (LAS const float*)(lds + CK_SSQ + ((k - 1) & 1) * 512);
        float cp[8];
        cp[0] = rw_dec[0]; cp[1] = cp[0] * rw_dec[1]; cp[2] = cp[1] * rw_dec[2]; cp[3] = cp[2] * rw_dec[3];
        cp[4] = rw_dec[4]; cp[5] = cp[4] * rw_dec[5]; cp[6] = cp[5] * rw_dec[6]; cp[7] = cp[6] * rw_dec[7];
        float E0, E1;
        {
          float t0 = cp[3], t1 = cp[7];
          float x0 = __shfl(t0, (lane + 48) & 63), x1 = __shfl(t1, (lane + 48) & 63); if (g < 1) { x0 = 1.f; x1 = 1.f; }
          float i0 = t0 * x0, i1 = t1 * x1;
          float y0 = __shfl(i0, (lane + 32) & 63), y1 = __shfl(i1, (lane + 32) & 63); if (g < 2) { y0 = 1.f; y1 = 1.f; }
          i0 *= y0; i1 *= y1;
          float e0 = __shfl(i0, (lane + 48) & 63), e1 = __shfl(i1, (lane + 48) & 63); if (g < 1) { e0 = 1.f; e1 = 1.f; }
          const float T0 = __shfl(i0, col + 48);
          E0 = e0; E1 = T0 * e1;
        }
#pragma unroll
        for (int e = 0; e < 8; ++e) {
          const int mt = e >> 2, r = e & 3;
          const f32x4 q4 = *(LAS const f32x4*)((LAS const unsigned char*)sq + pb_sq + (16 * mt + r) * 16);
          const float rn = rsqrtf((q4.x + q4.y) + (q4.z + q4.w) + 1e-12f);
          const float Eb = mt ? E1 : E0;
          const float Wt = Eb * cp[e], Wp = (r == 0) ? Eb : Eb * cp[e - 1];
          const float iw = __builtin_amdgcn_rcpf(Wt);
          const float kqn = rw_kq[e] * rn;
          LAS unsigned short* o16 = (LAS unsigned short*)(ob + pb_e + (16 * mt + r) * 128);
          o16[0] = bfr(-Wp * kqn);
          o16[2048] = bfr(kqn * rw_al[e] * iw);
          o16[4096] = bfr(rw_kd[e] * iw);
          o16[6144] = bfr(Wt * rw_r[e]);
          o16[8192] = bfr(rw_v[e]);
          if (e == 7 && g == 3) ((LAS float*)(ob + 20480))[16 * nt + col] = Wt;
        }
      }
      if (k < ch.nch) {
        const float c_biasw = cn[0], c_biasa = cn[64], c_kkc = cn[128], c_kac = cn[192], c_rkc = cn[256];
        LAS float* sq = (LAS float*)(lds + CK_SSQ + (k & 1) * 512);
        LAS const unsigned char* in = lds + CK_IN + (k & 1) * CK_INS;
#pragma unroll
        for (int mt = 0; mt < 2; ++mt) {
          f32x4 aw = (f32x4){c_biasw, c_biasw, c_biasw, c_biasw}, aa = (f32x4){c_biasa, c_biasa, c_biasa, c_biasa};
          LAS const unsigned char* hrow = in + 12288 + pb_h + 16 * mt * 272;
          aw = __builtin_amdgcn_mfma_f32_16x16x32_bf16(*(LAS const bf16x8*)(hrow), *(LAS const bf16x8*)(lds + froff), aw, 0, 0, 0);
          aw = __builtin_amdgcn_mfma_f32_16x16x32_bf16(*(LAS const bf16x8*)(hrow + 64), *(LAS const bf16x8*)(lds + froff + 1024), aw, 0, 0, 0);
          aa = __builtin_amdgcn_mfma_f32_16x16x32_bf16(*(LAS const bf16x8*)(hrow + 128), *(LAS const bf16x8*)(lds + froff + 2048), aa, 0, 0, 0);
          aa = __builtin_amdgcn_mfma_f32_16x16x32_bf16(*(LAS const bf16x8*)(hrow + 192), *(LAS const bf16x8*)(lds + froff + 3072), aa, 0, 0, 0);
          unsigned pf_k[8], pf_r[8], pf_v[8];
#pragma unroll
          for (int r = 0; r < 4; ++r) {
            LAS const unsigned short* e16 = (LAS const unsigned short*)(in + pb_e + (16 * mt + r) * 128);
            pf_k[4 * mt + r] = e16[0]; pf_r[4 * mt + r] = e16[2048]; pf_v[4 * mt + r] = e16[4096];
          }
          float sq4[4], bn4[4];
#pragma unroll
          for (int r = 0; r < 4; ++r) {
            const int e = 4 * mt + r;
            const float sig = __builtin_amdgcn_rcpf(1.f + __expf(-aw[r]));
            rw_dec[e] = __expf(-0.6065306597126334f * sig);
            const float a = __builtin_amdgcn_rcpf(1.f + __expf(-aa[r]));
            rw_al[e] = a;
            const float kv = bf2f(pf_k[e]), rv = bf2f(pf_r[e]);
            rw_r[e] = rv; rw_v[e] = bf2f(pf_v[e]);
            const float kq = kv * c_kkc; rw_kq[e] = kq;
            const float kd = kv * (1.f + (a - 1.f) * c_kac); rw_kd[e] = kd;
            sq4[r] = kq * kq; bn4[r] = rv * kd * c_rkc;
          }
#define CK_DPP(v, CTRL) __builtin_bit_cast(float, __builtin_amdgcn_update_dpp(0, __builtin_bit_cast(int, (v)), (CTRL), 0xF, 0xF, true))
#pragma unroll
          for (int r = 0; r < 4; ++r) { sq4[r] += CK_DPP(sq4[r], 0xB1); bn4[r] += CK_DPP(bn4[r], 0xB1); }
#pragma unroll
          for (int r = 0; r < 4; ++r) { sq4[r] += CK_DPP(sq4[r], 0x4E); bn4[r] += CK_DPP(bn4[r], 0x4E); }
#pragma unroll
          for (int r = 0; r < 4; ++r) { sq4[r] += CK_DPP(sq4[r], 0x141); bn4[r] += CK_DPP(bn4[r], 0x141); }
#pragma unroll
          for (int r = 0; r < 4; ++r) { sq4[r] += CK_DPP(sq4[r], 0x140); bn4[r] += CK_DPP(bn4[r], 0x140); }
#undef CK_DPP
          if (col == 0) {
            float* bo = (float*)(ws + M_BON) + ((((unsigned)ch.dir * NTOK + (unsigned)ctok(ch.m0, ch.L, ch.dir, 32 * k + 16 * mt + 4 * g)) * 16u + (unsigned)ch.hd) * 4u + (unsigned)nt);
#pragma unroll
            for (int r = 0; r < 4; ++r) {
              *(LAS float*)((LAS unsigned char*)sq + pb_sqw + (16 * mt + r) * 16) = sq4[r];
              bo[r * dstep * 64] = bn4[r];
            }
          }
        }
      }
      LDS_BARRIER();
    }
  } else if (wave == 3) {
    u32x4 ld_k[4], ld_r[4], ld_v[4], ld_h[8];
#define CK_LOAD(KC) do { const int s0_ = 32 * (KC); \
      _Pragma("unroll") for (int i_ = 0; i_ < 4; ++i_) { const int id_ = lane + 64 * i_; const int t_ = id_ >> 3, c8_ = id_ & 7; \
        const unsigned gi_ = (unsigned)ctok(ch.m0, ch.L, ch.dir, s0_ + t_) * (unsigned)D + (unsigned)(ch.hd * 64 + 8 * c8_); \
        ld_k[i_] = *(const u32x4*)((const bf16_t*)(ws + M_KB) + gi_); ld_r[i_] = *(const u32x4*)((const bf16_t*)(ws + M_RB) + gi_); ld_v[i_] = *(const u32x4*)((const bf16_t*)(ws + M_VB) + gi_); } \
      _Pragma("unroll") for (int i_ = 0; i_ < 8; ++i_) { const int id_ = lane + 64 * i_; const int t_ = id_ >> 4, c8_ = id_ & 15; \
        const unsigned go_ = (unsigned)ctok(ch.m0, ch.L, ch.dir, s0_ + t_) * 256u + (unsigned)((c8_ >> 3) * 128 + ch.dir * 64 + 8 * (c8_ & 7)); \
        ld_h[i_] = *(const u32x4*)((const bf16_t*)(ws + M_HWA) + go_); } } while (0)
#define CK_PUT(BUF) do { LAS unsigned char* in_ = lds + CK_IN + (BUF) * CK_INS; \
      _Pragma("unroll") for (int i_ = 0; i_ < 4; ++i_) { const int id_ = lane + 64 * i_; \
        *(LAS u32x4*)(in_ + id_ * 16) = ld_k[i_]; *(LAS u32x4*)(in_ + 4096 + id_ * 16) = ld_r[i_]; *(LAS u32x4*)(in_ + 8192 + id_ * 16) = ld_v[i_]; } \
      _Pragma("unroll") for (int i_ = 0; i_ < 8; ++i_) { const int id_ = lane + 64 * i_; const int t_ = id_ >> 4, c8_ = id_ & 15; \
        *(LAS u32x4*)(in_ + 12288 + t_ * 272 + c8_ * 16) = ld_h[i_]; } } while (0)
    CK_LOAD(0); CK_PUT(0);
    if (ch.nch > 1) CK_LOAD(1);
    LDS_BARRIER();
    for (int k = 0; k < NK; ++k) {
      if (k + 1 < ch.nch) CK_PUT((k + 1) & 1);
      if (k + 2 < ch.nch) CK_LOAD(k + 2);
      if (k >= 2 && k <= ch.nch + 1) {
        const int lane_o = opq5(lane); const int r32 = lane_o & 31, hi = lane_o >> 5;
        LAS const unsigned char* ob = lds + ((k - 2) % 3) * CK_OPS;
        LAS unsigned char* mx = lds + CK_MX + ((k - 2) & 1) * 8192;
        f32x16 acc;
        CK_PROD(acc, 8192, 0);     CK_STORE_T(acc, mx + 0, true);
        CK_PROD(acc, 4096, 12288); CK_STORE_T(acc, mx + 2048, false);
        CK_PROD(acc, 8192, 12288); CK_STORE_T(acc, mx + 4096, false);
      }
      LDS_BARRIER();
    }
#undef CK_LOAD
#undef CK_PUT
  } else if (wave == 2) {
    LDS_BARRIER();
    for (int k = 0; k < NK; ++k) {
      if (k >= 2 && k <= ch.nch + 1) {
        const int lane_o = opq5(lane); const int r32 = lane_o & 31, hi = lane_o >> 5;
        LAS const unsigned char* ob = lds + ((k - 2) % 3) * CK_OPS;
        LAS unsigned char* mx = lds + CK_MX + ((k - 2) & 1) * 8192;
        LAS unsigned char* sc = lds + CK_SCR;
        f32x16 Q, Pm;
        CK_PROD(Q, 4096, 0);
        CK_STORE_T(Q, sc + 2048, true);
#pragma unroll
        for (int i = 0; i < 16; ++i) Pm[i] = Q[i] + ((crow_(i, hi) == r32) ? 1.f : 0.f);
        CK_STORE_TN(Pm, sc + 4096);
        asm volatile("s_waitcnt lgkmcnt(0)" ::: "memory");
#define CK_MM(ACC, Z1T, Z2T) do { _Pragma("unroll") for (int ks = 0; ks < 2; ++ks) { \
          const bf16x8 af_ = ldT_nat(sc + (Z1T), 32, 16 * ks, 0, lane_o), bf_ = *(LAS const bf16x8*)(sc + (Z2T) + (r32 * 32 + 16 * ks + 8 * hi) * 2); \
          ACC = MFMA32(af_, bf_, ACC); } } while (0)
#pragma unroll 1
        for (int it = 0; it < 4; ++it) {
          f32x16 Q2;
#pragma unroll
          for (int i = 0; i < 16; ++i) Q2[i] = 0.f;
          CK_MM(Q2, 2048, 2048);
          asm volatile("s_waitcnt lgkmcnt(0)" ::: "memory");
          CK_STORE_TN(Q2, sc + 2048);
          asm volatile("s_waitcnt lgkmcnt(0)" ::: "memory");
          CK_MM(Pm, 4096, 2048);
          asm volatile("s_waitcnt lgkmcnt(0)" ::: "memory");
          if (it < 3) { CK_STORE_TN(Pm, sc + 4096); asm volatile("s_waitcnt lgkmcnt(0)" ::: "memory"); }
        }
        CK_STORE_TN(Pm, mx + 6144);
#undef CK_MM
      }
      LDS_BARRIER();
    }
  } else {
    f32x16 St0, St1;
#pragma unroll
    for (int i = 0; i < 16; ++i) { St0[i] = 0.f; St1[i] = 0.f; }
    if (ch.L == 2048) {
      const GASF* s0 = p.state_rwkv + ((((size_t)(ch.seq - 16)) * 2 + ch.dir) * 16 + ch.hd) * 4096 + (size_t)(32 * wave + r32) * 64;
#pragma unroll
      for (int q = 0; q < 4; ++q) {
        const f32x4 a = *(const GAS f32x4*)(s0 + 8 * q + 4 * hi), b = *(const GAS f32x4*)(s0 + 32 + 8 * q + 4 * hi);
        St0[4 * q] = a.x; St0[4 * q + 1] = a.y; St0[4 * q + 2] = a.z; St0[4 * q + 3] = a.w;
        St1[4 * q] = b.x; St1[4 * q + 1] = b.y; St1[4 * q + 2] = b.z; St1[4 * q + 3] = b.w;
      }
    }
    LDS_BARRIER();
    for (int k = 0; k < NK; ++k) {
      const int lane = opq5(lane_in); const int hi = lane >> 5, r32 = lane & 31;
      if (k >= 3) {
        const int kc = k - 3, ih = wave;
        LAS const unsigned char* ob = lds + (kc % 3) * CK_OPS;
        LAS const unsigned char* mx = lds + CK_MX + (kc & 1) * 8192;
        const bf16x8 s00 = cvt8(St0, 0), s01 = cvt8(St0, 1), s10 = cvt8(St1, 0), s11 = cvt8(St1, 1);
        const bf16x8 v0 = ldT_perm(ob + 16384, 64, 0, 32 * ih, lane), v1 = ldT_perm(ob + 16384, 64, 16, 32 * ih, lane);
        f32x16 G, U, Y;
#pragma unroll
        for (int i = 0; i < 16; ++i) { G[i] = 0.f; U[i] = 0.f; Y[i] = 0.f; }
        G = MFMA32(ldA_perm(ob + 0, 64, r32, 0, hi), s00, G);  G = MFMA32(ldA_perm(ob + 0, 64, r32, 16, hi), s01, G);
        G = MFMA32(ldA_perm(ob + 0, 64, r32, 32, hi), s10, G); G = MFMA32(ldA_perm(ob + 0, 64, r32, 48, hi), s11, G);
        G = MFMA32(ldA_perm(mx + 0, 32, r32, 0, hi), v0, G);   G = MFMA32(ldA_perm(mx + 0, 32, r32, 16, hi), v1, G);
        const bf16x8 g0 = cvt8(G, 0), g1 = cvt8(G, 1);
        U = MFMA32(ldA_perm(mx + 6144, 32, r32, 0, hi), g0, U); U = MFMA32(ldA_perm(mx + 6144, 32, r32, 16, hi), g1, U);
        const bf16x8 u0 = cvt8(U, 0), u1 = cvt8(U, 1);
        Y = MFMA32(ldA_perm(ob + 12288, 64, r32, 0, hi), s00, Y);  Y = MFMA32(ldA_perm(ob + 12288, 64, r32, 16, hi), s01, Y);
        Y = MFMA32(ldA_perm(ob + 12288, 64, r32, 32, hi), s10, Y); Y = MFMA32(ldA_perm(ob + 12288, 64, r32, 48, hi), s11, Y);
        Y = MFMA32(ldA_perm(mx + 2048, 32, r32, 0, hi), u0, Y);    Y = MFMA32(ldA_perm(mx + 2048, 32, r32, 16, hi), u1, Y);
        Y = MFMA32(ldA_perm(mx + 4096, 32, r32, 0, hi), v0, Y);    Y = MFMA32(ldA_perm(mx + 4096, 32, r32, 16, hi), v1, Y);
        St0 = MFMA32(ldT_perm(ob + 4096, 64, 0, 0, lane), u0, St0);  St0 = MFMA32(ldT_perm(ob + 4096, 64, 16, 0, lane), u1, St0);
        St0 = MFMA32(ldT_perm(ob + 8192, 64, 0, 0, lane), v0, St0);  St0 = MFMA32(ldT_perm(ob + 8192, 64, 16, 0, lane), v1, St0);
        St1 = MFMA32(ldT_perm(ob + 4096, 64, 0, 32, lane), u0, St1); St1 = MFMA32(ldT_perm(ob + 4096, 64, 16, 32, lane), u1, St1);
        St1 = MFMA32(ldT_perm(ob + 8192, 64, 0, 32, lane), v0, St1); St1 = MFMA32(ldT_perm(ob + 8192, 64, 16, 32, lane), v1, St1);
        LAS const float* wt = (LAS const float*)(ob + 20480);
#pragma unroll
        for (int q = 0; q < 4; ++q) {
          const f32x4 w0 = *(LAS const f32x4*)(wt + 8 * q + 4 * hi), w1 = *(LAS const f32x4*)(wt + 32 + 8 * q + 4 * hi);
          St0[4 * q] *= w0.x; St0[4 * q + 1] *= w0.y; St0[4 * q + 2] *= w0.z; St0[4 * q + 3] *= w0.w;
          St1[4 * q] *= w1.x; St1[4 * q + 1] *= w1.y; St1[4 * q + 2] *= w1.z; St1[4 * q + 3] *= w1.w;
        }
        {
          const int tk0 = ctok(ch.m0, ch.L, ch.dir, 32 * kc); const int dstep = ch.dir ? -1 : 1;
          const unsigned cb = (unsigned)(ch.hd * 64 + 32 * ih + r32);
#pragma unroll
          for (int i = 0; i < 16; ++i) Yo[(unsigned)(tk0 + crow_(i, hi) * dstep) * (unsigned)D + cb] = Y[i];
        }
      }
      LDS_BARRIER();
    }
    if (ch.L == 256) {
    GASF* so = p.out + OUT_ST + ((((size_t)ch.seq) * 2 + ch.dir) * 16 + ch.hd) * 4096 + (size_t)(32 * wave + r32) * 64;
#pragma unroll
    for (int q = 0; q < 4; ++q) {
      *(GAS f32x4*)(so + 8 * q + 4 * hi) = (f32x4){St0[4 * q], St0[4 * q + 1], St0[4 * q + 2], St0[4 * q + 3]};
      *(GAS f32x4*)(so + 32 + 8 * q + 4 * hi) = (f32x4){St1[4 * q], St1[4 * q + 1], St1[4 * q + 2], St1[4 * q + 3]};
    }
  }
  }
}

__device__ __forceinline__ void phase_rw_scan_ck(const LAS PG& p, unsigned char* ws, LAS unsigned char* lds, int tid, int lane, int wave, int bid, int G) {
  int dfirst = bid * 8 + wave, dstride = G * 8;
  if (G >= 128) {
    if (bid < 64) { __syncthreads(); ck_run_chain(p, ws, lds, ck_chain(bid), lane, wave); dfirst = NTR_DEF; }
    else { const int nb = G - 64; for (int pc = bid - 64; pc < 512; pc += nb) { __syncthreads(); ck_run_chain(p, ws, lds, ck_chain(64 + pc), lane, wave); }
      dfirst = (bid - 64) * 8 + wave; dstride = nb * 8; }
  } else {
    for (int id = bid; id < 576; id += G) { __syncthreads(); ck_run_chain(p, ws, lds, ck_chain(id), lane, wave); }
  }
  __syncthreads();
  tr_run<true>(p, ws, (LAS float*)(lds + wave * 16384), lane, dfirst, dstride, NTR_DEF);
}
__device__ __forceinline__ int opq(int x) { asm volatile("" : "+v"(x)); return x; }
#ifndef RPT_MASK
#define RPT_MASK 0u
#endif
struct MArgs { P p; int ph_lo, ph_hi; };
__global__ void __launch_bounds__(512, 2) mega(MArgs a) {
  extern __shared__ __attribute__((aligned(16))) unsigned char lds_raw[];
  LAS unsigned char* lds = (LAS unsigned char*)lds_raw;
  const int tid = threadIdx.x, lane = tid & 63, wave = __builtin_amdgcn_readfirstlane(tid >> 6);
  const int G = gridDim.x, bid = blockIdx.x;
  unsigned char* ws = (unsigned char*)a.p.ws;
  if (tid == 0) {
    LAS PG* t = (LAS PG*)(lds + PTAB_OFF);
    t->x_prompt = (decltype(t->x_prompt))a.p.x_prompt;
    t->x_sample = (decltype(t->x_sample))a.p.x_sample;
    t->cache_ckv = (decltype(t->cache_ckv))a.p.cache_ckv;
    t->cache_kpe = (decltype(t->cache_kpe))a.p.cache_kpe;
    t->state_rwkv = (decltype(t->state_rwkv))a.p.state_rwkv;
    t->c = (decltype(t->c))a.p.c;
    t->c_ctx = (decltype(t->c_ctx))a.p.c_ctx;
    t->mod_w = (decltype(t->mod_w))a.p.mod_w;
    t->mod_b = (decltype(t->mod_b))a.p.mod_b;
    t->ln_g = (decltype(t->ln_g))a.p.ln_g;
    t->ln_b = (decltype(t->ln_b))a.p.ln_b;
    t->hy_w_in = (decltype(t->hy_w_in))a.p.hy_w_in;
    t->hy_conv_w = (decltype(t->hy_conv_w))a.p.hy_conv_w;
    t->hy_conv_b = (decltype(t->hy_conv_b))a.p.hy_conv_b;
    t->hy_w1 = (decltype(t->hy_w1))a.p.hy_w1;
    t->hy_b1 = (decltype(t->hy_b1))a.p.hy_b1;
    t->hy_w2 = (decltype(t->hy_w2))a.p.hy_w2;
    t->hy_b2 = (decltype(t->hy_b2))a.p.hy_b2;
    t->hy_w3 = (decltype(t->hy_w3))a.p.hy_w3;
    t->hy_b3 = (decltype(t->hy_b3))a.p.hy_b3;
    t->hy_freq = (decltype(t->hy_freq))a.p.hy_freq;
    t->hy_decay = (decltype(t->hy_decay))a.p.hy_decay;
    t->hy_skip = (decltype(t->hy_skip))a.p.hy_skip;
    t->hy_w_out = (decltype(t->hy_w_out))a.p.hy_w_out;
    t->mla_w_in = (decltype(t->mla_w_in))a.p.mla_w_in;
    t->mla_q_norm = (decltype(t->mla_q_norm))a.p.mla_q_norm;
    t->mla_kv_norm = (decltype(t->mla_kv_norm))a.p.mla_kv_norm;
    t->mla_w_q_up = (decltype(t->mla_w_q_up))a.p.mla_w_q_up;
    t->mla_w_kv_up = (decltype(t->mla_w_kv_up))a.p.mla_w_kv_up;
    t->mla_w_out = (decltype(t->mla_w_out))a.p.mla_w_out;
    t->rw_mu = (decltype(t->rw_mu))a.p.rw_mu;
    t->rw_w_in = (decltype(t->rw_w_in))a.p.rw_w_in;
    t->rw_w0 = (decltype(t->rw_w0))a.p.rw_w0;
    t->rw_w1 = (decltype(t->rw_w1))a.p.rw_w1;
    t->rw_w2 = (decltype(t->rw_w2))a.p.rw_w2;
    t->rw_a0 = (decltype(t->rw_a0))a.p.rw_a0;
    t->rw_a1 = (decltype(t->rw_a1))a.p.rw_a1;
    t->rw_a2 = (decltype(t->rw_a2))a.p.rw_a2;
    t->rw_k_k = (decltype(t->rw_k_k))a.p.rw_k_k;
    t->rw_k_a = (decltype(t->rw_k_a))a.p.rw_k_a;
    t->rw_r_k = (decltype(t->rw_r_k))a.p.rw_r_k;
    t->rw_gn_g = (decltype(t->rw_gn_g))a.p.rw_gn_g;
    t->rw_gn_b = (decltype(t->rw_gn_b))a.p.rw_gn_b;
    t->rw_w_out = (decltype(t->rw_w_out))a.p.rw_w_out;
    t->out = (decltype(t->out))a.p.out;
    t->ws = (decltype(t->ws))a.p.ws;
  }
  const LAS PG& p = *(const LAS PG*)(lds + PTAB_OFF);
  volatile LAS unsigned* MISC = (volatile LAS unsigned*)(lds + MISC_OFF);
  for (int u = tid; u < 128; u += 512) ((LAS unsigned*)(lds + MISC_OFF))[u] = 0u;
  __syncthreads();
  const int lo = a.ph_lo, hi = a.ph_hi;
  XcdBarrier bar; bar.bar = (unsigned*)(ws + M_CTL); bar.x = 0; bar.st = nullptr;
  if (hi - lo > 0 || RPT_MASK) bar = xcd_barrier_post((unsigned*)(ws + M_CTL), MISC + 8);
#ifndef PH_MASK
#define PH_MASK 0xffffffffu
#endif
#ifndef TP_PHASE
#define TP_PHASE -1
#endif
#ifndef TP_MULT
#define TP_MULT 4
#endif
  unsigned long long tp0 = 0ull, tp1 = 0ull;
#define IN(k) (((PH_MASK >> (k)) & 1u) && lo <= (k) && (k) < hi)
#define SEAM(k) do { if (IN(k) && IN((k) + 1)) xcd_barrier(bar); if ((k) + 1 == TP_PHASE) tp0 = __builtin_amdgcn_s_memrealtime(); if ((k) == TP_PHASE) tp1 = __builtin_amdgcn_s_memrealtime(); } while (0)
  if (IN(0)) { { phase_p0a(p, ws, lds, opq((int)threadIdx.x), (opq((int)threadIdx.x) & 63), wave, bid, G); } if ((RPT_MASK >> 0) & 1u) { xcd_barrier(bar); { phase_p0a(p, ws, lds, opq((int)threadIdx.x), (opq((int)threadIdx.x) & 63), wave, bid, G); } } } SEAM(0);
  if (IN(1)) { { phase_p0b(p, ws, lds, opq((int)threadIdx.x), (opq((int)threadIdx.x) & 63), wave, bid, G); } if ((RPT_MASK >> 1) & 1u) { xcd_barrier(bar); { phase_p0b(p, ws, lds, opq((int)threadIdx.x), (opq((int)threadIdx.x) & 63), wave, bid, G); } } } SEAM(1);
  if (IN(2)) { {
    pg8::Gemm g{(const pg8::bf16_t*)(ws + W_HYIN), (const pg8::bf16_t*)(ws + M_HB), 4096, 8192, 1024};
    pg8::StaticOrder S; S.init(4096, 8192, G, bid);
    pg8::EpiBf16<0> E{(pg8::bf16_t*)(ws + M_UT), 8192, nullptr, 0, 0, 1.f};
    pg8::gemm_phase<pg8::EpiBf16<0>, pg8::StaticOrder, true, true>(lds, g, S, E); } if ((RPT_MASK >> 2) & 1u) { xcd_barrier(bar); {
    pg8::Gemm g{(const pg8::bf16_t*)(ws + W_HYIN), (const pg8::bf16_t*)(ws + M_HB), 4096, 8192, 1024};
    pg8::StaticOrder S; S.init(4096, 8192, G, bid);
    pg8::EpiBf16<0> E{(pg8::bf16_t*)(ws + M_UT), 8192, nullptr, 0, 0, 1.f};
    pg8::gemm_phase<pg8::EpiBf16<0>, pg8::StaticOrder, true, true>(lds, g, S, E); } } } SEAM(2);
  if (IN(3)) { { phase_hy_conv(p, ws, lds, 0, opq((int)threadIdx.x), (opq((int)threadIdx.x) & 63), wave, bid, G); } if ((RPT_MASK >> 3) & 1u) { xcd_barrier(bar); { phase_hy_conv(p, ws, lds, 0, opq((int)threadIdx.x), (opq((int)threadIdx.x) & 63), wave, bid, G); } } } SEAM(3);
  if (IN(4)) { { phase_out_ln<1>(p, ws, lds, 0, (const bf16_t*)(ws + W_HYOUT), opq((int)threadIdx.x), (opq((int)threadIdx.x) & 63), wave, bid, G); } if ((RPT_MASK >> 4) & 1u) { xcd_barrier(bar); { phase_out_ln<1>(p, ws, lds, 0, (const bf16_t*)(ws + W_HYOUT), opq((int)threadIdx.x), (opq((int)threadIdx.x) & 63), wave, bid, G); } } } SEAM(4);
  if (IN(5)) { {
    pg8::Gemm g{(const pg8::bf16_t*)(ws + M_HB), (const pg8::bf16_t*)(ws + W_MLAIN + MiB), 8192, 1024, 1024};
    pg8::StaticOrder S; S.init(8192, 1024, G, bid);
    EpiSilu E{(bf16_t*)(ws + M_SZB), 1024};
    pg8::gemm_phase<EpiSilu, pg8::StaticOrder, true, true>(lds, g, S, E);
    { pg8::Gemm g2{(const pg8::bf16_t*)(ws + M_HB), (const pg8::bf16_t*)(ws + W_MLAIN), 8192, 512, 1024};
      pg8::StaticOrder S2; S2.init(8192, 512, G, (bid + G - 128 % G) % G);
      EpiF32 E2{(float*)(ws + M_U2S), 512};
      pg8::gemm_phase<EpiF32, pg8::StaticOrder, true, true>(lds, g2, S2, E2); } } if ((RPT_MASK >> 5) & 1u) { xcd_barrier(bar); {
    pg8::Gemm g{(const pg8::bf16_t*)(ws + M_HB), (const pg8::bf16_t*)(ws + W_MLAIN + MiB), 8192, 1024, 1024};
    pg8::StaticOrder S; S.init(8192, 1024, G, bid);
    EpiSilu E{(bf16_t*)(ws + M_SZB), 1024};
    pg8::gemm_phase<EpiSilu, pg8::StaticOrder, true, true>(lds, g, S, E);
    { pg8::Gemm g2{(const pg8::bf16_t*)(ws + M_HB), (const pg8::bf16_t*)(ws + W_MLAIN), 8192, 512, 1024};
      pg8::StaticOrder S2; S2.init(8192, 512, G, (bid + G - 128 % G) % G);
      EpiF32 E2{(float*)(ws + M_U2S), 512};
      pg8::gemm_phase<EpiF32, pg8::StaticOrder, true, true>(lds, g2, S2, E2); } } } } SEAM(5);
  if (IN(6)) { { phase_mla_rows(p, ws, (opq((int)threadIdx.x) & 63), wave, bid, G); xcd_barrier(bar); } {
    { pg8::Gemm g{(const pg8::bf16_t*)(ws + M_QN), (const pg8::bf16_t*)(ws + W_QUP), 8192, 1536, 256};
      pg8::StaticOrder S; S.init(8192, 1536, G, bid);
      pg8::EpiBf16<0> E{(pg8::bf16_t*)(ws + M_Q), 1536, nullptr, 0, 0, 1.f};
      pg8::gemm_phase<pg8::EpiBf16<0>, pg8::StaticOrder, true, true>(lds, g, S, E); }
    { pg8::Gemm g{(const pg8::bf16_t*)(ws + M_CKVALL), (const pg8::bf16_t*)(ws + W_KVUP), 9216, 2048, 128};
      pg8::StaticOrder S; S.init(9216, 2048, G, (bid + G - 192 % G) % G);
      EpiKV E{(bf16_t*)(ws + M_KN), (bf16_t*)(ws + M_V)};
      pg8::gemm_phase<EpiKV, pg8::StaticOrder, true, true>(lds, g, S, E); } } if ((RPT_MASK >> 6) & 1u) { xcd_barrier(bar); { phase_mla_rows(p, ws, (opq((int)threadIdx.x) & 63), wave, bid, G); xcd_barrier(bar); } {
    { pg8::Gemm g{(const pg8::bf16_t*)(ws + M_QN), (const pg8::bf16_t*)(ws + W_QUP), 8192, 1536, 256};
      pg8::StaticOrder S; S.init(8192, 1536, G, bid);
      pg8::EpiBf16<0> E{(pg8::bf16_t*)(ws + M_Q), 1536, nullptr, 0, 0, 1.f};
      pg8::gemm_phase<pg8::EpiBf16<0>, pg8::StaticOrder, true, true>(lds, g, S, E); }
    { pg8::Gemm g{(const pg8::bf16_t*)(ws + M_CKVALL), (const pg8::bf16_t*)(ws + W_KVUP), 9216, 2048, 128};
      pg8::StaticOrder S; S.init(9216, 2048, G, (bid + G - 192 % G) % G);
      EpiKV E{(bf16_t*)(ws + M_KN), (bf16_t*)(ws + M_V)};
      pg8::gemm_phase<EpiKV, pg8::StaticOrder, true, true>(lds, g, S, E); } } } } SEAM(6);
  if (IN(7)) { {
    for (int u = bid; u < 512; u += G) {
      int seq, hd, qb;
      if (u < 256) { seq = 16 + (u >> 7); hd = (u >> 3) & 15; qb = u & 7; } else { const int uu = u - 256; seq = uu >> 4; hd = uu & 15; qb = 0; }
      attn_unit(ws, lds, seq, hd, qb, (bf16_t*)(ws + M_GB), opq((int)threadIdx.x), (opq((int)threadIdx.x) & 63), wave);
    } } if ((RPT_MASK >> 7) & 1u) { xcd_barrier(bar); {
    for (int u = bid; u < 512; u += G) {
      int seq, hd, qb;
      if (u < 256) { seq = 16 + (u >> 7); hd = (u >> 3) & 15; qb = u & 7; } else { const int uu = u - 256; seq = uu >> 4; hd = uu & 15; qb = 0; }
      attn_unit(ws, lds, seq, hd, qb, (bf16_t*)(ws + M_GB), opq((int)threadIdx.x), (opq((int)threadIdx.x) & 63), wave);
    } } } } SEAM(7);
  if (IN(8)) { { phase_out_ln<0>(p, ws, lds, 1, (const bf16_t*)(ws + W_MLAOUT), opq((int)threadIdx.x), (opq((int)threadIdx.x) & 63), wave, bid, G); } if ((RPT_MASK >> 8) & 1u) { xcd_barrier(bar); { phase_out_ln<0>(p, ws, lds, 1, (const bf16_t*)(ws + W_MLAOUT), opq((int)threadIdx.x), (opq((int)threadIdx.x) & 63), wave, bid, G); } } } SEAM(8);
  if (IN(9)) { { phase_rw_mix(p, ws, opq((int)threadIdx.x), bid, G); } if ((RPT_MASK >> 9) & 1u) { xcd_barrier(bar); { phase_rw_mix(p, ws, opq((int)threadIdx.x), bid, G); } } } SEAM(9);
  if (IN(10)) { {
#pragma unroll 1
    for (int q = 0; q < 4; ++q) {
      pg8::Gemm g{(const pg8::bf16_t*)(ws + M_XMIX + (size_t)q * 16 * MiB), (const pg8::bf16_t*)(ws + W_RWIN + (size_t)q * 2 * MiB), 8192, 1024, 1024};
      pg8::StaticOrder S; S.init(8192, 1024, G, (bid + (q & 1) * (G / 2)) % G);
      if (q < 3) { pg8::EpiBf16<0> E{(pg8::bf16_t*)(ws + M_SCR2 + (size_t)q * 16 * MiB), 1024, nullptr, 0, 0, 1.f}; pg8::gemm_phase<pg8::EpiBf16<0>, pg8::StaticOrder, true, true>(lds, g, S, E); }
      else { EpiSilu E{(bf16_t*)(ws + M_SZR), 1024}; pg8::gemm_phase<EpiSilu, pg8::StaticOrder, true, true>(lds, g, S, E); }
    }
    for (int tile = bid; tile < 256; tile += G) rw_lora_tile(p, ws, lds, tile, opq((int)threadIdx.x), (opq((int)threadIdx.x) & 63), wave); } if ((RPT_MASK >> 10) & 1u) { xcd_barrier(bar); {
#pragma unroll 1
    for (int q = 0; q < 4; ++q) {
      pg8::Gemm g{(const pg8::bf16_t*)(ws + M_XMIX + (size_t)q * 16 * MiB), (const pg8::bf16_t*)(ws + W_RWIN + (size_t)q * 2 * MiB), 8192, 1024, 1024};
      pg8::StaticOrder S; S.init(8192, 1024, G, (bid + (q & 1) * (G / 2)) % G);
      if (q < 3) { pg8::EpiBf16<0> E{(pg8::bf16_t*)(ws + M_SCR2 + (size_t)q * 16 * MiB), 1024, nullptr, 0, 0, 1.f}; pg8::gemm_phase<pg8::EpiBf16<0>, pg8::StaticOrder, true, true>(lds, g, S, E); }
      else { EpiSilu E{(bf16_t*)(ws + M_SZR), 1024}; pg8::gemm_phase<EpiSilu, pg8::StaticOrder, true, true>(lds, g, S, E); }
    }
    for (int tile = bid; tile < 256; tile += G) rw_lora_tile(p, ws, lds, tile, opq((int)threadIdx.x), (opq((int)threadIdx.x) & 63), wave); } } } SEAM(10);
  if (IN(11)) { { phase_rw_scan_ck(p, ws, lds, opq((int)threadIdx.x), (opq((int)threadIdx.x) & 63), wave, bid, G); } if ((RPT_MASK >> 11) & 1u) { xcd_barrier(bar); { phase_rw_scan_ck(p, ws, lds, opq((int)threadIdx.x), (opq((int)threadIdx.x) & 63), wave, bid, G); } } } SEAM(11);
  if (IN(12)) { { phase_out_ln<2>(p, ws, lds, 2, (const bf16_t*)(ws + W_RWOUT), opq((int)threadIdx.x), (opq((int)threadIdx.x) & 63), wave, bid, G); } if ((RPT_MASK >> 12) & 1u) { xcd_barrier(bar); { phase_out_ln<2>(p, ws, lds, 2, (const bf16_t*)(ws + W_RWOUT), opq((int)threadIdx.x), (opq((int)threadIdx.x) & 63), wave, bid, G); } } } SEAM(12);
  if (IN(13)) { {
    pg8::Gemm g{(const pg8::bf16_t*)(ws + W_HYIN + 8 * MiB), (const pg8::bf16_t*)(ws + M_HB), 4096, 8192, 1024};
    pg8::StaticOrder S; S.init(4096, 8192, G, bid);
    pg8::EpiBf16<0> E{(pg8::bf16_t*)(ws + M_UT), 8192, nullptr, 0, 0, 1.f};
    pg8::gemm_phase<pg8::EpiBf16<0>, pg8::StaticOrder, true, true>(lds, g, S, E); } if ((RPT_MASK >> 13) & 1u) { xcd_barrier(bar); {
    pg8::Gemm g{(const pg8::bf16_t*)(ws + W_HYIN + 8 * MiB), (const pg8::bf16_t*)(ws + M_HB), 4096, 8192, 1024};
    pg8::StaticOrder S; S.init(4096, 8192, G, bid);
    pg8::EpiBf16<0> E{(pg8::bf16_t*)(ws + M_UT), 8192, nullptr, 0, 0, 1.f};
    pg8::gemm_phase<pg8::EpiBf16<0>, pg8::StaticOrder, true, true>(lds, g, S, E); } } } SEAM(13);
  if (IN(14)) { { phase_hy_conv(p, ws, lds, 1, opq((int)threadIdx.x), (opq((int)threadIdx.x) & 63), wave, bid, G); } if ((RPT_MASK >> 14) & 1u) { xcd_barrier(bar); { phase_hy_conv(p, ws, lds, 1, opq((int)threadIdx.x), (opq((int)threadIdx.x) & 63), wave, bid, G); } } } SEAM(14);
  if (IN(15)) { { phase_out_ln<1>(p, ws, lds, 3, (const bf16_t*)(ws + W_HYOUT + 2 * MiB), opq((int)threadIdx.x), (opq((int)threadIdx.x) & 63), wave, bid, G); } if ((RPT_MASK >> 15) & 1u) { xcd_barrier(bar); { phase_out_ln<1>(p, ws, lds, 3, (const bf16_t*)(ws + W_HYOUT + 2 * MiB), opq((int)threadIdx.x), (opq((int)threadIdx.x) & 63), wave, bid, G); } } }
  if (TP_PHASE >= 0 && bid == 0) { if (TP_PHASE == 15) tp1 = __builtin_amdgcn_s_memrealtime(); const unsigned long long dl = (tp1 - tp0) * TP_MULT; const unsigned long long ts = __builtin_amdgcn_s_memrealtime(); while (__builtin_amdgcn_s_memrealtime() - ts < dl) __builtin_amdgcn_s_sleep(8); }
#undef IN
#undef SEAM
}
}
}

extern "C" void kernel_launch(void* const* d_in, const int* in_sizes, int n_in, void* d_out, int out_size, void* d_ws, size_t ws_size, hipStream_t stream) {
  P p{};
  const float** pp = (const float**)&p;
  for (int i = 0; i < 44; ++i) pp[i] = (const float*)d_in[i];
  p.out = (float*)d_out; p.ws = (float*)d_ws;
  float* ws = p.ws;
  static int grid = 0;
  if (grid == 0) {
    int dev = 0, cus = 0;
    (void)hipGetDevice(&dev); (void)hipDeviceGetAttribute(&cus, hipDeviceAttributeMultiprocessorCount, dev);
    (void)hipFuncSetAttribute((const void*)mk::mega, hipFuncAttributeMaxDynamicSharedMemorySize, mk::LDS_BYTES);
    grid = cus > 0 ? cus : 256;
  }
  (void)hipMemsetAsync((char*)d_ws + mk::M_CTL, 0, 65536, stream);
  mk::MArgs a{}; a.p = p; a.ph_lo = 0; a.ph_hi = MEGA_PHASES;
  hipLaunchKernelGGL(mk::mega, dim3(grid), dim3(512), mk::LDS_BYTES, stream, a);

  float* X = ws + WS_X; float* S1 = ws + WS_S1; float* S4 = ws + WS_S4; float* S2 = ws + WS_S2;
  const int EB = (int)((SZ + 255) / 256);
  if (NAIVE_FROM < 4) hipLaunchKernelGGL(k_mods, dim3((4 * 3 * 3072 + 255) / 256), dim3(256), 0, stream, p);
  for (int layer = NAIVE_FROM; layer < 4; ++layer) {
    const int kind = layer % 3, j = layer / 3;
    const float* xa = (layer == 0) ? p.x_prompt : X;
    const float* xb = (layer == 0) ? p.x_sample : X + (size_t)NPT * D;
    float* Xn = (layer == 3) ? p.out + OUT_Y : X;
    hipLaunchKernelGGL(k_modulate, dim3(EB), dim3(256), 0, stream, p, xa, xb, S1, layer);
    if (kind == 0) {
      hipLaunchKernelGGL(k_hy_filter, dim3(2304), dim3(256), 0, stream, p, j);
      gemm(stream, ALPlain{S1, D}, p.hy_w_in + (size_t)j * D * 4096, 4096, NTOK, 4096, D, EPPlain{S2, 4096});
      hipLaunchKernelGGL(k_hy_vv, dim3(EB), dim3(256), 0, stream, p, S2, S1, j);
      hipLaunchKernelGGL(k_hy_long, dim3(EB), dim3(256), 0, stream, p, S2, S1, S4, j);
      gemm(stream, ALPlain{S4, D}, p.hy_w_out + (size_t)j * D * D, D, NTOK, D, D, EPPlain{S1, D});
    } else if (kind == 1) {
      float* U2 = S2; float* QN = S1; float* CKVALL = S1 + (size_t)NTOK * 256; float* KPEALL = CKVALL + (size_t)9216 * 128;
      float* Q = S2; float* KV = S2 + (size_t)NTOK * 1536;
      gemm(stream, ALPlain{S1, D}, p.mla_w_in, 1440, NTOK, 1440, D, EPPlain{U2, 1440});
      hipLaunchKernelGGL(k_mla_extract, dim3(NTOK), dim3(64), 0, stream, p, U2, QN, CKVALL, KPEALL, S4);
      hipLaunchKernelGGL(k_mla_cache, dim3((2 * PAST * 128 + 255) / 256), dim3(256), 0, stream, p, CKVALL, KPEALL);
      gemm(stream, ALPlain{QN, 256}, p.mla_w_q_up, 1536, NTOK, 1536, 256, EPPlain{Q, 1536});
      hipLaunchKernelGGL(k_rope_q, dim3((4096 * 16 + 255) / 256), dim3(256), 0, stream, Q);
      gemm(stream, ALPlain{CKVALL, 128}, p.mla_w_kv_up, 2048, 9216, 2048, 128, EPPlain{KV, 2048});
      hipLaunchKernelGGL(k_attn, dim3(32, 18 * 16), dim3(64), 0, stream, Q, KV, KPEALL, S4);
      gemm(stream, ALPlain{S4, D}, p.mla_w_out, D, NTOK, D, D, EPPlain{S1, D});
    } else {
      float* R = S2; float* K = S2 + SZ; float* V = S2 + 2 * SZ; float* Z = S2 + 3 * SZ;
      float* HW = ws + WS_MISC + MISC_END; float* HA = HW + (size_t)NTOK * 128;
      const float* mu = p.rw_mu; const float* win = p.rw_w_in;
      gemm(stream, ALMix{S1, mu + 0 * D}, win + 0 * (size_t)D * D, D, NTOK, D, D, EPPlain{R, D});
      gemm(stream, ALMix{S1, mu + 2 * D}, win + 1 * (size_t)D * D, D, NTOK, D, D, EPPlain{K, D});
      gemm(stream, ALMix{S1, mu + 3 * D}, win + 2 * (size_t)D * D, D, NTOK, D, D, EPPlain{V, D});
      gemm(stream, ALMix{S1, mu + 5 * D}, win + 3 * (size_t)D * D, D, NTOK, D, D, EPPlain{Z, D});
      for (int dir = 0; dir < 2; ++dir) {
        gemm(stream, ALMix{S1, mu + 1 * D}, p.rw_w1 + (size_t)dir * D * 64, 64, NTOK, 64, D, EPTanh{HW + dir * 64, 128});
        gemm(stream, ALMix{S1, mu + 4 * D}, p.rw_a1 + (size_t)dir * D * 64, 64, NTOK, 64, D, EPPlain{HA + dir * 64, 128});
      }
      (void)hipMemsetAsync(S4, 0, SZ * sizeof(float), stream);
      hipLaunchKernelGGL(k_rw_scan, dim3(18 * 32), dim3(64), 0, stream, p, R, K, V, HW, HA, S4);
      hipLaunchKernelGGL(k_rw_post, dim3(NTOK * 16), dim3(64), 0, stream, p, R, K, V, Z, HA, S4, S4);
      gemm(stream, ALPlain{S4, D}, p.rw_w_out, D, NTOK, D, D, EPPlain{S1, D});
    }
    hipLaunchKernelGGL(k_ln, dim3(NTOK / 4), dim3(256), 0, stream, p, xa, xb, S1, Xn, layer);
  }
}
```

```cpp
#define MEGA_PHASES 16
#define NAIVE_FROM 4
#define RPT_MASK 0x0u
#include <hip/hip_runtime.h>
#include <stdint.h>
#include <math.h>

namespace {

constexpr int D = 1024;
constexpr int NTOK = 8192;
constexpr int NPT = 4096;
constexpr int PAST = 512;
constexpr float ALPHA = 1.681792830507429f;
constexpr float LN_EPS = 1e-5f, RMS_EPS = 1e-6f, GN_EPS = 64e-5f;

struct P {
  const float *x_prompt, *x_sample, *cache_ckv, *cache_kpe, *state_rwkv, *c, *c_ctx;
  const float *mod_w, *mod_b, *ln_g, *ln_b;
  const float *hy_w_in, *hy_conv_w, *hy_conv_b, *hy_w1, *hy_b1, *hy_w2, *hy_b2, *hy_w3, *hy_b3, *hy_freq, *hy_decay, *hy_skip, *hy_w_out;
  const float *mla_w_in, *mla_q_norm, *mla_kv_norm, *mla_w_q_up, *mla_w_kv_up, *mla_w_out;
  const float *rw_mu, *rw_w_in, *rw_w0, *rw_w1, *rw_w2, *rw_a0, *rw_a1, *rw_a2, *rw_k_k, *rw_k_a, *rw_r_k, *rw_gn_g, *rw_gn_b, *rw_w_out;
  float* out;
  float* ws;
};

constexpr size_t OUT_Y = 0, OUT_CKV = 8388608, OUT_KPE = 8912896, OUT_ST = 9043968;

constexpr size_t SZ = (size_t)NTOK * D;
constexpr size_t WS_X = 0;
constexpr size_t WS_S1 = WS_X + SZ;
constexpr size_t WS_S4 = WS_S1 + SZ;
constexpr size_t WS_S2 = WS_S4 + SZ;
constexpr size_t WS_MISC = WS_S2 + 4 * SZ;
constexpr size_t MISC_MODS = 0;
constexpr size_t MISC_FILT = 65536;
constexpr size_t MISC_END = MISC_FILT + (size_t)2304 * 2048;

__device__ __forceinline__ float silu(float x) { return x / (1.f + expf(-x)); }
__device__ __forceinline__ float sigmoidf(float x) { return 1.f / (1.f + expf(-x)); }

__device__ __forceinline__ void tokinfo(int m, int& l, int& L, int& cond, int& m0) {
  if (m < NPT) { l = m & 255; L = 256; cond = 0; m0 = m & ~255; }
  else { int mm = m - NPT; l = mm & 2047; L = 2048; cond = 1 + (mm >> 11); m0 = NPT + (mm & ~2047); }
}

__global__ void k_mods(P p) {
  int idx = blockIdx.x * blockDim.x + threadIdx.x;
  if (idx >= 4 * 3 * 3072) return;
  int n = idx % 3072, g = (idx / 3072) % 3, i = idx / (3 * 3072);
  const float* cond = (g == 0) ? p.c_ctx : p.c + (size_t)(g - 1) * D;
  const float* w = p.mod_w + (size_t)i * D * 3072;
  float acc = 0.f;
  for (int k = 0; k < D; ++k) acc += silu(cond[k]) * w[(size_t)k * 3072 + n];
  p.ws[WS_MISC + MISC_MODS + idx] = acc + p.mod_b[i * 3072 + n];
}

__global__ void k_modulate(P p, const float* xa, const float* xb, float* H, int layer) {
  size_t idx = (size_t)blockIdx.x * blockDim.x + threadIdx.x;
  if (idx >= SZ) return;
  int m = (int)(idx >> 10), k = (int)(idx & 1023);
  int l, L, cond, m0; tokinfo(m, l, L, cond, m0);
  const float* md = p.ws + WS_MISC + MISC_MODS + (size_t)(layer * 3 + cond) * 3072;
  float x = (m < NPT) ? xa[idx] : xb[idx - (size_t)NPT * D];
  H[idx] = x * (1.f + md[1024 + k]) + md[k];
}

template <class AL, class EP>
__global__ void __launch_bounds__(256) k_gemm(AL al, const float* __restrict__ W, int ldw, int M, int N, int K, EP ep) {
  __shared__ float As[16][68];
  __shared__ float Bs[16][68];
  const int tx = threadIdx.x & 15, ty = threadIdx.x >> 4;
  const int m0 = blockIdx.y * 64, n0 = blockIdx.x * 64;
  float acc[4][4];
#pragma unroll
  for (int i = 0; i < 4; ++i)
#pragma unroll
    for (int j = 0; j < 4; ++j) acc[i][j] = 0.f;
  for (int k0 = 0; k0 < K; k0 += 16) {
#pragma unroll
    for (int i = 0; i < 4; ++i) {
      int e = threadIdx.x + i * 256; int mm = e >> 4, kk = e & 15;
      As[kk][mm] = (m0 + mm < M) ? al(m0 + mm, k0 + kk) : 0.f;
    }
#pragma unroll
    for (int i = 0; i < 4; ++i) {
      int e = threadIdx.x + i * 256; int kk = e >> 6, nn = e & 63;
      Bs[kk][nn] = (n0 + nn < N) ? W[(size_t)(k0 + kk) * ldw + n0 + nn] : 0.f;
    }
    __syncthreads();
#pragma unroll
    for (int kk = 0; kk < 16; ++kk) {
      float a[4], b[4];
#pragma unroll
      for (int i = 0; i < 4; ++i) { a[i] = As[kk][ty * 4 + i]; b[i] = Bs[kk][tx * 4 + i]; }
#pragma unroll
      for (int i = 0; i < 4; ++i)
#pragma unroll
        for (int j = 0; j < 4; ++j) acc[i][j] += a[i] * b[j];
    }
    __syncthreads();
  }
#pragma unroll
  for (int i = 0; i < 4; ++i)
#pragma unroll
    for (int j = 0; j < 4; ++j) {
      int m = m0 + ty * 4 + i, n = n0 + tx * 4 + j;
      if (m < M && n < N) ep(m, n, acc[i][j]);
    }
}

struct ALPlain { const float* A; long lda; __device__ float operator()(int m, int k) const { return A[(size_t)m * lda + k]; } };
struct EPPlain { float* C; long ldc; __device__ void operator()(int m, int n, float v) const { C[(size_t)m * ldc + n] = v; } };
struct EPTanh { float* C; long ldc; __device__ void operator()(int m, int n, float v) const { C[(size_t)m * ldc + n] = tanhf(v); } };
struct ALMix {
  const float* H; const float* mu;
  __device__ float operator()(int m, int k) const {
    int l, L, cond, m0; tokinfo(m, l, L, cond, m0);
    float h = H[(size_t)m * D + k];
    float pv = (l > 0) ? H[(size_t)(m - 1) * D + k] : 0.f;
    float nx = (l < L - 1) ? H[(size_t)(m + 1) * D + k] : 0.f;
    return h + (0.5f * (pv + nx) - h) * mu[k];
  }
};

template <class AL, class EP>
void gemm(hipStream_t s, AL al, const float* W, int ldw, int M, int N, int K, EP ep) {
  dim3 g((N + 63) / 64, (M + 63) / 64);
  hipLaunchKernelGGL((k_gemm<AL, EP>), g, dim3(256), 0, s, al, W, ldw, M, N, K, ep);
}

__global__ void __launch_bounds__(256) k_ln(P p, const float* xa, const float* xb, const float* O, float* Xn, int layer) {
  int m = blockIdx.x * 4 + (threadIdx.x >> 6), lane = threadIdx.x & 63;
  int l, L, cond, m0; tokinfo(m, l, L, cond, m0);
  const float* gate = p.ws + WS_MISC + MISC_MODS + (size_t)(layer * 3 + cond) * 3072 + 2048;
  const float* xr = (m < NPT) ? xa + (size_t)m * D : xb + (size_t)(m - NPT) * D;
  float v[16]; float s = 0.f;
#pragma unroll
  for (int i = 0; i < 16; ++i) { int k = lane + 64 * i; v[i] = ALPHA * xr[k] + gate[k] * O[(size_t)m * D + k]; s += v[i]; }
#pragma unroll
  for (int o = 1; o < 64; o <<= 1) s += __shfl_xor(s, o);
  float mu = s * (1.f / D), q = 0.f;
#pragma unroll
  for (int i = 0; i < 16; ++i) { v[i] -= mu; q += v[i] * v[i]; }
#pragma unroll
  for (int o = 1; o < 64; o <<= 1) q += __shfl_xor(q, o);
  float rs = rsqrtf(q * (1.f / D) + LN_EPS);
#pragma unroll
  for (int i = 0; i < 16; ++i) { int k = lane + 64 * i; Xn[(size_t)m * D + k] = v[i] * rs * p.ln_g[layer * D + k] + p.ln_b[layer * D + k]; }
}

__global__ void __launch_bounds__(256) k_hy_filter(P p, int j) {
  __shared__ float feat[33], h1[64], h2[64];
  int row = blockIdx.x; int L = row < 256 ? 256 : 2048; int l = row < 256 ? row : row - 256;
  int tid = threadIdx.x;
  float t = (float)l / (float)(L - 1);
  if (tid < 33) {
    float f;
    if (tid == 0) f = t;
    else {
      int b = (tid - 1) & 15;
      float band = 1e-4f + (float)b * ((15.f - 1e-4f) / 15.f);
      float ang = (6.283185307179586f / (float)L) * (float)l * band;
      f = (tid <= 16) ? cosf(ang) : -sinf(ang);
    }
    feat[tid] = f;
  }
  __syncthreads();
  if (tid < 64) {
    float a = p.hy_b1[j * 64 + tid];
    for (int f = 0; f < 33; ++f) a += feat[f] * p.hy_w1[((size_t)j * 33 + f) * 64 + tid];
    h1[tid] = sinf(p.hy_freq[(j * 2 + 0) * 64 + tid] * a);
  }
  __syncthreads();
  if (tid < 64) {
    float a = p.hy_b2[j * 64 + tid];
    for (int f = 0; f < 64; ++f) a += h1[f] * p.hy_w2[((size_t)j * 64 + f) * 64 + tid];
    h2[tid] = sinf(p.hy_freq[(j * 2 + 1) * 64 + tid] * a);
  }
  __syncthreads();
  for (int o = tid; o < 2048; o += 256) {
    float a = p.hy_b3[j * 2048 + o];
    for (int f = 0; f < 64; ++f) a += h2[f] * p.hy_w3[((size_t)j * 64 + f) * 2048 + o];
    float w = expf(-t * fabsf(p.hy_decay[(size_t)j * 2048 + o]));
    p.ws[WS_MISC + MISC_FILT + (size_t)row * 2048 + o] = a * w;
  }
}

__device__ __forceinline__ float conv3(const float* U, int m, int l, int L, int ch, const float* cw, const float* cb) {
  float cur = U[(size_t)m * 4096 + ch];
  float pv = (l > 0) ? U[(size_t)(m - 1) * 4096 + ch] : 0.f;
  float nx = (l < L - 1) ? U[(size_t)(m + 1) * 4096 + ch] : 0.f;
  return pv * cw[ch] + cur * cw[3072 + ch] + nx * cw[6144 + ch] + cb[ch];
}
__global__ void k_hy_vv(P p, const float* U, float* VV, int j) {
  size_t idx = (size_t)blockIdx.x * blockDim.x + threadIdx.x;
  if (idx >= SZ) return;
  int m = (int)(idx >> 10), c = (int)(idx & 1023);
  int l, L, cond, m0; tokinfo(m, l, L, cond, m0);
  const float* cw = p.hy_conv_w + (size_t)j * 3 * 3072; const float* cb = p.hy_conv_b + (size_t)j * 3072;
  float x1 = conv3(U, m, l, L, 1024 + c, cw, cb);
  float v = conv3(U, m, l, L, 2048 + c, cw, cb);
  VV[idx] = v * x1;
}
__global__ void k_hy_long(P p, const float* U, const float* VV, float* G, int j) {
  size_t idx = (size_t)blockIdx.x * blockDim.x + threadIdx.x;
  if (idx >= SZ) return;
  int m = (int)(idx >> 10), c = (int)(idx & 1023);
  int l, L, cond, m0; tokinfo(m, l, L, cond, m0);
  const float* F = p.ws + WS_MISC + MISC_FILT + (size_t)(L == 256 ? 0 : 256) * 2048;
  float acc = 0.f;
  for (int s = 0; s <= l; ++s) acc += VV[(size_t)(m0 + s) * D + c] * F[(size_t)(l - s) * 2048 + c];
  for (int s = l + 1; s < L; ++s) acc += VV[(size_t)(m0 + s) * D + c] * F[(size_t)(s - l) * 2048 + 1024 + c];
  const float* cw = p.hy_conv_w + (size_t)j * 3 * 3072; const float* cb = p.hy_conv_b + (size_t)j * 3072;
  float x0 = conv3(U, m, l, L, c, cw, cb);
  float z = U[(size_t)m * 4096 + 3072 + c];
  float y = (acc + VV[idx] * p.hy_skip[j * D + c]) * x0;
  G[idx] = y * silu(z);
}

__device__ __forceinline__ int kvrow(int m) { if (m < NPT) return m; int mm = m - NPT; return NPT + (mm >> 11) * 2560 + PAST + (mm & 2047); }
__device__ __forceinline__ void rope32(const float* x, float* o, int l) {
  int r = l >> 6, col = l & 63;
#pragma unroll
  for (int i = 0; i < 8; ++i) {
    float inv = powf(10000.f, -(float)(2 * i) / 16.f);
    float ar = (float)r * inv, ac = (float)col * inv;
    float cr = cosf(ar), sr = sinf(ar), cc = cosf(ac), sc = sinf(ac);
    o[i] = x[i] * cr - x[i + 8] * sr;
    o[i + 8] = x[i + 8] * cr + x[i] * sr;
    o[16 + i] = x[16 + i] * cc - x[24 + i] * sc;
    o[24 + i] = x[24 + i] * cc + x[16 + i] * sc;
  }
}
__global__ void __launch_bounds__(64) k_mla_extract(P p, const float* U2, float* QN, float* CKVALL, float* KPEALL, float* Z) {
  int m = blockIdx.x, lane = threadIdx.x;
  int l, L, cond, m0; tokinfo(m, l, L, cond, m0);
  const float* u = U2 + (size_t)m * 1440;
  float q[4], s = 0.f;
#pragma unroll
  for (int i = 0; i < 4; ++i) { q[i] = u[lane + 64 * i]; s += q[i] * q[i]; }
#pragma unroll
  for (int o = 1; o < 64; o <<= 1) s += __shfl_xor(s, o);
  float rs = rsqrtf(s * (1.f / 256.f) + RMS_EPS);
#pragma unroll
  for (int i = 0; i < 4; ++i) QN[(size_t)m * 256 + lane + 64 * i] = q[i] * rs * p.mla_q_norm[lane + 64 * i];
  float k0 = u[256 + lane], k1 = u[256 + 64 + lane];
  float s2 = k0 * k0 + k1 * k1;
#pragma unroll
  for (int o = 1; o < 64; o <<= 1) s2 += __shfl_xor(s2, o);
  float rs2 = rsqrtf(s2 * (1.f / 128.f) + RMS_EPS);
  float c0 = k0 * rs2 * p.mla_kv_norm[lane], c1 = k1 * rs2 * p.mla_kv_norm[64 + lane];
  int kr = kvrow(m);
  CKVALL[(size_t)kr * 128 + lane] = c0; CKVALL[(size_t)kr * 128 + 64 + lane] = c1;
  if (m < NPT) { p.out[OUT_CKV + (size_t)m * 128 + lane] = c0; p.out[OUT_CKV + (size_t)m * 128 + 64 + lane] = c1; }
  if (lane == 0) {
    float x[32], o[32];
#pragma unroll
    for (int i = 0; i < 32; ++i) x[i] = u[384 + i];
    if (m < NPT) {
#pragma unroll
      for (int i = 0; i < 32; ++i) { KPEALL[(size_t)kr * 32 + i] = x[i]; p.out[OUT_KPE + (size_t)m * 32 + i] = x[i]; }
    } else {
      rope32(x, o, l);
#pragma unroll
      for (int i = 0; i < 32; ++i) KPEALL[(size_t)kr * 32 + i] = o[i];
    }
  }
  for (int i = lane; i < 1024; i += 64) Z[(size_t)m * D + i] = u[416 + i];
}
__global__ void k_mla_cache(P p, float* CKVALL, float* KPEALL) {
  int idx = blockIdx.x * blockDim.x + threadIdx.x;
  if (idx >= 2 * PAST * 128) return;
  int d = idx & 127, pl = (idx >> 7) & 511, b = idx >> 16;
  int row = NPT + b * 2560 + pl;
  CKVALL[(size_t)row * 128 + d] = p.cache_ckv[idx];
  if (d < 32) KPEALL[(size_t)row * 32 + d] = p.cache_kpe[((size_t)b * PAST + pl) * 32 + d];
}
__global__ void k_rope_q(float* Q) {
  int idx = blockIdx.x * blockDim.x + threadIdx.x;
  if (idx >= 4096 * 16) return;
  int h = idx & 15, mm = idx >> 4; int m = NPT + mm; int l = mm & 2047;
  float* q = Q + (size_t)m * 1536 + h * 96 + 64;
  float x[32], o[32];
#pragma unroll
  for (int i = 0; i < 32; ++i) x[i] = q[i];
  rope32(x, o, l);
#pragma unroll
  for (int i = 0; i < 32; ++i) q[i] = o[i];
}
__global__ void __launch_bounds__(64) k_attn(const float* Q, const float* KV, const float* KPEALL, float* G) {
  int qi = blockIdx.x * 64 + threadIdx.x;
  int sh = blockIdx.y; int h = sh & 15, seq = sh >> 4;
  int L = seq < 16 ? 256 : 2048;
  if (qi >= L) return;
  int m = seq < 16 ? seq * 256 + qi : NPT + (seq - 16) * 2048 + qi;
  int kbase = seq < 16 ? seq * 256 : NPT + (seq - 16) * 2560;
  int nk = seq < 16 ? 256 : 2560;
  float q[96];
#pragma unroll
  for (int i = 0; i < 96; ++i) q[i] = Q[(size_t)m * 1536 + h * 96 + i];
  float acc[64];
#pragma unroll
  for (int i = 0; i < 64; ++i) acc[i] = 0.f;
  float mx = -1e30f, lsum = 0.f;
  const float scale = 0.10206207261596575f;
  for (int k = 0; k < nk; ++k) {
    const float* kv = KV + (size_t)(kbase + k) * 2048 + h * 128;
    const float* kp = KPEALL + (size_t)(kbase + k) * 32;
    float s = 0.f;
#pragma unroll
    for (int i = 0; i < 64; ++i) s += q[i] * kv[i];
#pragma unroll
    for (int i = 0; i < 32; ++i) s += q[64 + i] * kp[i];
    s *= scale;
    float mn = fmaxf(mx, s);
    float corr = expf(mx - mn), pe = expf(s - mn);
    lsum = lsum * corr + pe;
#pragma unroll
    for (int i = 0; i < 64; ++i) acc[i] = acc[i] * corr + pe * kv[64 + i];
    mx = mn;
  }
  float inv = 1.f / lsum;
#pragma unroll
  for (int i = 0; i < 64; ++i) { size_t o = (size_t)m * D + h * 64 + i; G[o] = acc[i] * inv * silu(G[o]); }
}

__global__ void __launch_bounds__(64) k_rw_scan(P p, const float* R, const float* K, const float* V, const float* HW, const float* HA, float* Y) {
  int id = blockIdx.x;
  int h = id & 15, dir = (id >> 4) & 1, seq = id >> 5;
  int lane = threadIdx.x;
  int L = seq < 16 ? 256 : 2048;
  int m0 = seq < 16 ? seq * 256 : NPT + (seq - 16) * 2048;
  int ch = h * 64 + lane;
  float S[64];
  if (seq < 16) {
#pragma unroll
    for (int j = 0; j < 64; ++j) S[j] = 0.f;
  } else {
    const float* s0 = p.state_rwkv + ((((size_t)(seq - 16) * 1 + 0) * 2 + dir) * 16 + h) * 4096 + (size_t)lane * 64;
#pragma unroll
    for (int j = 0; j < 64; ++j) S[j] = s0[j];
  }
  const float w0 = p.rw_w0[dir * D + ch], a0 = p.rw_a0[dir * D + ch];
  const float kkw = p.rw_k_k[ch], kaw = p.rw_k_a[ch];
  const float* w2 = p.rw_w2 + (size_t)dir * 64 * D + ch;
  const float* a2 = p.rw_a2 + (size_t)dir * 64 * D + ch;
  for (int st = 0; st < L; ++st) {
    int t = dir ? (L - 1 - st) : st;
    int m = m0 + t;
    float wl = w0, al = a0;
    const float* hw = HW + (size_t)m * 128 + dir * 64;
    const float* ha = HA + (size_t)m * 128 + dir * 64;
    for (int r = 0; r < 64; ++r) { wl += hw[r] * w2[(size_t)r * D]; al += ha[r] * a2[(size_t)r * D]; }
    float sp = (-wl > 20.f) ? -wl : log1pf(expf(-wl));
    float dec = expf(-expf(-sp - 0.5f));
    float a = sigmoidf(al);
    float k = K[(size_t)m * D + ch], r_ = R[(size_t)m * D + ch], v = V[(size_t)m * D + ch];
    float kk = k * kkw; float ss = kk * kk;
#pragma unroll
    for (int o = 1; o < 64; o <<= 1) ss += __shfl_xor(ss, o);
    kk *= rsqrtf(ss + 1e-12f);
    float kd = k * (1.f + (a - 1.f) * kaw);
    float bd = kk * a;
    float at = -kk;
    float sa = 0.f;
#pragma unroll
    for (int j = 0; j < 64; ++j) sa += S[j] * __shfl(at, j);
    float y = 0.f;
#pragma unroll
    for (int j = 0; j < 64; ++j) {
      float wj = __shfl(dec, j), bj = __shfl(bd, j), kj = __shfl(kd, j), rj = __shfl(r_, j);
      S[j] = S[j] * wj + sa * bj + v * kj;
      y += S[j] * rj;
    }
    atomicAdd(&Y[(size_t)m * D + ch], y);
  }
  if (seq < 16) {
    float* so = p.out + OUT_ST + ((((size_t)seq * 1 + 0) * 2 + dir) * 16 + h) * 4096 + (size_t)lane * 64;
#pragma unroll
    for (int j = 0; j < 64; ++j) so[j] = S[j];
  }
}
__global__ void __launch_bounds__(64) k_rw_post(P p, const float* R, const float* K, const float* V, const float* Z, const float* HA, const float* Y, float* G) {
  int m = blockIdx.x >> 4, h = blockIdx.x & 15, lane = threadIdx.x; int ch = h * 64 + lane;
  float y = Y[(size_t)m * D + ch];
  float s = y;
#pragma unroll
  for (int o = 1; o < 64; o <<= 1) s += __shfl_xor(s, o);
  float mu = s * (1.f / 64.f); float d = y - mu; float q = d * d;
#pragma unroll
  for (int o = 1; o < 64; o <<= 1) q += __shfl_xor(q, o);
  float yn = d * rsqrtf(q * (1.f / 64.f) + GN_EPS) * p.rw_gn_g[ch] + p.rw_gn_b[ch];
  float k = K[(size_t)m * D + ch], r_ = R[(size_t)m * D + ch], v = V[(size_t)m * D + ch];
  float bsum = 0.f;
  for (int dir = 0; dir < 2; ++dir) {
    float al = p.rw_a0[dir * D + ch];
    const float* ha = HA + (size_t)m * 128 + dir * 64;
    const float* a2 = p.rw_a2 + (size_t)dir * 64 * D + ch;
    for (int r = 0; r < 64; ++r) al += ha[r] * a2[(size_t)r * D];
    float a = sigmoidf(al);
    float kd = k * (1.f + (a - 1.f) * p.rw_k_a[ch]);
    bsum += r_ * kd * p.rw_r_k[ch];
  }
#pragma unroll
  for (int o = 1; o < 64; o <<= 1) bsum += __shfl_xor(bsum, o);
  float o_ = yn + bsum * v;
  G[(size_t)m * D + ch] = o_ * silu(Z[(size_t)m * D + ch]);
}

typedef unsigned short bf16_t;
namespace pg8 {
#define PG8_LAS __attribute__((address_space(3)))
typedef unsigned short bf16_t;
typedef short bf16x8 __attribute__((ext_vector_type(8)));
typedef float f32x4 __attribute__((ext_vector_type(4)));
typedef unsigned u32x4 __attribute__((ext_vector_type(4)));
constexpr int BM = 256, BK = 64, HALF = 128, HTB = HALF * BK * 2  , STAGE_BYTES = 8 * HTB, NXCD = 8, WGM = 8;

__host__ __device__ __forceinline__ int lds_byte(int r, int c) { const int st = (r >> 4) * 2 + (c >> 5), rr = r & 15, cc = c & 31, ob = rr * 64 + cc * 2; return st * 1024 + (ob ^ (((ob >> 9) & 1) << 5)); }
__host__ __device__ __forceinline__ void stage_rc(int b, int& R, int& C) { const int st = b / 1024, sb = b % 1024, swz = sb ^ (((sb >> 9) & 1) << 5); R = (st >> 1) * 16 + swz / 64; C = (st & 1) * 32 + (swz % 64) / 2; }
__host__ __device__ __forceinline__ int perm32(int rho) { const int n = rho >> 4, i = rho & 15; return 8 * (i >> 2) + 4 * n + (i & 3); }

struct Unit { int pm, pn; };
struct Gemm { const bf16_t* A; const bf16_t* Bt; int M, N, K; };

struct StaticOrder {
    int nM, nN, nwg, G, c;
    __host__ __device__ void init(int M, int N, int G_, int c_) { nM = M / BM; nN = N / BM; nwg = nM * nN; G = G_; c = c_; }
    __host__ __device__ bool next(int i, Unit& u) const {
        const long L = (long)i * G + c; if (L >= nwg) return false;
        int wgid = (int)L; { const int q = nwg / NXCD, r = nwg % NXCD, xcd = wgid % NXCD, off = wgid / NXCD; wgid = (xcd < r ? xcd * (q + 1) : r * (q + 1) + (xcd - r) * q) + off; }
        const int nig = WGM * nN, gid = wgid / nig, fm = gid * WGM, gsz = (nM - fm) < WGM ? (nM - fm) : WGM;
        u.pm = fm + ((wgid % nig) % gsz); u.pn = (wgid % nig) / gsz; return true;
    }
    __device__ __forceinline__ void a_ready(const Unit&) const {}
    __device__ __forceinline__ void done(const Unit&) const {}
};
__device__ __forceinline__ unsigned cvt_pk_bf16(float lo, float hi) { unsigned r; asm volatile("v_cvt_pk_bf16_f32 %0, %1, %2" : "=v"(r) : "v"(lo), "v"(hi)); return r; }
typedef float f32x2 __attribute__((ext_vector_type(2)));
template <int ACT  > struct EpiBf16 {
    static constexpr bool PERM = true, AFTER_DRAIN = false; static_assert(ACT == 0 || ACT == 1, "EpiBf16: ACT is 0 (none) or 1 (gelu_pk)");
    bf16_t* O; int ldc; const float* bias; int split_cols; size_t split_stride; float scale0;
    __device__ __forceinline__ void operator()(const f32x4 (&acc)[2][2][4][2], const Unit& u, int wr, int wc, int fr, int fq) const {
        const int row0 = u.pm * BM + wr * 64 + fr; int colt = u.pn * BM; bf16_t* base = O;
        float sc = 1.f; if (split_cols) { const int t = colt / split_cols; base += (size_t)t * split_stride; colt -= t * split_cols; if (t == 0) sc = scale0; }
        const int col0 = colt + wc * 32 + 8 * fq, bcol0 = u.pn * BM + wc * 32 + 8 * fq;
        f32x4 bv[2][2];
#pragma unroll
        for (int bj = 0; bj < 2; ++bj)
#pragma unroll
            for (int n = 0; n < 2; ++n) bv[bj][n] = bias ? *(const f32x4*)(bias + bcol0 + bj * HALF + 4 * n) : (f32x4){0.f, 0.f, 0.f, 0.f};
#pragma unroll
        for (int ai = 0; ai < 2; ++ai)
#pragma unroll
            for (int m = 0; m < 4; ++m) { bf16_t* rowp = base + (size_t)(row0 + ai * HALF + m * 16) * ldc + col0;
#pragma unroll
                for (int bj = 0; bj < 2; ++bj) { f32x4 v0 = acc[ai][bj][m][0] + bv[bj][0], v1 = acc[ai][bj][m][1] + bv[bj][1];
                    v0 = v0 * sc; v1 = v1 * sc; u32x4 w; w.x = cvt_pk_bf16(v0[0], v0[1]); w.y = cvt_pk_bf16(v0[2], v0[3]); w.z = cvt_pk_bf16(v1[0], v1[1]); w.w = cvt_pk_bf16(v1[2], v1[3]);
                    *(u32x4*)(rowp + bj * HALF) = w; } }
    }
};
template <class Epi, class Sched, bool ALIGN_EPI = false, bool SP2 = false>
__device__ __forceinline__ void gemm_phase(PG8_LAS unsigned char* lds, const Gemm g, const Sched& S, const Epi& E) {
    const int tid = threadIdx.x, wid = __builtin_amdgcn_readfirstlane(tid >> 6), lane = tid & 63, wr = wid >> 2, wc = wid & 3, fr = lane & 15, fq = lane >> 4;
    const int K = g.K, nt = K / BK;
    unsigned voffA[2], voffB[2];
#pragma unroll
    for (int i = 0; i < 2; ++i) { int R, C; stage_rc(tid * 16 + i * 8192, R, C); const int Rb = Epi::PERM ? ((R & ~31) + perm32(R & 31)) : R;
        voffA[i] = (unsigned)(R * K + C) * 2u; voffB[i] = (unsigned)(Rb * K + C) * 2u; }
    const size_t kstep = (size_t)(BK * 2);
    const size_t hstep = (size_t)HALF * K * 2;
    const size_t tstep = 2 * hstep;
    const unsigned ldsw = (unsigned)wid * 1024u;
    const int aoff = lds_byte(wr * 64 + fr, fq * 8), boff = lds_byte(wc * 32 + fr, fq * 8);
#define PG8_SA(b, h) (((b) * 2 + (h)) * HTB)
#define PG8_SB(b, h) ((4 + (b) * 2 + (h)) * HTB)
#define PG8_STAGE(bufoff, gbase, voff) do { _Pragma("unroll") for (int _i = 0; _i < 2; ++_i) \
        __builtin_amdgcn_global_load_lds((const unsigned*)((const char*)(gbase) + (voff)[_i]), (PG8_LAS unsigned*)(lds + (bufoff) + ldsw + _i * 8192), 16, 0, 0); } while (0)
#define PG8_LDA(dst, b, h) do { _Pragma("unroll") for (int m = 0; m < 4; ++m) _Pragma("unroll") for (int k = 0; k < 2; ++k) dst[m][k] = *(const PG8_LAS bf16x8*)(lds + PG8_SA(b, h) + aoff + m * 2048 + k * 1024); } while (0)
#define PG8_LDB(dst, b, h) do { _Pragma("unroll") for (int n = 0; n < 2; ++n) _Pragma("unroll") for (int k = 0; k < 2; ++k) dst[n][k] = *(const PG8_LAS bf16x8*)(lds + PG8_SB(b, h) + boff + n * 2048 + k * 1024); } while (0)
#define PG8_MMA(ai, bj, At, Bt) do { __builtin_amdgcn_s_setprio(1); _Pragma("unroll") for (int m = 0; m < 4; ++m) _Pragma("unroll") for (int n = 0; n < 2; ++n) _Pragma("unroll") for (int k = 0; k < 2; ++k) \
        acc[ai][bj][m][n] = __builtin_amdgcn_mfma_f32_16x16x32_bf16(Bt[n][k], At[m][k], acc[ai][bj][m][n], 0, 0, 0); __builtin_amdgcn_s_setprio(0); } while (0)
#define PG8_WAIT_V(n) asm volatile("s_waitcnt vmcnt(" #n ")" ::: "memory")
#define PG8_WAIT_L(n) asm volatile("s_waitcnt lgkmcnt(" #n ")" ::: "memory")
#define PG8_BAR __builtin_amdgcn_s_barrier()
#define PG8_SCHED __builtin_amdgcn_sched_barrier(0)
    Unit cur, nxt; int ui = 0;
    if (!S.next(0, cur)) return;
    f32x4 acc[2][2][4][2];
#pragma unroll
    for (int a = 0; a < 2; ++a)
#pragma unroll
        for (int b = 0; b < 2; ++b)
#pragma unroll
            for (int m = 0; m < 4; ++m)
#pragma unroll
                for (int n = 0; n < 2; ++n) acc[a][b][m][n] = (f32x4){0.f, 0.f, 0.f, 0.f};
    bf16x8 At[4][2], B0[2][2], B1[2][2];
    const char* cA = (const char*)g.A + (size_t)cur.pm * tstep; const char* cB = (const char*)g.Bt + (size_t)cur.pn * tstep;
    S.a_ready(cur);
    if constexpr (SP2) {
        PG8_STAGE(PG8_SB(0, 0), cB, voffB); PG8_STAGE(PG8_SB(0, 1), cB + hstep, voffB); PG8_STAGE(PG8_SA(0, 0), cA, voffA); PG8_STAGE(PG8_SA(0, 1), cA + hstep, voffA);
        if (wr == 1) PG8_BAR;
        PG8_WAIT_V(2); PG8_BAR;
        PG8_STAGE(PG8_SB(1, 0), cB + kstep, voffB); PG8_STAGE(PG8_SA(1, 0), cA + kstep, voffA); PG8_STAGE(PG8_SB(1, 1), cB + hstep + kstep, voffB);
        PG8_WAIT_V(6); PG8_BAR;
    } else {
        PG8_STAGE(PG8_SB(0, 0), cB, voffB); PG8_STAGE(PG8_SA(0, 0), cA, voffA); PG8_STAGE(PG8_SB(0, 1), cB + hstep, voffB); PG8_STAGE(PG8_SA(0, 1), cA + hstep, voffA);
        if (wr == 1) PG8_BAR;
        PG8_WAIT_V(4); PG8_BAR;
        PG8_STAGE(PG8_SB(1, 0), cB + kstep, voffB); PG8_STAGE(PG8_SA(1, 0), cA + kstep, voffA); PG8_STAGE(PG8_SB(1, 1), cB + hstep + kstep, voffB);
        PG8_WAIT_V(6); PG8_BAR;
    }
    for (;;) {
        const bool has_next = S.next(ui + 1, nxt);
        const char* nA = has_next ? (const char*)g.A + (size_t)nxt.pm * tstep : cA; const char* nB = has_next ? (const char*)g.Bt + (size_t)nxt.pn * tstep : cB;
        for (int t = 0; t < nt; t += 2) {
            const bool last = (t == nt - 2);
            const char* a1 = cA + (size_t)(t + 1) * kstep;
            const char* a2 = last ? nA : cA + (size_t)(t + 2) * kstep; const char* b2 = last ? nB : cB + (size_t)(t + 2) * kstep;
            const char* a3 = a2 + kstep; const char* b3 = b2 + kstep;
            if (last && has_next) S.a_ready(nxt);
            if constexpr (SP2) {
            PG8_LDB(B0, 0, 0); PG8_LDB(B1, 0, 1); PG8_SCHED; PG8_LDA(At, 0, 0); PG8_STAGE(PG8_SA(1, 1), a1 + hstep, voffA);
            PG8_WAIT_V(8); PG8_WAIT_L(0); PG8_BAR; PG8_MMA(0, 0, At, B0); PG8_MMA(0, 1, At, B1); PG8_BAR; PG8_SCHED;
            PG8_LDA(At, 0, 1); PG8_STAGE(PG8_SB(0, 0), b2, voffB); PG8_STAGE(PG8_SB(0, 1), b2 + hstep, voffB); PG8_STAGE(PG8_SA(0, 0), a2, voffA);
            PG8_WAIT_V(8); PG8_WAIT_L(0); PG8_BAR; PG8_MMA(1, 0, At, B0); PG8_MMA(1, 1, At, B1); PG8_BAR; PG8_SCHED;
            PG8_LDB(B0, 1, 0); PG8_LDB(B1, 1, 1); PG8_SCHED; PG8_LDA(At, 1, 0); PG8_STAGE(PG8_SA(0, 1), a2 + hstep, voffA);
            PG8_WAIT_V(8); PG8_WAIT_L(0); PG8_BAR; PG8_MMA(0, 0, At, B0); PG8_MMA(0, 1, At, B1); PG8_BAR; PG8_SCHED;
            PG8_LDA(At, 1, 1); PG8_STAGE(PG8_SB(1, 0), b3, voffB); PG8_STAGE(PG8_SB(1, 1), b3 + hstep, voffB); PG8_STAGE(PG8_SA(1, 0), a3, voffA);
            PG8_WAIT_V(8); PG8_WAIT_L(0); PG8_BAR; PG8_MMA(1, 0, At, B0); PG8_MMA(1, 1, At, B1); PG8_BAR; PG8_SCHED;
            } else {
            PG8_LDB(B0, 0, 0); PG8_SCHED; PG8_LDA(At, 0, 0); PG8_STAGE(PG8_SA(1, 1), a1 + hstep, voffA);
            PG8_WAIT_L(8); PG8_BAR; PG8_WAIT_L(0); PG8_MMA(0, 0, At, B0); PG8_BAR; PG8_SCHED;
            PG8_LDB(B1, 0, 1); PG8_STAGE(PG8_SB(0, 0), b2, voffB);
            PG8_BAR; PG8_WAIT_L(0); PG8_MMA(0, 1, At, B1); PG8_BAR;
            PG8_LDA(At, 0, 1); PG8_STAGE(PG8_SA(0, 0), a2, voffA);
            PG8_BAR; PG8_WAIT_L(0); PG8_MMA(1, 0, At, B0); PG8_BAR; PG8_SCHED;
            PG8_STAGE(PG8_SB(0, 1), b2 + hstep, voffB);
            PG8_WAIT_V(6); PG8_BAR; PG8_MMA(1, 1, At, B1); PG8_BAR;
            PG8_LDB(B0, 1, 0); PG8_SCHED; PG8_LDA(At, 1, 0); PG8_STAGE(PG8_SA(0, 1), a2 + hstep, voffA);
            PG8_WAIT_L(8); PG8_BAR; PG8_WAIT_L(0); PG8_MMA(0, 0, At, B0); PG8_BAR; PG8_SCHED;
            PG8_LDB(B1, 1, 1); PG8_STAGE(PG8_SB(1, 0), b3, voffB);
            PG8_BAR; PG8_WAIT_L(0); PG8_MMA(0, 1, At, B1); PG8_BAR;
            PG8_LDA(At, 1, 1); PG8_STAGE(PG8_SA(1, 0), a3, voffA);
            PG8_BAR; PG8_WAIT_L(0); PG8_MMA(1, 0, At, B0); PG8_BAR; PG8_SCHED;
            PG8_STAGE(PG8_SB(1, 1), b3 + hstep, voffB);
            PG8_WAIT_V(6); PG8_BAR; PG8_MMA(1, 1, At, B1); PG8_BAR;
            }
        }
        if constexpr (ALIGN_EPI) { if (wr == 0) PG8_BAR; }
        if constexpr (!Epi::AFTER_DRAIN) { E(acc, cur, wr, wc, fr, fq); S.done(cur); }
        if (!has_next) break;
#pragma unroll
        for (int a = 0; a < 2; ++a)
#pragma unroll
            for (int b = 0; b < 2; ++b)
#pragma unroll
                for (int m = 0; m < 4; ++m)
#pragma unroll
                    for (int n = 0; n < 2; ++n) acc[a][b][m][n] = (f32x4){0.f, 0.f, 0.f, 0.f};
        cur = nxt; cA = nA; cB = nB; ++ui;
        if constexpr (ALIGN_EPI) { if (wr == 1) PG8_BAR; }
    }
    PG8_WAIT_V(0);
    if constexpr (!ALIGN_EPI) { if (wr == 0) PG8_BAR; }
    PG8_BAR;
    if constexpr (Epi::AFTER_DRAIN) { E.fused(acc, cur, wr, wc, fr, fq, lds, wid, lane); S.done(cur); }
#undef PG8_SA
#undef PG8_SB
#undef PG8_STAGE
#undef PG8_LDA
#undef PG8_LDB
#undef PG8_MMA
#undef PG8_WAIT_V
#undef PG8_WAIT_L
#undef PG8_BAR
#undef PG8_SCHED
}
}
#define GAS __attribute__((address_space(1)))
#define LAS __attribute__((address_space(3)))
typedef unsigned short bf16;
typedef unsigned v4u __attribute__((ext_vector_type(4)));
typedef float f32x4 __attribute__((ext_vector_type(4)));
typedef short bf16x8 __attribute__((ext_vector_type(8)));
typedef GAS unsigned gu32;
typedef GAS unsigned long long gu64;
#define RLX_AGENT __ATOMIC_RELAXED, __HIP_MEMORY_SCOPE_AGENT
#define LDS_WAIT() asm volatile("s_waitcnt lgkmcnt(0)" ::: "memory")
#define VM_WAIT() asm volatile("s_waitcnt vmcnt(0)" ::: "memory")
__device__ __forceinline__ unsigned long long rt() { return __builtin_amdgcn_s_memrealtime(); }
__device__ __forceinline__ unsigned f2bf(float f) { unsigned u = __builtin_bit_cast(unsigned, f); return (u + 0x7fffu + ((u >> 16) & 1u)) >> 16; }
__device__ __forceinline__ unsigned pk2(float lo, float hi) { return f2bf(lo) | (f2bf(hi) << 16); }

#define XB_TMO      128
#define XB_XCNT(j)  (256  + 64 * (j))
#define XB_XSUB(j)  (1280 + 64 * (j))
#define XB_XGEN(j)  (2304 + 64 * (j))
#define XB_TOP      3328
#define XB_TOPGEN   3392
#define XCD_BAR_WORDS 3456
#define XB_SPIN_CAP (1u << 18)

__device__ __forceinline__ unsigned xb_ld(unsigned* p)              { return __hip_atomic_load(p, __ATOMIC_RELAXED, __HIP_MEMORY_SCOPE_AGENT); }
__device__ __forceinline__ unsigned xb_add(unsigned* p, unsigned v) { return __hip_atomic_fetch_add(p, v, __ATOMIC_RELAXED, __HIP_MEMORY_SCOPE_AGENT); }
__device__ __forceinline__ unsigned xb_xcc_id() { return (unsigned)__builtin_amdgcn_s_getreg((3 << 11) | 20) & 0xFu; }
#define XB_SPIN(cond, bar) do { unsigned _sp = 0; while (cond) { __builtin_amdgcn_s_sleep(1); \
    if ((++_sp & 255u) == 0u) { if (xb_ld(&(bar)[XB_TMO])) break; if (_sp > XB_SPIN_CAP) { atomicAdd(&(bar)[XB_TMO], 1u); break; } } } } while (0)

struct XcdBarrier {
    unsigned* bar; unsigned x;
    volatile LAS unsigned* st;
};

__device__ __forceinline__ XcdBarrier xcd_barrier_post(unsigned* bar, volatile LAS unsigned* st) {
    XcdBarrier b; b.bar = bar; b.x = xb_xcc_id(); b.st = st;
    if (threadIdx.x == 0) (void)xb_add(&bar[XB_XCNT(b.x)], 1u);
    return b;
}
__device__ __forceinline__ void xcd_barrier_complete(unsigned* bar, unsigned x, unsigned& nloc, unsigned& nx) {
    const unsigned G = gridDim.x * gridDim.y * gridDim.z;
    unsigned sum, cnt, mine, sp = 0u;
    for (;;) {
        sum = 0u; cnt = 0u; mine = 0u;
#pragma unroll
        for (unsigned j = 0; j < 16; ++j) { const unsigned c = xb_ld(&bar[XB_XCNT(j)]); sum += c; cnt += (c > 0u) ? 1u : 0u; mine = (j == x) ? c : mine; }
        if (sum == G) break;
        __builtin_amdgcn_s_sleep(1);
        if ((++sp & 255u) == 0u) { if (xb_ld(&bar[XB_TMO])) break; if (sp > XB_SPIN_CAP) { atomicAdd(&bar[XB_TMO], 1u); break; } }
    }
    nloc = mine > 0u ? mine : 1u; nx = cnt > 0u ? cnt : 1u;
}

__device__ __forceinline__ void xcd_barrier(const XcdBarrier& b) {
    asm volatile("s_waitcnt vmcnt(0)" ::: "memory");
    __syncthreads();
    if (threadIdx.x == 0) {
        unsigned* bar = b.bar;
        __builtin_amdgcn_s_waitcnt(0);
        unsigned nloc = b.st[0], nx = b.st[1];
        if (nloc == 0u) { xcd_barrier_complete(bar, b.x, nloc, nx); b.st[0] = nloc; b.st[1] = nx; }
        const unsigned old = xb_add(&bar[XB_XSUB(b.x)], 1u);
        const unsigned gen = old / nloc;
        if (old + 1u == (gen + 1u) * nloc) {
            __builtin_amdgcn_fence(__ATOMIC_RELEASE, "agent");
            asm volatile("s_waitcnt vmcnt(0)" ::: "memory");
            const unsigned og = xb_add(&bar[XB_TOP], 1u);
            const unsigned tg = og / nx;
            if (og + 1u == (tg + 1u) * nx) xb_add(&bar[XB_TOPGEN], 1u);
            else XB_SPIN(xb_ld(&bar[XB_TOPGEN]) == tg, bar);
            __builtin_amdgcn_fence(__ATOMIC_ACQUIRE, "agent");
            xb_add(&bar[XB_XGEN(b.x)], 1u);
            asm volatile("s_waitcnt vmcnt(0)" ::: "memory");
        } else {
            XB_SPIN(xb_ld(&bar[XB_XGEN(b.x)]) == gen, bar);
            __builtin_amdgcn_fence(__ATOMIC_ACQUIRE, "agent");
            asm volatile("s_waitcnt vmcnt(0)" ::: "memory");
        }
    }
    __syncthreads();
}
typedef __attribute__((address_space(1))) float GASF;
struct PG {
  const GASF *x_prompt, *x_sample, *cache_ckv, *cache_kpe, *state_rwkv, *c, *c_ctx;
  const GASF *mod_w, *mod_b, *ln_g, *ln_b;
  const GASF *hy_w_in, *hy_conv_w, *hy_conv_b, *hy_w1, *hy_b1, *hy_w2, *hy_b2, *hy_w3, *hy_b3, *hy_freq, *hy_decay, *hy_skip, *hy_w_out;
  const GASF *mla_w_in, *mla_q_norm, *mla_kv_norm, *mla_w_q_up, *mla_w_kv_up, *mla_w_out;
  const GASF *rw_mu, *rw_w_in, *rw_w0, *rw_w1, *rw_w2, *rw_a0, *rw_a1, *rw_a2, *rw_k_k, *rw_k_a, *rw_r_k, *rw_gn_g, *rw_gn_b, *rw_w_out;
  GASF* out;
  GASF* ws;
};
namespace mk {
typedef float f32x16 __attribute__((ext_vector_type(16)));
typedef short v4i16_t __attribute__((ext_vector_type(4)));
typedef unsigned u32x4 __attribute__((ext_vector_type(4)));
typedef unsigned u32x2 __attribute__((ext_vector_type(2)));
typedef unsigned short u16;

constexpr size_t MiB = 1u << 20;
constexpr size_t M_X = 0, M_HB = 32 * MiB, M_GB = 48 * MiB, M_UT = 64 * MiB, M_SCR2 = 128 * MiB, M_WTS = 192 * MiB, M_FILT = 230 * MiB;
constexpr size_t M_HDN2 = 248 * MiB + 512 * 1024, M_MODP = 250 * MiB, M_MODS = 254 * MiB, M_CTL = 255 * MiB;
constexpr size_t W_HYIN = M_WTS, W_HYOUT = M_WTS + 16 * MiB, W_MLAIN = M_WTS + 20 * MiB, W_QUP = M_WTS + 23 * MiB, W_KVUP = M_WTS + 24 * MiB,
                 W_MLAOUT = M_WTS + 25 * MiB, W_RWIN = M_WTS + 27 * MiB, W_LORA1 = M_WTS + 35 * MiB, W_RWOUT = M_WTS + 36 * MiB;
constexpr size_t M_U2S = M_SCR2 + 24 * MiB;
constexpr size_t M_QN = M_SCR2, M_CKVALL = M_SCR2 + 4 * MiB, M_KPEB = M_SCR2 + 7 * MiB, M_SZB = M_SCR2 + 8 * MiB, M_Q = M_UT, M_KN = M_UT + 24 * MiB, M_V = M_UT + 42 * MiB;
constexpr int FILT_CH = 4640;
constexpr int LDS_BYTES = 163840, MISC_OFF = LDS_BYTES - 512, PTAB_OFF = LDS_BYTES - 1024;

__device__ __forceinline__ float bf2f(unsigned v) { return __builtin_bit_cast(float, v << 16); }
typedef float f32x2_t __attribute__((ext_vector_type(2))); typedef __bf16 bf16x2_t __attribute__((ext_vector_type(2)));
__device__ __forceinline__ unsigned pk2_(float lo, float hi) { const f32x2_t v = {lo, hi}; const bf16x2_t b = __builtin_convertvector(v, bf16x2_t); return __builtin_bit_cast(unsigned, b); }
__device__ __forceinline__ unsigned f2bf_(float f) { return pk2_(f, 0.f) & 0xffffu; }
__device__ __forceinline__ v4i16_t vtr(LAS const unsigned char* p) { return __builtin_amdgcn_ds_read_tr16_b64_v4i16((LAS v4i16_t*)p); }
template <class T> __device__ __forceinline__ T* uni(T* p) {
  const unsigned long long v = (unsigned long long)p;
  const unsigned lo = __builtin_amdgcn_readfirstlane((unsigned)v), hi = __builtin_amdgcn_readfirstlane((unsigned)(v >> 32));
  return (T*)(((unsigned long long)hi << 32) | lo);
}
__device__ __forceinline__ float wsum(float v) {
#pragma unroll
  for (int o = 1; o < 64; o <<= 1) v += __shfl_xor(v, o);
  return v;
}
__device__ __forceinline__ const GASF* xrow_in(const LAS PG& p, int layer, const unsigned char* ws, int m) {
  if (layer == 0) return (m < NPT) ? p.x_prompt + (size_t)m * D : p.x_sample + (size_t)(m - NPT) * D;
  if (layer == 2) return p.out + OUT_Y + (size_t)m * D;
  return (const GASF*)(ws + M_X) + (size_t)m * D;
}

struct TrD { const GASF* W; bf16_t* WT; int K, N, kind, row_off, item; };
constexpr int I_HYIN = 16 * 128, I_SQ = 16 * 32, I_MLAIN = 16 * 45, I_QUP = 4 * 48, I_KVUP = 2 * 64, I_LORA = 16 * 2;
constexpr int NTR = 2 * I_HYIN + 2 * I_SQ + I_MLAIN + I_QUP + I_KVUP + I_SQ + 4 * I_SQ + 4 * I_LORA + I_SQ;
constexpr int NTR_DEF = I_HYIN + I_SQ + I_SQ;
constexpr int NTR_DEF2 = 4 * I_SQ + 4 * I_LORA;
constexpr int NTR_P0 = NTR - NTR_DEF - NTR_DEF2;
constexpr int R_RWIN = 2 * I_HYIN + 2 * I_SQ + I_MLAIN + I_QUP + I_KVUP + I_SQ;
__device__ __forceinline__ int tr_map_p0(int idx) { return idx < I_HYIN ? idx : (idx < I_HYIN + I_SQ ? 2 * I_HYIN + (idx - I_HYIN) : 2 * I_HYIN + 2 * I_SQ + (idx - I_HYIN - I_SQ)); }
__device__ __forceinline__ int tr_map_def(int idx) { return idx < I_HYIN ? I_HYIN + idx : (idx < I_HYIN + I_SQ ? 2 * I_HYIN + I_SQ + (idx - I_HYIN) : NTR - I_SQ + (idx - I_HYIN - I_SQ)); }
__device__ __forceinline__ int tr_map_def2(int idx) { return R_RWIN + idx; }
__device__ __forceinline__ TrD tr_decode(const LAS PG& p, unsigned char* ws, int r) {
  TrD d; d.kind = 0; d.row_off = 0; d.K = 1024; d.N = 1024;
  if (r < 2 * I_HYIN) { const int j = r / I_HYIN; d.W = p.hy_w_in + (size_t)j * D * 4096; d.N = 4096; d.WT = (bf16_t*)(ws + W_HYIN + (size_t)j * 8 * MiB); d.item = r % I_HYIN; return d; } r -= 2 * I_HYIN;
  if (r < 2 * I_SQ) { const int j = r / I_SQ; d.W = p.hy_w_out + (size_t)j * D * D; d.WT = (bf16_t*)(ws + W_HYOUT + (size_t)j * 2 * MiB); d.kind = 1; d.item = r % I_SQ; return d; } r -= 2 * I_SQ;
  if (r < I_MLAIN) { const int nb = r % 45; d.W = p.mla_w_in; d.N = 1440; d.item = r; if (nb < 13) d.WT = (bf16_t*)(ws + W_MLAIN); else { d.WT = (bf16_t*)(ws + W_MLAIN + MiB); d.row_off = -416; } return d; } r -= I_MLAIN;
  if (r < I_QUP) { d.W = p.mla_w_q_up; d.K = 256; d.N = 1536; d.WT = (bf16_t*)(ws + W_QUP); d.item = r; return d; } r -= I_QUP;
  if (r < I_KVUP) { d.W = p.mla_w_kv_up; d.K = 128; d.N = 2048; d.WT = (bf16_t*)(ws + W_KVUP); d.item = r; return d; } r -= I_KVUP;
  if (r < I_SQ) { d.W = p.mla_w_out; d.WT = (bf16_t*)(ws + W_MLAOUT); d.kind = 1; d.item = r; return d; } r -= I_SQ;
  if (r < 4 * I_SQ) { const int q = r / I_SQ; d.W = p.rw_w_in + (size_t)q * D * D; d.WT = (bf16_t*)(ws + W_RWIN + (size_t)q * 2 * MiB); d.item = r % I_SQ; return d; } r -= 4 * I_SQ;
  if (r < 4 * I_LORA) { const int q = r / I_LORA; d.W = (q < 2) ? p.rw_w1 + (size_t)q * D * 64 : p.rw_a1 + (size_t)(q - 2) * D * 64; d.N = 64; d.WT = (bf16_t*)(ws + W_LORA1); d.kind = 1; d.row_off = q * 64; d.item = r % I_LORA; return d; } r -= 4 * I_LORA;
  d.W = p.rw_w_out; d.WT = (bf16_t*)(ws + W_RWOUT); d.kind = 1; d.item = r; return d;
}
__device__ __forceinline__ void tr_load(const TrD& d, int lane, f32x4 (&v)[8]) {
  const int nblk = d.N / 32, kb = d.item / nblk, nb = d.item % nblk, k0 = 64 * kb, n0 = 32 * nb;
  const GAS f32x4* src = (const GAS f32x4*)(d.W + (size_t)(k0 + (lane >> 3)) * d.N + n0 + 4 * (lane & 7));
#pragma unroll
  for (int i = 0; i < 8; ++i) v[i] = src[(size_t)i * 2 * d.N];
}
__device__ __forceinline__ void tr_finish(const TrD& d, LAS float* scr, int lane, const f32x4 (&v)[8]) {
  const int nblk = d.N / 32, kb = d.item / nblk, nb = d.item % nblk, k0 = 64 * kb, n0 = 32 * nb, K = d.K;
#pragma unroll
  for (int i = 0; i < 8; ++i) { LAS float* dd = scr + (8 * i + (lane >> 3)) * 33 + 4 * (lane & 7); dd[0] = v[i].x; dd[1] = v[i].y; dd[2] = v[i].z; dd[3] = v[i].w; }
  asm volatile("s_waitcnt lgkmcnt(0)" ::: "memory");
  const int c = lane & 7;
#pragma unroll
  for (int jj = 0; jj < 4; ++jj) {
    const int n = (lane >> 3) + 8 * jj; LAS const float* s = scr + (8 * c) * 33 + n;
    u32x4 o; o.x = pk2_(s[0 * 33], s[1 * 33]); o.y = pk2_(s[2 * 33], s[3 * 33]); o.z = pk2_(s[4 * 33], s[5 * 33]); o.w = pk2_(s[6 * 33], s[7 * 33]);
    const int ng = n0 + n + d.row_off;
    if (d.kind == 0) {
      *(u32x4*)(d.WT + (size_t)ng * K + k0 + 8 * c) = o;
    } else {
      const int k8 = (k0 >> 3) + c;
      const size_t ci = ((size_t)((ng >> 5) * 64 + (k8 >> 1))) * 64 + (ng & 31) + 32 * (k8 & 1);
      *(u32x4*)(d.WT + ci * 8) = o;
    }
  }
  asm volatile("s_waitcnt lgkmcnt(0)" ::: "memory");
}
template <int DEF>
__device__ __forceinline__ void tr_run(const LAS PG& p, unsigned char* ws, LAS float* scr, int lane, int first, int stride, int n) {
  for (int it = first; it < n; it += 2 * stride) {
    const TrD dA = tr_decode(p, ws, DEF == 2 ? tr_map_def2(it) : (DEF == 1 ? tr_map_def(it) : tr_map_p0(it)));
    f32x4 vA[8], vB[8];
    tr_load(dA, lane, vA);
    const bool hasB = (it + stride) < n;
    TrD dB = dA;
    if (hasB) { dB = tr_decode(p, ws, DEF == 2 ? tr_map_def2(it + stride) : (DEF == 1 ? tr_map_def(it + stride) : tr_map_p0(it + stride))); tr_load(dB, lane, vB); }
    tr_finish(dA, scr, lane, vA);
    if (hasB) tr_finish(dB, scr, lane, vB);
  }
}

__device__ __forceinline__ void phase_p0a(const LAS PG& p, unsigned char* ws, LAS unsigned char* lds, int tid, int lane, int wave, int bid, int G) {
  LAS float* SC = (LAS float*)lds;
  for (int i = tid; i < 3072; i += 512) { const int g = i >> 10, k = i & 1023; const float c = (g == 0) ? p.c_ctx[k] : p.c[(g - 1) * 1024 + k]; SC[i] = silu(c); }
  __syncthreads();
  LAS float* RED = (LAS float*)lds + 3072;
#ifdef MP_TWICE
  for (int rep_ = 0; rep_ < 2; ++rep_)
#endif
  for (int it = bid; it < 96; it += G) {
    const int kc = it & 7, cc = (it >> 3) % 3, i = it / 24;
    const int c4 = tid & 255, kh = tid >> 8;
    const int n = cc * 1024 + 4 * c4;
    const GAS f32x4* w = (const GAS f32x4*)(p.mod_w + ((size_t)i * 1024 + kc * 128 + kh * 64) * 3072 + n);
    f32x4 a0 = (f32x4){0.f, 0.f, 0.f, 0.f}, a1 = a0, a2 = a0;
#pragma unroll 8
    for (int k = 0; k < 64; ++k) { const f32x4 wv = w[(size_t)k * 768]; const int kk = kc * 128 + kh * 64 + k; a0 += SC[kk] * wv; a1 += SC[1024 + kk] * wv; a2 += SC[2048 + kk] * wv; }
    if (kh == 1) { LAS f32x4* r = (LAS f32x4*)(RED + c4 * 12); r[0] = a0; r[1] = a1; r[2] = a2; }
    __syncthreads();
    if (kh == 0) {
      LAS const f32x4* r = (LAS const f32x4*)(RED + c4 * 12);
      float* mp = (float*)(ws + M_MODP) + (size_t)kc * 36864 + (size_t)i * 9216 + n;
      *(f32x4*)mp = a0 + r[0]; *(f32x4*)(mp + 3072) = a1 + r[1]; *(f32x4*)(mp + 6144) = a2 + r[2];
    }
    __syncthreads();
  }
  __syncthreads();
  for (int i = bid * 512 + tid; i < 12288; i += G * 512) *(u32x4*)(ws + W_MLAIN + (size_t)416 * 2048 + (size_t)i * 16) = (u32x4){0u, 0u, 0u, 0u};
  for (int i = bid * 512 + tid; i < 2 * PAST * 128 / 8; i += G * 512) {
    const int d8 = i & 15, pl = (i >> 4) & 511, b = i >> 13;
    const f32x4* src = (const f32x4*)(p.cache_ckv + ((size_t)(b * PAST + pl)) * 128 + d8 * 8);
    const f32x4 x0 = src[0], x1 = src[1];
    u32x4 o; o.x = pk2_(x0.x, x0.y); o.y = pk2_(x0.z, x0.w); o.z = pk2_(x1.x, x1.y); o.w = pk2_(x1.z, x1.w);
    *(u32x4*)((bf16_t*)(ws + M_CKVALL) + ((size_t)(NPT + b * 2560 + pl)) * 128 + d8 * 8) = o;
    if (d8 < 4) {
      const f32x4* s2 = (const f32x4*)(p.cache_kpe + ((size_t)(b * PAST + pl)) * 32 + d8 * 8);
      const f32x4 y0 = s2[0], y1 = s2[1];
      u32x4 o2; o2.x = pk2_(y0.x, y0.y); o2.y = pk2_(y0.z, y0.w); o2.z = pk2_(y1.x, y1.y); o2.w = pk2_(y1.z, y1.w);
      *(u32x4*)((bf16_t*)(ws + M_KPEB) + ((size_t)(NPT + b * 2560 + pl)) * 32 + d8 * 8) = o2;
    }
  }
  LAS float* scr = (LAS float*)(lds + wave * 16384);
  const int gw = bid * 8 + wave, NGW = G * 8;
  tr_run<0>(p, ws, scr, lane, gw, NGW, NTR_P0);
#ifdef TR_TWICE
  tr_run<0>(p, ws, scr, lane, gw, NGW, NTR_P0);
#endif
  {
    __syncthreads();
    const int jh = (bid * 2 >= G) ? 1 : 0;
    LAS float* w1s = (LAS float*)(lds + 131072);
    LAS float* w2s = w1s + 33 * 64;
    for (int i = tid; i < 33 * 64; i += 512) w1s[i] = p.hy_w1[(size_t)jh * 33 * 64 + i];
    for (int i = tid; i < 64 * 64; i += 512) w2s[i] = p.hy_w2[(size_t)jh * 64 * 64 + i];
    __syncthreads();
    const float b1 = p.hy_b1[jh * 64 + lane], b2 = p.hy_b2[jh * 64 + lane], f0 = p.hy_freq[(jh * 2 + 0) * 64 + lane], f1 = p.hy_freq[(jh * 2 + 1) * 64 + lane];
    const int nbh = jh ? (G - (G + 1) / 2) : ((G + 1) / 2), bh = jh ? (bid - (G + 1) / 2) : bid;
    for (int row = bh * 8 + wave; row < 2304; row += nbh * 8) {
      const int L = row < 256 ? 256 : 2048, l = row < 256 ? row : row - 256;
      const float t = (float)l / (float)(L - 1);
      float feat = 0.f;
      if (lane == 0) feat = t;
      else if (lane < 33) {
        const int b = (lane - 1) & 15;
        const float band = 1e-4f + (float)b * ((15.f - 1e-4f) / 15.f);
        const float rev = ((float)l / (float)L) * band;
        const float fr = rev - floorf(rev);
        feat = (lane <= 16) ? __builtin_amdgcn_cosf(fr) : -__builtin_amdgcn_sinf(fr);
      }
      float a = b1;
#pragma unroll
      for (int f = 0; f < 33; ++f) a += __shfl(feat, f) * w1s[f * 64 + lane];
      const float x1 = f0 * a * 0.15915494309189535f;
      const float h1 = __builtin_amdgcn_sinf(x1 - floorf(x1));
      float a2 = b2;
#pragma unroll 16
      for (int f = 0; f < 64; ++f) a2 += __shfl(h1, f) * w2s[f * 64 + lane];
      const float x2 = f1 * a2 * 0.15915494309189535f;
      const float h2 = __builtin_amdgcn_sinf(x2 - floorf(x2));
      ((float*)(ws + M_HDN2))[((size_t)jh * 2304 + row) * 64 + lane] = h2;
    }
  }
}

__device__ __forceinline__ void phase_p0b(const LAS PG& p, unsigned char* ws, LAS unsigned char* lds, int tid, int lane, int wave, int bid, int G) {
  const float* MP = (const float*)(ws + M_MODP);
  float* MODS = (float*)(ws + M_MODS);
  for (int idx = bid * 512 + tid; idx < 36864; idx += G * 512) {
    float s = p.mod_b[(idx / 9216) * 3072 + (idx % 3072)];
#pragma unroll
    for (int kc = 0; kc < 8; ++kc) s += MP[(size_t)kc * 36864 + idx];
    MODS[idx] = s;
  }
  LAS float* ML = (LAS float*)lds;
  for (int e = tid; e < 6144; e += 512) {
    const int g = e >> 11, r = e & 2047; const int idx = g * 3072 + r;
    float s = p.mod_b[r];
#pragma unroll
    for (int kc = 0; kc < 8; ++kc) s += MP[(size_t)kc * 36864 + idx];
    ML[e] = s;
  }
  __syncthreads();
  bf16_t* HB = (bf16_t*)(ws + M_HB);
#ifndef NO_H0
#ifdef H0_TWICE
  for (int rep_ = 0; rep_ < 2; ++rep_)
#endif
  for (int m = bid * 8 + wave; m < NTOK; m += G * 8) {
    int l, L, cond, m0; tokinfo(m, l, L, cond, m0);
    const GAS f32x4* xr = (const GAS f32x4*)xrow_in(p, 0, ws, m);
    LAS const float* sh = ML + cond * 2048; LAS const float* sc = sh + 1024;
#pragma unroll
    for (int i = 0; i < 4; ++i) {
      const int k = 4 * lane + 256 * i; const f32x4 x = xr[lane + 64 * i];
      u32x2 o; o.x = pk2_(x.x * (1.f + sc[k]) + sh[k], x.y * (1.f + sc[k + 1]) + sh[k + 1]); o.y = pk2_(x.z * (1.f + sc[k + 2]) + sh[k + 2], x.w * (1.f + sc[k + 3]) + sh[k + 3]);
      *(u32x2*)(HB + (size_t)m * D + k) = o;
    }
  }
#endif
  __syncthreads();
#ifndef NO_FG
  const int gw = bid * 8 + wave, NGW = G * 8;
  const float* HD = (const float*)(ws + M_HDN2);
  bf16_t* FILT = (bf16_t*)(ws + M_FILT);
  const int r32 = lane & 31, hi = lane >> 5;
#ifdef FG_TWICE
  for (int rep_ = 0; rep_ < 2; ++rep_)
#endif
  for (int wslot = gw; wslot < 64 * 32; wslot += NGW) {
    const int combo = wslot & 63, sub = wslot >> 6;
    const int cch = combo & 15, dir = (combo >> 4) & 1, j = combo >> 5;
    LAS float* w3s = (LAS float*)(lds + 16384 + wave * 16384);
    {
      const GASF* w3 = p.hy_w3 + ((size_t)j * 64 * 2048 + dir * 1024 + cch * 64 + lane);
      asm volatile("s_waitcnt lgkmcnt(0)" ::: "memory");
#pragma unroll 8
      for (int m = 0; m < 64; ++m) { w3s[m * 64 + lane] = *w3; w3 += 2048; }
      asm volatile("s_waitcnt lgkmcnt(0)" ::: "memory");
    }
    bf16x8 bw[2][4];
    {
      LAS const float* wb = w3s + (8 * hi) * 64 + r32;
#pragma unroll
      for (int nt = 0; nt < 2; ++nt)
#pragma unroll
        for (int ks = 0; ks < 4; ++ks) {
          LAS const float* q = wb + (16 * ks) * 64 + 32 * nt;
          u32x4 o; o.x = pk2_(q[0], q[64]); o.y = pk2_(q[128], q[192]); o.z = pk2_(q[256], q[320]); o.w = pk2_(q[384], q[448]);
          bw[nt][ks] = __builtin_bit_cast(bf16x8, o);
        }
    }
    float cb3[2], cdec[2];
#pragma unroll
    for (int nt = 0; nt < 2; ++nt) { const int o = dir * 1024 + cch * 64 + 32 * nt + r32; cb3[nt] = p.hy_b3[j * 2048 + o]; cdec[nt] = fabsf(p.hy_decay[(size_t)j * 2048 + o]); }
#pragma unroll 1
    for (int it = sub; it < 72; it += 32) {
      const int set = it < 8 ? 0 : 1, b = set ? it - 8 : it, L = set ? 2048 : 256, row0 = set ? 256 : 0;
      const int lag0 = 32 * b + (dir ? 0 : 1);
      bf16x8 af[4];
      {
        const int lag = lag0 + r32; const bool ok = dir ? (lag >= 1) : (lag <= L - 1);
        const float* hrow = HD + ((size_t)j * 2304 + row0 + (ok ? lag : 0)) * 64 + 8 * hi;
#pragma unroll
        for (int ks = 0; ks < 4; ++ks) {
          f32x4 x0 = *(const f32x4*)(hrow + 16 * ks), x1 = *(const f32x4*)(hrow + 16 * ks + 4);
          if (!ok) { x0 = (f32x4){0.f, 0.f, 0.f, 0.f}; x1 = x0; }
          u32x4 o; o.x = pk2_(x0.x, x0.y); o.y = pk2_(x0.z, x0.w); o.z = pk2_(x1.x, x1.y); o.w = pk2_(x1.z, x1.w);
          af[ks] = __builtin_bit_cast(bf16x8, o);
        }
      }
      const float tinv = 1.f / (float)(L - 1);
#pragma unroll
      for (int nt = 0; nt < 2; ++nt) {
        f32x16 acc;
#pragma unroll
        for (int i = 0; i < 16; ++i) acc[i] = 0.f;
#pragma unroll
        for (int ks = 0; ks < 4; ++ks) acc = __builtin_amdgcn_mfma_f32_32x32x16_bf16(af[ks], bw[nt][ks], acc, 0, 0, 0);
        bf16_t* fch = FILT + ((size_t)(j * 1024 + cch * 64 + 32 * nt + r32)) * FILT_CH + (set ? 528 : 0) + L + 8;
#pragma unroll
        for (int q = 0; q < 4; ++q) {
          unsigned v[4];
#pragma unroll
          for (int x = 0; x < 4; ++x) {
            const int lag = lag0 + 8 * q + 4 * hi + x;
            const bool ok = dir ? (lag >= 1) : (lag <= L - 1);
            const float val = (acc[4 * q + x] + cb3[nt]) * __expf(-(float)lag * tinv * cdec[nt]);
            v[x] = ok ? f2bf_(val) : 0u;
          }
          if (dir) {
            const int i0 = lag0 + 8 * q + 4 * hi;
            if (i0 != 0) { u32x2 w; w.x = v[0] | (v[1] << 16); w.y = v[2] | (v[3] << 16); *(u32x2*)(fch + i0) = w; }
            else { fch[1] = (bf16_t)v[1]; fch[2] = (bf16_t)v[2]; fch[3] = (bf16_t)v[3]; }
          } else {
            const int i0 = -(lag0 + 8 * q + 4 * hi + 3);
            u32x2 w; w.x = v[3] | (v[2] << 16); w.y = v[1] | (v[0] << 16); *(u32x2*)(fch + i0) = w;
          }
        }
      }
    }
    if (sub == 0) {
      const int c = cch * 64 + lane, o = dir * 1024 + c;
#pragma unroll 1
      for (int set = 0; set < 2; ++set) {
        const int L = set ? 2048 : 256, row0 = set ? 256 : 0;
        bf16_t* fch = FILT + ((size_t)(j * 1024 + c)) * FILT_CH + (set ? 528 : 0) + L + 8;
        if (!dir) {
          const float* h0r = HD + ((size_t)j * 2304 + row0) * 64;
          float a = p.hy_b3[j * 2048 + o];
#pragma unroll 8
          for (int m = 0; m < 64; ++m) a += h0r[m] * w3s[m * 64 + lane];
          fch[0] = (bf16_t)f2bf_(a + p.hy_skip[j * D + c]);
        } else {
          *(u32x4*)(fch + L) = (u32x4){0u, 0u, 0u, 0u};
        }
      }
    }
  }
#endif
}
constexpr int FK_S = 0, FK_P = 65920, VBS = 74368, VBP = 91776, VB_END = 118400, E_OFF = 118400, SCR_S = 0, SCR_P = 65536;
__device__ __forceinline__ float conv3e(float pv, float cur, float nx, float w0, float w1, float w2, float b) { return pv * w0 + cur * w1 + nx * w2 + b; }

__device__ __forceinline__ void phase_hy_conv(const LAS PG& p, unsigned char* ws, LAS unsigned char* lds, int j, int tid, int lane, int wave, int bid, int G) {
  const bf16_t* UT = (const bf16_t*)(ws + M_UT);
  bf16_t* GT = (bf16_t*)(ws + M_GB);
  const bf16_t* FILT = (const bf16_t*)(ws + M_FILT);
  const int r = lane & 31, h = lane >> 5, rho = (-r) & 7;
  u32x4 fX0[2], fX1[2], fXV[2], fXZ[2]; unsigned fP[2][3], fN[2][3]; u32x4 fLo[2], fHi[2];
#define HC_FETCH(CH) do { const int c_ = (CH); \
    _Pragma("unroll") for (int u_ = 0; u_ < 2; ++u_) { const int tok_ = (tid + 512 * u_) * 8; \
      const int l_ = (tok_ < NPT) ? (tok_ & 255) : ((tok_ - NPT) & 2047); const int L_ = (tok_ < NPT) ? 256 : 2048; \
      const bf16_t* r0_ = UT + (size_t)c_ * 8192 + tok_; const bf16_t* r1_ = r0_ + (size_t)1024 * 8192; const bf16_t* r2_ = r0_ + (size_t)2048 * 8192; const bf16_t* r3_ = r0_ + (size_t)3072 * 8192; \
      fX0[u_] = *(const u32x4*)r0_; fX1[u_] = *(const u32x4*)r1_; fXV[u_] = *(const u32x4*)r2_; fXZ[u_] = *(const u32x4*)r3_; \
      const bool hp_ = l_ > 0, hn_ = (l_ + 8) < L_; \
      fP[u_][0] = hp_ ? (unsigned)r0_[-1] : 0u; fP[u_][1] = hp_ ? (unsigned)r1_[-1] : 0u; fP[u_][2] = hp_ ? (unsigned)r2_[-1] : 0u; \
      fN[u_][0] = hn_ ? (unsigned)r0_[8] : 0u; fN[u_][1] = hn_ ? (unsigned)r1_[8] : 0u; fN[u_][2] = hn_ ? (unsigned)r2_[8] : 0u; } \
    const bf16_t* Rc_ = FILT + ((size_t)(j * 1024 + c_)) * FILT_CH; \
    _Pragma("unroll") for (int u_ = 0; u_ < 2; ++u_) { const int gi_ = tid + 512 * u_; fLo[u_] = (u32x4){0u, 0u, 0u, 0u}; fHi[u_] = fLo[u_]; \
      if (gi_ < 515 + 66) { const bool smp_ = gi_ < 515; const int gq_ = smp_ ? gi_ : gi_ - 515; const int LEN_ = smp_ ? 4112 : 528; const bf16_t* Rg_ = Rc_ + (smp_ ? 528 : 0); const int idx0_ = 8 * gq_ + 8; \
        if (idx0_ + 8 <= LEN_) fLo[u_] = *(const u32x4*)(Rg_ + idx0_); if (idx0_ + 16 <= LEN_) fHi[u_] = *(const u32x4*)(Rg_ + idx0_ + 8); } } } while (0)
  if (bid < 1024) HC_FETCH(bid);
  for (int c = bid; c < 1024; c += G) {
    __syncthreads();
    for (int i = tid; i < (VB_END - VBS) / 16; i += 512) *(LAS u32x4*)(lds + VBS + i * 16) = (u32x4){0u, 0u, 0u, 0u};
    __syncthreads();
    {
      const GASF* cw = p.hy_conv_w + (size_t)j * 3 * 3072; const GASF* cb = p.hy_conv_b + (size_t)j * 3072;
      const float a0 = cw[c], a1 = cw[3072 + c], a2 = cw[6144 + c], ab = cb[c];
      const float b0 = cw[1024 + c], b1 = cw[3072 + 1024 + c], b2 = cw[6144 + 1024 + c], bb = cb[1024 + c];
      const float v0 = cw[2048 + c], v1 = cw[3072 + 2048 + c], v2 = cw[6144 + 2048 + c], vbb = cb[2048 + c];
#pragma unroll
      for (int u = 0; u < 2; ++u) {
        const int tok = (tid + 512 * u) * 8;
        unsigned dst;
        if (tok < NPT) { const int l = tok & 255; const int chunk = 32 + (l >> 3); dst = VBP + (tok >> 8) * 1664 + (chunk + (chunk >> 4)) * 16; }
        else { const int mm = tok - NPT; const int l = mm & 2047; const int chunk = 128 + (l >> 3); dst = VBS + (mm >> 11) * 8704 + (chunk + (chunk >> 4)) * 16; }
        const u32x4 X0 = fX0[u], X1 = fX1[u], XV = fXV[u], XZ = fXZ[u];
        float x0[10], x1[10], xv[10], z[8];
        x0[0] = bf2f(fP[u][0]); x1[0] = bf2f(fP[u][1]); xv[0] = bf2f(fP[u][2]); x0[9] = bf2f(fN[u][0]); x1[9] = bf2f(fN[u][1]); xv[9] = bf2f(fN[u][2]);
#pragma unroll
        for (int e = 0; e < 4; ++e) {
          x0[1 + 2 * e] = bf2f(X0[e] & 0xffffu); x0[2 + 2 * e] = bf2f(X0[e] >> 16);
          x1[1 + 2 * e] = bf2f(X1[e] & 0xffffu); x1[2 + 2 * e] = bf2f(X1[e] >> 16);
          xv[1 + 2 * e] = bf2f(XV[e] & 0xffffu); xv[2 + 2 * e] = bf2f(XV[e] >> 16);
          z[2 * e] = bf2f(XZ[e] & 0xffffu); z[2 * e + 1] = bf2f(XZ[e] >> 16);
        }
        float vv[8], ev[8];
#pragma unroll
        for (int e = 0; e < 8; ++e) {
          const float c0 = conv3e(x0[e], x0[e + 1], x0[e + 2], a0, a1, a2, ab);
          const float c1 = conv3e(x1[e], x1[e + 1], x1[e + 2], b0, b1, b2, bb);
          const float cv = conv3e(xv[e], xv[e + 1], xv[e + 2], v0, v1, v2, vbb);
          vv[e] = cv * c1; ev[e] = c0 * (z[e] * __builtin_amdgcn_rcpf(1.f + __expf(-z[e])));
        }
        u32x4 o; o.x = pk2_(vv[0], vv[1]); o.y = pk2_(vv[2], vv[3]); o.z = pk2_(vv[4], vv[5]); o.w = pk2_(vv[6], vv[7]);
        *(LAS u32x4*)(lds + dst) = o;
        *(LAS f32x4*)(lds + E_OFF + tok * 4) = (f32x4){ev[0], ev[1], ev[2], ev[3]};
        *(LAS f32x4*)(lds + E_OFF + tok * 4 + 16) = (f32x4){ev[4], ev[5], ev[6], ev[7]};
      }
#pragma unroll
      for (int u = 0; u < 2; ++u) {
        const int gi = tid + 512 * u;
        if (gi < 515 + 66) {
          const bool smp = gi < 515; const int gq = smp ? gi : gi - 515;
          const u32x4 lo = fLo[u], hi = fHi[u];
          const unsigned d0 = lo.x, d1 = lo.y, d2 = lo.z, d3 = lo.w, d4 = hi.x, d5 = hi.y, d6 = hi.z, d7 = hi.w;
          LAS unsigned char* dstp = lds + (smp ? FK_S : FK_P) + gq * 128;
#define AB(hi_, lo_) __builtin_amdgcn_alignbit(hi_, lo_, 16)
          *(LAS u32x4*)(dstp + 0) = (u32x4){d0, d1, d2, d3};
          *(LAS u32x4*)(dstp + 16) = (u32x4){AB(d1, d0), AB(d2, d1), AB(d3, d2), AB(d4, d3)};
          *(LAS u32x4*)(dstp + 32) = (u32x4){d1, d2, d3, d4};
          *(LAS u32x4*)(dstp + 48) = (u32x4){AB(d2, d1), AB(d3, d2), AB(d4, d3), AB(d5, d4)};
          *(LAS u32x4*)(dstp + 64) = (u32x4){d2, d3, d4, d5};
          *(LAS u32x4*)(dstp + 80) = (u32x4){AB(d3, d2), AB(d4, d3), AB(d5, d4), AB(d6, d5)};
          *(LAS u32x4*)(dstp + 96) = (u32x4){d3, d4, d5, d6};
          *(LAS u32x4*)(dstp + 112) = (u32x4){AB(d4, d3), AB(d5, d4), AB(d6, d5), AB(d7, d6)};
#undef AB
        }
      }
    }
    __syncthreads();
    if (c + G < 1024) HC_FETCH(c + G);
    f32x16 s0, s1, pr;
#pragma unroll
    for (int i = 0; i < 16; ++i) { s0[i] = 0.f; s1[i] = 0.f; pr[i] = 0.f; }
    {
      const int ahalf = wave & 1, dq = wave >> 1;
      const int a = ahalf * 32 + r;
      const int n0 = (ahalf ? -64 : -128) + 48 * dq, cnt = (dq == 3) ? 47 : 48;
      for (int s = 0; s < cnt; ++s) {
        const int n = n0 + s;
        const int e0 = 8 * h - r - 16 * n; const int q = (e0 - rho) >> 3;
        const bf16x8 af = *(LAS const bf16x8*)(lds + FK_S + ((q + 256) * 8 + rho) * 16);
        const int qb = 128 + h + 4 * a - 2 * n; const int pb = qb + (qb >> 4);
        const bf16x8 b0 = *(LAS const bf16x8*)(lds + VBS + pb * 16);
        const bf16x8 b1 = *(LAS const bf16x8*)(lds + VBS + 8704 + pb * 16);
        s0 = __builtin_amdgcn_mfma_f32_32x32x16_bf16(af, b0, s0, 0, 0, 0);
        s1 = __builtin_amdgcn_mfma_f32_32x32x16_bf16(af, b1, s1, 0, 0, 0);
      }
    }
    {
      const int ntile = wave & 3, dh = wave >> 2;
      const int batch = 4 * ntile + (r >> 3), a = r & 7;
      const int n0 = dh ? 0 : -16, cnt = dh ? 15 : 16;
      for (int s = 0; s < cnt; ++s) {
        const int n = n0 + s;
        const int e0 = 8 * h - r - 16 * n; const int q = (e0 - rho) >> 3;
        const bf16x8 af = *(LAS const bf16x8*)(lds + FK_P + ((q + 32) * 8 + rho) * 16);
        const int qb = 32 + h + 4 * a - 2 * n; const int pb = qb + (qb >> 4);
        const bf16x8 b0 = *(LAS const bf16x8*)(lds + VBP + batch * 1664 + pb * 16);
        pr = __builtin_amdgcn_mfma_f32_32x32x16_bf16(af, b0, pr, 0, 0, 0);
      }
    }
    __syncthreads();
    {
      const int ahalf = wave & 1, dq = wave >> 1;
#pragma unroll
      for (int g = 0; g < 4; ++g) {
        const int off = (r * 32 + 8 * g + 4 * h) * 4;
        *(LAS f32x4*)(lds + SCR_S + (((ahalf * 2 + 0) * 4 + dq) * 1024) * 4 + off) = (f32x4){s0[4 * g], s0[4 * g + 1], s0[4 * g + 2], s0[4 * g + 3]};
        *(LAS f32x4*)(lds + SCR_S + (((ahalf * 2 + 1) * 4 + dq) * 1024) * 4 + off) = (f32x4){s1[4 * g], s1[4 * g + 1], s1[4 * g + 2], s1[4 * g + 3]};
        *(LAS f32x4*)(lds + SCR_P + (((wave & 3) * 2 + (wave >> 2)) * 1024) * 4 + off) = (f32x4){pr[4 * g], pr[4 * g + 1], pr[4 * g + 2], pr[4 * g + 3]};
      }
    }
    __syncthreads();
    {
      {
        const int o = tid * 8; const int b = o >> 11, t = o & 2047; const int a = t >> 5, rr = t & 31; const int tile = (a >> 5) * 2 + b, col = a & 31;
        f32x4 y0 = (f32x4){0.f, 0.f, 0.f, 0.f}, y1 = y0;
#pragma unroll
        for (int dq = 0; dq < 4; ++dq) {
          LAS const unsigned char* sp = lds + SCR_S + (((tile * 4 + dq) * 1024) + col * 32 + rr) * 4;
          y0 += *(LAS const f32x4*)sp; y1 += *(LAS const f32x4*)(sp + 16);
        }
        const int token = NPT + o;
        const f32x4 e0 = *(LAS const f32x4*)(lds + E_OFF + token * 4), e1 = *(LAS const f32x4*)(lds + E_OFF + token * 4 + 16);
        u32x4 ov; ov.x = pk2_(y0.x * e0.x, y0.y * e0.y); ov.y = pk2_(y0.z * e0.z, y0.w * e0.w); ov.z = pk2_(y1.x * e1.x, y1.y * e1.y); ov.w = pk2_(y1.z * e1.z, y1.w * e1.w);
        *(u32x4*)(GT + (size_t)c * 8192 + token) = ov;
      }
      {
        const int o = tid * 8; const int batch = o >> 8, t = o & 255; const int ntile = batch >> 2, col = (batch & 3) * 8 + (t >> 5), rr = t & 31;
        f32x4 y0 = (f32x4){0.f, 0.f, 0.f, 0.f}, y1 = y0;
#pragma unroll
        for (int dh = 0; dh < 2; ++dh) {
          LAS const unsigned char* sp = lds + SCR_P + (((ntile * 2 + dh) * 1024) + col * 32 + rr) * 4;
          y0 += *(LAS const f32x4*)sp; y1 += *(LAS const f32x4*)(sp + 16);
        }
        const int token = o;
        const f32x4 e0 = *(LAS const f32x4*)(lds + E_OFF + token * 4), e1 = *(LAS const f32x4*)(lds + E_OFF + token * 4 + 16);
        u32x4 ov; ov.x = pk2_(y0.x * e0.x, y0.y * e0.y); ov.y = pk2_(y0.z * e0.z, y0.w * e0.w); ov.z = pk2_(y1.x * e1.x, y1.y * e1.y); ov.w = pk2_(y1.z * e1.z, y1.w * e1.w);
        *(u32x4*)(GT + (size_t)c * 8192 + token) = ov;
      }
    }
  }
}

template <int MODE>
__device__ __forceinline__ void phase_out_ln(const LAS PG& p, unsigned char* ws, LAS unsigned char* lds, int layer, const bf16_t* Wf, int tid, int lane, int wave, int bid, int G) {
  const bf16_t* GA = (const bf16_t*)(ws + M_GB);
  const float* MODS = (const float*)(ws + M_MODS);
  const int h = lane >> 5;
  for (int tile = bid; tile < NTOK / 32; tile += G) {
    const int t0 = tile * 32;
    __syncthreads();
    constexpr bool CHM = (MODE == 1);
    if (MODE == 2) {
      const float* BON = (const float*)(ws + M_GB + 8 * MiB);
      const int sub = lane >> 4, c4 = lane & 15;
#pragma unroll 2
      for (int it = 0; it < 16; ++it) {
        const int pr = wave * 64 + it * 4 + sub; const int tok = pr >> 4, hd = pr & 15, m = t0 + tok;
        const unsigned gi = (unsigned)m * (unsigned)D + (unsigned)(hd * 64 + 4 * c4);
        const f32x4 y = *(const f32x4*)((const float*)(ws + M_UT) + gi) + *(const f32x4*)((const float*)(ws + M_UT + 32 * MiB) + gi);
        float s1 = (y.x + y.y) + (y.z + y.w);
        s1 += __builtin_bit_cast(float, __builtin_amdgcn_update_dpp(0, __builtin_bit_cast(int, s1), 0xB1, 0xF, 0xF, true));
        s1 += __builtin_bit_cast(float, __builtin_amdgcn_update_dpp(0, __builtin_bit_cast(int, s1), 0x4E, 0xF, 0xF, true));
        s1 += __builtin_bit_cast(float, __builtin_amdgcn_update_dpp(0, __builtin_bit_cast(int, s1), 0x141, 0xF, 0xF, true));
        s1 += __builtin_bit_cast(float, __builtin_amdgcn_update_dpp(0, __builtin_bit_cast(int, s1), 0x140, 0xF, 0xF, true));
        const float mu = s1 * (1.f / 64.f);
        const f32x4 d = y - mu;
        float s2 = (d.x * d.x + d.y * d.y) + (d.z * d.z + d.w * d.w);
        s2 += __builtin_bit_cast(float, __builtin_amdgcn_update_dpp(0, __builtin_bit_cast(int, s2), 0xB1, 0xF, 0xF, true));
        s2 += __builtin_bit_cast(float, __builtin_amdgcn_update_dpp(0, __builtin_bit_cast(int, s2), 0x4E, 0xF, 0xF, true));
        s2 += __builtin_bit_cast(float, __builtin_amdgcn_update_dpp(0, __builtin_bit_cast(int, s2), 0x141, 0xF, 0xF, true));
        s2 += __builtin_bit_cast(float, __builtin_amdgcn_update_dpp(0, __builtin_bit_cast(int, s2), 0x140, 0xF, 0xF, true));
        const float rstd = rsqrtf(s2 * (1.f / 64.f) + GN_EPS);
        const f32x4 bo0 = *(const f32x4*)(BON + ((unsigned)m * 16u + (unsigned)hd) * 4u), bo1 = *(const f32x4*)(BON + (((unsigned)NTOK + (unsigned)m) * 16u + (unsigned)hd) * 4u);
        const float bon = ((bo0.x + bo0.y) + (bo0.z + bo0.w)) + ((bo1.x + bo1.y) + (bo1.z + bo1.w));
        const u32x2 v2 = *(const u32x2*)((const bf16_t*)(ws + M_SCR2 + 32 * MiB) + gi), z2 = *(const u32x2*)((const bf16_t*)(ws + M_SCR2 + 48 * MiB) + gi);
        const f32x4 gg = *(const GAS f32x4*)(p.rw_gn_g + hd * 64 + 4 * c4), gb = *(const GAS f32x4*)(p.rw_gn_b + hd * 64 + 4 * c4);
        const f32x4 yn = d * rstd * gg + gb;
        u32x2 o;
        o.x = pk2_((yn.x + bon * bf2f(v2.x & 0xffffu)) * bf2f(z2.x & 0xffffu), (yn.y + bon * bf2f(v2.x >> 16)) * bf2f(z2.x >> 16));
        o.y = pk2_((yn.z + bon * bf2f(v2.y & 0xffffu)) * bf2f(z2.y & 0xffffu), (yn.w + bon * bf2f(v2.y >> 16)) * bf2f(z2.y >> 16));
        *(LAS u32x2*)(lds + ((hd * 8 + (c4 >> 1)) * 32 + tok) * 16 + (c4 & 1) * 8) = o;
      }
    } else {
#pragma unroll
    for (int i = 0; i < 8; ++i) {
      const int idx = tid + 512 * i;
      if (CHM) { const int c = idx >> 2, part = idx & 3; *(LAS u32x4*)(lds + c * 64 + part * 16) = *(const u32x4*)(GA + (size_t)c * 8192 + t0 + 8 * part); }
      else { const int tok = idx >> 7, k8 = idx & 127; *(LAS u32x4*)(lds + (k8 * 32 + tok) * 16) = *(const u32x4*)(GA + (size_t)(t0 + tok) * D + 8 * k8); }
    }
    }
    __syncthreads();
    f32x16 acc[4];
#pragma unroll
    for (int nt = 0; nt < 4; ++nt)
#pragma unroll
      for (int i = 0; i < 16; ++i) acc[nt][i] = 0.f;
    const bf16_t* wf = Wf + ((size_t)(wave * 4) * 64 * 64 + lane) * 8;
    const int aoffT = ((h * 32) + (lane & 31)) * 16;
    const int aoffC = (8 * h + ((lane & 15) >> 2)) * 64 + 32 * ((lane >> 4) & 1) + 8 * (lane & 3);
#pragma unroll 4
    for (int ks = 0; ks < 64; ++ks) {
      bf16x8 af;
      if (CHM) {
        const v4i16_t lo = vtr(lds + aoffC + ks * 1024), hi = vtr(lds + aoffC + ks * 1024 + 256);
        af = (bf16x8){lo[0], lo[1], lo[2], lo[3], hi[0], hi[1], hi[2], hi[3]};
      } else {
        af = *(LAS const bf16x8*)(lds + aoffT + ks * 1024);
      }
#pragma unroll
      for (int nt = 0; nt < 4; ++nt) {
        const bf16x8 bfr = *(const bf16x8*)(wf + ((size_t)(nt * 64 + ks) * 64) * 8);
        acc[nt] = __builtin_amdgcn_mfma_f32_32x32x16_bf16(af, bfr, acc[nt], 0, 0, 0);
      }
    }
    __syncthreads();
#pragma unroll
    for (int nt = 0; nt < 4; ++nt)
#pragma unroll
      for (int i = 0; i < 16; ++i) {
        const int row = (i & 3) + 8 * (i >> 2) + 4 * h;
        *(LAS float*)(lds + (row * 1028 + (wave * 4 + nt) * 32 + (lane & 31)) * 4) = acc[nt][i];
      }
    __syncthreads();
#pragma unroll 1
    for (int i = 0; i < 4; ++i) {
      const int row = wave * 4 + i, m = t0 + row;
      int l, L, cond, m0; tokinfo(m, l, L, cond, m0);
      const float* gate = MODS + (size_t)(layer * 3 + cond) * 3072 + 2048;
      const GAS f32x4* xr = (const GAS f32x4*)xrow_in(p, layer, ws, m);
      f32x4 v[4]; float s = 0.f;
#pragma unroll
      for (int q = 0; q < 4; ++q) {
        const int k = 4 * lane + 256 * q;
        const f32x4 o = *(LAS const f32x4*)(lds + (row * 1028 + k) * 4);
        const f32x4 x = xr[lane + 64 * q]; const f32x4 g = *(const f32x4*)(gate + k);
        v[q] = ALPHA * x + g * o; s += (v[q].x + v[q].y) + (v[q].z + v[q].w);
      }
      const float mu = wsum(s) * (1.f / D); float qq = 0.f;
#pragma unroll
      for (int q = 0; q < 4; ++q) { v[q] = v[q] - mu; qq += (v[q].x * v[q].x + v[q].y * v[q].y) + (v[q].z * v[q].z + v[q].w * v[q].w); }
      const float rs = rsqrtf(wsum(qq) * (1.f / D) + LN_EPS);
      GASF* xo = (layer & 1) ? p.out + OUT_Y + (size_t)m * D : (GASF*)(ws + M_X) + (size_t)m * D;
      const float* nmod = MODS + (size_t)((layer + 1) * 3 + cond) * 3072;
      bf16_t* HB = (bf16_t*)(ws + M_HB) + (size_t)m * D;
#pragma unroll
      for (int q = 0; q < 4; ++q) {
        const int k = 4 * lane + 256 * q;
        const f32x4 lg = *(const f32x4*)(p.ln_g + layer * D + k), lb = *(const f32x4*)(p.ln_b + layer * D + k);
        const f32x4 y = v[q] * rs * lg + lb;
        *(GAS f32x4*)(xo + k) = y;
        if (layer < 3) {
          const f32x4 sh = *(const f32x4*)(nmod + k), sc = *(const f32x4*)(nmod + 1024 + k);
          u32x2 o; o.x = pk2_(y.x * (1.f + sc.x) + sh.x, y.y * (1.f + sc.y) + sh.y); o.y = pk2_(y.z * (1.f + sc.z) + sh.z, y.w * (1.f + sc.w) + sh.w);
          *(u32x2*)(HB + k) = o;
        }
      }
    }
  }
}

__device__ __forceinline__ int kvrow_(int m) { if (m < NPT) return m; const int mm = m - NPT; return NPT + (mm >> 11) * 2560 + PAST + (mm & 2047); }

struct EpiSilu {
  static constexpr bool PERM = true, AFTER_DRAIN = false;
  bf16_t* O; int ldc;
  __device__ __forceinline__ void operator()(const f32x4 (&acc)[2][2][4][2], const pg8::Unit& u, int wr, int wc, int fr, int fq) const {
    const int row0 = u.pm * 256 + wr * 64 + fr, col0 = u.pn * 256 + wc * 32 + 8 * fq;
#pragma unroll
    for (int ai = 0; ai < 2; ++ai)
#pragma unroll
      for (int m = 0; m < 4; ++m) {
        bf16_t* rowp = O + (size_t)(row0 + ai * 128 + m * 16) * ldc + col0;
#pragma unroll
        for (int bj = 0; bj < 2; ++bj) {
          const f32x4 v0 = acc[ai][bj][m][0], v1 = acc[ai][bj][m][1];
          u32x4 w; w.x = pk2_(silu(v0[0]), silu(v0[1])); w.y = pk2_(silu(v0[2]), silu(v0[3])); w.z = pk2_(silu(v1[0]), silu(v1[1])); w.w = pk2_(silu(v1[2]), silu(v1[3]));
          *(u32x4*)(rowp + bj * 128) = w;
        }
      }
  }
};
struct EpiF32 {
  static constexpr bool PERM = true, AFTER_DRAIN = false;
  float* O; int ldc;
  __device__ __forceinline__ void operator()(const f32x4 (&acc)[2][2][4][2], const pg8::Unit& u, int wr, int wc, int fr, int fq) const {
    const int row0 = u.pm * 256 + wr * 64 + fr, col0 = u.pn * 256 + wc * 32 + 8 * fq;
#pragma unroll
    for (int ai = 0; ai < 2; ++ai)
#pragma unroll
      for (int m = 0; m < 4; ++m) {
        float* rowp = O + (size_t)(row0 + ai * 128 + m * 16) * ldc + col0;
#pragma unroll
        for (int bj = 0; bj < 2; ++bj) { *(f32x4*)(rowp + bj * 128) = acc[ai][bj][m][0]; *(f32x4*)(rowp + bj * 128 + 4) = acc[ai][bj][m][1]; }
      }
  }
};
struct EpiKV {
  static constexpr bool PERM = true, AFTER_DRAIN = false;
  bf16_t* Kn; bf16_t* V;
  __device__ __forceinline__ void operator()(const f32x4 (&acc)[2][2][4][2], const pg8::Unit& u, int wr, int wc, int fr, int fq) const {
    const int row0 = u.pm * 256 + wr * 64 + fr;
    const int d = wc * 32 + 8 * fq;
    bf16_t* base = (d < 64 ? Kn : V) + (d & 63);
#pragma unroll
    for (int ai = 0; ai < 2; ++ai)
#pragma unroll
      for (int m = 0; m < 4; ++m) {
        const size_t row = (size_t)(row0 + ai * 128 + m * 16);
#pragma unroll
        for (int bj = 0; bj < 2; ++bj) {
          const int h = u.pn * 2 + bj;
          const f32x4 v0 = acc[ai][bj][m][0], v1 = acc[ai][bj][m][1];
          u32x4 w; w.x = pg8::cvt_pk_bf16(v0[0], v0[1]); w.y = pg8::cvt_pk_bf16(v0[2], v0[3]); w.z = pg8::cvt_pk_bf16(v1[0], v1[1]); w.w = pg8::cvt_pk_bf16(v1[2], v1[3]);
          *(u32x4*)(base + row * 1024 + h * 64) = w;
        }
      }
  }
};

__device__ __forceinline__ void phase_mla_rows(const LAS PG& p, unsigned char* ws, int lane, int wave, int bid, int G) {
  const float* U2S = (const float*)(ws + M_U2S);
  for (int m = bid * 8 + wave; m < NTOK; m += G * 8) {
    int l, L, cond, m0; tokinfo(m, l, L, cond, m0);
    const float* rb = U2S + (size_t)m * 512;
    const f32x4 q = *(const f32x4*)(rb + 4 * lane);
    const float rs = rsqrtf(wsum(q.x * q.x + q.y * q.y + q.z * q.z + q.w * q.w) * (1.f / 256.f) + RMS_EPS);
    const f32x4 g = *(const GAS f32x4*)(p.mla_q_norm + 4 * lane);
    u32x2 qo; qo.x = pk2_(q.x * rs * g.x, q.y * rs * g.y); qo.y = pk2_(q.z * rs * g.z, q.w * rs * g.w);
    *(u32x2*)((bf16_t*)(ws + M_QN) + (size_t)m * 256 + 4 * lane) = qo;
    const float k0 = rb[256 + 2 * lane], k1 = rb[256 + 2 * lane + 1];
    const float rs2 = rsqrtf(wsum(k0 * k0 + k1 * k1) * (1.f / 128.f) + RMS_EPS);
    const float c0 = k0 * rs2 * p.mla_kv_norm[2 * lane], c1 = k1 * rs2 * p.mla_kv_norm[2 * lane + 1];
    const int kr = kvrow_(m);
    *(unsigned*)((bf16_t*)(ws + M_CKVALL) + (size_t)kr * 128 + 2 * lane) = pk2_(c0, c1);
    if (m < NPT) { p.out[OUT_CKV + (size_t)m * 128 + 2 * lane] = c0; p.out[OUT_CKV + (size_t)m * 128 + 2 * lane + 1] = c1; }
    const float x = rb[384 + (lane & 31)];
    const float partner = __shfl_xor(x, 8);
    float o = x;
    if (m >= NPT) {
      const int d = lane & 31, jj = d & 7;
      const float inv = exp2f(-(float)(2 * jj) * (13.287712379549449f / 16.f));
      const float pos = (d < 16) ? (float)(l >> 6) : (float)(l & 63);
      const float ang = pos * inv; const float cs = cosf(ang), sn = sinf(ang);
      o = (d & 8) ? x * cs + partner * sn : x * cs - partner * sn;
    }
    if (lane < 32) {
      ((bf16_t*)(ws + M_KPEB))[(size_t)kr * 32 + lane] = (bf16_t)f2bf_(o);
      if (m < NPT) p.out[OUT_KPE + (size_t)m * 32 + lane] = x;
    }
  }
}

constexpr int AT_KB = 12288, AT_VB = 8192, AT_BUF = AT_KB + AT_VB, AT_WS = 2 * AT_BUF, AT_ST = AT_WS + 8 * 256;
__device__ __forceinline__ int crow_(int r, int hi) { return (r & 3) + 8 * (r >> 2) + 4 * hi; }
__device__ __forceinline__ unsigned cvtpk(float lo, float hi) { return pk2_(lo, hi); }

__device__ __forceinline__ void attn_unit(const unsigned char* ws, LAS unsigned char* lds, int seq, int hd, int qb, bf16_t* Gout, int tid, int lane, int wave) {
  const bf16_t* Q = (const bf16_t*)(ws + M_Q); const bf16_t* Kn = (const bf16_t*)(ws + M_KN); const bf16_t* Vv = (const bf16_t*)(ws + M_V);
  const bf16_t* KP = (const bf16_t*)(ws + M_KPEB); const bf16_t* SZ = (const bf16_t*)(ws + M_SZB);
  const int r32 = lane & 31, hi = lane >> 5;
  const bool smp = seq >= 16;
  const int mq0 = smp ? NPT + (seq - 16) * 2048 + qb * 256 : seq * 256;
  const int kbase = smp ? NPT + (seq - 16) * 2560 : seq * 256;
  const int NT = smp ? 40 : 4;
  const float C2 = 0.10206207261596575f * 1.4426950408889634f;
  bf16x8 qr[6];
  {
    const int m = mq0 + wave * 32 + r32;
    const bf16_t* qp = Q + (size_t)m * 1536 + hd * 96;
    const int l = smp ? ((m - NPT) & 2047) : 0;
#pragma unroll
    for (int d0 = 0; d0 < 6; ++d0) {
      const u32x4 own = *(const u32x4*)(qp + 16 * d0 + 8 * hi);
      float f[8];
#pragma unroll
      for (int e = 0; e < 4; ++e) { f[2 * e] = bf2f(own[e] & 0xffffu); f[2 * e + 1] = bf2f(own[e] >> 16); }
      if (d0 >= 4 && smp) {
        const u32x4 oth = *(const u32x4*)(qp + 16 * d0 + 8 * (1 - hi));
        const float pos = (d0 == 4) ? (float)(l >> 6) : (float)(l & 63);
#pragma unroll
        for (int e = 0; e < 8; ++e) {
          const float pf = bf2f((e & 1) ? (oth[e >> 1] >> 16) : (oth[e >> 1] & 0xffffu));
          const float inv = exp2f(-(float)(2 * e) * (13.287712379549449f / 16.f));
          const float ang = pos * inv; const float cs = cosf(ang), sn = sinf(ang);
          f[e] = hi ? f[e] * cs + pf * sn : f[e] * cs - pf * sn;
        }
      }
      u32x4 o; o.x = pk2_(f[0] * C2, f[1] * C2); o.y = pk2_(f[2] * C2, f[3] * C2); o.z = pk2_(f[4] * C2, f[5] * C2); o.w = pk2_(f[6] * C2, f[7] * C2);
      qr[d0] = __builtin_bit_cast(bf16x8, o);
    }
  }
  const bf16_t* vsrc = Vv + (size_t)(kbase + 16 * (wave & 3) + (lane >> 2)) * 1024 + hd * 64 + (wave >> 2) * 32 + (lane & 3) * 8;
  const int kc0 = tid >> 6, key0 = tid & 63;
  const bf16_t* ksrc0 = Kn + (size_t)(kbase + key0) * 1024 + hd * 64 + 8 * kc0;
  const bool k2 = tid < 256;
  const bf16_t* ksrc1 = KP + (size_t)(kbase + key0) * 32 + 8 * (tid >> 6);
  u32x4 rv, rk0, rk1 = (u32x4){0u, 0u, 0u, 0u};
#define AT_LOAD(t) do { rv = *(const u32x4*)(vsrc + (size_t)(t) * 64 * 1024); rk0 = *(const u32x4*)(ksrc0 + (size_t)(t) * 64 * 1024); if (k2) rk1 = *(const u32x4*)(ksrc1 + (size_t)(t) * 64 * 32); } while (0)
#define AT_STORE(b) do { LAS unsigned char* bb = lds + (b) * AT_BUF; *(LAS u32x4*)(bb + tid * 16) = rk0; if (k2) *(LAS u32x4*)(bb + 8192 + tid * 16) = rk1; *(LAS u32x4*)(bb + AT_KB + tid * 16) = rv; } while (0)
  __syncthreads();
  AT_LOAD(0); AT_STORE(0);
  __syncthreads();
  LAS float* wsf = (LAS float*)(lds + AT_WS + wave * 256);
  f32x16 o0, o1;
#pragma unroll
  for (int i = 0; i < 16; ++i) { o0[i] = 0.f; o1[i] = 0.f; }
  float mref = 0.f, lrun = 0.f;
  f32x16 negm;
#pragma unroll
  for (int i = 0; i < 16; ++i) negm[i] = 0.f;
  const int vboff = ((lane >> 4) & 1) * 32 + (lane & 3) * 8 + (4 * hi + ((lane & 15) >> 2)) * 64;
  for (int t = 0; t < NT; ++t) {
    const int cur = t & 1;
    if (t + 1 < NT) AT_LOAD(t + 1);
    LAS const unsigned char* kb = lds + cur * AT_BUF + hi * 1024 + r32 * 16;
    f32x16 p0 = negm, p1 = negm;
#pragma unroll
    for (int d0 = 0; d0 < 6; ++d0) {
      const bf16x8 a0 = *(LAS const bf16x8*)(kb + d0 * 2048), a1 = *(LAS const bf16x8*)(kb + d0 * 2048 + 512);
      p0 = __builtin_amdgcn_mfma_f32_32x32x16_bf16(a0, qr[d0], p0, 0, 0, 0);
      p1 = __builtin_amdgcn_mfma_f32_32x32x16_bf16(a1, qr[d0], p1, 0, 0, 0);
    }
    float rm = fmaxf(fmaxf(p0[0], p0[1]), fmaxf(p1[0], p1[1]));
#pragma unroll
    for (int i = 2; i < 16; i += 2) rm = fmaxf(rm, fmaxf(fmaxf(p0[i], p0[i + 1]), fmaxf(p1[i], p1[i + 1])));
    rm = fmaxf(rm, __shfl_xor(rm, 32));
    if (t == 0 || __any(rm > 8.f)) {
      const float dl = (t == 0) ? rm : fmaxf(rm, 0.f);
      mref += dl;
      const float alpha = __builtin_amdgcn_exp2f(-dl);
      lrun *= alpha;
#pragma unroll
      for (int i = 0; i < 16; ++i) { p0[i] -= dl; p1[i] -= dl; negm[i] = -mref; }
      if (hi == 0) wsf[r32] = alpha;
      asm volatile("s_waitcnt lgkmcnt(0)" ::: "memory");
#pragma unroll
      for (int i = 0; i < 16; ++i) { const float al = wsf[crow_(i, hi)]; o0[i] *= al; o1[i] *= al; }
    }
    float ps0 = 0.f, ps1 = 0.f;
#pragma unroll
    for (int i = 0; i < 16; ++i) { p0[i] = __builtin_amdgcn_exp2f(p0[i]); p1[i] = __builtin_amdgcn_exp2f(p1[i]); ps0 += p0[i]; ps1 += p1[i]; }
    lrun += ps0 + ps1;
    u32x4 w0, w1, w2, w3;
    w0.x = cvtpk(p0[0], p0[1]); w0.y = cvtpk(p0[2], p0[3]); w0.z = cvtpk(p0[4], p0[5]); w0.w = cvtpk(p0[6], p0[7]);
    w1.x = cvtpk(p0[8], p0[9]); w1.y = cvtpk(p0[10], p0[11]); w1.z = cvtpk(p0[12], p0[13]); w1.w = cvtpk(p0[14], p0[15]);
    w2.x = cvtpk(p1[0], p1[1]); w2.y = cvtpk(p1[2], p1[3]); w2.z = cvtpk(p1[4], p1[5]); w2.w = cvtpk(p1[6], p1[7]);
    w3.x = cvtpk(p1[8], p1[9]); w3.y = cvtpk(p1[10], p1[11]); w3.z = cvtpk(p1[12], p1[13]); w3.w = cvtpk(p1[14], p1[15]);
    const bf16x8 pa0 = __builtin_bit_cast(bf16x8, w0), pa1 = __builtin_bit_cast(bf16x8, w1), pa2 = __builtin_bit_cast(bf16x8, w2), pa3 = __builtin_bit_cast(bf16x8, w3);
    LAS const unsigned char* vb = lds + cur * AT_BUF + AT_KB + vboff;
#define AT_PV(O_, D0) do { \
      const v4i16_t l0 = vtr(vb + (D0) * 4096), h0 = vtr(vb + (D0) * 4096 + 512), l1 = vtr(vb + (D0) * 4096 + 1024), h1 = vtr(vb + (D0) * 4096 + 1024 + 512); \
      const v4i16_t l2 = vtr(vb + (D0) * 4096 + 2048), h2 = vtr(vb + (D0) * 4096 + 2048 + 512), l3 = vtr(vb + (D0) * 4096 + 3072), h3 = vtr(vb + (D0) * 4096 + 3072 + 512); \
      O_ = __builtin_amdgcn_mfma_f32_32x32x16_bf16(pa0, ((bf16x8){l0[0], l0[1], l0[2], l0[3], h0[0], h0[1], h0[2], h0[3]}), O_, 0, 0, 0); \
      O_ = __builtin_amdgcn_mfma_f32_32x32x16_bf16(pa1, ((bf16x8){l1[0], l1[1], l1[2], l1[3], h1[0], h1[1], h1[2], h1[3]}), O_, 0, 0, 0); \
      O_ = __builtin_amdgcn_mfma_f32_32x32x16_bf16(pa2, ((bf16x8){l2[0], l2[1], l2[2], l2[3], h2[0], h2[1], h2[2], h2[3]}), O_, 0, 0, 0); \
      O_ = __builtin_amdgcn_mfma_f32_32x32x16_bf16(pa3, ((bf16x8){l3[0], l3[1], l3[2], l3[3], h3[0], h3[1], h3[2], h3[3]}), O_, 0, 0, 0); } while (0)
    AT_PV(o0, 0); AT_PV(o1, 1);
#undef AT_PV
    if (t + 1 < NT) AT_STORE(cur ^ 1);
    __syncthreads();
  }
#undef AT_LOAD
#undef AT_STORE
  lrun += __shfl_xor(lrun, 32);
  if (hi == 0) wsf[32 + r32] = 1.f / lrun;
  asm volatile("s_waitcnt lgkmcnt(0)" ::: "memory");
  LAS bf16_t* stg = (LAS bf16_t*)(lds + AT_ST + wave * 4096);
#pragma unroll
  for (int i = 0; i < 16; ++i) {
    const int orow = crow_(i, hi); const float rl = wsf[32 + orow];
    stg[orow * 64 + r32] = (bf16_t)f2bf_(o0[i] * rl);
    stg[orow * 64 + 32 + r32] = (bf16_t)f2bf_(o1[i] * rl);
  }
  asm volatile("s_waitcnt lgkmcnt(0)" ::: "memory");
#pragma unroll
  for (int i = 0; i < 4; ++i) {
    const int row = i * 8 + (lane >> 3), ch = lane & 7;
    const u32x4 ov = *(LAS const u32x4*)(stg + row * 64 + ch * 8);
    const size_t gi = (size_t)(mq0 + wave * 32 + row) * D + hd * 64 + ch * 8;
    const u32x4 zv = *(const u32x4*)(SZ + gi);
    u32x4 res;
#pragma unroll
    for (int e = 0; e < 4; ++e) res[e] = pk2_(bf2f(ov[e] & 0xffffu) * bf2f(zv[e] & 0xffffu), bf2f(ov[e] >> 16) * bf2f(zv[e] >> 16));
    *(u32x4*)(Gout + gi) = res;
  }
}
constexpr size_t M_XMIX = M_UT;
constexpr size_t M_YF = M_UT, M_YB = M_UT + 32 * MiB;
constexpr size_t M_RB = M_SCR2, M_KB = M_SCR2 + 16 * MiB, M_VB = M_SCR2 + 32 * MiB, M_SZR = M_SCR2 + 48 * MiB;
constexpr size_t M_HWA = M_GB;
constexpr size_t M_BON = M_GB + 8 * MiB;

__device__ __forceinline__ void phase_rw_mix(const LAS PG& p, unsigned char* ws, int tid, int bid, int G) {
  const bf16_t* HB = (const bf16_t*)(ws + M_HB);
  bf16_t* XM = (bf16_t*)(ws + M_XMIX);
  for (int i = bid * 512 + tid; i < NTOK * 128; i += G * 512) {
    const int m = i >> 7, k8 = i & 127;
    int l, L, cond, m0; tokinfo(m, l, L, cond, m0);
    const u32x4 hc = *(const u32x4*)(HB + (size_t)m * D + 8 * k8);
    u32x4 hp = (u32x4){0u, 0u, 0u, 0u}, hn = hp;
    if (l > 0) hp = *(const u32x4*)(HB + (size_t)(m - 1) * D + 8 * k8);
    if (l < L - 1) hn = *(const u32x4*)(HB + (size_t)(m + 1) * D + 8 * k8);
    float h[8], d[8];
#pragma unroll
    for (int e = 0; e < 4; ++e) {
      h[2 * e] = bf2f(hc[e] & 0xffffu); h[2 * e + 1] = bf2f(hc[e] >> 16);
      d[2 * e] = 0.5f * (bf2f(hp[e] & 0xffffu) + bf2f(hn[e] & 0xffffu)) - h[2 * e];
      d[2 * e + 1] = 0.5f * (bf2f(hp[e] >> 16) + bf2f(hn[e] >> 16)) - h[2 * e + 1];
    }
#pragma unroll
    for (int q = 0; q < 4; ++q) {
      const int mi = (q == 0) ? 0 : (q == 1) ? 2 : (q == 2) ? 3 : 5;
      const f32x4 u0 = *(const f32x4*)(p.rw_mu + mi * D + 8 * k8), u1 = *(const f32x4*)(p.rw_mu + mi * D + 8 * k8 + 4);
      u32x4 o; o.x = pk2_(h[0] + d[0] * u0.x, h[1] + d[1] * u0.y); o.y = pk2_(h[2] + d[2] * u0.z, h[3] + d[3] * u0.w);
      o.z = pk2_(h[4] + d[4] * u1.x, h[5] + d[5] * u1.y); o.w = pk2_(h[6] + d[6] * u1.z, h[7] + d[7] * u1.w);
      *(u32x4*)(XM + (size_t)q * NTOK * D + (size_t)m * D + 8 * k8) = o;
    }
  }
}

__device__ __forceinline__ void rw_lora_tile(const LAS PG& p, unsigned char* ws, LAS unsigned char* lds, int tile, int tid, int lane, int wave) {
  const bf16_t* HB = (const bf16_t*)(ws + M_HB);
  const bf16_t* Wf = (const bf16_t*)(ws + W_LORA1);
  const int h = lane >> 5, t0 = tile * 32;
  __syncthreads();
#pragma unroll 2
  for (int i = 0; i < 8; ++i) {
    const int idx = tid + 512 * i; const int tok = idx >> 7, k8 = idx & 127; const int m = t0 + tok;
    int l, L, cond, m0; tokinfo(m, l, L, cond, m0);
    const u32x4 hc = *(const u32x4*)(HB + (size_t)m * D + 8 * k8);
    u32x4 hp = (u32x4){0u, 0u, 0u, 0u}, hn = hp;
    if (l > 0) hp = *(const u32x4*)(HB + (size_t)(m - 1) * D + 8 * k8);
    if (l < L - 1) hn = *(const u32x4*)(HB + (size_t)(m + 1) * D + 8 * k8);
    float hh[8], d[8];
#pragma unroll
    for (int e = 0; e < 4; ++e) {
      hh[2 * e] = bf2f(hc[e] & 0xffffu); hh[2 * e + 1] = bf2f(hc[e] >> 16);
      d[2 * e] = 0.5f * (bf2f(hp[e] & 0xffffu) + bf2f(hn[e] & 0xffffu)) - hh[2 * e];
      d[2 * e + 1] = 0.5f * (bf2f(hp[e] >> 16) + bf2f(hn[e] >> 16)) - hh[2 * e + 1];
    }
#pragma unroll
    for (int q = 0; q < 2; ++q) {
      const int mi = q ? 4 : 1;
      const f32x4 u0 = *(const f32x4*)(p.rw_mu + mi * D + 8 * k8), u1 = *(const f32x4*)(p.rw_mu + mi * D + 8 * k8 + 4);
      u32x4 o; o.x = pk2_(hh[0] + d[0] * u0.x, hh[1] + d[1] * u0.y); o.y = pk2_(hh[2] + d[2] * u0.z, hh[3] + d[3] * u0.w);
      o.z = pk2_(hh[4] + d[4] * u1.x, hh[5] + d[5] * u1.y); o.w = pk2_(hh[6] + d[6] * u1.z, hh[7] + d[7] * u1.w);
      *(LAS u32x4*)(lds + q * 65536 + (k8 * 32 + tok) * 16) = o;
    }
  }
  __syncthreads();
  f32x16 acc;
#pragma unroll
  for (int i = 0; i < 16; ++i) acc[i] = 0.f;
  const int aoff = (wave >> 2) * 65536 + ((h * 32) + (lane & 31)) * 16;
  const bf16_t* wf = Wf + ((size_t)wave * 64 * 64 + lane) * 8;
#pragma unroll 16
  for (int ks = 0; ks < 64; ++ks) {
    const bf16x8 af = *(LAS const bf16x8*)(lds + aoff + ks * 1024);
    const bf16x8 b0 = *(const bf16x8*)(wf + ((size_t)ks * 64) * 8);
    acc = __builtin_amdgcn_mfma_f32_32x32x16_bf16(af, b0, acc, 0, 0, 0);
  }
  bf16_t* HWA = (bf16_t*)(ws + M_HWA);
#pragma unroll
  for (int i = 0; i < 16; ++i) {
    const int row = (i & 3) + 8 * (i >> 2) + 4 * h;
    const float v = (wave < 4) ? tanhf(acc[i]) : acc[i];
    HWA[(size_t)(t0 + row) * 256 + wave * 32 + (lane & 31)] = (bf16_t)f2bf_(v);
  }
}

#define DPP_ADD(v, CTRL) ((v) + __builtin_bit_cast(float, __builtin_amdgcn_mov_dpp(__builtin_bit_cast(int, (v)), (CTRL), 0xF, 0xF, true)))
__device__ __forceinline__ float allred4(float v) { v = DPP_ADD(v, 0xB1); v = DPP_ADD(v, 0x4E); return v; }
__device__ __forceinline__ float allred16(float v) { v = DPP_ADD(v, 0xB1); v = DPP_ADD(v, 0x4E); v = DPP_ADD(v, 0x141); v = DPP_ADD(v, 0x140); return v; }

__device__ __forceinline__ float fma_s(float a, float b, float c) { float d; asm("v_fma_f32 %0, %1, %2, %3" : "=v"(d) : "v"(a), "v"(b), "v"(c)); return d; }
__device__ __forceinline__ float mul_s(float a, float b) { float d; asm("v_mul_f32_e32 %0, %1, %2" : "=v"(d) : "v"(a), "v"(b)); return d; }
__device__ __forceinline__ float add_s(float a, float b) { float d; asm("v_add_f32_e32 %0, %1, %2" : "=v"(d) : "v"(a), "v"(b)); return d; }
#define DPPADD_(NAME, CTRL) __device__ __forceinline__ float NAME(float s) { float d; asm("s_nop 1\n\tv_add_f32_dpp %0, %1, %1 " CTRL " row_mask:0xf bank_mask:0xf bound_ctrl:1" : "=v"(d) : "v"(s)); return d; }
DPPADD_(dpp_x1, "quad_perm:[1,0,3,2]")
DPPADD_(dpp_x2, "quad_perm:[2,3,0,1]")
DPPADD_(dpp_hm, "row_half_mirror")
DPPADD_(dpp_rm, "row_mirror")
__device__ __forceinline__ float ar4(float v) { return dpp_x2(dpp_x1(v)); }
__device__ __forceinline__ float ar16(float v) { return dpp_rm(dpp_hm(dpp_x2(dpp_x1(v)))); }
__device__ __forceinline__ float dot4_s(const f32x4& s, const f32x4& a) { return add_s(fma_s(s.y, a.y, mul_s(s.x, a.x)), fma_s(s.w, a.w, mul_s(s.z, a.z))); }
__device__ __forceinline__ void upd4_s(f32x4& s, const f32x4& w, const f32x4& b, const f32x4& k, float sa, float vi) {
  s.x = fma_s(s.x, w.x, fma_s(sa, b.x, mul_s(vi, k.x))); s.y = fma_s(s.y, w.y, fma_s(sa, b.y, mul_s(vi, k.y)));
  s.z = fma_s(s.z, w.z, fma_s(sa, b.z, mul_s(vi, k.z))); s.w = fma_s(s.w, w.w, fma_s(sa, b.w, mul_s(vi, k.w)));
}
constexpr int PB_BYTES = 24832;
constexpr int SC_PS0 = 0, SC_PP0 = 2 * PB_BYTES;

constexpr int SC_FR = 4 * PB_BYTES;
__device__ __forceinline__ u32x4 ld_bfrag(const GASF* W2, int ks, int lane) {
  const int k0 = 32 * ks + 8 * (lane >> 4);
  u32x4 o; o.x = pk2_(W2[(size_t)(k0 + 0) * D], W2[(size_t)(k0 + 1) * D]); o.y = pk2_(W2[(size_t)(k0 + 2) * D], W2[(size_t)(k0 + 3) * D]);
  o.z = pk2_(W2[(size_t)(k0 + 4) * D], W2[(size_t)(k0 + 5) * D]); o.w = pk2_(W2[(size_t)(k0 + 6) * D], W2[(size_t)(k0 + 7) * D]);
  return o;
}
struct ChId { int dir, hd, m0, L, froff; };
__device__ __forceinline__ ChId chid(int slot, int seq, int dir, int hd, int lane, int ntile) {
  ChId c; c.dir = dir; c.hd = hd; c.L = seq < 16 ? 256 : 2048; c.m0 = seq < 16 ? seq * 256 : NPT + (seq - 16) * 2048;
  c.froff = SC_FR + ((slot * 4 + ntile) * 6) * 1024 + lane * 16; return c;
}
__device__ __forceinline__ void prepc_load(const LAS PG& p, LAS unsigned char* lds, int froff, int dir, int hd, int lane, int ntile) {
  const int ch = hd * 64 + 16 * ntile + (lane & 15);
  const GASF* W2 = p.rw_w2 + (size_t)dir * 64 * D + ch; const GASF* A2 = p.rw_a2 + (size_t)dir * 64 * D + ch;
  *(LAS u32x4*)(lds + froff) = ld_bfrag(W2, 0, lane); __builtin_amdgcn_sched_barrier(0);
  *(LAS u32x4*)(lds + froff + 1024) = ld_bfrag(W2, 1, lane); __builtin_amdgcn_sched_barrier(0);
  *(LAS u32x4*)(lds + froff + 2048) = ld_bfrag(A2, 0, lane); __builtin_amdgcn_sched_barrier(0);
  *(LAS u32x4*)(lds + froff + 3072) = ld_bfrag(A2, 1, lane); __builtin_amdgcn_sched_barrier(0);
  LAS float* cn = (LAS float*)(lds + (froff - lane * 16) + 4096) + lane;
  cn[0] = p.rw_w0[dir * D + ch]; cn[64] = p.rw_a0[dir * D + ch]; cn[128] = p.rw_k_k[ch]; cn[192] = p.rw_k_a[ch]; cn[256] = p.rw_r_k[ch];
}
struct PrepIn { u32x4 hw[2], ha[2]; unsigned kr[4], rr[4], vr[4]; };
__device__ __forceinline__ int ctok(int m0, int L, int dir, int step) { return m0 + (dir ? (L - 1 - step) : step); }
__device__ __forceinline__ void prep_fetch(const unsigned char* ws, int c_m0, int c_L, int c_dir, int c_hd, int s0, int lane, int ntile, PrepIn& in) {
  const bf16_t* HWA = (const bf16_t*)(ws + M_HWA);
  const int m = ctok(c_m0, c_L, c_dir, s0 + (lane & 15));
  const bf16_t* src = HWA + (size_t)m * 256 + c_dir * 64 + 8 * (lane >> 4);
  in.hw[0] = *(const u32x4*)(src); in.hw[1] = *(const u32x4*)(src + 32);
  in.ha[0] = *(const u32x4*)(src + 128); in.ha[1] = *(const u32x4*)(src + 160);
#pragma unroll
  for (int r = 0; r < 4; ++r) {
    const int mt = ctok(c_m0, c_L, c_dir, s0 + 4 * (lane >> 4) + r);
    const size_t gi = (size_t)mt * D + c_hd * 64 + 16 * ntile + (lane & 15);
    in.kr[r] = ((const bf16_t*)(ws + M_KB))[gi]; in.rr[r] = ((const bf16_t*)(ws + M_RB))[gi]; in.vr[r] = ((const bf16_t*)(ws + M_VB))[gi];
  }
}
__device__ __forceinline__ bf16x8 pack8(const f32x4& a, const f32x4& b) { u32x4 o; o.x = pk2_(a.x, a.y); o.y = pk2_(a.z, a.w); o.z = pk2_(b.x, b.y); o.w = pk2_(b.z, b.w); return __builtin_bit_cast(bf16x8, o); }
__device__ __forceinline__ void prep_finish(unsigned char* ws, LAS unsigned char* lds, int c_m0, int c_L, int c_dir, int c_hd, int c_froff, int s0, int pboff, int lane, int ntile, const PrepIn& in) {
  LAS const float* cn = (LAS const float*)(lds + (c_froff - lane * 16) + 4096) + lane;
  const float c_biasw = cn[0], c_biasa = cn[64], c_kkc = cn[128], c_kac = cn[192], c_rkc = cn[256];
  f32x4 aw = (f32x4){c_biasw, c_biasw, c_biasw, c_biasw}, aa = (f32x4){c_biasa, c_biasa, c_biasa, c_biasa};
  aw = __builtin_amdgcn_mfma_f32_16x16x32_bf16(__builtin_bit_cast(bf16x8, in.hw[0]), *(LAS const bf16x8*)(lds + c_froff), aw, 0, 0, 0);
  aw = __builtin_amdgcn_mfma_f32_16x16x32_bf16(__builtin_bit_cast(bf16x8, in.hw[1]), *(LAS const bf16x8*)(lds + c_froff + 1024), aw, 0, 0, 0);
  aa = __builtin_amdgcn_mfma_f32_16x16x32_bf16(__builtin_bit_cast(bf16x8, in.ha[0]), *(LAS const bf16x8*)(lds + c_froff + 2048), aa, 0, 0, 0);
  aa = __builtin_amdgcn_mfma_f32_16x16x32_bf16(__builtin_bit_cast(bf16x8, in.ha[1]), *(LAS const bf16x8*)(lds + c_froff + 3072), aa, 0, 0, 0);
  LAS float* pb = (LAS float*)(lds + pboff);
  const int col = lane & 15, rg = lane >> 4, chl = 16 * ntile + col;
#pragma unroll
  for (int r = 0; r < 4; ++r) {
    const int t = 4 * rg + r;
    const float sig = __builtin_amdgcn_rcpf(1.f + __expf(-aw[r]));
    const float dec = __expf(-0.6065306597126334f * sig);
    const float a = __builtin_amdgcn_rcpf(1.f + __expf(-aa[r]));
    const float k = bf2f(in.kr[r]), rv = bf2f(in.rr[r]), v = bf2f(in.vr[r]);
    const float kq = k * c_kkc;
    const float ssq = ar16(kq * kq);
    const float kd = k * (1.f + (a - 1.f) * c_kac);
    const float bon = ar16(rv * kd * c_rkc);
    pb[t * 64 + chl] = dec; pb[1024 + t * 64 + chl] = -kq; pb[2048 + t * 64 + chl] = kq * a; pb[3072 + t * 64 + chl] = kd; pb[4096 + t * 64 + chl] = rv; pb[5120 + t * 64 + chl] = v;
    if (col == 0) {
      pb[6144 + t * 4 + ntile] = ssq;
      const int mt = ctok(c_m0, c_L, c_dir, s0 + t);
      ((float*)(ws + M_BON))[(((size_t)c_dir * NTOK + mt) * 16 + c_hd) * 4 + ntile] = bon;
    }
  }
}

#define LDS_BARRIER() asm volatile("s_waitcnt lgkmcnt(0)\n\ts_barrier" ::: "memory")
__device__ __forceinline__ void phase_rw_scan(const LAS PG& p, unsigned char* ws, LAS unsigned char* lds, int tid, int lane, int wave, int bid, int G) {
  for (int item = bid; item < 256; item += G) {
    const int sc = item >> 2, qt = item & 3;
    const int s_seq = 16 + (sc >> 5), s_dir = (sc >> 4) & 1, s_hd = sc & 15, s_m0 = NPT + (s_seq - 16) * 2048;
    __syncthreads();
    if (wave < 4) {
      __builtin_amdgcn_s_setprio(2);
      float* Yo = (float*)(ws + (s_dir ? M_YB : M_YF));
      const int srow = 16 * qt + 4 * wave + (lane >> 4), scg = lane & 15;
      f32x4 Ss = *(const GAS f32x4*)(p.state_rwkv + ((((size_t)(s_seq - 16)) * 2 + s_dir) * 16 + s_hd) * 4096 + (size_t)srow * 64 + 4 * scg);
      __syncthreads();
      for (int c = 0; c < 128; ++c) {
        LAS const float* ps = (LAS const float*)(lds + SC_PS0 + (c & 1) * PB_BYTES);
        float rn2v;
        { const f32x4 q4 = *(LAS const f32x4*)(ps + 6144 + (lane & 15) * 4); rn2v = __builtin_amdgcn_rcpf((q4.x + q4.y) + (q4.z + q4.w) + 1e-12f); }
        float yk[16];
#pragma unroll
        for (int t = 0; t < 16; ++t) {
          const f32x4 w4 = *(LAS const f32x4*)(ps + t * 64 + 4 * scg), a4 = *(LAS const f32x4*)(ps + 1024 + t * 64 + 4 * scg);
          const f32x4 b4 = *(LAS const f32x4*)(ps + 2048 + t * 64 + 4 * scg), k4 = *(LAS const f32x4*)(ps + 3072 + t * 64 + 4 * scg);
          const f32x4 r4 = *(LAS const f32x4*)(ps + 4096 + t * 64 + 4 * scg);
          const float vi = ps[5120 + t * 64 + srow];
          const float rn2 = __builtin_bit_cast(float, __builtin_amdgcn_readlane(__builtin_bit_cast(int, rn2v), t));
          const float sa = ar16(dot4_s(Ss, a4)) * rn2;
          upd4_s(Ss, w4, b4, k4, sa, vi);
          yk[t] = ar16(dot4_s(Ss, r4));
        }
        if (scg == 0) {
          const int mfirst = ctok(s_m0, 2048, s_dir, 16 * c);
          float* yp = Yo + (size_t)mfirst * D + s_hd * 64 + srow;
          const long stride = s_dir ? -(long)D : (long)D;
#pragma unroll
          for (int t = 0; t < 16; ++t) yp[t * stride] = yk[t];
        }
        LDS_BARRIER();
      }
      __builtin_amdgcn_s_setprio(0);
    } else {
      const int nt = wave - 4;
      const int s_fr = SC_FR + ((0 * 4 + nt) * 6) * 1024 + lane * 16;
      prepc_load(p, lds, s_fr, s_dir, s_hd, lane, nt);
      int pc = 2 * item;
      const int q_fr = SC_FR + ((1 * 4 + nt) * 6) * 1024 + lane * 16;
      prepc_load(p, lds, q_fr, (pc >> 4) & 1, pc & 15, lane, nt);
      int r_seq = pc >> 5, r_dir = (pc >> 4) & 1, r_hd = pc & 15;
      int q_seq = pc >> 5, q_dir = (pc >> 4) & 1, q_hd = pc & 15;
      PrepIn in_s, in_p;
      prep_fetch(ws, s_m0, 2048, s_dir, s_hd, 0, lane, nt, in_s); prep_fetch(ws, r_seq * 256, 256, r_dir, r_hd, 0, lane, nt, in_p);
      prep_finish(ws, lds, s_m0, 2048, s_dir, s_hd, s_fr, 0, SC_PS0, lane, nt, in_s); prep_finish(ws, lds, r_seq * 256, 256, r_dir, r_hd, q_fr, 0, SC_PP0, lane, nt, in_p);
      const int prow = 16 * nt + (lane >> 2), pcq = lane & 3;
      f32x4 Sp0 = (f32x4){0.f, 0.f, 0.f, 0.f}, Sp1 = Sp0, Sp2 = Sp0, Sp3 = Sp0;
      __syncthreads();
      for (int c = 0; c < 128; ++c) {
        const bool more_s = (c + 1) < 128;
        const bool pgrp = ((c & 3) == 0) && (c + 4 < 128);
        if (more_s) prep_fetch(ws, s_m0, 2048, s_dir, s_hd, 16 * (c + 1), lane, nt, in_s);
        if (pgrp) {
          if (c == 60) { pc = 2 * item + 1; r_seq = pc >> 5; r_dir = (pc >> 4) & 1; r_hd = pc & 15; prepc_load(p, lds, q_fr, r_dir, r_hd, lane, nt); }
          prep_fetch(ws, r_seq * 256, 256, r_dir, r_hd, 4 * ((c + 4) & 63), lane, nt, in_p);
        }
        if (c == 64) { q_seq = r_seq; q_dir = r_dir; q_hd = r_hd; Sp0 = (f32x4){0.f, 0.f, 0.f, 0.f}; Sp1 = Sp0; Sp2 = Sp0; Sp3 = Sp0; }
        {
          LAS const float* pp = (LAS const float*)(lds + SC_PP0 + ((c >> 2) & 1) * PB_BYTES);
          float* Yp = (float*)(ws + (q_dir ? M_YB : M_YF));
          float rn2v;
          { const f32x4 q4 = *(LAS const f32x4*)(pp + 6144 + (lane & 15) * 4); rn2v = __builtin_amdgcn_rcpf((q4.x + q4.y) + (q4.z + q4.w) + 1e-12f); }
#pragma unroll 2
          for (int s = 0; s < 4; ++s) {
            const int t = 4 * (c & 3) + s;
            const float vi = pp[5120 + t * 64 + prow];
            const float rn2 = __builtin_bit_cast(float, __builtin_amdgcn_readlane(__builtin_bit_cast(int, rn2v), t));
            LAS const float* q = pp + t * 64 + 16 * pcq;
            const f32x4 a0 = *(LAS const f32x4*)(q + 1024), a1 = *(LAS const f32x4*)(q + 1028), a2 = *(LAS const f32x4*)(q + 1032), a3 = *(LAS const f32x4*)(q + 1036);
            const float sa = ar4(add_s(add_s(dot4_s(Sp0, a0), dot4_s(Sp1, a1)), add_s(dot4_s(Sp2, a2), dot4_s(Sp3, a3)))) * rn2;
            float y0, y1, y2, y3;
#define UP4(S_, O_, Y_) { const f32x4 w4 = *(LAS const f32x4*)(q + (O_)), b4 = *(LAS const f32x4*)(q + 2048 + (O_)), k4 = *(LAS const f32x4*)(q + 3072 + (O_)), r4 = *(LAS const f32x4*)(q + 4096 + (O_)); \
              upd4_s(S_, w4, b4, k4, sa, vi); Y_ = dot4_s(S_, r4); }
            UP4(Sp0, 0, y0) UP4(Sp1, 4, y1) UP4(Sp2, 8, y2) UP4(Sp3, 12, y3)
#undef UP4
            const float y = ar4(add_s(add_s(y0, y1), add_s(y2, y3)));
            if (pcq == 0) Yp[(size_t)ctok(q_seq * 256, 256, q_dir, 4 * (c & 63) + s) * D + q_hd * 64 + prow] = y;
          }
          if ((c & 63) == 63) {
            GASF* so = p.out + OUT_ST + ((((size_t)q_seq) * 2 + q_dir) * 16 + q_hd) * 4096 + (size_t)prow * 64 + 16 * pcq;
            *(GAS f32x4*)so = Sp0; *(GAS f32x4*)(so + 4) = Sp1; *(GAS f32x4*)(so + 8) = Sp2; *(GAS f32x4*)(so + 12) = Sp3;
          }
        }
        if (more_s) prep_finish(ws, lds, s_m0, 2048, s_dir, s_hd, s_fr, 16 * (c + 1), SC_PS0 + ((c + 1) & 1) * PB_BYTES, lane, nt, in_s);
        if (pgrp) prep_finish(ws, lds, r_seq * 256, 256, r_dir, r_hd, q_fr, 4 * ((c + 4) & 63), SC_PP0 + (((c >> 2) + 1) & 1) * PB_BYTES, lane, nt, in_p);
        LDS_BARRIER();
      }
    }
  }
}
constexpr int CK_OPS = 20992;
constexpr int CK_MX = 3 * CK_OPS;
constexpr int CK_SCR = CK_MX + 2 * 8192;
constexpr int CK_SSQ = CK_SCR + 6144;
constexpr int CK_FR = CK_SSQ + 1024;
constexpr int CK_IN = CK_FR + 4 * 6144;
constexpr int CK_INS = 20992;

__device__ __forceinline__ unsigned short bfr(float f) { return (unsigned short)f2bf_(f); }
__device__ __forceinline__ bf16x8 cvt8(const f32x16& a, int s) {
  u32x4 o; o.x = pk2_(a[8 * s + 0], a[8 * s + 1]); o.y = pk2_(a[8 * s + 2], a[8 * s + 3]); o.z = pk2_(a[8 * s + 4], a[8 * s + 5]); o.w = pk2_(a[8 * s + 6], a[8 * s + 7]);
  return __builtin_bit_cast(bf16x8, o);
}
__device__ __forceinline__ bf16x8 ldA_perm(LAS const unsigned char* base, int ld, int row, int k0, int hi) {
  const u32x2 lo = *(LAS const u32x2*)(base + (row * ld + k0 + 4 * hi) * 2), hh = *(LAS const u32x2*)(base + (row * ld + k0 + 8 + 4 * hi) * 2);
  u32x4 o; o.x = lo.x; o.y = lo.y; o.z = hh.x; o.w = hh.y; return __builtin_bit_cast(bf16x8, o);
}
__device__ __forceinline__ bf16x8 ldT_perm(LAS const unsigned char* base, int ld, int k0, int c0, int lane) {
  const int hi = lane >> 5;
  LAS const unsigned char* a = base + ((k0 + 4 * hi + ((lane & 15) >> 2)) * ld + c0 + 16 * ((lane >> 4) & 1) + 4 * (lane & 3)) * 2;
  const v4i16_t lo = vtr(a), hh = vtr(a + 8 * ld * 2);
  return (bf16x8){lo[0], lo[1], lo[2], lo[3], hh[0], hh[1], hh[2], hh[3]};
}
__device__ __forceinline__ bf16x8 ldT_nat(LAS const unsigned char* base, int ld, int k0, int c0, int lane) {
  const int hi = lane >> 5;
  LAS const unsigned char* a = base + ((k0 + 8 * hi + ((lane & 15) >> 2)) * ld + c0 + 16 * ((lane >> 4) & 1) + 4 * (lane & 3)) * 2;
  const v4i16_t lo = vtr(a), hh = vtr(a + 4 * ld * 2);
  return (bf16x8){lo[0], lo[1], lo[2], lo[3], hh[0], hh[1], hh[2], hh[3]};
}
__device__ __forceinline__ int opq5(int x) { asm volatile("" : "+v"(x)); return x; }
#define MFMA32(A_, B_, C_) __builtin_amdgcn_mfma_f32_32x32x16_bf16((A_), (B_), (C_), 0, 0, 0)

struct CkChain { int seq, dir, hd, m0, L, nch, kofs; };
__device__ __forceinline__ CkChain ck_chain(int id) {
  CkChain c;
  if (id < 64) { c.seq = 16 + (id >> 5); c.dir = (id >> 4) & 1; c.hd = id & 15; c.L = 2048; c.m0 = NPT + (c.seq - 16) * 2048; }
  else { const int p = id - 64; c.seq = p >> 5; c.dir = (p >> 4) & 1; c.hd = p & 15; c.L = 256; c.m0 = c.seq * 256; }
  c.nch = c.L / 32; c.kofs = 0; return c;
}

constexpr int CK_K0 = 40, CK_NREC = 24;
constexpr int CK_REC = 24832;
constexpr size_t M_REC = 0;
constexpr size_t CK_FLAGS = 32768;
__device__ __forceinline__ void ck_run_chain(const LAS PG& p, unsigned char* ws, LAS unsigned char* lds, const CkChain ch, int lane_in, int wave, const int mode, const int nprep, const int cidx) {
  const int lane = lane_in;
  const int hi = lane >> 5, r32 = lane & 31;
  float* Yo = (float*)(ws + (ch.dir ? M_YB : M_YF));
  const int NK = ch.nch + 3;
  const int sb0 = 32 * ch.kofs;
#define CK_PROD(ACC, AOFF, BOFF) do { _Pragma("unroll") for (int i_ = 0; i_ < 16; ++i_) ACC[i_] = 0.f; \
          _Pragma("unroll") for (int ks = 0; ks < 4; ++ks) { \
            const bf16x8 af_ = *(LAS const bf16x8*)(ob + (AOFF) + (r32 * 64 + 16 * ks + 8 * hi) * 2), bf_ = *(LAS const bf16x8*)(ob + (BOFF) + (r32 * 64 + 16 * ks + 8 * hi) * 2); \
            ACC = MFMA32(af_, bf_, ACC); } } while (0)
#define CK_STORE_T(ACC, DST, STRICT) do { _Pragma("unroll") for (int q_ = 0; q_ < 4; ++q_) { \
            float v_[4]; _Pragma("unroll") for (int x_ = 0; x_ < 4; ++x_) { const int s_ = 8 * q_ + 4 * hi + x_; const bool keep_ = (STRICT) ? (s_ < r32) : (s_ <= r32); v_[x_] = keep_ ? ACC[4 * q_ + x_] : 0.f; ACC[4 * q_ + x_] = v_[x_]; } \
            u32x2 w_; w_.x = pk2_(v_[0], v_[1]); w_.y = pk2_(v_[2], v_[3]); *(LAS u32x2*)((DST) + (r32 * 32 + 8 * q_ + 4 * hi) * 2) = w_; } } while (0)
#define CK_STORE_TN(ACC, DST) do { _Pragma("unroll") for (int q_ = 0; q_ < 4; ++q_) { u32x2 w_; w_.x = pk2_(ACC[4 * q_], ACC[4 * q_ + 1]); w_.y = pk2_(ACC[4 * q_ + 2], ACC[4 * q_ + 3]); \
            *(LAS u32x2*)((DST) + (r32 * 32 + 8 * q_ + 4 * hi) * 2) = w_; } } while (0)
  if (wave >= 4) {
    float rw_dec[8], rw_al[8], rw_kq[8], rw_kd[8], rw_r[8], rw_v[8];
    u32x4 cr[8];
#pragma unroll
    for (int i = 0; i < 8; ++i) cr[i] = (u32x4){0u, 0u, 0u, 0u};
    const int nt = wave - 4, col = lane & 15, g = lane >> 4;
    const int froff = CK_FR + nt * 6144 + lane * 16;
#pragma unroll
    for (int i = 0; i < 8; ++i) { rw_dec[i] = 1.f; rw_al[i] = 0.f; rw_kq[i] = 0.f; rw_kd[i] = 0.f; rw_r[i] = 0.f; rw_v[i] = 0.f; }
    prepc_load(p, lds, froff, ch.dir, ch.hd, lane, nt);
    const int pb_e = (4 * g * 64 + 16 * nt + col) * 2;
    const int pb_h = col * 272 + 16 * g;
    const int pb_sq = (16 * g) * 4, pb_sqw = (16 * g + nt) * 4;
    const int dstep = ch.dir ? -1 : 1;
    LDS_BARRIER();
    for (int k = 0; k < NK; ++k) {
      LAS const float* cn = (LAS const float*)(lds + (froff - lane * 16) + 4096) + lane;
      if (k >= 1 && k <= nprep) {
        LAS unsigned char* ob = lds + ((k - 1) % 3) * CK_OPS;
        LAS const float* sq = (LAS const float*)(lds + CK_SSQ + ((k - 1) & 1) * 512);
        float cp[8];
        cp[0] = rw_dec[0]; cp[1] = cp[0] * rw_dec[1]; cp[2] = cp[1] * rw_dec[2]; cp[3] = cp[2] * rw_dec[3];
        cp[4] = rw_dec[4]; cp[5] = cp[4] * rw_dec[5]; cp[6] = cp[5] * rw_dec[6]; cp[7] = cp[6] * rw_dec[7];
        float E0, E1;
        {
          float t0 = cp[3], t1 = cp[7];
          float x0 = __shfl(t0, (lane + 48) & 63), x1 = __shfl(t1, (lane + 48) & 63); if (g < 1) { x0 = 1.f; x1 = 1.f; }
          float i0 = t0 * x0, i1 = t1 * x1;
          float y0 = __shfl(i0, (lane + 32) & 63), y1 = __shfl(i1, (lane + 32) & 63); if (g < 2) { y0 = 1.f; y1 = 1.f; }
          i0 *= y0; i1 *= y1;
          float e0 = __shfl(i0, (lane + 48) & 63), e1 = __shfl(i1, (lane + 48) & 63); if (g < 1) { e0 = 1.f; e1 = 1.f; }
          const float T0 = __shfl(i0, col + 48);
          E0 = e0; E1 = T0 * e1;
        }
#pragma unroll
        for (int e = 0; e < 8; ++e) {
          const int mt = e >> 2, r = e & 3;
          const f32x4 q4 = *(LAS const f32x4*)((LAS const unsigned char*)sq + pb_sq + (16 * mt + r) * 16);
          const float rn = rsqrtf((q4.x + q4.y) + (q4.z + q4.w) + 1e-12f);
          const float Eb = mt ? E1 : E0;
          const float Wt = Eb * cp[e], Wp = (r == 0) ? Eb : Eb * cp[e - 1];
          const float iw = __builtin_amdgcn_rcpf(Wt);
          const float kqn = rw_kq[e] * rn;
          LAS unsigned short* o16 = (LAS unsigned short*)(ob + pb_e + (16 * mt + r) * 128);
          o16[0] = bfr(-Wp * kqn);
          o16[2048] = bfr(kqn * rw_al[e] * iw);
          o16[4096] = bfr(rw_kd[e] * iw);
          o16[6144] = bfr(Wt * rw_r[e]);
          o16[8192] = bfr(rw_v[e]);
          if (e == 7 && g == 3) ((LAS float*)(ob + 20480))[16 * nt + col] = Wt;
        }
      }
      if (k < nprep) {
        const float c_biasw = cn[0], c_biasa = cn[64], c_kkc = cn[128], c_kac = cn[192], c_rkc = cn[256];
        LAS float* sq = (LAS float*)(lds + CK_SSQ + (k & 1) * 512);
        LAS const unsigned char* in = lds + CK_IN + (k & 1) * CK_INS;
#pragma unroll
        for (int mt = 0; mt < 2; ++mt) {
          f32x4 aw = (f32x4){c_biasw, c_biasw, c_biasw, c_biasw}, aa = (f32x4){c_biasa, c_biasa, c_biasa, c_biasa};
          LAS const unsigned char* hrow = in + 12288 + pb_h + 16 * mt * 272;
          aw = __builtin_amdgcn_mfma_f32_16x16x32_bf16(*(LAS const bf16x8*)(hrow), *(LAS const bf16x8*)(lds + froff), aw, 0, 0, 0);
          aw = __builtin_amdgcn_mfma_f32_16x16x32_bf16(*(LAS const bf16x8*)(hrow + 64), *(LAS const bf16x8*)(lds + froff + 1024), aw, 0, 0, 0);
          aa = __builtin_amdgcn_mfma_f32_16x16x32_bf16(*(LAS const bf16x8*)(hrow + 128), *(LAS const bf16x8*)(lds + froff + 2048), aa, 0, 0, 0);
          aa = __builtin_amdgcn_mfma_f32_16x16x32_bf16(*(LAS const bf16x8*)(hrow + 192), *(LAS const bf16x8*)(lds + froff + 3072), aa, 0, 0, 0);
          unsigned pf_k[8], pf_r[8], pf_v[8];
#pragma unroll
          for (int r = 0; r < 4; ++r) {
            LAS const unsigned short* e16 = (LAS const unsigned short*)(in + pb_e + (16 * mt + r) * 128);
            pf_k[4 * mt + r] = e16[0]; pf_r[4 * mt + r] = e16[2048]; pf_v[4 * mt + r] = e16[4096];
          }
          float sq4[4], bn4[4];
#pragma unroll
          for (int r = 0; r < 4; ++r) {
            const int e = 4 * mt + r;
            const float sig = __builtin_amdgcn_rcpf(1.f + __expf(-aw[r]));
            rw_dec[e] = __expf(-0.6065306597126334f * sig);
            const float a = __builtin_amdgcn_rcpf(1.f + __expf(-aa[r]));
            rw_al[e] = a;
            const float kv = bf2f(pf_k[e]), rv = bf2f(pf_r[e]);
            rw_r[e] = rv; rw_v[e] = bf2f(pf_v[e]);
            const float kq = kv * c_kkc; rw_kq[e] = kq;
            const float kd = kv * (1.f + (a - 1.f) * c_kac); rw_kd[e] = kd;
            sq4[r] = kq * kq; bn4[r] = rv * kd * c_rkc;
          }
#define CK_DPP(v, CTRL) __builtin_bit_cast(float, __builtin_amdgcn_update_dpp(0, __builtin_bit_cast(int, (v)), (CTRL), 0xF, 0xF, true))
#pragma unroll
          for (int r = 0; r < 4; ++r) { sq4[r] += CK_DPP(sq4[r], 0xB1); bn4[r] += CK_DPP(bn4[r], 0xB1); }
#pragma unroll
          for (int r = 0; r < 4; ++r) { sq4[r] += CK_DPP(sq4[r], 0x4E); bn4[r] += CK_DPP(bn4[r], 0x4E); }
#pragma unroll
          for (int r = 0; r < 4; ++r) { sq4[r] += CK_DPP(sq4[r], 0x141); bn4[r] += CK_DPP(bn4[r], 0x141); }
#pragma unroll
          for (int r = 0; r < 4; ++r) { sq4[r] += CK_DPP(sq4[r], 0x140); bn4[r] += CK_DPP(bn4[r], 0x140); }
#undef CK_DPP
          if (col == 0) {
            float* bo = (float*)(ws + M_BON) + ((((unsigned)ch.dir * NTOK + (unsigned)ctok(ch.m0, ch.L, ch.dir, sb0 + 32 * k + 16 * mt + 4 * g)) * 16u + (unsigned)ch.hd) * 4u + (unsigned)nt);
#pragma unroll
            for (int r = 0; r < 4; ++r) {
              *(LAS float*)((LAS unsigned char*)sq + pb_sqw + (16 * mt + r) * 16) = sq4[r];
              bo[r * dstep * 64] = bn4[r];
            }
          }
        }
      }
      if (mode == 1) {
        const int l4 = nt * 64 + lane;
        if (k - 2 >= nprep && k - 2 < ch.nch) {
          const int kc = k - 2;
          LAS unsigned char* ob = lds + (kc % 3) * CK_OPS;
          LAS unsigned char* mxb = lds + CK_MX + (kc & 1) * 8192;
#pragma unroll
          for (int i = 0; i < 4; ++i) *(LAS u32x4*)(ob + (l4 + 256 * i) * 16) = cr[i];
          if (l4 < 16) *(LAS u32x4*)(ob + 20480 + l4 * 16) = cr[4];
#pragma unroll
          for (int i = 0; i < 2; ++i) *(LAS u32x4*)(mxb + (l4 + 256 * i) * 16) = cr[5 + i];
          *(LAS u32x4*)(ob + 16384 + l4 * 16) = cr[7];
        }
        if (k - 1 >= nprep && k - 1 < ch.nch) {
          const int kc = k - 1;
          const unsigned rec = (unsigned)(cidx * CK_NREC + (kc - CK_K0));
          if (((kc - CK_K0) & 7) == 0) {
            unsigned* flag = (unsigned*)(ws + M_CTL + CK_FLAGS) + rec + 7;
            { unsigned sp = 0; while (__hip_atomic_load(flag, __ATOMIC_RELAXED, __HIP_MEMORY_SCOPE_AGENT) == 0u) { __builtin_amdgcn_s_sleep(2); if (++sp > (1u << 22)) break; } }
            __builtin_amdgcn_fence(__ATOMIC_ACQUIRE, "agent");
            asm volatile("s_waitcnt vmcnt(0)" ::: "memory");
          }
          const unsigned char* rp = ws + M_REC + (size_t)rec * CK_REC;
#pragma unroll
          for (int i = 0; i < 4; ++i) cr[i] = *(const u32x4*)(rp + (l4 + 256 * i) * 16);
          if (l4 < 16) cr[4] = *(const u32x4*)(rp + 16384 + l4 * 16);
#pragma unroll
          for (int i = 0; i < 2; ++i) cr[5 + i] = *(const u32x4*)(rp + 16640 + (l4 + 256 * i) * 16);
          { const int t = l4 >> 3, c8 = l4 & 7;
            const unsigned gi = (unsigned)ctok(ch.m0, ch.L, ch.dir, sb0 + 32 * kc + t) * (unsigned)D + (unsigned)(ch.hd * 64 + 8 * c8);
            cr[7] = *(const u32x4*)((const bf16_t*)(ws + M_VB) + gi); }
        }
      }
      LDS_BARRIER();
    }
  } else if (wave == 3) {
    u32x4 ld_k[4], ld_r[4], ld_v[4], ld_h[8];
#define CK_LOAD(KC) do { const int s0_ = sb0 + 32 * (KC); \
      _Pragma("unroll") for (int i_ = 0; i_ < 4; ++i_) { const int id_ = lane + 64 * i_; const int t_ = id_ >> 3, c8_ = id_ & 7; \
        const unsigned gi_ = (unsigned)ctok(ch.m0, ch.L, ch.dir, s0_ + t_) * (unsigned)D + (unsigned)(ch.hd * 64 + 8 * c8_); \
        ld_k[i_] = *(const u32x4*)((const bf16_t*)(ws + M_KB) + gi_); ld_r[i_] = *(const u32x4*)((const bf16_t*)(ws + M_RB) + gi_); ld_v[i_] = *(const u32x4*)((const bf16_t*)(ws + M_VB) + gi_); } \
      _Pragma("unroll") for (int i_ = 0; i_ < 8; ++i_) { const int id_ = lane + 64 * i_; const int t_ = id_ >> 4, c8_ = id_ & 15; \
        const unsigned go_ = (unsigned)ctok(ch.m0, ch.L, ch.dir, s0_ + t_) * 256u + (unsigned)((c8_ >> 3) * 128 + ch.dir * 64 + 8 * (c8_ & 7)); \
        ld_h[i_] = *(const u32x4*)((const bf16_t*)(ws + M_HWA) + go_); } } while (0)
#define CK_PUT(BUF) do { LAS unsigned char* in_ = lds + CK_IN + (BUF) * CK_INS; \
      _Pragma("unroll") for (int i_ = 0; i_ < 4; ++i_) { const int id_ = lane + 64 * i_; \
        *(LAS u32x4*)(in_ + id_ * 16) = ld_k[i_]; *(LAS u32x4*)(in_ + 4096 + id_ * 16) = ld_r[i_]; *(LAS u32x4*)(in_ + 8192 + id_ * 16) = ld_v[i_]; } \
      _Pragma("unroll") for (int i_ = 0; i_ < 8; ++i_) { const int id_ = lane + 64 * i_; const int t_ = id_ >> 4, c8_ = id_ & 15; \
        *(LAS u32x4*)(in_ + 12288 + t_ * 272 + c8_ * 16) = ld_h[i_]; } } while (0)
    CK_LOAD(0); CK_PUT(0);
    if (nprep > 1) CK_LOAD(1);
    LDS_BARRIER();
    for (int k = 0; k < NK; ++k) {
      if (k + 1 < nprep) CK_PUT((k + 1) & 1);
      if (k + 2 < nprep) CK_LOAD(k + 2);
      if (k >= 2 && k <= nprep + 1) {
        const int lane_o = opq5(lane); const int r32 = lane_o & 31, hi = lane_o >> 5;
        LAS const unsigned char* ob = lds + ((k - 2) % 3) * CK_OPS;
        LAS unsigned char* mx = lds + CK_MX + ((k - 2) & 1) * 8192;
        f32x16 acc;
        CK_PROD(acc, 8192, 0);     CK_STORE_T(acc, mx + 0, true);
        CK_PROD(acc, 4096, 12288); CK_STORE_T(acc, mx + 2048, false);
        CK_PROD(acc, 8192, 12288); CK_STORE_T(acc, mx + 4096, false);
      }
      LDS_BARRIER();
    }
#undef CK_LOAD
#undef CK_PUT
  } else if (wave == 2) {
    LDS_BARRIER();
    for (int k = 0; k < NK; ++k) {
      if (k >= 2 && k <= nprep + 1) {
        const int lane_o = opq5(lane); const int r32 = lane_o & 31, hi = lane_o >> 5;
        LAS const unsigned char* ob = lds + ((k - 2) % 3) * CK_OPS;
        LAS unsigned char* mx = lds + CK_MX + ((k - 2) & 1) * 8192;
        LAS unsigned char* sc = lds + CK_SCR;
        f32x16 Q, Pm;
        CK_PROD(Q, 4096, 0);
        CK_STORE_T(Q, sc + 2048, true);
#pragma unroll
        for (int i = 0; i < 16; ++i) Pm[i] = Q[i] + ((crow_(i, hi) == r32) ? 1.f : 0.f);
        CK_STORE_TN(Pm, sc + 4096);
        asm volatile("s_waitcnt lgkmcnt(0)" ::: "memory");
#define CK_MM(ACC, Z1T, Z2T) do { _Pragma("unroll") for (int ks = 0; ks < 2; ++ks) { \
          const bf16x8 af_ = ldT_nat(sc + (Z1T), 32, 16 * ks, 0, lane_o), bf_ = *(LAS const bf16x8*)(sc + (Z2T) + (r32 * 32 + 16 * ks + 8 * hi) * 2); \
          ACC = MFMA32(af_, bf_, ACC); } } while (0)
#pragma unroll 1
        for (int it = 0; it < 4; ++it) {
          f32x16 Q2;
#pragma unroll
          for (int i = 0; i < 16; ++i) Q2[i] = 0.f;
          CK_MM(Q2, 2048, 2048);
          asm volatile("s_waitcnt lgkmcnt(0)" ::: "memory");
          CK_STORE_TN(Q2, sc + 2048);
          asm volatile("s_waitcnt lgkmcnt(0)" ::: "memory");
          CK_MM(Pm, 4096, 2048);
          asm volatile("s_waitcnt lgkmcnt(0)" ::: "memory");
          if (it < 3) { CK_STORE_TN(Pm, sc + 4096); asm volatile("s_waitcnt lgkmcnt(0)" ::: "memory"); }
        }
        CK_STORE_TN(Pm, mx + 6144);
#undef CK_MM
      }
      LDS_BARRIER();
    }
  } else {
    f32x16 St0, St1;
#pragma unroll
    for (int i = 0; i < 16; ++i) { St0[i] = 0.f; St1[i] = 0.f; }
    if (mode != 2 && ch.L == 2048) {
      const GASF* s0 = p.state_rwkv + ((((size_t)(ch.seq - 16)) * 2 + ch.dir) * 16 + ch.hd) * 4096 + (size_t)(32 * wave + r32) * 64;
#pragma unroll
      for (int q = 0; q < 4; ++q) {
        const f32x4 a = *(const GAS f32x4*)(s0 + 8 * q + 4 * hi), b = *(const GAS f32x4*)(s0 + 32 + 8 * q + 4 * hi);
        St0[4 * q] = a.x; St0[4 * q + 1] = a.y; St0[4 * q + 2] = a.z; St0[4 * q + 3] = a.w;
        St1[4 * q] = b.x; St1[4 * q + 1] = b.y; St1[4 * q + 2] = b.z; St1[4 * q + 3] = b.w;
      }
    }
    LDS_BARRIER();
    for (int k = 0; k < NK; ++k) {
      const int lane = opq5(lane_in); const int hi = lane >> 5, r32 = lane & 31;
      if (mode == 2) {
        if (k >= 4 && wave == 0 && lane == 0) {
          __builtin_amdgcn_fence(__ATOMIC_RELEASE, "agent");
          asm volatile("s_waitcnt vmcnt(0)" ::: "memory");
          __hip_atomic_store((unsigned*)(ws + M_CTL + CK_FLAGS) + (unsigned)(cidx * CK_NREC + (ch.kofs + (k - 4) - CK_K0)), 1u, __ATOMIC_RELAXED, __HIP_MEMORY_SCOPE_AGENT);
        }
        if (k >= 3) {
          const int kc = k - 3;
          unsigned char* rp = ws + M_REC + (size_t)(cidx * CK_NREC + (ch.kofs + kc - CK_K0)) * CK_REC;
          LAS const unsigned char* ob = lds + (kc % 3) * CK_OPS;
          LAS const unsigned char* mxb = lds + CK_MX + (kc & 1) * 8192;
          const int l2 = wave * 64 + lane;
#pragma unroll 4
          for (int i = 0; i < 8; ++i) *(u32x4*)(rp + (l2 + 128 * i) * 16) = *(LAS const u32x4*)(ob + (l2 + 128 * i) * 16);
          if (l2 < 16) *(u32x4*)(rp + 16384 + l2 * 16) = *(LAS const u32x4*)(ob + 20480 + l2 * 16);
#pragma unroll 4
          for (int i = 0; i < 4; ++i) *(u32x4*)(rp + 16640 + (l2 + 128 * i) * 16) = *(LAS const u32x4*)(mxb + (l2 + 128 * i) * 16);
          asm volatile("s_waitcnt vmcnt(0)" ::: "memory");
        }
      } else if (k >= 3) {
        const int kc = k - 3, ih = wave;
        LAS const unsigned char* ob = lds + (kc % 3) * CK_OPS;
        LAS const unsigned char* mx = lds + CK_MX + (kc & 1) * 8192;
        const bf16x8 s00 = cvt8(St0, 0), s01 = cvt8(St0, 1), s10 = cvt8(St1, 0), s11 = cvt8(St1, 1);
        const bf16x8 v0 = ldT_perm(ob + 16384, 64, 0, 32 * ih, lane), v1 = ldT_perm(ob + 16384, 64, 16, 32 * ih, lane);
        f32x16 G, U, Y;
#pragma unroll
        for (int i = 0; i < 16; ++i) { G[i] = 0.f; U[i] = 0.f; Y[i] = 0.f; }
        G = MFMA32(ldA_perm(ob + 0, 64, r32, 0, hi), s00, G);  G = MFMA32(ldA_perm(ob + 0, 64, r32, 16, hi), s01, G);
        G = MFMA32(ldA_perm(ob + 0, 64, r32, 32, hi), s10, G); G = MFMA32(ldA_perm(ob + 0, 64, r32, 48, hi), s11, G);
        G = MFMA32(ldA_perm(mx + 0, 32, r32, 0, hi), v0, G);   G = MFMA32(ldA_perm(mx + 0, 32, r32, 16, hi), v1, G);
        const bf16x8 g0 = cvt8(G, 0), g1 = cvt8(G, 1);
        U = MFMA32(ldA_perm(mx + 6144, 32, r32, 0, hi), g0, U); U = MFMA32(ldA_perm(mx + 6144, 32, r32, 16, hi), g1, U);
        const bf16x8 u0 = cvt8(U, 0), u1 = cvt8(U, 1);
        Y = MFMA32(ldA_perm(ob + 12288, 64, r32, 0, hi), s00, Y);  Y = MFMA32(ldA_perm(ob + 12288, 64, r32, 16, hi), s01, Y);
        Y = MFMA32(ldA_perm(ob + 12288, 64, r32, 32, hi), s10, Y); Y = MFMA32(ldA_perm(ob + 12288, 64, r32, 48, hi), s11, Y);
        Y = MFMA32(ldA_perm(mx + 2048, 32, r32, 0, hi), u0, Y);    Y = MFMA32(ldA_perm(mx + 2048, 32, r32, 16, hi), u1, Y);
        Y = MFMA32(ldA_perm(mx + 4096, 32, r32, 0, hi), v0, Y);    Y = MFMA32(ldA_perm(mx + 4096, 32, r32, 16, hi), v1, Y);
        St0 = MFMA32(ldT_perm(ob + 4096, 64, 0, 0, lane), u0, St0);  St0 = MFMA32(ldT_perm(ob + 4096, 64, 16, 0, lane), u1, St0);
        St0 = MFMA32(ldT_perm(ob + 8192, 64, 0, 0, lane), v0, St0);  St0 = MFMA32(ldT_perm(ob + 8192, 64, 16, 0, lane), v1, St0);
        St1 = MFMA32(ldT_perm(ob + 4096, 64, 0, 32, lane), u0, St1); St1 = MFMA32(ldT_perm(ob + 4096, 64, 16, 32, lane), u1, St1);
        St1 = MFMA32(ldT_perm(ob + 8192, 64, 0, 32, lane), v0, St1); St1 = MFMA32(ldT_perm(ob + 8192, 64, 16, 32, lane), v1, St1);
        LAS const float* wt = (LAS const float*)(ob + 20480);
#pragma unroll
        for (int q = 0; q < 4; ++q) {
          const f32x4 w0 = *(LAS const f32x4*)(wt + 8 * q + 4 * hi), w1 = *(LAS const f32x4*)(wt + 32 + 8 * q + 4 * hi);
          St0[4 * q] *= w0.x; St0[4 * q + 1] *= w0.y; St0[4 * q + 2] *= w0.z; St0[4 * q + 3] *= w0.w;
          St1[4 * q] *= w1.x; St1[4 * q + 1] *= w1.y; St1[4 * q + 2] *= w1.z; St1[4 * q + 3] *= w1.w;
        }
        {
          const int tk0 = ctok(ch.m0, ch.L, ch.dir, sb0 + 32 * kc); const int dstep = ch.dir ? -1 : 1;
          const unsigned cb = (unsigned)(ch.hd * 64 + 32 * ih + r32);
#pragma unroll
          for (int i = 0; i < 16; ++i) Yo[(unsigned)(tk0 + crow_(i, hi) * dstep) * (unsigned)D + cb] = Y[i];
        }
      }
      LDS_BARRIER();
    }
    if (mode == 2 && wave == 0 && lane == 0) {
      __builtin_amdgcn_fence(__ATOMIC_RELEASE, "agent");
      asm volatile("s_waitcnt vmcnt(0)" ::: "memory");
      __hip_atomic_store((unsigned*)(ws + M_CTL + CK_FLAGS) + (unsigned)(cidx * CK_NREC + (ch.kofs + ch.nch - 1 - CK_K0)), 1u, __ATOMIC_RELAXED, __HIP_MEMORY_SCOPE_AGENT);
    }
    if (mode != 2 && ch.L == 256) {
    GASF* so = p.out + OUT_ST + ((((size_t)ch.seq) * 2 + ch.dir) * 16 + ch.hd) * 4096 + (size_t)(32 * wave + r32) * 64;
#pragma unroll
    for (int q = 0; q < 4; ++q) {
      *(GAS f32x4*)(so + 8 * q + 4 * hi) = (f32x4){St0[4 * q], St0[4 * q + 1], St0[4 * q + 2], St0[4 * q + 3]};
      *(GAS f32x4*)(so + 32 + 8 * q + 4 * hi) = (f32x4){St1[4 * q], St1[4 * q + 1], St1[4 * q + 2], St1[4 * q + 3]};
    }
  }
  }
}

__device__ __forceinline__ void phase_rw_scan_ck(const LAS PG& p, unsigned char* ws, LAS unsigned char* lds, int tid, int lane, int wave, int bid, int G) {
  int dfirst = bid * 8 + wave, dstride = G * 8;
  if (G == 256) {
    if (bid < 64) { __syncthreads(); ck_run_chain(p, ws, lds, ck_chain(bid), lane, wave, 1, CK_K0, bid); dfirst = NTR_DEF; }
    else {
      for (int pc = bid - 64; pc < 512; pc += 192) { __syncthreads(); ck_run_chain(p, ws, lds, ck_chain(64 + pc), lane, wave, 0, 8, 0); }
      {
        const int pb = bid - 64; const int c = pb / 3, r = pb % 3;
        CkChain pch = ck_chain(c); pch.kofs = CK_K0 + 8 * r; pch.nch = 8;
        __syncthreads(); ck_run_chain(p, ws, lds, pch, lane, wave, 2, 8, c);
      }
      dfirst = (bid - 64) * 8 + wave; dstride = 192 * 8;
    }
  } else {
    for (int id = bid; id < 576; id += G) { __syncthreads(); const CkChain cc = ck_chain(id); ck_run_chain(p, ws, lds, cc, lane, wave, 0, cc.nch, 0); }
  }
  __syncthreads();
  tr_run<1>(p, ws, (LAS float*)(lds + wave * 16384), lane, dfirst, dstride, NTR_DEF);
}
__device__ __forceinline__ int opq(int x) { asm volatile("" : "+v"(x)); return x; }
#ifndef RPT_MASK
#define RPT_MASK 0u
#endif
struct MArgs { P p; int ph_lo, ph_hi; };
__global__ void __launch_bounds__(512, 2) mega(MArgs a) {
  extern __shared__ __attribute__((aligned(16))) unsigned char lds_raw[];
  LAS unsigned char* lds = (LAS unsigned char*)lds_raw;
  const int tid = threadIdx.x, lane = tid & 63, wave = __builtin_amdgcn_readfirstlane(tid >> 6);
  const int G = gridDim.x, bid = blockIdx.x;
  unsigned char* ws = (unsigned char*)a.p.ws;
  if (tid == 0) {
    LAS PG* t = (LAS PG*)(lds + PTAB_OFF);
    t->x_prompt = (decltype(t->x_prompt))a.p.x_prompt;
    t->x_sample = (decltype(t->x_sample))a.p.x_sample;
    t->cache_ckv = (decltype(t->cache_ckv))a.p.cache_ckv;
    t->cache_kpe = (decltype(t->cache_kpe))a.p.cache_kpe;
    t->state_rwkv = (decltype(t->state_rwkv))a.p.state_rwkv;
    t->c = (decltype(t->c))a.p.c;
    t->c_ctx = (decltype(t->c_ctx))a.p.c_ctx;
    t->mod_w = (decltype(t->mod_w))a.p.mod_w;
    t->mod_b = (decltype(t->mod_b))a.p.mod_b;
    t->ln_g = (decltype(t->ln_g))a.p.ln_g;
    t->ln_b = (decltype(t->ln_b))a.p.ln_b;
    t->hy_w_in = (decltype(t->hy_w_in))a.p.hy_w_in;
    t->hy_conv_w = (decltype(t->hy_conv_w))a.p.hy_conv_w;
    t->hy_conv_b = (decltype(t->hy_conv_b))a.p.hy_conv_b;
    t->hy_w1 = (decltype(t->hy_w1))a.p.hy_w1;
    t->hy_b1 = (decltype(t->hy_b1))a.p.hy_b1;
    t->hy_w2 = (decltype(t->hy_w2))a.p.hy_w2;
    t->hy_b2 = (decltype(t->hy_b2))a.p.hy_b2;
    t->hy_w3 = (decltype(t->hy_w3))a.p.hy_w3;
    t->hy_b3 = (decltype(t->hy_b3))a.p.hy_b3;
    t->hy_freq = (decltype(t->hy_freq))a.p.hy_freq;
    t->hy_decay = (decltype(t->hy_decay))a.p.hy_decay;
    t->hy_skip = (decltype(t->hy_skip))a.p.hy_skip;
    t->hy_w_out = (decltype(t->hy_w_out))a.p.hy_w_out;
    t->mla_w_in = (decltype(t->mla_w_in))a.p.mla_w_in;
    t->mla_q_norm = (decltype(t->mla_q_norm))a.p.mla_q_norm;
    t->mla_kv_norm = (decltype(t->mla_kv_norm))a.p.mla_kv_norm;
    t->mla_w_q_up = (decltype(t->mla_w_q_up))a.p.mla_w_q_up;
    t->mla_w_kv_up = (decltype(t->mla_w_kv_up))a.p.mla_w_kv_up;
    t->mla_w_out = (decltype(t->mla_w_out))a.p.mla_w_out;
    t->rw_mu = (decltype(t->rw_mu))a.p.rw_mu;
    t->rw_w_in = (decltype(t->rw_w_in))a.p.rw_w_in;
    t->rw_w0 = (decltype(t->rw_w0))a.p.rw_w0;
    t->rw_w1 = (decltype(t->rw_w1))a.p.rw_w1;
    t->rw_w2 = (decltype(t->rw_w2))a.p.rw_w2;
    t->rw_a0 = (decltype(t->rw_a0))a.p.rw_a0;
    t->rw_a1 = (decltype(t->rw_a1))a.p.rw_a1;
    t->rw_a2 = (decltype(t->rw_a2))a.p.rw_a2;
    t->rw_k_k = (decltype(t->rw_k_k))a.p.rw_k_k;
    t->rw_k_a = (decltype(t->rw_k_a))a.p.rw_k_a;
    t->rw_r_k = (decltype(t->rw_r_k))a.p.rw_r_k;
    t->rw_gn_g = (decltype(t->rw_gn_g))a.p.rw_gn_g;
    t->rw_gn_b = (decltype(t->rw_gn_b))a.p.rw_gn_b;
    t->rw_w_out = (decltype(t->rw_w_out))a.p.rw_w_out;
    t->out = (decltype(t->out))a.p.out;
    t->ws = (decltype(t->ws))a.p.ws;
  }
  const LAS PG& p = *(const LAS PG*)(lds + PTAB_OFF);
  volatile LAS unsigned* MISC = (volatile LAS unsigned*)(lds + MISC_OFF);
  for (int u = tid; u < 128; u += 512) ((LAS unsigned*)(lds + MISC_OFF))[u] = 0u;
  __syncthreads();
  const int lo = a.ph_lo, hi = a.ph_hi;
  XcdBarrier bar; bar.bar = (unsigned*)(ws + M_CTL); bar.x = 0; bar.st = nullptr;
  if (hi - lo > 0 || RPT_MASK) bar = xcd_barrier_post((unsigned*)(ws + M_CTL), MISC + 8);
#ifndef PH_MASK
#define PH_MASK 0xffffffffu
#endif
#ifndef TP_PHASE
#define TP_PHASE -1
#endif
#ifndef TP_MULT
#define TP_MULT 4
#endif
  unsigned long long tp0 = (TP_PHASE == 0) ? __builtin_amdgcn_s_memrealtime() : 0ull, tp1 = 0ull;
#define IN(k) (((PH_MASK >> (k)) & 1u) && lo <= (k) && (k) < hi)
#define SEAM(k) do { if (IN(k) && IN((k) + 1)) xcd_barrier(bar); if ((k) + 1 == TP_PHASE) tp0 = __builtin_amdgcn_s_memrealtime(); if ((k) == TP_PHASE) tp1 = __builtin_amdgcn_s_memrealtime(); } while (0)
  if (IN(0)) { { phase_p0a(p, ws, lds, opq((int)threadIdx.x), (opq((int)threadIdx.x) & 63), wave, bid, G); } if ((RPT_MASK >> 0) & 1u) { xcd_barrier(bar); { phase_p0a(p, ws, lds, opq((int)threadIdx.x), (opq((int)threadIdx.x) & 63), wave, bid, G); } } } SEAM(0);
  if (IN(1)) { { phase_p0b(p, ws, lds, opq((int)threadIdx.x), (opq((int)threadIdx.x) & 63), wave, bid, G); } if ((RPT_MASK >> 1) & 1u) { xcd_barrier(bar); { phase_p0b(p, ws, lds, opq((int)threadIdx.x), (opq((int)threadIdx.x) & 63), wave, bid, G); } } } SEAM(1);
  if (IN(2)) { {
    pg8::Gemm g{(const pg8::bf16_t*)(ws + W_HYIN), (const pg8::bf16_t*)(ws + M_HB), 4096, 8192, 1024};
    pg8::StaticOrder S; S.init(4096, 8192, G, bid);
    pg8::EpiBf16<0> E{(pg8::bf16_t*)(ws + M_UT), 8192, nullptr, 0, 0, 1.f};
    pg8::gemm_phase<pg8::EpiBf16<0>, pg8::StaticOrder, true, true>(lds, g, S, E); } if ((RPT_MASK >> 2) & 1u) { xcd_barrier(bar); {
    pg8::Gemm g{(const pg8::bf16_t*)(ws + W_HYIN), (const pg8::bf16_t*)(ws + M_HB), 4096, 8192, 1024};
    pg8::StaticOrder S; S.init(4096, 8192, G, bid);
    pg8::EpiBf16<0> E{(pg8::bf16_t*)(ws + M_UT), 8192, nullptr, 0, 0, 1.f};
    pg8::gemm_phase<pg8::EpiBf16<0>, pg8::StaticOrder, true, true>(lds, g, S, E); } } } SEAM(2);
  if (IN(3)) { { phase_hy_conv(p, ws, lds, 0, opq((int)threadIdx.x), (opq((int)threadIdx.x) & 63), wave, bid, G); } if ((RPT_MASK >> 3) & 1u) { xcd_barrier(bar); { phase_hy_conv(p, ws, lds, 0, opq((int)threadIdx.x), (opq((int)threadIdx.x) & 63), wave, bid, G); } } } SEAM(3);
  if (IN(4)) { { phase_out_ln<1>(p, ws, lds, 0, (const bf16_t*)(ws + W_HYOUT), opq((int)threadIdx.x), (opq((int)threadIdx.x) & 63), wave, bid, G); } if ((RPT_MASK >> 4) & 1u) { xcd_barrier(bar); { phase_out_ln<1>(p, ws, lds, 0, (const bf16_t*)(ws + W_HYOUT), opq((int)threadIdx.x), (opq((int)threadIdx.x) & 63), wave, bid, G); } } } SEAM(4);
  if (IN(5)) { {
    pg8::Gemm g{(const pg8::bf16_t*)(ws + M_HB), (const pg8::bf16_t*)(ws + W_MLAIN + MiB), 8192, 1024, 1024};
    pg8::StaticOrder S; S.init(8192, 1024, G, bid);
    EpiSilu E{(bf16_t*)(ws + M_SZB), 1024};
    pg8::gemm_phase<EpiSilu, pg8::StaticOrder, true, true>(lds, g, S, E);
    { pg8::Gemm g2{(const pg8::bf16_t*)(ws + M_HB), (const pg8::bf16_t*)(ws + W_MLAIN), 8192, 512, 1024};
      pg8::StaticOrder S2; S2.init(8192, 512, G, (bid + G - 128 % G) % G);
      EpiF32 E2{(float*)(ws + M_U2S), 512};
      pg8::gemm_phase<EpiF32, pg8::StaticOrder, true, true>(lds, g2, S2, E2); }
    if (G == 256 && bid >= 192) { __syncthreads(); tr_run<2>(p, ws, (LAS float*)(lds + wave * 16384), (opq((int)threadIdx.x) & 63), (bid - 192) * 8 + wave, 64 * 8, NTR_DEF2); }
    else if (G != 256) { __syncthreads(); tr_run<2>(p, ws, (LAS float*)(lds + wave * 16384), (opq((int)threadIdx.x) & 63), bid * 8 + wave, G * 8, NTR_DEF2); } } if ((RPT_MASK >> 5) & 1u) { xcd_barrier(bar); {
    pg8::Gemm g{(const pg8::bf16_t*)(ws + M_HB), (const pg8::bf16_t*)(ws + W_MLAIN + MiB), 8192, 1024, 1024};
    pg8::StaticOrder S; S.init(8192, 1024, G, bid);
    EpiSilu E{(bf16_t*)(ws + M_SZB), 1024};
    pg8::gemm_phase<EpiSilu, pg8::StaticOrder, true, true>(lds, g, S, E);
    { pg8::Gemm g2{(const pg8::bf16_t*)(ws + M_HB), (const pg8::bf16_t*)(ws + W_MLAIN), 8192, 512, 1024};
      pg8::StaticOrder S2; S2.init(8192, 512, G, (bid + G - 128 % G) % G);
      EpiF32 E2{(float*)(ws + M_U2S), 512};
      pg8::gemm_phase<EpiF32, pg8::StaticOrder, true, true>(lds, g2, S2, E2); }
    if (G == 256 && bid >= 192) { __syncthreads(); tr_run<2>(p, ws, (LAS float*)(lds + wave * 16384), (opq((int)threadIdx.x) & 63), (bid - 192) * 8 + wave, 64 * 8, NTR_DEF2); }
    else if (G != 256) { __syncthreads(); tr_run<2>(p, ws, (LAS float*)(lds + wave * 16384), (opq((int)threadIdx.x) & 63), bid * 8 + wave, G * 8, NTR_DEF2); } } } } SEAM(5);
  if (IN(6)) { { phase_mla_rows(p, ws, (opq((int)threadIdx.x) & 63), wave, bid, G); xcd_barrier(bar); } {
    { pg8::Gemm g{(const pg8::bf16_t*)(ws + M_QN), (const pg8::bf16_t*)(ws + W_QUP), 8192, 1536, 256};
      pg8::StaticOrder S; S.init(8192, 1536, G, bid);
      pg8::EpiBf16<0> E{(pg8::bf16_t*)(ws + M_Q), 1536, nullptr, 0, 0, 1.f};
      pg8::gemm_phase<pg8::EpiBf16<0>, pg8::StaticOrder, true, true>(lds, g, S, E); }
    { pg8::Gemm g{(const pg8::bf16_t*)(ws + M_CKVALL), (const pg8::bf16_t*)(ws + W_KVUP), 9216, 2048, 128};
      pg8::StaticOrder S; S.init(9216, 2048, G, (bid + G - 192 % G) % G);
      EpiKV E{(bf16_t*)(ws + M_KN), (bf16_t*)(ws + M_V)};
      pg8::gemm_phase<EpiKV, pg8::StaticOrder, true, true>(lds, g, S, E); } } if ((RPT_MASK >> 6) & 1u) { xcd_barrier(bar); { phase_mla_rows(p, ws, (opq((int)threadIdx.x) & 63), wave, bid, G); xcd_barrier(bar); } {
    { pg8::Gemm g{(const pg8::bf16_t*)(ws + M_QN), (const pg8::bf16_t*)(ws + W_QUP), 8192, 1536, 256};
      pg8::StaticOrder S; S.init(8192, 1536, G, bid);
      pg8::EpiBf16<0> E{(pg8::bf16_t*)(ws + M_Q), 1536, nullptr, 0, 0, 1.f};
      pg8::gemm_phase<pg8::EpiBf16<0>, pg8::StaticOrder, true, true>(lds, g, S, E); }
    { pg8::Gemm g{(const pg8::bf16_t*)(ws + M_CKVALL), (const pg8::bf16_t*)(ws + W_KVUP), 9216, 2048, 128};
      pg8::StaticOrder S; S.init(9216, 2048, G, (bid + G - 192 % G) % G);
      EpiKV E{(bf16_t*)(ws + M_KN), (bf16_t*)(ws + M_V)};
      pg8::gemm_phase<EpiKV, pg8::StaticOrder, true, true>(lds, g, S, E); } } } } SEAM(6);
  if (IN(7)) { {
    for (int u = bid; u < 512; u += G) {
      int seq, hd, qb;
      if (u < 256) { seq = 16 + (u >> 7); hd = (u >> 3) & 15; qb = u & 7; } else { const int uu = u - 256; seq = uu >> 4; hd = uu & 15; qb = 0; }
      attn_unit(ws, lds, seq, hd, qb, (bf16_t*)(ws + M_GB), opq((int)threadIdx.x), (opq((int)threadIdx.x) & 63), wave);
    } } if ((RPT_MASK >> 7) & 1u) { xcd_barrier(bar); {
    for (int u = bid; u < 512; u += G) {
      int seq, hd, qb;
      if (u < 256) { seq = 16 + (u >> 7); hd = (u >> 3) & 15; qb = u & 7; } else { const int uu = u - 256; seq = uu >> 4; hd = uu & 15; qb = 0; }
      attn_unit(ws, lds, seq, hd, qb, (bf16_t*)(ws + M_GB), opq((int)threadIdx.x), (opq((int)threadIdx.x) & 63), wave);
    } } } } SEAM(7);
  if (IN(8)) { { phase_out_ln<0>(p, ws, lds, 1, (const bf16_t*)(ws + W_MLAOUT), opq((int)threadIdx.x), (opq((int)threadIdx.x) & 63), wave, bid, G); } if ((RPT_MASK >> 8) & 1u) { xcd_barrier(bar); { phase_out_ln<0>(p, ws, lds, 1, (const bf16_t*)(ws + W_MLAOUT), opq((int)threadIdx.x), (opq((int)threadIdx.x) & 63), wave, bid, G); } } } SEAM(8);
  if (IN(9)) { { phase_rw_mix(p, ws, opq((int)threadIdx.x), bid, G); } if ((RPT_MASK >> 9) & 1u) { xcd_barrier(bar); { phase_rw_mix(p, ws, opq((int)threadIdx.x), bid, G); } } } SEAM(9);
  if (IN(10)) { {
#pragma unroll 1
    for (int q = 0; q < 4; ++q) {
      pg8::Gemm g{(const pg8::bf16_t*)(ws + M_XMIX + (size_t)q * 16 * MiB), (const pg8::bf16_t*)(ws + W_RWIN + (size_t)q * 2 * MiB), 8192, 1024, 1024};
      pg8::StaticOrder S; S.init(8192, 1024, G, (bid + (q & 1) * (G / 2)) % G);
      if (q < 3) { pg8::EpiBf16<0> E{(pg8::bf16_t*)(ws + M_SCR2 + (size_t)q * 16 * MiB), 1024, nullptr, 0, 0, 1.f}; pg8::gemm_phase<pg8::EpiBf16<0>, pg8::StaticOrder, true, true>(lds, g, S, E); }
      else { EpiSilu E{(bf16_t*)(ws + M_SZR), 1024}; pg8::gemm_phase<EpiSilu, pg8::StaticOrder, true, true>(lds, g, S, E); }
    }
    for (int tile = bid; tile < 256; tile += G) rw_lora_tile(p, ws, lds, tile, opq((int)threadIdx.x), (opq((int)threadIdx.x) & 63), wave); } if ((RPT_MASK >> 10) & 1u) { xcd_barrier(bar); {
#pragma unroll 1
    for (int q = 0; q < 4; ++q) {
      pg8::Gemm g{(const pg8::bf16_t*)(ws + M_XMIX + (size_t)q * 16 * MiB), (const pg8::bf16_t*)(ws + W_RWIN + (size_t)q * 2 * MiB), 8192, 1024, 1024};
      pg8::StaticOrder S; S.init(8192, 1024, G, (bid + (q & 1) * (G / 2)) % G);
      if (q < 3) { pg8::EpiBf16<0> E{(pg8::bf16_t*)(ws + M_SCR2 + (size_t)q * 16 * MiB), 1024, nullptr, 0, 0, 1.f}; pg8::gemm_phase<pg8::EpiBf16<0>, pg8::StaticOrder, true, true>(lds, g, S, E); }
      else { EpiSilu E{(bf16_t*)(ws + M_SZR), 1024}; pg8::gemm_phase<EpiSilu, pg8::StaticOrder, true, true>(lds, g, S, E); }
    }
    for (int tile = bid; tile < 256; tile += G) rw_lora_tile(p, ws, lds, tile, opq((int)threadIdx.x), (opq((int)threadIdx.x) & 63), wave); } } } SEAM(10);
  if (IN(11)) { { phase_rw_scan_ck(p, ws, lds, opq((int)threadIdx.x), (opq((int)threadIdx.x) & 63), wave, bid, G); } if ((RPT_MASK >> 11) & 1u) { xcd_barrier(bar); { phase_rw_scan_ck(p, ws, lds, opq((int)threadIdx.x), (opq((int)threadIdx.x) & 63), wave, bid, G); } } } SEAM(11);
  if (IN(12)) { { phase_out_ln<2>(p, ws, lds, 2, (const bf16_t*)(ws + W_RWOUT), opq((int)threadIdx.x), (opq((int)threadIdx.x) & 63), wave, bid, G); } if ((RPT_MASK >> 12) & 1u) { xcd_barrier(bar); { phase_out_ln<2>(p, ws, lds, 2, (const bf16_t*)(ws + W_RWOUT), opq((int)threadIdx.x), (opq((int)threadIdx.x) & 63), wave, bid, G); } } } SEAM(12);
  if (IN(13)) { {
    pg8::Gemm g{(const pg8::bf16_t*)(ws + W_HYIN + 8 * MiB), (const pg8::bf16_t*)(ws + M_HB), 4096, 8192, 1024};
    pg8::StaticOrder S; S.init(4096, 8192, G, bid);
    pg8::EpiBf16<0> E{(pg8::bf16_t*)(ws + M_UT), 8192, nullptr, 0, 0, 1.f};
    pg8::gemm_phase<pg8::EpiBf16<0>, pg8::StaticOrder, true, true>(lds, g, S, E); } if ((RPT_MASK >> 13) & 1u) { xcd_barrier(bar); {
    pg8::Gemm g{(const pg8::bf16_t*)(ws + W_HYIN + 8 * MiB), (const pg8::bf16_t*)(ws + M_HB), 4096, 8192, 1024};
    pg8::StaticOrder S; S.init(4096, 8192, G, bid);
    pg8::EpiBf16<0> E{(pg8::bf16_t*)(ws + M_UT), 8192, nullptr, 0, 0, 1.f};
    pg8::gemm_phase<pg8::EpiBf16<0>, pg8::StaticOrder, true, true>(lds, g, S, E); } } } SEAM(13);
  if (IN(14)) { { phase_hy_conv(p, ws, lds, 1, opq((int)threadIdx.x), (opq((int)threadIdx.x) & 63), wave, bid, G); } if ((RPT_MASK >> 14) & 1u) { xcd_barrier(bar); { phase_hy_conv(p, ws, lds, 1, opq((int)threadIdx.x), (opq((int)threadIdx.x) & 63), wave, bid, G); } } } SEAM(14);
  if (IN(15)) { { phase_out_ln<1>(p, ws, lds, 3, (const bf16_t*)(ws + W_HYOUT + 2 * MiB), opq((int)threadIdx.x), (opq((int)threadIdx.x) & 63), wave, bid, G); } if ((RPT_MASK >> 15) & 1u) { xcd_barrier(bar); { phase_out_ln<1>(p, ws, lds, 3, (const bf16_t*)(ws + W_HYOUT + 2 * MiB), opq((int)threadIdx.x), (opq((int)threadIdx.x) & 63), wave, bid, G); } } }
  if (TP_PHASE >= 0 && bid == 0) { if (TP_PHASE == 15) tp1 = __builtin_amdgcn_s_memrealtime(); const unsigned long long dl = (tp1 - tp0) * TP_MULT; const unsigned long long ts = __builtin_amdgcn_s_memrealtime(); while (__builtin_amdgcn_s_memrealtime() - ts < dl) __builtin_amdgcn_s_sleep(8); }
#undef IN
#undef SEAM
}
}
}

extern "C" void kernel_launch(void* const* d_in, const int* in_sizes, int n_in, void* d_out, int out_size, void* d_ws, size_t ws_size, hipStream_t stream) {
  P p{};
  const float** pp = (const float**)&p;
  for (int i = 0; i < 44; ++i) pp[i] = (const float*)d_in[i];
  p.out = (float*)d_out; p.ws = (float*)d_ws;
  float* ws = p.ws;
  static int grid = 0;
  if (grid == 0) {
    int dev = 0, cus = 0;
    (void)hipGetDevice(&dev); (void)hipDeviceGetAttribute(&cus, hipDeviceAttributeMultiprocessorCount, dev);
    (void)hipFuncSetAttribute((const void*)mk::mega, hipFuncAttributeMaxDynamicSharedMemorySize, mk::LDS_BYTES);
    grid = cus > 0 ? cus : 256;
  }
  (void)hipMemsetAsync((char*)d_ws + mk::M_CTL, 0, 65536, stream);
  mk::MArgs a{}; a.p = p; a.ph_lo = 0; a.ph_hi = MEGA_PHASES;
  hipLaunchKernelGGL(mk::mega, dim3(grid), dim3(512), mk::LDS_BYTES, stream, a);

  float* X = ws + WS_X; float* S1 = ws + WS_S1; float* S4 = ws + WS_S4; float* S2 = ws + WS_S2;
  const int EB = (int)((SZ + 255) / 256);
  if (NAIVE_FROM < 4) hipLaunchKernelGGL(k_mods, dim3((4 * 3 * 3072 + 255) / 256), dim3(256), 0, stream, p);
  for (int layer = NAIVE_FROM; layer < 4; ++layer) {
    const int kind = layer % 3, j = layer / 3;
    const float* xa = (layer == 0) ? p.x_prompt : X;
    const float* xb = (layer == 0) ? p.x_sample : X + (size_t)NPT * D;
    float* Xn = (layer == 3) ? p.out + OUT_Y : X;
    hipLaunchKernelGGL(k_modulate, dim3(EB), dim3(256), 0, stream, p, xa, xb, S1, layer);
    if (kind == 0) {
      hipLaunchKernelGGL(k_hy_filter, dim3(2304), dim3(256), 0, stream, p, j);
      gemm(stream, ALPlain{S1, D}, p.hy_w_in + (size_t)j * D * 4096, 4096, NTOK, 4096, D, EPPlain{S2, 4096});
      hipLaunchKernelGGL(k_hy_vv, dim3(EB), dim3(256), 0, stream, p, S2, S1, j);
      hipLaunchKernelGGL(k_hy_long, dim3(EB), dim3(256), 0, stream, p, S2, S1, S4, j);
      gemm(stream, ALPlain{S4, D}, p.hy_w_out + (size_t)j * D * D, D, NTOK, D, D, EPPlain{S1, D});
    } else if (kind == 1) {
      float* U2 = S2; float* QN = S1; float* CKVALL = S1 + (size_t)NTOK * 256; float* KPEALL = CKVALL + (size_t)9216 * 128;
      float* Q = S2; float* KV = S2 + (size_t)NTOK * 1536;
      gemm(stream, ALPlain{S1, D}, p.mla_w_in, 1440, NTOK, 1440, D, EPPlain{U2, 1440});
      hipLaunchKernelGGL(k_mla_extract, dim3(NTOK), dim3(64), 0, stream, p, U2, QN, CKVALL, KPEALL, S4);
      hipLaunchKernelGGL(k_mla_cache, dim3((2 * PAST * 128 + 255) / 256), dim3(256), 0, stream, p, CKVALL, KPEALL);
      gemm(stream, ALPlain{QN, 256}, p.mla_w_q_up, 1536, NTOK, 1536, 256, EPPlain{Q, 1536});
      hipLaunchKernelGGL(k_rope_q, dim3((4096 * 16 + 255) / 256), dim3(256), 0, stream, Q);
      gemm(stream, ALPlain{CKVALL, 128}, p.mla_w_kv_up, 2048, 9216, 2048, 128, EPPlain{KV, 2048});
      hipLaunchKernelGGL(k_attn, dim3(32, 18 * 16), dim3(64), 0, stream, Q, KV, KPEALL, S4);
      gemm(stream, ALPlain{S4, D}, p.mla_w_out, D, NTOK, D, D, EPPlain{S1, D});
    } else {
      float* R = S2; float* K = S2 + SZ; float* V = S2 + 2 * SZ; float* Z = S2 + 3 * SZ;
      float* HW = ws + WS_MISC + MISC_END; float* HA = HW + (size_t)NTOK * 128;
      const float* mu = p.rw_mu; const float* win = p.rw_w_in;
      gemm(stream, ALMix{S1, mu + 0 * D}, win + 0 * (size_t)D * D, D, NTOK, D, D, EPPlain{R, D});
      gemm(stream, ALMix{S1, mu + 2 * D}, win + 1 * (size_t)D * D, D, NTOK, D, D, EPPlain{K, D});
      gemm(stream, ALMix{S1, mu + 3 * D}, win + 2 * (size_t)D * D, D, NTOK, D, D, EPPlain{V, D});
      gemm(stream, ALMix{S1, mu + 5 * D}, win + 3 * (size_t)D * D, D, NTOK, D, D, EPPlain{Z, D});
      for (int dir = 0; dir < 2; ++dir) {
        gemm(stream, ALMix{S1, mu + 1 * D}, p.rw_w1 + (size_t)dir * D * 64, 64, NTOK, 64, D, EPTanh{HW + dir * 64, 128});
        gemm(stream, ALMix{S1, mu + 4 * D}, p.rw_a1 + (size_t)dir * D * 64, 64, NTOK, 64, D, EPPlain{HA + dir * 64, 128});
      }
      (void)hipMemsetAsync(S4, 0, SZ * sizeof(float), stream);
      hipLaunchKernelGGL(k_rw_scan, dim3(18 * 32), dim3(64), 0, stream, p, R, K, V, HW, HA, S4);
      hipLaunchKernelGGL(k_rw_post, dim3(NTOK * 16), dim3(64), 0, stream, p, R, K, V, Z, HA, S4, S4);
      gemm(stream, ALPlain{S4, D}, p.rw_w_out, D, NTOK, D, D, EPPlain{S1, D});
    }
    hipLaunchKernelGGL(k_ln, dim3(NTOK / 4), dim3(256), 0, stream, p, xa, xb, S1, Xn, layer);
  }
}
```

```cpp
#define MEGA_PHASES 16
#define NAIVE_FROM 4
#include <hip/hip_runtime.h>
#include <stdint.h>
#include <math.h>

namespace {

constexpr int D = 1024;
constexpr int NTOK = 8192;
constexpr int NPT = 4096;
constexpr int PAST = 512;
constexpr float ALPHA = 1.681792830507429f;
constexpr float LN_EPS = 1e-5f, RMS_EPS = 1e-6f, GN_EPS = 64e-5f;

struct P {
  const float *x_prompt, *x_sample, *cache_ckv, *cache_kpe, *state_rwkv, *c, *c_ctx;
  const float *mod_w, *mod_b, *ln_g, *ln_b;
  const float *hy_w_in, *hy_conv_w, *hy_conv_b, *hy_w1, *hy_b1, *hy_w2, *hy_b2, *hy_w3, *hy_b3, *hy_freq, *hy_decay, *hy_skip, *hy_w_out;
  const float *mla_w_in, *mla_q_norm, *mla_kv_norm, *mla_w_q_up, *mla_w_kv_up, *mla_w_out;
  const float *rw_mu, *rw_w_in, *rw_w0, *rw_w1, *rw_w2, *rw_a0, *rw_a1, *rw_a2, *rw_k_k, *rw_k_a, *rw_r_k, *rw_gn_g, *rw_gn_b, *rw_w_out;
  float* out;
  float* ws;
};

constexpr size_t OUT_Y = 0, OUT_CKV = 8388608, OUT_KPE = 8912896, OUT_ST = 9043968;

constexpr size_t SZ = (size_t)NTOK * D;
constexpr size_t WS_X = 0;
constexpr size_t WS_S1 = WS_X + SZ;
constexpr size_t WS_S4 = WS_S1 + SZ;
constexpr size_t WS_S2 = WS_S4 + SZ;
constexpr size_t WS_MISC = WS_S2 + 4 * SZ;
constexpr size_t MISC_MODS = 0;
constexpr size_t MISC_FILT = 65536;
constexpr size_t MISC_END = MISC_FILT + (size_t)2304 * 2048;

__device__ __forceinline__ float silu(float x) { return x / (1.f + expf(-x)); }
__device__ __forceinline__ float sigmoidf(float x) { return 1.f / (1.f + expf(-x)); }

__device__ __forceinline__ void tokinfo(int m, int& l, int& L, int& cond, int& m0) {
  if (m < NPT) { l = m & 255; L = 256; cond = 0; m0 = m & ~255; }
  else { int mm = m - NPT; l = mm & 2047; L = 2048; cond = 1 + (mm >> 11); m0 = NPT + (mm & ~2047); }
}

__global__ void k_mods(P p) {
  int idx = blockIdx.x * blockDim.x + threadIdx.x;
  if (idx >= 4 * 3 * 3072) return;
  int n = idx % 3072, g = (idx / 3072) % 3, i = idx / (3 * 3072);
  const float* cond = (g == 0) ? p.c_ctx : p.c + (size_t)(g - 1) * D;
  const float* w = p.mod_w + (size_t)i * D * 3072;
  float acc = 0.f;
  for (int k = 0; k < D; ++k) acc += silu(cond[k]) * w[(size_t)k * 3072 + n];
  p.ws[WS_MISC + MISC_MODS + idx] = acc + p.mod_b[i * 3072 + n];
}

__global__ void k_modulate(P p, const float* xa, const float* xb, float* H, int layer) {
  size_t idx = (size_t)blockIdx.x * blockDim.x + threadIdx.x;
  if (idx >= SZ) return;
  int m = (int)(idx >> 10), k = (int)(idx & 1023);
  int l, L, cond, m0; tokinfo(m, l, L, cond, m0);
  const float* md = p.ws + WS_MISC + MISC_MODS + (size_t)(layer * 3 + cond) * 3072;
  float x = (m < NPT) ? xa[idx] : xb[idx - (size_t)NPT * D];
  H[idx] = x * (1.f + md[1024 + k]) + md[k];
}

template <class AL, class EP>
__global__ void __launch_bounds__(256) k_gemm(AL al, const float* __restrict__ W, int ldw, int M, int N, int K, EP ep) {
  __shared__ float As[16][68];
  __shared__ float Bs[16][68];
  const int tx = threadIdx.x & 15, ty = threadIdx.x >> 4;
  const int m0 = blockIdx.y * 64, n0 = blockIdx.x * 64;
  float acc[4][4];
#pragma unroll
  for (int i = 0; i < 4; ++i)
#pragma unroll
    for (int j = 0; j < 4; ++j) acc[i][j] = 0.f;
  for (int k0 = 0; k0 < K; k0 += 16) {
#pragma unroll
    for (int i = 0; i < 4; ++i) {
      int e = threadIdx.x + i * 256; int mm = e >> 4, kk = e & 15;
      As[kk][mm] = (m0 + mm < M) ? al(m0 + mm, k0 + kk) : 0.f;
    }
#pragma unroll
    for (int i = 0; i < 4; ++i) {
      int e = threadIdx.x + i * 256; int kk = e >> 6, nn = e & 63;
      Bs[kk][nn] = (n0 + nn < N) ? W[(size_t)(k0 + kk) * ldw + n0 + nn] : 0.f;
    }
    __syncthreads();
#pragma unroll
    for (int kk = 0; kk < 16; ++kk) {
      float a[4], b[4];
#pragma unroll
      for (int i = 0; i < 4; ++i) { a[i] = As[kk][ty * 4 + i]; b[i] = Bs[kk][tx * 4 + i]; }
#pragma unroll
      for (int i = 0; i < 4; ++i)
#pragma unroll
        for (int j = 0; j < 4; ++j) acc[i][j] += a[i] * b[j];
    }
    __syncthreads();
  }
#pragma unroll
  for (int i = 0; i < 4; ++i)
#pragma unroll
    for (int j = 0; j < 4; ++j) {
      int m = m0 + ty * 4 + i, n = n0 + tx * 4 + j;
      if (m < M && n < N) ep(m, n, acc[i][j]);
    }
}

struct ALPlain { const float* A; long lda; __device__ float operator()(int m, int k) const { return A[(size_t)m * lda + k]; } };
struct EPPlain { float* C; long ldc; __device__ void operator()(int m, int n, float v) const { C[(size_t)m * ldc + n] = v; } };
struct EPTanh { float* C; long ldc; __device__ void operator()(int m, int n, float v) const { C[(size_t)m * ldc + n] = tanhf(v); } };
struct ALMix {
  const float* H; const float* mu;
  __device__ float operator()(int m, int k) const {
    int l, L, cond, m0; tokinfo(m, l, L, cond, m0);
    float h = H[(size_t)m * D + k];
    float pv = (l > 0) ? H[(size_t)(m - 1) * D + k] : 0.f;
    float nx = (l < L - 1) ? H[(size_t)(m + 1) * D + k] : 0.f;
    return h + (0.5f * (pv + nx) - h) * mu[k];
  }
};

template <class AL, class EP>
void gemm(hipStream_t s, AL al, const float* W, int ldw, int M, int N, int K, EP ep) {
  dim3 g((N + 63) / 64, (M + 63) / 64);
  hipLaunchKernelGGL((k_gemm<AL, EP>), g, dim3(256), 0, s, al, W, ldw, M, N, K, ep);
}

__global__ void __launch_bounds__(256) k_ln(P p, const float* xa, const float* xb, const float* O, float* Xn, int layer) {
  int m = blockIdx.x * 4 + (threadIdx.x >> 6), lane = threadIdx.x & 63;
  int l, L, cond, m0; tokinfo(m, l, L, cond, m0);
  const float* gate = p.ws + WS_MISC + MISC_MODS + (size_t)(layer * 3 + cond) * 3072 + 2048;
  const float* xr = (m < NPT) ? xa + (size_t)m * D : xb + (size_t)(m - NPT) * D;
  float v[16]; float s = 0.f;
#pragma unroll
  for (int i = 0; i < 16; ++i) { int k = lane + 64 * i; v[i] = ALPHA * xr[k] + gate[k] * O[(size_t)m * D + k]; s += v[i]; }
#pragma unroll
  for (int o = 1; o < 64; o <<= 1) s += __shfl_xor(s, o);
  float mu = s * (1.f / D), q = 0.f;
#pragma unroll
  for (int i = 0; i < 16; ++i) { v[i] -= mu; q += v[i] * v[i]; }
#pragma unroll
  for (int o = 1; o < 64; o <<= 1) q += __shfl_xor(q, o);
  float rs = rsqrtf(q * (1.f / D) + LN_EPS);
#pragma unroll
  for (int i = 0; i < 16; ++i) { int k = lane + 64 * i; Xn[(size_t)m * D + k] = v[i] * rs * p.ln_g[layer * D + k] + p.ln_b[layer * D + k]; }
}

__global__ void __launch_bounds__(256) k_hy_filter(P p, int j) {
  __shared__ float feat[33], h1[64], h2[64];
  int row = blockIdx.x; int L = row < 256 ? 256 : 2048; int l = row < 256 ? row : row - 256;
  int tid = threadIdx.x;
  float t = (float)l / (float)(L - 1);
  if (tid < 33) {
    float f;
    if (tid == 0) f = t;
    else {
      int b = (tid - 1) & 15;
      float band = 1e-4f + (float)b * ((15.f - 1e-4f) / 15.f);
      float ang = (6.283185307179586f / (float)L) * (float)l * band;
      f = (tid <= 16) ? cosf(ang) : -sinf(ang);
    }
    feat[tid] = f;
  }
  __syncthreads();
  if (tid < 64) {
    float a = p.hy_b1[j * 64 + tid];
    for (int f = 0; f < 33; ++f) a += feat[f] * p.hy_w1[((size_t)j * 33 + f) * 64 + tid];
    h1[tid] = sinf(p.hy_freq[(j * 2 + 0) * 64 + tid] * a);
  }
  __syncthreads();
  if (tid < 64) {
    float a = p.hy_b2[j * 64 + tid];
    for (int f = 0; f < 64; ++f) a += h1[f] * p.hy_w2[((size_t)j * 64 + f) * 64 + tid];
    h2[tid] = sinf(p.hy_freq[(j * 2 + 1) * 64 + tid] * a);
  }
  __syncthreads();
  for (int o = tid; o < 2048; o += 256) {
    float a = p.hy_b3[j * 2048 + o];
    for (int f = 0; f < 64; ++f) a += h2[f] * p.hy_w3[((size_t)j * 64 + f) * 2048 + o];
    float w = expf(-t * fabsf(p.hy_decay[(size_t)j * 2048 + o]));
    p.ws[WS_MISC + MISC_FILT + (size_t)row * 2048 + o] = a * w;
  }
}

__device__ __forceinline__ float conv3(const float* U, int m, int l, int L, int ch, const float* cw, const float* cb) {
  float cur = U[(size_t)m * 4096 + ch];
  float pv = (l > 0) ? U[(size_t)(m - 1) * 4096 + ch] : 0.f;
  float nx = (l < L - 1) ? U[(size_t)(m + 1) * 4096 + ch] : 0.f;
  return pv * cw[ch] + cur * cw[3072 + ch] + nx * cw[6144 + ch] + cb[ch];
}
__global__ void k_hy_vv(P p, const float* U, float* VV, int j) {
  size_t idx = (size_t)blockIdx.x * blockDim.x + threadIdx.x;
  if (idx >= SZ) return;
  int m = (int)(idx >> 10), c = (int)(idx & 1023);
  int l, L, cond, m0; tokinfo(m, l, L, cond, m0);
  const float* cw = p.hy_conv_w + (size_t)j * 3 * 3072; const float* cb = p.hy_conv_b + (size_t)j * 3072;
  float x1 = conv3(U, m, l, L, 1024 + c, cw, cb);
  float v = conv3(U, m, l, L, 2048 + c, cw, cb);
  VV[idx] = v * x1;
}
__global__ void k_hy_long(P p, const float* U, const float* VV, float* G, int j) {
  size_t idx = (size_t)blockIdx.x * blockDim.x + threadIdx.x;
  if (idx >= SZ) return;
  int m = (int)(idx >> 10), c = (int)(idx & 1023);
  int l, L, cond, m0; tokinfo(m, l, L, cond, m0);
  const float* F = p.ws + WS_MISC + MISC_FILT + (size_t)(L == 256 ? 0 : 256) * 2048;
  float acc = 0.f;
  for (int s = 0; s <= l; ++s) acc += VV[(size_t)(m0 + s) * D + c] * F[(size_t)(l - s) * 2048 + c];
  for (int s = l + 1; s < L; ++s) acc += VV[(size_t)(m0 + s) * D + c] * F[(size_t)(s - l) * 2048 + 1024 + c];
  const float* cw = p.hy_conv_w + (size_t)j * 3 * 3072; const float* cb = p.hy_conv_b + (size_t)j * 3072;
  float x0 = conv3(U, m, l, L, c, cw, cb);
  float z = U[(size_t)m * 4096 + 3072 + c];
  float y = (acc + VV[idx] * p.hy_skip[j * D + c]) * x0;
  G[idx] = y * silu(z);
}

__device__ __forceinline__ int kvrow(int m) { if (m < NPT) return m; int mm = m - NPT; return NPT + (mm >> 11) * 2560 + PAST + (mm & 2047); }
__device__ __forceinline__ void rope32(const float* x, float* o, int l) {
  int r = l >> 6, col = l & 63;
#pragma unroll
  for (int i = 0; i < 8; ++i) {
    float inv = powf(10000.f, -(float)(2 * i) / 16.f);
    float ar = (float)r * inv, ac = (float)col * inv;
    float cr = cosf(ar), sr = sinf(ar), cc = cosf(ac), sc = sinf(ac);
    o[i] = x[i] * cr - x[i + 8] * sr;
    o[i + 8] = x[i + 8] * cr + x[i] * sr;
    o[16 + i] = x[16 + i] * cc - x[24 + i] * sc;
    o[24 + i] = x[24 + i] * cc + x[16 + i] * sc;
  }
}
__global__ void __launch_bounds__(64) k_mla_extract(P p, const float* U2, float* QN, float* CKVALL, float* KPEALL, float* Z) {
  int m = blockIdx.x, lane = threadIdx.x;
  int l, L, cond, m0; tokinfo(m, l, L, cond, m0);
  const float* u = U2 + (size_t)m * 1440;
  float q[4], s = 0.f;
#pragma unroll
  for (int i = 0; i < 4; ++i) { q[i] = u[lane + 64 * i]; s += q[i] * q[i]; }
#pragma unroll
  for (int o = 1; o < 64; o <<= 1) s += __shfl_xor(s, o);
  float rs = rsqrtf(s * (1.f / 256.f) + RMS_EPS);
#pragma unroll
  for (int i = 0; i < 4; ++i) QN[(size_t)m * 256 + lane + 64 * i] = q[i] * rs * p.mla_q_norm[lane + 64 * i];
  float k0 = u[256 + lane], k1 = u[256 + 64 + lane];
  float s2 = k0 * k0 + k1 * k1;
#pragma unroll
  for (int o = 1; o < 64; o <<= 1) s2 += __shfl_xor(s2, o);
  float rs2 = rsqrtf(s2 * (1.f / 128.f) + RMS_EPS);
  float c0 = k0 * rs2 * p.mla_kv_norm[lane], c1 = k1 * rs2 * p.mla_kv_norm[64 + lane];
  int kr = kvrow(m);
  CKVALL[(size_t)kr * 128 + lane] = c0; CKVALL[(size_t)kr * 128 + 64 + lane] = c1;
  if (m < NPT) { p.out[OUT_CKV + (size_t)m * 128 + lane] = c0; p.out[OUT_CKV + (size_t)m * 128 + 64 + lane] = c1; }
  if (lane == 0) {
    float x[32], o[32];
#pragma unroll
    for (int i = 0; i < 32; ++i) x[i] = u[384 + i];
    if (m < NPT) {
#pragma unroll
      for (int i = 0; i < 32; ++i) { KPEALL[(size_t)kr * 32 + i] = x[i]; p.out[OUT_KPE + (size_t)m * 32 + i] = x[i]; }
    } else {
      rope32(x, o, l);
#pragma unroll
      for (int i = 0; i < 32; ++i) KPEALL[(size_t)kr * 32 + i] = o[i];
    }
  }
  for (int i = lane; i < 1024; i += 64) Z[(size_t)m * D + i] = u[416 + i];
}
__global__ void k_mla_cache(P p, float* CKVALL, float* KPEALL) {
  int idx = blockIdx.x * blockDim.x + threadIdx.x;
  if (idx >= 2 * PAST * 128) return;
  int d = idx & 127, pl = (idx >> 7) & 511, b = idx >> 16;
  int row = NPT + b * 2560 + pl;
  CKVALL[(size_t)row * 128 + d] = p.cache_ckv[idx];
  if (d < 32) KPEALL[(size_t)row * 32 + d] = p.cache_kpe[((size_t)b * PAST + pl) * 32 + d];
}
__global__ void k_rope_q(float* Q) {
  int idx = blockIdx.x * blockDim.x + threadIdx.x;
  if (idx >= 4096 * 16) return;
  int h = idx & 15, mm = idx >> 4; int m = NPT + mm; int l = mm & 2047;
  float* q = Q + (size_t)m * 1536 + h * 96 + 64;
  float x[32], o[32];
#pragma unroll
  for (int i = 0; i < 32; ++i) x[i] = q[i];
  rope32(x, o, l);
#pragma unroll
  for (int i = 0; i < 32; ++i) q[i] = o[i];
}
__global__ void __launch_bounds__(64) k_attn(const float* Q, const float* KV, const float* KPEALL, float* G) {
  int qi = blockIdx.x * 64 + threadIdx.x;
  int sh = blockIdx.y; int h = sh & 15, seq = sh >> 4;
  int L = seq < 16 ? 256 : 2048;
  if (qi >= L) return;
  int m = seq < 16 ? seq * 256 + qi : NPT + (seq - 16) * 2048 + qi;
  int kbase = seq < 16 ? seq * 256 : NPT + (seq - 16) * 2560;
  int nk = seq < 16 ? 256 : 2560;
  float q[96];
#pragma unroll
  for (int i = 0; i < 96; ++i) q[i] = Q[(size_t)m * 1536 + h * 96 + i];
  float acc[64];
#pragma unroll
  for (int i = 0; i < 64; ++i) acc[i] = 0.f;
  float mx = -1e30f, lsum = 0.f;
  const float scale = 0.10206207261596575f;
  for (int k = 0; k < nk; ++k) {
    const float* kv = KV + (size_t)(kbase + k) * 2048 + h * 128;
    const float* kp = KPEALL + (size_t)(kbase + k) * 32;
    float s = 0.f;
#pragma unroll
    for (int i = 0; i < 64; ++i) s += q[i] * kv[i];
#pragma unroll
    for (int i = 0; i < 32; ++i) s += q[64 + i] * kp[i];
    s *= scale;
    float mn = fmaxf(mx, s);
    float corr = expf(mx - mn), pe = expf(s - mn);
    lsum = lsum * corr + pe;
#pragma unroll
    for (int i = 0; i < 64; ++i) acc[i] = acc[i] * corr + pe * kv[64 + i];
    mx = mn;
  }
  float inv = 1.f / lsum;
#pragma unroll
  for (int i = 0; i < 64; ++i) { size_t o = (size_t)m * D + h * 64 + i; G[o] = acc[i] * inv * silu(G[o]); }
}

__global__ void __launch_bounds__(64) k_rw_scan(P p, const float* R, const float* K, const float* V, const float* HW, const float* HA, float* Y) {
  int id = blockIdx.x;
  int h = id & 15, dir = (id >> 4) & 1, seq = id >> 5;
  int lane = threadIdx.x;
  int L = seq < 16 ? 256 : 2048;
  int m0 = seq < 16 ? seq * 256 : NPT + (seq - 16) * 2048;
  int ch = h * 64 + lane;
  float S[64];
  if (seq < 16) {
#pragma unroll
    for (int j = 0; j < 64; ++j) S[j] = 0.f;
  } else {
    const float* s0 = p.state_rwkv + ((((size_t)(seq - 16) * 1 + 0) * 2 + dir) * 16 + h) * 4096 + (size_t)lane * 64;
#pragma unroll
    for (int j = 0; j < 64; ++j) S[j] = s0[j];
  }
  const float w0 = p.rw_w0[dir * D + ch], a0 = p.rw_a0[dir * D + ch];
  const float kkw = p.rw_k_k[ch], kaw = p.rw_k_a[ch];
  const float* w2 = p.rw_w2 + (size_t)dir * 64 * D + ch;
  const float* a2 = p.rw_a2 + (size_t)dir * 64 * D + ch;
  for (int st = 0; st < L; ++st) {
    int t = dir ? (L - 1 - st) : st;
    int m = m0 + t;
    float wl = w0, al = a0;
    const float* hw = HW + (size_t)m * 128 + dir * 64;
    const float* ha = HA + (size_t)m * 128 + dir * 64;
    for (int r = 0; r < 64; ++r) { wl += hw[r] * w2[(size_t)r * D]; al += ha[r] * a2[(size_t)r * D]; }
    float sp = (-wl > 20.f) ? -wl : log1pf(expf(-wl));
    float dec = expf(-expf(-sp - 0.5f));
    float a = sigmoidf(al);
    float k = K[(size_t)m * D + ch], r_ = R[(size_t)m * D + ch], v = V[(size_t)m * D + ch];
    float kk = k * kkw; float ss = kk * kk;
#pragma unroll
    for (int o = 1; o < 64; o <<= 1) ss += __shfl_xor(ss, o);
    kk *= rsqrtf(ss + 1e-12f);
    float kd = k * (1.f + (a - 1.f) * kaw);
    float bd = kk * a;
    float at = -kk;
    float sa = 0.f;
#pragma unroll
    for (int j = 0; j < 64; ++j) sa += S[j] * __shfl(at, j);
    float y = 0.f;
#pragma unroll
    for (int j = 0; j < 64; ++j) {
      float wj = __shfl(dec, j), bj = __shfl(bd, j), kj = __shfl(kd, j), rj = __shfl(r_, j);
      S[j] = S[j] * wj + sa * bj + v * kj;
      y += S[j] * rj;
    }
    atomicAdd(&Y[(size_t)m * D + ch], y);
  }
  if (seq < 16) {
    float* so = p.out + OUT_ST + ((((size_t)seq * 1 + 0) * 2 + dir) * 16 + h) * 4096 + (size_t)lane * 64;
#pragma unroll
    for (int j = 0; j < 64; ++j) so[j] = S[j];
  }
}
__global__ void __launch_bounds__(64) k_rw_post(P p, const float* R, const float* K, const float* V, const float* Z, const float* HA, const float* Y, float* G) {
  int m = blockIdx.x >> 4, h = blockIdx.x & 15, lane = threadIdx.x; int ch = h * 64 + lane;
  float y = Y[(size_t)m * D + ch];
  float s = y;
#pragma unroll
  for (int o = 1; o < 64; o <<= 1) s += __shfl_xor(s, o);
  float mu = s * (1.f / 64.f); float d = y - mu; float q = d * d;
#pragma unroll
  for (int o = 1; o < 64; o <<= 1) q += __shfl_xor(q, o);
  float yn = d * rsqrtf(q * (1.f / 64.f) + GN_EPS) * p.rw_gn_g[ch] + p.rw_gn_b[ch];
  float k = K[(size_t)m * D + ch], r_ = R[(size_t)m * D + ch], v = V[(size_t)m * D + ch];
  float bsum = 0.f;
  for (int dir = 0; dir < 2; ++dir) {
    float al = p.rw_a0[dir * D + ch];
    const float* ha = HA + (size_t)m * 128 + dir * 64;
    const float* a2 = p.rw_a2 + (size_t)dir * 64 * D + ch;
    for (int r = 0; r < 64; ++r) al += ha[r] * a2[(size_t)r * D];
    float a = sigmoidf(al);
    float kd = k * (1.f + (a - 1.f) * p.rw_k_a[ch]);
    bsum += r_ * kd * p.rw_r_k[ch];
  }
#pragma unroll
  for (int o = 1; o < 64; o <<= 1) bsum += __shfl_xor(bsum, o);
  float o_ = yn + bsum * v;
  G[(size_t)m * D + ch] = o_ * silu(Z[(size_t)m * D + ch]);
}

typedef unsigned short bf16_t;
namespace pg8 {
#define PG8_LAS __attribute__((address_space(3)))
typedef unsigned short bf16_t;
typedef short bf16x8 __attribute__((ext_vector_type(8)));
typedef float f32x4 __attribute__((ext_vector_type(4)));
typedef unsigned u32x4 __attribute__((ext_vector_type(4)));
constexpr int BM = 256, BK = 64, HALF = 128, HTB = HALF * BK * 2  , STAGE_BYTES = 8 * HTB, NXCD = 8, WGM = 8;

__host__ __device__ __forceinline__ int lds_byte(int r, int c) { const int st = (r >> 4) * 2 + (c >> 5), rr = r & 15, cc = c & 31, ob = rr * 64 + cc * 2; return st * 1024 + (ob ^ (((ob >> 9) & 1) << 5)); }
__host__ __device__ __forceinline__ void stage_rc(int b, int& R, int& C) { const int st = b / 1024, sb = b % 1024, swz = sb ^ (((sb >> 9) & 1) << 5); R = (st >> 1) * 16 + swz / 64; C = (st & 1) * 32 + (swz % 64) / 2; }
__host__ __device__ __forceinline__ int perm32(int rho) { const int n = rho >> 4, i = rho & 15; return 8 * (i >> 2) + 4 * n + (i & 3); }

struct Unit { int pm, pn; };
struct Gemm { const bf16_t* A; const bf16_t* Bt; int M, N, K; };

struct StaticOrder {
    int nM, nN, nwg, G, c;
    __host__ __device__ void init(int M, int N, int G_, int c_) { nM = M / BM; nN = N / BM; nwg = nM * nN; G = G_; c = c_; }
    __host__ __device__ bool next(int i, Unit& u) const {
        const long L = (long)i * G + c; if (L >= nwg) return false;
        int wgid = (int)L; { const int q = nwg / NXCD, r = nwg % NXCD, xcd = wgid % NXCD, off = wgid / NXCD; wgid = (xcd < r ? xcd * (q + 1) : r * (q + 1) + (xcd - r) * q) + off; }
        const int nig = WGM * nN, gid = wgid / nig, fm = gid * WGM, gsz = (nM - fm) < WGM ? (nM - fm) : WGM;
        u.pm = fm + ((wgid % nig) % gsz); u.pn = (wgid % nig) / gsz; return true;
    }
    __device__ __forceinline__ void a_ready(const Unit&) const {}
    __device__ __forceinline__ void done(const Unit&) const {}
};
__device__ __forceinline__ unsigned cvt_pk_bf16(float lo, float hi) { unsigned r; asm volatile("v_cvt_pk_bf16_f32 %0, %1, %2" : "=v"(r) : "v"(lo), "v"(hi)); return r; }
typedef float f32x2 __attribute__((ext_vector_type(2)));
template <int ACT  > struct EpiBf16 {
    static constexpr bool PERM = true, AFTER_DRAIN = false; static_assert(ACT == 0 || ACT == 1, "EpiBf16: ACT is 0 (none) or 1 (gelu_pk)");
    bf16_t* O; int ldc; const float* bias; int split_cols; size_t split_stride; float scale0;
    __device__ __forceinline__ void operator()(const f32x4 (&acc)[2][2][4][2], const Unit& u, int wr, int wc, int fr, int fq) const {
        const int row0 = u.pm * BM + wr * 64 + fr; int colt = u.pn * BM; bf16_t* base = O;
        float sc = 1.f; if (split_cols) { const int t = colt / split_cols; base += (size_t)t * split_stride; colt -= t * split_cols; if (t == 0) sc = scale0; }
        const int col0 = colt + wc * 32 + 8 * fq, bcol0 = u.pn * BM + wc * 32 + 8 * fq;
        f32x4 bv[2][2];
#pragma unroll
        for (int bj = 0; bj < 2; ++bj)
#pragma unroll
            for (int n = 0; n < 2; ++n) bv[bj][n] = bias ? *(const f32x4*)(bias + bcol0 + bj * HALF + 4 * n) : (f32x4){0.f, 0.f, 0.f, 0.f};
#pragma unroll
        for (int ai = 0; ai < 2; ++ai)
#pragma unroll
            for (int m = 0; m < 4; ++m) { bf16_t* rowp = base + (size_t)(row0 + ai * HALF + m * 16) * ldc + col0;
#pragma unroll
                for (int bj = 0; bj < 2; ++bj) { f32x4 v0 = acc[ai][bj][m][0] + bv[bj][0], v1 = acc[ai][bj][m][1] + bv[bj][1];
                    v0 = v0 * sc; v1 = v1 * sc; u32x4 w; w.x = cvt_pk_bf16(v0[0], v0[1]); w.y = cvt_pk_bf16(v0[2], v0[3]); w.z = cvt_pk_bf16(v1[0], v1[1]); w.w = cvt_pk_bf16(v1[2], v1[3]);
                    *(u32x4*)(rowp + bj * HALF) = w; } }
    }
};
template <class Epi, class Sched, bool ALIGN_EPI = false, bool SP2 = false>
__device__ __forceinline__ void gemm_phase(PG8_LAS unsigned char* lds, const Gemm g, const Sched& S, const Epi& E) {
    const int tid = threadIdx.x, wid = __builtin_amdgcn_readfirstlane(tid >> 6), lane = tid & 63, wr = wid >> 2, wc = wid & 3, fr = lane & 15, fq = lane >> 4;
    const int K = g.K, nt = K / BK;
    unsigned voffA[2], voffB[2];
#pragma unroll
    for (int i = 0; i < 2; ++i) { int R, C; stage_rc(tid * 16 + i * 8192, R, C); const int Rb = Epi::PERM ? ((R & ~31) + perm32(R & 31)) : R;
        voffA[i] = (unsigned)(R * K + C) * 2u; voffB[i] = (unsigned)(Rb * K + C) * 2u; }
    const size_t kstep = (size_t)(BK * 2);
    const size_t hstep = (size_t)HALF * K * 2;
    const size_t tstep = 2 * hstep;
    const unsigned ldsw = (unsigned)wid * 1024u;
    const int aoff = lds_byte(wr * 64 + fr, fq * 8), boff = lds_byte(wc * 32 + fr, fq * 8);
#define PG8_SA(b, h) (((b) * 2 + (h)) * HTB)
#define PG8_SB(b, h) ((4 + (b) * 2 + (h)) * HTB)
#define PG8_STAGE(bufoff, gbase, voff) do { _Pragma("unroll") for (int _i = 0; _i < 2; ++_i) \
        __builtin_amdgcn_global_load_lds((const unsigned*)((const char*)(gbase) + (voff)[_i]), (PG8_LAS unsigned*)(lds + (bufoff) + ldsw + _i * 8192), 16, 0, 0); } while (0)
#define PG8_LDA(dst, b, h) do { _Pragma("unroll") for (int m = 0; m < 4; ++m) _Pragma("unroll") for (int k = 0; k < 2; ++k) dst[m][k] = *(const PG8_LAS bf16x8*)(lds + PG8_SA(b, h) + aoff + m * 2048 + k * 1024); } while (0)
#define PG8_LDB(dst, b, h) do { _Pragma("unroll") for (int n = 0; n < 2; ++n) _Pragma("unroll") for (int k = 0; k < 2; ++k) dst[n][k] = *(const PG8_LAS bf16x8*)(lds + PG8_SB(b, h) + boff + n * 2048 + k * 1024); } while (0)
#define PG8_MMA(ai, bj, At, Bt) do { __builtin_amdgcn_s_setprio(1); _Pragma("unroll") for (int m = 0; m < 4; ++m) _Pragma("unroll") for (int n = 0; n < 2; ++n) _Pragma("unroll") for (int k = 0; k < 2; ++k) \
        acc[ai][bj][m][n] = __builtin_amdgcn_mfma_f32_16x16x32_bf16(Bt[n][k], At[m][k], acc[ai][bj][m][n], 0, 0, 0); __builtin_amdgcn_s_setprio(0); } while (0)
#define PG8_WAIT_V(n) asm volatile("s_waitcnt vmcnt(" #n ")" ::: "memory")
#define PG8_WAIT_L(n) asm volatile("s_waitcnt lgkmcnt(" #n ")" ::: "memory")
#define PG8_BAR __builtin_amdgcn_s_barrier()
#define PG8_SCHED __builtin_amdgcn_sched_barrier(0)
    Unit cur, nxt; int ui = 0;
    if (!S.next(0, cur)) return;
    f32x4 acc[2][2][4][2];
#pragma unroll
    for (int a = 0; a < 2; ++a)
#pragma unroll
        for (int b = 0; b < 2; ++b)
#pragma unroll
            for (int m = 0; m < 4; ++m)
#pragma unroll
                for (int n = 0; n < 2; ++n) acc[a][b][m][n] = (f32x4){0.f, 0.f, 0.f, 0.f};
    bf16x8 At[4][2], B0[2][2], B1[2][2];
    const char* cA = (const char*)g.A + (size_t)cur.pm * tstep; const char* cB = (const char*)g.Bt + (size_t)cur.pn * tstep;
    S.a_ready(cur);
    if constexpr (SP2) {
        PG8_STAGE(PG8_SB(0, 0), cB, voffB); PG8_STAGE(PG8_SB(0, 1), cB + hstep, voffB); PG8_STAGE(PG8_SA(0, 0), cA, voffA); PG8_STAGE(PG8_SA(0, 1), cA + hstep, voffA);
        if (wr == 1) PG8_BAR;
        PG8_WAIT_V(2); PG8_BAR;
        PG8_STAGE(PG8_SB(1, 0), cB + kstep, voffB); PG8_STAGE(PG8_SA(1, 0), cA + kstep, voffA); PG8_STAGE(PG8_SB(1, 1), cB + hstep + kstep, voffB);
        PG8_WAIT_V(6); PG8_BAR;
    } else {
        PG8_STAGE(PG8_SB(0, 0), cB, voffB); PG8_STAGE(PG8_SA(0, 0), cA, voffA); PG8_STAGE(PG8_SB(0, 1), cB + hstep, voffB); PG8_STAGE(PG8_SA(0, 1), cA + hstep, voffA);
        if (wr == 1) PG8_BAR;
        PG8_WAIT_V(4); PG8_BAR;
        PG8_STAGE(PG8_SB(1, 0), cB + kstep, voffB); PG8_STAGE(PG8_SA(1, 0), cA + kstep, voffA); PG8_STAGE(PG8_SB(1, 1), cB + hstep + kstep, voffB);
        PG8_WAIT_V(6); PG8_BAR;
    }
    for (;;) {
        const bool has_next = S.next(ui + 1, nxt);
        const char* nA = has_next ? (const char*)g.A + (size_t)nxt.pm * tstep : cA; const char* nB = has_next ? (const char*)g.Bt + (size_t)nxt.pn * tstep : cB;
        for (int t = 0; t < nt; t += 2) {
            const bool last = (t == nt - 2);
            const char* a1 = cA + (size_t)(t + 1) * kstep;
            const char* a2 = last ? nA : cA + (size_t)(t + 2) * kstep; const char* b2 = last ? nB : cB + (size_t)(t + 2) * kstep;
            const char* a3 = a2 + kstep; const char* b3 = b2 + kstep;
            if (last && has_next) S.a_ready(nxt);
            if constexpr (SP2) {
            PG8_LDB(B0, 0, 0); PG8_LDB(B1, 0, 1); PG8_SCHED; PG8_LDA(At, 0, 0); PG8_STAGE(PG8_SA(1, 1), a1 + hstep, voffA);
            PG8_WAIT_V(8); PG8_WAIT_L(0); PG8_BAR; PG8_MMA(0, 0, At, B0); PG8_MMA(0, 1, At, B1); PG8_BAR; PG8_SCHED;
            PG8_LDA(At, 0, 1); PG8_STAGE(PG8_SB(0, 0), b2, voffB); PG8_STAGE(PG8_SB(0, 1), b2 + hstep, voffB); PG8_STAGE(PG8_SA(0, 0), a2, voffA);
            PG8_WAIT_V(8); PG8_WAIT_L(0); PG8_BAR; PG8_MMA(1, 0, At, B0); PG8_MMA(1, 1, At, B1); PG8_BAR; PG8_SCHED;
            PG8_LDB(B0, 1, 0); PG8_LDB(B1, 1, 1); PG8_SCHED; PG8_LDA(At, 1, 0); PG8_STAGE(PG8_SA(0, 1), a2 + hstep, voffA);
            PG8_WAIT_V(8); PG8_WAIT_L(0); PG8_BAR; PG8_MMA(0, 0, At, B0); PG8_MMA(0, 1, At, B1); PG8_BAR; PG8_SCHED;
            PG8_LDA(At, 1, 1); PG8_STAGE(PG8_SB(1, 0), b3, voffB); PG8_STAGE(PG8_SB(1, 1), b3 + hstep, voffB); PG8_STAGE(PG8_SA(1, 0), a3, voffA);
            PG8_WAIT_V(8); PG8_WAIT_L(0); PG8_BAR; PG8_MMA(1, 0, At, B0); PG8_MMA(1, 1, At, B1); PG8_BAR; PG8_SCHED;
            } else {
            PG8_LDB(B0, 0, 0); PG8_SCHED; PG8_LDA(At, 0, 0); PG8_STAGE(PG8_SA(1, 1), a1 + hstep, voffA);
            PG8_WAIT_L(8); PG8_BAR; PG8_WAIT_L(0); PG8_MMA(0, 0, At, B0); PG8_BAR; PG8_SCHED;
            PG8_LDB(B1, 0, 1); PG8_STAGE(PG8_SB(0, 0), b2, voffB);
            PG8_BAR; PG8_WAIT_L(0); PG8_MMA(0, 1, At, B1); PG8_BAR;
            PG8_LDA(At, 0, 1); PG8_STAGE(PG8_SA(0, 0), a2, voffA);
            PG8_BAR; PG8_WAIT_L(0); PG8_MMA(1, 0, At, B0); PG8_BAR; PG8_SCHED;
            PG8_STAGE(PG8_SB(0, 1), b2 + hstep, voffB);
            PG8_WAIT_V(6); PG8_BAR; PG8_MMA(1, 1, At, B1); PG8_BAR;
            PG8_LDB(B0, 1, 0); PG8_SCHED; PG8_LDA(At, 1, 0); PG8_STAGE(PG8_SA(0, 1), a2 + hstep, voffA);
            PG8_WAIT_L(8); PG8_BAR; PG8_WAIT_L(0); PG8_MMA(0, 0, At, B0); PG8_BAR; PG8_SCHED;
            PG8_LDB(B1, 1, 1); PG8_STAGE(PG8_SB(1, 0), b3, voffB);
            PG8_BAR; PG8_WAIT_L(0); PG8_MMA(0, 1, At, B1); PG8_BAR;
            PG8_LDA(At, 1, 1); PG8_STAGE(PG8_SA(1, 0), a3, voffA);
            PG8_BAR; PG8_WAIT_L(0); PG8_MMA(1, 0, At, B0); PG8_BAR; PG8_SCHED;
            PG8_STAGE(PG8_SB(1, 1), b3 + hstep, voffB);
            PG8_WAIT_V(6); PG8_BAR; PG8_MMA(1, 1, At, B1); PG8_BAR;
            }
        }
        if constexpr (ALIGN_EPI) { if (wr == 0) PG8_BAR; }
        if constexpr (!Epi::AFTER_DRAIN) { E(acc, cur, wr, wc, fr, fq); S.done(cur); }
        if (!has_next) break;
#pragma unroll
        for (int a = 0; a < 2; ++a)
#pragma unroll
            for (int b = 0; b < 2; ++b)
#pragma unroll
                for (int m = 0; m < 4; ++m)
#pragma unroll
                    for (int n = 0; n < 2; ++n) acc[a][b][m][n] = (f32x4){0.f, 0.f, 0.f, 0.f};
        cur = nxt; cA = nA; cB = nB; ++ui;
        if constexpr (ALIGN_EPI) { if (wr == 1) PG8_BAR; }
    }
    PG8_WAIT_V(0);
    if constexpr (!ALIGN_EPI) { if (wr == 0) PG8_BAR; }
    PG8_BAR;
    if constexpr (Epi::AFTER_DRAIN) { E.fused(acc, cur, wr, wc, fr, fq, lds, wid, lane); S.done(cur); }
#undef PG8_SA
#undef PG8_SB
#undef PG8_STAGE
#undef PG8_LDA
#undef PG8_LDB
#undef PG8_MMA
#undef PG8_WAIT_V
#undef PG8_WAIT_L
#undef PG8_BAR
#undef PG8_SCHED
}
}
#define GAS __attribute__((address_space(1)))
#define LAS __attribute__((address_space(3)))
typedef unsigned short bf16;
typedef unsigned v4u __attribute__((ext_vector_type(4)));
typedef float f32x4 __attribute__((ext_vector_type(4)));
typedef short bf16x8 __attribute__((ext_vector_type(8)));
typedef GAS unsigned gu32;
typedef GAS unsigned long long gu64;
#define RLX_AGENT __ATOMIC_RELAXED, __HIP_MEMORY_SCOPE_AGENT
#define LDS_WAIT() asm volatile("s_waitcnt lgkmcnt(0)" ::: "memory")
#define VM_WAIT() asm volatile("s_waitcnt vmcnt(0)" ::: "memory")
__device__ __forceinline__ unsigned long long rt() { return __builtin_amdgcn_s_memrealtime(); }
__device__ __forceinline__ unsigned f2bf(float f) { unsigned u = __builtin_bit_cast(unsigned, f); return (u + 0x7fffu + ((u >> 16) & 1u)) >> 16; }
__device__ __forceinline__ unsigned pk2(float lo, float hi) { return f2bf(lo) | (f2bf(hi) << 16); }

#define XB_TMO      128
#define XB_XCNT(j)  (256  + 64 * (j))
#define XB_XSUB(j)  (1280 + 64 * (j))
#define XB_XGEN(j)  (2304 + 64 * (j))
#define XB_TOP      3328
#define XB_TOPGEN   3392
#define XCD_BAR_WORDS 3456
#define XB_SPIN_CAP (1u << 18)

__device__ __forceinline__ unsigned xb_ld(unsigned* p)              { return __hip_atomic_load(p, __ATOMIC_RELAXED, __HIP_MEMORY_SCOPE_AGENT); }
__device__ __forceinline__ unsigned xb_add(unsigned* p, unsigned v) { return __hip_atomic_fetch_add(p, v, __ATOMIC_RELAXED, __HIP_MEMORY_SCOPE_AGENT); }
__device__ __forceinline__ unsigned xb_xcc_id() { return (unsigned)__builtin_amdgcn_s_getreg((3 << 11) | 20) & 0xFu; }
#define XB_SPIN(cond, bar) do { unsigned _sp = 0; while (cond) { __builtin_amdgcn_s_sleep(1); \
    if ((++_sp & 255u) == 0u) { if (xb_ld(&(bar)[XB_TMO])) break; if (_sp > XB_SPIN_CAP) { atomicAdd(&(bar)[XB_TMO], 1u); break; } } } } while (0)

struct XcdBarrier {
    unsigned* bar; unsigned x;
    volatile LAS unsigned* st;
};

__device__ __forceinline__ XcdBarrier xcd_barrier_post(unsigned* bar, volatile LAS unsigned* st) {
    XcdBarrier b; b.bar = bar; b.x = xb_xcc_id(); b.st = st;
    if (threadIdx.x == 0) (void)xb_add(&bar[XB_XCNT(b.x)], 1u);
    return b;
}
__device__ __forceinline__ void xcd_barrier_complete(unsigned* bar, unsigned x, unsigned& nloc, unsigned& nx) {
    const unsigned G = gridDim.x * gridDim.y * gridDim.z;
    unsigned sum, cnt, mine, sp = 0u;
    for (;;) {
        sum = 0u; cnt = 0u; mine = 0u;
#pragma unroll
        for (unsigned j = 0; j < 16; ++j) { const unsigned c = xb_ld(&bar[XB_XCNT(j)]); sum += c; cnt += (c > 0u) ? 1u : 0u; mine = (j == x) ? c : mine; }
        if (sum == G) break;
        __builtin_amdgcn_s_sleep(1);
        if ((++sp & 255u) == 0u) { if (xb_ld(&bar[XB_TMO])) break; if (sp > XB_SPIN_CAP) { atomicAdd(&bar[XB_TMO], 1u); break; } }
    }
    nloc = mine > 0u ? mine : 1u; nx = cnt > 0u ? cnt : 1u;
}

__device__ __forceinline__ void xcd_barrier(const XcdBarrier& b) {
    asm volatile("s_waitcnt vmcnt(0)" ::: "memory");
    __syncthreads();
    if (threadIdx.x == 0) {
        unsigned* bar = b.bar;
        __builtin_amdgcn_s_waitcnt(0);
        unsigned nloc = b.st[0], nx = b.st[1];
        if (nloc == 0u) { xcd_barrier_complete(bar, b.x, nloc, nx); b.st[0] = nloc; b.st[1] = nx; }
        const unsigned old = xb_add(&bar[XB_XSUB(b.x)], 1u);
        const unsigned gen = old / nloc;
        if (old + 1u == (gen + 1u) * nloc) {
            __builtin_amdgcn_fence(__ATOMIC_RELEASE, "agent");
            asm volatile("s_waitcnt vmcnt(0)" ::: "memory");
            const unsigned og = xb_add(&bar[XB_TOP], 1u);
            const unsigned tg = og / nx;
            if (og + 1u == (tg + 1u) * nx) xb_add(&bar[XB_TOPGEN], 1u);
            else XB_SPIN(xb_ld(&bar[XB_TOPGEN]) == tg, bar);
            __builtin_amdgcn_fence(__ATOMIC_ACQUIRE, "agent");
            xb_add(&bar[XB_XGEN(b.x)], 1u);
            asm volatile("s_waitcnt vmcnt(0)" ::: "memory");
        } else {
            XB_SPIN(xb_ld(&bar[XB_XGEN(b.x)]) == gen, bar);
            __builtin_amdgcn_fence(__ATOMIC_ACQUIRE, "agent");
            asm volatile("s_waitcnt vmcnt(0)" ::: "memory");
        }
    }
    __syncthreads();
}
typedef __attribute__((address_space(1))) float GASF;
struct PG {
  const GASF *x_prompt, *x_sample, *cache_ckv, *cache_kpe, *state_rwkv, *c, *c_ctx;
  const GASF *mod_w, *mod_b, *ln_g, *ln_b;
  const GASF *hy_w_in, *hy_conv_w, *hy_conv_b, *hy_w1, *hy_b1, *hy_w2, *hy_b2, *hy_w3, *hy_b3, *hy_freq, *hy_decay, *hy_skip, *hy_w_out;
  const GASF *mla_w_in, *mla_q_norm, *mla_kv_norm, *mla_w_q_up, *mla_w_kv_up, *mla_w_out;
  const GASF *rw_mu, *rw_w_in, *rw_w0, *rw_w1, *rw_w2, *rw_a0, *rw_a1, *rw_a2, *rw_k_k, *rw_k_a, *rw_r_k, *rw_gn_g, *rw_gn_b, *rw_w_out;
  GASF* out;
  GASF* ws;
};
namespace mk {
typedef float f32x16 __attribute__((ext_vector_type(16)));
typedef short v4i16_t __attribute__((ext_vector_type(4)));
typedef unsigned u32x4 __attribute__((ext_vector_type(4)));
typedef unsigned u32x2 __attribute__((ext_vector_type(2)));
typedef unsigned short u16;

constexpr size_t MiB = 1u << 20;
constexpr size_t M_X = 0, M_HB = 32 * MiB, M_GB = 48 * MiB, M_UT = 64 * MiB, M_SCR2 = 128 * MiB, M_WTS = 192 * MiB, M_FILT = 230 * MiB;
constexpr size_t M_HDN2 = 248 * MiB + 512 * 1024, M_MODP = 250 * MiB, M_MODS = 254 * MiB, M_CTL = 255 * MiB;
constexpr size_t W_HYIN = M_WTS, W_HYOUT = M_WTS + 16 * MiB, W_MLAIN = M_WTS + 20 * MiB, W_QUP = M_WTS + 23 * MiB, W_KVUP = M_WTS + 24 * MiB,
                 W_MLAOUT = M_WTS + 25 * MiB, W_RWIN = M_WTS + 27 * MiB, W_LORA1 = M_WTS + 35 * MiB, W_RWOUT = M_WTS + 36 * MiB;
constexpr size_t M_U2S = M_SCR2 + 24 * MiB;
constexpr size_t M_QN = M_SCR2, M_CKVALL = M_SCR2 + 4 * MiB, M_KPEB = M_SCR2 + 7 * MiB, M_SZB = M_SCR2 + 8 * MiB, M_Q = M_UT, M_KN = M_UT + 24 * MiB, M_V = M_UT + 42 * MiB;
constexpr int FILT_CH = 4640;
constexpr int LDS_BYTES = 163840, MISC_OFF = LDS_BYTES - 512, PTAB_OFF = LDS_BYTES - 1024;

__device__ __forceinline__ float bf2f(unsigned v) { return __builtin_bit_cast(float, v << 16); }
typedef float f32x2_t __attribute__((ext_vector_type(2))); typedef __bf16 bf16x2_t __attribute__((ext_vector_type(2)));
__device__ __forceinline__ unsigned pk2_(float lo, float hi) { const f32x2_t v = {lo, hi}; const bf16x2_t b = __builtin_convertvector(v, bf16x2_t); return __builtin_bit_cast(unsigned, b); }
__device__ __forceinline__ unsigned f2bf_(float f) { return pk2_(f, 0.f) & 0xffffu; }
__device__ __forceinline__ v4i16_t vtr(LAS const unsigned char* p) { return __builtin_amdgcn_ds_read_tr16_b64_v4i16((LAS v4i16_t*)p); }
template <class T> __device__ __forceinline__ T* uni(T* p) {
  const unsigned long long v = (unsigned long long)p;
  const unsigned lo = __builtin_amdgcn_readfirstlane((unsigned)v), hi = __builtin_amdgcn_readfirstlane((unsigned)(v >> 32));
  return (T*)(((unsigned long long)hi << 32) | lo);
}
__device__ __forceinline__ float wsum(float v) {
#pragma unroll
  for (int o = 1; o < 64; o <<= 1) v += __shfl_xor(v, o);
  return v;
}
__device__ __forceinline__ const GASF* xrow_in(const LAS PG& p, int layer, const unsigned char* ws, int m) {
  if (layer == 0) return (m < NPT) ? p.x_prompt + (size_t)m * D : p.x_sample + (size_t)(m - NPT) * D;
  if (layer == 2) return p.out + OUT_Y + (size_t)m * D;
  return (const GASF*)(ws + M_X) + (size_t)m * D;
}

struct TrD { const GASF* W; bf16_t* WT; int K, N, kind, row_off, item; };
constexpr int I_HYIN = 16 * 128, I_SQ = 16 * 32, I_MLAIN = 16 * 45, I_QUP = 4 * 48, I_KVUP = 2 * 64, I_LORA = 16 * 2;
constexpr int NTR = 2 * I_HYIN + 2 * I_SQ + I_MLAIN + I_QUP + I_KVUP + I_SQ + 4 * I_SQ + 4 * I_LORA + I_SQ;
constexpr int NTR_DEF = I_HYIN + I_SQ + I_SQ;
constexpr int NTR_DEF2 = 4 * I_SQ + 4 * I_LORA;
constexpr int NTR_P0 = NTR - NTR_DEF - NTR_DEF2;
constexpr int R_RWIN = 2 * I_HYIN + 2 * I_SQ + I_MLAIN + I_QUP + I_KVUP + I_SQ;
__device__ __forceinline__ int tr_map_p0(int idx) { return idx < I_HYIN ? idx : (idx < I_HYIN + I_SQ ? 2 * I_HYIN + (idx - I_HYIN) : 2 * I_HYIN + 2 * I_SQ + (idx - I_HYIN - I_SQ)); }
__device__ __forceinline__ int tr_map_def(int idx) { return idx < I_HYIN ? I_HYIN + idx : (idx < I_HYIN + I_SQ ? 2 * I_HYIN + I_SQ + (idx - I_HYIN) : NTR - I_SQ + (idx - I_HYIN - I_SQ)); }
__device__ __forceinline__ int tr_map_def2(int idx) { return R_RWIN + idx; }
__device__ __forceinline__ TrD tr_decode(const LAS PG& p, unsigned char* ws, int r) {
  TrD d; d.kind = 0; d.row_off = 0; d.K = 1024; d.N = 1024;
  if (r < 2 * I_HYIN) { const int j = r / I_HYIN; d.W = p.hy_w_in + (size_t)j * D * 4096; d.N = 4096; d.WT = (bf16_t*)(ws + W_HYIN + (size_t)j * 8 * MiB); d.item = r % I_HYIN; return d; } r -= 2 * I_HYIN;
  if (r < 2 * I_SQ) { const int j = r / I_SQ; d.W = p.hy_w_out + (size_t)j * D * D; d.WT = (bf16_t*)(ws + W_HYOUT + (size_t)j * 2 * MiB); d.kind = 1; d.item = r % I_SQ; return d; } r -= 2 * I_SQ;
  if (r < I_MLAIN) { const int nb = r % 45; d.W = p.mla_w_in; d.N = 1440; d.item = r; if (nb < 13) d.WT = (bf16_t*)(ws + W_MLAIN); else { d.WT = (bf16_t*)(ws + W_MLAIN + MiB); d.row_off = -416; } return d; } r -= I_MLAIN;
  if (r < I_QUP) { d.W = p.mla_w_q_up; d.K = 256; d.N = 1536; d.WT = (bf16_t*)(ws + W_QUP); d.item = r; return d; } r -= I_QUP;
  if (r < I_KVUP) { d.W = p.mla_w_kv_up; d.K = 128; d.N = 2048; d.WT = (bf16_t*)(ws + W_KVUP); d.item = r; return d; } r -= I_KVUP;
  if (r < I_SQ) { d.W = p.mla_w_out; d.WT = (bf16_t*)(ws + W_MLAOUT); d.kind = 1; d.item = r; return d; } r -= I_SQ;
  if (r < 4 * I_SQ) { const int q = r / I_SQ; d.W = p.rw_w_in + (size_t)q * D * D; d.WT = (bf16_t*)(ws + W_RWIN + (size_t)q * 2 * MiB); d.item = r % I_SQ; return d; } r -= 4 * I_SQ;
  if (r < 4 * I_LORA) { const int q = r / I_LORA; d.W = (q < 2) ? p.rw_w1 + (size_t)q * D * 64 : p.rw_a1 + (size_t)(q - 2) * D * 64; d.N = 64; d.WT = (bf16_t*)(ws + W_LORA1); d.kind = 1; d.row_off = q * 64; d.item = r % I_LORA; return d; } r -= 4 * I_LORA;
  d.W = p.rw_w_out; d.WT = (bf16_t*)(ws + W_RWOUT); d.kind = 1; d.item = r; return d;
}
__device__ __forceinline__ void tr_load(const TrD& d, int lane, f32x4 (&v)[8]) {
  const int nblk = d.N / 32, kb = d.item / nblk, nb = d.item % nblk, k0 = 64 * kb, n0 = 32 * nb;
  const GAS f32x4* src = (const GAS f32x4*)(d.W + (size_t)(k0 + (lane >> 3)) * d.N + n0 + 4 * (lane & 7));
#pragma unroll
  for (int i = 0; i < 8; ++i) v[i] = src[(size_t)i * 2 * d.N];
}
__device__ __forceinline__ void tr_finish(const TrD& d, LAS float* scr, int lane, const f32x4 (&v)[8]) {
  const int nblk = d.N / 32, kb = d.item / nblk, nb = d.item % nblk, k0 = 64 * kb, n0 = 32 * nb, K = d.K;
#pragma unroll
  for (int i = 0; i < 8; ++i) { LAS float* dd = scr + (8 * i + (lane >> 3)) * 33 + 4 * (lane & 7); dd[0] = v[i].x; dd[1] = v[i].y; dd[2] = v[i].z; dd[3] = v[i].w; }
  asm volatile("s_waitcnt lgkmcnt(0)" ::: "memory");
  const int c = lane & 7;
#pragma unroll
  for (int jj = 0; jj < 4; ++jj) {
    const int n = (lane >> 3) + 8 * jj; LAS const float* s = scr + (8 * c) * 33 + n;
    u32x4 o; o.x = pk2_(s[0 * 33], s[1 * 33]); o.y = pk2_(s[2 * 33], s[3 * 33]); o.z = pk2_(s[4 * 33], s[5 * 33]); o.w = pk2_(s[6 * 33], s[7 * 33]);
    const int ng = n0 + n + d.row_off;
    if (d.kind == 0) {
      *(u32x4*)(d.WT + (size_t)ng * K + k0 + 8 * c) = o;
    } else {
      const int k8 = (k0 >> 3) + c;
      const size_t ci = ((size_t)((ng >> 5) * 64 + (k8 >> 1))) * 64 + (ng & 31) + 32 * (k8 & 1);
      *(u32x4*)(d.WT + ci * 8) = o;
    }
  }
  asm volatile("s_waitcnt lgkmcnt(0)" ::: "memory");
}
template <int DEF>
__device__ __forceinline__ void tr_run(const LAS PG& p, unsigned char* ws, LAS float* scr, int lane, int first, int stride, int n) {
  for (int it = first; it < n; it += 2 * stride) {
    const TrD dA = tr_decode(p, ws, DEF == 2 ? tr_map_def2(it) : (DEF == 1 ? tr_map_def(it) : tr_map_p0(it)));
    f32x4 vA[8], vB[8];
    tr_load(dA, lane, vA);
    const bool hasB = (it + stride) < n;
    TrD dB = dA;
    if (hasB) { dB = tr_decode(p, ws, DEF == 2 ? tr_map_def2(it + stride) : (DEF == 1 ? tr_map_def(it + stride) : tr_map_p0(it + stride))); tr_load(dB, lane, vB); }
    tr_finish(dA, scr, lane, vA);
    if (hasB) tr_finish(dB, scr, lane, vB);
  }
}

__device__ __forceinline__ void phase_p0a(const LAS PG& p, unsigned char* ws, LAS unsigned char* lds, int tid, int lane, int wave, int bid, int G) {
  LAS float* SC = (LAS float*)lds;
  for (int i = tid; i < 3072; i += 512) { const int g = i >> 10, k = i & 1023; const float c = (g == 0) ? p.c_ctx[k] : p.c[(g - 1) * 1024 + k]; SC[i] = silu(c); }
  __syncthreads();
  LAS float* RED = (LAS float*)lds + 3072;
#ifdef MP_TWICE
  for (int rep_ = 0; rep_ < 2; ++rep_)
#endif
  for (int it = bid; it < 96; it += G) {
    const int kc = it & 7, cc = (it >> 3) % 3, i = it / 24;
    const int c4 = tid & 255, kh = tid >> 8;
    const int n = cc * 1024 + 4 * c4;
    const GAS f32x4* w = (const GAS f32x4*)(p.mod_w + ((size_t)i * 1024 + kc * 128 + kh * 64) * 3072 + n);
    f32x4 a0 = (f32x4){0.f, 0.f, 0.f, 0.f}, a1 = a0, a2 = a0;
#pragma unroll 8
    for (int k = 0; k < 64; ++k) { const f32x4 wv = w[(size_t)k * 768]; const int kk = kc * 128 + kh * 64 + k; a0 += SC[kk] * wv; a1 += SC[1024 + kk] * wv; a2 += SC[2048 + kk] * wv; }
    if (kh == 1) { LAS f32x4* r = (LAS f32x4*)(RED + c4 * 12); r[0] = a0; r[1] = a1; r[2] = a2; }
    __syncthreads();
    if (kh == 0) {
      LAS const f32x4* r = (LAS const f32x4*)(RED + c4 * 12);
      float* mp = (float*)(ws + M_MODP) + (size_t)kc * 36864 + (size_t)i * 9216 + n;
      *(f32x4*)mp = a0 + r[0]; *(f32x4*)(mp + 3072) = a1 + r[1]; *(f32x4*)(mp + 6144) = a2 + r[2];
    }
    __syncthreads();
  }
  __syncthreads();
  for (int i = bid * 512 + tid; i < 12288; i += G * 512) *(u32x4*)(ws + W_MLAIN + (size_t)416 * 2048 + (size_t)i * 16) = (u32x4){0u, 0u, 0u, 0u};
  for (int i = bid * 512 + tid; i < 2 * PAST * 128 / 8; i += G * 512) {
    const int d8 = i & 15, pl = (i >> 4) & 511, b = i >> 13;
    const f32x4* src = (const f32x4*)(p.cache_ckv + ((size_t)(b * PAST + pl)) * 128 + d8 * 8);
    const f32x4 x0 = src[0], x1 = src[1];
    u32x4 o; o.x = pk2_(x0.x, x0.y); o.y = pk2_(x0.z, x0.w); o.z = pk2_(x1.x, x1.y); o.w = pk2_(x1.z, x1.w);
    *(u32x4*)((bf16_t*)(ws + M_CKVALL) + ((size_t)(NPT + b * 2560 + pl)) * 128 + d8 * 8) = o;
    if (d8 < 4) {
      const f32x4* s2 = (const f32x4*)(p.cache_kpe + ((size_t)(b * PAST + pl)) * 32 + d8 * 8);
      const f32x4 y0 = s2[0], y1 = s2[1];
      u32x4 o2; o2.x = pk2_(y0.x, y0.y); o2.y = pk2_(y0.z, y0.w); o2.z = pk2_(y1.x, y1.y); o2.w = pk2_(y1.z, y1.w);
      *(u32x4*)((bf16_t*)(ws + M_KPEB) + ((size_t)(NPT + b * 2560 + pl)) * 32 + d8 * 8) = o2;
    }
  }
  LAS float* scr = (LAS float*)(lds + wave * 16384);
  const int gw = bid * 8 + wave, NGW = G * 8;
  tr_run<0>(p, ws, scr, lane, gw, NGW, NTR_P0);
#ifdef TR_TWICE
  tr_run<0>(p, ws, scr, lane, gw, NGW, NTR_P0);
#endif
  {
    __syncthreads();
    const int jh = (bid * 2 >= G) ? 1 : 0;
    LAS float* w1s = (LAS float*)(lds + 131072);
    LAS float* w2s = w1s + 33 * 64;
    for (int i = tid; i < 33 * 64; i += 512) w1s[i] = p.hy_w1[(size_t)jh * 33 * 64 + i];
    for (int i = tid; i < 64 * 64; i += 512) w2s[i] = p.hy_w2[(size_t)jh * 64 * 64 + i];
    __syncthreads();
    const float b1 = p.hy_b1[jh * 64 + lane], b2 = p.hy_b2[jh * 64 + lane], f0 = p.hy_freq[(jh * 2 + 0) * 64 + lane], f1 = p.hy_freq[(jh * 2 + 1) * 64 + lane];
    const int nbh = jh ? (G - (G + 1) / 2) : ((G + 1) / 2), bh = jh ? (bid - (G + 1) / 2) : bid;
    for (int row = bh * 8 + wave; row < 2304; row += nbh * 8) {
      const int L = row < 256 ? 256 : 2048, l = row < 256 ? row : row - 256;
      const float t = (float)l / (float)(L - 1);
      float feat = 0.f;
      if (lane == 0) feat = t;
      else if (lane < 33) {
        const int b = (lane - 1) & 15;
        const float band = 1e-4f + (float)b * ((15.f - 1e-4f) / 15.f);
        const float rev = ((float)l / (float)L) * band;
        const float fr = rev - floorf(rev);
        feat = (lane <= 16) ? __builtin_amdgcn_cosf(fr) : -__builtin_amdgcn_sinf(fr);
      }
      float a = b1;
#pragma unroll
      for (int f = 0; f < 33; ++f) a += __shfl(feat, f) * w1s[f * 64 + lane];
      const float x1 = f0 * a * 0.15915494309189535f;
      const float h1 = __builtin_amdgcn_sinf(x1 - floorf(x1));
      float a2 = b2;
#pragma unroll 16
      for (int f = 0; f < 64; ++f) a2 += __shfl(h1, f) * w2s[f * 64 + lane];
      const float x2 = f1 * a2 * 0.15915494309189535f;
      const float h2 = __builtin_amdgcn_sinf(x2 - floorf(x2));
      ((float*)(ws + M_HDN2))[((size_t)jh * 2304 + row) * 64 + lane] = h2;
    }
  }
}

__device__ __forceinline__ void phase_p0b(const LAS PG& p, unsigned char* ws, LAS unsigned char* lds, int tid, int lane, int wave, int bid, int G) {
  const float* MP = (const float*)(ws + M_MODP);
  float* MODS = (float*)(ws + M_MODS);
  for (int idx = bid * 512 + tid; idx < 36864; idx += G * 512) {
    float s = p.mod_b[(idx / 9216) * 3072 + (idx % 3072)];
#pragma unroll
    for (int kc = 0; kc < 8; ++kc) s += MP[(size_t)kc * 36864 + idx];
    MODS[idx] = s;
  }
  LAS float* ML = (LAS float*)lds;
  for (int e = tid; e < 6144; e += 512) {
    const int g = e >> 11, r = e & 2047; const int idx = g * 3072 + r;
    float s = p.mod_b[r];
#pragma unroll
    for (int kc = 0; kc < 8; ++kc) s += MP[(size_t)kc * 36864 + idx];
    ML[e] = s;
  }
  __syncthreads();
  bf16_t* HB = (bf16_t*)(ws + M_HB);
#ifndef NO_H0
#ifdef H0_TWICE
  for (int rep_ = 0; rep_ < 2; ++rep_)
#endif
  for (int m = bid * 8 + wave; m < NTOK; m += G * 8) {
    int l, L, cond, m0; tokinfo(m, l, L, cond, m0);
    const GAS f32x4* xr = (const GAS f32x4*)xrow_in(p, 0, ws, m);
    LAS const float* sh = ML + cond * 2048; LAS const float* sc = sh + 1024;
#pragma unroll
    for (int i = 0; i < 4; ++i) {
      const int k = 4 * lane + 256 * i; const f32x4 x = xr[lane + 64 * i];
      u32x2 o; o.x = pk2_(x.x * (1.f + sc[k]) + sh[k], x.y * (1.f + sc[k + 1]) + sh[k + 1]); o.y = pk2_(x.z * (1.f + sc[k + 2]) + sh[k + 2], x.w * (1.f + sc[k + 3]) + sh[k + 3]);
      *(u32x2*)(HB + (size_t)m * D + k) = o;
    }
  }
#endif
  __syncthreads();
#ifndef NO_FG
  const int gw = bid * 8 + wave, NGW = G * 8;
  const float* HD = (const float*)(ws + M_HDN2);
  bf16_t* FILT = (bf16_t*)(ws + M_FILT);
  const int r32 = lane & 31, hi = lane >> 5;
#ifdef FG_TWICE
  for (int rep_ = 0; rep_ < 2; ++rep_)
#endif
  for (int wslot = gw; wslot < 64 * 32; wslot += NGW) {
    const int combo = wslot & 63, sub = wslot >> 6;
    const int cch = combo & 15, dir = (combo >> 4) & 1, j = combo >> 5;
    LAS float* w3s = (LAS float*)(lds + 16384 + wave * 16384);
    {
      const GASF* w3 = p.hy_w3 + ((size_t)j * 64 * 2048 + dir * 1024 + cch * 64 + lane);
      asm volatile("s_waitcnt lgkmcnt(0)" ::: "memory");
#pragma unroll 8
      for (int m = 0; m < 64; ++m) { w3s[m * 64 + lane] = *w3; w3 += 2048; }
      asm volatile("s_waitcnt lgkmcnt(0)" ::: "memory");
    }
    bf16x8 bw[2][4];
    {
      LAS const float* wb = w3s + (8 * hi) * 64 + r32;
#pragma unroll
      for (int nt = 0; nt < 2; ++nt)
#pragma unroll
        for (int ks = 0; ks < 4; ++ks) {
          LAS const float* q = wb + (16 * ks) * 64 + 32 * nt;
          u32x4 o; o.x = pk2_(q[0], q[64]); o.y = pk2_(q[128], q[192]); o.z = pk2_(q[256], q[320]); o.w = pk2_(q[384], q[448]);
          bw[nt][ks] = __builtin_bit_cast(bf16x8, o);
        }
    }
    float cb3[2], cdec[2];
#pragma unroll
    for (int nt = 0; nt < 2; ++nt) { const int o = dir * 1024 + cch * 64 + 32 * nt + r32; cb3[nt] = p.hy_b3[j * 2048 + o]; cdec[nt] = fabsf(p.hy_decay[(size_t)j * 2048 + o]); }
#pragma unroll 1
    for (int it = sub; it < 72; it += 32) {
      const int set = it < 8 ? 0 : 1, b = set ? it - 8 : it, L = set ? 2048 : 256, row0 = set ? 256 : 0;
      const int lag0 = 32 * b + (dir ? 0 : 1);
      bf16x8 af[4];
      {
        const int lag = lag0 + r32; const bool ok = dir ? (lag >= 1) : (lag <= L - 1);
        const float* hrow = HD + ((size_t)j * 2304 + row0 + (ok ? lag : 0)) * 64 + 8 * hi;
#pragma unroll
        for (int ks = 0; ks < 4; ++ks) {
          f32x4 x0 = *(const f32x4*)(hrow + 16 * ks), x1 = *(const f32x4*)(hrow + 16 * ks + 4);
          if (!ok) { x0 = (f32x4){0.f, 0.f, 0.f, 0.f}; x1 = x0; }
          u32x4 o; o.x = pk2_(x0.x, x0.y); o.y = pk2_(x0.z, x0.w); o.z = pk2_(x1.x, x1.y); o.w = pk2_(x1.z, x1.w);
          af[ks] = __builtin_bit_cast(bf16x8, o);
        }
      }
      const float tinv = 1.f / (float)(L - 1);
#pragma unroll
      for (int nt = 0; nt < 2; ++nt) {
        f32x16 acc;
#pragma unroll
        for (int i = 0; i < 16; ++i) acc[i] = 0.f;
#pragma unroll
        for (int ks = 0; ks < 4; ++ks) acc = __builtin_amdgcn_mfma_f32_32x32x16_bf16(af[ks], bw[nt][ks], acc, 0, 0, 0);
        bf16_t* fch = FILT + ((size_t)(j * 1024 + cch * 64 + 32 * nt + r32)) * FILT_CH + (set ? 528 : 0) + L + 8;
#pragma unroll
        for (int q = 0; q < 4; ++q) {
          unsigned v[4];
#pragma unroll
          for (int x = 0; x < 4; ++x) {
            const int lag = lag0 + 8 * q + 4 * hi + x;
            const bool ok = dir ? (lag >= 1) : (lag <= L - 1);
            const float val = (acc[4 * q + x] + cb3[nt]) * __expf(-(float)lag * tinv * cdec[nt]);
            v[x] = ok ? f2bf_(val) : 0u;
          }
          if (dir) {
            const int i0 = lag0 + 8 * q + 4 * hi;
            if (i0 != 0) { u32x2 w; w.x = v[0] | (v[1] << 16); w.y = v[2] | (v[3] << 16); *(u32x2*)(fch + i0) = w; }
            else { fch[1] = (bf16_t)v[1]; fch[2] = (bf16_t)v[2]; fch[3] = (bf16_t)v[3]; }
          } else {
            const int i0 = -(lag0 + 8 * q + 4 * hi + 3);
            u32x2 w; w.x = v[3] | (v[2] << 16); w.y = v[1] | (v[0] << 16); *(u32x2*)(fch + i0) = w;
          }
        }
      }
    }
    if (sub == 0) {
      const int c = cch * 64 + lane, o = dir * 1024 + c;
#pragma unroll 1
      for (int set = 0; set < 2; ++set) {
        const int L = set ? 2048 : 256, row0 = set ? 256 : 0;
        bf16_t* fch = FILT + ((size_t)(j * 1024 + c)) * FILT_CH + (set ? 528 : 0) + L + 8;
        if (!dir) {
          const float* h0r = HD + ((size_t)j * 2304 + row0) * 64;
          float a = p.hy_b3[j * 2048 + o];
#pragma unroll 8
          for (int m = 0; m < 64; ++m) a += h0r[m] * w3s[m * 64 + lane];
          fch[0] = (bf16_t)f2bf_(a + p.hy_skip[j * D + c]);
        } else {
          *(u32x4*)(fch + L) = (u32x4){0u, 0u, 0u, 0u};
        }
      }
    }
  }
#endif
}
constexpr int FK_S = 0, FK_P = 65920, VBS = 74368, VBP = 91776, VB_END = 118400, E_OFF = 118400, SCR_S = 0, SCR_P = 65536;
__device__ __forceinline__ float conv3e(float pv, float cur, float nx, float w0, float w1, float w2, float b) { return pv * w0 + cur * w1 + nx * w2 + b; }

__device__ __forceinline__ void phase_hy_conv(const LAS PG& p, unsigned char* ws, LAS unsigned char* lds, int j, int tid, int lane, int wave, int bid, int G) {
  const bf16_t* UT = (const bf16_t*)(ws + M_UT);
  bf16_t* GT = (bf16_t*)(ws + M_GB);
  const bf16_t* FILT = (const bf16_t*)(ws + M_FILT);
  const int r = lane & 31, h = lane >> 5, rho = (-r) & 7;
  u32x4 fX0[2], fX1[2], fXV[2], fXZ[2]; unsigned fP[2][3], fN[2][3]; u32x4 fLo[2], fHi[2];
#define HC_FETCH(CH) do { const int c_ = (CH); \
    _Pragma("unroll") for (int u_ = 0; u_ < 2; ++u_) { const int tok_ = (tid + 512 * u_) * 8; \
      const int l_ = (tok_ < NPT) ? (tok_ & 255) : ((tok_ - NPT) & 2047); const int L_ = (tok_ < NPT) ? 256 : 2048; \
      const bf16_t* r0_ = UT + (size_t)c_ * 8192 + tok_; const bf16_t* r1_ = r0_ + (size_t)1024 * 8192; const bf16_t* r2_ = r0_ + (size_t)2048 * 8192; const bf16_t* r3_ = r0_ + (size_t)3072 * 8192; \
      fX0[u_] = *(const u32x4*)r0_; fX1[u_] = *(const u32x4*)r1_; fXV[u_] = *(const u32x4*)r2_; fXZ[u_] = *(const u32x4*)r3_; \
      const bool hp_ = l_ > 0, hn_ = (l_ + 8) < L_; \
      fP[u_][0] = hp_ ? (unsigned)r0_[-1] : 0u; fP[u_][1] = hp_ ? (unsigned)r1_[-1] : 0u; fP[u_][2] = hp_ ? (unsigned)r2_[-1] : 0u; \
      fN[u_][0] = hn_ ? (unsigned)r0_[8] : 0u; fN[u_][1] = hn_ ? (unsigned)r1_[8] : 0u; fN[u_][2] = hn_ ? (unsigned)r2_[8] : 0u; } \
    const bf16_t* Rc_ = FILT + ((size_t)(j * 1024 + c_)) * FILT_CH; \
    _Pragma("unroll") for (int u_ = 0; u_ < 2; ++u_) { const int gi_ = tid + 512 * u_; fLo[u_] = (u32x4){0u, 0u, 0u, 0u}; fHi[u_] = fLo[u_]; \
      if (gi_ < 515 + 66) { const bool smp_ = gi_ < 515; const int gq_ = smp_ ? gi_ : gi_ - 515; const int LEN_ = smp_ ? 4112 : 528; const bf16_t* Rg_ = Rc_ + (smp_ ? 528 : 0); const int idx0_ = 8 * gq_ + 8; \
        if (idx0_ + 8 <= LEN_) fLo[u_] = *(const u32x4*)(Rg_ + idx0_); if (idx0_ + 16 <= LEN_) fHi[u_] = *(const u32x4*)(Rg_ + idx0_ + 8); } } } while (0)
  if (bid < 1024) HC_FETCH(bid);
  for (int c = bid; c < 1024; c += G) {
    __syncthreads();
    for (int i = tid; i < (VB_END - VBS) / 16; i += 512) *(LAS u32x4*)(lds + VBS + i * 16) = (u32x4){0u, 0u, 0u, 0u};
    __syncthreads();
    {
      const GASF* cw = p.hy_conv_w + (size_t)j * 3 * 3072; const GASF* cb = p.hy_conv_b + (size_t)j * 3072;
      const float a0 = cw[c], a1 = cw[3072 + c], a2 = cw[6144 + c], ab = cb[c];
      const float b0 = cw[1024 + c], b1 = cw[3072 + 1024 + c], b2 = cw[6144 + 1024 + c], bb = cb[1024 + c];
      const float v0 = cw[2048 + c], v1 = cw[3072 + 2048 + c], v2 = cw[6144 + 2048 + c], vbb = cb[2048 + c];
#pragma unroll
      for (int u = 0; u < 2; ++u) {
        const int tok = (tid + 512 * u) * 8;
        unsigned dst;
        if (tok < NPT) { const int l = tok & 255; const int chunk = 32 + (l >> 3); dst = VBP + (tok >> 8) * 1664 + (chunk + (chunk >> 4)) * 16; }
        else { const int mm = tok - NPT; const int l = mm & 2047; const int chunk = 128 + (l >> 3); dst = VBS + (mm >> 11) * 8704 + (chunk + (chunk >> 4)) * 16; }
        const u32x4 X0 = fX0[u], X1 = fX1[u], XV = fXV[u], XZ = fXZ[u];
        float x0[10], x1[10], xv[10], z[8];
        x0[0] = bf2f(fP[u][0]); x1[0] = bf2f(fP[u][1]); xv[0] = bf2f(fP[u][2]); x0[9] = bf2f(fN[u][0]); x1[9] = bf2f(fN[u][1]); xv[9] = bf2f(fN[u][2]);
#pragma unroll
        for (int e = 0; e < 4; ++e) {
          x0[1 + 2 * e] = bf2f(X0[e] & 0xffffu); x0[2 + 2 * e] = bf2f(X0[e] >> 16);
          x1[1 + 2 * e] = bf2f(X1[e] & 0xffffu); x1[2 + 2 * e] = bf2f(X1[e] >> 16);
          xv[1 + 2 * e] = bf2f(XV[e] & 0xffffu); xv[2 + 2 * e] = bf2f(XV[e] >> 16);
          z[2 * e] = bf2f(XZ[e] & 0xffffu); z[2 * e + 1] = bf2f(XZ[e] >> 16);
        }
        float vv[8], ev[8];
#pragma unroll
        for (int e = 0; e < 8; ++e) {
          const float c0 = conv3e(x0[e], x0[e + 1], x0[e + 2], a0, a1, a2, ab);
          const float c1 = conv3e(x1[e], x1[e + 1], x1[e + 2], b0, b1, b2, bb);
          const float cv = conv3e(xv[e], xv[e + 1], xv[e + 2], v0, v1, v2, vbb);
          vv[e] = cv * c1; ev[e] = c0 * (z[e] * __builtin_amdgcn_rcpf(1.f + __expf(-z[e])));
        }
        u32x4 o; o.x = pk2_(vv[0], vv[1]); o.y = pk2_(vv[2], vv[3]); o.z = pk2_(vv[4], vv[5]); o.w = pk2_(vv[6], vv[7]);
        *(LAS u32x4*)(lds + dst) = o;
        *(LAS f32x4*)(lds + E_OFF + tok * 4) = (f32x4){ev[0], ev[1], ev[2], ev[3]};
        *(LAS f32x4*)(lds + E_OFF + tok * 4 + 16) = (f32x4){ev[4], ev[5], ev[6], ev[7]};
      }
#pragma unroll
      for (int u = 0; u < 2; ++u) {
        const int gi = tid + 512 * u;
        if (gi < 515 + 66) {
          const bool smp = gi < 515; const int gq = smp ? gi : gi - 515;
          const u32x4 lo = fLo[u], hi = fHi[u];
          const unsigned d0 = lo.x, d1 = lo.y, d2 = lo.z, d3 = lo.w, d4 = hi.x, d5 = hi.y, d6 = hi.z, d7 = hi.w;
          LAS unsigned char* dstp = lds + (smp ? FK_S : FK_P) + gq * 128;
#define AB(hi_, lo_) __builtin_amdgcn_alignbit(hi_, lo_, 16)
          *(LAS u32x4*)(dstp + 0) = (u32x4){d0, d1, d2, d3};
          *(LAS u32x4*)(dstp + 16) = (u32x4){AB(d1, d0), AB(d2, d1), AB(d3, d2), AB(d4, d3)};
          *(LAS u32x4*)(dstp + 32) = (u32x4){d1, d2, d3, d4};
          *(LAS u32x4*)(dstp + 48) = (u32x4){AB(d2, d1), AB(d3, d2), AB(d4, d3), AB(d5, d4)};
          *(LAS u32x4*)(dstp + 64) = (u32x4){d2, d3, d4, d5};
          *(LAS u32x4*)(dstp + 80) = (u32x4){AB(d3, d2), AB(d4, d3), AB(d5, d4), AB(d6, d5)};
          *(LAS u32x4*)(dstp + 96) = (u32x4){d3, d4, d5, d6};
          *(LAS u32x4*)(dstp + 112) = (u32x4){AB(d4, d3), AB(d5, d4), AB(d6, d5), AB(d7, d6)};
#undef AB
        }
      }
    }
    __syncthreads();
    if (c + G < 1024) HC_FETCH(c + G);
    f32x16 s0, s1, pr;
#pragma unroll
    for (int i = 0; i < 16; ++i) { s0[i] = 0.f; s1[i] = 0.f; pr[i] = 0.f; }
    {
      const int ahalf = wave & 1, dq = wave >> 1;
      const int a = ahalf * 32 + r;
      const int n0 = (ahalf ? -64 : -128) + 48 * dq, cnt = (dq == 3) ? 47 : 48;
      for (int s = 0; s < cnt; ++s) {
        const int n = n0 + s;
        const int e0 = 8 * h - r - 16 * n; const int q = (e0 - rho) >> 3;
        const bf16x8 af = *(LAS const bf16x8*)(lds + FK_S + ((q + 256) * 8 + rho) * 16);
        const int qb = 128 + h + 4 * a - 2 * n; const int pb = qb + (qb >> 4);
        const bf16x8 b0 = *(LAS const bf16x8*)(lds + VBS + pb * 16);
        const bf16x8 b1 = *(LAS const bf16x8*)(lds + VBS + 8704 + pb * 16);
        s0 = __builtin_amdgcn_mfma_f32_32x32x16_bf16(af, b0, s0, 0, 0, 0);
        s1 = __builtin_amdgcn_mfma_f32_32x32x16_bf16(af, b1, s1, 0, 0, 0);
      }
    }
    {
      const int ntile = wave & 3, dh = wave >> 2;
      const int batch = 4 * ntile + (r >> 3), a = r & 7;
      const int n0 = dh ? 0 : -16, cnt = dh ? 15 : 16;
      for (int s = 0; s < cnt; ++s) {
        const int n = n0 + s;
        const int e0 = 8 * h - r - 16 * n; const int q = (e0 - rho) >> 3;
        const bf16x8 af = *(LAS const bf16x8*)(lds + FK_P + ((q + 32) * 8 + rho) * 16);
        const int qb = 32 + h + 4 * a - 2 * n; const int pb = qb + (qb >> 4);
        const bf16x8 b0 = *(LAS const bf16x8*)(lds + VBP + batch * 1664 + pb * 16);
        pr = __builtin_amdgcn_mfma_f32_32x32x16_bf16(af, b0, pr, 0, 0, 0);
      }
    }
    __syncthreads();
    {
      const int ahalf = wave & 1, dq = wave >> 1;
#pragma unroll
      for (int g = 0; g < 4; ++g) {
        const int off = (r * 32 + 8 * g + 4 * h) * 4;
        *(LAS f32x4*)(lds + SCR_S + (((ahalf * 2 + 0) * 4 + dq) * 1024) * 4 + off) = (f32x4){s0[4 * g], s0[4 * g + 1], s0[4 * g + 2], s0[4 * g + 3]};
        *(LAS f32x4*)(lds + SCR_S + (((ahalf * 2 + 1) * 4 + dq) * 1024) * 4 + off) = (f32x4){s1[4 * g], s1[4 * g + 1], s1[4 * g + 2], s1[4 * g + 3]};
        *(LAS f32x4*)(lds + SCR_P + (((wave & 3) * 2 + (wave >> 2)) * 1024) * 4 + off) = (f32x4){pr[4 * g], pr[4 * g + 1], pr[4 * g + 2], pr[4 * g + 3]};
      }
    }
    __syncthreads();
    {
      {
        const int o = tid * 8; const int b = o >> 11, t = o & 2047; const int a = t >> 5, rr = t & 31; const int tile = (a >> 5) * 2 + b, col = a & 31;
        f32x4 y0 = (f32x4){0.f, 0.f, 0.f, 0.f}, y1 = y0;
#pragma unroll
        for (int dq = 0; dq < 4; ++dq) {
          LAS const unsigned char* sp = lds + SCR_S + (((tile * 4 + dq) * 1024) + col * 32 + rr) * 4;
          y0 += *(LAS const f32x4*)sp; y1 += *(LAS const f32x4*)(sp + 16);
        }
        const int token = NPT + o;
        const f32x4 e0 = *(LAS const f32x4*)(lds + E_OFF + token * 4), e1 = *(LAS const f32x4*)(lds + E_OFF + token * 4 + 16);
        u32x4 ov; ov.x = pk2_(y0.x * e0.x, y0.y * e0.y); ov.y = pk2_(y0.z * e0.z, y0.w * e0.w); ov.z = pk2_(y1.x * e1.x, y1.y * e1.y); ov.w = pk2_(y1.z * e1.z, y1.w * e1.w);
        *(u32x4*)(GT + (size_t)c * 8192 + token) = ov;
      }
      {
        const int o = tid * 8; const int batch = o >> 8, t = o & 255; const int ntile = batch >> 2, col = (batch & 3) * 8 + (t >> 5), rr = t & 31;
        f32x4 y0 = (f32x4){0.f, 0.f, 0.f, 0.f}, y1 = y0;
#pragma unroll
        for (int dh = 0; dh < 2; ++dh) {
          LAS const unsigned char* sp = lds + SCR_P + (((ntile * 2 + dh) * 1024) + col * 32 + rr) * 4;
          y0 += *(LAS const f32x4*)sp; y1 += *(LAS const f32x4*)(sp + 16);
        }
        const int token = o;
        const f32x4 e0 = *(LAS const f32x4*)(lds + E_OFF + token * 4), e1 = *(LAS const f32x4*)(lds + E_OFF + token * 4 + 16);
        u32x4 ov; ov.x = pk2_(y0.x * e0.x, y0.y * e0.y); ov.y = pk2_(y0.z * e0.z, y0.w * e0.w); ov.z = pk2_(y1.x * e1.x, y1.y * e1.y); ov.w = pk2_(y1.z * e1.z, y1.w * e1.w);
        *(u32x4*)(GT + (size_t)c * 8192 + token) = ov;
      }
    }
  }
}

template <int MODE>
__device__ __forceinline__ void phase_out_ln(const LAS PG& p, unsigned char* ws, LAS unsigned char* lds, int layer, const bf16_t* Wf, int tid, int lane, int wave, int bid, int G) {
  const bf16_t* GA = (const bf16_t*)(ws + M_GB);
  const float* MODS = (const float*)(ws + M_MODS);
  const int h = lane >> 5;
  for (int tile = bid; tile < NTOK / 32; tile += G) {
    const int t0 = tile * 32;
    __syncthreads();
    constexpr bool CHM = (MODE == 1);
    if (MODE == 2) {
      const float* BON = (const float*)(ws + M_GB + 8 * MiB);
      const int sub = lane >> 4, c4 = lane & 15;
#pragma unroll 2
      for (int it = 0; it < 16; ++it) {
        const int pr = wave * 64 + it * 4 + sub; const int tok = pr >> 4, hd = pr & 15, m = t0 + tok;
        const unsigned gi = (unsigned)m * (unsigned)D + (unsigned)(hd * 64 + 4 * c4);
        const f32x4 y = *(const f32x4*)((const float*)(ws + M_UT) + gi) + *(const f32x4*)((const float*)(ws + M_UT + 32 * MiB) + gi);
        float s1 = (y.x + y.y) + (y.z + y.w);
        s1 += __builtin_bit_cast(float, __builtin_amdgcn_update_dpp(0, __builtin_bit_cast(int, s1), 0xB1, 0xF, 0xF, true));
        s1 += __builtin_bit_cast(float, __builtin_amdgcn_update_dpp(0, __builtin_bit_cast(int, s1), 0x4E, 0xF, 0xF, true));
        s1 += __builtin_bit_cast(float, __builtin_amdgcn_update_dpp(0, __builtin_bit_cast(int, s1), 0x141, 0xF, 0xF, true));
        s1 += __builtin_bit_cast(float, __builtin_amdgcn_update_dpp(0, __builtin_bit_cast(int, s1), 0x140, 0xF, 0xF, true));
        const float mu = s1 * (1.f / 64.f);
        const f32x4 d = y - mu;
        float s2 = (d.x * d.x + d.y * d.y) + (d.z * d.z + d.w * d.w);
        s2 += __builtin_bit_cast(float, __builtin_amdgcn_update_dpp(0, __builtin_bit_cast(int, s2), 0xB1, 0xF, 0xF, true));
        s2 += __builtin_bit_cast(float, __builtin_amdgcn_update_dpp(0, __builtin_bit_cast(int, s2), 0x4E, 0xF, 0xF, true));
        s2 += __builtin_bit_cast(float, __builtin_amdgcn_update_dpp(0, __builtin_bit_cast(int, s2), 0x141, 0xF, 0xF, true));
        s2 += __builtin_bit_cast(float, __builtin_amdgcn_update_dpp(0, __builtin_bit_cast(int, s2), 0x140, 0xF, 0xF, true));
        const float rstd = rsqrtf(s2 * (1.f / 64.f) + GN_EPS);
        const f32x4 bo0 = *(const f32x4*)(BON + ((unsigned)m * 16u + (unsigned)hd) * 4u), bo1 = *(const f32x4*)(BON + (((unsigned)NTOK + (unsigned)m) * 16u + (unsigned)hd) * 4u);
        const float bon = ((bo0.x + bo0.y) + (bo0.z + bo0.w)) + ((bo1.x + bo1.y) + (bo1.z + bo1.w));
        const u32x2 v2 = *(const u32x2*)((const bf16_t*)(ws + M_SCR2 + 32 * MiB) + gi), z2 = *(const u32x2*)((const bf16_t*)(ws + M_SCR2 + 48 * MiB) + gi);
        const f32x4 gg = *(const GAS f32x4*)(p.rw_gn_g + hd * 64 + 4 * c4), gb = *(const GAS f32x4*)(p.rw_gn_b + hd * 64 + 4 * c4);
        const f32x4 yn = d * rstd * gg + gb;
        u32x2 o;
        o.x = pk2_((yn.x + bon * bf2f(v2.x & 0xffffu)) * bf2f(z2.x & 0xffffu), (yn.y + bon * bf2f(v2.x >> 16)) * bf2f(z2.x >> 16));
        o.y = pk2_((yn.z + bon * bf2f(v2.y & 0xffffu)) * bf2f(z2.y & 0xffffu), (yn.w + bon * bf2f(v2.y >> 16)) * bf2f(z2.y >> 16));
        *(LAS u32x2*)(lds + ((hd * 8 + (c4 >> 1)) * 32 + tok) * 16 + (c4 & 1) * 8) = o;
      }
    } else {
#pragma unroll
    for (int i = 0; i < 8; ++i) {
      const int idx = tid + 512 * i;
      if (CHM) { const int c = idx >> 2, part = idx & 3; *(LAS u32x4*)(lds + c * 64 + part * 16) = *(const u32x4*)(GA + (size_t)c * 8192 + t0 + 8 * part); }
      else { const int tok = idx >> 7, k8 = idx & 127; *(LAS u32x4*)(lds + (k8 * 32 + tok) * 16) = *(const u32x4*)(GA + (size_t)(t0 + tok) * D + 8 * k8); }
    }
    }
    __syncthreads();
    f32x16 acc[4];
#pragma unroll
    for (int nt = 0; nt < 4; ++nt)
#pragma unroll
      for (int i = 0; i < 16; ++i) acc[nt][i] = 0.f;
    const bf16_t* wf = Wf + ((size_t)(wave * 4) * 64 * 64 + lane) * 8;
    const int aoffT = ((h * 32) + (lane & 31)) * 16;
    const int aoffC = (8 * h + ((lane & 15) >> 2)) * 64 + 32 * ((lane >> 4) & 1) + 8 * (lane & 3);
#pragma unroll 4
    for (int ks = 0; ks < 64; ++ks) {
      bf16x8 af;
      if (CHM) {
        const v4i16_t lo = vtr(lds + aoffC + ks * 1024), hi = vtr(lds + aoffC + ks * 1024 + 256);
        af = (bf16x8){lo[0], lo[1], lo[2], lo[3], hi[0], hi[1], hi[2], hi[3]};
      } else {
        af = *(LAS const bf16x8*)(lds + aoffT + ks * 1024);
      }
#pragma unroll
      for (int nt = 0; nt < 4; ++nt) {
        const bf16x8 bfr = *(const bf16x8*)(wf + ((size_t)(nt * 64 + ks) * 64) * 8);
        acc[nt] = __builtin_amdgcn_mfma_f32_32x32x16_bf16(af, bfr, acc[nt], 0, 0, 0);
      }
    }
    __syncthreads();
#pragma unroll
    for (int nt = 0; nt < 4; ++nt)
#pragma unroll
      for (int i = 0; i < 16; ++i) {
        const int row = (i & 3) + 8 * (i >> 2) + 4 * h;
        *(LAS float*)(lds + (row * 1028 + (wave * 4 + nt) * 32 + (lane & 31)) * 4) = acc[nt][i];
      }
    __syncthreads();
#pragma unroll 1
    for (int i = 0; i < 4; ++i) {
      const int row = wave * 4 + i, m = t0 + row;
      int l, L, cond, m0; tokinfo(m, l, L, cond, m0);
      const float* gate = MODS + (size_t)(layer * 3 + cond) * 3072 + 2048;
      const GAS f32x4* xr = (const GAS f32x4*)xrow_in(p, layer, ws, m);
      f32x4 v[4]; float s = 0.f;
#pragma unroll
      for (int q = 0; q < 4; ++q) {
        const int k = 4 * lane + 256 * q;
        const f32x4 o = *(LAS const f32x4*)(lds + (row * 1028 + k) * 4);
        const f32x4 x = xr[lane + 64 * q]; const f32x4 g = *(const f32x4*)(gate + k);
        v[q] = ALPHA * x + g * o; s += (v[q].x + v[q].y) + (v[q].z + v[q].w);
      }
      const float mu = wsum(s) * (1.f / D); float qq = 0.f;
#pragma unroll
      for (int q = 0; q < 4; ++q) { v[q] = v[q] - mu; qq += (v[q].x * v[q].x + v[q].y * v[q].y) + (v[q].z * v[q].z + v[q].w * v[q].w); }
      const float rs = rsqrtf(wsum(qq) * (1.f / D) + LN_EPS);
      GASF* xo = (layer & 1) ? p.out + OUT_Y + (size_t)m * D : (GASF*)(ws + M_X) + (size_t)m * D;
      const float* nmod = MODS + (size_t)((layer + 1) * 3 + cond) * 3072;
      bf16_t* HB = (bf16_t*)(ws + M_HB) + (size_t)m * D;
#pragma unroll
      for (int q = 0; q < 4; ++q) {
        const int k = 4 * lane + 256 * q;
        const f32x4 lg = *(const f32x4*)(p.ln_g + layer * D + k), lb = *(const f32x4*)(p.ln_b + layer * D + k);
        const f32x4 y = v[q] * rs * lg + lb;
        *(GAS f32x4*)(xo + k) = y;
        if (layer < 3) {
          const f32x4 sh = *(const f32x4*)(nmod + k), sc = *(const f32x4*)(nmod + 1024 + k);
          u32x2 o; o.x = pk2_(y.x * (1.f + sc.x) + sh.x, y.y * (1.f + sc.y) + sh.y); o.y = pk2_(y.z * (1.f + sc.z) + sh.z, y.w * (1.f + sc.w) + sh.w);
          *(u32x2*)(HB + k) = o;
        }
      }
    }
  }
}

__device__ __forceinline__ int kvrow_(int m) { if (m < NPT) return m; const int mm = m - NPT; return NPT + (mm >> 11) * 2560 + PAST + (mm & 2047); }

struct EpiSilu {
  static constexpr bool PERM = true, AFTER_DRAIN = false;
  bf16_t* O; int ldc;
  __device__ __forceinline__ void operator()(const f32x4 (&acc)[2][2][4][2], const pg8::Unit& u, int wr, int wc, int fr, int fq) const {
    const int row0 = u.pm * 256 + wr * 64 + fr, col0 = u.pn * 256 + wc * 32 + 8 * fq;
#pragma unroll
    for (int ai = 0; ai < 2; ++ai)
#pragma unroll
      for (int m = 0; m < 4; ++m) {
        bf16_t* rowp = O + (size_t)(row0 + ai * 128 + m * 16) * ldc + col0;
#pragma unroll
        for (int bj = 0; bj < 2; ++bj) {
          const f32x4 v0 = acc[ai][bj][m][0], v1 = acc[ai][bj][m][1];
          u32x4 w; w.x = pk2_(silu(v0[0]), silu(v0[1])); w.y = pk2_(silu(v0[2]), silu(v0[3])); w.z = pk2_(silu(v1[0]), silu(v1[1])); w.w = pk2_(silu(v1[2]), silu(v1[3]));
          *(u32x4*)(rowp + bj * 128) = w;
        }
      }
  }
};
struct EpiF32 {
  static constexpr bool PERM = true, AFTER_DRAIN = false;
  float* O; int ldc;
  __device__ __forceinline__ void operator()(const f32x4 (&acc)[2][2][4][2], const pg8::Unit& u, int wr, int wc, int fr, int fq) const {
    const int row0 = u.pm * 256 + wr * 64 + fr, col0 = u.pn * 256 + wc * 32 + 8 * fq;
#pragma unroll
    for (int ai = 0; ai < 2; ++ai)
#pragma unroll
      for (int m = 0; m < 4; ++m) {
        float* rowp = O + (size_t)(row0 + ai * 128 + m * 16) * ldc + col0;
#pragma unroll
        for (int bj = 0; bj < 2; ++bj) { *(f32x4*)(rowp + bj * 128) = acc[ai][bj][m][0]; *(f32x4*)(rowp + bj * 128 + 4) = acc[ai][bj][m][1]; }
      }
  }
};
struct EpiKV {
  static constexpr bool PERM = true, AFTER_DRAIN = false;
  bf16_t* Kn; bf16_t* V;
  __device__ __forceinline__ void operator()(const f32x4 (&acc)[2][2][4][2], const pg8::Unit& u, int wr, int wc, int fr, int fq) const {
    const int row0 = u.pm * 256 + wr * 64 + fr;
    const int d = wc * 32 + 8 * fq;
    bf16_t* base = (d < 64 ? Kn : V) + (d & 63);
#pragma unroll
    for (int ai = 0; ai < 2; ++ai)
#pragma unroll
      for (int m = 0; m < 4; ++m) {
        const size_t row = (size_t)(row0 + ai * 128 + m * 16);
#pragma unroll
        for (int bj = 0; bj < 2; ++bj) {
          const int h = u.pn * 2 + bj;
          const f32x4 v0 = acc[ai][bj][m][0], v1 = acc[ai][bj][m][1];
          u32x4 w; w.x = pg8::cvt_pk_bf16(v0[0], v0[1]); w.y = pg8::cvt_pk_bf16(v0[2], v0[3]); w.z = pg8::cvt_pk_bf16(v1[0], v1[1]); w.w = pg8::cvt_pk_bf16(v1[2], v1[3]);
          *(u32x4*)(base + row * 1024 + h * 64) = w;
        }
      }
  }
};

__device__ __forceinline__ void phase_mla_rows(const LAS PG& p, unsigned char* ws, int lane, int wave, int bid, int G) {
  const float* U2S = (const float*)(ws + M_U2S);
  for (int m = bid * 8 + wave; m < NTOK; m += G * 8) {
    int l, L, cond, m0; tokinfo(m, l, L, cond, m0);
    const float* rb = U2S + (size_t)m * 512;
    const f32x4 q = *(const f32x4*)(rb + 4 * lane);
    const float rs = rsqrtf(wsum(q.x * q.x + q.y * q.y + q.z * q.z + q.w * q.w) * (1.f / 256.f) + RMS_EPS);
    const f32x4 g = *(const GAS f32x4*)(p.mla_q_norm + 4 * lane);
    u32x2 qo; qo.x = pk2_(q.x * rs * g.x, q.y * rs * g.y); qo.y = pk2_(q.z * rs * g.z, q.w * rs * g.w);
    *(u32x2*)((bf16_t*)(ws + M_QN) + (size_t)m * 256 + 4 * lane) = qo;
    const float k0 = rb[256 + 2 * lane], k1 = rb[256 + 2 * lane + 1];
    const float rs2 = rsqrtf(wsum(k0 * k0 + k1 * k1) * (1.f / 128.f) + RMS_EPS);
    const float c0 = k0 * rs2 * p.mla_kv_norm[2 * lane], c1 = k1 * rs2 * p.mla_kv_norm[2 * lane + 1];
    const int kr = kvrow_(m);
    *(unsigned*)((bf16_t*)(ws + M_CKVALL) + (size_t)kr * 128 + 2 * lane) = pk2_(c0, c1);
    if (m < NPT) { p.out[OUT_CKV + (size_t)m * 128 + 2 * lane] = c0; p.out[OUT_CKV + (size_t)m * 128 + 2 * lane + 1] = c1; }
    const float x = rb[384 + (lane & 31)];
    const float partner = __shfl_xor(x, 8);
    float o = x;
    if (m >= NPT) {
      const int d = lane & 31, jj = d & 7;
      const float inv = exp2f(-(float)(2 * jj) * (13.287712379549449f / 16.f));
      const float pos = (d < 16) ? (float)(l >> 6) : (float)(l & 63);
      const float ang = pos * inv; const float cs = cosf(ang), sn = sinf(ang);
      o = (d & 8) ? x * cs + partner * sn : x * cs - partner * sn;
    }
    if (lane < 32) {
      ((bf16_t*)(ws + M_KPEB))[(size_t)kr * 32 + lane] = (bf16_t)f2bf_(o);
      if (m < NPT) p.out[OUT_KPE + (size_t)m * 32 + lane] = x;
    }
  }
}

constexpr int AT_KB = 12288, AT_VB = 8192, AT_BUF = AT_KB + AT_VB, AT_WS = 2 * AT_BUF, AT_ST = AT_WS + 8 * 256;
__device__ __forceinline__ int crow_(int r, int hi) { return (r & 3) + 8 * (r >> 2) + 4 * hi; }
__device__ __forceinline__ unsigned cvtpk(float lo, float hi) { return pk2_(lo, hi); }

__device__ __forceinline__ void attn_unit(const unsigned char* ws, LAS unsigned char* lds, int seq, int hd, int qb, bf16_t* Gout, int tid, int lane, int wave) {
  const bf16_t* Q = (const bf16_t*)(ws + M_Q); const bf16_t* Kn = (const bf16_t*)(ws + M_KN); const bf16_t* Vv = (const bf16_t*)(ws + M_V);
  const bf16_t* KP = (const bf16_t*)(ws + M_KPEB); const bf16_t* SZ = (const bf16_t*)(ws + M_SZB);
  const int r32 = lane & 31, hi = lane >> 5;
  const bool smp = seq >= 16;
  const int mq0 = smp ? NPT + (seq - 16) * 2048 + qb * 256 : seq * 256;
  const int kbase = smp ? NPT + (seq - 16) * 2560 : seq * 256;
  const int NT = smp ? 40 : 4;
  const float C2 = 0.10206207261596575f * 1.4426950408889634f;
  bf16x8 qr[6];
  {
    const int m = mq0 + wave * 32 + r32;
    const bf16_t* qp = Q + (size_t)m * 1536 + hd * 96;
    const int l = smp ? ((m - NPT) & 2047) : 0;
#pragma unroll
    for (int d0 = 0; d0 < 6; ++d0) {
      const u32x4 own = *(const u32x4*)(qp + 16 * d0 + 8 * hi);
      float f[8];
#pragma unroll
      for (int e = 0; e < 4; ++e) { f[2 * e] = bf2f(own[e] & 0xffffu); f[2 * e + 1] = bf2f(own[e] >> 16); }
      if (d0 >= 4 && smp) {
        const u32x4 oth = *(const u32x4*)(qp + 16 * d0 + 8 * (1 - hi));
        const float pos = (d0 == 4) ? (float)(l >> 6) : (float)(l & 63);
#pragma unroll
        for (int e = 0; e < 8; ++e) {
          const float pf = bf2f((e & 1) ? (oth[e >> 1] >> 16) : (oth[e >> 1] & 0xffffu));
          const float inv = exp2f(-(float)(2 * e) * (13.287712379549449f / 16.f));
          const float ang = pos * inv; const float cs = cosf(ang), sn = sinf(ang);
          f[e] = hi ? f[e] * cs + pf * sn : f[e] * cs - pf * sn;
        }
      }
      u32x4 o; o.x = pk2_(f[0] * C2, f[1] * C2); o.y = pk2_(f[2] * C2, f[3] * C2); o.z = pk2_(f[4] * C2, f[5] * C2); o.w = pk2_(f[6] * C2, f[7] * C2);
      qr[d0] = __builtin_bit_cast(bf16x8, o);
    }
  }
  const bf16_t* vsrc = Vv + (size_t)(kbase + 16 * (wave & 3) + (lane >> 2)) * 1024 + hd * 64 + (wave >> 2) * 32 + (lane & 3) * 8;
  const int kc0 = tid >> 6, key0 = tid & 63;
  const bf16_t* ksrc0 = Kn + (size_t)(kbase + key0) * 1024 + hd * 64 + 8 * kc0;
  const bool k2 = tid < 256;
  const bf16_t* ksrc1 = KP + (size_t)(kbase + key0) * 32 + 8 * (tid >> 6);
  u32x4 rv, rk0, rk1 = (u32x4){0u, 0u, 0u, 0u};
#define AT_LOAD(t) do { rv = *(const u32x4*)(vsrc + (size_t)(t) * 64 * 1024); rk0 = *(const u32x4*)(ksrc0 + (size_t)(t) * 64 * 1024); if (k2) rk1 = *(const u32x4*)(ksrc1 + (size_t)(t) * 64 * 32); } while (0)
#define AT_STORE(b) do { LAS unsigned char* bb = lds + (b) * AT_BUF; *(LAS u32x4*)(bb + tid * 16) = rk0; if (k2) *(LAS u32x4*)(bb + 8192 + tid * 16) = rk1; *(LAS u32x4*)(bb + AT_KB + tid * 16) = rv; } while (0)
  __syncthreads();
  AT_LOAD(0); AT_STORE(0);
  __syncthreads();
  LAS float* wsf = (LAS float*)(lds + AT_WS + wave * 256);
  f32x16 o0, o1;
#pragma unroll
  for (int i = 0; i < 16; ++i) { o0[i] = 0.f; o1[i] = 0.f; }
  float mref = 0.f, lrun = 0.f;
  f32x16 negm;
#pragma unroll
  for (int i = 0; i < 16; ++i) negm[i] = 0.f;
  const int vboff = ((lane >> 4) & 1) * 32 + (lane & 3) * 8 + (4 * hi + ((lane & 15) >> 2)) * 64;
  for (int t = 0; t < NT; ++t) {
    const int cur = t & 1;
    if (t + 1 < NT) AT_LOAD(t + 1);
    LAS const unsigned char* kb = lds + cur * AT_BUF + hi * 1024 + r32 * 16;
    f32x16 p0 = negm, p1 = negm;
#pragma unroll
    for (int d0 = 0; d0 < 6; ++d0) {
      const bf16x8 a0 = *(LAS const bf16x8*)(kb + d0 * 2048), a1 = *(LAS const bf16x8*)(kb + d0 * 2048 + 512);
      p0 = __builtin_amdgcn_mfma_f32_32x32x16_bf16(a0, qr[d0], p0, 0, 0, 0);
      p1 = __builtin_amdgcn_mfma_f32_32x32x16_bf16(a1, qr[d0], p1, 0, 0, 0);
    }
    float rm = fmaxf(fmaxf(p0[0], p0[1]), fmaxf(p1[0], p1[1]));
#pragma unroll
    for (int i = 2; i < 16; i += 2) rm = fmaxf(rm, fmaxf(fmaxf(p0[i], p0[i + 1]), fmaxf(p1[i], p1[i + 1])));
    rm = fmaxf(rm, __shfl_xor(rm, 32));
    if (t == 0 || __any(rm > 8.f)) {
      const float dl = (t == 0) ? rm : fmaxf(rm, 0.f);
      mref += dl;
      const float alpha = __builtin_amdgcn_exp2f(-dl);
      lrun *= alpha;
#pragma unroll
      for (int i = 0; i < 16; ++i) { p0[i] -= dl; p1[i] -= dl; negm[i] = -mref; }
      if (hi == 0) wsf[r32] = alpha;
      asm volatile("s_waitcnt lgkmcnt(0)" ::: "memory");
#pragma unroll
      for (int i = 0; i < 16; ++i) { const float al = wsf[crow_(i, hi)]; o0[i] *= al; o1[i] *= al; }
    }
    float ps0 = 0.f, ps1 = 0.f;
#pragma unroll
    for (int i = 0; i < 16; ++i) { p0[i] = __builtin_amdgcn_exp2f(p0[i]); p1[i] = __builtin_amdgcn_exp2f(p1[i]); ps0 += p0[i]; ps1 += p1[i]; }
    lrun += ps0 + ps1;
    u32x4 w0, w1, w2, w3;
    w0.x = cvtpk(p0[0], p0[1]); w0.y = cvtpk(p0[2], p0[3]); w0.z = cvtpk(p0[4], p0[5]); w0.w = cvtpk(p0[6], p0[7]);
    w1.x = cvtpk(p0[8], p0[9]); w1.y = cvtpk(p0[10], p0[11]); w1.z = cvtpk(p0[12], p0[13]); w1.w = cvtpk(p0[14], p0[15]);
    w2.x = cvtpk(p1[0], p1[1]); w2.y = cvtpk(p1[2], p1[3]); w2.z = cvtpk(p1[4], p1[5]); w2.w = cvtpk(p1[6], p1[7]);
    w3.x = cvtpk(p1[8], p1[9]); w3.y = cvtpk(p1[10], p1[11]); w3.z = cvtpk(p1[12], p1[13]); w3.w = cvtpk(p1[14], p1[15]);
    const bf16x8 pa0 = __builtin_bit_cast(bf16x8, w0), pa1 = __builtin_bit_cast(bf16x8, w1), pa2 = __builtin_bit_cast(bf16x8, w2), pa3 = __builtin_bit_cast(bf16x8, w3);
    LAS const unsigned char* vb = lds + cur * AT_BUF + AT_KB + vboff;
#define AT_PV(O_, D0) do { \
      const v4i16_t l0 = vtr(vb + (D0) * 4096), h0 = vtr(vb + (D0) * 4096 + 512), l1 = vtr(vb + (D0) * 4096 + 1024), h1 = vtr(vb + (D0) * 4096 + 1024 + 512); \
      const v4i16_t l2 = vtr(vb + (D0) * 4096 + 2048), h2 = vtr(vb + (D0) * 4096 + 2048 + 512), l3 = vtr(vb + (D0) * 4096 + 3072), h3 = vtr(vb + (D0) * 4096 + 3072 + 512); \
      O_ = __builtin_amdgcn_mfma_f32_32x32x16_bf16(pa0, ((bf16x8){l0[0], l0[1], l0[2], l0[3], h0[0], h0[1], h0[2], h0[3]}), O_, 0, 0, 0); \
      O_ = __builtin_amdgcn_mfma_f32_32x32x16_bf16(pa1, ((bf16x8){l1[0], l1[1], l1[2], l1[3], h1[0], h1[1], h1[2], h1[3]}), O_, 0, 0, 0); \
      O_ = __builtin_amdgcn_mfma_f32_32x32x16_bf16(pa2, ((bf16x8){l2[0], l2[1], l2[2], l2[3], h2[0], h2[1], h2[2], h2[3]}), O_, 0, 0, 0); \
      O_ = __builtin_amdgcn_mfma_f32_32x32x16_bf16(pa3, ((bf16x8){l3[0], l3[1], l3[2], l3[3], h3[0], h3[1], h3[2], h3[3]}), O_, 0, 0, 0); } while (0)
    AT_PV(o0, 0); AT_PV(o1, 1);
#undef AT_PV
    if (t + 1 < NT) AT_STORE(cur ^ 1);
    __syncthreads();
  }
#undef AT_LOAD
#undef AT_STORE
  lrun += __shfl_xor(lrun, 32);
  if (hi == 0) wsf[32 + r32] = 1.f / lrun;
  asm volatile("s_waitcnt lgkmcnt(0)" ::: "memory");
  LAS bf16_t* stg = (LAS bf16_t*)(lds + AT_ST + wave * 4096);
#pragma unroll
  for (int i = 0; i < 16; ++i) {
    const int orow = crow_(i, hi); const float rl = wsf[32 + orow];
    stg[orow * 64 + r32] = (bf16_t)f2bf_(o0[i] * rl);
    stg[orow * 64 + 32 + r32] = (bf16_t)f2bf_(o1[i] * rl);
  }
  asm volatile("s_waitcnt lgkmcnt(0)" ::: "memory");
#pragma unroll
  for (int i = 0; i < 4; ++i) {
    const int row = i * 8 + (lane >> 3), ch = lane & 7;
    const u32x4 ov = *(LAS const u32x4*)(stg + row * 64 + ch * 8);
    const size_t gi = (size_t)(mq0 + wave * 32 + row) * D + hd * 64 + ch * 8;
    const u32x4 zv = *(const u32x4*)(SZ + gi);
    u32x4 res;
#pragma unroll
    for (int e = 0; e < 4; ++e) res[e] = pk2_(bf2f(ov[e] & 0xffffu) * bf2f(zv[e] & 0xffffu), bf2f(ov[e] >> 16) * bf2f(zv[e] >> 16));
    *(u32x4*)(Gout + gi) = res;
  }
}
constexpr size_t M_XMIX = M_UT;
constexpr size_t M_YF = M_UT, M_YB = M_UT + 32 * MiB;
constexpr size_t M_RB = M_SCR2, M_KB = M_SCR2 + 16 * MiB, M_VB = M_SCR2 + 32 * MiB, M_SZR = M_SCR2 + 48 * MiB;
constexpr size_t M_HWA = M_GB;
constexpr size_t M_BON = M_GB + 8 * MiB;

__device__ __forceinline__ void phase_rw_mix(const LAS PG& p, unsigned char* ws, int tid, int bid, int G) {
  const bf16_t* HB = (const bf16_t*)(ws + M_HB);
  bf16_t* XM = (bf16_t*)(ws + M_XMIX);
  for (int i = bid * 512 + tid; i < NTOK * 128; i += G * 512) {
    const int m = i >> 7, k8 = i & 127;
    int l, L, cond, m0; tokinfo(m, l, L, cond, m0);
    const u32x4 hc = *(const u32x4*)(HB + (size_t)m * D + 8 * k8);
    u32x4 hp = (u32x4){0u, 0u, 0u, 0u}, hn = hp;
    if (l > 0) hp = *(const u32x4*)(HB + (size_t)(m - 1) * D + 8 * k8);
    if (l < L - 1) hn = *(const u32x4*)(HB + (size_t)(m + 1) * D + 8 * k8);
    float h[8], d[8];
#pragma unroll
    for (int e = 0; e < 4; ++e) {
      h[2 * e] = bf2f(hc[e] & 0xffffu); h[2 * e + 1] = bf2f(hc[e] >> 16);
      d[2 * e] = 0.5f * (bf2f(hp[e] & 0xffffu) + bf2f(hn[e] & 0xffffu)) - h[2 * e];
      d[2 * e + 1] = 0.5f * (bf2f(hp[e] >> 16) + bf2f(hn[e] >> 16)) - h[2 * e + 1];
    }
#pragma unroll
    for (int q = 0; q < 4; ++q) {
      const int mi = (q == 0) ? 0 : (q == 1) ? 2 : (q == 2) ? 3 : 5;
      const f32x4 u0 = *(const f32x4*)(p.rw_mu + mi * D + 8 * k8), u1 = *(const f32x4*)(p.rw_mu + mi * D + 8 * k8 + 4);
      u32x4 o; o.x = pk2_(h[0] + d[0] * u0.x, h[1] + d[1] * u0.y); o.y = pk2_(h[2] + d[2] * u0.z, h[3] + d[3] * u0.w);
      o.z = pk2_(h[4] + d[4] * u1.x, h[5] + d[5] * u1.y); o.w = pk2_(h[6] + d[6] * u1.z, h[7] + d[7] * u1.w);
      *(u32x4*)(XM + (size_t)q * NTOK * D + (size_t)m * D + 8 * k8) = o;
    }
  }
}

__device__ __forceinline__ void rw_lora_tile(const LAS PG& p, unsigned char* ws, LAS unsigned char* lds, int tile, int tid, int lane, int wave) {
  const bf16_t* HB = (const bf16_t*)(ws + M_HB);
  const bf16_t* Wf = (const bf16_t*)(ws + W_LORA1);
  const int h = lane >> 5, t0 = tile * 32;
  __syncthreads();
#pragma unroll 2
  for (int i = 0; i < 8; ++i) {
    const int idx = tid + 512 * i; const int tok = idx >> 7, k8 = idx & 127; const int m = t0 + tok;
    int l, L, cond, m0; tokinfo(m, l, L, cond, m0);
    const u32x4 hc = *(const u32x4*)(HB + (size_t)m * D + 8 * k8);
    u32x4 hp = (u32x4){0u, 0u, 0u, 0u}, hn = hp;
    if (l > 0) hp = *(const u32x4*)(HB + (size_t)(m - 1) * D + 8 * k8);
    if (l < L - 1) hn = *(const u32x4*)(HB + (size_t)(m + 1) * D + 8 * k8);
    float hh[8], d[8];
#pragma unroll
    for (int e = 0; e < 4; ++e) {
      hh[2 * e] = bf2f(hc[e] & 0xffffu); hh[2 * e + 1] = bf2f(hc[e] >> 16);
      d[2 * e] = 0.5f * (bf2f(hp[e] & 0xffffu) + bf2f(hn[e] & 0xffffu)) - hh[2 * e];
      d[2 * e + 1] = 0.5f * (bf2f(hp[e] >> 16) + bf2f(hn[e] >> 16)) - hh[2 * e + 1];
    }
#pragma unroll
    for (int q = 0; q < 2; ++q) {
      const int mi = q ? 4 : 1;
      const f32x4 u0 = *(const f32x4*)(p.rw_mu + mi * D + 8 * k8), u1 = *(const f32x4*)(p.rw_mu + mi * D + 8 * k8 + 4);
      u32x4 o; o.x = pk2_(hh[0] + d[0] * u0.x, hh[1] + d[1] * u0.y); o.y = pk2_(hh[2] + d[2] * u0.z, hh[3] + d[3] * u0.w);
      o.z = pk2_(hh[4] + d[4] * u1.x, hh[5] + d[5] * u1.y); o.w = pk2_(hh[6] + d[6] * u1.z, hh[7] + d[7] * u1.w);
      *(LAS u32x4*)(lds + q * 65536 + (k8 * 32 + tok) * 16) = o;
    }
  }
  __syncthreads();
  f32x16 acc;
#pragma unroll
  for (int i = 0; i < 16; ++i) acc[i] = 0.f;
  const int aoff = (wave >> 2) * 65536 + ((h * 32) + (lane & 31)) * 16;
  const bf16_t* wf = Wf + ((size_t)wave * 64 * 64 + lane) * 8;
#pragma unroll 16
  for (int ks = 0; ks < 64; ++ks) {
    const bf16x8 af = *(LAS const bf16x8*)(lds + aoff + ks * 1024);
    const bf16x8 b0 = *(const bf16x8*)(wf + ((size_t)ks * 64) * 8);
    acc = __builtin_amdgcn_mfma_f32_32x32x16_bf16(af, b0, acc, 0, 0, 0);
  }
  bf16_t* HWA = (bf16_t*)(ws + M_HWA);
#pragma unroll
  for (int i = 0; i < 16; ++i) {
    const int row = (i & 3) + 8 * (i >> 2) + 4 * h;
    const float v = (wave < 4) ? tanhf(acc[i]) : acc[i];
    HWA[(size_t)(t0 + row) * 256 + wave * 32 + (lane & 31)] = (bf16_t)f2bf_(v);
  }
}

#define DPP_ADD(v, CTRL) ((v) + __builtin_bit_cast(float, __builtin_amdgcn_mov_dpp(__builtin_bit_cast(int, (v)), (CTRL), 0xF, 0xF, true)))
__device__ __forceinline__ float allred4(float v) { v = DPP_ADD(v, 0xB1); v = DPP_ADD(v, 0x4E); return v; }
__device__ __forceinline__ float allred16(float v) { v = DPP_ADD(v, 0xB1); v = DPP_ADD(v, 0x4E); v = DPP_ADD(v, 0x141); v = DPP_ADD(v, 0x140); return v; }

__device__ __forceinline__ float fma_s(float a, float b, float c) { float d; asm("v_fma_f32 %0, %1, %2, %3" : "=v"(d) : "v"(a), "v"(b), "v"(c)); return d; }
__device__ __forceinline__ float mul_s(float a, float b) { float d; asm("v_mul_f32_e32 %0, %1, %2" : "=v"(d) : "v"(a), "v"(b)); return d; }
__device__ __forceinline__ float add_s(float a, float b) { float d; asm("v_add_f32_e32 %0, %1, %2" : "=v"(d) : "v"(a), "v"(b)); return d; }
#define DPPADD_(NAME, CTRL) __device__ __forceinline__ float NAME(float s) { float d; asm("s_nop 1\n\tv_add_f32_dpp %0, %1, %1 " CTRL " row_mask:0xf bank_mask:0xf bound_ctrl:1" : "=v"(d) : "v"(s)); return d; }
DPPADD_(dpp_x1, "quad_perm:[1,0,3,2]")
DPPADD_(dpp_x2, "quad_perm:[2,3,0,1]")
DPPADD_(dpp_hm, "row_half_mirror")
DPPADD_(dpp_rm, "row_mirror")
__device__ __forceinline__ float ar4(float v) { return dpp_x2(dpp_x1(v)); }
__device__ __forceinline__ float ar16(float v) { return dpp_rm(dpp_hm(dpp_x2(dpp_x1(v)))); }
__device__ __forceinline__ float dot4_s(const f32x4& s, const f32x4& a) { return add_s(fma_s(s.y, a.y, mul_s(s.x, a.x)), fma_s(s.w, a.w, mul_s(s.z, a.z))); }
__device__ __forceinline__ void upd4_s(f32x4& s, const f32x4& w, const f32x4& b, const f32x4& k, float sa, float vi) {
  s.x = fma_s(s.x, w.x, fma_s(sa, b.x, mul_s(vi, k.x))); s.y = fma_s(s.y, w.y, fma_s(sa, b.y, mul_s(vi, k.y)));
  s.z = fma_s(s.z, w.z, fma_s(sa, b.z, mul_s(vi, k.z))); s.w = fma_s(s.w, w.w, fma_s(sa, b.w, mul_s(vi, k.w)));
}
constexpr int PB_BYTES = 24832;
constexpr int SC_PS0 = 0, SC_PP0 = 2 * PB_BYTES;

constexpr int SC_FR = 4 * PB_BYTES;
__device__ __forceinline__ u32x4 ld_bfrag(const GASF* W2, int ks, int lane) {
  const int k0 = 32 * ks + 8 * (lane >> 4);
  u32x4 o; o.x = pk2_(W2[(size_t)(k0 + 0) * D], W2[(size_t)(k0 + 1) * D]); o.y = pk2_(W2[(size_t)(k0 + 2) * D], W2[(size_t)(k0 + 3) * D]);
  o.z = pk2_(W2[(size_t)(k0 + 4) * D], W2[(size_t)(k0 + 5) * D]); o.w = pk2_(W2[(size_t)(k0 + 6) * D], W2[(size_t)(k0 + 7) * D]);
  return o;
}
struct ChId { int dir, hd, m0, L, froff; };
__device__ __forceinline__ ChId chid(int slot, int seq, int dir, int hd, int lane, int ntile) {
  ChId c; c.dir = dir; c.hd = hd; c.L = seq < 16 ? 256 : 2048; c.m0 = seq < 16 ? seq * 256 : NPT + (seq - 16) * 2048;
  c.froff = SC_FR + ((slot * 4 + ntile) * 6) * 1024 + lane * 16; return c;
}
__device__ __forceinline__ void prepc_load(const LAS PG& p, LAS unsigned char* lds, int froff, int dir, int hd, int lane, int ntile) {
  const int ch = hd * 64 + 16 * ntile + (lane & 15);
  const GASF* W2 = p.rw_w2 + (size_t)dir * 64 * D + ch; const GASF* A2 = p.rw_a2 + (size_t)dir * 64 * D + ch;
  *(LAS u32x4*)(lds + froff) = ld_bfrag(W2, 0, lane); __builtin_amdgcn_sched_barrier(0);
  *(LAS u32x4*)(lds + froff + 1024) = ld_bfrag(W2, 1, lane); __builtin_amdgcn_sched_barrier(0);
  *(LAS u32x4*)(lds + froff + 2048) = ld_bfrag(A2, 0, lane); __builtin_amdgcn_sched_barrier(0);
  *(LAS u32x4*)(lds + froff + 3072) = ld_bfrag(A2, 1, lane); __builtin_amdgcn_sched_barrier(0);
  LAS float* cn = (LAS float*)(lds + (froff - lane * 16) + 4096) + lane;
  cn[0] = p.rw_w0[dir * D + ch]; cn[64] = p.rw_a0[dir * D + ch]; cn[128] = p.rw_k_k[ch]; cn[192] = p.rw_k_a[ch]; cn[256] = p.rw_r_k[ch];
}
struct PrepIn { u32x4 hw[2], ha[2]; unsigned kr[4], rr[4], vr[4]; };
__device__ __forceinline__ int ctok(int m0, int L, int dir, int step) { return m0 + (dir ? (L - 1 - step) : step); }
__device__ __forceinline__ void prep_fetch(const unsigned char* ws, int c_m0, int c_L, int c_dir, int c_hd, int s0, int lane, int ntile, PrepIn& in) {
  const bf16_t* HWA = (const bf16_t*)(ws + M_HWA);
  const int m = ctok(c_m0, c_L, c_dir, s0 + (lane & 15));
  const bf16_t* src = HWA + (size_t)m * 256 + c_dir * 64 + 8 * (lane >> 4);
  in.hw[0] = *(const u32x4*)(src); in.hw[1] = *(const u32x4*)(src + 32);
  in.ha[0] = *(const u32x4*)(src + 128); in.ha[1] = *(const u32x4*)(src + 160);
#pragma unroll
  for (int r = 0; r < 4; ++r) {
    const int mt = ctok(c_m0, c_L, c_dir, s0 + 4 * (lane >> 4) + r);
    const size_t gi = (size_t)mt * D + c_hd * 64 + 16 * ntile + (lane & 15);
    in.kr[r] = ((const bf16_t*)(ws + M_KB))[gi]; in.rr[r] = ((const bf16_t*)(ws + M_RB))[gi]; in.vr[r] = ((const bf16_t*)(ws + M_VB))[gi];
  }
}
__device__ __forceinline__ bf16x8 pack8(const f32x4& a, const f32x4& b) { u32x4 o; o.x = pk2_(a.x, a.y); o.y = pk2_(a.z, a.w); o.z = pk2_(b.x, b.y); o.w = pk2_(b.z, b.w); return __builtin_bit_cast(bf16x8, o); }
__device__ __forceinline__ void prep_finish(unsigned char* ws, LAS unsigned char* lds, int c_m0, int c_L, int c_dir, int c_hd, int c_froff, int s0, int pboff, int lane, int ntile, const PrepIn& in) {
  LAS const float* cn = (LAS const float*)(lds + (c_froff - lane * 16) + 4096) + lane;
  const float c_biasw = cn[0], c_biasa = cn[64], c_kkc = cn[128], c_kac = cn[192], c_rkc = cn[256];
  f32x4 aw = (f32x4){c_biasw, c_biasw, c_biasw, c_biasw}, aa = (f32x4){c_biasa, c_biasa, c_biasa, c_biasa};
  aw = __builtin_amdgcn_mfma_f32_16x16x32_bf16(__builtin_bit_cast(bf16x8, in.hw[0]), *(LAS const bf16x8*)(lds + c_froff), aw, 0, 0, 0);
  aw = __builtin_amdgcn_mfma_f32_16x16x32_bf16(__builtin_bit_cast(bf16x8, in.hw[1]), *(LAS const bf16x8*)(lds + c_froff + 1024), aw, 0, 0, 0);
  aa = __builtin_amdgcn_mfma_f32_16x16x32_bf16(__builtin_bit_cast(bf16x8, in.ha[0]), *(LAS const bf16x8*)(lds + c_froff + 2048), aa, 0, 0, 0);
  aa = __builtin_amdgcn_mfma_f32_16x16x32_bf16(__builtin_bit_cast(bf16x8, in.ha[1]), *(LAS const bf16x8*)(lds + c_froff + 3072), aa, 0, 0, 0);
  LAS float* pb = (LAS float*)(lds + pboff);
  const int col = lane & 15, rg = lane >> 4, chl = 16 * ntile + col;
#pragma unroll
  for (int r = 0; r < 4; ++r) {
    const int t = 4 * rg + r;
    const float sig = __builtin_amdgcn_rcpf(1.f + __expf(-aw[r]));
    const float dec = __expf(-0.6065306597126334f * sig);
    const float a = __builtin_amdgcn_rcpf(1.f + __expf(-aa[r]));
    const float k = bf2f(in.kr[r]), rv = bf2f(in.rr[r]), v = bf2f(in.vr[r]);
    const float kq = k * c_kkc;
    const float ssq = ar16(kq * kq);
    const float kd = k * (1.f + (a - 1.f) * c_kac);
    const float bon = ar16(rv * kd * c_rkc);
    pb[t * 64 + chl] = dec; pb[1024 + t * 64 + chl] = -kq; pb[2048 + t * 64 + chl] = kq * a; pb[3072 + t * 64 + chl] = kd; pb[4096 + t * 64 + chl] = rv; pb[5120 + t * 64 + chl] = v;
    if (col == 0) {
      pb[6144 + t * 4 + ntile] = ssq;
      const int mt = ctok(c_m0, c_L, c_dir, s0 + t);
      ((float*)(ws + M_BON))[(((size_t)c_dir * NTOK + mt) * 16 + c_hd) * 4 + ntile] = bon;
    }
  }
}

#define LDS_BARRIER() asm volatile("s_waitcnt lgkmcnt(0)\n\ts_barrier" ::: "memory")
__device__ __forceinline__ void phase_rw_scan(const LAS PG& p, unsigned char* ws, LAS unsigned char* lds, int tid, int lane, int wave, int bid, int G) {
  for (int item = bid; item < 256; item += G) {
    const int sc = item >> 2, qt = item & 3;
    const int s_seq = 16 + (sc >> 5), s_dir = (sc >> 4) & 1, s_hd = sc & 15, s_m0 = NPT + (s_seq - 16) * 2048;
    __syncthreads();
    if (wave < 4) {
      __builtin_amdgcn_s_setprio(2);
      float* Yo = (float*)(ws + (s_dir ? M_YB : M_YF));
      const int srow = 16 * qt + 4 * wave + (lane >> 4), scg = lane & 15;
      f32x4 Ss = *(const GAS f32x4*)(p.state_rwkv + ((((size_t)(s_seq - 16)) * 2 + s_dir) * 16 + s_hd) * 4096 + (size_t)srow * 64 + 4 * scg);
      __syncthreads();
      for (int c = 0; c < 128; ++c) {
        LAS const float* ps = (LAS const float*)(lds + SC_PS0 + (c & 1) * PB_BYTES);
        float rn2v;
        { const f32x4 q4 = *(LAS const f32x4*)(ps + 6144 + (lane & 15) * 4); rn2v = __builtin_amdgcn_rcpf((q4.x + q4.y) + (q4.z + q4.w) + 1e-12f); }
        float yk[16];
#pragma unroll
        for (int t = 0; t < 16; ++t) {
          const f32x4 w4 = *(LAS const f32x4*)(ps + t * 64 + 4 * scg), a4 = *(LAS const f32x4*)(ps + 1024 + t * 64 + 4 * scg);
          const f32x4 b4 = *(LAS const f32x4*)(ps + 2048 + t * 64 + 4 * scg), k4 = *(LAS const f32x4*)(ps + 3072 + t * 64 + 4 * scg);
          const f32x4 r4 = *(LAS const f32x4*)(ps + 4096 + t * 64 + 4 * scg);
          const float vi = ps[5120 + t * 64 + srow];
          const float rn2 = __builtin_bit_cast(float, __builtin_amdgcn_readlane(__builtin_bit_cast(int, rn2v), t));
          const float sa = ar16(dot4_s(Ss, a4)) * rn2;
          upd4_s(Ss, w4, b4, k4, sa, vi);
          yk[t] = ar16(dot4_s(Ss, r4));
        }
        if (scg == 0) {
          const int mfirst = ctok(s_m0, 2048, s_dir, 16 * c);
          float* yp = Yo + (size_t)mfirst * D + s_hd * 64 + srow;
          const long stride = s_dir ? -(long)D : (long)D;
#pragma unroll
          for (int t = 0; t < 16; ++t) yp[t * stride] = yk[t];
        }
        LDS_BARRIER();
      }
      __builtin_amdgcn_s_setprio(0);
    } else {
      const int nt = wave - 4;
      const int s_fr = SC_FR + ((0 * 4 + nt) * 6) * 1024 + lane * 16;
      prepc_load(p, lds, s_fr, s_dir, s_hd, lane, nt);
      int pc = 2 * item;
      const int q_fr = SC_FR + ((1 * 4 + nt) * 6) * 1024 + lane * 16;
      prepc_load(p, lds, q_fr, (pc >> 4) & 1, pc & 15, lane, nt);
      int r_seq = pc >> 5, r_dir = (pc >> 4) & 1, r_hd = pc & 15;
      int q_seq = pc >> 5, q_dir = (pc >> 4) & 1, q_hd = pc & 15;
      PrepIn in_s, in_p;
      prep_fetch(ws, s_m0, 2048, s_dir, s_hd, 0, lane, nt, in_s); prep_fetch(ws, r_seq * 256, 256, r_dir, r_hd, 0, lane, nt, in_p);
      prep_finish(ws, lds, s_m0, 2048, s_dir, s_hd, s_fr, 0, SC_PS0, lane, nt, in_s); prep_finish(ws, lds, r_seq * 256, 256, r_dir, r_hd, q_fr, 0, SC_PP0, lane, nt, in_p);
      const int prow = 16 * nt + (lane >> 2), pcq = lane & 3;
      f32x4 Sp0 = (f32x4){0.f, 0.f, 0.f, 0.f}, Sp1 = Sp0, Sp2 = Sp0, Sp3 = Sp0;
      __syncthreads();
      for (int c = 0; c < 128; ++c) {
        const bool more_s = (c + 1) < 128;
        const bool pgrp = ((c & 3) == 0) && (c + 4 < 128);
        if (more_s) prep_fetch(ws, s_m0, 2048, s_dir, s_hd, 16 * (c + 1), lane, nt, in_s);
        if (pgrp) {
          if (c == 60) { pc = 2 * item + 1; r_seq = pc >> 5; r_dir = (pc >> 4) & 1; r_hd = pc & 15; prepc_load(p, lds, q_fr, r_dir, r_hd, lane, nt); }
          prep_fetch(ws, r_seq * 256, 256, r_dir, r_hd, 4 * ((c + 4) & 63), lane, nt, in_p);
        }
        if (c == 64) { q_seq = r_seq; q_dir = r_dir; q_hd = r_hd; Sp0 = (f32x4){0.f, 0.f, 0.f, 0.f}; Sp1 = Sp0; Sp2 = Sp0; Sp3 = Sp0; }
        {
          LAS const float* pp = (LAS const float*)(lds + SC_PP0 + ((c >> 2) & 1) * PB_BYTES);
          float* Yp = (float*)(ws + (q_dir ? M_YB : M_YF));
          float rn2v;
          { const f32x4 q4 = *(LAS const f32x4*)(pp + 6144 + (lane & 15) * 4); rn2v = __builtin_amdgcn_rcpf((q4.x + q4.y) + (q4.z + q4.w) + 1e-12f); }
#pragma unroll 2
          for (int s = 0; s < 4; ++s) {
            const int t = 4 * (c & 3) + s;
            const float vi = pp[5120 + t * 64 + prow];
            const float rn2 = __builtin_bit_cast(float, __builtin_amdgcn_readlane(__builtin_bit_cast(int, rn2v), t));
            LAS const float* q = pp + t * 64 + 16 * pcq;
            const f32x4 a0 = *(LAS const f32x4*)(q + 1024), a1 = *(LAS const f32x4*)(q + 1028), a2 = *(LAS const f32x4*)(q + 1032), a3 = *(LAS const f32x4*)(q + 1036);
            const float sa = ar4(add_s(add_s(dot4_s(Sp0, a0), dot4_s(Sp1, a1)), add_s(dot4_s(Sp2, a2), dot4_s(Sp3, a3)))) * rn2;
            float y0, y1, y2, y3;
#define UP4(S_, O_, Y_) { const f32x4 w4 = *(LAS const f32x4*)(q + (O_)), b4 = *(LAS const f32x4*)(q + 2048 + (O_)), k4 = *(LAS const f32x4*)(q + 3072 + (O_)), r4 = *(LAS const f32x4*)(q + 4096 + (O_)); \
              upd4_s(S_, w4, b4, k4, sa, vi); Y_ = dot4_s(S_, r4); }
            UP4(Sp0, 0, y0) UP4(Sp1, 4, y1) UP4(Sp2, 8, y2) UP4(Sp3, 12, y3)
#undef UP4
            const float y = ar4(add_s(add_s(y0, y1), add_s(y2, y3)));
            if (pcq == 0) Yp[(size_t)ctok(q_seq * 256, 256, q_dir, 4 * (c & 63) + s) * D + q_hd * 64 + prow] = y;
          }
          if ((c & 63) == 63) {
            GASF* so = p.out + OUT_ST + ((((size_t)q_seq) * 2 + q_dir) * 16 + q_hd) * 4096 + (size_t)prow * 64 + 16 * pcq;
            *(GAS f32x4*)so = Sp0; *(GAS f32x4*)(so + 4) = Sp1; *(GAS f32x4*)(so + 8) = Sp2; *(GAS f32x4*)(so + 12) = Sp3;
          }
        }
        if (more_s) prep_finish(ws, lds, s_m0, 2048, s_dir, s_hd, s_fr, 16 * (c + 1), SC_PS0 + ((c + 1) & 1) * PB_BYTES, lane, nt, in_s);
        if (pgrp) prep_finish(ws, lds, r_seq * 256, 256, r_dir, r_hd, q_fr, 4 * ((c + 4) & 63), SC_PP0 + (((c >> 2) + 1) & 1) * PB_BYTES, lane, nt, in_p);
        LDS_BARRIER();
      }
    }
  }
}
constexpr int LDO = 68, OSZ = 32 * LDO * 2;
constexpr int O_B = OSZ, O_K = 2 * OSZ, O_R = 3 * OSZ, O_V = 4 * OSZ, O_W = 5 * OSZ;
constexpr int LDM = 36, MSZ = 32 * LDM * 2;
constexpr int CK_OPS = 5 * OSZ + 256;
constexpr int CK_MX = 3 * CK_OPS;
constexpr int CK_MXS = 4 * MSZ;
constexpr int CK_SCR = CK_MX + 2 * CK_MXS;
constexpr int CK_SSQ = CK_SCR + 3 * MSZ;
constexpr int CK_FR = CK_SSQ + 1024;
constexpr int CK_IN = CK_FR + 4 * 6144;
constexpr int CK_INS = 3 * OSZ + 32 * 272;
static_assert(CK_IN + 2 * CK_INS <= PTAB_OFF, "scan LDS map overflows");

__device__ __forceinline__ unsigned short bfr(float f) { return (unsigned short)f2bf_(f); }
__device__ __forceinline__ bf16x8 cvt8(const f32x16& a, int s) {
  u32x4 o; o.x = pk2_(a[8 * s + 0], a[8 * s + 1]); o.y = pk2_(a[8 * s + 2], a[8 * s + 3]); o.z = pk2_(a[8 * s + 4], a[8 * s + 5]); o.w = pk2_(a[8 * s + 6], a[8 * s + 7]);
  return __builtin_bit_cast(bf16x8, o);
}
__device__ __forceinline__ bf16x8 ldA_perm(LAS const unsigned char* base, int ld, int row, int k0, int hi) {
  const u32x2 lo = *(LAS const u32x2*)(base + (row * ld + k0 + 4 * hi) * 2), hh = *(LAS const u32x2*)(base + (row * ld + k0 + 8 + 4 * hi) * 2);
  u32x4 o; o.x = lo.x; o.y = lo.y; o.z = hh.x; o.w = hh.y; return __builtin_bit_cast(bf16x8, o);
}
__device__ __forceinline__ bf16x8 ldT_perm(LAS const unsigned char* base, int ld, int k0, int c0, int lane) {
  const int hi = lane >> 5;
  LAS const unsigned char* a = base + ((k0 + 4 * hi + ((lane & 15) >> 2)) * ld + c0 + 16 * ((lane >> 4) & 1) + 4 * (lane & 3)) * 2;
  const v4i16_t lo = vtr(a), hh = vtr(a + 8 * ld * 2);
  return (bf16x8){lo[0], lo[1], lo[2], lo[3], hh[0], hh[1], hh[2], hh[3]};
}
__device__ __forceinline__ bf16x8 ldT_nat(LAS const unsigned char* base, int ld, int k0, int c0, int lane) {
  const int hi = lane >> 5;
  LAS const unsigned char* a = base + ((k0 + 8 * hi + ((lane & 15) >> 2)) * ld + c0 + 16 * ((lane >> 4) & 1) + 4 * (lane & 3)) * 2;
  const v4i16_t lo = vtr(a), hh = vtr(a + 4 * ld * 2);
  return (bf16x8){lo[0], lo[1], lo[2], lo[3], hh[0], hh[1], hh[2], hh[3]};
}
__device__ __forceinline__ bf16x8 ld16_(LAS const unsigned char* a) {
  const u32x2 lo = *(LAS const u32x2*)a, hh = *(LAS const u32x2*)(a + 8); u32x4 o; o.x = lo.x; o.y = lo.y; o.z = hh.x; o.w = hh.y; return __builtin_bit_cast(bf16x8, o);
}
__device__ __forceinline__ void st16_(LAS unsigned char* a, const u32x4 v) { *(LAS u32x2*)a = (u32x2){v.x, v.y}; *(LAS u32x2*)(a + 8) = (u32x2){v.z, v.w}; }
__device__ __forceinline__ int opq5(int x) { asm volatile("" : "+v"(x)); return x; }
#define MFMA32(A_, B_, C_) __builtin_amdgcn_mfma_f32_32x32x16_bf16((A_), (B_), (C_), 0, 0, 0)

struct CkChain { int seq, dir, hd, m0, L, nch, kofs; };
__device__ __forceinline__ CkChain ck_chain(int id) {
  CkChain c;
  if (id < 64) { c.seq = 16 + (id >> 5); c.dir = (id >> 4) & 1; c.hd = id & 15; c.L = 2048; c.m0 = NPT + (c.seq - 16) * 2048; }
  else { const int p = id - 64; c.seq = p >> 5; c.dir = (p >> 4) & 1; c.hd = p & 15; c.L = 256; c.m0 = c.seq * 256; }
  c.nch = c.L / 32; c.kofs = 0; return c;
}

constexpr int CK_K0 = 40, CK_NREC = 24;
constexpr int CK_REC = 4 * OSZ + 256 + CK_MXS;
constexpr size_t M_REC = 0;
constexpr size_t CK_FLAGS = 32768;
__device__ __forceinline__ void ck_run_chain(const LAS PG& p, unsigned char* ws, LAS unsigned char* lds, const CkChain ch, int lane_in, int wave, const int mode, const int nprep, const int cidx) {
  const int lane = lane_in;
  const int hi = lane >> 5, r32 = lane & 31;
  float* Yo = (float*)(ws + (ch.dir ? M_YB : M_YF));
  const int NK = ch.nch + 3;
  const int sb0 = 32 * ch.kofs;
#define CK_PROD(ACC, AOFF, BOFF) do { _Pragma("unroll") for (int i_ = 0; i_ < 16; ++i_) ACC[i_] = 0.f; \
          _Pragma("unroll") for (int ks = 0; ks < 4; ++ks) { \
            const bf16x8 af_ = ld16_(ob + (AOFF) + (r32 * LDO + 16 * ks + 8 * hi) * 2), bf_ = ld16_(ob + (BOFF) + (r32 * LDO + 16 * ks + 8 * hi) * 2); \
            ACC = MFMA32(af_, bf_, ACC); } } while (0)
#define CK_STORE_T(ACC, DST, STRICT) do { _Pragma("unroll") for (int q_ = 0; q_ < 4; ++q_) { \
            float v_[4]; _Pragma("unroll") for (int x_ = 0; x_ < 4; ++x_) { const int s_ = 8 * q_ + 4 * hi + x_; const bool keep_ = (STRICT) ? (s_ < r32) : (s_ <= r32); v_[x_] = keep_ ? ACC[4 * q_ + x_] : 0.f; ACC[4 * q_ + x_] = v_[x_]; } \
            u32x2 w_; w_.x = pk2_(v_[0], v_[1]); w_.y = pk2_(v_[2], v_[3]); *(LAS u32x2*)((DST) + (r32 * LDM + 8 * q_ + 4 * hi) * 2) = w_; } } while (0)
#define CK_STORE_TN(ACC, DST) do { _Pragma("unroll") for (int q_ = 0; q_ < 4; ++q_) { u32x2 w_; w_.x = pk2_(ACC[4 * q_], ACC[4 * q_ + 1]); w_.y = pk2_(ACC[4 * q_ + 2], ACC[4 * q_ + 3]); \
            *(LAS u32x2*)((DST) + (r32 * LDM + 8 * q_ + 4 * hi) * 2) = w_; } } while (0)
  if (wave >= 4) {
    float rw_dec[8], rw_al[8], rw_kq[8], rw_kd[8], rw_r[8], rw_v[8];
    u32x4 cr[9];
#pragma unroll
    for (int i = 0; i < 9; ++i) cr[i] = (u32x4){0u, 0u, 0u, 0u};
    const int nt = wave - 4, col = lane & 15, g = lane >> 4;
    const int froff = CK_FR + nt * 6144 + lane * 16;
#pragma unroll
    for (int i = 0; i < 8; ++i) { rw_dec[i] = 1.f; rw_al[i] = 0.f; rw_kq[i] = 0.f; rw_kd[i] = 0.f; rw_r[i] = 0.f; rw_v[i] = 0.f; }
    prepc_load(p, lds, froff, ch.dir, ch.hd, lane, nt);
    const int pb_e = (4 * g * LDO + 16 * nt + col) * 2;
    const int pb_h = col * 272 + 16 * g;
    const int pb_sq = (16 * g) * 4, pb_sqw = (16 * g + nt) * 4;
    const int dstep = ch.dir ? -1 : 1;
    LDS_BARRIER();
    for (int k = 0; k < NK; ++k) {
      LAS const float* cn = (LAS const float*)(lds + (froff - lane * 16) + 4096) + lane;
      if (k >= 1 && k <= nprep) {
        LAS unsigned char* ob = lds + ((k - 1) % 3) * CK_OPS;
        LAS const float* sq = (LAS const float*)(lds + CK_SSQ + ((k - 1) & 1) * 512);
        float cp[8];
        cp[0] = rw_dec[0]; cp[1] = cp[0] * rw_dec[1]; cp[2] = cp[1] * rw_dec[2]; cp[3] = cp[2] * rw_dec[3];
        cp[4] = rw_dec[4]; cp[5] = cp[4] * rw_dec[5]; cp[6] = cp[5] * rw_dec[6]; cp[7] = cp[6] * rw_dec[7];
        float E0, E1;
        {
          float t0 = cp[3], t1 = cp[7];
          float x0 = __shfl(t0, (lane + 48) & 63), x1 = __shfl(t1, (lane + 48) & 63); if (g < 1) { x0 = 1.f; x1 = 1.f; }
          float i0 = t0 * x0, i1 = t1 * x1;
          float y0 = __shfl(i0, (lane + 32) & 63), y1 = __shfl(i1, (lane + 32) & 63); if (g < 2) { y0 = 1.f; y1 = 1.f; }
          i0 *= y0; i1 *= y1;
          float e0 = __shfl(i0, (lane + 48) & 63), e1 = __shfl(i1, (lane + 48) & 63); if (g < 1) { e0 = 1.f; e1 = 1.f; }
          const float T0 = __shfl(i0, col + 48);
          E0 = e0; E1 = T0 * e1;
        }
#pragma unroll
        for (int e = 0; e < 8; ++e) {
          const int mt = e >> 2, r = e & 3;
          const f32x4 q4 = *(LAS const f32x4*)((LAS const unsigned char*)sq + pb_sq + (16 * mt + r) * 16);
          const float rn = rsqrtf((q4.x + q4.y) + (q4.z + q4.w) + 1e-12f);
          const float Eb = mt ? E1 : E0;
          const float Wt = Eb * cp[e], Wp = (r == 0) ? Eb : Eb * cp[e - 1];
          const float iw = __builtin_amdgcn_rcpf(Wt);
          const float kqn = rw_kq[e] * rn;
          LAS unsigned short* o16 = (LAS unsigned short*)(ob + pb_e + (16 * mt + r) * (LDO * 2));
          o16[0] = bfr(-Wp * kqn);
          o16[O_B / 2] = bfr(kqn * rw_al[e] * iw);
          o16[O_K / 2] = bfr(rw_kd[e] * iw);
          o16[O_R / 2] = bfr(Wt * rw_r[e]);
          o16[O_V / 2] = bfr(rw_v[e]);
          if (e == 7 && g == 3) ((LAS float*)(ob + O_W))[16 * nt + col] = Wt;
        }
      }
      if (k < nprep) {
        const float c_biasw = cn[0], c_biasa = cn[64], c_kkc = cn[128], c_kac = cn[192], c_rkc = cn[256];
        LAS float* sq = (LAS float*)(lds + CK_SSQ + (k & 1) * 512);
        LAS const unsigned char* in = lds + CK_IN + (k & 1) * CK_INS;
#pragma unroll
        for (int mt = 0; mt < 2; ++mt) {
          f32x4 aw = (f32x4){c_biasw, c_biasw, c_biasw, c_biasw}, aa = (f32x4){c_biasa, c_biasa, c_biasa, c_biasa};
          LAS const unsigned char* hrow = in + 3 * OSZ + pb_h + 16 * mt * 272;
          aw = __builtin_amdgcn_mfma_f32_16x16x32_bf16(*(LAS const bf16x8*)(hrow), *(LAS const bf16x8*)(lds + froff), aw, 0, 0, 0);
          aw = __builtin_amdgcn_mfma_f32_16x16x32_bf16(*(LAS const bf16x8*)(hrow + 64), *(LAS const bf16x8*)(lds + froff + 1024), aw, 0, 0, 0);
          aa = __builtin_amdgcn_mfma_f32_16x16x32_bf16(*(LAS const bf16x8*)(hrow + 128), *(LAS const bf16x8*)(lds + froff + 2048), aa, 0, 0, 0);
          aa = __builtin_amdgcn_mfma_f32_16x16x32_bf16(*(LAS const bf16x8*)(hrow + 192), *(LAS const bf16x8*)(lds + froff + 3072), aa, 0, 0, 0);
          unsigned pf_k[8], pf_r[8], pf_v[8];
#pragma unroll
          for (int r = 0; r < 4; ++r) {
            LAS const unsigned short* e16 = (LAS const unsigned short*)(in + pb_e + (16 * mt + r) * (LDO * 2));
            pf_k[4 * mt + r] = e16[0]; pf_r[4 * mt + r] = e16[OSZ / 2]; pf_v[4 * mt + r] = e16[OSZ];
          }
          float sq4[4], bn4[4];
#pragma unroll
          for (int r = 0; r < 4; ++r) {
            const int e = 4 * mt + r;
            const float sig = __builtin_amdgcn_rcpf(1.f + __expf(-aw[r]));
            rw_dec[e] = __expf(-0.6065306597126334f * sig);
            const float a = __builtin_amdgcn_rcpf(1.f + __expf(-aa[r]));
            rw_al[e] = a;
            const float kv = bf2f(pf_k[e]), rv = bf2f(pf_r[e]);
            rw_r[e] = rv; rw_v[e] = bf2f(pf_v[e]);
            const float kq = kv * c_kkc; rw_kq[e] = kq;
            const float kd = kv * (1.f + (a - 1.f) * c_kac); rw_kd[e] = kd;
            sq4[r] = kq * kq; bn4[r] = rv * kd * c_rkc;
          }
#define CK_DPP(v, CTRL) __builtin_bit_cast(float, __builtin_amdgcn_update_dpp(0, __builtin_bit_cast(int, (v)), (CTRL), 0xF, 0xF, true))
#pragma unroll
          for (int r = 0; r < 4; ++r) { sq4[r] += CK_DPP(sq4[r], 0xB1); bn4[r] += CK_DPP(bn4[r], 0xB1); }
#pragma unroll
          for (int r = 0; r < 4; ++r) { sq4[r] += CK_DPP(sq4[r], 0x4E); bn4[r] += CK_DPP(bn4[r], 0x4E); }
#pragma unroll
          for (int r = 0; r < 4; ++r) { sq4[r] += CK_DPP(sq4[r], 0x141); bn4[r] += CK_DPP(bn4[r], 0x141); }
#pragma unroll
          for (int r = 0; r < 4; ++r) { sq4[r] += CK_DPP(sq4[r], 0x140); bn4[r] += CK_DPP(bn4[r], 0x140); }
#undef CK_DPP
          if (col == 0) {
            float* bo = (float*)(ws + M_BON) + ((((unsigned)ch.dir * NTOK + (unsigned)ctok(ch.m0, ch.L, ch.dir, sb0 + 32 * k + 16 * mt + 4 * g)) * 16u + (unsigned)ch.hd) * 4u + (unsigned)nt);
#pragma unroll
            for (int r = 0; r < 4; ++r) {
              *(LAS float*)((LAS unsigned char*)sq + pb_sqw + (16 * mt + r) * 16) = sq4[r];
              bo[r * dstep * 64] = bn4[r];
            }
          }
        }
      }
      if (mode == 1) {
        const int l4 = nt * 64 + lane;
        if (k - 2 >= nprep && k - 2 < ch.nch) {
          const int kc = k - 2;
          LAS unsigned char* ob = lds + (kc % 3) * CK_OPS;
          LAS unsigned char* mxb = lds + CK_MX + (kc & 1) * CK_MXS;
#pragma unroll
          for (int i = 0; i < 4; ++i) *(LAS u32x4*)(ob + (l4 + 256 * i) * 16) = cr[i];
          if (l4 < 64) *(LAS u32x4*)(ob + (1024 + l4) * 16) = cr[4];
          else if (l4 < 80) *(LAS u32x4*)(ob + O_W + (l4 - 64) * 16) = cr[4];
#pragma unroll
          for (int i = 0; i < 2; ++i) *(LAS u32x4*)(mxb + (l4 + 256 * i) * 16) = cr[5 + i];
          if (l4 < 64) *(LAS u32x4*)(mxb + (512 + l4) * 16) = cr[7];
          st16_(ob + O_V + (l4 >> 3) * (LDO * 2) + (l4 & 7) * 16, cr[8]);
        }
        if (k - 1 >= nprep && k - 1 < ch.nch) {
          const int kc = k - 1;
          const unsigned rec = (unsigned)(cidx * CK_NREC + (kc - CK_K0));
          if (((kc - CK_K0) & 7) == 0) {
            unsigned* flag = (unsigned*)(ws + M_CTL + CK_FLAGS) + rec + 7;
            { unsigned sp = 0; while (__hip_atomic_load(flag, __ATOMIC_RELAXED, __HIP_MEMORY_SCOPE_AGENT) == 0u) { __builtin_amdgcn_s_sleep(2); if (++sp > (1u << 22)) break; } }
            __builtin_amdgcn_fence(__ATOMIC_ACQUIRE, "agent");
            asm volatile("s_waitcnt vmcnt(0)" ::: "memory");
          }
          const unsigned char* rp = ws + M_REC + (size_t)rec * CK_REC;
#pragma unroll
          for (int i = 0; i < 4; ++i) cr[i] = *(const u32x4*)(rp + (l4 + 256 * i) * 16);
          if (l4 < 80) cr[4] = *(const u32x4*)(rp + (1024 + l4) * 16);
#pragma unroll
          for (int i = 0; i < 2; ++i) cr[5 + i] = *(const u32x4*)(rp + 4 * OSZ + 256 + (l4 + 256 * i) * 16);
          if (l4 < 64) cr[7] = *(const u32x4*)(rp + 4 * OSZ + 256 + (512 + l4) * 16);
          { const int t = l4 >> 3, c8 = l4 & 7;
            const unsigned gi = (unsigned)ctok(ch.m0, ch.L, ch.dir, sb0 + 32 * kc + t) * (unsigned)D + (unsigned)(ch.hd * 64 + 8 * c8);
            cr[8] = *(const u32x4*)((const bf16_t*)(ws + M_VB) + gi); }
        }
      }
      LDS_BARRIER();
    }
  } else if (wave == 3) {
    u32x4 ld_k[4], ld_r[4], ld_v[4], ld_h[8];
#define CK_LOAD(KC) do { const int s0_ = sb0 + 32 * (KC); \
      _Pragma("unroll") for (int i_ = 0; i_ < 4; ++i_) { const int id_ = lane + 64 * i_; const int t_ = id_ >> 3, c8_ = id_ & 7; \
        const unsigned gi_ = (unsigned)ctok(ch.m0, ch.L, ch.dir, s0_ + t_) * (unsigned)D + (unsigned)(ch.hd * 64 + 8 * c8_); \
        ld_k[i_] = *(const u32x4*)((const bf16_t*)(ws + M_KB) + gi_); ld_r[i_] = *(const u32x4*)((const bf16_t*)(ws + M_RB) + gi_); ld_v[i_] = *(const u32x4*)((const bf16_t*)(ws + M_VB) + gi_); } \
      _Pragma("unroll") for (int i_ = 0; i_ < 8; ++i_) { const int id_ = lane + 64 * i_; const int t_ = id_ >> 4, c8_ = id_ & 15; \
        const unsigned go_ = (unsigned)ctok(ch.m0, ch.L, ch.dir, s0_ + t_) * 256u + (unsigned)((c8_ >> 3) * 128 + ch.dir * 64 + 8 * (c8_ & 7)); \
        ld_h[i_] = *(const u32x4*)((const bf16_t*)(ws + M_HWA) + go_); } } while (0)
#define CK_PUT(BUF) do { LAS unsigned char* in_ = lds + CK_IN + (BUF) * CK_INS; \
      _Pragma("unroll") for (int i_ = 0; i_ < 4; ++i_) { const int id_ = lane + 64 * i_; \
        LAS unsigned char* d_ = in_ + (id_ >> 3) * (LDO * 2) + (id_ & 7) * 16; st16_(d_, ld_k[i_]); st16_(d_ + OSZ, ld_r[i_]); st16_(d_ + 2 * OSZ, ld_v[i_]); } \
      _Pragma("unroll") for (int i_ = 0; i_ < 8; ++i_) { const int id_ = lane + 64 * i_; const int t_ = id_ >> 4, c8_ = id_ & 15; \
        *(LAS u32x4*)(in_ + 3 * OSZ + t_ * 272 + c8_ * 16) = ld_h[i_]; } } while (0)
    CK_LOAD(0); CK_PUT(0);
    if (nprep > 1) CK_LOAD(1);
    LDS_BARRIER();
    for (int k = 0; k < NK; ++k) {
      if (k + 1 < nprep) CK_PUT((k + 1) & 1);
      if (k + 2 < nprep) CK_LOAD(k + 2);
      if (k >= 2 && k <= nprep + 1) {
        const int lane_o = opq5(lane); const int r32 = lane_o & 31, hi = lane_o >> 5;
        LAS const unsigned char* ob = lds + ((k - 2) % 3) * CK_OPS;
        LAS unsigned char* mx = lds + CK_MX + ((k - 2) & 1) * CK_MXS;
        f32x16 acc;
        CK_PROD(acc, O_K, 0);     CK_STORE_T(acc, mx + 0, true);
        CK_PROD(acc, O_B, O_R); CK_STORE_T(acc, mx + MSZ, false);
        CK_PROD(acc, O_K, O_R); CK_STORE_T(acc, mx + 2 * MSZ, false);
      }
      LDS_BARRIER();
    }
#undef CK_LOAD
#undef CK_PUT
  } else if (wave == 2) {
    LDS_BARRIER();
    for (int k = 0; k < NK; ++k) {
      if (k >= 2 && k <= nprep + 1) {
        const int lane_o = opq5(lane); const int r32 = lane_o & 31, hi = lane_o >> 5;
        LAS const unsigned char* ob = lds + ((k - 2) % 3) * CK_OPS;
        LAS unsigned char* mx = lds + CK_MX + ((k - 2) & 1) * CK_MXS;
        LAS unsigned char* sc = lds + CK_SCR;
        f32x16 Q, Pm;
        CK_PROD(Q, O_B, 0);
        CK_STORE_T(Q, sc + MSZ, true);
#pragma unroll
        for (int i = 0; i < 16; ++i) Pm[i] = Q[i] + ((crow_(i, hi) == r32) ? 1.f : 0.f);
        CK_STORE_TN(Pm, sc + 2 * MSZ);
        asm volatile("s_waitcnt lgkmcnt(0)" ::: "memory");
#define CK_MM(ACC, Z1T, Z2T) do { _Pragma("unroll") for (int ks = 0; ks < 2; ++ks) { \
          const bf16x8 af_ = ldT_nat(sc + (Z1T), LDM, 16 * ks, 0, lane_o), bf_ = ld16_(sc + (Z2T) + (r32 * LDM + 16 * ks + 8 * hi) * 2); \
          ACC = MFMA32(af_, bf_, ACC); } } while (0)
#pragma unroll 1
        for (int it = 0; it < 4; ++it) {
          f32x16 Q2;
#pragma unroll
          for (int i = 0; i < 16; ++i) Q2[i] = 0.f;
          CK_MM(Q2, MSZ, MSZ);
          asm volatile("s_waitcnt lgkmcnt(0)" ::: "memory");
          CK_STORE_TN(Q2, sc + MSZ);
          asm volatile("s_waitcnt lgkmcnt(0)" ::: "memory");
          CK_MM(Pm, 2 * MSZ, MSZ);
          asm volatile("s_waitcnt lgkmcnt(0)" ::: "memory");
          if (it < 3) { CK_STORE_TN(Pm, sc + 2 * MSZ); asm volatile("s_waitcnt lgkmcnt(0)" ::: "memory"); }
        }
        CK_STORE_TN(Pm, mx + 3 * MSZ);
#undef CK_MM
      }
      LDS_BARRIER();
    }
  } else {
    f32x16 St0, St1;
#pragma unroll
    for (int i = 0; i < 16; ++i) { St0[i] = 0.f; St1[i] = 0.f; }
    if (mode != 2 && ch.L == 2048) {
      const GASF* s0 = p.state_rwkv + ((((size_t)(ch.seq - 16)) * 2 + ch.dir) * 16 + ch.hd) * 4096 + (size_t)(32 * wave + r32) * 64;
#pragma unroll
      for (int q = 0; q < 4; ++q) {
        const f32x4 a = *(const GAS f32x4*)(s0 + 8 * q + 4 * hi), b = *(const GAS f32x4*)(s0 + 32 + 8 * q + 4 * hi);
        St0[4 * q] = a.x; St0[4 * q + 1] = a.y; St0[4 * q + 2] = a.z; St0[4 * q + 3] = a.w;
        St1[4 * q] = b.x; St1[4 * q + 1] = b.y; St1[4 * q + 2] = b.z; St1[4 * q + 3] = b.w;
      }
    }
    LDS_BARRIER();
    for (int k = 0; k < NK; ++k) {
      const int lane = opq5(lane_in); const int hi = lane >> 5, r32 = lane & 31;
      if (mode == 2) {
        if (k >= 4 && wave == 0 && lane == 0) {
          __builtin_amdgcn_fence(__ATOMIC_RELEASE, "agent");
          asm volatile("s_waitcnt vmcnt(0)" ::: "memory");
          __hip_atomic_store((unsigned*)(ws + M_CTL + CK_FLAGS) + (unsigned)(cidx * CK_NREC + (ch.kofs + (k - 4) - CK_K0)), 1u, __ATOMIC_RELAXED, __HIP_MEMORY_SCOPE_AGENT);
        }
        if (k >= 3) {
          const int kc = k - 3;
          unsigned char* rp = ws + M_REC + (size_t)(cidx * CK_NREC + (ch.kofs + kc - CK_K0)) * CK_REC;
          LAS const unsigned char* ob = lds + (kc % 3) * CK_OPS;
          LAS const unsigned char* mxb = lds + CK_MX + (kc & 1) * CK_MXS;
          const int l2 = wave * 64 + lane;
#pragma unroll 4
          for (int i = 0; i < 8; ++i) *(u32x4*)(rp + (l2 + 128 * i) * 16) = *(LAS const u32x4*)(ob + (l2 + 128 * i) * 16);
          if (l2 < 64) *(u32x4*)(rp + (1024 + l2) * 16) = *(LAS const u32x4*)(ob + (1024 + l2) * 16);
          else if (l2 < 80) *(u32x4*)(rp + (1024 + l2) * 16) = *(LAS const u32x4*)(ob + O_W + (l2 - 64) * 16);
#pragma unroll 4
          for (int i = 0; i < 4; ++i) *(u32x4*)(rp + 4 * OSZ + 256 + (l2 + 128 * i) * 16) = *(LAS const u32x4*)(mxb + (l2 + 128 * i) * 16);
          if (l2 < 64) *(u32x4*)(rp + 4 * OSZ + 256 + (512 + l2) * 16) = *(LAS const u32x4*)(mxb + (512 + l2) * 16);
          asm volatile("s_waitcnt vmcnt(0)" ::: "memory");
        }
      } else if (k >= 3) {
        const int kc = k - 3, ih = wave;
        LAS const unsigned char* ob = lds + (kc % 3) * CK_OPS;
        LAS const unsigned char* mx = lds + CK_MX + (kc & 1) * CK_MXS;
        const bf16x8 s00 = cvt8(St0, 0), s01 = cvt8(St0, 1), s10 = cvt8(St1, 0), s11 = cvt8(St1, 1);
        const bf16x8 v0 = ldT_perm(ob + O_V, LDO, 0, 32 * ih, lane), v1 = ldT_perm(ob + O_V, LDO, 16, 32 * ih, lane);
        f32x16 G, U, Y;
#pragma unroll
        for (int i = 0; i < 16; ++i) { G[i] = 0.f; U[i] = 0.f; Y[i] = 0.f; }
        G = MFMA32(ldA_perm(ob + 0, LDO, r32, 0, hi), s00, G);  G = MFMA32(ldA_perm(ob + 0, LDO, r32, 16, hi), s01, G);
        G = MFMA32(ldA_perm(ob + 0, LDO, r32, 32, hi), s10, G); G = MFMA32(ldA_perm(ob + 0, LDO, r32, 48, hi), s11, G);
        G = MFMA32(ldA_perm(mx + 0, LDM, r32, 0, hi), v0, G);   G = MFMA32(ldA_perm(mx + 0, LDM, r32, 16, hi), v1, G);
        const bf16x8 g0 = cvt8(G, 0), g1 = cvt8(G, 1);
        U = MFMA32(ldA_perm(mx + 3 * MSZ, LDM, r32, 0, hi), g0, U); U = MFMA32(ldA_perm(mx + 3 * MSZ, LDM, r32, 16, hi), g1, U);
        const bf16x8 u0 = cvt8(U, 0), u1 = cvt8(U, 1);
        Y = MFMA32(ldA_perm(ob + O_R, LDO, r32, 0, hi), s00, Y);  Y = MFMA32(ldA_perm(ob + O_R, LDO, r32, 16, hi), s01, Y);
        Y = MFMA32(ldA_perm(ob + O_R, LDO, r32, 32, hi), s10, Y); Y = MFMA32(ldA_perm(ob + O_R, LDO, r32, 48, hi), s11, Y);
        Y = MFMA32(ldA_perm(mx + MSZ, LDM, r32, 0, hi), u0, Y);    Y = MFMA32(ldA_perm(mx + MSZ, LDM, r32, 16, hi), u1, Y);
        Y = MFMA32(ldA_perm(mx + 2 * MSZ, LDM, r32, 0, hi), v0, Y);    Y = MFMA32(ldA_perm(mx + 2 * MSZ, LDM, r32, 16, hi), v1, Y);
        St0 = MFMA32(ldT_perm(ob + O_B, LDO, 0, 0, lane), u0, St0);  St0 = MFMA32(ldT_perm(ob + O_B, LDO, 16, 0, lane), u1, St0);
        St0 = MFMA32(ldT_perm(ob + O_K, LDO, 0, 0, lane), v0, St0);  St0 = MFMA32(ldT_perm(ob + O_K, LDO, 16, 0, lane), v1, St0);
        St1 = MFMA32(ldT_perm(ob + O_B, LDO, 0, 32, lane), u0, St1); St1 = MFMA32(ldT_perm(ob + O_B, LDO, 16, 32, lane), u1, St1);
        St1 = MFMA32(ldT_perm(ob + O_K, LDO, 0, 32, lane), v0, St1); St1 = MFMA32(ldT_perm(ob + O_K, LDO, 16, 32, lane), v1, St1);
        LAS const float* wt = (LAS const float*)(ob + O_W);
#pragma unroll
        for (int q = 0; q < 4; ++q) {
          const f32x4 w0 = *(LAS const f32x4*)(wt + 8 * q + 4 * hi), w1 = *(LAS const f32x4*)(wt + 32 + 8 * q + 4 * hi);
          St0[4 * q] *= w0.x; St0[4 * q + 1] *= w0.y; St0[4 * q + 2] *= w0.z; St0[4 * q + 3] *= w0.w;
          St1[4 * q] *= w1.x; St1[4 * q + 1] *= w1.y; St1[4 * q + 2] *= w1.z; St1[4 * q + 3] *= w1.w;
        }
        {
          const int tk0 = ctok(ch.m0, ch.L, ch.dir, sb0 + 32 * kc); const int dstep = ch.dir ? -1 : 1;
          const unsigned cb = (unsigned)(ch.hd * 64 + 32 * ih + r32);
#pragma unroll
          for (int i = 0; i < 16; ++i) Yo[(unsigned)(tk0 + crow_(i, hi) * dstep) * (unsigned)D + cb] = Y[i];
        }
      }
      LDS_BARRIER();
    }
    if (mode == 2 && wave == 0 && lane == 0) {
      __builtin_amdgcn_fence(__ATOMIC_RELEASE, "agent");
      asm volatile("s_waitcnt vmcnt(0)" ::: "memory");
      __hip_atomic_store((unsigned*)(ws + M_CTL + CK_FLAGS) + (unsigned)(cidx * CK_NREC + (ch.kofs + ch.nch - 1 - CK_K0)), 1u, __ATOMIC_RELAXED, __HIP_MEMORY_SCOPE_AGENT);
    }
    if (mode != 2 && ch.L == 256) {
    GASF* so = p.out + OUT_ST + ((((size_t)ch.seq) * 2 + ch.dir) * 16 + ch.hd) * 4096 + (size_t)(32 * wave + r32) * 64;
#pragma unroll
    for (int q = 0; q < 4; ++q) {
      *(GAS f32x4*)(so + 8 * q + 4 * hi) = (f32x4){St0[4 * q], St0[4 * q + 1], St0[4 * q + 2], St0[4 * q + 3]};
      *(GAS f32x4*)(so + 32 + 8 * q + 4 * hi) = (f32x4){St1[4 * q], St1[4 * q + 1], St1[4 * q + 2], St1[4 * q + 3]};
    }
  }
  }
}

__device__ __forceinline__ void phase_rw_scan_ck(const LAS PG& p, unsigned char* ws, LAS unsigned char* lds, int tid, int lane, int wave, int bid, int G) {
  int dfirst = bid * 8 + wave, dstride = G * 8;
  if (G == 256) {
    if (bid < 64) { __syncthreads(); ck_run_chain(p, ws, lds, ck_chain(bid), lane, wave, 1, CK_K0, bid); dfirst = NTR_DEF; }
    else {
      for (int pc = bid - 64; pc < 512; pc += 192) { __syncthreads(); ck_run_chain(p, ws, lds, ck_chain(64 + pc), lane, wave, 0, 8, 0); }
      {
        const int pb = bid - 64; const int c = pb / 3, r = pb % 3;
        CkChain pch = ck_chain(c); pch.kofs = CK_K0 + 8 * r; pch.nch = 8;
        __syncthreads(); ck_run_chain(p, ws, lds, pch, lane, wave, 2, 8, c);
      }
      dfirst = (bid - 64) * 8 + wave; dstride = 192 * 8;
    }
  } else {
    for (int id = bid; id < 576; id += G) { __syncthreads(); const CkChain cc = ck_chain(id); ck_run_chain(p, ws, lds, cc, lane, wave, 0, cc.nch, 0); }
  }
  __syncthreads();
  tr_run<1>(p, ws, (LAS float*)(lds + wave * 16384), lane, dfirst, dstride, NTR_DEF);
}
__device__ __forceinline__ int opq(int x) { asm volatile("" : "+v"(x)); return x; }
#ifndef RPT_MASK
#define RPT_MASK 0u
#endif
struct MArgs { P p; int ph_lo, ph_hi; };
__global__ void __launch_bounds__(512, 2) mega(MArgs a) {
  extern __shared__ __attribute__((aligned(16))) unsigned char lds_raw[];
  LAS unsigned char* lds = (LAS unsigned char*)lds_raw;
  const int tid = threadIdx.x, lane = tid & 63, wave = __builtin_amdgcn_readfirstlane(tid >> 6);
  const int G = gridDim.x, bid = blockIdx.x;
  unsigned char* ws = (unsigned char*)a.p.ws;
  if (tid == 0) {
    LAS PG* t = (LAS PG*)(lds + PTAB_OFF);
    t->x_prompt = (decltype(t->x_prompt))a.p.x_prompt;
    t->x_sample = (decltype(t->x_sample))a.p.x_sample;
    t->cache_ckv = (decltype(t->cache_ckv))a.p.cache_ckv;
    t->cache_kpe = (decltype(t->cache_kpe))a.p.cache_kpe;
    t->state_rwkv = (decltype(t->state_rwkv))a.p.state_rwkv;
    t->c = (decltype(t->c))a.p.c;
    t->c_ctx = (decltype(t->c_ctx))a.p.c_ctx;
    t->mod_w = (decltype(t->mod_w))a.p.mod_w;
    t->mod_b = (decltype(t->mod_b))a.p.mod_b;
    t->ln_g = (decltype(t->ln_g))a.p.ln_g;
    t->ln_b = (decltype(t->ln_b))a.p.ln_b;
    t->hy_w_in = (decltype(t->hy_w_in))a.p.hy_w_in;
    t->hy_conv_w = (decltype(t->hy_conv_w))a.p.hy_conv_w;
    t->hy_conv_b = (decltype(t->hy_conv_b))a.p.hy_conv_b;
    t->hy_w1 = (decltype(t->hy_w1))a.p.hy_w1;
    t->hy_b1 = (decltype(t->hy_b1))a.p.hy_b1;
    t->hy_w2 = (decltype(t->hy_w2))a.p.hy_w2;
    t->hy_b2 = (decltype(t->hy_b2))a.p.hy_b2;
    t->hy_w3 = (decltype(t->hy_w3))a.p.hy_w3;
    t->hy_b3 = (decltype(t->hy_b3))a.p.hy_b3;
    t->hy_freq = (decltype(t->hy_freq))a.p.hy_freq;
    t->hy_decay = (decltype(t->hy_decay))a.p.hy_decay;
    t->hy_skip = (decltype(t->hy_skip))a.p.hy_skip;
    t->hy_w_out = (decltype(t->hy_w_out))a.p.hy_w_out;
    t->mla_w_in = (decltype(t->mla_w_in))a.p.mla_w_in;
    t->mla_q_norm = (decltype(t->mla_q_norm))a.p.mla_q_norm;
    t->mla_kv_norm = (decltype(t->mla_kv_norm))a.p.mla_kv_norm;
    t->mla_w_q_up = (decltype(t->mla_w_q_up))a.p.mla_w_q_up;
    t->mla_w_kv_up = (decltype(t->mla_w_kv_up))a.p.mla_w_kv_up;
    t->mla_w_out = (decltype(t->mla_w_out))a.p.mla_w_out;
    t->rw_mu = (decltype(t->rw_mu))a.p.rw_mu;
    t->rw_w_in = (decltype(t->rw_w_in))a.p.rw_w_in;
    t->rw_w0 = (decltype(t->rw_w0))a.p.rw_w0;
    t->rw_w1 = (decltype(t->rw_w1))a.p.rw_w1;
    t->rw_w2 = (decltype(t->rw_w2))a.p.rw_w2;
    t->rw_a0 = (decltype(t->rw_a0))a.p.rw_a0;
    t->rw_a1 = (decltype(t->rw_a1))a.p.rw_a1;
    t->rw_a2 = (decltype(t->rw_a2))a.p.rw_a2;
    t->rw_k_k = (decltype(t->rw_k_k))a.p.rw_k_k;
    t->rw_k_a = (decltype(t->rw_k_a))a.p.rw_k_a;
    t->rw_r_k = (decltype(t->rw_r_k))a.p.rw_r_k;
    t->rw_gn_g = (decltype(t->rw_gn_g))a.p.rw_gn_g;
    t->rw_gn_b = (decltype(t->rw_gn_b))a.p.rw_gn_b;
    t->rw_w_out = (decltype(t->rw_w_out))a.p.rw_w_out;
    t->out = (decltype(t->out))a.p.out;
    t->ws = (decltype(t->ws))a.p.ws;
  }
  const LAS PG& p = *(const LAS PG*)(lds + PTAB_OFF);
  volatile LAS unsigned* MISC = (volatile LAS unsigned*)(lds + MISC_OFF);
  for (int u = tid; u < 128; u += 512) ((LAS unsigned*)(lds + MISC_OFF))[u] = 0u;
  __syncthreads();
  const int lo = a.ph_lo, hi = a.ph_hi;
  XcdBarrier bar; bar.bar = (unsigned*)(ws + M_CTL); bar.x = 0; bar.st = nullptr;
  if (hi - lo > 0 || RPT_MASK) bar = xcd_barrier_post((unsigned*)(ws + M_CTL), MISC + 8);
#ifndef PH_MASK
#define PH_MASK 0xffffffffu
#endif
#ifndef TP_PHASE
#define TP_PHASE -1
#endif
#ifndef TP_MULT
#define TP_MULT 4
#endif
  unsigned long long tp0 = (TP_PHASE == 0) ? __builtin_amdgcn_s_memrealtime() : 0ull, tp1 = 0ull;
#define IN(k) (((PH_MASK >> (k)) & 1u) && lo <= (k) && (k) < hi)
#define SEAM(k) do { if (IN(k) && IN((k) + 1)) xcd_barrier(bar); if ((k) + 1 == TP_PHASE) tp0 = __builtin_amdgcn_s_memrealtime(); if ((k) == TP_PHASE) tp1 = __builtin_amdgcn_s_memrealtime(); } while (0)
  if (IN(0)) { { phase_p0a(p, ws, lds, opq((int)threadIdx.x), (opq((int)threadIdx.x) & 63), wave, bid, G); } if ((RPT_MASK >> 0) & 1u) { xcd_barrier(bar); { phase_p0a(p, ws, lds, opq((int)threadIdx.x), (opq((int)threadIdx.x) & 63), wave, bid, G); } } } SEAM(0);
  if (IN(1)) { { phase_p0b(p, ws, lds, opq((int)threadIdx.x), (opq((int)threadIdx.x) & 63), wave, bid, G); } if ((RPT_MASK >> 1) & 1u) { xcd_barrier(bar); { phase_p0b(p, ws, lds, opq((int)threadIdx.x), (opq((int)threadIdx.x) & 63), wave, bid, G); } } } SEAM(1);
  if (IN(2)) { {
    pg8::Gemm g{(const pg8::bf16_t*)(ws + W_HYIN), (const pg8::bf16_t*)(ws + M_HB), 4096, 8192, 1024};
    pg8::StaticOrder S; S.init(4096, 8192, G, bid);
    pg8::EpiBf16<0> E{(pg8::bf16_t*)(ws + M_UT), 8192, nullptr, 0, 0, 1.f};
    pg8::gemm_phase<pg8::EpiBf16<0>, pg8::StaticOrder, true, true>(lds, g, S, E); } if ((RPT_MASK >> 2) & 1u) { xcd_barrier(bar); {
    pg8::Gemm g{(const pg8::bf16_t*)(ws + W_HYIN), (const pg8::bf16_t*)(ws + M_HB), 4096, 8192, 1024};
    pg8::StaticOrder S; S.init(4096, 8192, G, bid);
    pg8::EpiBf16<0> E{(pg8::bf16_t*)(ws + M_UT), 8192, nullptr, 0, 0, 1.f};
    pg8::gemm_phase<pg8::EpiBf16<0>, pg8::StaticOrder, true, true>(lds, g, S, E); } } } SEAM(2);
  if (IN(3)) { { phase_hy_conv(p, ws, lds, 0, opq((int)threadIdx.x), (opq((int)threadIdx.x) & 63), wave, bid, G); } if ((RPT_MASK >> 3) & 1u) { xcd_barrier(bar); { phase_hy_conv(p, ws, lds, 0, opq((int)threadIdx.x), (opq((int)threadIdx.x) & 63), wave, bid, G); } } } SEAM(3);
  if (IN(4)) { { phase_out_ln<1>(p, ws, lds, 0, (const bf16_t*)(ws + W_HYOUT), opq((int)threadIdx.x), (opq((int)threadIdx.x) & 63), wave, bid, G); } if ((RPT_MASK >> 4) & 1u) { xcd_barrier(bar); { phase_out_ln<1>(p, ws, lds, 0, (const bf16_t*)(ws + W_HYOUT), opq((int)threadIdx.x), (opq((int)threadIdx.x) & 63), wave, bid, G); } } } SEAM(4);
  if (IN(5)) { {
    pg8::Gemm g{(const pg8::bf16_t*)(ws + M_HB), (const pg8::bf16_t*)(ws + W_MLAIN + MiB), 8192, 1024, 1024};
    pg8::StaticOrder S; S.init(8192, 1024, G, bid);
    EpiSilu E{(bf16_t*)(ws + M_SZB), 1024};
    pg8::gemm_phase<EpiSilu, pg8::StaticOrder, true, true>(lds, g, S, E);
    { pg8::Gemm g2{(const pg8::bf16_t*)(ws + M_HB), (const pg8::bf16_t*)(ws + W_MLAIN), 8192, 512, 1024};
      pg8::StaticOrder S2; S2.init(8192, 512, G, (bid + G - 128 % G) % G);
      EpiF32 E2{(float*)(ws + M_U2S), 512};
      pg8::gemm_phase<EpiF32, pg8::StaticOrder, true, true>(lds, g2, S2, E2); }
    if (G == 256 && bid >= 192) { __syncthreads(); tr_run<2>(p, ws, (LAS float*)(lds + wave * 16384), (opq((int)threadIdx.x) & 63), (bid - 192) * 8 + wave, 64 * 8, NTR_DEF2); }
    else if (G != 256) { __syncthreads(); tr_run<2>(p, ws, (LAS float*)(lds + wave * 16384), (opq((int)threadIdx.x) & 63), bid * 8 + wave, G * 8, NTR_DEF2); } } if ((RPT_MASK >> 5) & 1u) { xcd_barrier(bar); {
    pg8::Gemm g{(const pg8::bf16_t*)(ws + M_HB), (const pg8::bf16_t*)(ws + W_MLAIN + MiB), 8192, 1024, 1024};
    pg8::StaticOrder S; S.init(8192, 1024, G, bid);
    EpiSilu E{(bf16_t*)(ws + M_SZB), 1024};
    pg8::gemm_phase<EpiSilu, pg8::StaticOrder, true, true>(lds, g, S, E);
    { pg8::Gemm g2{(const pg8::bf16_t*)(ws + M_HB), (const pg8::bf16_t*)(ws + W_MLAIN), 8192, 512, 1024};
      pg8::StaticOrder S2; S2.init(8192, 512, G, (bid + G - 128 % G) % G);
      EpiF32 E2{(float*)(ws + M_U2S), 512};
      pg8::gemm_phase<EpiF32, pg8::StaticOrder, true, true>(lds, g2, S2, E2); }
    if (G == 256 && bid >= 192) { __syncthreads(); tr_run<2>(p, ws, (LAS float*)(lds + wave * 16384), (opq((int)threadIdx.x) & 63), (bid - 192) * 8 + wave, 64 * 8, NTR_DEF2); }
    else if (G != 256) { __syncthreads(); tr_run<2>(p, ws, (LAS float*)(lds + wave * 16384), (opq((int)threadIdx.x) & 63), bid * 8 + wave, G * 8, NTR_DEF2); } } } } SEAM(5);
  if (IN(6)) { { phase_mla_rows(p, ws, (opq((int)threadIdx.x) & 63), wave, bid, G); xcd_barrier(bar); } {
    { pg8::Gemm g{(const pg8::bf16_t*)(ws + M_QN), (const pg8::bf16_t*)(ws + W_QUP), 8192, 1536, 256};
      pg8::StaticOrder S; S.init(8192, 1536, G, bid);
      pg8::EpiBf16<0> E{(pg8::bf16_t*)(ws + M_Q), 1536, nullptr, 0, 0, 1.f};
      pg8::gemm_phase<pg8::EpiBf16<0>, pg8::StaticOrder, true, true>(lds, g, S, E); }
    { pg8::Gemm g{(const pg8::bf16_t*)(ws + M_CKVALL), (const pg8::bf16_t*)(ws + W_KVUP), 9216, 2048, 128};
      pg8::StaticOrder S; S.init(9216, 2048, G, (bid + G - 192 % G) % G);
      EpiKV E{(bf16_t*)(ws + M_KN), (bf16_t*)(ws + M_V)};
      pg8::gemm_phase<EpiKV, pg8::StaticOrder, true, true>(lds, g, S, E); } } if ((RPT_MASK >> 6) & 1u) { xcd_barrier(bar); { phase_mla_rows(p, ws, (opq((int)threadIdx.x) & 63), wave, bid, G); xcd_barrier(bar); } {
    { pg8::Gemm g{(const pg8::bf16_t*)(ws + M_QN), (const pg8::bf16_t*)(ws + W_QUP), 8192, 1536, 256};
      pg8::StaticOrder S; S.init(8192, 1536, G, bid);
      pg8::EpiBf16<0> E{(pg8::bf16_t*)(ws + M_Q), 1536, nullptr, 0, 0, 1.f};
      pg8::gemm_phase<pg8::EpiBf16<0>, pg8::StaticOrder, true, true>(lds, g, S, E); }
    { pg8::Gemm g{(const pg8::bf16_t*)(ws + M_CKVALL), (const pg8::bf16_t*)(ws + W_KVUP), 9216, 2048, 128};
      pg8::StaticOrder S; S.init(9216, 2048, G, (bid + G - 192 % G) % G);
      EpiKV E{(bf16_t*)(ws + M_KN), (bf16_t*)(ws + M_V)};
      pg8::gemm_phase<EpiKV, pg8::StaticOrder, true, true>(lds, g, S, E); } } } } SEAM(6);
  if (IN(7)) { {
    for (int u = bid; u < 512; u += G) {
      int seq, hd, qb;
      if (u < 256) { seq = 16 + (u >> 7); hd = (u >> 3) & 15; qb = u & 7; } else { const int uu = u - 256; seq = uu >> 4; hd = uu & 15; qb = 0; }
      attn_unit(ws, lds, seq, hd, qb, (bf16_t*)(ws + M_GB), opq((int)threadIdx.x), (opq((int)threadIdx.x) & 63), wave);
    } } if ((RPT_MASK >> 7) & 1u) { xcd_barrier(bar); {
    for (int u = bid; u < 512; u += G) {
      int seq, hd, qb;
      if (u < 256) { seq = 16 + (u >> 7); hd = (u >> 3) & 15; qb = u & 7; } else { const int uu = u - 256; seq = uu >> 4; hd = uu & 15; qb = 0; }
      attn_unit(ws, lds, seq, hd, qb, (bf16_t*)(ws + M_GB), opq((int)threadIdx.x), (opq((int)threadIdx.x) & 63), wave);
    } } } } SEAM(7);
  if (IN(8)) { { phase_out_ln<0>(p, ws, lds, 1, (const bf16_t*)(ws + W_MLAOUT), opq((int)threadIdx.x), (opq((int)threadIdx.x) & 63), wave, bid, G); } if ((RPT_MASK >> 8) & 1u) { xcd_barrier(bar); { phase_out_ln<0>(p, ws, lds, 1, (const bf16_t*)(ws + W_MLAOUT), opq((int)threadIdx.x), (opq((int)threadIdx.x) & 63), wave, bid, G); } } } SEAM(8);
  if (IN(9)) { { phase_rw_mix(p, ws, opq((int)threadIdx.x), bid, G); } if ((RPT_MASK >> 9) & 1u) { xcd_barrier(bar); { phase_rw_mix(p, ws, opq((int)threadIdx.x), bid, G); } } } SEAM(9);
  if (IN(10)) { {
#pragma unroll 1
    for (int q = 0; q < 4; ++q) {
      pg8::Gemm g{(const pg8::bf16_t*)(ws + M_XMIX + (size_t)q * 16 * MiB), (const pg8::bf16_t*)(ws + W_RWIN + (size_t)q * 2 * MiB), 8192, 1024, 1024};
      pg8::StaticOrder S; S.init(8192, 1024, G, (bid + (q & 1) * (G / 2)) % G);
      if (q < 3) { pg8::EpiBf16<0> E{(pg8::bf16_t*)(ws + M_SCR2 + (size_t)q * 16 * MiB), 1024, nullptr, 0, 0, 1.f}; pg8::gemm_phase<pg8::EpiBf16<0>, pg8::StaticOrder, true, true>(lds, g, S, E); }
      else { EpiSilu E{(bf16_t*)(ws + M_SZR), 1024}; pg8::gemm_phase<EpiSilu, pg8::StaticOrder, true, true>(lds, g, S, E); }
    }
    for (int tile = bid; tile < 256; tile += G) rw_lora_tile(p, ws, lds, tile, opq((int)threadIdx.x), (opq((int)threadIdx.x) & 63), wave); } if ((RPT_MASK >> 10) & 1u) { xcd_barrier(bar); {
#pragma unroll 1
    for (int q = 0; q < 4; ++q) {
      pg8::Gemm g{(const pg8::bf16_t*)(ws + M_XMIX + (size_t)q * 16 * MiB), (const pg8::bf16_t*)(ws + W_RWIN + (size_t)q * 2 * MiB), 8192, 1024, 1024};
      pg8::StaticOrder S; S.init(8192, 1024, G, (bid + (q & 1) * (G / 2)) % G);
      if (q < 3) { pg8::EpiBf16<0> E{(pg8::bf16_t*)(ws + M_SCR2 + (size_t)q * 16 * MiB), 1024, nullptr, 0, 0, 1.f}; pg8::gemm_phase<pg8::EpiBf16<0>, pg8::StaticOrder, true, true>(lds, g, S, E); }
      else { EpiSilu E{(bf16_t*)(ws + M_SZR), 1024}; pg8::gemm_phase<EpiSilu, pg8::StaticOrder, true, true>(lds, g, S, E); }
    }
    for (int tile = bid; tile < 256; tile += G) rw_lora_tile(p, ws, lds, tile, opq((int)threadIdx.x), (opq((int)threadIdx.x) & 63), wave); } } } SEAM(10);
  if (IN(11)) { { phase_rw_scan_ck(p, ws, lds, opq((int)threadIdx.x), (opq((int)threadIdx.x) & 63), wave, bid, G); } if ((RPT_MASK >> 11) & 1u) { xcd_barrier(bar); { phase_rw_scan_ck(p, ws, lds, opq((int)threadIdx.x), (opq((int)threadIdx.x) & 63), wave, bid, G); } } } SEAM(11);
  if (IN(12)) { { phase_out_ln<2>(p, ws, lds, 2, (const bf16_t*)(ws + W_RWOUT), opq((int)threadIdx.x), (opq((int)threadIdx.x) & 63), wave, bid, G); } if ((RPT_MASK >> 12) & 1u) { xcd_barrier(bar); { phase_out_ln<2>(p, ws, lds, 2, (const bf16_t*)(ws + W_RWOUT), opq((int)threadIdx.x), (opq((int)threadIdx.x) & 63), wave, bid, G); } } } SEAM(12);
  if (IN(13)) { {
    pg8::Gemm g{(const pg8::bf16_t*)(ws + W_HYIN + 8 * MiB), (const pg8::bf16_t*)(ws + M_HB), 4096, 8192, 1024};
    pg8::StaticOrder S; S.init(4096, 8192, G, bid);
    pg8::EpiBf16<0> E{(pg8::bf16_t*)(ws + M_UT), 8192, nullptr, 0, 0, 1.f};
    pg8::gemm_phase<pg8::EpiBf16<0>, pg8::StaticOrder, true, true>(lds, g, S, E); } if ((RPT_MASK >> 13) & 1u) { xcd_barrier(bar); {
    pg8::Gemm g{(const pg8::bf16_t*)(ws + W_HYIN + 8 * MiB), (const pg8::bf16_t*)(ws + M_HB), 4096, 8192, 1024};
    pg8::StaticOrder S; S.init(4096, 8192, G, bid);
    pg8::EpiBf16<0> E{(pg8::bf16_t*)(ws + M_UT), 8192, nullptr, 0, 0, 1.f};
    pg8::gemm_phase<pg8::EpiBf16<0>, pg8::StaticOrder, true, true>(lds, g, S, E); } } } SEAM(13);
  if (IN(14)) { { phase_hy_conv(p, ws, lds, 1, opq((int)threadIdx.x), (opq((int)threadIdx.x) & 63), wave, bid, G); } if ((RPT_MASK >> 14) & 1u) { xcd_barrier(bar); { phase_hy_conv(p, ws, lds, 1, opq((int)threadIdx.x), (opq((int)threadIdx.x) & 63), wave, bid, G); } } } SEAM(14);
  if (IN(15)) { { phase_out_ln<1>(p, ws, lds, 3, (const bf16_t*)(ws + W_HYOUT + 2 * MiB), opq((int)threadIdx.x), (opq((int)threadIdx.x) & 63), wave, bid, G); } if ((RPT_MASK >> 15) & 1u) { xcd_barrier(bar); { phase_out_ln<1>(p, ws, lds, 3, (const bf16_t*)(ws + W_HYOUT + 2 * MiB), opq((int)threadIdx.x), (opq((int)threadIdx.x) & 63), wave, bid, G); } } }
  if (TP_PHASE >= 0 && bid == 0) { if (TP_PHASE == 15) tp1 = __builtin_amdgcn_s_memrealtime(); const unsigned long long dl = (tp1 - tp0) * TP_MULT; const unsigned long long ts = __builtin_amdgcn_s_memrealtime(); while (__builtin_amdgcn_s_memrealtime() - ts < dl) __builtin_amdgcn_s_sleep(8); }
#undef IN
#undef SEAM
}
}
}

extern "C" void kernel_launch(void* const* d_in, const int* in_sizes, int n_in, void* d_out, int out_size, void* d_ws, size_t ws_size, hipStream_t stream) {
  P p{};
  const float** pp = (const float**)&p;
  for (int i = 0; i < 44; ++i) pp[i] = (const float*)d_in[i];
  p.out = (float*)d_out; p.ws = (float*)d_ws;
  float* ws = p.ws;
  static int grid = 0;
  if (grid == 0) {
    int dev = 0, cus = 0;
    (void)hipGetDevice(&dev); (void)hipDeviceGetAttribute(&cus, hipDeviceAttributeMultiprocessorCount, dev);
    (void)hipFuncSetAttribute((const void*)mk::mega, hipFuncAttributeMaxDynamicSharedMemorySize, mk::LDS_BYTES);
    grid = cus > 0 ? cus : 256;
  }
  (void)hipMemsetAsync((char*)d_ws + mk::M_CTL, 0, 65536, stream);
  mk::MArgs a{}; a.p = p; a.ph_lo = 0; a.ph_hi = MEGA_PHASES;
  hipLaunchKernelGGL(mk::mega, dim3(grid), dim3(512), mk::LDS_BYTES, stream, a);

  float* X = ws + WS_X; float* S1 = ws + WS_S1; float* S4 = ws + WS_S4; float* S2 = ws + WS_S2;
  const int EB = (int)((SZ + 255) / 256);
  if (NAIVE_FROM < 4) hipLaunchKernelGGL(k_mods, dim3((4 * 3 * 3072 + 255) / 256), dim3(256), 0, stream, p);
  for (int layer = NAIVE_FROM; layer < 4; ++layer) {
    const int kind = layer % 3, j = layer / 3;
    const float* xa = (layer == 0) ? p.x_prompt : X;
    const float* xb = (layer == 0) ? p.x_sample : X + (size_t)NPT * D;
    float* Xn = (layer == 3) ? p.out + OUT_Y : X;
    hipLaunchKernelGGL(k_modulate, dim3(EB), dim3(256), 0, stream, p, xa, xb, S1, layer);
    if (kind == 0) {
      hipLaunchKernelGGL(k_hy_filter, dim3(2304), dim3(256), 0, stream, p, j);
      gemm(stream, ALPlain{S1, D}, p.hy_w_in + (size_t)j * D * 4096, 4096, NTOK, 4096, D, EPPlain{S2, 4096});
      hipLaunchKernelGGL(k_hy_vv, dim3(EB), dim3(256), 0, stream, p, S2, S1, j);
      hipLaunchKernelGGL(k_hy_long, dim3(EB), dim3(256), 0, stream, p, S2, S1, S4, j);
      gemm(stream, ALPlain{S4, D}, p.hy_w_out + (size_t)j * D * D, D, NTOK, D, D, EPPlain{S1, D});
    } else if (kind == 1) {
      float* U2 = S2; float* QN = S1; float* CKVALL = S1 + (size_t)NTOK * 256; float* KPEALL = CKVALL + (size_t)9216 * 128;
      float* Q = S2; float* KV = S2 + (size_t)NTOK * 1536;
      gemm(stream, ALPlain{S1, D}, p.mla_w_in, 1440, NTOK, 1440, D, EPPlain{U2, 1440});
      hipLaunchKernelGGL(k_mla_extract, dim3(NTOK), dim3(64), 0, stream, p, U2, QN, CKVALL, KPEALL, S4);
      hipLaunchKernelGGL(k_mla_cache, dim3((2 * PAST * 128 + 255) / 256), dim3(256), 0, stream, p, CKVALL, KPEALL);
      gemm(stream, ALPlain{QN, 256}, p.mla_w_q_up, 1536, NTOK, 1536, 256, EPPlain{Q, 1536});
      hipLaunchKernelGGL(k_rope_q, dim3((4096 * 16 + 255) / 256), dim3(256), 0, stream, Q);
      gemm(stream, ALPlain{CKVALL, 128}, p.mla_w_kv_up, 2048, 9216, 2048, 128, EPPlain{KV, 2048});
      hipLaunchKernelGGL(k_attn, dim3(32, 18 * 16), dim3(64), 0, stream, Q, KV, KPEALL, S4);
      gemm(stream, ALPlain{S4, D}, p.mla_w_out, D, NTOK, D, D, EPPlain{S1, D});
    } else {
      float* R = S2; float* K = S2 + SZ; float* V = S2 + 2 * SZ; float* Z = S2 + 3 * SZ;
      float* HW = ws + WS_MISC + MISC_END; float* HA = HW + (size_t)NTOK * 128;
      const float* mu = p.rw_mu; const float* win = p.rw_w_in;
      gemm(stream, ALMix{S1, mu + 0 * D}, win + 0 * (size_t)D * D, D, NTOK, D, D, EPPlain{R, D});
      gemm(stream, ALMix{S1, mu + 2 * D}, win + 1 * (size_t)D * D, D, NTOK, D, D, EPPlain{K, D});
      gemm(stream, ALMix{S1, mu + 3 * D}, win + 2 * (size_t)D * D, D, NTOK, D, D, EPPlain{V, D});
      gemm(stream, ALMix{S1, mu + 5 * D}, win + 3 * (size_t)D * D, D, NTOK, D, D, EPPlain{Z, D});
      for (int dir = 0; dir < 2; ++dir) {
        gemm(stream, ALMix{S1, mu + 1 * D}, p.rw_w1 + (size_t)dir * D * 64, 64, NTOK, 64, D, EPTanh{HW + dir * 64, 128});
        gemm(stream, ALMix{S1, mu + 4 * D}, p.rw_a1 + (size_t)dir * D * 64, 64, NTOK, 64, D, EPPlain{HA + dir * 64, 128});
      }
      (void)hipMemsetAsync(S4, 0, SZ * sizeof(float), stream);
      hipLaunchKernelGGL(k_rw_scan, dim3(18 * 32), dim3(64), 0, stream, p, R, K, V, HW, HA, S4);
      hipLaunchKernelGGL(k_rw_post, dim3(NTOK * 16), dim3(64), 0, stream, p, R, K, V, Z, HA, S4, S4);
      gemm(stream, ALPlain{S4, D}, p.rw_w_out, D, NTOK, D, D, EPPlain{S1, D});
    }
    hipLaunchKernelGGL(k_ln, dim3(NTOK / 4), dim3(256), 0, stream, p, xa, xb, S1, Xn, layer);
  }
}
```

```cpp
#define MEGA_PHASES 16
#define NAIVE_FROM 4
#include <hip/hip_runtime.h>
#include <stdint.h>
#include <math.h>

namespace {

constexpr int D = 1024;
constexpr int NTOK = 8192;
constexpr int NPT = 4096;
constexpr int PAST = 512;
constexpr float ALPHA = 1.681792830507429f;
constexpr float LN_EPS = 1e-5f, RMS_EPS = 1e-6f, GN_EPS = 64e-5f;

struct P {
  const float *x_prompt, *x_sample, *cache_ckv, *cache_kpe, *state_rwkv, *c, *c_ctx;
  const float *mod_w, *mod_b, *ln_g, *ln_b;
  const float *hy_w_in, *hy_conv_w, *hy_conv_b, *hy_w1, *hy_b1, *hy_w2, *hy_b2, *hy_w3, *hy_b3, *hy_freq, *hy_decay, *hy_skip, *hy_w_out;
  const float *mla_w_in, *mla_q_norm, *mla_kv_norm, *mla_w_q_up, *mla_w_kv_up, *mla_w_out;
  const float *rw_mu, *rw_w_in, *rw_w0, *rw_w1, *rw_w2, *rw_a0, *rw_a1, *rw_a2, *rw_k_k, *rw_k_a, *rw_r_k, *rw_gn_g, *rw_gn_b, *rw_w_out;
  float* out;
  float* ws;
};

constexpr size_t OUT_Y = 0, OUT_CKV = 8388608, OUT_KPE = 8912896, OUT_ST = 9043968;

constexpr size_t SZ = (size_t)NTOK * D;
constexpr size_t WS_X = 0;
constexpr size_t WS_S1 = WS_X + SZ;
constexpr size_t WS_S4 = WS_S1 + SZ;
constexpr size_t WS_S2 = WS_S4 + SZ;
constexpr size_t WS_MISC = WS_S2 + 4 * SZ;
constexpr size_t MISC_MODS = 0;
constexpr size_t MISC_FILT = 65536;
constexpr size_t MISC_END = MISC_FILT + (size_t)2304 * 2048;

__device__ __forceinline__ float silu(float x) { return x / (1.f + expf(-x)); }
__device__ __forceinline__ float sigmoidf(float x) { return 1.f / (1.f + expf(-x)); }

__device__ __forceinline__ void tokinfo(int m, int& l, int& L, int& cond, int& m0) {
  if (m < NPT) { l = m & 255; L = 256; cond = 0; m0 = m & ~255; }
  else { int mm = m - NPT; l = mm & 2047; L = 2048; cond = 1 + (mm >> 11); m0 = NPT + (mm & ~2047); }
}

__global__ void k_mods(P p) {
  int idx = blockIdx.x * blockDim.x + threadIdx.x;
  if (idx >= 4 * 3 * 3072) return;
  int n = idx % 3072, g = (idx / 3072) % 3, i = idx / (3 * 3072);
  const float* cond = (g == 0) ? p.c_ctx : p.c + (size_t)(g - 1) * D;
  const float* w = p.mod_w + (size_t)i * D * 3072;
  float acc = 0.f;
  for (int k = 0; k < D; ++k) acc += silu(cond[k]) * w[(size_t)k * 3072 + n];
  p.ws[WS_MISC + MISC_MODS + idx] = acc + p.mod_b[i * 3072 + n];
}

__global__ void k_modulate(P p, const float* xa, const float* xb, float* H, int layer) {
  size_t idx = (size_t)blockIdx.x * blockDim.x + threadIdx.x;
  if (idx >= SZ) return;
  int m = (int)(idx >> 10), k = (int)(idx & 1023);
  int l, L, cond, m0; tokinfo(m, l, L, cond, m0);
  const float* md = p.ws + WS_MISC + MISC_MODS + (size_t)(layer * 3 + cond) * 3072;
  float x = (m < NPT) ? xa[idx] : xb[idx - (size_t)NPT * D];
  H[idx] = x * (1.f + md[1024 + k]) + md[k];
}

template <class AL, class EP>
__global__ void __launch_bounds__(256) k_gemm(AL al, const float* __restrict__ W, int ldw, int M, int N, int K, EP ep) {
  __shared__ float As[16][68];
  __shared__ float Bs[16][68];
  const int tx = threadIdx.x & 15, ty = threadIdx.x >> 4;
  const int m0 = blockIdx.y * 64, n0 = blockIdx.x * 64;
  float acc[4][4];
#pragma unroll
  for (int i = 0; i < 4; ++i)
#pragma unroll
    for (int j = 0; j < 4; ++j) acc[i][j] = 0.f;
  for (int k0 = 0; k0 < K; k0 += 16) {
#pragma unroll
    for (int i = 0; i < 4; ++i) {
      int e = threadIdx.x + i * 256; int mm = e >> 4, kk = e & 15;
      As[kk][mm] = (m0 + mm < M) ? al(m0 + mm, k0 + kk) : 0.f;
    }
#pragma unroll
    for (int i = 0; i < 4; ++i) {
      int e = threadIdx.x + i * 256; int kk = e >> 6, nn = e & 63;
      Bs[kk][nn] = (n0 + nn < N) ? W[(size_t)(k0 + kk) * ldw + n0 + nn] : 0.f;
    }
    __syncthreads();
#pragma unroll
    for (int kk = 0; kk < 16; ++kk) {
      float a[4], b[4];
#pragma unroll
      for (int i = 0; i < 4; ++i) { a[i] = As[kk][ty * 4 + i]; b[i] = Bs[kk][tx * 4 + i]; }
#pragma unroll
      for (int i = 0; i < 4; ++i)
#pragma unroll
        for (int j = 0; j < 4; ++j) acc[i][j] += a[i] * b[j];
    }
    __syncthreads();
  }
#pragma unroll
  for (int i = 0; i < 4; ++i)
#pragma unroll
    for (int j = 0; j < 4; ++j) {
      int m = m0 + ty * 4 + i, n = n0 + tx * 4 + j;
      if (m < M && n < N) ep(m, n, acc[i][j]);
    }
}

struct ALPlain { const float* A; long lda; __device__ float operator()(int m, int k) const { return A[(size_t)m * lda + k]; } };
struct EPPlain { float* C; long ldc; __device__ void operator()(int m, int n, float v) const { C[(size_t)m * ldc + n] = v; } };
struct EPTanh { float* C; long ldc; __device__ void operator()(int m, int n, float v) const { C[(size_t)m * ldc + n] = tanhf(v); } };
struct ALMix {
  const float* H; const float* mu;
  __device__ float operator()(int m, int k) const {
    int l, L, cond, m0; tokinfo(m, l, L, cond, m0);
    float h = H[(size_t)m * D + k];
    float pv = (l > 0) ? H[(size_t)(m - 1) * D + k] : 0.f;
    float nx = (l < L - 1) ? H[(size_t)(m + 1) * D + k] : 0.f;
    return h + (0.5f * (pv + nx) - h) * mu[k];
  }
};

template <class AL, class EP>
void gemm(hipStream_t s, AL al, const float* W, int ldw, int M, int N, int K, EP ep) {
  dim3 g((N + 63) / 64, (M + 63) / 64);
  hipLaunchKernelGGL((k_gemm<AL, EP>), g, dim3(256), 0, s, al, W, ldw, M, N, K, ep);
}

__global__ void __launch_bounds__(256) k_ln(P p, const float* xa, const float* xb, const float* O, float* Xn, int layer) {
  int m = blockIdx.x * 4 + (threadIdx.x >> 6), lane = threadIdx.x & 63;
  int l, L, cond, m0; tokinfo(m, l, L, cond, m0);
  const float* gate = p.ws + WS_MISC + MISC_MODS + (size_t)(layer * 3 + cond) * 3072 + 2048;
  const float* xr = (m < NPT) ? xa + (size_t)m * D : xb + (size_t)(m - NPT) * D;
  float v[16]; float s = 0.f;
#pragma unroll
  for (int i = 0; i < 16; ++i) { int k = lane + 64 * i; v[i] = ALPHA * xr[k] + gate[k] * O[(size_t)m * D + k]; s += v[i]; }
#pragma unroll
  for (int o = 1; o < 64; o <<= 1) s += __shfl_xor(s, o);
  float mu = s * (1.f / D), q = 0.f;
#pragma unroll
  for (int i = 0; i < 16; ++i) { v[i] -= mu; q += v[i] * v[i]; }
#pragma unroll
  for (int o = 1; o < 64; o <<= 1) q += __shfl_xor(q, o);
  float rs = rsqrtf(q * (1.f / D) + LN_EPS);
#pragma unroll
  for (int i = 0; i < 16; ++i) { int k = lane + 64 * i; Xn[(size_t)m * D + k] = v[i] * rs * p.ln_g[layer * D + k] + p.ln_b[layer * D + k]; }
}

__global__ void __launch_bounds__(256) k_hy_filter(P p, int j) {
  __shared__ float feat[33], h1[64], h2[64];
  int row = blockIdx.x; int L = row < 256 ? 256 : 2048; int l = row < 256 ? row : row - 256;
  int tid = threadIdx.x;
  float t = (float)l / (float)(L - 1);
  if (tid < 33) {
    float f;
    if (tid == 0) f = t;
    else {
      int b = (tid - 1) & 15;
      float band = 1e-4f + (float)b * ((15.f - 1e-4f) / 15.f);
      float ang = (6.283185307179586f / (float)L) * (float)l * band;
      f = (tid <= 16) ? cosf(ang) : -sinf(ang);
    }
    feat[tid] = f;
  }
  __syncthreads();
  if (tid < 64) {
    float a = p.hy_b1[j * 64 + tid];
    for (int f = 0; f < 33; ++f) a += feat[f] * p.hy_w1[((size_t)j * 33 + f) * 64 + tid];
    h1[tid] = sinf(p.hy_freq[(j * 2 + 0) * 64 + tid] * a);
  }
  __syncthreads();
  if (tid < 64) {
    float a = p.hy_b2[j * 64 + tid];
    for (int f = 0; f < 64; ++f) a += h1[f] * p.hy_w2[((size_t)j * 64 + f) * 64 + tid];
    h2[tid] = sinf(p.hy_freq[(j * 2 + 1) * 64 + tid] * a);
  }
  __syncthreads();
  for (int o = tid; o < 2048; o += 256) {
    float a = p.hy_b3[j * 2048 + o];
    for (int f = 0; f < 64; ++f) a += h2[f] * p.hy_w3[((size_t)j * 64 + f) * 2048 + o];
    float w = expf(-t * fabsf(p.hy_decay[(size_t)j * 2048 + o]));
    p.ws[WS_MISC + MISC_FILT + (size_t)row * 2048 + o] = a * w;
  }
}

__device__ __forceinline__ float conv3(const float* U, int m, int l, int L, int ch, const float* cw, const float* cb) {
  float cur = U[(size_t)m * 4096 + ch];
  float pv = (l > 0) ? U[(size_t)(m - 1) * 4096 + ch] : 0.f;
  float nx = (l < L - 1) ? U[(size_t)(m + 1) * 4096 + ch] : 0.f;
  return pv * cw[ch] + cur * cw[3072 + ch] + nx * cw[6144 + ch] + cb[ch];
}
__global__ void k_hy_vv(P p, const float* U, float* VV, int j) {
  size_t idx = (size_t)blockIdx.x * blockDim.x + threadIdx.x;
  if (idx >= SZ) return;
  int m = (int)(idx >> 10), c = (int)(idx & 1023);
  int l, L, cond, m0; tokinfo(m, l, L, cond, m0);
  const float* cw = p.hy_conv_w + (size_t)j * 3 * 3072; const float* cb = p.hy_conv_b + (size_t)j * 3072;
  float x1 = conv3(U, m, l, L, 1024 + c, cw, cb);
  float v = conv3(U, m, l, L, 2048 + c, cw, cb);
  VV[idx] = v * x1;
}
__global__ void k_hy_long(P p, const float* U, const float* VV, float* G, int j) {
  size_t idx = (size_t)blockIdx.x * blockDim.x + threadIdx.x;
  if (idx >= SZ) return;
  int m = (int)(idx >> 10), c = (int)(idx & 1023);
  int l, L, cond, m0; tokinfo(m, l, L, cond, m0);
  const float* F = p.ws + WS_MISC + MISC_FILT + (size_t)(L == 256 ? 0 : 256) * 2048;
  float acc = 0.f;
  for (int s = 0; s <= l; ++s) acc += VV[(size_t)(m0 + s) * D + c] * F[(size_t)(l - s) * 2048 + c];
  for (int s = l + 1; s < L; ++s) acc += VV[(size_t)(m0 + s) * D + c] * F[(size_t)(s - l) * 2048 + 1024 + c];
  const float* cw = p.hy_conv_w + (size_t)j * 3 * 3072; const float* cb = p.hy_conv_b + (size_t)j * 3072;
  float x0 = conv3(U, m, l, L, c, cw, cb);
  float z = U[(size_t)m * 4096 + 3072 + c];
  float y = (acc + VV[idx] * p.hy_skip[j * D + c]) * x0;
  G[idx] = y * silu(z);
}

__device__ __forceinline__ int kvrow(int m) { if (m < NPT) return m; int mm = m - NPT; return NPT + (mm >> 11) * 2560 + PAST + (mm & 2047); }
__device__ __forceinline__ void rope32(const float* x, float* o, int l) {
  int r = l >> 6, col = l & 63;
#pragma unroll
  for (int i = 0; i < 8; ++i) {
    float inv = powf(10000.f, -(float)(2 * i) / 16.f);
    float ar = (float)r * inv, ac = (float)col * inv;
    float cr = cosf(ar), sr = sinf(ar), cc = cosf(ac), sc = sinf(ac);
    o[i] = x[i] * cr - x[i + 8] * sr;
    o[i + 8] = x[i + 8] * cr + x[i] * sr;
    o[16 + i] = x[16 + i] * cc - x[24 + i] * sc;
    o[24 + i] = x[24 + i] * cc + x[16 + i] * sc;
  }
}
__global__ void __launch_bounds__(64) k_mla_extract(P p, const float* U2, float* QN, float* CKVALL, float* KPEALL, float* Z) {
  int m = blockIdx.x, lane = threadIdx.x;
  int l, L, cond, m0; tokinfo(m, l, L, cond, m0);
  const float* u = U2 + (size_t)m * 1440;
  float q[4], s = 0.f;
#pragma unroll
  for (int i = 0; i < 4; ++i) { q[i] = u[lane + 64 * i]; s += q[i] * q[i]; }
#pragma unroll
  for (int o = 1; o < 64; o <<= 1) s += __shfl_xor(s, o);
  float rs = rsqrtf(s * (1.f / 256.f) + RMS_EPS);
#pragma unroll
  for (int i = 0; i < 4; ++i) QN[(size_t)m * 256 + lane + 64 * i] = q[i] * rs * p.mla_q_norm[lane + 64 * i];
  float k0 = u[256 + lane], k1 = u[256 + 64 + lane];
  float s2 = k0 * k0 + k1 * k1;
#pragma unroll
  for (int o = 1; o < 64; o <<= 1) s2 += __shfl_xor(s2, o);
  float rs2 = rsqrtf(s2 * (1.f / 128.f) + RMS_EPS);
  float c0 = k0 * rs2 * p.mla_kv_norm[lane], c1 = k1 * rs2 * p.mla_kv_norm[64 + lane];
  int kr = kvrow(m);
  CKVALL[(size_t)kr * 128 + lane] = c0; CKVALL[(size_t)kr * 128 + 64 + lane] = c1;
  if (m < NPT) { p.out[OUT_CKV + (size_t)m * 128 + lane] = c0; p.out[OUT_CKV + (size_t)m * 128 + 64 + lane] = c1; }
  if (lane == 0) {
    float x[32], o[32];
#pragma unroll
    for (int i = 0; i < 32; ++i) x[i] = u[384 + i];
    if (m < NPT) {
#pragma unroll
      for (int i = 0; i < 32; ++i) { KPEALL[(size_t)kr * 32 + i] = x[i]; p.out[OUT_KPE + (size_t)m * 32 + i] = x[i]; }
    } else {
      rope32(x, o, l);
#pragma unroll
      for (int i = 0; i < 32; ++i) KPEALL[(size_t)kr * 32 + i] = o[i];
    }
  }
  for (int i = lane; i < 1024; i += 64) Z[(size_t)m * D + i] = u[416 + i];
}
__global__ void k_mla_cache(P p, float* CKVALL, float* KPEALL) {
  int idx = blockIdx.x * blockDim.x + threadIdx.x;
  if (idx >= 2 * PAST * 128) return;
  int d = idx & 127, pl = (idx >> 7) & 511, b = idx >> 16;
  int row = NPT + b * 2560 + pl;
  CKVALL[(size_t)row * 128 + d] = p.cache_ckv[idx];
  if (d < 32) KPEALL[(size_t)row * 32 + d] = p.cache_kpe[((size_t)b * PAST + pl) * 32 + d];
}
__global__ void k_rope_q(float* Q) {
  int idx = blockIdx.x * blockDim.x + threadIdx.x;
  if (idx >= 4096 * 16) return;
  int h = idx & 15, mm = idx >> 4; int m = NPT + mm; int l = mm & 2047;
  float* q = Q + (size_t)m * 1536 + h * 96 + 64;
  float x[32], o[32];
#pragma unroll
  for (int i = 0; i < 32; ++i) x[i] = q[i];
  rope32(x, o, l);
#pragma unroll
  for (int i = 0; i < 32; ++i) q[i] = o[i];
}
__global__ void __launch_bounds__(64) k_attn(const float* Q, const float* KV, const float* KPEALL, float* G) {
  int qi = blockIdx.x * 64 + threadIdx.x;
  int sh = blockIdx.y; int h = sh & 15, seq = sh >> 4;
  int L = seq < 16 ? 256 : 2048;
  if (qi >= L) return;
  int m = seq < 16 ? seq * 256 + qi : NPT + (seq - 16) * 2048 + qi;
  int kbase = seq < 16 ? seq * 256 : NPT + (seq - 16) * 2560;
  int nk = seq < 16 ? 256 : 2560;
  float q[96];
#pragma unroll
  for (int i = 0; i < 96; ++i) q[i] = Q[(size_t)m * 1536 + h * 96 + i];
  float acc[64];
#pragma unroll
  for (int i = 0; i < 64; ++i) acc[i] = 0.f;
  float mx = -1e30f, lsum = 0.f;
  const float scale = 0.10206207261596575f;
  for (int k = 0; k < nk; ++k) {
    const float* kv = KV + (size_t)(kbase + k) * 2048 + h * 128;
    const float* kp = KPEALL + (size_t)(kbase + k) * 32;
    float s = 0.f;
#pragma unroll
    for (int i = 0; i < 64; ++i) s += q[i] * kv[i];
#pragma unroll
    for (int i = 0; i < 32; ++i) s += q[64 + i] * kp[i];
    s *= scale;
    float mn = fmaxf(mx, s);
    float corr = expf(mx - mn), pe = expf(s - mn);
    lsum = lsum * corr + pe;
#pragma unroll
    for (int i = 0; i < 64; ++i) acc[i] = acc[i] * corr + pe * kv[64 + i];
    mx = mn;
  }
  float inv = 1.f / lsum;
#pragma unroll
  for (int i = 0; i < 64; ++i) { size_t o = (size_t)m * D + h * 64 + i; G[o] = acc[i] * inv * silu(G[o]); }
}

__global__ void __launch_bounds__(64) k_rw_scan(P p, const float* R, const float* K, const float* V, const float* HW, const float* HA, float* Y) {
  int id = blockIdx.x;
  int h = id & 15, dir = (id >> 4) & 1, seq = id >> 5;
  int lane = threadIdx.x;
  int L = seq < 16 ? 256 : 2048;
  int m0 = seq < 16 ? seq * 256 : NPT + (seq - 16) * 2048;
  int ch = h * 64 + lane;
  float S[64];
  if (seq < 16) {
#pragma unroll
    for (int j = 0; j < 64; ++j) S[j] = 0.f;
  } else {
    const float* s0 = p.state_rwkv + ((((size_t)(seq - 16) * 1 + 0) * 2 + dir) * 16 + h) * 4096 + (size_t)lane * 64;
#pragma unroll
    for (int j = 0; j < 64; ++j) S[j] = s0[j];
  }
  const float w0 = p.rw_w0[dir * D + ch], a0 = p.rw_a0[dir * D + ch];
  const float kkw = p.rw_k_k[ch], kaw = p.rw_k_a[ch];
  const float* w2 = p.rw_w2 + (size_t)dir * 64 * D + ch;
  const float* a2 = p.rw_a2 + (size_t)dir * 64 * D + ch;
  for (int st = 0; st < L; ++st) {
    int t = dir ? (L - 1 - st) : st;
    int m = m0 + t;
    float wl = w0, al = a0;
    const float* hw = HW + (size_t)m * 128 + dir * 64;
    const float* ha = HA + (size_t)m * 128 + dir * 64;
    for (int r = 0; r < 64; ++r) { wl += hw[r] * w2[(size_t)r * D]; al += ha[r] * a2[(size_t)r * D]; }
    float sp = (-wl > 20.f) ? -wl : log1pf(expf(-wl));
    float dec = expf(-expf(-sp - 0.5f));
    float a = sigmoidf(al);
    float k = K[(size_t)m * D + ch], r_ = R[(size_t)m * D + ch], v = V[(size_t)m * D + ch];
    float kk = k * kkw; float ss = kk * kk;
#pragma unroll
    for (int o = 1; o < 64; o <<= 1) ss += __shfl_xor(ss, o);
    kk *= rsqrtf(ss + 1e-12f);
    float kd = k * (1.f + (a - 1.f) * kaw);
    float bd = kk * a;
    float at = -kk;
    float sa = 0.f;
#pragma unroll
    for (int j = 0; j < 64; ++j) sa += S[j] * __shfl(at, j);
    float y = 0.f;
#pragma unroll
    for (int j = 0; j < 64; ++j) {
      float wj = __shfl(dec, j), bj = __shfl(bd, j), kj = __shfl(kd, j), rj = __shfl(r_, j);
      S[j] = S[j] * wj + sa * bj + v * kj;
      y += S[j] * rj;
    }
    atomicAdd(&Y[(size_t)m * D + ch], y);
  }
  if (seq < 16) {
    float* so = p.out + OUT_ST + ((((size_t)seq * 1 + 0) * 2 + dir) * 16 + h) * 4096 + (size_t)lane * 64;
#pragma unroll
    for (int j = 0; j < 64; ++j) so[j] = S[j];
  }
}
__global__ void __launch_bounds__(64) k_rw_post(P p, const float* R, const float* K, const float* V, const float* Z, const float* HA, const float* Y, float* G) {
  int m = blockIdx.x >> 4, h = blockIdx.x & 15, lane = threadIdx.x; int ch = h * 64 + lane;
  float y = Y[(size_t)m * D + ch];
  float s = y;
#pragma unroll
  for (int o = 1; o < 64; o <<= 1) s += __shfl_xor(s, o);
  float mu = s * (1.f / 64.f); float d = y - mu; float q = d * d;
#pragma unroll
  for (int o = 1; o < 64; o <<= 1) q += __shfl_xor(q, o);
  float yn = d * rsqrtf(q * (1.f / 64.f) + GN_EPS) * p.rw_gn_g[ch] + p.rw_gn_b[ch];
  float k = K[(size_t)m * D + ch], r_ = R[(size_t)m * D + ch], v = V[(size_t)m * D + ch];
  float bsum = 0.f;
  for (int dir = 0; dir < 2; ++dir) {
    float al = p.rw_a0[dir * D + ch];
    const float* ha = HA + (size_t)m * 128 + dir * 64;
    const float* a2 = p.rw_a2 + (size_t)dir * 64 * D + ch;
    for (int r = 0; r < 64; ++r) al += ha[r] * a2[(size_t)r * D];
    float a = sigmoidf(al);
    float kd = k * (1.f + (a - 1.f) * p.rw_k_a[ch]);
    bsum += r_ * kd * p.rw_r_k[ch];
  }
#pragma unroll
  for (int o = 1; o < 64; o <<= 1) bsum += __shfl_xor(bsum, o);
  float o_ = yn + bsum * v;
  G[(size_t)m * D + ch] = o_ * silu(Z[(size_t)m * D + ch]);
}

typedef unsigned short bf16_t;
namespace pg8 {
#define PG8_LAS __attribute__((address_space(3)))
typedef unsigned short bf16_t;
typedef short bf16x8 __attribute__((ext_vector_type(8)));
typedef float f32x4 __attribute__((ext_vector_type(4)));
typedef unsigned u32x4 __attribute__((ext_vector_type(4)));
constexpr int BM = 256, BK = 64, HALF = 128, HTB = HALF * BK * 2  , STAGE_BYTES = 8 * HTB, NXCD = 8, WGM = 8;

__host__ __device__ __forceinline__ int lds_byte(int r, int c) { const int st = (r >> 4) * 2 + (c >> 5), rr = r & 15, cc = c & 31, ob = rr * 64 + cc * 2; return st * 1024 + (ob ^ (((ob >> 9) & 1) << 5)); }
__host__ __device__ __forceinline__ void stage_rc(int b, int& R, int& C) { const int st = b / 1024, sb = b % 1024, swz = sb ^ (((sb >> 9) & 1) << 5); R = (st >> 1) * 16 + swz / 64; C = (st & 1) * 32 + (swz % 64) / 2; }
__host__ __device__ __forceinline__ int perm32(int rho) { const int n = rho >> 4, i = rho & 15; return 8 * (i >> 2) + 4 * n + (i & 3); }

struct Unit { int pm, pn; };
struct Gemm { const bf16_t* A; const bf16_t* Bt; int M, N, K; };

struct StaticOrder {
    int nM, nN, nwg, G, c;
    __host__ __device__ void init(int M, int N, int G_, int c_) { nM = M / BM; nN = N / BM; nwg = nM * nN; G = G_; c = c_; }
    __host__ __device__ bool next(int i, Unit& u) const {
        const long L = (long)i * G + c; if (L >= nwg) return false;
        int wgid = (int)L; { const int q = nwg / NXCD, r = nwg % NXCD, xcd = wgid % NXCD, off = wgid / NXCD; wgid = (xcd < r ? xcd * (q + 1) : r * (q + 1) + (xcd - r) * q) + off; }
        const int nig = WGM * nN, gid = wgid / nig, fm = gid * WGM, gsz = (nM - fm) < WGM ? (nM - fm) : WGM;
        u.pm = fm + ((wgid % nig) % gsz); u.pn = (wgid % nig) / gsz; return true;
    }
    __device__ __forceinline__ void a_ready(const Unit&) const {}
    __device__ __forceinline__ void done(const Unit&) const {}
};
__device__ __forceinline__ unsigned cvt_pk_bf16(float lo, float hi) { unsigned r; asm volatile("v_cvt_pk_bf16_f32 %0, %1, %2" : "=v"(r) : "v"(lo), "v"(hi)); return r; }
typedef float f32x2 __attribute__((ext_vector_type(2)));
template <int ACT  > struct EpiBf16 {
    static constexpr bool PERM = true, AFTER_DRAIN = false; static_assert(ACT == 0 || ACT == 1, "EpiBf16: ACT is 0 (none) or 1 (gelu_pk)");
    bf16_t* O; int ldc; const float* bias; int split_cols; size_t split_stride; float scale0;
    __device__ __forceinline__ void operator()(const f32x4 (&acc)[2][2][4][2], const Unit& u, int wr, int wc, int fr, int fq) const {
        const int row0 = u.pm * BM + wr * 64 + fr; int colt = u.pn * BM; bf16_t* base = O;
        float sc = 1.f; if (split_cols) { const int t = colt / split_cols; base += (size_t)t * split_stride; colt -= t * split_cols; if (t == 0) sc = scale0; }
        const int col0 = colt + wc * 32 + 8 * fq, bcol0 = u.pn * BM + wc * 32 + 8 * fq;
        f32x4 bv[2][2];
#pragma unroll
        for (int bj = 0; bj < 2; ++bj)
#pragma unroll
            for (int n = 0; n < 2; ++n) bv[bj][n] = bias ? *(const f32x4*)(bias + bcol0 + bj * HALF + 4 * n) : (f32x4){0.f, 0.f, 0.f, 0.f};
#pragma unroll
        for (int ai = 0; ai < 2; ++ai)
#pragma unroll
            for (int m = 0; m < 4; ++m) { bf16_t* rowp = base + (size_t)(row0 + ai * HALF + m * 16) * ldc + col0;
#pragma unroll
                for (int bj = 0; bj < 2; ++bj) { f32x4 v0 = acc[ai][bj][m][0] + bv[bj][0], v1 = acc[ai][bj][m][1] + bv[bj][1];
                    v0 = v0 * sc; v1 = v1 * sc; u32x4 w; w.x = cvt_pk_bf16(v0[0], v0[1]); w.y = cvt_pk_bf16(v0[2], v0[3]); w.z = cvt_pk_bf16(v1[0], v1[1]); w.w = cvt_pk_bf16(v1[2], v1[3]);
                    *(u32x4*)(rowp + bj * HALF) = w; } }
    }
};
template <class Epi, class Sched, bool ALIGN_EPI = false, bool SP2 = false>
__device__ __forceinline__ void gemm_phase(PG8_LAS unsigned char* lds, const Gemm g, const Sched& S, const Epi& E) {
    const int tid = threadIdx.x, wid = __builtin_amdgcn_readfirstlane(tid >> 6), lane = tid & 63, wr = wid >> 2, wc = wid & 3, fr = lane & 15, fq = lane >> 4;
    const int K = g.K, nt = K / BK;
    unsigned voffA[2], voffB[2];
#pragma unroll
    for (int i = 0; i < 2; ++i) { int R, C; stage_rc(tid * 16 + i * 8192, R, C); const int Rb = Epi::PERM ? ((R & ~31) + perm32(R & 31)) : R;
        voffA[i] = (unsigned)(R * K + C) * 2u; voffB[i] = (unsigned)(Rb * K + C) * 2u; }
    const size_t kstep = (size_t)(BK * 2);
    const size_t hstep = (size_t)HALF * K * 2;
    const size_t tstep = 2 * hstep;
    const unsigned ldsw = (unsigned)wid * 1024u;
    const int aoff = lds_byte(wr * 64 + fr, fq * 8), boff = lds_byte(wc * 32 + fr, fq * 8);
#define PG8_SA(b, h) (((b) * 2 + (h)) * HTB)
#define PG8_SB(b, h) ((4 + (b) * 2 + (h)) * HTB)
#define PG8_STAGE(bufoff, gbase, voff) do { _Pragma("unroll") for (int _i = 0; _i < 2; ++_i) \
        __builtin_amdgcn_global_load_lds((const unsigned*)((const char*)(gbase) + (voff)[_i]), (PG8_LAS unsigned*)(lds + (bufoff) + ldsw + _i * 8192), 16, 0, 0); } while (0)
#define PG8_LDA(dst, b, h) do { _Pragma("unroll") for (int m = 0; m < 4; ++m) _Pragma("unroll") for (int k = 0; k < 2; ++k) dst[m][k] = *(const PG8_LAS bf16x8*)(lds + PG8_SA(b, h) + aoff + m * 2048 + k * 1024); } while (0)
#define PG8_LDB(dst, b, h) do { _Pragma("unroll") for (int n = 0; n < 2; ++n) _Pragma("unroll") for (int k = 0; k < 2; ++k) dst[n][k] = *(const PG8_LAS bf16x8*)(lds + PG8_SB(b, h) + boff + n * 2048 + k * 1024); } while (0)
#define PG8_MMA(ai, bj, At, Bt) do { __builtin_amdgcn_s_setprio(1); _Pragma("unroll") for (int m = 0; m < 4; ++m) _Pragma("unroll") for (int n = 0; n < 2; ++n) _Pragma("unroll") for (int k = 0; k < 2; ++k) \
        acc[ai][bj][m][n] = __builtin_amdgcn_mfma_f32_16x16x32_bf16(Bt[n][k], At[m][k], acc[ai][bj][m][n], 0, 0, 0); __builtin_amdgcn_s_setprio(0); } while (0)
#define PG8_WAIT_V(n) asm volatile("s_waitcnt vmcnt(" #n ")" ::: "memory")
#define PG8_WAIT_L(n) asm volatile("s_waitcnt lgkmcnt(" #n ")" ::: "memory")
#define PG8_BAR __builtin_amdgcn_s_barrier()
#define PG8_SCHED __builtin_amdgcn_sched_barrier(0)
    Unit cur, nxt; int ui = 0;
    if (!S.next(0, cur)) return;
    f32x4 acc[2][2][4][2];
#pragma unroll
    for (int a = 0; a < 2; ++a)
#pragma unroll
        for (int b = 0; b < 2; ++b)
#pragma unroll
            for (int m = 0; m < 4; ++m)
#pragma unroll
                for (int n = 0; n < 2; ++n) acc[a][b][m][n] = (f32x4){0.f, 0.f, 0.f, 0.f};
    bf16x8 At[4][2], B0[2][2], B1[2][2];
    const char* cA = (const char*)g.A + (size_t)cur.pm * tstep; const char* cB = (const char*)g.Bt + (size_t)cur.pn * tstep;
    S.a_ready(cur);
    if constexpr (SP2) {
        PG8_STAGE(PG8_SB(0, 0), cB, voffB); PG8_STAGE(PG8_SB(0, 1), cB + hstep, voffB); PG8_STAGE(PG8_SA(0, 0), cA, voffA); PG8_STAGE(PG8_SA(0, 1), cA + hstep, voffA);
        if (wr == 1) PG8_BAR;
        PG8_WAIT_V(2); PG8_BAR;
        PG8_STAGE(PG8_SB(1, 0), cB + kstep, voffB); PG8_STAGE(PG8_SA(1, 0), cA + kstep, voffA); PG8_STAGE(PG8_SB(1, 1), cB + hstep + kstep, voffB);
        PG8_WAIT_V(6); PG8_BAR;
    } else {
        PG8_STAGE(PG8_SB(0, 0), cB, voffB); PG8_STAGE(PG8_SA(0, 0), cA, voffA); PG8_STAGE(PG8_SB(0, 1), cB + hstep, voffB); PG8_STAGE(PG8_SA(0, 1), cA + hstep, voffA);
        if (wr == 1) PG8_BAR;
        PG8_WAIT_V(4); PG8_BAR;
        PG8_STAGE(PG8_SB(1, 0), cB + kstep, voffB); PG8_STAGE(PG8_SA(1, 0), cA + kstep, voffA); PG8_STAGE(PG8_SB(1, 1), cB + hstep + kstep, voffB);
        PG8_WAIT_V(6); PG8_BAR;
    }
    for (;;) {
        const bool has_next = S.next(ui + 1, nxt);
        const char* nA = has_next ? (const char*)g.A + (size_t)nxt.pm * tstep : cA; const char* nB = has_next ? (const char*)g.Bt + (size_t)nxt.pn * tstep : cB;
        for (int t = 0; t < nt; t += 2) {
            const bool last = (t == nt - 2);
            const char* a1 = cA + (size_t)(t + 1) * kstep;
            const char* a2 = last ? nA : cA + (size_t)(t + 2) * kstep; const char* b2 = last ? nB : cB + (size_t)(t + 2) * kstep;
            const char* a3 = a2 + kstep; const char* b3 = b2 + kstep;
            if (last && has_next) S.a_ready(nxt);
            if constexpr (SP2) {
            PG8_LDB(B0, 0, 0); PG8_LDB(B1, 0, 1); PG8_SCHED; PG8_LDA(At, 0, 0); PG8_STAGE(PG8_SA(1, 1), a1 + hstep, voffA);
            PG8_WAIT_V(8); PG8_WAIT_L(0); PG8_BAR; PG8_MMA(0, 0, At, B0); PG8_MMA(0, 1, At, B1); PG8_BAR; PG8_SCHED;
            PG8_LDA(At, 0, 1); PG8_STAGE(PG8_SB(0, 0), b2, voffB); PG8_STAGE(PG8_SB(0, 1), b2 + hstep, voffB); PG8_STAGE(PG8_SA(0, 0), a2, voffA);
            PG8_WAIT_V(8); PG8_WAIT_L(0); PG8_BAR; PG8_MMA(1, 0, At, B0); PG8_MMA(1, 1, At, B1); PG8_BAR; PG8_SCHED;
            PG8_LDB(B0, 1, 0); PG8_LDB(B1, 1, 1); PG8_SCHED; PG8_LDA(At, 1, 0); PG8_STAGE(PG8_SA(0, 1), a2 + hstep, voffA);
            PG8_WAIT_V(8); PG8_WAIT_L(0); PG8_BAR; PG8_MMA(0, 0, At, B0); PG8_MMA(0, 1, At, B1); PG8_BAR; PG8_SCHED;
            PG8_LDA(At, 1, 1); PG8_STAGE(PG8_SB(1, 0), b3, voffB); PG8_STAGE(PG8_SB(1, 1), b3 + hstep, voffB); PG8_STAGE(PG8_SA(1, 0), a3, voffA);
            PG8_WAIT_V(8); PG8_WAIT_L(0); PG8_BAR; PG8_MMA(1, 0, At, B0); PG8_MMA(1, 1, At, B1); PG8_BAR; PG8_SCHED;
            } else {
            PG8_LDB(B0, 0, 0); PG8_SCHED; PG8_LDA(At, 0, 0); PG8_STAGE(PG8_SA(1, 1), a1 + hstep, voffA);
            PG8_WAIT_L(8); PG8_BAR; PG8_WAIT_L(0); PG8_MMA(0, 0, At, B0); PG8_BAR; PG8_SCHED;
            PG8_LDB(B1, 0, 1); PG8_STAGE(PG8_SB(0, 0), b2, voffB);
            PG8_BAR; PG8_WAIT_L(0); PG8_MMA(0, 1, At, B1); PG8_BAR;
            PG8_LDA(At, 0, 1); PG8_STAGE(PG8_SA(0, 0), a2, voffA);
            PG8_BAR; PG8_WAIT_L(0); PG8_MMA(1, 0, At, B0); PG8_BAR; PG8_SCHED;
            PG8_STAGE(PG8_SB(0, 1), b2 + hstep, voffB);
            PG8_WAIT_V(6); PG8_BAR; PG8_MMA(1, 1, At, B1); PG8_BAR;
            PG8_LDB(B0, 1, 0); PG8_SCHED; PG8_LDA(At, 1, 0); PG8_STAGE(PG8_SA(0, 1), a2 + hstep, voffA);
            PG8_WAIT_L(8); PG8_BAR; PG8_WAIT_L(0); PG8_MMA(0, 0, At, B0); PG8_BAR; PG8_SCHED;
            PG8_LDB(B1, 1, 1); PG8_STAGE(PG8_SB(1, 0), b3, voffB);
            PG8_BAR; PG8_WAIT_L(0); PG8_MMA(0, 1, At, B1); PG8_BAR;
            PG8_LDA(At, 1, 1); PG8_STAGE(PG8_SA(1, 0), a3, voffA);
            PG8_BAR; PG8_WAIT_L(0); PG8_MMA(1, 0, At, B0); PG8_BAR; PG8_SCHED;
            PG8_STAGE(PG8_SB(1, 1), b3 + hstep, voffB);
            PG8_WAIT_V(6); PG8_BAR; PG8_MMA(1, 1, At, B1); PG8_BAR;
            }
        }
        if constexpr (ALIGN_EPI) { if (wr == 0) PG8_BAR; }
        if constexpr (!Epi::AFTER_DRAIN) { E(acc, cur, wr, wc, fr, fq); S.done(cur); }
        if (!has_next) break;
#pragma unroll
        for (int a = 0; a < 2; ++a)
#pragma unroll
            for (int b = 0; b < 2; ++b)
#pragma unroll
                for (int m = 0; m < 4; ++m)
#pragma unroll
                    for (int n = 0; n < 2; ++n) acc[a][b][m][n] = (f32x4){0.f, 0.f, 0.f, 0.f};
        cur = nxt; cA = nA; cB = nB; ++ui;
        if constexpr (ALIGN_EPI) { if (wr == 1) PG8_BAR; }
    }
    PG8_WAIT_V(0);
    if constexpr (!ALIGN_EPI) { if (wr == 0) PG8_BAR; }
    PG8_BAR;
    if constexpr (Epi::AFTER_DRAIN) { E.fused(acc, cur, wr, wc, fr, fq, lds, wid, lane); S.done(cur); }
#undef PG8_SA
#undef PG8_SB
#undef PG8_STAGE
#undef PG8_LDA
#undef PG8_LDB
#undef PG8_MMA
#undef PG8_WAIT_V
#undef PG8_WAIT_L
#undef PG8_BAR
#undef PG8_SCHED
}
}
#define GAS __attribute__((address_space(1)))
#define LAS __attribute__((address_space(3)))
typedef unsigned short bf16;
typedef unsigned v4u __attribute__((ext_vector_type(4)));
typedef float f32x4 __attribute__((ext_vector_type(4)));
typedef short bf16x8 __attribute__((ext_vector_type(8)));
typedef GAS unsigned gu32;
typedef GAS unsigned long long gu64;
#define RLX_AGENT __ATOMIC_RELAXED, __HIP_MEMORY_SCOPE_AGENT
#define LDS_WAIT() asm volatile("s_waitcnt lgkmcnt(0)" ::: "memory")
#define VM_WAIT() asm volatile("s_waitcnt vmcnt(0)" ::: "memory")
__device__ __forceinline__ unsigned long long rt() { return __builtin_amdgcn_s_memrealtime(); }
__device__ __forceinline__ unsigned f2bf(float f) { unsigned u = __builtin_bit_cast(unsigned, f); return (u + 0x7fffu + ((u >> 16) & 1u)) >> 16; }
__device__ __forceinline__ unsigned pk2(float lo, float hi) { return f2bf(lo) | (f2bf(hi) << 16); }

#define XB_TMO      128
#define XB_XCNT(j)  (256  + 64 * (j))
#define XB_XSUB(j)  (1280 + 64 * (j))
#define XB_XGEN(j)  (2304 + 64 * (j))
#define XB_TOP      3328
#define XB_TOPGEN   3392
#define XCD_BAR_WORDS 3456
#define XB_SPIN_CAP (1u << 18)

__device__ __forceinline__ unsigned xb_ld(unsigned* p)              { return __hip_atomic_load(p, __ATOMIC_RELAXED, __HIP_MEMORY_SCOPE_AGENT); }
__device__ __forceinline__ unsigned xb_add(unsigned* p, unsigned v) { return __hip_atomic_fetch_add(p, v, __ATOMIC_RELAXED, __HIP_MEMORY_SCOPE_AGENT); }
__device__ __forceinline__ unsigned xb_xcc_id() { return (unsigned)__builtin_amdgcn_s_getreg((3 << 11) | 20) & 0xFu; }
#define XB_SPIN(cond, bar) do { unsigned _sp = 0; while (cond) { __builtin_amdgcn_s_sleep(1); \
    if ((++_sp & 255u) == 0u) { if (xb_ld(&(bar)[XB_TMO])) break; if (_sp > XB_SPIN_CAP) { atomicAdd(&(bar)[XB_TMO], 1u); break; } } } } while (0)

struct XcdBarrier {
    unsigned* bar; unsigned x;
    volatile LAS unsigned* st;
};

__device__ __forceinline__ XcdBarrier xcd_barrier_post(unsigned* bar, volatile LAS unsigned* st) {
    XcdBarrier b; b.bar = bar; b.x = xb_xcc_id(); b.st = st;
    if (threadIdx.x == 0) (void)xb_add(&bar[XB_XCNT(b.x)], 1u);
    return b;
}
__device__ __forceinline__ void xcd_barrier_complete(unsigned* bar, unsigned x, unsigned& nloc, unsigned& nx) {
    const unsigned G = gridDim.x * gridDim.y * gridDim.z;
    unsigned sum, cnt, mine, sp = 0u;
    for (;;) {
        sum = 0u; cnt = 0u; mine = 0u;
#pragma unroll
        for (unsigned j = 0; j < 16; ++j) { const unsigned c = xb_ld(&bar[XB_XCNT(j)]); sum += c; cnt += (c > 0u) ? 1u : 0u; mine = (j == x) ? c : mine; }
        if (sum == G) break;
        __builtin_amdgcn_s_sleep(1);
        if ((++sp & 255u) == 0u) { if (xb_ld(&bar[XB_TMO])) break; if (sp > XB_SPIN_CAP) { atomicAdd(&bar[XB_TMO], 1u); break; } }
    }
    nloc = mine > 0u ? mine : 1u; nx = cnt > 0u ? cnt : 1u;
}

__device__ __forceinline__ void xcd_barrier(const XcdBarrier& b) {
    asm volatile("s_waitcnt vmcnt(0)" ::: "memory");
    __syncthreads();
    if (threadIdx.x == 0) {
        unsigned* bar = b.bar;
        __builtin_amdgcn_s_waitcnt(0);
        unsigned nloc = b.st[0], nx = b.st[1];
        if (nloc == 0u) { xcd_barrier_complete(bar, b.x, nloc, nx); b.st[0] = nloc; b.st[1] = nx; }
        const unsigned old = xb_add(&bar[XB_XSUB(b.x)], 1u);
        const unsigned gen = old / nloc;
        if (old + 1u == (gen + 1u) * nloc) {
            __builtin_amdgcn_fence(__ATOMIC_RELEASE, "agent");
            asm volatile("s_waitcnt vmcnt(0)" ::: "memory");
            const unsigned og = xb_add(&bar[XB_TOP], 1u);
            const unsigned tg = og / nx;
            if (og + 1u == (tg + 1u) * nx) xb_add(&bar[XB_TOPGEN], 1u);
            else XB_SPIN(xb_ld(&bar[XB_TOPGEN]) == tg, bar);
            __builtin_amdgcn_fence(__ATOMIC_ACQUIRE, "agent");
            xb_add(&bar[XB_XGEN(b.x)], 1u);
            asm volatile("s_waitcnt vmcnt(0)" ::: "memory");
        } else {
            XB_SPIN(xb_ld(&bar[XB_XGEN(b.x)]) == gen, bar);
            __builtin_amdgcn_fence(__ATOMIC_ACQUIRE, "agent");
            asm volatile("s_waitcnt vmcnt(0)" ::: "memory");
        }
    }
    __syncthreads();
}
typedef __attribute__((address_space(1))) float GASF;
struct PG {
  const GASF *x_prompt, *x_sample, *cache_ckv, *cache_kpe, *state_rwkv, *c, *c_ctx;
  const GASF *mod_w, *mod_b, *ln_g, *ln_b;
  const GASF *hy_w_in, *hy_conv_w, *hy_conv_b, *hy_w1, *hy_b1, *hy_w2, *hy_b2, *hy_w3, *hy_b3, *hy_freq, *hy_decay, *hy_skip, *hy_w_out;
  const GASF *mla_w_in, *mla_q_norm, *mla_kv_norm, *mla_w_q_up, *mla_w_kv_up, *mla_w_out;
  const GASF *rw_mu, *rw_w_in, *rw_w0, *rw_w1, *rw_w2, *rw_a0, *rw_a1, *rw_a2, *rw_k_k, *rw_k_a, *rw_r_k, *rw_gn_g, *rw_gn_b, *rw_w_out;
  GASF* out;
  GASF* ws;
};
namespace mk {
typedef float f32x16 __attribute__((ext_vector_type(16)));
typedef short v4i16_t __attribute__((ext_vector_type(4)));
typedef unsigned u32x4 __attribute__((ext_vector_type(4)));
typedef unsigned u32x2 __attribute__((ext_vector_type(2)));
typedef unsigned short u16;

constexpr size_t MiB = 1u << 20;
constexpr size_t M_X = 0, M_HB = 32 * MiB, M_GB = 48 * MiB, M_UT = 64 * MiB, M_SCR2 = 128 * MiB, M_WTS = 192 * MiB, M_FILT = 230 * MiB;
constexpr size_t M_HDN2 = 248 * MiB + 512 * 1024, M_MODP = 250 * MiB, M_MODS = 254 * MiB, M_CTL = 255 * MiB;
constexpr size_t W_HYIN = M_WTS, W_HYOUT = M_WTS + 16 * MiB, W_MLAIN = M_WTS + 20 * MiB, W_QUP = M_WTS + 23 * MiB, W_KVUP = M_WTS + 24 * MiB,
                 W_MLAOUT = M_WTS + 25 * MiB, W_RWIN = M_WTS + 27 * MiB, W_LORA1 = M_WTS + 35 * MiB, W_RWOUT = M_WTS + 36 * MiB;
constexpr size_t M_U2S = M_SCR2 + 24 * MiB;
constexpr size_t M_QN = M_SCR2, M_CKVALL = M_SCR2 + 4 * MiB, M_KPEB = M_SCR2 + 7 * MiB, M_SZB = M_SCR2 + 8 * MiB, M_Q = M_UT, M_KN = M_UT + 24 * MiB, M_V = M_UT + 42 * MiB;
constexpr int FILT_CH = 4640;
constexpr int LDS_BYTES = 163840, MISC_OFF = LDS_BYTES - 512, PTAB_OFF = LDS_BYTES - 1024;

__device__ __forceinline__ float bf2f(unsigned v) { return __builtin_bit_cast(float, v << 16); }
typedef float f32x2_t __attribute__((ext_vector_type(2))); typedef __bf16 bf16x2_t __attribute__((ext_vector_type(2)));
__device__ __forceinline__ unsigned pk2_(float lo, float hi) { const f32x2_t v = {lo, hi}; const bf16x2_t b = __builtin_convertvector(v, bf16x2_t); return __builtin_bit_cast(unsigned, b); }
__device__ __forceinline__ unsigned f2bf_(float f) { return pk2_(f, 0.f) & 0xffffu; }
__device__ __forceinline__ v4i16_t vtr(LAS const unsigned char* p) { return __builtin_amdgcn_ds_read_tr16_b64_v4i16((LAS v4i16_t*)p); }
template <class T> __device__ __forceinline__ T* uni(T* p) {
  const unsigned long long v = (unsigned long long)p;
  const unsigned lo = __builtin_amdgcn_readfirstlane((unsigned)v), hi = __builtin_amdgcn_readfirstlane((unsigned)(v >> 32));
  return (T*)(((unsigned long long)hi << 32) | lo);
}
__device__ __forceinline__ float wsum(float v) {
#pragma unroll
  for (int o = 1; o < 64; o <<= 1) v += __shfl_xor(v, o);
  return v;
}
__device__ __forceinline__ const GASF* xrow_in(const LAS PG& p, int layer, const unsigned char* ws, int m) {
  if (layer == 0) return (m < NPT) ? p.x_prompt + (size_t)m * D : p.x_sample + (size_t)(m - NPT) * D;
  if (layer == 2) return p.out + OUT_Y + (size_t)m * D;
  return (const GASF*)(ws + M_X) + (size_t)m * D;
}

struct TrD { const GASF* W; bf16_t* WT; int K, N, kind, row_off, item; };
constexpr int I_HYIN = 16 * 128, I_SQ = 16 * 32, I_MLAIN = 16 * 45, I_QUP = 4 * 48, I_KVUP = 2 * 64, I_LORA = 16 * 2;
constexpr int NTR = 2 * I_HYIN + 2 * I_SQ + I_MLAIN + I_QUP + I_KVUP + I_SQ + 4 * I_SQ + 4 * I_LORA + I_SQ;
constexpr int NTR_DEF = I_HYIN + I_SQ + I_SQ;
constexpr int NTR_DEF2 = 4 * I_SQ + 4 * I_LORA;
constexpr int NTR_P0 = NTR - NTR_DEF - NTR_DEF2;
constexpr int R_RWIN = 2 * I_HYIN + 2 * I_SQ + I_MLAIN + I_QUP + I_KVUP + I_SQ;
__device__ __forceinline__ int tr_map_p0(int idx) { return idx < I_HYIN ? idx : (idx < I_HYIN + I_SQ ? 2 * I_HYIN + (idx - I_HYIN) : 2 * I_HYIN + 2 * I_SQ + (idx - I_HYIN - I_SQ)); }
__device__ __forceinline__ int tr_map_def(int idx) { return idx < I_HYIN ? I_HYIN + idx : (idx < I_HYIN + I_SQ ? 2 * I_HYIN + I_SQ + (idx - I_HYIN) : NTR - I_SQ + (idx - I_HYIN - I_SQ)); }
__device__ __forceinline__ int tr_map_def2(int idx) { return R_RWIN + idx; }
__device__ __forceinline__ TrD tr_decode(const LAS PG& p, unsigned char* ws, int r) {
  TrD d; d.kind = 0; d.row_off = 0; d.K = 1024; d.N = 1024;
  if (r < 2 * I_HYIN) { const int j = r / I_HYIN; d.W = p.hy_w_in + (size_t)j * D * 4096; d.N = 4096; d.WT = (bf16_t*)(ws + W_HYIN + (size_t)j * 8 * MiB); d.item = r % I_HYIN; return d; } r -= 2 * I_HYIN;
  if (r < 2 * I_SQ) { const int j = r / I_SQ; d.W = p.hy_w_out + (size_t)j * D * D; d.WT = (bf16_t*)(ws + W_HYOUT + (size_t)j * 2 * MiB); d.kind = 1; d.item = r % I_SQ; return d; } r -= 2 * I_SQ;
  if (r < I_MLAIN) { const int nb = r % 45; d.W = p.mla_w_in; d.N = 1440; d.item = r; if (nb < 13) d.WT = (bf16_t*)(ws + W_MLAIN); else { d.WT = (bf16_t*)(ws + W_MLAIN + MiB); d.row_off = -416; } return d; } r -= I_MLAIN;
  if (r < I_QUP) { d.W = p.mla_w_q_up; d.K = 256; d.N = 1536; d.WT = (bf16_t*)(ws + W_QUP); d.item = r; return d; } r -= I_QUP;
  if (r < I_KVUP) { d.W = p.mla_w_kv_up; d.K = 128; d.N = 2048; d.WT = (bf16_t*)(ws + W_KVUP); d.item = r; return d; } r -= I_KVUP;
  if (r < I_SQ) { d.W = p.mla_w_out; d.WT = (bf16_t*)(ws + W_MLAOUT); d.kind = 1; d.item = r; return d; } r -= I_SQ;
  if (r < 4 * I_SQ) { const int q = r / I_SQ; d.W = p.rw_w_in + (size_t)q * D * D; d.WT = (bf16_t*)(ws + W_RWIN + (size_t)q * 2 * MiB); d.item = r % I_SQ; return d; } r -= 4 * I_SQ;
  if (r < 4 * I_LORA) { const int q = r / I_LORA; d.W = (q < 2) ? p.rw_w1 + (size_t)q * D * 64 : p.rw_a1 + (size_t)(q - 2) * D * 64; d.N = 64; d.WT = (bf16_t*)(ws + W_LORA1); d.kind = 1; d.row_off = q * 64; d.item = r % I_LORA; return d; } r -= 4 * I_LORA;
  d.W = p.rw_w_out; d.WT = (bf16_t*)(ws + W_RWOUT); d.kind = 1; d.item = r; return d;
}
__device__ __forceinline__ void tr_load(const TrD& d, int lane, f32x4 (&v)[8]) {
  const int nblk = d.N / 32, kb = d.item / nblk, nb = d.item % nblk, k0 = 64 * kb, n0 = 32 * nb;
  const GAS f32x4* src = (const GAS f32x4*)(d.W + (size_t)(k0 + (lane >> 3)) * d.N + n0 + 4 * (lane & 7));
#pragma unroll
  for (int i = 0; i < 8; ++i) v[i] = src[(size_t)i * 2 * d.N];
}
__device__ __forceinline__ void tr_finish(const TrD& d, LAS float* scr, int lane, const f32x4 (&v)[8]) {
  const int nblk = d.N / 32, kb = d.item / nblk, nb = d.item % nblk, k0 = 64 * kb, n0 = 32 * nb, K = d.K;
#pragma unroll
  for (int i = 0; i < 8; ++i) { LAS float* dd = scr + (8 * i + (lane >> 3)) * 33 + 4 * (lane & 7); dd[0] = v[i].x; dd[1] = v[i].y; dd[2] = v[i].z; dd[3] = v[i].w; }
  asm volatile("s_waitcnt lgkmcnt(0)" ::: "memory");
  const int c = lane & 7;
#pragma unroll
  for (int jj = 0; jj < 4; ++jj) {
    const int n = (lane >> 3) + 8 * jj; LAS const float* s = scr + (8 * c) * 33 + n;
    u32x4 o; o.x = pk2_(s[0 * 33], s[1 * 33]); o.y = pk2_(s[2 * 33], s[3 * 33]); o.z = pk2_(s[4 * 33], s[5 * 33]); o.w = pk2_(s[6 * 33], s[7 * 33]);
    const int ng = n0 + n + d.row_off;
    if (d.kind == 0) {
      *(u32x4*)(d.WT + (size_t)ng * K + k0 + 8 * c) = o;
    } else {
      const int k8 = (k0 >> 3) + c;
      const size_t ci = ((size_t)((ng >> 5) * 64 + (k8 >> 1))) * 64 + (ng & 31) + 32 * (k8 & 1);
      *(u32x4*)(d.WT + ci * 8) = o;
    }
  }
  asm volatile("s_waitcnt lgkmcnt(0)" ::: "memory");
}
template <int DEF>
__device__ __forceinline__ void tr_run(const LAS PG& p, unsigned char* ws, LAS float* scr, int lane, int first, int stride, int n) {
  for (int it = first; it < n; it += 2 * stride) {
    const TrD dA = tr_decode(p, ws, DEF == 2 ? tr_map_def2(it) : (DEF == 1 ? tr_map_def(it) : tr_map_p0(it)));
    f32x4 vA[8], vB[8];
    tr_load(dA, lane, vA);
    const bool hasB = (it + stride) < n;
    TrD dB = dA;
    if (hasB) { dB = tr_decode(p, ws, DEF == 2 ? tr_map_def2(it + stride) : (DEF == 1 ? tr_map_def(it + stride) : tr_map_p0(it + stride))); tr_load(dB, lane, vB); }
    tr_finish(dA, scr, lane, vA);
    if (hasB) tr_finish(dB, scr, lane, vB);
  }
}

__device__ __forceinline__ void phase_p0a(const LAS PG& p, unsigned char* ws, LAS unsigned char* lds, int tid, int lane, int wave, int bid, int G) {
  LAS float* SC = (LAS float*)lds;
  for (int i = tid; i < 3072; i += 512) { const int g = i >> 10, k = i & 1023; const float c = (g == 0) ? p.c_ctx[k] : p.c[(g - 1) * 1024 + k]; SC[i] = silu(c); }
  __syncthreads();
  LAS float* RED = (LAS float*)lds + 3072;
#ifdef MP_TWICE
  for (int rep_ = 0; rep_ < 2; ++rep_)
#endif
  for (int it = bid; it < 96; it += G) {
    const int kc = it & 7, cc = (it >> 3) % 3, i = it / 24;
    const int c4 = tid & 255, kh = tid >> 8;
    const int n = cc * 1024 + 4 * c4;
    const GAS f32x4* w = (const GAS f32x4*)(p.mod_w + ((size_t)i * 1024 + kc * 128 + kh * 64) * 3072 + n);
    f32x4 a0 = (f32x4){0.f, 0.f, 0.f, 0.f}, a1 = a0, a2 = a0;
#pragma unroll 8
    for (int k = 0; k < 64; ++k) { const f32x4 wv = w[(size_t)k * 768]; const int kk = kc * 128 + kh * 64 + k; a0 += SC[kk] * wv; a1 += SC[1024 + kk] * wv; a2 += SC[2048 + kk] * wv; }
    if (kh == 1) { LAS f32x4* r = (LAS f32x4*)(RED + c4 * 12); r[0] = a0; r[1] = a1; r[2] = a2; }
    __syncthreads();
    if (kh == 0) {
      LAS const f32x4* r = (LAS const f32x4*)(RED + c4 * 12);
      float* mp = (float*)(ws + M_MODP) + (size_t)kc * 36864 + (size_t)i * 9216 + n;
      *(f32x4*)mp = a0 + r[0]; *(f32x4*)(mp + 3072) = a1 + r[1]; *(f32x4*)(mp + 6144) = a2 + r[2];
    }
    __syncthreads();
  }
  __syncthreads();
  for (int i = bid * 512 + tid; i < 12288; i += G * 512) *(u32x4*)(ws + W_MLAIN + (size_t)416 * 2048 + (size_t)i * 16) = (u32x4){0u, 0u, 0u, 0u};
  for (int i = bid * 512 + tid; i < 2 * PAST * 128 / 8; i += G * 512) {
    const int d8 = i & 15, pl = (i >> 4) & 511, b = i >> 13;
    const f32x4* src = (const f32x4*)(p.cache_ckv + ((size_t)(b * PAST + pl)) * 128 + d8 * 8);
    const f32x4 x0 = src[0], x1 = src[1];
    u32x4 o; o.x = pk2_(x0.x, x0.y); o.y = pk2_(x0.z, x0.w); o.z = pk2_(x1.x, x1.y); o.w = pk2_(x1.z, x1.w);
    *(u32x4*)((bf16_t*)(ws + M_CKVALL) + ((size_t)(NPT + b * 2560 + pl)) * 128 + d8 * 8) = o;
    if (d8 < 4) {
      const f32x4* s2 = (const f32x4*)(p.cache_kpe + ((size_t)(b * PAST + pl)) * 32 + d8 * 8);
      const f32x4 y0 = s2[0], y1 = s2[1];
      u32x4 o2; o2.x = pk2_(y0.x, y0.y); o2.y = pk2_(y0.z, y0.w); o2.z = pk2_(y1.x, y1.y); o2.w = pk2_(y1.z, y1.w);
      *(u32x4*)((bf16_t*)(ws + M_KPEB) + ((size_t)(NPT + b * 2560 + pl)) * 32 + d8 * 8) = o2;
    }
  }
  LAS float* scr = (LAS float*)(lds + wave * 16384);
  const int gw = bid * 8 + wave, NGW = G * 8;
  tr_run<0>(p, ws, scr, lane, gw, NGW, NTR_P0);
#ifdef TR_TWICE
  tr_run<0>(p, ws, scr, lane, gw, NGW, NTR_P0);
#endif
  {
    __syncthreads();
    const int jh = (bid * 2 >= G) ? 1 : 0;
    LAS float* w1s = (LAS float*)(lds + 131072);
    LAS float* w2s = w1s + 33 * 64;
    for (int i = tid; i < 33 * 64; i += 512) w1s[i] = p.hy_w1[(size_t)jh * 33 * 64 + i];
    for (int i = tid; i < 64 * 64; i += 512) w2s[i] = p.hy_w2[(size_t)jh * 64 * 64 + i];
    __syncthreads();
    const float b1 = p.hy_b1[jh * 64 + lane], b2 = p.hy_b2[jh * 64 + lane], f0 = p.hy_freq[(jh * 2 + 0) * 64 + lane], f1 = p.hy_freq[(jh * 2 + 1) * 64 + lane];
    const int nbh = jh ? (G - (G + 1) / 2) : ((G + 1) / 2), bh = jh ? (bid - (G + 1) / 2) : bid;
    for (int row = bh * 8 + wave; row < 2304; row += nbh * 8) {
      const int L = row < 256 ? 256 : 2048, l = row < 256 ? row : row - 256;
      const float t = (float)l / (float)(L - 1);
      float feat = 0.f;
      if (lane == 0) feat = t;
      else if (lane < 33) {
        const int b = (lane - 1) & 15;
        const float band = 1e-4f + (float)b * ((15.f - 1e-4f) / 15.f);
        const float rev = ((float)l / (float)L) * band;
        const float fr = rev - floorf(rev);
        feat = (lane <= 16) ? __builtin_amdgcn_cosf(fr) : -__builtin_amdgcn_sinf(fr);
      }
      float a = b1;
#pragma unroll
      for (int f = 0; f < 33; ++f) a += __shfl(feat, f) * w1s[f * 64 + lane];
      const float x1 = f0 * a * 0.15915494309189535f;
      const float h1 = __builtin_amdgcn_sinf(x1 - floorf(x1));
      float a2 = b2;
#pragma unroll 16
      for (int f = 0; f < 64; ++f) a2 += __shfl(h1, f) * w2s[f * 64 + lane];
      const float x2 = f1 * a2 * 0.15915494309189535f;
      const float h2 = __builtin_amdgcn_sinf(x2 - floorf(x2));
      ((float*)(ws + M_HDN2))[((size_t)jh * 2304 + row) * 64 + lane] = h2;
    }
  }
}

__device__ __forceinline__ void phase_p0b(const LAS PG& p, unsigned char* ws, LAS unsigned char* lds, int tid, int lane, int wave, int bid, int G) {
  const float* MP = (const float*)(ws + M_MODP);
  float* MODS = (float*)(ws + M_MODS);
  for (int idx = bid * 512 + tid; idx < 36864; idx += G * 512) {
    float s = p.mod_b[(idx / 9216) * 3072 + (idx % 3072)];
#pragma unroll
    for (int kc = 0; kc < 8; ++kc) s += MP[(size_t)kc * 36864 + idx];
    MODS[idx] = s;
  }
  LAS float* ML = (LAS float*)lds;
  for (int e = tid; e < 6144; e += 512) {
    const int g = e >> 11, r = e & 2047; const int idx = g * 3072 + r;
    float s = p.mod_b[r];
#pragma unroll
    for (int kc = 0; kc < 8; ++kc) s += MP[(size_t)kc * 36864 + idx];
    ML[e] = s;
  }
  __syncthreads();
  bf16_t* HB = (bf16_t*)(ws + M_HB);
#ifndef NO_H0
#ifdef H0_TWICE
  for (int rep_ = 0; rep_ < 2; ++rep_)
#endif
  for (int m = bid * 8 + wave; m < NTOK; m += G * 8) {
    int l, L, cond, m0; tokinfo(m, l, L, cond, m0);
    const GAS f32x4* xr = (const GAS f32x4*)xrow_in(p, 0, ws, m);
    LAS const float* sh = ML + cond * 2048; LAS const float* sc = sh + 1024;
#pragma unroll
    for (int i = 0; i < 4; ++i) {
      const int k = 4 * lane + 256 * i; const f32x4 x = xr[lane + 64 * i];
      u32x2 o; o.x = pk2_(x.x * (1.f + sc[k]) + sh[k], x.y * (1.f + sc[k + 1]) + sh[k + 1]); o.y = pk2_(x.z * (1.f + sc[k + 2]) + sh[k + 2], x.w * (1.f + sc[k + 3]) + sh[k + 3]);
      *(u32x2*)(HB + (size_t)m * D + k) = o;
    }
  }
#endif
  __syncthreads();
#ifndef NO_FG
  const int gw = bid * 8 + wave, NGW = G * 8;
  const float* HD = (const float*)(ws + M_HDN2);
  bf16_t* FILT = (bf16_t*)(ws + M_FILT);
  const int r32 = lane & 31, hi = lane >> 5;
#ifdef FG_TWICE
  for (int rep_ = 0; rep_ < 2; ++rep_)
#endif
  for (int wslot = gw; wslot < 64 * 32; wslot += NGW) {
    const int combo = wslot & 63, sub = wslot >> 6;
    const int cch = combo & 15, dir = (combo >> 4) & 1, j = combo >> 5;
    LAS float* w3s = (LAS float*)(lds + 16384 + wave * 16384);
    {
      const GASF* w3 = p.hy_w3 + ((size_t)j * 64 * 2048 + dir * 1024 + cch * 64 + lane);
      asm volatile("s_waitcnt lgkmcnt(0)" ::: "memory");
#pragma unroll 8
      for (int m = 0; m < 64; ++m) { w3s[m * 64 + lane] = *w3; w3 += 2048; }
      asm volatile("s_waitcnt lgkmcnt(0)" ::: "memory");
    }
    bf16x8 bw[2][4];
    {
      LAS const float* wb = w3s + (8 * hi) * 64 + r32;
#pragma unroll
      for (int nt = 0; nt < 2; ++nt)
#pragma unroll
        for (int ks = 0; ks < 4; ++ks) {
          LAS const float* q = wb + (16 * ks) * 64 + 32 * nt;
          u32x4 o; o.x = pk2_(q[0], q[64]); o.y = pk2_(q[128], q[192]); o.z = pk2_(q[256], q[320]); o.w = pk2_(q[384], q[448]);
          bw[nt][ks] = __builtin_bit_cast(bf16x8, o);
        }
    }
    float cb3[2], cdec[2];
#pragma unroll
    for (int nt = 0; nt < 2; ++nt) { const int o = dir * 1024 + cch * 64 + 32 * nt + r32; cb3[nt] = p.hy_b3[j * 2048 + o]; cdec[nt] = fabsf(p.hy_decay[(size_t)j * 2048 + o]); }
#pragma unroll 1
    for (int it = sub; it < 72; it += 32) {
      const int set = it < 8 ? 0 : 1, b = set ? it - 8 : it, L = set ? 2048 : 256, row0 = set ? 256 : 0;
      const int lag0 = 32 * b + (dir ? 0 : 1);
      bf16x8 af[4];
      {
        const int lag = lag0 + r32; const bool ok = dir ? (lag >= 1) : (lag <= L - 1);
        const float* hrow = HD + ((size_t)j * 2304 + row0 + (ok ? lag : 0)) * 64 + 8 * hi;
#pragma unroll
        for (int ks = 0; ks < 4; ++ks) {
          f32x4 x0 = *(const f32x4*)(hrow + 16 * ks), x1 = *(const f32x4*)(hrow + 16 * ks + 4);
          if (!ok) { x0 = (f32x4){0.f, 0.f, 0.f, 0.f}; x1 = x0; }
          u32x4 o; o.x = pk2_(x0.x, x0.y); o.y = pk2_(x0.z, x0.w); o.z = pk2_(x1.x, x1.y); o.w = pk2_(x1.z, x1.w);
          af[ks] = __builtin_bit_cast(bf16x8, o);
        }
      }
      const float tinv = 1.f / (float)(L - 1);
#pragma unroll
      for (int nt = 0; nt < 2; ++nt) {
        f32x16 acc;
#pragma unroll
        for (int i = 0; i < 16; ++i) acc[i] = 0.f;
#pragma unroll
        for (int ks = 0; ks < 4; ++ks) acc = __builtin_amdgcn_mfma_f32_32x32x16_bf16(af[ks], bw[nt][ks], acc, 0, 0, 0);
        bf16_t* fch = FILT + ((size_t)(j * 1024 + cch * 64 + 32 * nt + r32)) * FILT_CH + (set ? 528 : 0) + L + 8;
#pragma unroll
        for (int q = 0; q < 4; ++q) {
          unsigned v[4];
#pragma unroll
          for (int x = 0; x < 4; ++x) {
            const int lag = lag0 + 8 * q + 4 * hi + x;
            const bool ok = dir ? (lag >= 1) : (lag <= L - 1);
            const float val = (acc[4 * q + x] + cb3[nt]) * __expf(-(float)lag * tinv * cdec[nt]);
            v[x] = ok ? f2bf_(val) : 0u;
          }
          if (dir) {
            const int i0 = lag0 + 8 * q + 4 * hi;
            if (i0 != 0) { u32x2 w; w.x = v[0] | (v[1] << 16); w.y = v[2] | (v[3] << 16); *(u32x2*)(fch + i0) = w; }
            else { fch[1] = (bf16_t)v[1]; fch[2] = (bf16_t)v[2]; fch[3] = (bf16_t)v[3]; }
          } else {
            const int i0 = -(lag0 + 8 * q + 4 * hi + 3);
            u32x2 w; w.x = v[3] | (v[2] << 16); w.y = v[1] | (v[0] << 16); *(u32x2*)(fch + i0) = w;
          }
        }
      }
    }
    if (sub == 0) {
      const int c = cch * 64 + lane, o = dir * 1024 + c;
#pragma unroll 1
      for (int set = 0; set < 2; ++set) {
        const int L = set ? 2048 : 256, row0 = set ? 256 : 0;
        bf16_t* fch = FILT + ((size_t)(j * 1024 + c)) * FILT_CH + (set ? 528 : 0) + L + 8;
        if (!dir) {
          const float* h0r = HD + ((size_t)j * 2304 + row0) * 64;
          float a = p.hy_b3[j * 2048 + o];
#pragma unroll 8
          for (int m = 0; m < 64; ++m) a += h0r[m] * w3s[m * 64 + lane];
          fch[0] = (bf16_t)f2bf_(a + p.hy_skip[j * D + c]);
        } else {
          *(u32x4*)(fch + L) = (u32x4){0u, 0u, 0u, 0u};
        }
      }
    }
  }
#endif
}
constexpr int FKG = 144;
constexpr int FK_S = 0, FK_P = 74240, VBS = FK_P + 66 * FKG, VBP = VBS + 2 * 8704, VB_END = VBP + 16 * 1664, E_OFF = VB_END, SCR_S = 0, SCR_SL = 32 * 36 * 4, SCR_P = 16 * SCR_SL;
__device__ __forceinline__ float conv3e(float pv, float cur, float nx, float w0, float w1, float w2, float b) { return pv * w0 + cur * w1 + nx * w2 + b; }

__device__ __forceinline__ void phase_hy_conv(const LAS PG& p, unsigned char* ws, LAS unsigned char* lds, int j, int tid, int lane, int wave, int bid, int G) {
  const bf16_t* UT = (const bf16_t*)(ws + M_UT);
  bf16_t* GT = (bf16_t*)(ws + M_GB);
  const bf16_t* FILT = (const bf16_t*)(ws + M_FILT);
  const int r = lane & 31, h = lane >> 5, rho = (-r) & 7;
  u32x4 fX0[2], fX1[2], fXV[2], fXZ[2]; unsigned fP[2][3], fN[2][3]; u32x4 fLo[2], fHi[2];
#define HC_FETCH(CH) do { const int c_ = (CH); \
    _Pragma("unroll") for (int u_ = 0; u_ < 2; ++u_) { const int tok_ = (tid + 512 * u_) * 8; \
      const int l_ = (tok_ < NPT) ? (tok_ & 255) : ((tok_ - NPT) & 2047); const int L_ = (tok_ < NPT) ? 256 : 2048; \
      const bf16_t* r0_ = UT + (size_t)c_ * 8192 + tok_; const bf16_t* r1_ = r0_ + (size_t)1024 * 8192; const bf16_t* r2_ = r0_ + (size_t)2048 * 8192; const bf16_t* r3_ = r0_ + (size_t)3072 * 8192; \
      fX0[u_] = *(const u32x4*)r0_; fX1[u_] = *(const u32x4*)r1_; fXV[u_] = *(const u32x4*)r2_; fXZ[u_] = *(const u32x4*)r3_; \
      const bool hp_ = l_ > 0, hn_ = (l_ + 8) < L_; \
      fP[u_][0] = hp_ ? (unsigned)r0_[-1] : 0u; fP[u_][1] = hp_ ? (unsigned)r1_[-1] : 0u; fP[u_][2] = hp_ ? (unsigned)r2_[-1] : 0u; \
      fN[u_][0] = hn_ ? (unsigned)r0_[8] : 0u; fN[u_][1] = hn_ ? (unsigned)r1_[8] : 0u; fN[u_][2] = hn_ ? (unsigned)r2_[8] : 0u; } \
    const bf16_t* Rc_ = FILT + ((size_t)(j * 1024 + c_)) * FILT_CH; \
    _Pragma("unroll") for (int u_ = 0; u_ < 2; ++u_) { const int gi_ = tid + 512 * u_; fLo[u_] = (u32x4){0u, 0u, 0u, 0u}; fHi[u_] = fLo[u_]; \
      if (gi_ < 515 + 66) { const bool smp_ = gi_ < 515; const int gq_ = smp_ ? gi_ : gi_ - 515; const int LEN_ = smp_ ? 4112 : 528; const bf16_t* Rg_ = Rc_ + (smp_ ? 528 : 0); const int idx0_ = 8 * gq_ + 8; \
        if (idx0_ + 8 <= LEN_) fLo[u_] = *(const u32x4*)(Rg_ + idx0_); if (idx0_ + 16 <= LEN_) fHi[u_] = *(const u32x4*)(Rg_ + idx0_ + 8); } } } while (0)
  if (bid < 1024) HC_FETCH(bid);
  static_assert(515 * FKG <= FK_P && E_OFF + 8192 * 4 <= PTAB_OFF && (VBS % 16) == 0, "conv LDS map");
  static_assert(SCR_P + 8 * SCR_SL <= E_OFF, "conv scratch overlaps the epilogue factors");
  for (int c = bid; c < 1024; c += G) {
    __syncthreads();
    for (int i = tid; i < (VB_END - VBS) / 16; i += 512) *(LAS u32x4*)(lds + VBS + i * 16) = (u32x4){0u, 0u, 0u, 0u};
    __syncthreads();
    {
      const GASF* cw = p.hy_conv_w + (size_t)j * 3 * 3072; const GASF* cb = p.hy_conv_b + (size_t)j * 3072;
      const float a0 = cw[c], a1 = cw[3072 + c], a2 = cw[6144 + c], ab = cb[c];
      const float b0 = cw[1024 + c], b1 = cw[3072 + 1024 + c], b2 = cw[6144 + 1024 + c], bb = cb[1024 + c];
      const float v0 = cw[2048 + c], v1 = cw[3072 + 2048 + c], v2 = cw[6144 + 2048 + c], vbb = cb[2048 + c];
#pragma unroll
      for (int u = 0; u < 2; ++u) {
        const int tok = (tid + 512 * u) * 8;
        unsigned dst;
        if (tok < NPT) { const int l = tok & 255; const int chunk = 32 + (l >> 3); dst = VBP + (tok >> 8) * 1664 + (chunk + (chunk >> 4)) * 16; }
        else { const int mm = tok - NPT; const int l = mm & 2047; const int chunk = 128 + (l >> 3); dst = VBS + (mm >> 11) * 8704 + (chunk + (chunk >> 4)) * 16; }
        const u32x4 X0 = fX0[u], X1 = fX1[u], XV = fXV[u], XZ = fXZ[u];
        float x0[10], x1[10], xv[10], z[8];
        x0[0] = bf2f(fP[u][0]); x1[0] = bf2f(fP[u][1]); xv[0] = bf2f(fP[u][2]); x0[9] = bf2f(fN[u][0]); x1[9] = bf2f(fN[u][1]); xv[9] = bf2f(fN[u][2]);
#pragma unroll
        for (int e = 0; e < 4; ++e) {
          x0[1 + 2 * e] = bf2f(X0[e] & 0xffffu); x0[2 + 2 * e] = bf2f(X0[e] >> 16);
          x1[1 + 2 * e] = bf2f(X1[e] & 0xffffu); x1[2 + 2 * e] = bf2f(X1[e] >> 16);
          xv[1 + 2 * e] = bf2f(XV[e] & 0xffffu); xv[2 + 2 * e] = bf2f(XV[e] >> 16);
          z[2 * e] = bf2f(XZ[e] & 0xffffu); z[2 * e + 1] = bf2f(XZ[e] >> 16);
        }
        float vv[8], ev[8];
#pragma unroll
        for (int e = 0; e < 8; ++e) {
          const float c0 = conv3e(x0[e], x0[e + 1], x0[e + 2], a0, a1, a2, ab);
          const float c1 = conv3e(x1[e], x1[e + 1], x1[e + 2], b0, b1, b2, bb);
          const float cv = conv3e(xv[e], xv[e + 1], xv[e + 2], v0, v1, v2, vbb);
          vv[e] = cv * c1; ev[e] = c0 * (z[e] * __builtin_amdgcn_rcpf(1.f + __expf(-z[e])));
        }
        u32x4 o; o.x = pk2_(vv[0], vv[1]); o.y = pk2_(vv[2], vv[3]); o.z = pk2_(vv[4], vv[5]); o.w = pk2_(vv[6], vv[7]);
        *(LAS u32x4*)(lds + dst) = o;
        *(LAS f32x4*)(lds + E_OFF + tok * 4) = (f32x4){ev[0], ev[1], ev[2], ev[3]};
        *(LAS f32x4*)(lds + E_OFF + tok * 4 + 16) = (f32x4){ev[4], ev[5], ev[6], ev[7]};
      }
#pragma unroll
      for (int u = 0; u < 2; ++u) {
        const int gi = tid + 512 * u;
        if (gi < 515 + 66) {
          const bool smp = gi < 515; const int gq = smp ? gi : gi - 515;
          const u32x4 lo = fLo[u], hi = fHi[u];
          const unsigned d0 = lo.x, d1 = lo.y, d2 = lo.z, d3 = lo.w, d4 = hi.x, d5 = hi.y, d6 = hi.z, d7 = hi.w;
          LAS unsigned char* dstp = lds + (smp ? FK_S : FK_P) + gq * FKG;
#define AB(hi_, lo_) __builtin_amdgcn_alignbit(hi_, lo_, 16)
          *(LAS u32x4*)(dstp + 0) = (u32x4){d0, d1, d2, d3};
          *(LAS u32x4*)(dstp + 16) = (u32x4){AB(d1, d0), AB(d2, d1), AB(d3, d2), AB(d4, d3)};
          *(LAS u32x4*)(dstp + 32) = (u32x4){d1, d2, d3, d4};
          *(LAS u32x4*)(dstp + 48) = (u32x4){AB(d2, d1), AB(d3, d2), AB(d4, d3), AB(d5, d4)};
          *(LAS u32x4*)(dstp + 64) = (u32x4){d2, d3, d4, d5};
          *(LAS u32x4*)(dstp + 80) = (u32x4){AB(d3, d2), AB(d4, d3), AB(d5, d4), AB(d6, d5)};
          *(LAS u32x4*)(dstp + 96) = (u32x4){d3, d4, d5, d6};
          *(LAS u32x4*)(dstp + 112) = (u32x4){AB(d4, d3), AB(d5, d4), AB(d6, d5), AB(d7, d6)};
#undef AB
        }
      }
    }
    __syncthreads();
    if (c + G < 1024) HC_FETCH(c + G);
    f32x16 s0, s1, pr;
#pragma unroll
    for (int i = 0; i < 16; ++i) { s0[i] = 0.f; s1[i] = 0.f; pr[i] = 0.f; }
    {
      const int ahalf = wave & 1, dq = wave >> 1;
      const int a = ahalf * 32 + r;
      const int n0 = (ahalf ? -64 : -128) + 48 * dq, cnt = (dq == 3) ? 47 : 48;
      for (int s = 0; s < cnt; ++s) {
        const int n = n0 + s;
        const int e0 = 8 * h - r - 16 * n; const int q = (e0 - rho) >> 3;
        const bf16x8 af = *(LAS const bf16x8*)(lds + FK_S + (q + 256) * FKG + rho * 16);
        const int qb = 128 + h + 4 * a - 2 * n; const int pb = qb + (qb >> 4);
        const bf16x8 b0 = *(LAS const bf16x8*)(lds + VBS + pb * 16);
        const bf16x8 b1 = *(LAS const bf16x8*)(lds + VBS + 8704 + pb * 16);
        s0 = __builtin_amdgcn_mfma_f32_32x32x16_bf16(af, b0, s0, 0, 0, 0);
        s1 = __builtin_amdgcn_mfma_f32_32x32x16_bf16(af, b1, s1, 0, 0, 0);
      }
    }
    {
      const int ntile = wave & 3, dh = wave >> 2;
      const int batch = 4 * ntile + (r >> 3), a = r & 7;
      const int n0 = dh ? 0 : -16, cnt = dh ? 15 : 16;
      for (int s = 0; s < cnt; ++s) {
        const int n = n0 + s;
        const int e0 = 8 * h - r - 16 * n; const int q = (e0 - rho) >> 3;
        const bf16x8 af = *(LAS const bf16x8*)(lds + FK_P + (q + 32) * FKG + rho * 16);
        const int qb = 32 + h + 4 * a - 2 * n; const int pb = qb + (qb >> 4);
        const bf16x8 b0 = *(LAS const bf16x8*)(lds + VBP + batch * 1664 + pb * 16);
        pr = __builtin_amdgcn_mfma_f32_32x32x16_bf16(af, b0, pr, 0, 0, 0);
      }
    }
    __syncthreads();
    {
      const int ahalf = wave & 1, dq = wave >> 1;
#pragma unroll
      for (int g = 0; g < 4; ++g) {
        const int off = (r * 36 + 8 * g + 4 * h) * 4;
        *(LAS f32x4*)(lds + SCR_S + ((ahalf * 2 + 0) * 4 + dq) * SCR_SL + off) = (f32x4){s0[4 * g], s0[4 * g + 1], s0[4 * g + 2], s0[4 * g + 3]};
        *(LAS f32x4*)(lds + SCR_S + ((ahalf * 2 + 1) * 4 + dq) * SCR_SL + off) = (f32x4){s1[4 * g], s1[4 * g + 1], s1[4 * g + 2], s1[4 * g + 3]};
        *(LAS f32x4*)(lds + SCR_P + ((wave & 3) * 2 + (wave >> 2)) * SCR_SL + off) = (f32x4){pr[4 * g], pr[4 * g + 1], pr[4 * g + 2], pr[4 * g + 3]};
      }
    }
    __syncthreads();
    {
      {
        const int o = tid * 8; const int b = o >> 11, t = o & 2047; const int a = t >> 5, rr = t & 31; const int tile = (a >> 5) * 2 + b, col = a & 31;
        f32x4 y0 = (f32x4){0.f, 0.f, 0.f, 0.f}, y1 = y0;
#pragma unroll
        for (int dq = 0; dq < 4; ++dq) {
          LAS const unsigned char* sp = lds + SCR_S + (tile * 4 + dq) * SCR_SL + (col * 36 + rr) * 4;
          y0 += *(LAS const f32x4*)sp; y1 += *(LAS const f32x4*)(sp + 16);
        }
        const int token = NPT + o;
        const f32x4 e0 = *(LAS const f32x4*)(lds + E_OFF + token * 4), e1 = *(LAS const f32x4*)(lds + E_OFF + token * 4 + 16);
        u32x4 ov; ov.x = pk2_(y0.x * e0.x, y0.y * e0.y); ov.y = pk2_(y0.z * e0.z, y0.w * e0.w); ov.z = pk2_(y1.x * e1.x, y1.y * e1.y); ov.w = pk2_(y1.z * e1.z, y1.w * e1.w);
        *(u32x4*)(GT + (size_t)c * 8192 + token) = ov;
      }
      {
        const int o = tid * 8; const int batch = o >> 8, t = o & 255; const int ntile = batch >> 2, col = (batch & 3) * 8 + (t >> 5), rr = t & 31;
        f32x4 y0 = (f32x4){0.f, 0.f, 0.f, 0.f}, y1 = y0;
#pragma unroll
        for (int dh = 0; dh < 2; ++dh) {
          LAS const unsigned char* sp = lds + SCR_P + (ntile * 2 + dh) * SCR_SL + (col * 36 + rr) * 4;
          y0 += *(LAS const f32x4*)sp; y1 += *(LAS const f32x4*)(sp + 16);
        }
        const int token = o;
        const f32x4 e0 = *(LAS const f32x4*)(lds + E_OFF + token * 4), e1 = *(LAS const f32x4*)(lds + E_OFF + token * 4 + 16);
        u32x4 ov; ov.x = pk2_(y0.x * e0.x, y0.y * e0.y); ov.y = pk2_(y0.z * e0.z, y0.w * e0.w); ov.z = pk2_(y1.x * e1.x, y1.y * e1.y); ov.w = pk2_(y1.z * e1.z, y1.w * e1.w);
        *(u32x4*)(GT + (size_t)c * 8192 + token) = ov;
      }
    }
  }
}

template <int MODE>
__device__ __forceinline__ void phase_out_ln(const LAS PG& p, unsigned char* ws, LAS unsigned char* lds, int layer, const bf16_t* Wf, int tid, int lane, int wave, int bid, int G) {
  const bf16_t* GA = (const bf16_t*)(ws + M_GB);
  const float* MODS = (const float*)(ws + M_MODS);
  const int h = lane >> 5;
  for (int tile = bid; tile < NTOK / 32; tile += G) {
    const int t0 = tile * 32;
    __syncthreads();
    constexpr bool CHM = (MODE == 1);
    if (MODE == 2) {
      const float* BON = (const float*)(ws + M_GB + 8 * MiB);
      const int sub = lane >> 4, c4 = lane & 15;
#pragma unroll 2
      for (int it = 0; it < 16; ++it) {
        const int pr = wave * 64 + it * 4 + sub; const int tok = pr >> 4, hd = pr & 15, m = t0 + tok;
        const unsigned gi = (unsigned)m * (unsigned)D + (unsigned)(hd * 64 + 4 * c4);
        const f32x4 y = *(const f32x4*)((const float*)(ws + M_UT) + gi) + *(const f32x4*)((const float*)(ws + M_UT + 32 * MiB) + gi);
        float s1 = (y.x + y.y) + (y.z + y.w);
        s1 += __builtin_bit_cast(float, __builtin_amdgcn_update_dpp(0, __builtin_bit_cast(int, s1), 0xB1, 0xF, 0xF, true));
        s1 += __builtin_bit_cast(float, __builtin_amdgcn_update_dpp(0, __builtin_bit_cast(int, s1), 0x4E, 0xF, 0xF, true));
        s1 += __builtin_bit_cast(float, __builtin_amdgcn_update_dpp(0, __builtin_bit_cast(int, s1), 0x141, 0xF, 0xF, true));
        s1 += __builtin_bit_cast(float, __builtin_amdgcn_update_dpp(0, __builtin_bit_cast(int, s1), 0x140, 0xF, 0xF, true));
        const float mu = s1 * (1.f / 64.f);
        const f32x4 d = y - mu;
        float s2 = (d.x * d.x + d.y * d.y) + (d.z * d.z + d.w * d.w);
        s2 += __builtin_bit_cast(float, __builtin_amdgcn_update_dpp(0, __builtin_bit_cast(int, s2), 0xB1, 0xF, 0xF, true));
        s2 += __builtin_bit_cast(float, __builtin_amdgcn_update_dpp(0, __builtin_bit_cast(int, s2), 0x4E, 0xF, 0xF, true));
        s2 += __builtin_bit_cast(float, __builtin_amdgcn_update_dpp(0, __builtin_bit_cast(int, s2), 0x141, 0xF, 0xF, true));
        s2 += __builtin_bit_cast(float, __builtin_amdgcn_update_dpp(0, __builtin_bit_cast(int, s2), 0x140, 0xF, 0xF, true));
        const float rstd = rsqrtf(s2 * (1.f / 64.f) + GN_EPS);
        const f32x4 bo0 = *(const f32x4*)(BON + ((unsigned)m * 16u + (unsigned)hd) * 4u), bo1 = *(const f32x4*)(BON + (((unsigned)NTOK + (unsigned)m) * 16u + (unsigned)hd) * 4u);
        const float bon = ((bo0.x + bo0.y) + (bo0.z + bo0.w)) + ((bo1.x + bo1.y) + (bo1.z + bo1.w));
        const u32x2 v2 = *(const u32x2*)((const bf16_t*)(ws + M_SCR2 + 32 * MiB) + gi), z2 = *(const u32x2*)((const bf16_t*)(ws + M_SCR2 + 48 * MiB) + gi);
        const f32x4 gg = *(const GAS f32x4*)(p.rw_gn_g + hd * 64 + 4 * c4), gb = *(const GAS f32x4*)(p.rw_gn_b + hd * 64 + 4 * c4);
        const f32x4 yn = d * rstd * gg + gb;
        u32x2 o;
        o.x = pk2_((yn.x + bon * bf2f(v2.x & 0xffffu)) * bf2f(z2.x & 0xffffu), (yn.y + bon * bf2f(v2.x >> 16)) * bf2f(z2.x >> 16));
        o.y = pk2_((yn.z + bon * bf2f(v2.y & 0xffffu)) * bf2f(z2.y & 0xffffu), (yn.w + bon * bf2f(v2.y >> 16)) * bf2f(z2.y >> 16));
        *(LAS u32x2*)(lds + ((hd * 8 + (c4 >> 1)) * 32 + tok) * 16 + (c4 & 1) * 8) = o;
      }
    } else {
#pragma unroll
    for (int i = 0; i < 8; ++i) {
      const int idx = tid + 512 * i;
      if (CHM) { const int c = idx >> 2, part = idx & 3; *(LAS u32x4*)(lds + c * 64 + part * 16) = *(const u32x4*)(GA + (size_t)c * 8192 + t0 + 8 * part); }
      else { const int tok = idx >> 7, k8 = idx & 127; *(LAS u32x4*)(lds + (k8 * 32 + tok) * 16) = *(const u32x4*)(GA + (size_t)(t0 + tok) * D + 8 * k8); }
    }
    }
    __syncthreads();
    f32x16 acc[4];
#pragma unroll
    for (int nt = 0; nt < 4; ++nt)
#pragma unroll
      for (int i = 0; i < 16; ++i) acc[nt][i] = 0.f;
    const bf16_t* wf = Wf + ((size_t)(wave * 4) * 64 * 64 + lane) * 8;
    const int aoffT = ((h * 32) + (lane & 31)) * 16;
    const int aoffC = (8 * h + ((lane & 15) >> 2)) * 64 + 32 * ((lane >> 4) & 1) + 8 * (lane & 3);
#pragma unroll 4
    for (int ks = 0; ks < 64; ++ks) {
      bf16x8 af;
      if (CHM) {
        const v4i16_t lo = vtr(lds + aoffC + ks * 1024), hi = vtr(lds + aoffC + ks * 1024 + 256);
        af = (bf16x8){lo[0], lo[1], lo[2], lo[3], hi[0], hi[1], hi[2], hi[3]};
      } else {
        af = *(LAS const bf16x8*)(lds + aoffT + ks * 1024);
      }
#pragma unroll
      for (int nt = 0; nt < 4; ++nt) {
        const bf16x8 bfr = *(const bf16x8*)(wf + ((size_t)(nt * 64 + ks) * 64) * 8);
        acc[nt] = __builtin_amdgcn_mfma_f32_32x32x16_bf16(af, bfr, acc[nt], 0, 0, 0);
      }
    }
    __syncthreads();
#pragma unroll
    for (int nt = 0; nt < 4; ++nt)
#pragma unroll
      for (int i = 0; i < 16; ++i) {
        const int row = (i & 3) + 8 * (i >> 2) + 4 * h;
        *(LAS float*)(lds + (row * 1028 + (wave * 4 + nt) * 32 + (lane & 31)) * 4) = acc[nt][i];
      }
    __syncthreads();
#pragma unroll 1
    for (int i = 0; i < 4; ++i) {
      const int row = wave * 4 + i, m = t0 + row;
      int l, L, cond, m0; tokinfo(m, l, L, cond, m0);
      const float* gate = MODS + (size_t)(layer * 3 + cond) * 3072 + 2048;
      const GAS f32x4* xr = (const GAS f32x4*)xrow_in(p, layer, ws, m);
      f32x4 v[4]; float s = 0.f;
#pragma unroll
      for (int q = 0; q < 4; ++q) {
        const int k = 4 * lane + 256 * q;
        const f32x4 o = *(LAS const f32x4*)(lds + (row * 1028 + k) * 4);
        const f32x4 x = xr[lane + 64 * q]; const f32x4 g = *(const f32x4*)(gate + k);
        v[q] = ALPHA * x + g * o; s += (v[q].x + v[q].y) + (v[q].z + v[q].w);
      }
      const float mu = wsum(s) * (1.f / D); float qq = 0.f;
#pragma unroll
      for (int q = 0; q < 4; ++q) { v[q] = v[q] - mu; qq += (v[q].x * v[q].x + v[q].y * v[q].y) + (v[q].z * v[q].z + v[q].w * v[q].w); }
      const float rs = rsqrtf(wsum(qq) * (1.f / D) + LN_EPS);
      GASF* xo = (layer & 1) ? p.out + OUT_Y + (size_t)m * D : (GASF*)(ws + M_X) + (size_t)m * D;
      const float* nmod = MODS + (size_t)((layer + 1) * 3 + cond) * 3072;
      bf16_t* HB = (bf16_t*)(ws + M_HB) + (size_t)m * D;
#pragma unroll
      for (int q = 0; q < 4; ++q) {
        const int k = 4 * lane + 256 * q;
        const f32x4 lg = *(const f32x4*)(p.ln_g + layer * D + k), lb = *(const f32x4*)(p.ln_b + layer * D + k);
        const f32x4 y = v[q] * rs * lg + lb;
        *(GAS f32x4*)(xo + k) = y;
        if (layer < 3) {
          const f32x4 sh = *(const f32x4*)(nmod + k), sc = *(const f32x4*)(nmod + 1024 + k);
          u32x2 o; o.x = pk2_(y.x * (1.f + sc.x) + sh.x, y.y * (1.f + sc.y) + sh.y); o.y = pk2_(y.z * (1.f + sc.z) + sh.z, y.w * (1.f + sc.w) + sh.w);
          *(u32x2*)(HB + k) = o;
        }
      }
    }
  }
}

__device__ __forceinline__ int kvrow_(int m) { if (m < NPT) return m; const int mm = m - NPT; return NPT + (mm >> 11) * 2560 + PAST + (mm & 2047); }

struct EpiSilu {
  static constexpr bool PERM = true, AFTER_DRAIN = false;
  bf16_t* O; int ldc;
  __device__ __forceinline__ void operator()(const f32x4 (&acc)[2][2][4][2], const pg8::Unit& u, int wr, int wc, int fr, int fq) const {
    const int row0 = u.pm * 256 + wr * 64 + fr, col0 = u.pn * 256 + wc * 32 + 8 * fq;
#pragma unroll
    for (int ai = 0; ai < 2; ++ai)
#pragma unroll
      for (int m = 0; m < 4; ++m) {
        bf16_t* rowp = O + (size_t)(row0 + ai * 128 + m * 16) * ldc + col0;
#pragma unroll
        for (int bj = 0; bj < 2; ++bj) {
          const f32x4 v0 = acc[ai][bj][m][0], v1 = acc[ai][bj][m][1];
          u32x4 w; w.x = pk2_(silu(v0[0]), silu(v0[1])); w.y = pk2_(silu(v0[2]), silu(v0[3])); w.z = pk2_(silu(v1[0]), silu(v1[1])); w.w = pk2_(silu(v1[2]), silu(v1[3]));
          *(u32x4*)(rowp + bj * 128) = w;
        }
      }
  }
};
struct EpiF32 {
  static constexpr bool PERM = true, AFTER_DRAIN = false;
  float* O; int ldc;
  __device__ __forceinline__ void operator()(const f32x4 (&acc)[2][2][4][2], const pg8::Unit& u, int wr, int wc, int fr, int fq) const {
    const int row0 = u.pm * 256 + wr * 64 + fr, col0 = u.pn * 256 + wc * 32 + 8 * fq;
#pragma unroll
    for (int ai = 0; ai < 2; ++ai)
#pragma unroll
      for (int m = 0; m < 4; ++m) {
        float* rowp = O + (size_t)(row0 + ai * 128 + m * 16) * ldc + col0;
#pragma unroll
        for (int bj = 0; bj < 2; ++bj) { *(f32x4*)(rowp + bj * 128) = acc[ai][bj][m][0]; *(f32x4*)(rowp + bj * 128 + 4) = acc[ai][bj][m][1]; }
      }
  }
};
struct EpiKV {
  static constexpr bool PERM = true, AFTER_DRAIN = false;
  bf16_t* Kn; bf16_t* V;
  __device__ __forceinline__ void operator()(const f32x4 (&acc)[2][2][4][2], const pg8::Unit& u, int wr, int wc, int fr, int fq) const {
    const int row0 = u.pm * 256 + wr * 64 + fr;
    const int d = wc * 32 + 8 * fq;
    bf16_t* base = (d < 64 ? Kn : V) + (d & 63);
#pragma unroll
    for (int ai = 0; ai < 2; ++ai)
#pragma unroll
      for (int m = 0; m < 4; ++m) {
        const size_t row = (size_t)(row0 + ai * 128 + m * 16);
#pragma unroll
        for (int bj = 0; bj < 2; ++bj) {
          const int h = u.pn * 2 + bj;
          const f32x4 v0 = acc[ai][bj][m][0], v1 = acc[ai][bj][m][1];
          u32x4 w; w.x = pg8::cvt_pk_bf16(v0[0], v0[1]); w.y = pg8::cvt_pk_bf16(v0[2], v0[3]); w.z = pg8::cvt_pk_bf16(v1[0], v1[1]); w.w = pg8::cvt_pk_bf16(v1[2], v1[3]);
          *(u32x4*)(base + row * 1024 + h * 64) = w;
        }
      }
  }
};

__device__ __forceinline__ void phase_mla_rows(const LAS PG& p, unsigned char* ws, int lane, int wave, int bid, int G) {
  const float* U2S = (const float*)(ws + M_U2S);
  for (int m = bid * 8 + wave; m < NTOK; m += G * 8) {
    int l, L, cond, m0; tokinfo(m, l, L, cond, m0);
    const float* rb = U2S + (size_t)m * 512;
    const f32x4 q = *(const f32x4*)(rb + 4 * lane);
    const float rs = rsqrtf(wsum(q.x * q.x + q.y * q.y + q.z * q.z + q.w * q.w) * (1.f / 256.f) + RMS_EPS);
    const f32x4 g = *(const GAS f32x4*)(p.mla_q_norm + 4 * lane);
    u32x2 qo; qo.x = pk2_(q.x * rs * g.x, q.y * rs * g.y); qo.y = pk2_(q.z * rs * g.z, q.w * rs * g.w);
    *(u32x2*)((bf16_t*)(ws + M_QN) + (size_t)m * 256 + 4 * lane) = qo;
    const float k0 = rb[256 + 2 * lane], k1 = rb[256 + 2 * lane + 1];
    const float rs2 = rsqrtf(wsum(k0 * k0 + k1 * k1) * (1.f / 128.f) + RMS_EPS);
    const float c0 = k0 * rs2 * p.mla_kv_norm[2 * lane], c1 = k1 * rs2 * p.mla_kv_norm[2 * lane + 1];
    const int kr = kvrow_(m);
    *(unsigned*)((bf16_t*)(ws + M_CKVALL) + (size_t)kr * 128 + 2 * lane) = pk2_(c0, c1);
    if (m < NPT) { p.out[OUT_CKV + (size_t)m * 128 + 2 * lane] = c0; p.out[OUT_CKV + (size_t)m * 128 + 2 * lane + 1] = c1; }
    const float x = rb[384 + (lane & 31)];
    const float partner = __shfl_xor(x, 8);
    float o = x;
    if (m >= NPT) {
      const int d = lane & 31, jj = d & 7;
      const float inv = exp2f(-(float)(2 * jj) * (13.287712379549449f / 16.f));
      const float pos = (d < 16) ? (float)(l >> 6) : (float)(l & 63);
      const float ang = pos * inv; const float cs = cosf(ang), sn = sinf(ang);
      o = (d & 8) ? x * cs + partner * sn : x * cs - partner * sn;
    }
    if (lane < 32) {
      ((bf16_t*)(ws + M_KPEB))[(size_t)kr * 32 + lane] = (bf16_t)f2bf_(o);
      if (m < NPT) p.out[OUT_KPE + (size_t)m * 32 + lane] = x;
    }
  }
}

constexpr int AT_KB = 12288, AT_VB = 8192, AT_BUF = AT_KB + AT_VB, AT_WS = 2 * AT_BUF, AT_ST = AT_WS + 8 * 256;
__device__ __forceinline__ int crow_(int r, int hi) { return (r & 3) + 8 * (r >> 2) + 4 * hi; }
__device__ __forceinline__ unsigned cvtpk(float lo, float hi) { return pk2_(lo, hi); }

__device__ __forceinline__ void attn_unit(const unsigned char* ws, LAS unsigned char* lds, int seq, int hd, int qb, bf16_t* Gout, int tid, int lane, int wave) {
  const bf16_t* Q = (const bf16_t*)(ws + M_Q); const bf16_t* Kn = (const bf16_t*)(ws + M_KN); const bf16_t* Vv = (const bf16_t*)(ws + M_V);
  const bf16_t* KP = (const bf16_t*)(ws + M_KPEB); const bf16_t* SZ = (const bf16_t*)(ws + M_SZB);
  const int r32 = lane & 31, hi = lane >> 5;
  const bool smp = seq >= 16;
  const int mq0 = smp ? NPT + (seq - 16) * 2048 + qb * 256 : seq * 256;
  const int kbase = smp ? NPT + (seq - 16) * 2560 : seq * 256;
  const int NT = smp ? 40 : 4;
  const float C2 = 0.10206207261596575f * 1.4426950408889634f;
  bf16x8 qr[6];
  {
    const int m = mq0 + wave * 32 + r32;
    const bf16_t* qp = Q + (size_t)m * 1536 + hd * 96;
    const int l = smp ? ((m - NPT) & 2047) : 0;
#pragma unroll
    for (int d0 = 0; d0 < 6; ++d0) {
      const u32x4 own = *(const u32x4*)(qp + 16 * d0 + 8 * hi);
      float f[8];
#pragma unroll
      for (int e = 0; e < 4; ++e) { f[2 * e] = bf2f(own[e] & 0xffffu); f[2 * e + 1] = bf2f(own[e] >> 16); }
      if (d0 >= 4 && smp) {
        const u32x4 oth = *(const u32x4*)(qp + 16 * d0 + 8 * (1 - hi));
        const float pos = (d0 == 4) ? (float)(l >> 6) : (float)(l & 63);
#pragma unroll
        for (int e = 0; e < 8; ++e) {
          const float pf = bf2f((e & 1) ? (oth[e >> 1] >> 16) : (oth[e >> 1] & 0xffffu));
          const float inv = exp2f(-(float)(2 * e) * (13.287712379549449f / 16.f));
          const float ang = pos * inv; const float cs = cosf(ang), sn = sinf(ang);
          f[e] = hi ? f[e] * cs + pf * sn : f[e] * cs - pf * sn;
        }
      }
      u32x4 o; o.x = pk2_(f[0] * C2, f[1] * C2); o.y = pk2_(f[2] * C2, f[3] * C2); o.z = pk2_(f[4] * C2, f[5] * C2); o.w = pk2_(f[6] * C2, f[7] * C2);
      qr[d0] = __builtin_bit_cast(bf16x8, o);
    }
  }
  const bf16_t* vsrc = Vv + (size_t)(kbase + 16 * (wave & 3) + (lane >> 2)) * 1024 + hd * 64 + (wave >> 2) * 32 + (lane & 3) * 8;
  const int kc0 = tid >> 6, key0 = tid & 63;
  const bf16_t* ksrc0 = Kn + (size_t)(kbase + key0) * 1024 + hd * 64 + 8 * kc0;
  const bool k2 = tid < 256;
  const bf16_t* ksrc1 = KP + (size_t)(kbase + key0) * 32 + 8 * (tid >> 6);
  u32x4 rv, rk0, rk1 = (u32x4){0u, 0u, 0u, 0u};
#define AT_LOAD(t) do { rv = *(const u32x4*)(vsrc + (size_t)(t) * 64 * 1024); rk0 = *(const u32x4*)(ksrc0 + (size_t)(t) * 64 * 1024); if (k2) rk1 = *(const u32x4*)(ksrc1 + (size_t)(t) * 64 * 32); } while (0)
#define AT_STORE(b) do { LAS unsigned char* bb = lds + (b) * AT_BUF; *(LAS u32x4*)(bb + tid * 16) = rk0; if (k2) *(LAS u32x4*)(bb + 8192 + tid * 16) = rk1; *(LAS u32x4*)(bb + AT_KB + tid * 16) = rv; } while (0)
  __syncthreads();
  AT_LOAD(0); AT_STORE(0);
  __syncthreads();
  LAS float* wsf = (LAS float*)(lds + AT_WS + wave * 256);
  f32x16 o0, o1;
#pragma unroll
  for (int i = 0; i < 16; ++i) { o0[i] = 0.f; o1[i] = 0.f; }
  float mref = 0.f, lrun = 0.f;
  f32x16 negm;
#pragma unroll
  for (int i = 0; i < 16; ++i) negm[i] = 0.f;
  const int vboff = ((lane >> 4) & 1) * 32 + (lane & 3) * 8 + (4 * hi + ((lane & 15) >> 2)) * 64;
  for (int t = 0; t < NT; ++t) {
    const int cur = t & 1;
    if (t + 1 < NT) AT_LOAD(t + 1);
    LAS const unsigned char* kb = lds + cur * AT_BUF + hi * 1024 + r32 * 16;
    f32x16 p0 = negm, p1 = negm;
#pragma unroll
    for (int d0 = 0; d0 < 6; ++d0) {
      const bf16x8 a0 = *(LAS const bf16x8*)(kb + d0 * 2048), a1 = *(LAS const bf16x8*)(kb + d0 * 2048 + 512);
      p0 = __builtin_amdgcn_mfma_f32_32x32x16_bf16(a0, qr[d0], p0, 0, 0, 0);
      p1 = __builtin_amdgcn_mfma_f32_32x32x16_bf16(a1, qr[d0], p1, 0, 0, 0);
    }
    float rm = fmaxf(fmaxf(p0[0], p0[1]), fmaxf(p1[0], p1[1]));
#pragma unroll
    for (int i = 2; i < 16; i += 2) rm = fmaxf(rm, fmaxf(fmaxf(p0[i], p0[i + 1]), fmaxf(p1[i], p1[i + 1])));
    rm = fmaxf(rm, __shfl_xor(rm, 32));
    if (t == 0 || __any(rm > 8.f)) {
      const float dl = (t == 0) ? rm : fmaxf(rm, 0.f);
      mref += dl;
      const float alpha = __builtin_amdgcn_exp2f(-dl);
      lrun *= alpha;
#pragma unroll
      for (int i = 0; i < 16; ++i) { p0[i] -= dl; p1[i] -= dl; negm[i] = -mref; }
      if (hi == 0) wsf[r32] = alpha;
      asm volatile("s_waitcnt lgkmcnt(0)" ::: "memory");
#pragma unroll
      for (int i = 0; i < 16; ++i) { const float al = wsf[crow_(i, hi)]; o0[i] *= al; o1[i] *= al; }
    }
    float ps0 = 0.f, ps1 = 0.f;
#pragma unroll
    for (int i = 0; i < 16; ++i) { p0[i] = __builtin_amdgcn_exp2f(p0[i]); p1[i] = __builtin_amdgcn_exp2f(p1[i]); ps0 += p0[i]; ps1 += p1[i]; }
    lrun += ps0 + ps1;
    u32x4 w0, w1, w2, w3;
    w0.x = cvtpk(p0[0], p0[1]); w0.y = cvtpk(p0[2], p0[3]); w0.z = cvtpk(p0[4], p0[5]); w0.w = cvtpk(p0[6], p0[7]);
    w1.x = cvtpk(p0[8], p0[9]); w1.y = cvtpk(p0[10], p0[11]); w1.z = cvtpk(p0[12], p0[13]); w1.w = cvtpk(p0[14], p0[15]);
    w2.x = cvtpk(p1[0], p1[1]); w2.y = cvtpk(p1[2], p1[3]); w2.z = cvtpk(p1[4], p1[5]); w2.w = cvtpk(p1[6], p1[7]);
    w3.x = cvtpk(p1[8], p1[9]); w3.y = cvtpk(p1[10], p1[11]); w3.z = cvtpk(p1[12], p1[13]); w3.w = cvtpk(p1[14], p1[15]);
    const bf16x8 pa0 = __builtin_bit_cast(bf16x8, w0), pa1 = __builtin_bit_cast(bf16x8, w1), pa2 = __builtin_bit_cast(bf16x8, w2), pa3 = __builtin_bit_cast(bf16x8, w3);
    LAS const unsigned char* vb = lds + cur * AT_BUF + AT_KB + vboff;
#define AT_PV(O_, D0) do { \
      const v4i16_t l0 = vtr(vb + (D0) * 4096), h0 = vtr(vb + (D0) * 4096 + 512), l1 = vtr(vb + (D0) * 4096 + 1024), h1 = vtr(vb + (D0) * 4096 + 1024 + 512); \
      const v4i16_t l2 = vtr(vb + (D0) * 4096 + 2048), h2 = vtr(vb + (D0) * 4096 + 2048 + 512), l3 = vtr(vb + (D0) * 4096 + 3072), h3 = vtr(vb + (D0) * 4096 + 3072 + 512); \
      O_ = __builtin_amdgcn_mfma_f32_32x32x16_bf16(pa0, ((bf16x8){l0[0], l0[1], l0[2], l0[3], h0[0], h0[1], h0[2], h0[3]}), O_, 0, 0, 0); \
      O_ = __builtin_amdgcn_mfma_f32_32x32x16_bf16(pa1, ((bf16x8){l1[0], l1[1], l1[2], l1[3], h1[0], h1[1], h1[2], h1[3]}), O_, 0, 0, 0); \
      O_ = __builtin_amdgcn_mfma_f32_32x32x16_bf16(pa2, ((bf16x8){l2[0], l2[1], l2[2], l2[3], h2[0], h2[1], h2[2], h2[3]}), O_, 0, 0, 0); \
      O_ = __builtin_amdgcn_mfma_f32_32x32x16_bf16(pa3, ((bf16x8){l3[0], l3[1], l3[2], l3[3], h3[0], h3[1], h3[2], h3[3]}), O_, 0, 0, 0); } while (0)
    AT_PV(o0, 0); AT_PV(o1, 1);
#undef AT_PV
    if (t + 1 < NT) AT_STORE(cur ^ 1);
    __syncthreads();
  }
#undef AT_LOAD
#undef AT_STORE
  lrun += __shfl_xor(lrun, 32);
  if (hi == 0) wsf[32 + r32] = 1.f / lrun;
  asm volatile("s_waitcnt lgkmcnt(0)" ::: "memory");
  LAS bf16_t* stg = (LAS bf16_t*)(lds + AT_ST + wave * 4096);
#pragma unroll
  for (int i = 0; i < 16; ++i) {
    const int orow = crow_(i, hi); const float rl = wsf[32 + orow];
    stg[orow * 64 + r32] = (bf16_t)f2bf_(o0[i] * rl);
    stg[orow * 64 + 32 + r32] = (bf16_t)f2bf_(o1[i] * rl);
  }
  asm volatile("s_waitcnt lgkmcnt(0)" ::: "memory");
#pragma unroll
  for (int i = 0; i < 4; ++i) {
    const int row = i * 8 + (lane >> 3), ch = lane & 7;
    const u32x4 ov = *(LAS const u32x4*)(stg + row * 64 + ch * 8);
    const size_t gi = (size_t)(mq0 + wave * 32 + row) * D + hd * 64 + ch * 8;
    const u32x4 zv = *(const u32x4*)(SZ + gi);
    u32x4 res;
#pragma unroll
    for (int e = 0; e < 4; ++e) res[e] = pk2_(bf2f(ov[e] & 0xffffu) * bf2f(zv[e] & 0xffffu), bf2f(ov[e] >> 16) * bf2f(zv[e] >> 16));
    *(u32x4*)(Gout + gi) = res;
  }
}
constexpr size_t M_XMIX = M_UT;
constexpr size_t M_YF = M_UT, M_YB = M_UT + 32 * MiB;
constexpr size_t M_RB = M_SCR2, M_KB = M_SCR2 + 16 * MiB, M_VB = M_SCR2 + 32 * MiB, M_SZR = M_SCR2 + 48 * MiB;
constexpr size_t M_HWA = M_GB;
constexpr size_t M_BON = M_GB + 8 * MiB;

__device__ __forceinline__ void phase_rw_mix(const LAS PG& p, unsigned char* ws, int tid, int bid, int G) {
  const bf16_t* HB = (const bf16_t*)(ws + M_HB);
  bf16_t* XM = (bf16_t*)(ws + M_XMIX);
  for (int i = bid * 512 + tid; i < NTOK * 128; i += G * 512) {
    const int m = i >> 7, k8 = i & 127;
    int l, L, cond, m0; tokinfo(m, l, L, cond, m0);
    const u32x4 hc = *(const u32x4*)(HB + (size_t)m * D + 8 * k8);
    u32x4 hp = (u32x4){0u, 0u, 0u, 0u}, hn = hp;
    if (l > 0) hp = *(const u32x4*)(HB + (size_t)(m - 1) * D + 8 * k8);
    if (l < L - 1) hn = *(const u32x4*)(HB + (size_t)(m + 1) * D + 8 * k8);
    float h[8], d[8];
#pragma unroll
    for (int e = 0; e < 4; ++e) {
      h[2 * e] = bf2f(hc[e] & 0xffffu); h[2 * e + 1] = bf2f(hc[e] >> 16);
      d[2 * e] = 0.5f * (bf2f(hp[e] & 0xffffu) + bf2f(hn[e] & 0xffffu)) - h[2 * e];
      d[2 * e + 1] = 0.5f * (bf2f(hp[e] >> 16) + bf2f(hn[e] >> 16)) - h[2 * e + 1];
    }
#pragma unroll
    for (int q = 0; q < 4; ++q) {
      const int mi = (q == 0) ? 0 : (q == 1) ? 2 : (q == 2) ? 3 : 5;
      const f32x4 u0 = *(const f32x4*)(p.rw_mu + mi * D + 8 * k8), u1 = *(const f32x4*)(p.rw_mu + mi * D + 8 * k8 + 4);
      u32x4 o; o.x = pk2_(h[0] + d[0] * u0.x, h[1] + d[1] * u0.y); o.y = pk2_(h[2] + d[2] * u0.z, h[3] + d[3] * u0.w);
      o.z = pk2_(h[4] + d[4] * u1.x, h[5] + d[5] * u1.y); o.w = pk2_(h[6] + d[6] * u1.z, h[7] + d[7] * u1.w);
      *(u32x4*)(XM + (size_t)q * NTOK * D + (size_t)m * D + 8 * k8) = o;
    }
  }
}

__device__ __forceinline__ void rw_lora_tile(const LAS PG& p, unsigned char* ws, LAS unsigned char* lds, int tile, int tid, int lane, int wave) {
  const bf16_t* HB = (const bf16_t*)(ws + M_HB);
  const bf16_t* Wf = (const bf16_t*)(ws + W_LORA1);
  const int h = lane >> 5, t0 = tile * 32;
  __syncthreads();
#pragma unroll 2
  for (int i = 0; i < 8; ++i) {
    const int idx = tid + 512 * i; const int tok = idx >> 7, k8 = idx & 127; const int m = t0 + tok;
    int l, L, cond, m0; tokinfo(m, l, L, cond, m0);
    const u32x4 hc = *(const u32x4*)(HB + (size_t)m * D + 8 * k8);
    u32x4 hp = (u32x4){0u, 0u, 0u, 0u}, hn = hp;
    if (l > 0) hp = *(const u32x4*)(HB + (size_t)(m - 1) * D + 8 * k8);
    if (l < L - 1) hn = *(const u32x4*)(HB + (size_t)(m + 1) * D + 8 * k8);
    float hh[8], d[8];
#pragma unroll
    for (int e = 0; e < 4; ++e) {
      hh[2 * e] = bf2f(hc[e] & 0xffffu); hh[2 * e + 1] = bf2f(hc[e] >> 16);
      d[2 * e] = 0.5f * (bf2f(hp[e] & 0xffffu) + bf2f(hn[e] & 0xffffu)) - hh[2 * e];
      d[2 * e + 1] = 0.5f * (bf2f(hp[e] >> 16) + bf2f(hn[e] >> 16)) - hh[2 * e + 1];
    }
#pragma unroll
    for (int q = 0; q < 2; ++q) {
      const int mi = q ? 4 : 1;
      const f32x4 u0 = *(const f32x4*)(p.rw_mu + mi * D + 8 * k8), u1 = *(const f32x4*)(p.rw_mu + mi * D + 8 * k8 + 4);
      u32x4 o; o.x = pk2_(hh[0] + d[0] * u0.x, hh[1] + d[1] * u0.y); o.y = pk2_(hh[2] + d[2] * u0.z, hh[3] + d[3] * u0.w);
      o.z = pk2_(hh[4] + d[4] * u1.x, hh[5] + d[5] * u1.y); o.w = pk2_(hh[6] + d[6] * u1.z, hh[7] + d[7] * u1.w);
      *(LAS u32x4*)(lds + q * 65536 + (k8 * 32 + tok) * 16) = o;
    }
  }
  __syncthreads();
  f32x16 acc;
#pragma unroll
  for (int i = 0; i < 16; ++i) acc[i] = 0.f;
  const int aoff = (wave >> 2) * 65536 + ((h * 32) + (lane & 31)) * 16;
  const bf16_t* wf = Wf + ((size_t)wave * 64 * 64 + lane) * 8;
#pragma unroll 16
  for (int ks = 0; ks < 64; ++ks) {
    const bf16x8 af = *(LAS const bf16x8*)(lds + aoff + ks * 1024);
    const bf16x8 b0 = *(const bf16x8*)(wf + ((size_t)ks * 64) * 8);
    acc = __builtin_amdgcn_mfma_f32_32x32x16_bf16(af, b0, acc, 0, 0, 0);
  }
  bf16_t* HWA = (bf16_t*)(ws + M_HWA);
#pragma unroll
  for (int i = 0; i < 16; ++i) {
    const int row = (i & 3) + 8 * (i >> 2) + 4 * h;
    const float v = (wave < 4) ? tanhf(acc[i]) : acc[i];
    HWA[(size_t)(t0 + row) * 256 + wave * 32 + (lane & 31)] = (bf16_t)f2bf_(v);
  }
}

#define DPP_ADD(v, CTRL) ((v) + __builtin_bit_cast(float, __builtin_amdgcn_mov_dpp(__builtin_bit_cast(int, (v)), (CTRL), 0xF, 0xF, true)))
__device__ __forceinline__ float allred4(float v) { v = DPP_ADD(v, 0xB1); v = DPP_ADD(v, 0x4E); return v; }
__device__ __forceinline__ float allred16(float v) { v = DPP_ADD(v, 0xB1); v = DPP_ADD(v, 0x4E); v = DPP_ADD(v, 0x141); v = DPP_ADD(v, 0x140); return v; }

__device__ __forceinline__ float fma_s(float a, float b, float c) { float d; asm("v_fma_f32 %0, %1, %2, %3" : "=v"(d) : "v"(a), "v"(b), "v"(c)); return d; }
__device__ __forceinline__ float mul_s(float a, float b) { float d; asm("v_mul_f32_e32 %0, %1, %2" : "=v"(d) : "v"(a), "v"(b)); return d; }
__device__ __forceinline__ float add_s(float a, float b) { float d; asm("v_add_f32_e32 %0, %1, %2" : "=v"(d) : "v"(a), "v"(b)); return d; }
#define DPPADD_(NAME, CTRL) __device__ __forceinline__ float NAME(float s) { float d; asm("s_nop 1\n\tv_add_f32_dpp %0, %1, %1 " CTRL " row_mask:0xf bank_mask:0xf bound_ctrl:1" : "=v"(d) : "v"(s)); return d; }
DPPADD_(dpp_x1, "quad_perm:[1,0,3,2]")
DPPADD_(dpp_x2, "quad_perm:[2,3,0,1]")
DPPADD_(dpp_hm, "row_half_mirror")
DPPADD_(dpp_rm, "row_mirror")
__device__ __forceinline__ float ar4(float v) { return dpp_x2(dpp_x1(v)); }
__device__ __forceinline__ float ar16(float v) { return dpp_rm(dpp_hm(dpp_x2(dpp_x1(v)))); }
__device__ __forceinline__ float dot4_s(const f32x4& s, const f32x4& a) { return add_s(fma_s(s.y, a.y, mul_s(s.x, a.x)), fma_s(s.w, a.w, mul_s(s.z, a.z))); }
__device__ __forceinline__ void upd4_s(f32x4& s, const f32x4& w, const f32x4& b, const f32x4& k, float sa, float vi) {
  s.x = fma_s(s.x, w.x, fma_s(sa, b.x, mul_s(vi, k.x))); s.y = fma_s(s.y, w.y, fma_s(sa, b.y, mul_s(vi, k.y)));
  s.z = fma_s(s.z, w.z, fma_s(sa, b.z, mul_s(vi, k.z))); s.w = fma_s(s.w, w.w, fma_s(sa, b.w, mul_s(vi, k.w)));
}
constexpr int PB_BYTES = 24832;
constexpr int SC_PS0 = 0, SC_PP0 = 2 * PB_BYTES;

constexpr int SC_FR = 4 * PB_BYTES;
__device__ __forceinline__ u32x4 ld_bfrag(const GASF* W2, int ks, int lane) {
  const int k0 = 32 * ks + 8 * (lane >> 4);
  u32x4 o; o.x = pk2_(W2[(size_t)(k0 + 0) * D], W2[(size_t)(k0 + 1) * D]); o.y = pk2_(W2[(size_t)(k0 + 2) * D], W2[(size_t)(k0 + 3) * D]);
  o.z = pk2_(W2[(size_t)(k0 + 4) * D], W2[(size_t)(k0 + 5) * D]); o.w = pk2_(W2[(size_t)(k0 + 6) * D], W2[(size_t)(k0 + 7) * D]);
  return o;
}
struct ChId { int dir, hd, m0, L, froff; };
__device__ __forceinline__ ChId chid(int slot, int seq, int dir, int hd, int lane, int ntile) {
  ChId c; c.dir = dir; c.hd = hd; c.L = seq < 16 ? 256 : 2048; c.m0 = seq < 16 ? seq * 256 : NPT + (seq - 16) * 2048;
  c.froff = SC_FR + ((slot * 4 + ntile) * 6) * 1024 + lane * 16; return c;
}
__device__ __forceinline__ void prepc_load(const LAS PG& p, LAS unsigned char* lds, int froff, int dir, int hd, int lane, int ntile) {
  const int ch = hd * 64 + 16 * ntile + (lane & 15);
  const GASF* W2 = p.rw_w2 + (size_t)dir * 64 * D + ch; const GASF* A2 = p.rw_a2 + (size_t)dir * 64 * D + ch;
  *(LAS u32x4*)(lds + froff) = ld_bfrag(W2, 0, lane); __builtin_amdgcn_sched_barrier(0);
  *(LAS u32x4*)(lds + froff + 1024) = ld_bfrag(W2, 1, lane); __builtin_amdgcn_sched_barrier(0);
  *(LAS u32x4*)(lds + froff + 2048) = ld_bfrag(A2, 0, lane); __builtin_amdgcn_sched_barrier(0);
  *(LAS u32x4*)(lds + froff + 3072) = ld_bfrag(A2, 1, lane); __builtin_amdgcn_sched_barrier(0);
  LAS float* cn = (LAS float*)(lds + (froff - lane * 16) + 4096) + lane;
  cn[0] = p.rw_w0[dir * D + ch]; cn[64] = p.rw_a0[dir * D + ch]; cn[128] = p.rw_k_k[ch]; cn[192] = p.rw_k_a[ch]; cn[256] = p.rw_r_k[ch];
}
struct PrepIn { u32x4 hw[2], ha[2]; unsigned kr[4], rr[4], vr[4]; };
__device__ __forceinline__ int ctok(int m0, int L, int dir, int step) { return m0 + (dir ? (L - 1 - step) : step); }
__device__ __forceinline__ void prep_fetch(const unsigned char* ws, int c_m0, int c_L, int c_dir, int c_hd, int s0, int lane, int ntile, PrepIn& in) {
  const bf16_t* HWA = (const bf16_t*)(ws + M_HWA);
  const int m = ctok(c_m0, c_L, c_dir, s0 + (lane & 15));
  const bf16_t* src = HWA + (size_t)m * 256 + c_dir * 64 + 8 * (lane >> 4);
  in.hw[0] = *(const u32x4*)(src); in.hw[1] = *(const u32x4*)(src + 32);
  in.ha[0] = *(const u32x4*)(src + 128); in.ha[1] = *(const u32x4*)(src + 160);
#pragma unroll
  for (int r = 0; r < 4; ++r) {
    const int mt = ctok(c_m0, c_L, c_dir, s0 + 4 * (lane >> 4) + r);
    const size_t gi = (size_t)mt * D + c_hd * 64 + 16 * ntile + (lane & 15);
    in.kr[r] = ((const bf16_t*)(ws + M_KB))[gi]; in.rr[r] = ((const bf16_t*)(ws + M_RB))[gi]; in.vr[r] = ((const bf16_t*)(ws + M_VB))[gi];
  }
}
__device__ __forceinline__ bf16x8 pack8(const f32x4& a, const f32x4& b) { u32x4 o; o.x = pk2_(a.x, a.y); o.y = pk2_(a.z, a.w); o.z = pk2_(b.x, b.y); o.w = pk2_(b.z, b.w); return __builtin_bit_cast(bf16x8, o); }
__device__ __forceinline__ void prep_finish(unsigned char* ws, LAS unsigned char* lds, int c_m0, int c_L, int c_dir, int c_hd, int c_froff, int s0, int pboff, int lane, int ntile, const PrepIn& in) {
  LAS const float* cn = (LAS const float*)(lds + (c_froff - lane * 16) + 4096) + lane;
  const float c_biasw = cn[0], c_biasa = cn[64], c_kkc = cn[128], c_kac = cn[192], c_rkc = cn[256];
  f32x4 aw = (f32x4){c_biasw, c_biasw, c_biasw, c_biasw}, aa = (f32x4){c_biasa, c_biasa, c_biasa, c_biasa};
  aw = __builtin_amdgcn_mfma_f32_16x16x32_bf16(__builtin_bit_cast(bf16x8, in.hw[0]), *(LAS const bf16x8*)(lds + c_froff), aw, 0, 0, 0);
  aw = __builtin_amdgcn_mfma_f32_16x16x32_bf16(__builtin_bit_cast(bf16x8, in.hw[1]), *(LAS const bf16x8*)(lds + c_froff + 1024), aw, 0, 0, 0);
  aa = __builtin_amdgcn_mfma_f32_16x16x32_bf16(__builtin_bit_cast(bf16x8, in.ha[0]), *(LAS const bf16x8*)(lds + c_froff + 2048), aa, 0, 0, 0);
  aa = __builtin_amdgcn_mfma_f32_16x16x32_bf16(__builtin_bit_cast(bf16x8, in.ha[1]), *(LAS const bf16x8*)(lds + c_froff + 3072), aa, 0, 0, 0);
  LAS float* pb = (LAS float*)(lds + pboff);
  const int col = lane & 15, rg = lane >> 4, chl = 16 * ntile + col;
#pragma unroll
  for (int r = 0; r < 4; ++r) {
    const int t = 4 * rg + r;
    const float sig = __builtin_amdgcn_rcpf(1.f + __expf(-aw[r]));
    const float dec = __expf(-0.6065306597126334f * sig);
    const float a = __builtin_amdgcn_rcpf(1.f + __expf(-aa[r]));
    const float k = bf2f(in.kr[r]), rv = bf2f(in.rr[r]), v = bf2f(in.vr[r]);
    const float kq = k * c_kkc;
    const float ssq = ar16(kq * kq);
    const float kd = k * (1.f + (a - 1.f) * c_kac);
    const float bon = ar16(rv * kd * c_rkc);
    pb[t * 64 + chl] = dec; pb[1024 + t * 64 + chl] = -kq; pb[2048 + t * 64 + chl] = kq * a; pb[3072 + t * 64 + chl] = kd; pb[4096 + t * 64 + chl] = rv; pb[5120 + t * 64 + chl] = v;
    if (col == 0) {
      pb[6144 + t * 4 + ntile] = ssq;
      const int mt = ctok(c_m0, c_L, c_dir, s0 + t);
      ((float*)(ws + M_BON))[(((size_t)c_dir * NTOK + mt) * 16 + c_hd) * 4 + ntile] = bon;
    }
  }
}

#define LDS_BARRIER() asm volatile("s_waitcnt lgkmcnt(0)\n\ts_barrier" ::: "memory")
__device__ __forceinline__ void phase_rw_scan(const LAS PG& p, unsigned char* ws, LAS unsigned char* lds, int tid, int lane, int wave, int bid, int G) {
  for (int item = bid; item < 256; item += G) {
    const int sc = item >> 2, qt = item & 3;
    const int s_seq = 16 + (sc >> 5), s_dir = (sc >> 4) & 1, s_hd = sc & 15, s_m0 = NPT + (s_seq - 16) * 2048;
    __syncthreads();
    if (wave < 4) {
      __builtin_amdgcn_s_setprio(2);
      float* Yo = (float*)(ws + (s_dir ? M_YB : M_YF));
      const int srow = 16 * qt + 4 * wave + (lane >> 4), scg = lane & 15;
      f32x4 Ss = *(const GAS f32x4*)(p.state_rwkv + ((((size_t)(s_seq - 16)) * 2 + s_dir) * 16 + s_hd) * 4096 + (size_t)srow * 64 + 4 * scg);
      __syncthreads();
      for (int c = 0; c < 128; ++c) {
        LAS const float* ps = (LAS const float*)(lds + SC_PS0 + (c & 1) * PB_BYTES);
        float rn2v;
        { const f32x4 q4 = *(LAS const f32x4*)(ps + 6144 + (lane & 15) * 4); rn2v = __builtin_amdgcn_rcpf((q4.x + q4.y) + (q4.z + q4.w) + 1e-12f); }
        float yk[16];
#pragma unroll
        for (int t = 0; t < 16; ++t) {
          const f32x4 w4 = *(LAS const f32x4*)(ps + t * 64 + 4 * scg), a4 = *(LAS const f32x4*)(ps + 1024 + t * 64 + 4 * scg);
          const f32x4 b4 = *(LAS const f32x4*)(ps + 2048 + t * 64 + 4 * scg), k4 = *(LAS const f32x4*)(ps + 3072 + t * 64 + 4 * scg);
          const f32x4 r4 = *(LAS const f32x4*)(ps + 4096 + t * 64 + 4 * scg);
          const float vi = ps[5120 + t * 64 + srow];
          const float rn2 = __builtin_bit_cast(float, __builtin_amdgcn_readlane(__builtin_bit_cast(int, rn2v), t));
          const float sa = ar16(dot4_s(Ss, a4)) * rn2;
          upd4_s(Ss, w4, b4, k4, sa, vi);
          yk[t] = ar16(dot4_s(Ss, r4));
        }
        if (scg == 0) {
          const int mfirst = ctok(s_m0, 2048, s_dir, 16 * c);
          float* yp = Yo + (size_t)mfirst * D + s_hd * 64 + srow;
          const long stride = s_dir ? -(long)D : (long)D;
#pragma unroll
          for (int t = 0; t < 16; ++t) yp[t * stride] = yk[t];
        }
        LDS_BARRIER();
      }
      __builtin_amdgcn_s_setprio(0);
    } else {
      const int nt = wave - 4;
      const int s_fr = SC_FR + ((0 * 4 + nt) * 6) * 1024 + lane * 16;
      prepc_load(p, lds, s_fr, s_dir, s_hd, lane, nt);
      int pc = 2 * item;
      const int q_fr = SC_FR + ((1 * 4 + nt) * 6) * 1024 + lane * 16;
      prepc_load(p, lds, q_fr, (pc >> 4) & 1, pc & 15, lane, nt);
      int r_seq = pc >> 5, r_dir = (pc >> 4) & 1, r_hd = pc & 15;
      int q_seq = pc >> 5, q_dir = (pc >> 4) & 1, q_hd = pc & 15;
      PrepIn in_s, in_p;
      prep_fetch(ws, s_m0, 2048, s_dir, s_hd, 0, lane, nt, in_s); prep_fetch(ws, r_seq * 256, 256, r_dir, r_hd, 0, lane, nt, in_p);
      prep_finish(ws, lds, s_m0, 2048, s_dir, s_hd, s_fr, 0, SC_PS0, lane, nt, in_s); prep_finish(ws, lds, r_seq * 256, 256, r_dir, r_hd, q_fr, 0, SC_PP0, lane, nt, in_p);
      const int prow = 16 * nt + (lane >> 2), pcq = lane & 3;
      f32x4 Sp0 = (f32x4){0.f, 0.f, 0.f, 0.f}, Sp1 = Sp0, Sp2 = Sp0, Sp3 = Sp0;
      __syncthreads();
      for (int c = 0; c < 128; ++c) {
        const bool more_s = (c + 1) < 128;
        const bool pgrp = ((c & 3) == 0) && (c + 4 < 128);
        if (more_s) prep_fetch(ws, s_m0, 2048, s_dir, s_hd, 16 * (c + 1), lane, nt, in_s);
        if (pgrp) {
          if (c == 60) { pc = 2 * item + 1; r_seq = pc >> 5; r_dir = (pc >> 4) & 1; r_hd = pc & 15; prepc_load(p, lds, q_fr, r_dir, r_hd, lane, nt); }
          prep_fetch(ws, r_seq * 256, 256, r_dir, r_hd, 4 * ((c + 4) & 63), lane, nt, in_p);
        }
        if (c == 64) { q_seq = r_seq; q_dir = r_dir; q_hd = r_hd; Sp0 = (f32x4){0.f, 0.f, 0.f, 0.f}; Sp1 = Sp0; Sp2 = Sp0; Sp3 = Sp0; }
        {
          LAS const float* pp = (LAS const float*)(lds + SC_PP0 + ((c >> 2) & 1) * PB_BYTES);
          float* Yp = (float*)(ws + (q_dir ? M_YB : M_YF));
          float rn2v;
          { const f32x4 q4 = *(LAS const f32x4*)(pp + 6144 + (lane & 15) * 4); rn2v = __builtin_amdgcn_rcpf((q4.x + q4.y) + (q4.z + q4.w) + 1e-12f); }
#pragma unroll 2
          for (int s = 0; s < 4; ++s) {
            const int t = 4 * (c & 3) + s;
            const float vi = pp[5120 + t * 64 + prow];
            const float rn2 = __builtin_bit_cast(float, __builtin_amdgcn_readlane(__builtin_bit_cast(int, rn2v), t));
            LAS const float* q = pp + t * 64 + 16 * pcq;
            const f32x4 a0 = *(LAS const f32x4*)(q + 1024), a1 = *(LAS const f32x4*)(q + 1028), a2 = *(LAS const f32x4*)(q + 1032), a3 = *(LAS const f32x4*)(q + 1036);
            const float sa = ar4(add_s(add_s(dot4_s(Sp0, a0), dot4_s(Sp1, a1)), add_s(dot4_s(Sp2, a2), dot4_s(Sp3, a3)))) * rn2;
            float y0, y1, y2, y3;
#define UP4(S_, O_, Y_) { const f32x4 w4 = *(LAS const f32x4*)(q + (O_)), b4 = *(LAS const f32x4*)(q + 2048 + (O_)), k4 = *(LAS const f32x4*)(q + 3072 + (O_)), r4 = *(LAS const f32x4*)(q + 4096 + (O_)); \
              upd4_s(S_, w4, b4, k4, sa, vi); Y_ = dot4_s(S_, r4); }
            UP4(Sp0, 0, y0) UP4(Sp1, 4, y1) UP4(Sp2, 8, y2) UP4(Sp3, 12, y3)
#undef UP4
            const float y = ar4(add_s(add_s(y0, y1), add_s(y2, y3)));
            if (pcq == 0) Yp[(size_t)ctok(q_seq * 256, 256, q_dir, 4 * (c & 63) + s) * D + q_hd * 64 + prow] = y;
          }
          if ((c & 63) == 63) {
            GASF* so = p.out + OUT_ST + ((((size_t)q_seq) * 2 + q_dir) * 16 + q_hd) * 4096 + (size_t)prow * 64 + 16 * pcq;
            *(GAS f32x4*)so = Sp0; *(GAS f32x4*)(so + 4) = Sp1; *(GAS f32x4*)(so + 8) = Sp2; *(GAS f32x4*)(so + 12) = Sp3;
          }
        }
        if (more_s) prep_finish(ws, lds, s_m0, 2048, s_dir, s_hd, s_fr, 16 * (c + 1), SC_PS0 + ((c + 1) & 1) * PB_BYTES, lane, nt, in_s);
        if (pgrp) prep_finish(ws, lds, r_seq * 256, 256, r_dir, r_hd, q_fr, 4 * ((c + 4) & 63), SC_PP0 + (((c >> 2) + 1) & 1) * PB_BYTES, lane, nt, in_p);
        LDS_BARRIER();
      }
    }
  }
}
constexpr int LDO = 68, OSZ = 32 * LDO * 2;
constexpr int O_B = OSZ, O_K = 2 * OSZ, O_R = 3 * OSZ, O_V = 4 * OSZ, O_W = 5 * OSZ;
constexpr int LDM = 36, MSZ = 32 * LDM * 2;
constexpr int CK_OPS = 5 * OSZ + 256;
constexpr int CK_MX = 3 * CK_OPS;
constexpr int CK_MXS = 4 * MSZ;
constexpr int CK_SCR = CK_MX + 2 * CK_MXS;
constexpr int CK_SSQ = CK_SCR + 3 * MSZ;
constexpr int CK_FR = CK_SSQ + 1024;
constexpr int CK_IN = CK_FR + 4 * 6144;
constexpr int CK_INS = 3 * OSZ + 32 * 272;
static_assert(CK_IN + 2 * CK_INS <= PTAB_OFF, "scan LDS map overflows");

__device__ __forceinline__ unsigned short bfr(float f) { return (unsigned short)f2bf_(f); }
__device__ __forceinline__ bf16x8 cvt8(const f32x16& a, int s) {
  u32x4 o; o.x = pk2_(a[8 * s + 0], a[8 * s + 1]); o.y = pk2_(a[8 * s + 2], a[8 * s + 3]); o.z = pk2_(a[8 * s + 4], a[8 * s + 5]); o.w = pk2_(a[8 * s + 6], a[8 * s + 7]);
  return __builtin_bit_cast(bf16x8, o);
}
__device__ __forceinline__ bf16x8 ldA_perm(LAS const unsigned char* base, int ld, int row, int k0, int hi) {
  const u32x2 lo = *(LAS const u32x2*)(base + (row * ld + k0 + 4 * hi) * 2), hh = *(LAS const u32x2*)(base + (row * ld + k0 + 8 + 4 * hi) * 2);
  u32x4 o; o.x = lo.x; o.y = lo.y; o.z = hh.x; o.w = hh.y; return __builtin_bit_cast(bf16x8, o);
}
__device__ __forceinline__ bf16x8 ldT_perm(LAS const unsigned char* base, int ld, int k0, int c0, int lane) {
  const int hi = lane >> 5;
  LAS const unsigned char* a = base + ((k0 + 4 * hi + ((lane & 15) >> 2)) * ld + c0 + 16 * ((lane >> 4) & 1) + 4 * (lane & 3)) * 2;
  const v4i16_t lo = vtr(a), hh = vtr(a + 8 * ld * 2);
  return (bf16x8){lo[0], lo[1], lo[2], lo[3], hh[0], hh[1], hh[2], hh[3]};
}
__device__ __forceinline__ bf16x8 ldT_nat(LAS const unsigned char* base, int ld, int k0, int c0, int lane) {
  const int hi = lane >> 5;
  LAS const unsigned char* a = base + ((k0 + 8 * hi + ((lane & 15) >> 2)) * ld + c0 + 16 * ((lane >> 4) & 1) + 4 * (lane & 3)) * 2;
  const v4i16_t lo = vtr(a), hh = vtr(a + 4 * ld * 2);
  return (bf16x8){lo[0], lo[1], lo[2], lo[3], hh[0], hh[1], hh[2], hh[3]};
}
__device__ __forceinline__ bf16x8 ld16_(LAS const unsigned char* a) {
  const u32x2 lo = *(LAS const u32x2*)a, hh = *(LAS const u32x2*)(a + 8); u32x4 o; o.x = lo.x; o.y = lo.y; o.z = hh.x; o.w = hh.y; return __builtin_bit_cast(bf16x8, o);
}
__device__ __forceinline__ void st16_(LAS unsigned char* a, const u32x4 v) { *(LAS u32x2*)a = (u32x2){v.x, v.y}; *(LAS u32x2*)(a + 8) = (u32x2){v.z, v.w}; }
__device__ __forceinline__ int opq5(int x) { asm volatile("" : "+v"(x)); return x; }
#define MFMA32(A_, B_, C_) __builtin_amdgcn_mfma_f32_32x32x16_bf16((A_), (B_), (C_), 0, 0, 0)

__device__ __forceinline__ float ck_ar16(float x) {
  unsigned a = __builtin_bit_cast(unsigned, x), b = a;
  asm volatile("s_nop 1\n\tv_permlane16_swap_b32 %0, %1" : "+v"(a), "+v"(b));
  return __builtin_bit_cast(float, a) + __builtin_bit_cast(float, b);
}
__device__ __forceinline__ float ck_ar32(float x) {
  unsigned a = __builtin_bit_cast(unsigned, x), b = a;
  asm volatile("s_nop 1\n\tv_permlane32_swap_b32 %0, %1" : "+v"(a), "+v"(b));
  return __builtin_bit_cast(float, a) + __builtin_bit_cast(float, b);
}
#ifdef CKT_WAVE
#ifndef CKT_SEC
#define CKT_SEC 0
#endif
#define CKT_S(n) unsigned long long ckt##n##_ = 0ull; if (CKT_SEC == (n)) { asm volatile("s_waitcnt lgkmcnt(0)" ::: "memory"); ckt##n##_ = __builtin_amdgcn_s_memrealtime(); }
#define CKT_E(n) do { if (CKT_SEC == (n) && blockIdx.x == 0 && wave == (CKT_WAVE) && (threadIdx.x & 63) == 0) { asm volatile("s_waitcnt lgkmcnt(0)" ::: "memory"); ((volatile LAS unsigned*)(lds + MISC_OFF))[40] += (unsigned)(__builtin_amdgcn_s_memrealtime() - ckt##n##_); } } while (0)
#else
#define CKT_S(n)
#define CKT_E(n) do {} while (0)
#endif
#define CKT_BEGIN() CKT_S(0)
#define CKT_END() CKT_E(0)
struct CkChain { int seq, dir, hd, m0, L, nch, kofs; };
__device__ __forceinline__ CkChain ck_chain(int id) {
  CkChain c;
  if (id < 64) { c.seq = 16 + (id >> 5); c.dir = (id >> 4) & 1; c.hd = id & 15; c.L = 2048; c.m0 = NPT + (c.seq - 16) * 2048; }
  else { const int p = id - 64; c.seq = p >> 5; c.dir = (p >> 4) & 1; c.hd = p & 15; c.L = 256; c.m0 = c.seq * 256; }
  c.nch = c.L / 32; c.kofs = 0; return c;
}

constexpr int CK_K0 = 32, CK_NREC = 32;
constexpr int CK_REC = 4 * OSZ + 256 + CK_MXS;
constexpr size_t M_REC = 0;
constexpr unsigned CK_R0N = (unsigned)((48 * MiB) / CK_REC);
constexpr size_t M_REC1 = M_WTS + 20 * MiB;
static_assert((64u * CK_NREC - CK_R0N) * (size_t)CK_REC <= 15 * MiB, "record overflow region");
__device__ __forceinline__ unsigned char* ck_rec(unsigned char* ws, unsigned rec) { return rec < CK_R0N ? ws + M_REC + (size_t)rec * CK_REC : ws + M_REC1 + (size_t)(rec - CK_R0N) * CK_REC; }
constexpr size_t CK_FLAGS = 32768;
__device__ __forceinline__ void ck_run_chain(const LAS PG& p, unsigned char* ws, LAS unsigned char* lds, const CkChain ch, int lane_in, int wave, const int mode, const int nprep, const int cidx) {
  const int lane = lane_in;
  const int hi = lane >> 5, r32 = lane & 31;
  float* Yo = (float*)(ws + (ch.dir ? M_YB : M_YF));
  const int NK = ch.nch + 3;
  const int sb0 = 32 * ch.kofs;
#define CK_PROD(ACC, AOFF, BOFF) do { _Pragma("unroll") for (int i_ = 0; i_ < 16; ++i_) ACC[i_] = 0.f; \
          _Pragma("unroll") for (int ks = 0; ks < 4; ++ks) { \
            const bf16x8 af_ = ld16_(ob + (AOFF) + (r32 * LDO + 16 * ks + 8 * hi) * 2), bf_ = ld16_(ob + (BOFF) + (r32 * LDO + 16 * ks + 8 * hi) * 2); \
            ACC = MFMA32(af_, bf_, ACC); } } while (0)
#define CK_STORE_T(ACC, DST, STRICT) do { _Pragma("unroll") for (int q_ = 0; q_ < 4; ++q_) { \
            float v_[4]; _Pragma("unroll") for (int x_ = 0; x_ < 4; ++x_) { const int s_ = 8 * q_ + 4 * hi + x_; const bool keep_ = (STRICT) ? (s_ < r32) : (s_ <= r32); v_[x_] = keep_ ? ACC[4 * q_ + x_] : 0.f; ACC[4 * q_ + x_] = v_[x_]; } \
            u32x2 w_; w_.x = pk2_(v_[0], v_[1]); w_.y = pk2_(v_[2], v_[3]); *(LAS u32x2*)((DST) + (r32 * LDM + 8 * q_ + 4 * hi) * 2) = w_; } } while (0)
#define CK_STORE_TN(ACC, DST) do { _Pragma("unroll") for (int q_ = 0; q_ < 4; ++q_) { u32x2 w_; w_.x = pk2_(ACC[4 * q_], ACC[4 * q_ + 1]); w_.y = pk2_(ACC[4 * q_ + 2], ACC[4 * q_ + 3]); \
            *(LAS u32x2*)((DST) + (r32 * LDM + 8 * q_ + 4 * hi) * 2) = w_; } } while (0)
  if (wave >= 4) {
    float rw_dec[8], rw_al[8], rw_kq[8], rw_kd[8], rw_r[8];
    u32x2 rw_vp[2];
    u32x4 cr[16];
#pragma unroll
    for (int i = 0; i < 16; ++i) cr[i] = (u32x4){0u, 0u, 0u, 0u};
    const int nt = wave - 4, col = lane & 15, g = lane >> 4;
    const int froff = CK_FR + nt * 6144 + lane * 16;
#pragma unroll
    for (int i = 0; i < 8; ++i) { rw_dec[i] = 1.f; rw_al[i] = 0.f; rw_kq[i] = 0.f; rw_kd[i] = 0.f; rw_r[i] = 0.f; }
    rw_vp[0] = (u32x2){0u, 0u}; rw_vp[1] = rw_vp[0];
    prepc_load(p, lds, froff, ch.dir, ch.hd, lane, nt);
    const int pb_x = col * (LDO * 2) + (16 * nt + 4 * g) * 2;
    const int pb_h = col * 272 + 16 * g;
    LDS_BARRIER();
#define CK_DPPF(OLD, V, CTRL) __builtin_bit_cast(float, __builtin_amdgcn_update_dpp(__builtin_bit_cast(int, (float)(OLD)), __builtin_bit_cast(int, (float)(V)), (CTRL), 0xF, 0xF, false))
    for (int k = 0; k < NK; ++k) {
      CKT_BEGIN();
      CKT_S(1)
      if (k >= 1 && k <= nprep) {
        LAS unsigned char* ob = lds + ((k - 1) % 3) * CK_OPS;
        LAS const unsigned char* sq = lds + CK_SSQ + ((k - 1) & 1) * 512;
        float wt[8], wp[8], T0[4];
#pragma unroll
        for (int e = 0; e < 8; ++e) wt[e] = rw_dec[e];
#pragma unroll
        for (int e = 0; e < 8; ++e) wt[e] *= CK_DPPF(1.f, wt[e], 0x111);
#pragma unroll
        for (int e = 0; e < 8; ++e) wt[e] *= CK_DPPF(1.f, wt[e], 0x112);
#pragma unroll
        for (int e = 0; e < 8; ++e) wt[e] *= CK_DPPF(1.f, wt[e], 0x114);
#pragma unroll
        for (int e = 0; e < 8; ++e) wt[e] *= CK_DPPF(1.f, wt[e], 0x118);
#pragma unroll
        for (int r = 0; r < 4; ++r) { T0[r] = CK_DPPF(0.f, wt[r], 0x15F); wt[4 + r] *= T0[r]; }
#pragma unroll
        for (int r = 0; r < 4; ++r) { wp[r] = CK_DPPF(1.f, wt[r], 0x111); wp[4 + r] = CK_DPPF(T0[r], wt[4 + r], 0x111); }
#pragma unroll
        for (int mt = 0; mt < 2; ++mt) {
          const f32x4 q4 = *(LAS const f32x4*)(sq + (16 * mt + col) * 16);
          const float rn = rsqrtf((q4.x + q4.y) + (q4.z + q4.w) + 1e-12f);
          float oa[4], obb[4], ok[4], orr[4];
#pragma unroll
          for (int r = 0; r < 4; ++r) {
            const int e = 4 * mt + r;
            const float iw = __builtin_amdgcn_rcpf(wt[e]);
            const float kqn = rw_kq[e] * rn;
            oa[r] = -wp[e] * kqn;
            obb[r] = kqn * rw_al[e] * iw;
            ok[r] = rw_kd[e] * iw;
            orr[r] = wt[e] * rw_r[e];
          }
          LAS unsigned char* o8 = ob + pb_x + 16 * mt * (LDO * 2);
          *(LAS u32x2*)(o8) = (u32x2){pk2_(oa[0], oa[1]), pk2_(oa[2], oa[3])};
          *(LAS u32x2*)(o8 + O_B) = (u32x2){pk2_(obb[0], obb[1]), pk2_(obb[2], obb[3])};
          *(LAS u32x2*)(o8 + O_K) = (u32x2){pk2_(ok[0], ok[1]), pk2_(ok[2], ok[3])};
          *(LAS u32x2*)(o8 + O_R) = (u32x2){pk2_(orr[0], orr[1]), pk2_(orr[2], orr[3])};
          *(LAS u32x2*)(o8 + O_V) = rw_vp[mt];
        }
        if (col == 15) *(LAS f32x4*)(ob + O_W + (16 * nt + 4 * g) * 4) = (f32x4){wt[4], wt[5], wt[6], wt[7]};
      }
      CKT_E(1);
      CKT_S(2)
      if (k < nprep) {
        LAS const f32x4* cn4 = (LAS const f32x4*)(lds + (froff - lane * 16) + 4096 + 16 * g);
        const f32x4 c_biasw = cn4[0], c_biasa = cn4[16], c_kkc = cn4[32], c_kac = cn4[48], c_rkc = cn4[64];
        LAS unsigned char* sq = lds + CK_SSQ + (k & 1) * 512;
        LAS const unsigned char* in = lds + CK_IN + (k & 1) * CK_INS;
#pragma unroll
        for (int mt = 0; mt < 2; ++mt) {
          f32x4 aw = c_biasw, aa = c_biasa;
          LAS const unsigned char* hrow = in + 3 * OSZ + pb_h + 16 * mt * 272;
          aw = __builtin_amdgcn_mfma_f32_16x16x32_bf16(*(LAS const bf16x8*)(lds + froff), *(LAS const bf16x8*)(hrow), aw, 0, 0, 0);
          aw = __builtin_amdgcn_mfma_f32_16x16x32_bf16(*(LAS const bf16x8*)(lds + froff + 1024), *(LAS const bf16x8*)(hrow + 64), aw, 0, 0, 0);
          aa = __builtin_amdgcn_mfma_f32_16x16x32_bf16(*(LAS const bf16x8*)(lds + froff + 2048), *(LAS const bf16x8*)(hrow + 128), aa, 0, 0, 0);
          aa = __builtin_amdgcn_mfma_f32_16x16x32_bf16(*(LAS const bf16x8*)(lds + froff + 3072), *(LAS const bf16x8*)(hrow + 192), aa, 0, 0, 0);
          LAS const unsigned char* i8 = in + pb_x + 16 * mt * (LDO * 2);
          const u32x2 pk = *(LAS const u32x2*)(i8), pr = *(LAS const u32x2*)(i8 + OSZ);
          rw_vp[mt] = *(LAS const u32x2*)(i8 + 2 * OSZ);
          float sqs = 0.f, bns = 0.f;
#pragma unroll
          for (int r = 0; r < 4; ++r) {
            const int e = 4 * mt + r;
            const float sig = __builtin_amdgcn_rcpf(1.f + __expf(-aw[r]));
            rw_dec[e] = __expf(-0.6065306597126334f * sig);
            const float a = __builtin_amdgcn_rcpf(1.f + __expf(-aa[r]));
            rw_al[e] = a;
            const unsigned kw = (r < 2) ? pk.x : pk.y, rww = (r < 2) ? pr.x : pr.y;
            const float kv = (r & 1) ? __builtin_bit_cast(float, kw & 0xffff0000u) : __builtin_bit_cast(float, kw << 16);
            const float rv = (r & 1) ? __builtin_bit_cast(float, rww & 0xffff0000u) : __builtin_bit_cast(float, rww << 16);
            rw_r[e] = rv;
            const float kq = kv * c_kkc[r]; rw_kq[e] = kq;
            const float kd = kv * (1.f + (a - 1.f) * c_kac[r]); rw_kd[e] = kd;
            sqs += kq * kq; bns += rv * kd * c_rkc[r];
          }
          sqs = ck_ar16(sqs); bns = ck_ar16(bns); sqs = ck_ar32(sqs); bns = ck_ar32(bns);
          if (g == 0) {
            *(LAS float*)(sq + (16 * mt + col) * 16 + nt * 4) = sqs;
            float* bo = (float*)(ws + M_BON) + ((((unsigned)ch.dir * NTOK + (unsigned)ctok(ch.m0, ch.L, ch.dir, sb0 + 32 * k + 16 * mt + col)) * 16u + (unsigned)ch.hd) * 4u + (unsigned)nt);
            *bo = bns;
          }
        }
      }
      CKT_E(2);
      CKT_S(3)
      if (mode == 1) {
        const int l2 = (nt & 1) * 64 + lane;
        if ((((k ^ (nt >> 1)) & 1) == 0)) {
          if (k - 2 >= nprep && k - 2 < ch.nch) {
            const int kc = k - 2;
            LAS unsigned char* ob = lds + (kc % 3) * CK_OPS;
            LAS unsigned char* mxb = lds + CK_MX + (kc & 1) * CK_MXS;
#pragma unroll
            for (int i = 0; i < 8; ++i) *(LAS u32x4*)(ob + (l2 + 128 * i) * 16) = cr[i];
            if (l2 < 64) *(LAS u32x4*)(ob + (1024 + l2) * 16) = cr[8];
            else if (l2 < 80) *(LAS u32x4*)(ob + O_W + (l2 - 64) * 16) = cr[8];
#pragma unroll
            for (int i = 0; i < 4; ++i) *(LAS u32x4*)(mxb + (l2 + 128 * i) * 16) = cr[9 + i];
            if (l2 < 64) *(LAS u32x4*)(mxb + (512 + l2) * 16) = cr[13];
#pragma unroll
            for (int i = 0; i < 2; ++i) { const int id = l2 + 128 * i; st16_(ob + O_V + (id >> 3) * (LDO * 2) + (id & 7) * 16, cr[14 + i]); }
          }
          if (k >= nprep && k < ch.nch) {
            const int kc = k;
            const unsigned rec = (unsigned)(cidx * CK_NREC + (kc - CK_K0));
            if (((kc - CK_K0) & 7) < 2) {
              unsigned* flag = (unsigned*)(ws + M_CTL + CK_FLAGS) + (rec | 7u);
              { unsigned sp = 0; while (__hip_atomic_load(flag, __ATOMIC_RELAXED, __HIP_MEMORY_SCOPE_AGENT) == 0u) { __builtin_amdgcn_s_sleep(2); if (++sp > (1u << 22)) break; } }
              __builtin_amdgcn_fence(__ATOMIC_ACQUIRE, "agent");
              asm volatile("s_waitcnt vmcnt(0)" ::: "memory");
            }
            const unsigned char* rp = ck_rec(ws, rec);
#pragma unroll
            for (int i = 0; i < 8; ++i) cr[i] = *(const u32x4*)(rp + (l2 + 128 * i) * 16);
            if (l2 < 80) cr[8] = *(const u32x4*)(rp + (1024 + l2) * 16);
#pragma unroll
            for (int i = 0; i < 4; ++i) cr[9 + i] = *(const u32x4*)(rp + 4 * OSZ + 256 + (l2 + 128 * i) * 16);
            if (l2 < 64) cr[13] = *(const u32x4*)(rp + 4 * OSZ + 256 + (512 + l2) * 16);
#pragma unroll
            for (int i = 0; i < 2; ++i) { const int id = l2 + 128 * i; const int t = id >> 3, c8 = id & 7;
              const unsigned gi = (unsigned)ctok(ch.m0, ch.L, ch.dir, sb0 + 32 * kc + t) * (unsigned)D + (unsigned)(ch.hd * 64 + 8 * c8);
              cr[14 + i] = *(const u32x4*)((const bf16_t*)(ws + M_VB) + gi); }
          }
        }
      }
      CKT_E(3);
      CKT_END();
      LDS_BARRIER();
    }
  } else if (wave == 3) {
    u32x4 ld_k[4], ld_r[4], ld_v[4], ld_h[8];
#define CK_LOAD(KC) do { const int s0_ = sb0 + 32 * (KC); \
      _Pragma("unroll") for (int i_ = 0; i_ < 4; ++i_) { const int id_ = lane + 64 * i_; const int t_ = id_ >> 3, c8_ = id_ & 7; \
        const unsigned gi_ = (unsigned)ctok(ch.m0, ch.L, ch.dir, s0_ + t_) * (unsigned)D + (unsigned)(ch.hd * 64 + 8 * c8_); \
        ld_k[i_] = *(const u32x4*)((const bf16_t*)(ws + M_KB) + gi_); ld_r[i_] = *(const u32x4*)((const bf16_t*)(ws + M_RB) + gi_); ld_v[i_] = *(const u32x4*)((const bf16_t*)(ws + M_VB) + gi_); } \
      _Pragma("unroll") for (int i_ = 0; i_ < 8; ++i_) { const int id_ = lane + 64 * i_; const int t_ = id_ >> 4, c8_ = id_ & 15; \
        const unsigned go_ = (unsigned)ctok(ch.m0, ch.L, ch.dir, s0_ + t_) * 256u + (unsigned)((c8_ >> 3) * 128 + ch.dir * 64 + 8 * (c8_ & 7)); \
        ld_h[i_] = *(const u32x4*)((const bf16_t*)(ws + M_HWA) + go_); } } while (0)
#define CK_PUT(BUF) do { LAS unsigned char* in_ = lds + CK_IN + (BUF) * CK_INS; \
      _Pragma("unroll") for (int i_ = 0; i_ < 4; ++i_) { const int id_ = lane + 64 * i_; \
        LAS unsigned char* d_ = in_ + (id_ >> 3) * (LDO * 2) + (id_ & 7) * 16; st16_(d_, ld_k[i_]); st16_(d_ + OSZ, ld_r[i_]); st16_(d_ + 2 * OSZ, ld_v[i_]); } \
      _Pragma("unroll") for (int i_ = 0; i_ < 8; ++i_) { const int id_ = lane + 64 * i_; const int t_ = id_ >> 4, c8_ = id_ & 15; \
        *(LAS u32x4*)(in_ + 3 * OSZ + t_ * 272 + c8_ * 16) = ld_h[i_]; } } while (0)
    CK_LOAD(0); CK_PUT(0);
    if (nprep > 1) CK_LOAD(1);
    LDS_BARRIER();
    for (int k = 0; k < NK; ++k) {
      CKT_BEGIN();
      if (k + 1 < nprep) CK_PUT((k + 1) & 1);
      if (k + 2 < nprep) CK_LOAD(k + 2);
      if (k >= 2 && k <= nprep + 1) {
        const int lane_o = opq5(lane); const int r32 = lane_o & 31, hi = lane_o >> 5;
        LAS const unsigned char* ob = lds + ((k - 2) % 3) * CK_OPS;
        LAS unsigned char* mx = lds + CK_MX + ((k - 2) & 1) * CK_MXS;
        f32x16 acc;
        CK_PROD(acc, O_K, 0);     CK_STORE_T(acc, mx + 0, true);
        CK_PROD(acc, O_B, O_R); CK_STORE_T(acc, mx + MSZ, false);
        CK_PROD(acc, O_K, O_R); CK_STORE_T(acc, mx + 2 * MSZ, false);
      }
      CKT_END();
      LDS_BARRIER();
    }
#undef CK_LOAD
#undef CK_PUT
  } else if (wave == 2) {
    LDS_BARRIER();
    for (int k = 0; k < NK; ++k) {
      CKT_BEGIN();
      if (k >= 2 && k <= nprep + 1) {
        const int lane_o = opq5(lane); const int r32 = lane_o & 31, hi = lane_o >> 5;
        LAS const unsigned char* ob = lds + ((k - 2) % 3) * CK_OPS;
        LAS unsigned char* mx = lds + CK_MX + ((k - 2) & 1) * CK_MXS;
        LAS unsigned char* sc = lds + CK_SCR;
        f32x16 Q, Pm;
        CK_PROD(Q, O_B, 0);
        CK_STORE_T(Q, sc + MSZ, true);
#pragma unroll
        for (int i = 0; i < 16; ++i) Pm[i] = Q[i] + ((crow_(i, hi) == r32) ? 1.f : 0.f);
        CK_STORE_TN(Pm, sc + 2 * MSZ);
        asm volatile("s_waitcnt lgkmcnt(0)" ::: "memory");
#define CK_MM(ACC, Z1T, Z2T) do { _Pragma("unroll") for (int ks = 0; ks < 2; ++ks) { \
          const bf16x8 af_ = ldT_nat(sc + (Z1T), LDM, 16 * ks, 0, lane_o), bf_ = ld16_(sc + (Z2T) + (r32 * LDM + 16 * ks + 8 * hi) * 2); \
          ACC = MFMA32(af_, bf_, ACC); } } while (0)
#pragma unroll 1
        for (int it = 0; it < 4; ++it) {
          f32x16 Q2;
#pragma unroll
          for (int i = 0; i < 16; ++i) Q2[i] = 0.f;
          CK_MM(Q2, MSZ, MSZ);
          asm volatile("s_waitcnt lgkmcnt(0)" ::: "memory");
          CK_STORE_TN(Q2, sc + MSZ);
          asm volatile("s_waitcnt lgkmcnt(0)" ::: "memory");
          CK_MM(Pm, 2 * MSZ, MSZ);
          asm volatile("s_waitcnt lgkmcnt(0)" ::: "memory");
          if (it < 3) { CK_STORE_TN(Pm, sc + 2 * MSZ); asm volatile("s_waitcnt lgkmcnt(0)" ::: "memory"); }
        }
        CK_STORE_TN(Pm, mx + 3 * MSZ);
#undef CK_MM
      }
      CKT_END();
      LDS_BARRIER();
    }
  } else {
    f32x16 St0, St1;
#pragma unroll
    for (int i = 0; i < 16; ++i) { St0[i] = 0.f; St1[i] = 0.f; }
    if (mode != 2 && ch.L == 2048) {
      const GASF* s0 = p.state_rwkv + ((((size_t)(ch.seq - 16)) * 2 + ch.dir) * 16 + ch.hd) * 4096 + (size_t)(32 * wave + r32) * 64;
#pragma unroll
      for (int q = 0; q < 4; ++q) {
        const f32x4 a = *(const GAS f32x4*)(s0 + 8 * q + 4 * hi), b = *(const GAS f32x4*)(s0 + 32 + 8 * q + 4 * hi);
        St0[4 * q] = a.x; St0[4 * q + 1] = a.y; St0[4 * q + 2] = a.z; St0[4 * q + 3] = a.w;
        St1[4 * q] = b.x; St1[4 * q + 1] = b.y; St1[4 * q + 2] = b.z; St1[4 * q + 3] = b.w;
      }
    }
    LDS_BARRIER();
    for (int k = 0; k < NK; ++k) {
      CKT_BEGIN();
      const int lane = opq5(lane_in); const int hi = lane >> 5, r32 = lane & 31;
      if (mode == 2) {
        if (k >= 4 && wave == 0 && lane == 0) {
          __builtin_amdgcn_fence(__ATOMIC_RELEASE, "agent");
          asm volatile("s_waitcnt vmcnt(0)" ::: "memory");
          __hip_atomic_store((unsigned*)(ws + M_CTL + CK_FLAGS) + (unsigned)(cidx * CK_NREC + (ch.kofs + (k - 4) - CK_K0)), 1u, __ATOMIC_RELAXED, __HIP_MEMORY_SCOPE_AGENT);
        }
        if (k >= 3) {
          const int kc = k - 3;
          unsigned char* rp = ck_rec(ws, (unsigned)(cidx * CK_NREC + (ch.kofs + kc - CK_K0)));
          LAS const unsigned char* ob = lds + (kc % 3) * CK_OPS;
          LAS const unsigned char* mxb = lds + CK_MX + (kc & 1) * CK_MXS;
          const int l2 = wave * 64 + lane;
#pragma unroll 4
          for (int i = 0; i < 8; ++i) *(u32x4*)(rp + (l2 + 128 * i) * 16) = *(LAS const u32x4*)(ob + (l2 + 128 * i) * 16);
          if (l2 < 64) *(u32x4*)(rp + (1024 + l2) * 16) = *(LAS const u32x4*)(ob + (1024 + l2) * 16);
          else if (l2 < 80) *(u32x4*)(rp + (1024 + l2) * 16) = *(LAS const u32x4*)(ob + O_W + (l2 - 64) * 16);
#pragma unroll 4
          for (int i = 0; i < 4; ++i) *(u32x4*)(rp + 4 * OSZ + 256 + (l2 + 128 * i) * 16) = *(LAS const u32x4*)(mxb + (l2 + 128 * i) * 16);
          if (l2 < 64) *(u32x4*)(rp + 4 * OSZ + 256 + (512 + l2) * 16) = *(LAS const u32x4*)(mxb + (512 + l2) * 16);
          asm volatile("s_waitcnt vmcnt(0)" ::: "memory");
        }
      } else if (k >= 3) {
        const int kc = k - 3, ih = wave;
        LAS const unsigned char* ob = lds + (kc % 3) * CK_OPS;
        LAS const unsigned char* mx = lds + CK_MX + (kc & 1) * CK_MXS;
        const bf16x8 s00 = cvt8(St0, 0), s01 = cvt8(St0, 1), s10 = cvt8(St1, 0), s11 = cvt8(St1, 1);
        const bf16x8 v0 = ldT_perm(ob + O_V, LDO, 0, 32 * ih, lane), v1 = ldT_perm(ob + O_V, LDO, 16, 32 * ih, lane);
        f32x16 G, U, Y;
#pragma unroll
        for (int i = 0; i < 16; ++i) { G[i] = 0.f; U[i] = 0.f; Y[i] = 0.f; }
        G = MFMA32(ldA_perm(ob + 0, LDO, r32, 0, hi), s00, G);  G = MFMA32(ldA_perm(ob + 0, LDO, r32, 16, hi), s01, G);
        G = MFMA32(ldA_perm(ob + 0, LDO, r32, 32, hi), s10, G); G = MFMA32(ldA_perm(ob + 0, LDO, r32, 48, hi), s11, G);
        G = MFMA32(ldA_perm(mx + 0, LDM, r32, 0, hi), v0, G);   G = MFMA32(ldA_perm(mx + 0, LDM, r32, 16, hi), v1, G);
        const bf16x8 g0 = cvt8(G, 0), g1 = cvt8(G, 1);
        U = MFMA32(ldA_perm(mx + 3 * MSZ, LDM, r32, 0, hi), g0, U); U = MFMA32(ldA_perm(mx + 3 * MSZ, LDM, r32, 16, hi), g1, U);
        const bf16x8 u0 = cvt8(U, 0), u1 = cvt8(U, 1);
        Y = MFMA32(ldA_perm(ob + O_R, LDO, r32, 0, hi), s00, Y);  Y = MFMA32(ldA_perm(ob + O_R, LDO, r32, 16, hi), s01, Y);
        Y = MFMA32(ldA_perm(ob + O_R, LDO, r32, 32, hi), s10, Y); Y = MFMA32(ldA_perm(ob + O_R, LDO, r32, 48, hi), s11, Y);
        Y = MFMA32(ldA_perm(mx + MSZ, LDM, r32, 0, hi), u0, Y);    Y = MFMA32(ldA_perm(mx + MSZ, LDM, r32, 16, hi), u1, Y);
        Y = MFMA32(ldA_perm(mx + 2 * MSZ, LDM, r32, 0, hi), v0, Y);    Y = MFMA32(ldA_perm(mx + 2 * MSZ, LDM, r32, 16, hi), v1, Y);
        St0 = MFMA32(ldT_perm(ob + O_B, LDO, 0, 0, lane), u0, St0);  St0 = MFMA32(ldT_perm(ob + O_B, LDO, 16, 0, lane), u1, St0);
        St0 = MFMA32(ldT_perm(ob + O_K, LDO, 0, 0, lane), v0, St0);  St0 = MFMA32(ldT_perm(ob + O_K, LDO, 16, 0, lane), v1, St0);
        St1 = MFMA32(ldT_perm(ob + O_B, LDO, 0, 32, lane), u0, St1); St1 = MFMA32(ldT_perm(ob + O_B, LDO, 16, 32, lane), u1, St1);
        St1 = MFMA32(ldT_perm(ob + O_K, LDO, 0, 32, lane), v0, St1); St1 = MFMA32(ldT_perm(ob + O_K, LDO, 16, 32, lane), v1, St1);
        LAS const float* wt = (LAS const float*)(ob + O_W);
#pragma unroll
        for (int q = 0; q < 4; ++q) {
          const f32x4 w0 = *(LAS const f32x4*)(wt + 8 * q + 4 * hi), w1 = *(LAS const f32x4*)(wt + 32 + 8 * q + 4 * hi);
          St0[4 * q] *= w0.x; St0[4 * q + 1] *= w0.y; St0[4 * q + 2] *= w0.z; St0[4 * q + 3] *= w0.w;
          St1[4 * q] *= w1.x; St1[4 * q + 1] *= w1.y; St1[4 * q + 2] *= w1.z; St1[4 * q + 3] *= w1.w;
        }
        {
          const int tk0 = ctok(ch.m0, ch.L, ch.dir, sb0 + 32 * kc); const int dstep = ch.dir ? -1 : 1;
          const unsigned cb = (unsigned)(ch.hd * 64 + 32 * ih + r32);
#pragma unroll
          for (int i = 0; i < 16; ++i) Yo[(unsigned)(tk0 + crow_(i, hi) * dstep) * (unsigned)D + cb] = Y[i];
        }
      }
      CKT_END();
      LDS_BARRIER();
    }
    if (mode == 2 && wave == 0 && lane == 0) {
      __builtin_amdgcn_fence(__ATOMIC_RELEASE, "agent");
      asm volatile("s_waitcnt vmcnt(0)" ::: "memory");
      __hip_atomic_store((unsigned*)(ws + M_CTL + CK_FLAGS) + (unsigned)(cidx * CK_NREC + (ch.kofs + ch.nch - 1 - CK_K0)), 1u, __ATOMIC_RELAXED, __HIP_MEMORY_SCOPE_AGENT);
    }
    if (mode != 2 && ch.L == 256) {
    GASF* so = p.out + OUT_ST + ((((size_t)ch.seq) * 2 + ch.dir) * 16 + ch.hd) * 4096 + (size_t)(32 * wave + r32) * 64;
#pragma unroll
    for (int q = 0; q < 4; ++q) {
      *(GAS f32x4*)(so + 8 * q + 4 * hi) = (f32x4){St0[4 * q], St0[4 * q + 1], St0[4 * q + 2], St0[4 * q + 3]};
      *(GAS f32x4*)(so + 32 + 8 * q + 4 * hi) = (f32x4){St1[4 * q], St1[4 * q + 1], St1[4 * q + 2], St1[4 * q + 3]};
    }
  }
  }
}

__device__ __forceinline__ void phase_rw_scan_ck(const LAS PG& p, unsigned char* ws, LAS unsigned char* lds, int tid, int lane, int wave, int bid, int G) {
  int dfirst = bid * 8 + wave, dstride = G * 8;
  if (G == 256) {
    if (bid < 64) { __syncthreads(); ck_run_chain(p, ws, lds, ck_chain(bid), lane, wave, 1, CK_K0, bid); dfirst = NTR_DEF; }
    else {
      const int pb = bid - 64;
      {
        CkChain pch = ck_chain(pb / 3); pch.kofs = CK_K0 + 8 * (pb % 3); pch.nch = 8;
        __syncthreads(); ck_run_chain(p, ws, lds, pch, lane, wave, 2, 8, pb / 3);
      }
      if (pb >= 128) {
        CkChain pch = ck_chain(pb - 128); pch.kofs = CK_K0 + 24; pch.nch = 8;
        __syncthreads(); ck_run_chain(p, ws, lds, pch, lane, wave, 2, 8, pb - 128);
      }
      for (int pc = pb; pc < 512; pc += 192) { __syncthreads(); ck_run_chain(p, ws, lds, ck_chain(64 + pc), lane, wave, 0, 8, 0); }
      dfirst = (bid - 64) * 8 + wave; dstride = 192 * 8;
    }
  } else {
    for (int id = bid; id < 576; id += G) { __syncthreads(); const CkChain cc = ck_chain(id); ck_run_chain(p, ws, lds, cc, lane, wave, 0, cc.nch, 0); }
  }
  __syncthreads();
  tr_run<1>(p, ws, (LAS float*)(lds + wave * 16384), lane, dfirst, dstride, NTR_DEF);
}
__device__ __forceinline__ int opq(int x) { asm volatile("" : "+v"(x)); return x; }
#ifndef RPT_MASK
#define RPT_MASK 0u
#endif
struct MArgs { P p; int ph_lo, ph_hi; };
__global__ void __launch_bounds__(512, 2) mega(MArgs a) {
  extern __shared__ __attribute__((aligned(16))) unsigned char lds_raw[];
  LAS unsigned char* lds = (LAS unsigned char*)lds_raw;
  const int tid = threadIdx.x, lane = tid & 63, wave = __builtin_amdgcn_readfirstlane(tid >> 6);
  const int G = gridDim.x, bid = blockIdx.x;
  unsigned char* ws = (unsigned char*)a.p.ws;
  if (tid == 0) {
    LAS PG* t = (LAS PG*)(lds + PTAB_OFF);
    t->x_prompt = (decltype(t->x_prompt))a.p.x_prompt;
    t->x_sample = (decltype(t->x_sample))a.p.x_sample;
    t->cache_ckv = (decltype(t->cache_ckv))a.p.cache_ckv;
    t->cache_kpe = (decltype(t->cache_kpe))a.p.cache_kpe;
    t->state_rwkv = (decltype(t->state_rwkv))a.p.state_rwkv;
    t->c = (decltype(t->c))a.p.c;
    t->c_ctx = (decltype(t->c_ctx))a.p.c_ctx;
    t->mod_w = (decltype(t->mod_w))a.p.mod_w;
    t->mod_b = (decltype(t->mod_b))a.p.mod_b;
    t->ln_g = (decltype(t->ln_g))a.p.ln_g;
    t->ln_b = (decltype(t->ln_b))a.p.ln_b;
    t->hy_w_in = (decltype(t->hy_w_in))a.p.hy_w_in;
    t->hy_conv_w = (decltype(t->hy_conv_w))a.p.hy_conv_w;
    t->hy_conv_b = (decltype(t->hy_conv_b))a.p.hy_conv_b;
    t->hy_w1 = (decltype(t->hy_w1))a.p.hy_w1;
    t->hy_b1 = (decltype(t->hy_b1))a.p.hy_b1;
    t->hy_w2 = (decltype(t->hy_w2))a.p.hy_w2;
    t->hy_b2 = (decltype(t->hy_b2))a.p.hy_b2;
    t->hy_w3 = (decltype(t->hy_w3))a.p.hy_w3;
    t->hy_b3 = (decltype(t->hy_b3))a.p.hy_b3;
    t->hy_freq = (decltype(t->hy_freq))a.p.hy_freq;
    t->hy_decay = (decltype(t->hy_decay))a.p.hy_decay;
    t->hy_skip = (decltype(t->hy_skip))a.p.hy_skip;
    t->hy_w_out = (decltype(t->hy_w_out))a.p.hy_w_out;
    t->mla_w_in = (decltype(t->mla_w_in))a.p.mla_w_in;
    t->mla_q_norm = (decltype(t->mla_q_norm))a.p.mla_q_norm;
    t->mla_kv_norm = (decltype(t->mla_kv_norm))a.p.mla_kv_norm;
    t->mla_w_q_up = (decltype(t->mla_w_q_up))a.p.mla_w_q_up;
    t->mla_w_kv_up = (decltype(t->mla_w_kv_up))a.p.mla_w_kv_up;
    t->mla_w_out = (decltype(t->mla_w_out))a.p.mla_w_out;
    t->rw_mu = (decltype(t->rw_mu))a.p.rw_mu;
    t->rw_w_in = (decltype(t->rw_w_in))a.p.rw_w_in;
    t->rw_w0 = (decltype(t->rw_w0))a.p.rw_w0;
    t->rw_w1 = (decltype(t->rw_w1))a.p.rw_w1;
    t->rw_w2 = (decltype(t->rw_w2))a.p.rw_w2;
    t->rw_a0 = (decltype(t->rw_a0))a.p.rw_a0;
    t->rw_a1 = (decltype(t->rw_a1))a.p.rw_a1;
    t->rw_a2 = (decltype(t->rw_a2))a.p.rw_a2;
    t->rw_k_k = (decltype(t->rw_k_k))a.p.rw_k_k;
    t->rw_k_a = (decltype(t->rw_k_a))a.p.rw_k_a;
    t->rw_r_k = (decltype(t->rw_r_k))a.p.rw_r_k;
    t->rw_gn_g = (decltype(t->rw_gn_g))a.p.rw_gn_g;
    t->rw_gn_b = (decltype(t->rw_gn_b))a.p.rw_gn_b;
    t->rw_w_out = (decltype(t->rw_w_out))a.p.rw_w_out;
    t->out = (decltype(t->out))a.p.out;
    t->ws = (decltype(t->ws))a.p.ws;
  }
  const LAS PG& p = *(const LAS PG*)(lds + PTAB_OFF);
  volatile LAS unsigned* MISC = (volatile LAS unsigned*)(lds + MISC_OFF);
  for (int u = tid; u < 128; u += 512) ((LAS unsigned*)(lds + MISC_OFF))[u] = 0u;
  __syncthreads();
  const int lo = a.ph_lo, hi = a.ph_hi;
  XcdBarrier bar; bar.bar = (unsigned*)(ws + M_CTL); bar.x = 0; bar.st = nullptr;
  if (hi - lo > 0 || RPT_MASK) bar = xcd_barrier_post((unsigned*)(ws + M_CTL), MISC + 8);
#ifndef PH_MASK
#define PH_MASK 0xffffffffu
#endif
#ifndef TP_PHASE
#define TP_PHASE -1
#endif
#ifndef TP_MULT
#define TP_MULT 4
#endif
  unsigned long long tp0 = (TP_PHASE == 0) ? __builtin_amdgcn_s_memrealtime() : 0ull, tp1 = 0ull;
#define IN(k) (((PH_MASK >> (k)) & 1u) && lo <= (k) && (k) < hi)
#define SEAM(k) do { if (IN(k) && IN((k) + 1)) xcd_barrier(bar); if ((k) + 1 == TP_PHASE) tp0 = __builtin_amdgcn_s_memrealtime(); if ((k) == TP_PHASE) tp1 = __builtin_amdgcn_s_memrealtime(); } while (0)
  if (IN(0)) { { phase_p0a(p, ws, lds, opq((int)threadIdx.x), (opq((int)threadIdx.x) & 63), wave, bid, G); } if ((RPT_MASK >> 0) & 1u) { xcd_barrier(bar); { phase_p0a(p, ws, lds, opq((int)threadIdx.x), (opq((int)threadIdx.x) & 63), wave, bid, G); } } } SEAM(0);
  if (IN(1)) { { phase_p0b(p, ws, lds, opq((int)threadIdx.x), (opq((int)threadIdx.x) & 63), wave, bid, G); } if ((RPT_MASK >> 1) & 1u) { xcd_barrier(bar); { phase_p0b(p, ws, lds, opq((int)threadIdx.x), (opq((int)threadIdx.x) & 63), wave, bid, G); } } } SEAM(1);
  if (IN(2)) { {
    pg8::Gemm g{(const pg8::bf16_t*)(ws + W_HYIN), (const pg8::bf16_t*)(ws + M_HB), 4096, 8192, 1024};
    pg8::StaticOrder S; S.init(4096, 8192, G, bid);
    pg8::EpiBf16<0> E{(pg8::bf16_t*)(ws + M_UT), 8192, nullptr, 0, 0, 1.f};
    pg8::gemm_phase<pg8::EpiBf16<0>, pg8::StaticOrder, true, true>(lds, g, S, E); } if ((RPT_MASK >> 2) & 1u) { xcd_barrier(bar); {
    pg8::Gemm g{(const pg8::bf16_t*)(ws + W_HYIN), (const pg8::bf16_t*)(ws + M_HB), 4096, 8192, 1024};
    pg8::StaticOrder S; S.init(4096, 8192, G, bid);
    pg8::EpiBf16<0> E{(pg8::bf16_t*)(ws + M_UT), 8192, nullptr, 0, 0, 1.f};
    pg8::gemm_phase<pg8::EpiBf16<0>, pg8::StaticOrder, true, true>(lds, g, S, E); } } } SEAM(2);
  if (IN(3)) { { phase_hy_conv(p, ws, lds, 0, opq((int)threadIdx.x), (opq((int)threadIdx.x) & 63), wave, bid, G); } if ((RPT_MASK >> 3) & 1u) { xcd_barrier(bar); { phase_hy_conv(p, ws, lds, 0, opq((int)threadIdx.x), (opq((int)threadIdx.x) & 63), wave, bid, G); } } } SEAM(3);
  if (IN(4)) { { phase_out_ln<1>(p, ws, lds, 0, (const bf16_t*)(ws + W_HYOUT), opq((int)threadIdx.x), (opq((int)threadIdx.x) & 63), wave, bid, G); } if ((RPT_MASK >> 4) & 1u) { xcd_barrier(bar); { phase_out_ln<1>(p, ws, lds, 0, (const bf16_t*)(ws + W_HYOUT), opq((int)threadIdx.x), (opq((int)threadIdx.x) & 63), wave, bid, G); } } } SEAM(4);
  if (IN(5)) { {
    pg8::Gemm g{(const pg8::bf16_t*)(ws + M_HB), (const pg8::bf16_t*)(ws + W_MLAIN + MiB), 8192, 1024, 1024};
    pg8::StaticOrder S; S.init(8192, 1024, G, bid);
    EpiSilu E{(bf16_t*)(ws + M_SZB), 1024};
    pg8::gemm_phase<EpiSilu, pg8::StaticOrder, true, true>(lds, g, S, E);
    { pg8::Gemm g2{(const pg8::bf16_t*)(ws + M_HB), (const pg8::bf16_t*)(ws + W_MLAIN), 8192, 512, 1024};
      pg8::StaticOrder S2; S2.init(8192, 512, G, (bid + G - 128 % G) % G);
      EpiF32 E2{(float*)(ws + M_U2S), 512};
      pg8::gemm_phase<EpiF32, pg8::StaticOrder, true, true>(lds, g2, S2, E2); }
    if (G == 256 && bid >= 192) { __syncthreads(); tr_run<2>(p, ws, (LAS float*)(lds + wave * 16384), (opq((int)threadIdx.x) & 63), (bid - 192) * 8 + wave, 64 * 8, NTR_DEF2); }
    else if (G != 256) { __syncthreads(); tr_run<2>(p, ws, (LAS float*)(lds + wave * 16384), (opq((int)threadIdx.x) & 63), bid * 8 + wave, G * 8, NTR_DEF2); } } if ((RPT_MASK >> 5) & 1u) { xcd_barrier(bar); {
    pg8::Gemm g{(const pg8::bf16_t*)(ws + M_HB), (const pg8::bf16_t*)(ws + W_MLAIN + MiB), 8192, 1024, 1024};
    pg8::StaticOrder S; S.init(8192, 1024, G, bid);
    EpiSilu E{(bf16_t*)(ws + M_SZB), 1024};
    pg8::gemm_phase<EpiSilu, pg8::StaticOrder, true, true>(lds, g, S, E);
    { pg8::Gemm g2{(const pg8::bf16_t*)(ws + M_HB), (const pg8::bf16_t*)(ws + W_MLAIN), 8192, 512, 1024};
      pg8::StaticOrder S2; S2.init(8192, 512, G, (bid + G - 128 % G) % G);
      EpiF32 E2{(float*)(ws + M_U2S), 512};
      pg8::gemm_phase<EpiF32, pg8::StaticOrder, true, true>(lds, g2, S2, E2); }
    if (G == 256 && bid >= 192) { __syncthreads(); tr_run<2>(p, ws, (LAS float*)(lds + wave * 16384), (opq((int)threadIdx.x) & 63), (bid - 192) * 8 + wave, 64 * 8, NTR_DEF2); }
    else if (G != 256) { __syncthreads(); tr_run<2>(p, ws, (LAS float*)(lds + wave * 16384), (opq((int)threadIdx.x) & 63), bid * 8 + wave, G * 8, NTR_DEF2); } } } } SEAM(5);
  if (IN(6)) { { phase_mla_rows(p, ws, (opq((int)threadIdx.x) & 63), wave, bid, G); xcd_barrier(bar); } {
    { pg8::Gemm g{(const pg8::bf16_t*)(ws + M_QN), (const pg8::bf16_t*)(ws + W_QUP), 8192, 1536, 256};
      pg8::StaticOrder S; S.init(8192, 1536, G, bid);
      pg8::EpiBf16<0> E{(pg8::bf16_t*)(ws + M_Q), 1536, nullptr, 0, 0, 1.f};
      pg8::gemm_phase<pg8::EpiBf16<0>, pg8::StaticOrder, true, true>(lds, g, S, E); }
    { pg8::Gemm g{(const pg8::bf16_t*)(ws + M_CKVALL), (const pg8::bf16_t*)(ws + W_KVUP), 9216, 2048, 128};
      pg8::StaticOrder S; S.init(9216, 2048, G, (bid + G - 192 % G) % G);
      EpiKV E{(bf16_t*)(ws + M_KN), (bf16_t*)(ws + M_V)};
      pg8::gemm_phase<EpiKV, pg8::StaticOrder, true, true>(lds, g, S, E); } } if ((RPT_MASK >> 6) & 1u) { xcd_barrier(bar); { phase_mla_rows(p, ws, (opq((int)threadIdx.x) & 63), wave, bid, G); xcd_barrier(bar); } {
    { pg8::Gemm g{(const pg8::bf16_t*)(ws + M_QN), (const pg8::bf16_t*)(ws + W_QUP), 8192, 1536, 256};
      pg8::StaticOrder S; S.init(8192, 1536, G, bid);
      pg8::EpiBf16<0> E{(pg8::bf16_t*)(ws + M_Q), 1536, nullptr, 0, 0, 1.f};
      pg8::gemm_phase<pg8::EpiBf16<0>, pg8::StaticOrder, true, true>(lds, g, S, E); }
    { pg8::Gemm g{(const pg8::bf16_t*)(ws + M_CKVALL), (const pg8::bf16_t*)(ws + W_KVUP), 9216, 2048, 128};
      pg8::StaticOrder S; S.init(9216, 2048, G, (bid + G - 192 % G) % G);
      EpiKV E{(bf16_t*)(ws + M_KN), (bf16_t*)(ws + M_V)};
      pg8::gemm_phase<EpiKV, pg8::StaticOrder, true, true>(lds, g, S, E); } } } } SEAM(6);
  if (IN(7)) { {
    for (int u = bid; u < 512; u += G) {
      int seq, hd, qb;
      if (u < 256) { seq = 16 + (u >> 7); hd = (u >> 3) & 15; qb = u & 7; } else { const int uu = u - 256; seq = uu >> 4; hd = uu & 15; qb = 0; }
      attn_unit(ws, lds, seq, hd, qb, (bf16_t*)(ws + M_GB), opq((int)threadIdx.x), (opq((int)threadIdx.x) & 63), wave);
    } } if ((RPT_MASK >> 7) & 1u) { xcd_barrier(bar); {
    for (int u = bid; u < 512; u += G) {
      int seq, hd, qb;
      if (u < 256) { seq = 16 + (u >> 7); hd = (u >> 3) & 15; qb = u & 7; } else { const int uu = u - 256; seq = uu >> 4; hd = uu & 15; qb = 0; }
      attn_unit(ws, lds, seq, hd, qb, (bf16_t*)(ws + M_GB), opq((int)threadIdx.x), (opq((int)threadIdx.x) & 63), wave);
    } } } } SEAM(7);
  if (IN(8)) { { phase_out_ln<0>(p, ws, lds, 1, (const bf16_t*)(ws + W_MLAOUT), opq((int)threadIdx.x), (opq((int)threadIdx.x) & 63), wave, bid, G); } if ((RPT_MASK >> 8) & 1u) { xcd_barrier(bar); { phase_out_ln<0>(p, ws, lds, 1, (const bf16_t*)(ws + W_MLAOUT), opq((int)threadIdx.x), (opq((int)threadIdx.x) & 63), wave, bid, G); } } } SEAM(8);
  if (IN(9)) { { phase_rw_mix(p, ws, opq((int)threadIdx.x), bid, G); } if ((RPT_MASK >> 9) & 1u) { xcd_barrier(bar); { phase_rw_mix(p, ws, opq((int)threadIdx.x), bid, G); } } } SEAM(9);
  if (IN(10)) { {
#pragma unroll 1
    for (int q = 0; q < 4; ++q) {
      pg8::Gemm g{(const pg8::bf16_t*)(ws + M_XMIX + (size_t)q * 16 * MiB), (const pg8::bf16_t*)(ws + W_RWIN + (size_t)q * 2 * MiB), 8192, 1024, 1024};
      pg8::StaticOrder S; S.init(8192, 1024, G, (bid + (q & 1) * (G / 2)) % G);
      if (q < 3) { pg8::EpiBf16<0> E{(pg8::bf16_t*)(ws + M_SCR2 + (size_t)q * 16 * MiB), 1024, nullptr, 0, 0, 1.f}; pg8::gemm_phase<pg8::EpiBf16<0>, pg8::StaticOrder, true, true>(lds, g, S, E); }
      else { EpiSilu E{(bf16_t*)(ws + M_SZR), 1024}; pg8::gemm_phase<EpiSilu, pg8::StaticOrder, true, true>(lds, g, S, E); }
    }
    for (int tile = bid; tile < 256; tile += G) rw_lora_tile(p, ws, lds, tile, opq((int)threadIdx.x), (opq((int)threadIdx.x) & 63), wave); } if ((RPT_MASK >> 10) & 1u) { xcd_barrier(bar); {
#pragma unroll 1
    for (int q = 0; q < 4; ++q) {
      pg8::Gemm g{(const pg8::bf16_t*)(ws + M_XMIX + (size_t)q * 16 * MiB), (const pg8::bf16_t*)(ws + W_RWIN + (size_t)q * 2 * MiB), 8192, 1024, 1024};
      pg8::StaticOrder S; S.init(8192, 1024, G, (bid + (q & 1) * (G / 2)) % G);
      if (q < 3) { pg8::EpiBf16<0> E{(pg8::bf16_t*)(ws + M_SCR2 + (size_t)q * 16 * MiB), 1024, nullptr, 0, 0, 1.f}; pg8::gemm_phase<pg8::EpiBf16<0>, pg8::StaticOrder, true, true>(lds, g, S, E); }
      else { EpiSilu E{(bf16_t*)(ws + M_SZR), 1024}; pg8::gemm_phase<EpiSilu, pg8::StaticOrder, true, true>(lds, g, S, E); }
    }
    for (int tile = bid; tile < 256; tile += G) rw_lora_tile(p, ws, lds, tile, opq((int)threadIdx.x), (opq((int)threadIdx.x) & 63), wave); } } } SEAM(10);
  if (IN(11)) { { phase_rw_scan_ck(p, ws, lds, opq((int)threadIdx.x), (opq((int)threadIdx.x) & 63), wave, bid, G); } if ((RPT_MASK >> 11) & 1u) { xcd_barrier(bar); { phase_rw_scan_ck(p, ws, lds, opq((int)threadIdx.x), (opq((int)threadIdx.x) & 63), wave, bid, G); } } } SEAM(11);
  if (IN(12)) { { phase_out_ln<2>(p, ws, lds, 2, (const bf16_t*)(ws + W_RWOUT), opq((int)threadIdx.x), (opq((int)threadIdx.x) & 63), wave, bid, G); } if ((RPT_MASK >> 12) & 1u) { xcd_barrier(bar); { phase_out_ln<2>(p, ws, lds, 2, (const bf16_t*)(ws + W_RWOUT), opq((int)threadIdx.x), (opq((int)threadIdx.x) & 63), wave, bid, G); } } } SEAM(12);
  if (IN(13)) { {
    pg8::Gemm g{(const pg8::bf16_t*)(ws + W_HYIN + 8 * MiB), (const pg8::bf16_t*)(ws + M_HB), 4096, 8192, 1024};
    pg8::StaticOrder S; S.init(4096, 8192, G, bid);
    pg8::EpiBf16<0> E{(pg8::bf16_t*)(ws + M_UT), 8192, nullptr, 0, 0, 1.f};
    pg8::gemm_phase<pg8::EpiBf16<0>, pg8::StaticOrder, true, true>(lds, g, S, E); } if ((RPT_MASK >> 13) & 1u) { xcd_barrier(bar); {
    pg8::Gemm g{(const pg8::bf16_t*)(ws + W_HYIN + 8 * MiB), (const pg8::bf16_t*)(ws + M_HB), 4096, 8192, 1024};
    pg8::StaticOrder S; S.init(4096, 8192, G, bid);
    pg8::EpiBf16<0> E{(pg8::bf16_t*)(ws + M_UT), 8192, nullptr, 0, 0, 1.f};
    pg8::gemm_phase<pg8::EpiBf16<0>, pg8::StaticOrder, true, true>(lds, g, S, E); } } } SEAM(13);
  if (IN(14)) { { phase_hy_conv(p, ws, lds, 1, opq((int)threadIdx.x), (opq((int)threadIdx.x) & 63), wave, bid, G); } if ((RPT_MASK >> 14) & 1u) { xcd_barrier(bar); { phase_hy_conv(p, ws, lds, 1, opq((int)threadIdx.x), (opq((int)threadIdx.x) & 63), wave, bid, G); } } } SEAM(14);
  if (IN(15)) { { phase_out_ln<1>(p, ws, lds, 3, (const bf16_t*)(ws + W_HYOUT + 2 * MiB), opq((int)threadIdx.x), (opq((int)threadIdx.x) & 63), wave, bid, G); } if ((RPT_MASK >> 15) & 1u) { xcd_barrier(bar); { phase_out_ln<1>(p, ws, lds, 3, (const bf16_t*)(ws + W_HYOUT + 2 * MiB), opq((int)threadIdx.x), (opq((int)threadIdx.x) & 63), wave, bid, G); } } }
  if (TP_PHASE >= 0 && bid == 0) { if (TP_PHASE == 15) tp1 = __builtin_amdgcn_s_memrealtime(); if (TP_PHASE == 99) { tp0 = 0ull; tp1 = (unsigned long long)MISC[40]; } const unsigned long long dl = (tp1 - tp0) * TP_MULT; const unsigned long long ts = __builtin_amdgcn_s_memrealtime(); while (__builtin_amdgcn_s_memrealtime() - ts < dl) __builtin_amdgcn_s_sleep(8); }
#undef IN
#undef SEAM
}
}
}

extern "C" void kernel_launch(void* const* d_in, const int* in_sizes, int n_in, void* d_out, int out_size, void* d_ws, size_t ws_size, hipStream_t stream) {
  P p{};
  const float** pp = (const float**)&p;
  for (int i = 0; i < 44; ++i) pp[i] = (const float*)d_in[i];
  p.out = (float*)d_out; p.ws = (float*)d_ws;
  float* ws = p.ws;
  static int grid = 0;
  if (grid == 0) {
    int dev = 0, cus = 0;
    (void)hipGetDevice(&dev); (void)hipDeviceGetAttribute(&cus, hipDeviceAttributeMultiprocessorCount, dev);
    (void)hipFuncSetAttribute((const void*)mk::mega, hipFuncAttributeMaxDynamicSharedMemorySize, mk::LDS_BYTES);
    grid = cus > 0 ? cus : 256;
  }
  (void)hipMemsetAsync((char*)d_ws + mk::M_CTL, 0, 65536, stream);
  mk::MArgs a{}; a.p = p; a.ph_lo = 0; a.ph_hi = MEGA_PHASES;
  hipLaunchKernelGGL(mk::mega, dim3(grid), dim3(512), mk::LDS_BYTES, stream, a);

  float* X = ws + WS_X; float* S1 = ws + WS_S1; float* S4 = ws + WS_S4; float* S2 = ws + WS_S2;
  const int EB = (int)((SZ + 255) / 256);
  if (NAIVE_FROM < 4) hipLaunchKernelGGL(k_mods, dim3((4 * 3 * 3072 + 255) / 256), dim3(256), 0, stream, p);
  for (int layer = NAIVE_FROM; layer < 4; ++layer) {
    const int kind = layer % 3, j = layer / 3;
    const float* xa = (layer == 0) ? p.x_prompt : X;
    const float* xb = (layer == 0) ? p.x_sample : X + (size_t)NPT * D;
    float* Xn = (layer == 3) ? p.out + OUT_Y : X;
    hipLaunchKernelGGL(k_modulate, dim3(EB), dim3(256), 0, stream, p, xa, xb, S1, layer);
    if (kind == 0) {
      hipLaunchKernelGGL(k_hy_filter, dim3(2304), dim3(256), 0, stream, p, j);
      gemm(stream, ALPlain{S1, D}, p.hy_w_in + (size_t)j * D * 4096, 4096, NTOK, 4096, D, EPPlain{S2, 4096});
      hipLaunchKernelGGL(k_hy_vv, dim3(EB), dim3(256), 0, stream, p, S2, S1, j);
      hipLaunchKernelGGL(k_hy_long, dim3(EB), dim3(256), 0, stream, p, S2, S1, S4, j);
      gemm(stream, ALPlain{S4, D}, p.hy_w_out + (size_t)j * D * D, D, NTOK, D, D, EPPlain{S1, D});
    } else if (kind == 1) {
      float* U2 = S2; float* QN = S1; float* CKVALL = S1 + (size_t)NTOK * 256; float* KPEALL = CKVALL + (size_t)9216 * 128;
      float* Q = S2; float* KV = S2 + (size_t)NTOK * 1536;
      gemm(stream, ALPlain{S1, D}, p.mla_w_in, 1440, NTOK, 1440, D, EPPlain{U2, 1440});
      hipLaunchKernelGGL(k_mla_extract, dim3(NTOK), dim3(64), 0, stream, p, U2, QN, CKVALL, KPEALL, S4);
      hipLaunchKernelGGL(k_mla_cache, dim3((2 * PAST * 128 + 255) / 256), dim3(256), 0, stream, p, CKVALL, KPEALL);
      gemm(stream, ALPlain{QN, 256}, p.mla_w_q_up, 1536, NTOK, 1536, 256, EPPlain{Q, 1536});
      hipLaunchKernelGGL(k_rope_q, dim3((4096 * 16 + 255) / 256), dim3(256), 0, stream, Q);
      gemm(stream, ALPlain{CKVALL, 128}, p.mla_w_kv_up, 2048, 9216, 2048, 128, EPPlain{KV, 2048});
      hipLaunchKernelGGL(k_attn, dim3(32, 18 * 16), dim3(64), 0, stream, Q, KV, KPEALL, S4);
      gemm(stream, ALPlain{S4, D}, p.mla_w_out, D, NTOK, D, D, EPPlain{S1, D});
    } else {
      float* R = S2; float* K = S2 + SZ; float* V = S2 + 2 * SZ; float* Z = S2 + 3 * SZ;
      float* HW = ws + WS_MISC + MISC_END; float* HA = HW + (size_t)NTOK * 128;
      const float* mu = p.rw_mu; const float* win = p.rw_w_in;
      gemm(stream, ALMix{S1, mu + 0 * D}, win + 0 * (size_t)D * D, D, NTOK, D, D, EPPlain{R, D});
      gemm(stream, ALMix{S1, mu + 2 * D}, win + 1 * (size_t)D * D, D, NTOK, D, D, EPPlain{K, D});
      gemm(stream, ALMix{S1, mu + 3 * D}, win + 2 * (size_t)D * D, D, NTOK, D, D, EPPlain{V, D});
      gemm(stream, ALMix{S1, mu + 5 * D}, win + 3 * (size_t)D * D, D, NTOK, D, D, EPPlain{Z, D});
      for (int dir = 0; dir < 2; ++dir) {
        gemm(stream, ALMix{S1, mu + 1 * D}, p.rw_w1 + (size_t)dir * D * 64, 64, NTOK, 64, D, EPTanh{HW + dir * 64, 128});
        gemm(stream, ALMix{S1, mu + 4 * D}, p.rw_a1 + (size_t)dir * D * 64, 64, NTOK, 64, D, EPPlain{HA + dir * 64, 128});
      }
      (void)hipMemsetAsync(S4, 0, SZ * sizeof(float), stream);
      hipLaunchKernelGGL(k_rw_scan, dim3(18 * 32), dim3(64), 0, stream, p, R, K, V, HW, HA, S4);
      hipLaunchKernelGGL(k_rw_post, dim3(NTOK * 16), dim3(64), 0, stream, p, R, K, V, Z, HA, S4, S4);
      gemm(stream, ALPlain{S4, D}, p.rw_w_out, D, NTOK, D, D, EPPlain{S1, D});
    }
    hipLaunchKernelGGL(k_ln, dim3(NTOK / 4), dim3(256), 0, stream, p, xa, xb, S1, Xn, layer);
  }
}
```

```cpp
#define MEGA_PHASES 16
#define NAIVE_FROM 4
#include <hip/hip_runtime.h>
#include <stdint.h>
#include <math.h>

namespace {

constexpr int D = 1024;
constexpr int NTOK = 8192;
constexpr int NPT = 4096;
constexpr int PAST = 512;
constexpr float ALPHA = 1.681792830507429f;
constexpr float LN_EPS = 1e-5f, RMS_EPS = 1e-6f, GN_EPS = 64e-5f;

struct P {
  const float *x_prompt, *x_sample, *cache_ckv, *cache_kpe, *state_rwkv, *c, *c_ctx;
  const float *mod_w, *mod_b, *ln_g, *ln_b;
  const float *hy_w_in, *hy_conv_w, *hy_conv_b, *hy_w1, *hy_b1, *hy_w2, *hy_b2, *hy_w3, *hy_b3, *hy_freq, *hy_decay, *hy_skip, *hy_w_out;
  const float *mla_w_in, *mla_q_norm, *mla_kv_norm, *mla_w_q_up, *mla_w_kv_up, *mla_w_out;
  const float *rw_mu, *rw_w_in, *rw_w0, *rw_w1, *rw_w2, *rw_a0, *rw_a1, *rw_a2, *rw_k_k, *rw_k_a, *rw_r_k, *rw_gn_g, *rw_gn_b, *rw_w_out;
  float* out;
  float* ws;
};

constexpr size_t OUT_Y = 0, OUT_CKV = 8388608, OUT_KPE = 8912896, OUT_ST = 9043968;

constexpr size_t SZ = (size_t)NTOK * D;
constexpr size_t WS_X = 0;
constexpr size_t WS_S1 = WS_X + SZ;
constexpr size_t WS_S4 = WS_S1 + SZ;
constexpr size_t WS_S2 = WS_S4 + SZ;
constexpr size_t WS_MISC = WS_S2 + 4 * SZ;
constexpr size_t MISC_MODS = 0;
constexpr size_t MISC_FILT = 65536;
constexpr size_t MISC_END = MISC_FILT + (size_t)2304 * 2048;

__device__ __forceinline__ float silu(float x) { return x / (1.f + expf(-x)); }
__device__ __forceinline__ float sigmoidf(float x) { return 1.f / (1.f + expf(-x)); }

__device__ __forceinline__ void tokinfo(int m, int& l, int& L, int& cond, int& m0) {
  if (m < NPT) { l = m & 255; L = 256; cond = 0; m0 = m & ~255; }
  else { int mm = m - NPT; l = mm & 2047; L = 2048; cond = 1 + (mm >> 11); m0 = NPT + (mm & ~2047); }
}

__global__ void k_mods(P p) {
  int idx = blockIdx.x * blockDim.x + threadIdx.x;
  if (idx >= 4 * 3 * 3072) return;
  int n = idx % 3072, g = (idx / 3072) % 3, i = idx / (3 * 3072);
  const float* cond = (g == 0) ? p.c_ctx : p.c + (size_t)(g - 1) * D;
  const float* w = p.mod_w + (size_t)i * D * 3072;
  float acc = 0.f;
  for (int k = 0; k < D; ++k) acc += silu(cond[k]) * w[(size_t)k * 3072 + n];
  p.ws[WS_MISC + MISC_MODS + idx] = acc + p.mod_b[i * 3072 + n];
}

__global__ void k_modulate(P p, const float* xa, const float* xb, float* H, int layer) {
  size_t idx = (size_t)blockIdx.x * blockDim.x + threadIdx.x;
  if (idx >= SZ) return;
  int m = (int)(idx >> 10), k = (int)(idx & 1023);
  int l, L, cond, m0; tokinfo(m, l, L, cond, m0);
  const float* md = p.ws + WS_MISC + MISC_MODS + (size_t)(layer * 3 + cond) * 3072;
  float x = (m < NPT) ? xa[idx] : xb[idx - (size_t)NPT * D];
  H[idx] = x * (1.f + md[1024 + k]) + md[k];
}

template <class AL, class EP>
__global__ void __launch_bounds__(256) k_gemm(AL al, const float* __restrict__ W, int ldw, int M, int N, int K, EP ep) {
  __shared__ float As[16][68];
  __shared__ float Bs[16][68];
  const int tx = threadIdx.x & 15, ty = threadIdx.x >> 4;
  const int m0 = blockIdx.y * 64, n0 = blockIdx.x * 64;
  float acc[4][4];
#pragma unroll
  for (int i = 0; i < 4; ++i)
#pragma unroll
    for (int j = 0; j < 4; ++j) acc[i][j] = 0.f;
  for (int k0 = 0; k0 < K; k0 += 16) {
#pragma unroll
    for (int i = 0; i < 4; ++i) {
      int e = threadIdx.x + i * 256; int mm = e >> 4, kk = e & 15;
      As[kk][mm] = (m0 + mm < M) ? al(m0 + mm, k0 + kk) : 0.f;
    }
#pragma unroll
    for (int i = 0; i < 4; ++i) {
      int e = threadIdx.x + i * 256; int kk = e >> 6, nn = e & 63;
      Bs[kk][nn] = (n0 + nn < N) ? W[(size_t)(k0 + kk) * ldw + n0 + nn] : 0.f;
    }
    __syncthreads();
#pragma unroll
    for (int kk = 0; kk < 16; ++kk) {
      float a[4], b[4];
#pragma unroll
      for (int i = 0; i < 4; ++i) { a[i] = As[kk][ty * 4 + i]; b[i] = Bs[kk][tx * 4 + i]; }
#pragma unroll
      for (int i = 0; i < 4; ++i)
#pragma unroll
        for (int j = 0; j < 4; ++j) acc[i][j] += a[i] * b[j];
    }
    __syncthreads();
  }
#pragma unroll
  for (int i = 0; i < 4; ++i)
#pragma unroll
    for (int j = 0; j < 4; ++j) {
      int m = m0 + ty * 4 + i, n = n0 + tx * 4 + j;
      if (m < M && n < N) ep(m, n, acc[i][j]);
    }
}

struct ALPlain { const float* A; long lda; __device__ float operator()(int m, int k) const { return A[(size_t)m * lda + k]; } };
struct EPPlain { float* C; long ldc; __device__ void operator()(int m, int n, float v) const { C[(size_t)m * ldc + n] = v; } };
struct EPTanh { float* C; long ldc; __device__ void operator()(int m, int n, float v) const { C[(size_t)m * ldc + n] = tanhf(v); } };
struct ALMix {
  const float* H; const float* mu;
  __device__ float operator()(int m, int k) const {
    int l, L, cond, m0; tokinfo(m, l, L, cond, m0);
    float h = H[(size_t)m * D + k];
    float pv = (l > 0) ? H[(size_t)(m - 1) * D + k] : 0.f;
    float nx = (l < L - 1) ? H[(size_t)(m + 1) * D + k] : 0.f;
    return h + (0.5f * (pv + nx) - h) * mu[k];
  }
};

template <class AL, class EP>
void gemm(hipStream_t s, AL al, const float* W, int ldw, int M, int N, int K, EP ep) {
  dim3 g((N + 63) / 64, (M + 63) / 64);
  hipLaunchKernelGGL((k_gemm<AL, EP>), g, dim3(256), 0, s, al, W, ldw, M, N, K, ep);
}

__global__ void __launch_bounds__(256) k_ln(P p, const float* xa, const float* xb, const float* O, float* Xn, int layer) {
  int m = blockIdx.x * 4 + (threadIdx.x >> 6), lane = threadIdx.x & 63;
  int l, L, cond, m0; tokinfo(m, l, L, cond, m0);
  const float* gate = p.ws + WS_MISC + MISC_MODS + (size_t)(layer * 3 + cond) * 3072 + 2048;
  const float* xr = (m < NPT) ? xa + (size_t)m * D : xb + (size_t)(m - NPT) * D;
  float v[16]; float s = 0.f;
#pragma unroll
  for (int i = 0; i < 16; ++i) { int k = lane + 64 * i; v[i] = ALPHA * xr[k] + gate[k] * O[(size_t)m * D + k]; s += v[i]; }
#pragma unroll
  for (int o = 1; o < 64; o <<= 1) s += __shfl_xor(s, o);
  float mu = s * (1.f / D), q = 0.f;
#pragma unroll
  for (int i = 0; i < 16; ++i) { v[i] -= mu; q += v[i] * v[i]; }
#pragma unroll
  for (int o = 1; o < 64; o <<= 1) q += __shfl_xor(q, o);
  float rs = rsqrtf(q * (1.f / D) + LN_EPS);
#pragma unroll
  for (int i = 0; i < 16; ++i) { int k = lane + 64 * i; Xn[(size_t)m * D + k] = v[i] * rs * p.ln_g[layer * D + k] + p.ln_b[layer * D + k]; }
}

__global__ void __launch_bounds__(256) k_hy_filter(P p, int j) {
  __shared__ float feat[33], h1[64], h2[64];
  int row = blockIdx.x; int L = row < 256 ? 256 : 2048; int l = row < 256 ? row : row - 256;
  int tid = threadIdx.x;
  float t = (float)l / (float)(L - 1);
  if (tid < 33) {
    float f;
    if (tid == 0) f = t;
    else {
      int b = (tid - 1) & 15;
      float band = 1e-4f + (float)b * ((15.f - 1e-4f) / 15.f);
      float ang = (6.283185307179586f / (float)L) * (float)l * band;
      f = (tid <= 16) ? cosf(ang) : -sinf(ang);
    }
    feat[tid] = f;
  }
  __syncthreads();
  if (tid < 64) {
    float a = p.hy_b1[j * 64 + tid];
    for (int f = 0; f < 33; ++f) a += feat[f] * p.hy_w1[((size_t)j * 33 + f) * 64 + tid];
    h1[tid] = sinf(p.hy_freq[(j * 2 + 0) * 64 + tid] * a);
  }
  __syncthreads();
  if (tid < 64) {
    float a = p.hy_b2[j * 64 + tid];
    for (int f = 0; f < 64; ++f) a += h1[f] * p.hy_w2[((size_t)j * 64 + f) * 64 + tid];
    h2[tid] = sinf(p.hy_freq[(j * 2 + 1) * 64 + tid] * a);
  }
  __syncthreads();
  for (int o = tid; o < 2048; o += 256) {
    float a = p.hy_b3[j * 2048 + o];
    for (int f = 0; f < 64; ++f) a += h2[f] * p.hy_w3[((size_t)j * 64 + f) * 2048 + o];
    float w = expf(-t * fabsf(p.hy_decay[(size_t)j * 2048 + o]));
    p.ws[WS_MISC + MISC_FILT + (size_t)row * 2048 + o] = a * w;
  }
}

__device__ __forceinline__ float conv3(const float* U, int m, int l, int L, int ch, const float* cw, const float* cb) {
  float cur = U[(size_t)m * 4096 + ch];
  float pv = (l > 0) ? U[(size_t)(m - 1) * 4096 + ch] : 0.f;
  float nx = (l < L - 1) ? U[(size_t)(m + 1) * 4096 + ch] : 0.f;
  return pv * cw[ch] + cur * cw[3072 + ch] + nx * cw[6144 + ch] + cb[ch];
}
__global__ void k_hy_vv(P p, const float* U, float* VV, int j) {
  size_t idx = (size_t)blockIdx.x * blockDim.x + threadIdx.x;
  if (idx >= SZ) return;
  int m = (int)(idx >> 10), c = (int)(idx & 1023);
  int l, L, cond, m0; tokinfo(m, l, L, cond, m0);
  const float* cw = p.hy_conv_w + (size_t)j * 3 * 3072; const float* cb = p.hy_conv_b + (size_t)j * 3072;
  float x1 = conv3(U, m, l, L, 1024 + c, cw, cb);
  float v = conv3(U, m, l, L, 2048 + c, cw, cb);
  VV[idx] = v * x1;
}
__global__ void k_hy_long(P p, const float* U, const float* VV, float* G, int j) {
  size_t idx = (size_t)blockIdx.x * blockDim.x + threadIdx.x;
  if (idx >= SZ) return;
  int m = (int)(idx >> 10), c = (int)(idx & 1023);
  int l, L, cond, m0; tokinfo(m, l, L, cond, m0);
  const float* F = p.ws + WS_MISC + MISC_FILT + (size_t)(L == 256 ? 0 : 256) * 2048;
  float acc = 0.f;
  for (int s = 0; s <= l; ++s) acc += VV[(size_t)(m0 + s) * D + c] * F[(size_t)(l - s) * 2048 + c];
  for (int s = l + 1; s < L; ++s) acc += VV[(size_t)(m0 + s) * D + c] * F[(size_t)(s - l) * 2048 + 1024 + c];
  const float* cw = p.hy_conv_w + (size_t)j * 3 * 3072; const float* cb = p.hy_conv_b + (size_t)j * 3072;
  float x0 = conv3(U, m, l, L, c, cw, cb);
  float z = U[(size_t)m * 4096 + 3072 + c];
  float y = (acc + VV[idx] * p.hy_skip[j * D + c]) * x0;
  G[idx] = y * silu(z);
}

__device__ __forceinline__ int kvrow(int m) { if (m < NPT) return m; int mm = m - NPT; return NPT + (mm >> 11) * 2560 + PAST + (mm & 2047); }
__device__ __forceinline__ void rope32(const float* x, float* o, int l) {
  int r = l >> 6, col = l & 63;
#pragma unroll
  for (int i = 0; i < 8; ++i) {
    float inv = powf(10000.f, -(float)(2 * i) / 16.f);
    float ar = (float)r * inv, ac = (float)col * inv;
    float cr = cosf(ar), sr = sinf(ar), cc = cosf(ac), sc = sinf(ac);
    o[i] = x[i] * cr - x[i + 8] * sr;
    o[i + 8] = x[i + 8] * cr + x[i] * sr;
    o[16 + i] = x[16 + i] * cc - x[24 + i] * sc;
    o[24 + i] = x[24 + i] * cc + x[16 + i] * sc;
  }
}
__global__ void __launch_bounds__(64) k_mla_extract(P p, const float* U2, float* QN, float* CKVALL, float* KPEALL, float* Z) {
  int m = blockIdx.x, lane = threadIdx.x;
  int l, L, cond, m0; tokinfo(m, l, L, cond, m0);
  const float* u = U2 + (size_t)m * 1440;
  float q[4], s = 0.f;
#pragma unroll
  for (int i = 0; i < 4; ++i) { q[i] = u[lane + 64 * i]; s += q[i] * q[i]; }
#pragma unroll
  for (int o = 1; o < 64; o <<= 1) s += __shfl_xor(s, o);
  float rs = rsqrtf(s * (1.f / 256.f) + RMS_EPS);
#pragma unroll
  for (int i = 0; i < 4; ++i) QN[(size_t)m * 256 + lane + 64 * i] = q[i] * rs * p.mla_q_norm[lane + 64 * i];
  float k0 = u[256 + lane], k1 = u[256 + 64 + lane];
  float s2 = k0 * k0 + k1 * k1;
#pragma unroll
  for (int o = 1; o < 64; o <<= 1) s2 += __shfl_xor(s2, o);
  float rs2 = rsqrtf(s2 * (1.f / 128.f) + RMS_EPS);
  float c0 = k0 * rs2 * p.mla_kv_norm[lane], c1 = k1 * rs2 * p.mla_kv_norm[64 + lane];
  int kr = kvrow(m);
  CKVALL[(size_t)kr * 128 + lane] = c0; CKVALL[(size_t)kr * 128 + 64 + lane] = c1;
  if (m < NPT) { p.out[OUT_CKV + (size_t)m * 128 + lane] = c0; p.out[OUT_CKV + (size_t)m * 128 + 64 + lane] = c1; }
  if (lane == 0) {
    float x[32], o[32];
#pragma unroll
    for (int i = 0; i < 32; ++i) x[i] = u[384 + i];
    if (m < NPT) {
#pragma unroll
      for (int i = 0; i < 32; ++i) { KPEALL[(size_t)kr * 32 + i] = x[i]; p.out[OUT_KPE + (size_t)m * 32 + i] = x[i]; }
    } else {
      rope32(x, o, l);
#pragma unroll
      for (int i = 0; i < 32; ++i) KPEALL[(size_t)kr * 32 + i] = o[i];
    }
  }
  for (int i = lane; i < 1024; i += 64) Z[(size_t)m * D + i] = u[416 + i];
}
__global__ void k_mla_cache(P p, float* CKVALL, float* KPEALL) {
  int idx = blockIdx.x * blockDim.x + threadIdx.x;
  if (idx >= 2 * PAST * 128) return;
  int d = idx & 127, pl = (idx >> 7) & 511, b = idx >> 16;
  int row = NPT + b * 2560 + pl;
  CKVALL[(size_t)row * 128 + d] = p.cache_ckv[idx];
  if (d < 32) KPEALL[(size_t)row * 32 + d] = p.cache_kpe[((size_t)b * PAST + pl) * 32 + d];
}
__global__ void k_rope_q(float* Q) {
  int idx = blockIdx.x * blockDim.x + threadIdx.x;
  if (idx >= 4096 * 16) return;
  int h = idx & 15, mm = idx >> 4; int m = NPT + mm; int l = mm & 2047;
  float* q = Q + (size_t)m * 1536 + h * 96 + 64;
  float x[32], o[32];
#pragma unroll
  for (int i = 0; i < 32; ++i) x[i] = q[i];
  rope32(x, o, l);
#pragma unroll
  for (int i = 0; i < 32; ++i) q[i] = o[i];
}
__global__ void __launch_bounds__(64) k_attn(const float* Q, const float* KV, const float* KPEALL, float* G) {
  int qi = blockIdx.x * 64 + threadIdx.x;
  int sh = blockIdx.y; int h = sh & 15, seq = sh >> 4;
  int L = seq < 16 ? 256 : 2048;
  if (qi >= L) return;
  int m = seq < 16 ? seq * 256 + qi : NPT + (seq - 16) * 2048 + qi;
  int kbase = seq < 16 ? seq * 256 : NPT + (seq - 16) * 2560;
  int nk = seq < 16 ? 256 : 2560;
  float q[96];
#pragma unroll
  for (int i = 0; i < 96; ++i) q[i] = Q[(size_t)m * 1536 + h * 96 + i];
  float acc[64];
#pragma unroll
  for (int i = 0; i < 64; ++i) acc[i] = 0.f;
  float mx = -1e30f, lsum = 0.f;
  const float scale = 0.10206207261596575f;
  for (int k = 0; k < nk; ++k) {
    const float* kv = KV + (size_t)(kbase + k) * 2048 + h * 128;
    const float* kp = KPEALL + (size_t)(kbase + k) * 32;
    float s = 0.f;
#pragma unroll
    for (int i = 0; i < 64; ++i) s += q[i] * kv[i];
#pragma unroll
    for (int i = 0; i < 32; ++i) s += q[64 + i] * kp[i];
    s *= scale;
    float mn = fmaxf(mx, s);
    float corr = expf(mx - mn), pe = expf(s - mn);
    lsum = lsum * corr + pe;
#pragma unroll
    for (int i = 0; i < 64; ++i) acc[i] = acc[i] * corr + pe * kv[64 + i];
    mx = mn;
  }
  float inv = 1.f / lsum;
#pragma unroll
  for (int i = 0; i < 64; ++i) { size_t o = (size_t)m * D + h * 64 + i; G[o] = acc[i] * inv * silu(G[o]); }
}

__global__ void __launch_bounds__(64) k_rw_scan(P p, const float* R, const float* K, const float* V, const float* HW, const float* HA, float* Y) {
  int id = blockIdx.x;
  int h = id & 15, dir = (id >> 4) & 1, seq = id >> 5;
  int lane = threadIdx.x;
  int L = seq < 16 ? 256 : 2048;
  int m0 = seq < 16 ? seq * 256 : NPT + (seq - 16) * 2048;
  int ch = h * 64 + lane;
  float S[64];
  if (seq < 16) {
#pragma unroll
    for (int j = 0; j < 64; ++j) S[j] = 0.f;
  } else {
    const float* s0 = p.state_rwkv + ((((size_t)(seq - 16) * 1 + 0) * 2 + dir) * 16 + h) * 4096 + (size_t)lane * 64;
#pragma unroll
    for (int j = 0; j < 64; ++j) S[j] = s0[j];
  }
  const float w0 = p.rw_w0[dir * D + ch], a0 = p.rw_a0[dir * D + ch];
  const float kkw = p.rw_k_k[ch], kaw = p.rw_k_a[ch];
  const float* w2 = p.rw_w2 + (size_t)dir * 64 * D + ch;
  const float* a2 = p.rw_a2 + (size_t)dir * 64 * D + ch;
  for (int st = 0; st < L; ++st) {
    int t = dir ? (L - 1 - st) : st;
    int m = m0 + t;
    float wl = w0, al = a0;
    const float* hw = HW + (size_t)m * 128 + dir * 64;
    const float* ha = HA + (size_t)m * 128 + dir * 64;
    for (int r = 0; r < 64; ++r) { wl += hw[r] * w2[(size_t)r * D]; al += ha[r] * a2[(size_t)r * D]; }
    float sp = (-wl > 20.f) ? -wl : log1pf(expf(-wl));
    float dec = expf(-expf(-sp - 0.5f));
    float a = sigmoidf(al);
    float k = K[(size_t)m * D + ch], r_ = R[(size_t)m * D + ch], v = V[(size_t)m * D + ch];
    float kk = k * kkw; float ss = kk * kk;
#pragma unroll
    for (int o = 1; o < 64; o <<= 1) ss += __shfl_xor(ss, o);
    kk *= rsqrtf(ss + 1e-12f);
    float kd = k * (1.f + (a - 1.f) * kaw);
    float bd = kk * a;
    float at = -kk;
    float sa = 0.f;
#pragma unroll
    for (int j = 0; j < 64; ++j) sa += S[j] * __shfl(at, j);
    float y = 0.f;
#pragma unroll
    for (int j = 0; j < 64; ++j) {
      float wj = __shfl(dec, j), bj = __shfl(bd, j), kj = __shfl(kd, j), rj = __shfl(r_, j);
      S[j] = S[j] * wj + sa * bj + v * kj;
      y += S[j] * rj;
    }
    atomicAdd(&Y[(size_t)m * D + ch], y);
  }
  if (seq < 16) {
    float* so = p.out + OUT_ST + ((((size_t)seq * 1 + 0) * 2 + dir) * 16 + h) * 4096 + (size_t)lane * 64;
#pragma unroll
    for (int j = 0; j < 64; ++j) so[j] = S[j];
  }
}
__global__ void __launch_bounds__(64) k_rw_post(P p, const float* R, const float* K, const float* V, const float* Z, const float* HA, const float* Y, float* G) {
  int m = blockIdx.x >> 4, h = blockIdx.x & 15, lane = threadIdx.x; int ch = h * 64 + lane;
  float y = Y[(size_t)m * D + ch];
  float s = y;
#pragma unroll
  for (int o = 1; o < 64; o <<= 1) s += __shfl_xor(s, o);
  float mu = s * (1.f / 64.f); float d = y - mu; float q = d * d;
#pragma unroll
  for (int o = 1; o < 64; o <<= 1) q += __shfl_xor(q, o);
  float yn = d * rsqrtf(q * (1.f / 64.f) + GN_EPS) * p.rw_gn_g[ch] + p.rw_gn_b[ch];
  float k = K[(size_t)m * D + ch], r_ = R[(size_t)m * D + ch], v = V[(size_t)m * D + ch];
  float bsum = 0.f;
  for (int dir = 0; dir < 2; ++dir) {
    float al = p.rw_a0[dir * D + ch];
    const float* ha = HA + (size_t)m * 128 + dir * 64;
    const float* a2 = p.rw_a2 + (size_t)dir * 64 * D + ch;
    for (int r = 0; r < 64; ++r) al += ha[r] * a2[(size_t)r * D];
    float a = sigmoidf(al);
    float kd = k * (1.f + (a - 1.f) * p.rw_k_a[ch]);
    bsum += r_ * kd * p.rw_r_k[ch];
  }
#pragma unroll
  for (int o = 1; o < 64; o <<= 1) bsum += __shfl_xor(bsum, o);
  float o_ = yn + bsum * v;
  G[(size_t)m * D + ch] = o_ * silu(Z[(size_t)m * D + ch]);
}

typedef unsigned short bf16_t;
namespace pg8 {
#define PG8_LAS __attribute__((address_space(3)))
typedef unsigned short bf16_t;
typedef short bf16x8 __attribute__((ext_vector_type(8)));
typedef float f32x4 __attribute__((ext_vector_type(4)));
typedef unsigned u32x4 __attribute__((ext_vector_type(4)));
constexpr int BM = 256, BK = 64, HALF = 128, HTB = HALF * BK * 2  , STAGE_BYTES = 8 * HTB, NXCD = 8, WGM = 8;

__host__ __device__ __forceinline__ int lds_byte(int r, int c) { const int st = (r >> 4) * 2 + (c >> 5), rr = r & 15, cc = c & 31, ob = rr * 64 + cc * 2; return st * 1024 + (ob ^ (((ob >> 9) & 1) << 5)); }
__host__ __device__ __forceinline__ void stage_rc(int b, int& R, int& C) { const int st = b / 1024, sb = b % 1024, swz = sb ^ (((sb >> 9) & 1) << 5); R = (st >> 1) * 16 + swz / 64; C = (st & 1) * 32 + (swz % 64) / 2; }
__host__ __device__ __forceinline__ int perm32(int rho) { const int n = rho >> 4, i = rho & 15; return 8 * (i >> 2) + 4 * n + (i & 3); }

struct Unit { int pm, pn; };
struct Gemm { const bf16_t* A; const bf16_t* Bt; int M, N, K; };

struct StaticOrder {
    int nM, nN, nwg, G, c;
    __host__ __device__ void init(int M, int N, int G_, int c_) { nM = M / BM; nN = N / BM; nwg = nM * nN; G = G_; c = c_; }
    __host__ __device__ bool next(int i, Unit& u) const {
        const long L = (long)i * G + c; if (L >= nwg) return false;
        int wgid = (int)L; { const int q = nwg / NXCD, r = nwg % NXCD, xcd = wgid % NXCD, off = wgid / NXCD; wgid = (xcd < r ? xcd * (q + 1) : r * (q + 1) + (xcd - r) * q) + off; }
        const int nig = WGM * nN, gid = wgid / nig, fm = gid * WGM, gsz = (nM - fm) < WGM ? (nM - fm) : WGM;
        u.pm = fm + ((wgid % nig) % gsz); u.pn = (wgid % nig) / gsz; return true;
    }
    __device__ __forceinline__ void a_ready(const Unit&) const {}
    __device__ __forceinline__ void done(const Unit&) const {}
};
__device__ __forceinline__ unsigned cvt_pk_bf16(float lo, float hi) { unsigned r; asm volatile("v_cvt_pk_bf16_f32 %0, %1, %2" : "=v"(r) : "v"(lo), "v"(hi)); return r; }
typedef float f32x2 __attribute__((ext_vector_type(2)));
template <int ACT  > struct EpiBf16 {
    static constexpr bool PERM = true, AFTER_DRAIN = false; static_assert(ACT == 0 || ACT == 1, "EpiBf16: ACT is 0 (none) or 1 (gelu_pk)");
    bf16_t* O; int ldc; const float* bias; int split_cols; size_t split_stride; float scale0;
    __device__ __forceinline__ void operator()(const f32x4 (&acc)[2][2][4][2], const Unit& u, int wr, int wc, int fr, int fq) const {
        const int row0 = u.pm * BM + wr * 64 + fr; int colt = u.pn * BM; bf16_t* base = O;
        float sc = 1.f; if (split_cols) { const int t = colt / split_cols; base += (size_t)t * split_stride; colt -= t * split_cols; if (t == 0) sc = scale0; }
        const int col0 = colt + wc * 32 + 8 * fq, bcol0 = u.pn * BM + wc * 32 + 8 * fq;
        f32x4 bv[2][2];
#pragma unroll
        for (int bj = 0; bj < 2; ++bj)
#pragma unroll
            for (int n = 0; n < 2; ++n) bv[bj][n] = bias ? *(const f32x4*)(bias + bcol0 + bj * HALF + 4 * n) : (f32x4){0.f, 0.f, 0.f, 0.f};
#pragma unroll
        for (int ai = 0; ai < 2; ++ai)
#pragma unroll
            for (int m = 0; m < 4; ++m) { bf16_t* rowp = base + (size_t)(row0 + ai * HALF + m * 16) * ldc + col0;
#pragma unroll
                for (int bj = 0; bj < 2; ++bj) { f32x4 v0 = acc[ai][bj][m][0] + bv[bj][0], v1 = acc[ai][bj][m][1] + bv[bj][1];
                    v0 = v0 * sc; v1 = v1 * sc; u32x4 w; w.x = cvt_pk_bf16(v0[0], v0[1]); w.y = cvt_pk_bf16(v0[2], v0[3]); w.z = cvt_pk_bf16(v1[0], v1[1]); w.w = cvt_pk_bf16(v1[2], v1[3]);
                    *(u32x4*)(rowp + bj * HALF) = w; } }
    }
};
template <class Epi, class Sched, bool ALIGN_EPI = false, bool SP2 = false>
__device__ __forceinline__ void gemm_phase(PG8_LAS unsigned char* lds, const Gemm g, const Sched& S, const Epi& E) {
    const int tid = threadIdx.x, wid = __builtin_amdgcn_readfirstlane(tid >> 6), lane = tid & 63, wr = wid >> 2, wc = wid & 3, fr = lane & 15, fq = lane >> 4;
    const int K = g.K, nt = K / BK;
    unsigned voffA[2], voffB[2];
#pragma unroll
    for (int i = 0; i < 2; ++i) { int R, C; stage_rc(tid * 16 + i * 8192, R, C); const int Rb = Epi::PERM ? ((R & ~31) + perm32(R & 31)) : R;
        voffA[i] = (unsigned)(R * K + C) * 2u; voffB[i] = (unsigned)(Rb * K + C) * 2u; }
    const size_t kstep = (size_t)(BK * 2);
    const size_t hstep = (size_t)HALF * K * 2;
    const size_t tstep = 2 * hstep;
    const unsigned ldsw = (unsigned)wid * 1024u;
    const int aoff = lds_byte(wr * 64 + fr, fq * 8), boff = lds_byte(wc * 32 + fr, fq * 8);
#define PG8_SA(b, h) (((b) * 2 + (h)) * HTB)
#define PG8_SB(b, h) ((4 + (b) * 2 + (h)) * HTB)
#define PG8_STAGE(bufoff, gbase, voff) do { _Pragma("unroll") for (int _i = 0; _i < 2; ++_i) \
        __builtin_amdgcn_global_load_lds((const unsigned*)((const char*)(gbase) + (voff)[_i]), (PG8_LAS unsigned*)(lds + (bufoff) + ldsw + _i * 8192), 16, 0, 0); } while (0)
#define PG8_LDA(dst, b, h) do { _Pragma("unroll") for (int m = 0; m < 4; ++m) _Pragma("unroll") for (int k = 0; k < 2; ++k) dst[m][k] = *(const PG8_LAS bf16x8*)(lds + PG8_SA(b, h) + aoff + m * 2048 + k * 1024); } while (0)
#define PG8_LDB(dst, b, h) do { _Pragma("unroll") for (int n = 0; n < 2; ++n) _Pragma("unroll") for (int k = 0; k < 2; ++k) dst[n][k] = *(const PG8_LAS bf16x8*)(lds + PG8_SB(b, h) + boff + n * 2048 + k * 1024); } while (0)
#define PG8_MMA(ai, bj, At, Bt) do { __builtin_amdgcn_s_setprio(1); _Pragma("unroll") for (int m = 0; m < 4; ++m) _Pragma("unroll") for (int n = 0; n < 2; ++n) _Pragma("unroll") for (int k = 0; k < 2; ++k) \
        acc[ai][bj][m][n] = __builtin_amdgcn_mfma_f32_16x16x32_bf16(Bt[n][k], At[m][k], acc[ai][bj][m][n], 0, 0, 0); __builtin_amdgcn_s_setprio(0); } while (0)
#define PG8_WAIT_V(n) asm volatile("s_waitcnt vmcnt(" #n ")" ::: "memory")
#define PG8_WAIT_L(n) asm volatile("s_waitcnt lgkmcnt(" #n ")" ::: "memory")
#define PG8_BAR __builtin_amdgcn_s_barrier()
#define PG8_SCHED __builtin_amdgcn_sched_barrier(0)
    Unit cur, nxt; int ui = 0;
    if (!S.next(0, cur)) return;
    f32x4 acc[2][2][4][2];
#pragma unroll
    for (int a = 0; a < 2; ++a)
#pragma unroll
        for (int b = 0; b < 2; ++b)
#pragma unroll
            for (int m = 0; m < 4; ++m)
#pragma unroll
                for (int n = 0; n < 2; ++n) acc[a][b][m][n] = (f32x4){0.f, 0.f, 0.f, 0.f};
    bf16x8 At[4][2], B0[2][2], B1[2][2];
    const char* cA = (const char*)g.A + (size_t)cur.pm * tstep; const char* cB = (const char*)g.Bt + (size_t)cur.pn * tstep;
    S.a_ready(cur);
    if constexpr (SP2) {
        PG8_STAGE(PG8_SB(0, 0), cB, voffB); PG8_STAGE(PG8_SB(0, 1), cB + hstep, voffB); PG8_STAGE(PG8_SA(0, 0), cA, voffA); PG8_STAGE(PG8_SA(0, 1), cA + hstep, voffA);
        if (wr == 1) PG8_BAR;
        PG8_WAIT_V(2); PG8_BAR;
        PG8_STAGE(PG8_SB(1, 0), cB + kstep, voffB); PG8_STAGE(PG8_SA(1, 0), cA + kstep, voffA); PG8_STAGE(PG8_SB(1, 1), cB + hstep + kstep, voffB);
        PG8_WAIT_V(6); PG8_BAR;
    } else {
        PG8_STAGE(PG8_SB(0, 0), cB, voffB); PG8_STAGE(PG8_SA(0, 0), cA, voffA); PG8_STAGE(PG8_SB(0, 1), cB + hstep, voffB); PG8_STAGE(PG8_SA(0, 1), cA + hstep, voffA);
        if (wr == 1) PG8_BAR;
        PG8_WAIT_V(4); PG8_BAR;
        PG8_STAGE(PG8_SB(1, 0), cB + kstep, voffB); PG8_STAGE(PG8_SA(1, 0), cA + kstep, voffA); PG8_STAGE(PG8_SB(1, 1), cB + hstep + kstep, voffB);
        PG8_WAIT_V(6); PG8_BAR;
    }
    for (;;) {
        const bool has_next = S.next(ui + 1, nxt);
        const char* nA = has_next ? (const char*)g.A + (size_t)nxt.pm * tstep : cA; const char* nB = has_next ? (const char*)g.Bt + (size_t)nxt.pn * tstep : cB;
        for (int t = 0; t < nt; t += 2) {
            const bool last = (t == nt - 2);
            const char* a1 = cA + (size_t)(t + 1) * kstep;
            const char* a2 = last ? nA : cA + (size_t)(t + 2) * kstep; const char* b2 = last ? nB : cB + (size_t)(t + 2) * kstep;
            const char* a3 = a2 + kstep; const char* b3 = b2 + kstep;
            if (last && has_next) S.a_ready(nxt);
            if constexpr (SP2) {
            PG8_LDB(B0, 0, 0); PG8_LDB(B1, 0, 1); PG8_SCHED; PG8_LDA(At, 0, 0); PG8_STAGE(PG8_SA(1, 1), a1 + hstep, voffA);
            PG8_WAIT_V(8); PG8_WAIT_L(0); PG8_BAR; PG8_MMA(0, 0, At, B0); PG8_MMA(0, 1, At, B1); PG8_BAR; PG8_SCHED;
            PG8_LDA(At, 0, 1); PG8_STAGE(PG8_SB(0, 0), b2, voffB); PG8_STAGE(PG8_SB(0, 1), b2 + hstep, voffB); PG8_STAGE(PG8_SA(0, 0), a2, voffA);
            PG8_WAIT_V(8); PG8_WAIT_L(0); PG8_BAR; PG8_MMA(1, 0, At, B0); PG8_MMA(1, 1, At, B1); PG8_BAR; PG8_SCHED;
            PG8_LDB(B0, 1, 0); PG8_LDB(B1, 1, 1); PG8_SCHED; PG8_LDA(At, 1, 0); PG8_STAGE(PG8_SA(0, 1), a2 + hstep, voffA);
            PG8_WAIT_V(8); PG8_WAIT_L(0); PG8_BAR; PG8_MMA(0, 0, At, B0); PG8_MMA(0, 1, At, B1); PG8_BAR; PG8_SCHED;
            PG8_LDA(At, 1, 1); PG8_STAGE(PG8_SB(1, 0), b3, voffB); PG8_STAGE(PG8_SB(1, 1), b3 + hstep, voffB); PG8_STAGE(PG8_SA(1, 0), a3, voffA);
            PG8_WAIT_V(8); PG8_WAIT_L(0); PG8_BAR; PG8_MMA(1, 0, At, B0); PG8_MMA(1, 1, At, B1); PG8_BAR; PG8_SCHED;
            } else {
            PG8_LDB(B0, 0, 0); PG8_SCHED; PG8_LDA(At, 0, 0); PG8_STAGE(PG8_SA(1, 1), a1 + hstep, voffA);
            PG8_WAIT_L(8); PG8_BAR; PG8_WAIT_L(0); PG8_MMA(0, 0, At, B0); PG8_BAR; PG8_SCHED;
            PG8_LDB(B1, 0, 1); PG8_STAGE(PG8_SB(0, 0), b2, voffB);
            PG8_BAR; PG8_WAIT_L(0); PG8_MMA(0, 1, At, B1); PG8_BAR;
            PG8_LDA(At, 0, 1); PG8_STAGE(PG8_SA(0, 0), a2, voffA);
            PG8_BAR; PG8_WAIT_L(0); PG8_MMA(1, 0, At, B0); PG8_BAR; PG8_SCHED;
            PG8_STAGE(PG8_SB(0, 1), b2 + hstep, voffB);
            PG8_WAIT_V(6); PG8_BAR; PG8_MMA(1, 1, At, B1); PG8_BAR;
            PG8_LDB(B0, 1, 0); PG8_SCHED; PG8_LDA(At, 1, 0); PG8_STAGE(PG8_SA(0, 1), a2 + hstep, voffA);
            PG8_WAIT_L(8); PG8_BAR; PG8_WAIT_L(0); PG8_MMA(0, 0, At, B0); PG8_BAR; PG8_SCHED;
            PG8_LDB(B1, 1, 1); PG8_STAGE(PG8_SB(1, 0), b3, voffB);
            PG8_BAR; PG8_WAIT_L(0); PG8_MMA(0, 1, At, B1); PG8_BAR;
            PG8_LDA(At, 1, 1); PG8_STAGE(PG8_SA(1, 0), a3, voffA);
            PG8_BAR; PG8_WAIT_L(0); PG8_MMA(1, 0, At, B0); PG8_BAR; PG8_SCHED;
            PG8_STAGE(PG8_SB(1, 1), b3 + hstep, voffB);
            PG8_WAIT_V(6); PG8_BAR; PG8_MMA(1, 1, At, B1); PG8_BAR;
            }
        }
        if constexpr (ALIGN_EPI) { if (wr == 0) PG8_BAR; }
        if constexpr (!Epi::AFTER_DRAIN) { E(acc, cur, wr, wc, fr, fq); S.done(cur); }
        if (!has_next) break;
#pragma unroll
        for (int a = 0; a < 2; ++a)
#pragma unroll
            for (int b = 0; b < 2; ++b)
#pragma unroll
                for (int m = 0; m < 4; ++m)
#pragma unroll
                    for (int n = 0; n < 2; ++n) acc[a][b][m][n] = (f32x4){0.f, 0.f, 0.f, 0.f};
        cur = nxt; cA = nA; cB = nB; ++ui;
        if constexpr (ALIGN_EPI) { if (wr == 1) PG8_BAR; }
    }
    PG8_WAIT_V(0);
    if constexpr (!ALIGN_EPI) { if (wr == 0) PG8_BAR; }
    PG8_BAR;
    if constexpr (Epi::AFTER_DRAIN) { E.fused(acc, cur, wr, wc, fr, fq, lds, wid, lane); S.done(cur); }
#undef PG8_SA
#undef PG8_SB
#undef PG8_STAGE
#undef PG8_LDA
#undef PG8_LDB
#undef PG8_MMA
#undef PG8_WAIT_V
#undef PG8_WAIT_L
#undef PG8_BAR
#undef PG8_SCHED
}
}
#define GAS __attribute__((address_space(1)))
#define LAS __attribute__((address_space(3)))
typedef unsigned short bf16;
typedef unsigned v4u __attribute__((ext_vector_type(4)));
typedef float f32x4 __attribute__((ext_vector_type(4)));
typedef short bf16x8 __attribute__((ext_vector_type(8)));
typedef GAS unsigned gu32;
typedef GAS unsigned long long gu64;
#define RLX_AGENT __ATOMIC_RELAXED, __HIP_MEMORY_SCOPE_AGENT
#define LDS_WAIT() asm volatile("s_waitcnt lgkmcnt(0)" ::: "memory")
#define VM_WAIT() asm volatile("s_waitcnt vmcnt(0)" ::: "memory")
__device__ __forceinline__ unsigned long long rt() { return __builtin_amdgcn_s_memrealtime(); }
__device__ __forceinline__ unsigned f2bf(float f) { unsigned u = __builtin_bit_cast(unsigned, f); return (u + 0x7fffu + ((u >> 16) & 1u)) >> 16; }
__device__ __forceinline__ unsigned pk2(float lo, float hi) { return f2bf(lo) | (f2bf(hi) << 16); }

#define XB_TMO      128
#define XB_XCNT(j)  (256  + 64 * (j))
#define XB_XSUB(j)  (1280 + 64 * (j))
#define XB_XGEN(j)  (2304 + 64 * (j))
#define XB_TOP      3328
#define XB_TOPGEN   3392
#define XCD_BAR_WORDS 3456
#define XB_SPIN_CAP (1u << 18)

__device__ __forceinline__ unsigned xb_ld(unsigned* p)              { return __hip_atomic_load(p, __ATOMIC_RELAXED, __HIP_MEMORY_SCOPE_AGENT); }
__device__ __forceinline__ unsigned xb_add(unsigned* p, unsigned v) { return __hip_atomic_fetch_add(p, v, __ATOMIC_RELAXED, __HIP_MEMORY_SCOPE_AGENT); }
__device__ __forceinline__ unsigned xb_xcc_id() { return (unsigned)__builtin_amdgcn_s_getreg((3 << 11) | 20) & 0xFu; }
#define XB_SPIN(cond, bar) do { unsigned _sp = 0; while (cond) { __builtin_amdgcn_s_sleep(1); \
    if ((++_sp & 255u) == 0u) { if (xb_ld(&(bar)[XB_TMO])) break; if (_sp > XB_SPIN_CAP) { atomicAdd(&(bar)[XB_TMO], 1u); break; } } } } while (0)

struct XcdBarrier {
    unsigned* bar; unsigned x;
    volatile LAS unsigned* st;
};

__device__ __forceinline__ XcdBarrier xcd_barrier_post(unsigned* bar, volatile LAS unsigned* st) {
    XcdBarrier b; b.bar = bar; b.x = xb_xcc_id(); b.st = st;
    if (threadIdx.x == 0) (void)xb_add(&bar[XB_XCNT(b.x)], 1u);
    return b;
}
__device__ __forceinline__ void xcd_barrier_complete(unsigned* bar, unsigned x, unsigned& nloc, unsigned& nx) {
    const unsigned G = gridDim.x * gridDim.y * gridDim.z;
    unsigned sum, cnt, mine, sp = 0u;
    for (;;) {
        sum = 0u; cnt = 0u; mine = 0u;
#pragma unroll
        for (unsigned j = 0; j < 16; ++j) { const unsigned c = xb_ld(&bar[XB_XCNT(j)]); sum += c; cnt += (c > 0u) ? 1u : 0u; mine = (j == x) ? c : mine; }
        if (sum == G) break;
        __builtin_amdgcn_s_sleep(1);
        if ((++sp & 255u) == 0u) { if (xb_ld(&bar[XB_TMO])) break; if (sp > XB_SPIN_CAP) { atomicAdd(&bar[XB_TMO], 1u); break; } }
    }
    nloc = mine > 0u ? mine : 1u; nx = cnt > 0u ? cnt : 1u;
}

__device__ __forceinline__ void xcd_barrier(const XcdBarrier& b) {
    asm volatile("s_waitcnt vmcnt(0)" ::: "memory");
    __syncthreads();
    if (threadIdx.x == 0) {
        unsigned* bar = b.bar;
        __builtin_amdgcn_s_waitcnt(0);
        unsigned nloc = b.st[0], nx = b.st[1];
        if (nloc == 0u) { xcd_barrier_complete(bar, b.x, nloc, nx); b.st[0] = nloc; b.st[1] = nx; }
        const unsigned old = xb_add(&bar[XB_XSUB(b.x)], 1u);
        const unsigned gen = old / nloc;
        if (old + 1u == (gen + 1u) * nloc) {
            __builtin_amdgcn_fence(__ATOMIC_RELEASE, "agent");
            asm volatile("s_waitcnt vmcnt(0)" ::: "memory");
            const unsigned og = xb_add(&bar[XB_TOP], 1u);
            const unsigned tg = og / nx;
            if (og + 1u == (tg + 1u) * nx) xb_add(&bar[XB_TOPGEN], 1u);
            else XB_SPIN(xb_ld(&bar[XB_TOPGEN]) == tg, bar);
            __builtin_amdgcn_fence(__ATOMIC_ACQUIRE, "agent");
            xb_add(&bar[XB_XGEN(b.x)], 1u);
            asm volatile("s_waitcnt vmcnt(0)" ::: "memory");
        } else {
            XB_SPIN(xb_ld(&bar[XB_XGEN(b.x)]) == gen, bar);
            __builtin_amdgcn_fence(__ATOMIC_ACQUIRE, "agent");
            asm volatile("s_waitcnt vmcnt(0)" ::: "memory");
        }
    }
    __syncthreads();
}
typedef __attribute__((address_space(1))) float GASF;
struct PG {
  const GASF *x_prompt, *x_sample, *cache_ckv, *cache_kpe, *state_rwkv, *c, *c_ctx;
  const GASF *mod_w, *mod_b, *ln_g, *ln_b;
  const GASF *hy_w_in, *hy_conv_w, *hy_conv_b, *hy_w1, *hy_b1, *hy_w2, *hy_b2, *hy_w3, *hy_b3, *hy_freq, *hy_decay, *hy_skip, *hy_w_out;
  const GASF *mla_w_in, *mla_q_norm, *mla_kv_norm, *mla_w_q_up, *mla_w_kv_up, *mla_w_out;
  const GASF *rw_mu, *rw_w_in, *rw_w0, *rw_w1, *rw_w2, *rw_a0, *rw_a1, *rw_a2, *rw_k_k, *rw_k_a, *rw_r_k, *rw_gn_g, *rw_gn_b, *rw_w_out;
  GASF* out;
  GASF* ws;
};
namespace mk {
typedef float f32x16 __attribute__((ext_vector_type(16)));
typedef short v4i16_t __attribute__((ext_vector_type(4)));
typedef unsigned u32x4 __attribute__((ext_vector_type(4)));
typedef unsigned u32x2 __attribute__((ext_vector_type(2)));
typedef unsigned short u16;

constexpr size_t MiB = 1u << 20;
constexpr size_t M_X = 0, M_HB = 32 * MiB, M_GB = 48 * MiB, M_UT = 64 * MiB, M_SCR2 = 128 * MiB, M_WTS = 192 * MiB, M_FILT = 230 * MiB;
constexpr size_t M_HDN2 = 248 * MiB + 512 * 1024, M_MODP = 250 * MiB, M_MODS = 254 * MiB, M_CTL = 255 * MiB;
constexpr size_t W_HYIN = M_WTS, W_HYOUT = M_WTS + 16 * MiB, W_MLAIN = M_WTS + 20 * MiB, W_QUP = M_WTS + 23 * MiB, W_KVUP = M_WTS + 24 * MiB,
                 W_MLAOUT = M_WTS + 25 * MiB, W_RWIN = M_WTS + 27 * MiB, W_LORA1 = M_WTS + 35 * MiB, W_RWOUT = M_WTS + 36 * MiB;
constexpr size_t M_U2S = M_SCR2 + 24 * MiB;
constexpr size_t M_QN = M_SCR2, M_CKVALL = M_SCR2 + 4 * MiB, M_KPEB = M_SCR2 + 7 * MiB, M_SZB = M_SCR2 + 8 * MiB, M_Q = M_UT, M_KN = M_UT + 24 * MiB, M_V = M_UT + 42 * MiB;
constexpr int FILT_CH = 4640;
constexpr int LDS_BYTES = 163840, MISC_OFF = LDS_BYTES - 512, PTAB_OFF = LDS_BYTES - 1024;

__device__ __forceinline__ float bf2f(unsigned v) { return __builtin_bit_cast(float, v << 16); }
typedef float f32x2_t __attribute__((ext_vector_type(2))); typedef __bf16 bf16x2_t __attribute__((ext_vector_type(2)));
__device__ __forceinline__ unsigned pk2_(float lo, float hi) { const f32x2_t v = {lo, hi}; const bf16x2_t b = __builtin_convertvector(v, bf16x2_t); return __builtin_bit_cast(unsigned, b); }
__device__ __forceinline__ unsigned f2bf_(float f) { return pk2_(f, 0.f) & 0xffffu; }
__device__ __forceinline__ v4i16_t vtr(LAS const unsigned char* p) { return __builtin_amdgcn_ds_read_tr16_b64_v4i16((LAS v4i16_t*)p); }
template <class T> __device__ __forceinline__ T* uni(T* p) {
  const unsigned long long v = (unsigned long long)p;
  const unsigned lo = __builtin_amdgcn_readfirstlane((unsigned)v), hi = __builtin_amdgcn_readfirstlane((unsigned)(v >> 32));
  return (T*)(((unsigned long long)hi << 32) | lo);
}
__device__ __forceinline__ float rdlane(float v, int l) { return __builtin_bit_cast(float, __builtin_amdgcn_readlane(__builtin_bit_cast(int, v), l)); }
__device__ __forceinline__ float wsum(float v) {
#pragma unroll
  for (int o = 1; o < 64; o <<= 1) v += __shfl_xor(v, o);
  return v;
}
#define WS_DPP(v, CTRL) __builtin_bit_cast(float, __builtin_amdgcn_update_dpp(0, __builtin_bit_cast(int, (float)(v)), (CTRL), 0xF, 0xF, true))
__device__ __forceinline__ float ws_x16(float x) { unsigned a = __builtin_bit_cast(unsigned, x), b = a; asm volatile("s_nop 1\n\tv_permlane16_swap_b32 %0, %1" : "+v"(a), "+v"(b)); return __builtin_bit_cast(float, a) + __builtin_bit_cast(float, b); }
__device__ __forceinline__ float ws_x32(float x) { unsigned a = __builtin_bit_cast(unsigned, x), b = a; asm volatile("s_nop 1\n\tv_permlane32_swap_b32 %0, %1" : "+v"(a), "+v"(b)); return __builtin_bit_cast(float, a) + __builtin_bit_cast(float, b); }
template <int N> __device__ __forceinline__ void wsum_n(float (&v)[N]) {
#pragma unroll
  for (int i = 0; i < N; ++i) v[i] += WS_DPP(v[i], 0xB1);
#pragma unroll
  for (int i = 0; i < N; ++i) v[i] += WS_DPP(v[i], 0x4E);
#pragma unroll
  for (int i = 0; i < N; ++i) v[i] += WS_DPP(v[i], 0x141);
#pragma unroll
  for (int i = 0; i < N; ++i) v[i] += WS_DPP(v[i], 0x140);
#pragma unroll
  for (int i = 0; i < N; ++i) v[i] = ws_x16(v[i]);
#pragma unroll
  for (int i = 0; i < N; ++i) v[i] = ws_x32(v[i]);
}
__device__ __forceinline__ const GASF* xrow_in(const LAS PG& p, int layer, const unsigned char* ws, int m) {
  if (layer == 0) return (m < NPT) ? p.x_prompt + (size_t)m * D : p.x_sample + (size_t)(m - NPT) * D;
  if (layer == 2) return p.out + OUT_Y + (size_t)m * D;
  return (const GASF*)(ws + M_X) + (size_t)m * D;
}

__device__ __forceinline__ f32x4 xres_load(const LAS PG& p, int layer, const unsigned char* ws, int m, int c) {
  if (layer == 0) return __builtin_nontemporal_load((const GAS f32x4*)(xrow_in(p, 0, ws, m) + c));
  u32x2 b;
  if (layer == 2) b = *(const GAS u32x2*)((const GAS bf16_t*)(p.out + OUT_Y) + (size_t)m * D + c);
  else b = *(const u32x2*)((const bf16_t*)(ws + M_X) + (size_t)m * D + c);
  return (f32x4){bf2f(b.x & 0xffffu), bf2f(b.x >> 16), bf2f(b.y & 0xffffu), bf2f(b.y >> 16)};
}
__device__ __forceinline__ void xres_store(const LAS PG& p, int layer, unsigned char* ws, int m, int c, const f32x4 y) {
  if (layer == 3) { *(GAS f32x4*)(p.out + OUT_Y + (size_t)m * D + c) = y; return; }
  u32x2 o; o.x = pk2_(y.x, y.y); o.y = pk2_(y.z, y.w);
  if (layer == 1) *(GAS u32x2*)((GAS bf16_t*)(p.out + OUT_Y) + (size_t)m * D + c) = o;
  else *(u32x2*)((bf16_t*)(ws + M_X) + (size_t)m * D + c) = o;
}
#ifdef PRB_SEC
#define PRB_S(n) unsigned long long prb##n##_ = 0ull; if (PRB_SEC == (n)) { prb##n##_ = __builtin_amdgcn_s_memrealtime(); }
#ifndef CKT_BLK
#define CKT_BLK 0
#endif
#define PRB_E(n) do { if (PRB_SEC == (n) && blockIdx.x == (CKT_BLK) && threadIdx.x == 0) { ((volatile LAS unsigned*)(lds + MISC_OFF))[40] += (unsigned)(__builtin_amdgcn_s_memrealtime() - prb##n##_); } } while (0)
#else
#define PRB_S(n)
#define PRB_E(n) do {} while (0)
#endif
struct TrD { const GASF* W; bf16_t* WT; int K, N, kind, row_off, item; };
constexpr int I_HYIN = 16 * 128, I_SQ = 16 * 32, I_MLAIN = 16 * 45, I_QUP = 4 * 48, I_KVUP = 2 * 64, I_LORA = 16 * 2;
constexpr int NTR = 2 * I_HYIN + 2 * I_SQ + I_MLAIN + I_QUP + I_KVUP + I_SQ + 4 * I_SQ + 4 * I_LORA + I_SQ;
constexpr int NTR_DEF = I_HYIN + I_SQ + I_SQ;
constexpr int NTR_DEF2 = 4 * I_SQ + 4 * I_LORA;
constexpr int NTR_P0 = NTR - NTR_DEF - NTR_DEF2;
constexpr int R_RWIN = 2 * I_HYIN + 2 * I_SQ + I_MLAIN + I_QUP + I_KVUP + I_SQ;
__device__ __forceinline__ int tr_map_p0(int idx) { return idx < I_HYIN ? idx : (idx < I_HYIN + I_SQ ? 2 * I_HYIN + (idx - I_HYIN) : 2 * I_HYIN + 2 * I_SQ + (idx - I_HYIN - I_SQ)); }
__device__ __forceinline__ int tr_map_def(int idx) { return idx < I_HYIN ? I_HYIN + idx : (idx < I_HYIN + I_SQ ? 2 * I_HYIN + I_SQ + (idx - I_HYIN) : NTR - I_SQ + (idx - I_HYIN - I_SQ)); }
__device__ __forceinline__ int tr_map_def2(int idx) { return R_RWIN + idx; }
__device__ __forceinline__ TrD tr_decode(const LAS PG& p, unsigned char* ws, int r) {
  TrD d; d.kind = 0; d.row_off = 0; d.K = 1024; d.N = 1024;
  if (r < 2 * I_HYIN) { const int j = r / I_HYIN; d.W = p.hy_w_in + (size_t)j * D * 4096; d.N = 4096; d.WT = (bf16_t*)(ws + W_HYIN + (size_t)j * 8 * MiB); d.item = r % I_HYIN; return d; } r -= 2 * I_HYIN;
  if (r < 2 * I_SQ) { const int j = r / I_SQ; d.W = p.hy_w_out + (size_t)j * D * D; d.WT = (bf16_t*)(ws + W_HYOUT + (size_t)j * 2 * MiB); d.kind = 1; d.item = r % I_SQ; return d; } r -= 2 * I_SQ;
  if (r < I_MLAIN) { const int nb = r % 45; d.W = p.mla_w_in; d.N = 1440; d.item = r; if (nb < 13) d.WT = (bf16_t*)(ws + W_MLAIN); else { d.WT = (bf16_t*)(ws + W_MLAIN + MiB); d.row_off = -416; } return d; } r -= I_MLAIN;
  if (r < I_QUP) { d.W = p.mla_w_q_up; d.K = 256; d.N = 1536; d.WT = (bf16_t*)(ws + W_QUP); d.item = r; return d; } r -= I_QUP;
  if (r < I_KVUP) { d.W = p.mla_w_kv_up; d.K = 128; d.N = 2048; d.WT = (bf16_t*)(ws + W_KVUP); d.item = r; return d; } r -= I_KVUP;
  if (r < I_SQ) { d.W = p.mla_w_out; d.WT = (bf16_t*)(ws + W_MLAOUT); d.kind = 1; d.item = r; return d; } r -= I_SQ;
  if (r < 4 * I_SQ) { const int q = r / I_SQ; d.W = p.rw_w_in + (size_t)q * D * D; d.WT = (bf16_t*)(ws + W_RWIN + (size_t)q * 2 * MiB); d.item = r % I_SQ; return d; } r -= 4 * I_SQ;
  if (r < 4 * I_LORA) { const int q = r / I_LORA; d.W = (q < 2) ? p.rw_w1 + (size_t)q * D * 64 : p.rw_a1 + (size_t)(q - 2) * D * 64; d.N = 64; d.WT = (bf16_t*)(ws + W_LORA1); d.kind = 1; d.row_off = q * 64; d.item = r % I_LORA; return d; } r -= 4 * I_LORA;
  d.W = p.rw_w_out; d.WT = (bf16_t*)(ws + W_RWOUT); d.kind = 1; d.item = r; return d;
}
__device__ __forceinline__ void tr_load(const TrD& d, int lane, f32x4 (&v)[8]) {
  const int nblk = d.N / 32, kb = d.item / nblk, nb = d.item % nblk, k0 = 64 * kb, n0 = 32 * nb;
  const GAS f32x4* src = (const GAS f32x4*)(d.W + (size_t)(k0 + (lane >> 3)) * d.N + n0 + 4 * (lane & 7));
#pragma unroll
  for (int i = 0; i < 8; ++i) v[i] = __builtin_nontemporal_load(src + (size_t)i * 2 * d.N);
}
__device__ __forceinline__ void tr_finish(const TrD& d, LAS float* scr, int lane, const f32x4 (&v)[8]) {
  const int nblk = d.N / 32, kb = d.item / nblk, nb = d.item % nblk, k0 = 64 * kb, n0 = 32 * nb, K = d.K;
#pragma unroll
  for (int i = 0; i < 8; ++i) { LAS float* dd = scr + (8 * i + (lane >> 3)) * 33 + 4 * (lane & 7); dd[0] = v[i].x; dd[1] = v[i].y; dd[2] = v[i].z; dd[3] = v[i].w; }
  asm volatile("s_waitcnt lgkmcnt(0)" ::: "memory");
  const int c = lane & 7;
#pragma unroll
  for (int jj = 0; jj < 4; ++jj) {
    const int n = (lane >> 3) + 8 * jj; LAS const float* s = scr + (8 * c) * 33 + n;
    u32x4 o; o.x = pk2_(s[0 * 33], s[1 * 33]); o.y = pk2_(s[2 * 33], s[3 * 33]); o.z = pk2_(s[4 * 33], s[5 * 33]); o.w = pk2_(s[6 * 33], s[7 * 33]);
    const int ng = n0 + n + d.row_off;
    if (d.kind == 0) {
      *(u32x4*)(d.WT + (size_t)ng * K + k0 + 8 * c) = o;
    } else {
      const int k8 = (k0 >> 3) + c;
      const size_t ci = ((size_t)((ng >> 5) * 64 + (k8 >> 1))) * 64 + (ng & 31) + 32 * (k8 & 1);
      *(u32x4*)(d.WT + ci * 8) = o;
    }
  }
  asm volatile("s_waitcnt lgkmcnt(0)" ::: "memory");
}
template <int DEF>
__device__ __forceinline__ void tr_run(const LAS PG& p, unsigned char* ws, LAS float* scr, int lane, int first, int stride, int n) {
  for (int it = first; it < n; it += 2 * stride) {
    const TrD dA = tr_decode(p, ws, DEF == 2 ? tr_map_def2(it) : (DEF == 1 ? tr_map_def(it) : tr_map_p0(it)));
    f32x4 vA[8], vB[8];
    tr_load(dA, lane, vA);
    const bool hasB = (it + stride) < n;
    TrD dB = dA;
    if (hasB) { dB = tr_decode(p, ws, DEF == 2 ? tr_map_def2(it + stride) : (DEF == 1 ? tr_map_def(it + stride) : tr_map_p0(it + stride))); tr_load(dB, lane, vB); }
    tr_finish(dA, scr, lane, vA);
    if (hasB) tr_finish(dB, scr, lane, vB);
  }
}

__device__ __forceinline__ void phase_p0a(const LAS PG& p, unsigned char* ws, LAS unsigned char* lds, int tid, int lane, int wave, int bid, int G) {
  PRB_S(10) PRB_S(11)
  LAS float* SC = (LAS float*)lds;
  for (int i = tid; i < 3072; i += 512) { const int g = i >> 10, k = i & 1023; const float c = (g == 0) ? p.c_ctx[k] : p.c[(g - 1) * 1024 + k]; SC[i] = silu(c); }
  __syncthreads();
  LAS float* RED = (LAS float*)lds + 3072;
#ifdef MP_TWICE
  for (int rep_ = 0; rep_ < 2; ++rep_)
#endif
  for (int it = bid; it < 192; it += G) {
    const int kc = it & 7, c6 = (it >> 3) % 6, i = it / 48;
    const int c4 = tid & 127, kq = tid >> 7;
    const int n = c6 * 512 + 4 * c4;
    const GAS f32x4* w = (const GAS f32x4*)(p.mod_w + ((size_t)i * 1024 + kc * 128 + kq * 32) * 3072 + n);
    f32x4 a0 = (f32x4){0.f, 0.f, 0.f, 0.f}, a1 = a0, a2 = a0;
#pragma unroll 16
    for (int k = 0; k < 32; ++k) { const f32x4 wv = __builtin_nontemporal_load(w + (size_t)k * 768); const int kk = kc * 128 + kq * 32 + k; a0 += SC[kk] * wv; a1 += SC[1024 + kk] * wv; a2 += SC[2048 + kk] * wv; }
    if (kq > 0) { LAS f32x4* r = (LAS f32x4*)(RED + ((kq - 1) * 128 + c4) * 12); r[0] = a0; r[1] = a1; r[2] = a2; }
    __syncthreads();
    if (kq == 0) {
#pragma unroll
      for (int q = 0; q < 3; ++q) { LAS const f32x4* r = (LAS const f32x4*)(RED + (q * 128 + c4) * 12); a0 += r[0]; a1 += r[1]; a2 += r[2]; }
      float* mp = (float*)(ws + M_MODP) + (size_t)kc * 36864 + (size_t)i * 9216 + n;
      *(f32x4*)mp = a0; *(f32x4*)(mp + 3072) = a1; *(f32x4*)(mp + 6144) = a2;
    }
    __syncthreads();
  }
  __syncthreads();
  PRB_E(11); PRB_S(12)
  for (int i = bid * 512 + tid; i < 12288; i += G * 512) *(u32x4*)(ws + W_MLAIN + (size_t)416 * 2048 + (size_t)i * 16) = (u32x4){0u, 0u, 0u, 0u};
  for (int i = bid * 512 + tid; i < 2 * PAST * 128 / 8; i += G * 512) {
    const int d8 = i & 15, pl = (i >> 4) & 511, b = i >> 13;
    const f32x4* src = (const f32x4*)(p.cache_ckv + ((size_t)(b * PAST + pl)) * 128 + d8 * 8);
    const f32x4 x0 = src[0], x1 = src[1];
    u32x4 o; o.x = pk2_(x0.x, x0.y); o.y = pk2_(x0.z, x0.w); o.z = pk2_(x1.x, x1.y); o.w = pk2_(x1.z, x1.w);
    *(u32x4*)((bf16_t*)(ws + M_CKVALL) + ((size_t)(NPT + b * 2560 + pl)) * 128 + d8 * 8) = o;
    if (d8 < 4) {
      const f32x4* s2 = (const f32x4*)(p.cache_kpe + ((size_t)(b * PAST + pl)) * 32 + d8 * 8);
      const f32x4 y0 = s2[0], y1 = s2[1];
      u32x4 o2; o2.x = pk2_(y0.x, y0.y); o2.y = pk2_(y0.z, y0.w); o2.z = pk2_(y1.x, y1.y); o2.w = pk2_(y1.z, y1.w);
      *(u32x4*)((bf16_t*)(ws + M_KPEB) + ((size_t)(NPT + b * 2560 + pl)) * 32 + d8 * 8) = o2;
    }
  }
  PRB_E(12); PRB_S(13)
  LAS float* scr = (LAS float*)(lds + wave * 16384);
  const int gw = bid * 8 + wave, NGW = G * 8;
  tr_run<0>(p, ws, scr, lane, gw, NGW, NTR_P0);
#ifdef TR_TWICE
  tr_run<0>(p, ws, scr, lane, gw, NGW, NTR_P0);
#endif
  PRB_E(13); PRB_S(14)
  if (G != 256 || bid >= 192) {
    __syncthreads();
    const int jh = (G == 256) ? ((bid >= 224) ? 1 : 0) : ((bid * 2 >= G) ? 1 : 0);
    LAS float* w1s = (LAS float*)(lds + 131072);
    LAS float* w2s = w1s + 33 * 64;
    for (int i = tid; i < 33 * 64; i += 512) w1s[i] = p.hy_w1[(size_t)jh * 33 * 64 + i];
    for (int i = tid; i < 64 * 64; i += 512) w2s[i] = p.hy_w2[(size_t)jh * 64 * 64 + i];
    __syncthreads();
    const float b1 = p.hy_b1[jh * 64 + lane], b2 = p.hy_b2[jh * 64 + lane], f0 = p.hy_freq[(jh * 2 + 0) * 64 + lane], f1 = p.hy_freq[(jh * 2 + 1) * 64 + lane];
    const int nbh = (G == 256) ? 32 : (jh ? (G - (G + 1) / 2) : ((G + 1) / 2)), bh = (G == 256) ? ((bid - 192) & 31) : (jh ? (bid - (G + 1) / 2) : bid);
    for (int row = bh * 8 + wave; row < 2304; row += nbh * 8) {
      const int L = row < 256 ? 256 : 2048, l = row < 256 ? row : row - 256;
      const float t = (float)l / (float)(L - 1);
      float feat = 0.f;
      if (lane == 0) feat = t;
      else if (lane < 33) {
        const int b = (lane - 1) & 15;
        const float band = 1e-4f + (float)b * ((15.f - 1e-4f) / 15.f);
        const float rev = ((float)l / (float)L) * band;
        const float fr = rev - floorf(rev);
        feat = (lane <= 16) ? __builtin_amdgcn_cosf(fr) : -__builtin_amdgcn_sinf(fr);
      }
      float a = b1;
#pragma unroll
      for (int f = 0; f < 33; ++f) a += rdlane(feat, f) * w1s[f * 64 + lane];
      const float x1 = f0 * a * 0.15915494309189535f;
      const float h1 = __builtin_amdgcn_sinf(x1 - floorf(x1));
      float a2 = b2;
#pragma unroll 16
      for (int f = 0; f < 64; ++f) a2 += rdlane(h1, f) * w2s[f * 64 + lane];
      const float x2 = f1 * a2 * 0.15915494309189535f;
      const float h2 = __builtin_amdgcn_sinf(x2 - floorf(x2));
      ((float*)(ws + M_HDN2))[((size_t)jh * 2304 + row) * 64 + lane] = h2;
    }
  }
  PRB_E(14); PRB_E(10);
}

__device__ __forceinline__ void phase_p0b(const LAS PG& p, unsigned char* ws, LAS unsigned char* lds, int tid, int lane, int wave, int bid, int G) {
  PRB_S(20) PRB_S(21)
  const float* MP = (const float*)(ws + M_MODP);
  float* MODS = (float*)(ws + M_MODS);
  for (int idx = bid * 512 + tid; idx < 36864; idx += G * 512) {
    float s = p.mod_b[(idx / 9216) * 3072 + (idx % 3072)];
#pragma unroll
    for (int kc = 0; kc < 8; ++kc) s += MP[(size_t)kc * 36864 + idx];
    MODS[idx] = s;
  }
  LAS float* ML = (LAS float*)lds;
  int l0_, L0_, cond0, m00_; tokinfo(bid * 32, l0_, L0_, cond0, m00_);
  const int e_lo = (G == 256) ? cond0 * 2048 : 0, e_hi = (G == 256) ? e_lo + 2048 : 6144;
  for (int e = e_lo + tid; e < e_hi; e += 512) {
    const int g = e >> 11, r = e & 2047; const int idx = g * 3072 + r;
    float s = p.mod_b[r];
#pragma unroll
    for (int kc = 0; kc < 8; ++kc) s += MP[(size_t)kc * 36864 + idx];
    ML[e] = s;
  }
  __syncthreads();
  PRB_E(21); PRB_S(22)
  bf16_t* HB = (bf16_t*)(ws + M_HB);
#ifndef NO_H0
#ifdef H0_TWICE
  for (int rep_ = 0; rep_ < 2; ++rep_)
#endif
  for (int mi = 0; mi < NTOK / (G * 8); ++mi) {
    const int m = (G == 256) ? (bid * 32 + wave * 4 + mi) : (bid * 8 + wave + mi * G * 8);
    int l, L, cond, m0; tokinfo(m, l, L, cond, m0);
    const GAS f32x4* xr = (const GAS f32x4*)xrow_in(p, 0, ws, m);
    LAS const float* sh = ML + cond * 2048; LAS const float* sc = sh + 1024;
#pragma unroll
    for (int i = 0; i < 4; ++i) {
      const int k = 4 * lane + 256 * i; const f32x4 x = __builtin_nontemporal_load(xr + lane + 64 * i);
      u32x2 o; o.x = pk2_(x.x * (1.f + sc[k]) + sh[k], x.y * (1.f + sc[k + 1]) + sh[k + 1]); o.y = pk2_(x.z * (1.f + sc[k + 2]) + sh[k + 2], x.w * (1.f + sc[k + 3]) + sh[k + 3]);
      *(u32x2*)(HB + (size_t)m * D + k) = o;
    }
  }
#endif
  __syncthreads();
  PRB_E(22); PRB_S(23)
#ifndef NO_FG
  const int gw = bid * 8 + wave, NGW = G * 8;
  const float* HD = (const float*)(ws + M_HDN2);
  bf16_t* FILT = (bf16_t*)(ws + M_FILT);
  const int r32 = lane & 31, hi = lane >> 5;
#ifdef FG_TWICE
  for (int rep_ = 0; rep_ < 2; ++rep_)
#endif
  for (int wslot = gw; wslot < 64 * 32; wslot += NGW) {
    const int combo = wslot & 63, sub = wslot >> 6;
    const int cch = combo & 15, dir = (combo >> 4) & 1, j = combo >> 5;
    LAS unsigned char* stg = lds + wave * 2048;
    LAS float* w3s = (LAS float*)(lds + 16384 + wave * 16384);
    {
      const GASF* w3u = p.hy_w3 + ((size_t)j * 64 * 2048 + dir * 1024 + cch * 64);
      asm volatile("s_waitcnt lgkmcnt(0)" ::: "memory");
#pragma unroll 2
      for (int mh = 0; mh < 2; ++mh) {
        float wv[32];
#pragma unroll
        for (int m = 0; m < 32; ++m) wv[m] = w3u[(size_t)(32 * mh + m) * 2048 + lane];
#pragma unroll
        for (int m = 0; m < 32; ++m) w3s[(32 * mh + m) * 64 + lane] = wv[m];
      }
      asm volatile("s_waitcnt lgkmcnt(0)" ::: "memory");
    }
    bf16x8 bw[2][4];
    {
      LAS const float* wb = w3s + (8 * hi) * 64 + r32;
#pragma unroll
      for (int nt = 0; nt < 2; ++nt)
#pragma unroll
        for (int ks = 0; ks < 4; ++ks) {
          LAS const float* q = wb + (16 * ks) * 64 + 32 * nt;
          u32x4 o; o.x = pk2_(q[0], q[64]); o.y = pk2_(q[128], q[192]); o.z = pk2_(q[256], q[320]); o.w = pk2_(q[384], q[448]);
          bw[nt][ks] = __builtin_bit_cast(bf16x8, o);
        }
    }
    float cb3[2], cdec[2];
#pragma unroll
    for (int nt = 0; nt < 2; ++nt) { const int o = dir * 1024 + cch * 64 + 32 * nt + r32; cb3[nt] = p.hy_b3[j * 2048 + o]; cdec[nt] = fabsf(p.hy_decay[(size_t)j * 2048 + o]); }
    f32x4 nx[8];
#define FG_FETCH(IT) do { const int it_ = (IT); const int set_ = it_ < 8 ? 0 : 1, b_ = set_ ? it_ - 8 : it_, L_ = set_ ? 2048 : 256, row0_ = set_ ? 256 : 0; \
      const int lag_ = 32 * b_ + (dir ? 0 : 1) + r32; const bool ok_ = dir ? (lag_ >= 1) : (lag_ <= L_ - 1); \
      const float* hrow_ = HD + ((size_t)j * 2304 + row0_ + (ok_ ? lag_ : 0)) * 64 + 8 * hi; \
      _Pragma("unroll") for (int ks = 0; ks < 4; ++ks) { nx[2 * ks] = *(const f32x4*)(hrow_ + 16 * ks); nx[2 * ks + 1] = *(const f32x4*)(hrow_ + 16 * ks + 4); } } while (0)
    FG_FETCH(sub);
#pragma unroll 1
    for (int it = sub; it < 72; it += 32) {
      const int set = it < 8 ? 0 : 1, b = set ? it - 8 : it, L = set ? 2048 : 256;
      const int lag0 = 32 * b + (dir ? 0 : 1);
      bf16x8 af[4];
      {
        const int lag = lag0 + r32; const bool ok = dir ? (lag >= 1) : (lag <= L - 1);
#pragma unroll
        for (int ks = 0; ks < 4; ++ks) {
          f32x4 x0 = nx[2 * ks], x1 = nx[2 * ks + 1];
          if (!ok) { x0 = (f32x4){0.f, 0.f, 0.f, 0.f}; x1 = x0; }
          u32x4 o; o.x = pk2_(x0.x, x0.y); o.y = pk2_(x0.z, x0.w); o.z = pk2_(x1.x, x1.y); o.w = pk2_(x1.z, x1.w);
          af[ks] = __builtin_bit_cast(bf16x8, o);
        }
      }
      if (it + 32 < 72) FG_FETCH(it + 32);
      const float tinv = 1.f / (float)(L - 1);
#pragma unroll
      for (int nt = 0; nt < 2; ++nt) {
        f32x16 acc;
#pragma unroll
        for (int i = 0; i < 16; ++i) acc[i] = 0.f;
#pragma unroll
        for (int ks = 0; ks < 4; ++ks) acc = __builtin_amdgcn_mfma_f32_32x32x16_bf16(af[ks], bw[nt][ks], acc, 0, 0, 0);
        bf16_t* fch = FILT + ((size_t)(j * 1024 + cch * 64 + 32 * nt + r32)) * FILT_CH + (set ? 528 : 0) + L + 8;
#pragma unroll
        for (int q = 0; q < 4; ++q) {
          unsigned v[4];
#pragma unroll
          for (int x = 0; x < 4; ++x) {
            const int lag = lag0 + 8 * q + 4 * hi + x;
            const bool ok = dir ? (lag >= 1) : (lag <= L - 1);
            const float val = (acc[4 * q + x] + cb3[nt]) * __expf(-(float)lag * tinv * cdec[nt]);
            v[x] = ok ? f2bf_(val) : 0u;
          }
          if (dir && lag0 == 0) {
            const int i0 = 8 * q + 4 * hi;
            if (i0 != 0) { u32x2 w; w.x = v[0] | (v[1] << 16); w.y = v[2] | (v[3] << 16); *(u32x2*)(fch + i0) = w; }
            else { fch[1] = (bf16_t)v[1]; fch[2] = (bf16_t)v[2]; fch[3] = (bf16_t)v[3]; }
          } else {
            const int g8 = dir ? (2 * q + hi) : (7 - 2 * q - hi);
            u32x2 w; if (dir) { w.x = v[0] | (v[1] << 16); w.y = v[2] | (v[3] << 16); } else { w.x = v[3] | (v[2] << 16); w.y = v[1] | (v[0] << 16); }
            *(LAS u32x2*)(stg + r32 * 64 + ((g8 ^ (r32 & 7)) << 3)) = w;
          }
        }
        if (!(dir && lag0 == 0)) {
          asm volatile("s_waitcnt lgkmcnt(0)" ::: "memory");
          const int ch2 = lane >> 1, hf = lane & 1;
          LAS const unsigned char* rowp = stg + ch2 * 64;
          const u32x2 g0 = *(LAS const u32x2*)(rowp + (((4 * hf + 0) ^ (ch2 & 7)) << 3)), g1 = *(LAS const u32x2*)(rowp + (((4 * hf + 1) ^ (ch2 & 7)) << 3));
          const u32x2 g2 = *(LAS const u32x2*)(rowp + (((4 * hf + 2) ^ (ch2 & 7)) << 3)), g3 = *(LAS const u32x2*)(rowp + (((4 * hf + 3) ^ (ch2 & 7)) << 3));
          bf16_t* dstp = FILT + ((size_t)(j * 1024 + cch * 64 + 32 * nt + ch2)) * FILT_CH + (set ? 528 : 0) + L + 8 + (dir ? lag0 : -(lag0 + 31)) + 16 * hf;
          *(u32x4*)dstp = (u32x4){g0.x, g0.y, g1.x, g1.y};
          *(u32x4*)(dstp + 8) = (u32x4){g2.x, g2.y, g3.x, g3.y};
          asm volatile("s_waitcnt lgkmcnt(0)" ::: "memory");
        }
      }
    }
#undef FG_FETCH
    if (sub == 31) {
      const int c = cch * 64 + lane, o = dir * 1024 + c;
#pragma unroll 1
      for (int set = 0; set < 2; ++set) {
        const int L = set ? 2048 : 256, row0 = set ? 256 : 0;
        bf16_t* fch = FILT + ((size_t)(j * 1024 + c)) * FILT_CH + (set ? 528 : 0) + L + 8;
        if (!dir) {
          const float hv = HD[((size_t)j * 2304 + row0) * 64 + lane];
          float a = p.hy_b3[j * 2048 + o];
#pragma unroll 16
          for (int m = 0; m < 64; ++m) a += rdlane(hv, m) * w3s[m * 64 + lane];
          fch[0] = (bf16_t)f2bf_(a + p.hy_skip[j * D + c]);
        } else {
          *(u32x4*)(fch + L) = (u32x4){0u, 0u, 0u, 0u};
        }
      }
    }
  }
#endif
  PRB_E(23); PRB_E(20);
}
constexpr int FKG = 144;
constexpr int FK_S = 0, FK_P = 74240, VBS = FK_P + 66 * FKG, VBP = VBS + 2 * 8704, VB_END = VBP + 16 * 1664, E_OFF = VB_END, SCR_S = 0, SCR_SL = 32 * 36 * 4, SCR_P = 16 * SCR_SL;
__device__ __forceinline__ float conv3e(float pv, float cur, float nx, float w0, float w1, float w2, float b) { return pv * w0 + cur * w1 + nx * w2 + b; }

__device__ __forceinline__ void phase_hy_conv(const LAS PG& p, unsigned char* ws, LAS unsigned char* lds, int j, int tid, int lane, int wave, int bid, int G) {
  const bf16_t* UT = (const bf16_t*)(ws + M_UT);
  bf16_t* GT = (bf16_t*)(ws + M_GB);
  const bf16_t* FILT = (const bf16_t*)(ws + M_FILT);
  const int r = lane & 31, h = lane >> 5, rho = (-r) & 7;
  u32x4 fX0[2], fX1[2], fXV[2], fXZ[2]; unsigned fP[2][3], fN[2][3]; u32x4 fLo[2], fHi[2];
#define HC_FETCH(CH) do { const int c_ = (CH); \
    _Pragma("unroll") for (int u_ = 0; u_ < 2; ++u_) { const int tok_ = (tid + 512 * u_) * 8; \
      const int l_ = (tok_ < NPT) ? (tok_ & 255) : ((tok_ - NPT) & 2047); const int L_ = (tok_ < NPT) ? 256 : 2048; \
      const bf16_t* r0_ = UT + (size_t)c_ * 8192 + tok_; const bf16_t* r1_ = r0_ + (size_t)1024 * 8192; const bf16_t* r2_ = r0_ + (size_t)2048 * 8192; const bf16_t* r3_ = r0_ + (size_t)3072 * 8192; \
      fX0[u_] = *(const u32x4*)r0_; fX1[u_] = *(const u32x4*)r1_; fXV[u_] = *(const u32x4*)r2_; fXZ[u_] = *(const u32x4*)r3_; \
      const bool hp_ = l_ > 0, hn_ = (l_ + 8) < L_; \
      fP[u_][0] = hp_ ? (unsigned)r0_[-1] : 0u; fP[u_][1] = hp_ ? (unsigned)r1_[-1] : 0u; fP[u_][2] = hp_ ? (unsigned)r2_[-1] : 0u; \
      fN[u_][0] = hn_ ? (unsigned)r0_[8] : 0u; fN[u_][1] = hn_ ? (unsigned)r1_[8] : 0u; fN[u_][2] = hn_ ? (unsigned)r2_[8] : 0u; } \
    const bf16_t* Rc_ = FILT + ((size_t)(j * 1024 + c_)) * FILT_CH; \
    _Pragma("unroll") for (int u_ = 0; u_ < 2; ++u_) { const int gi_ = tid + 512 * u_; fLo[u_] = (u32x4){0u, 0u, 0u, 0u}; fHi[u_] = fLo[u_]; \
      if (gi_ < 515 + 66) { const bool smp_ = gi_ < 515; const int gq_ = smp_ ? gi_ : gi_ - 515; const int LEN_ = smp_ ? 4112 : 528; const bf16_t* Rg_ = Rc_ + (smp_ ? 528 : 0); const int idx0_ = 8 * gq_ + 8; \
        if (idx0_ + 8 <= LEN_) fLo[u_] = *(const u32x4*)(Rg_ + idx0_); if (idx0_ + 16 <= LEN_) fHi[u_] = *(const u32x4*)(Rg_ + idx0_ + 8); } } } while (0)
  if (bid < 1024) HC_FETCH(bid);
  static_assert(515 * FKG <= FK_P && E_OFF + 8192 * 4 <= PTAB_OFF && (VBS % 16) == 0, "conv LDS map");
  static_assert(SCR_P + 8 * SCR_SL <= E_OFF, "conv scratch overlaps the epilogue factors");
  for (int c = bid; c < 1024; c += G) {
    PRB_S(1) PRB_S(5)
    __syncthreads();
    for (int i = tid; i < (VB_END - VBS) / 16; i += 512) *(LAS u32x4*)(lds + VBS + i * 16) = (u32x4){0u, 0u, 0u, 0u};
    __syncthreads();
    PRB_E(1); PRB_S(2)
    {
      const GASF* cw = p.hy_conv_w + (size_t)j * 3 * 3072; const GASF* cb = p.hy_conv_b + (size_t)j * 3072;
      const float a0 = cw[c], a1 = cw[3072 + c], a2 = cw[6144 + c], ab = cb[c];
      const float b0 = cw[1024 + c], b1 = cw[3072 + 1024 + c], b2 = cw[6144 + 1024 + c], bb = cb[1024 + c];
      const float v0 = cw[2048 + c], v1 = cw[3072 + 2048 + c], v2 = cw[6144 + 2048 + c], vbb = cb[2048 + c];
#pragma unroll
      for (int u = 0; u < 2; ++u) {
        const int tok = (tid + 512 * u) * 8;
        unsigned dst;
        if (tok < NPT) { const int l = tok & 255; const int chunk = 32 + (l >> 3); dst = VBP + (tok >> 8) * 1664 + (chunk + (chunk >> 4)) * 16; }
        else { const int mm = tok - NPT; const int l = mm & 2047; const int chunk = 128 + (l >> 3); dst = VBS + (mm >> 11) * 8704 + (chunk + (chunk >> 4)) * 16; }
        const u32x4 X0 = fX0[u], X1 = fX1[u], XV = fXV[u], XZ = fXZ[u];
        float x0[10], x1[10], xv[10], z[8];
        x0[0] = bf2f(fP[u][0]); x1[0] = bf2f(fP[u][1]); xv[0] = bf2f(fP[u][2]); x0[9] = bf2f(fN[u][0]); x1[9] = bf2f(fN[u][1]); xv[9] = bf2f(fN[u][2]);
#pragma unroll
        for (int e = 0; e < 4; ++e) {
          x0[1 + 2 * e] = bf2f(X0[e] & 0xffffu); x0[2 + 2 * e] = bf2f(X0[e] >> 16);
          x1[1 + 2 * e] = bf2f(X1[e] & 0xffffu); x1[2 + 2 * e] = bf2f(X1[e] >> 16);
          xv[1 + 2 * e] = bf2f(XV[e] & 0xffffu); xv[2 + 2 * e] = bf2f(XV[e] >> 16);
          z[2 * e] = bf2f(XZ[e] & 0xffffu); z[2 * e + 1] = bf2f(XZ[e] >> 16);
        }
        float vv[8], ev[8];
#pragma unroll
        for (int e = 0; e < 8; ++e) {
          const float c0 = conv3e(x0[e], x0[e + 1], x0[e + 2], a0, a1, a2, ab);
          const float c1 = conv3e(x1[e], x1[e + 1], x1[e + 2], b0, b1, b2, bb);
          const float cv = conv3e(xv[e], xv[e + 1], xv[e + 2], v0, v1, v2, vbb);
          vv[e] = cv * c1; ev[e] = c0 * (z[e] * __builtin_amdgcn_rcpf(1.f + __expf(-z[e])));
        }
        u32x4 o; o.x = pk2_(vv[0], vv[1]); o.y = pk2_(vv[2], vv[3]); o.z = pk2_(vv[4], vv[5]); o.w = pk2_(vv[6], vv[7]);
        *(LAS u32x4*)(lds + dst) = o;
        *(LAS f32x4*)(lds + E_OFF + tok * 4) = (f32x4){ev[0], ev[1], ev[2], ev[3]};
        *(LAS f32x4*)(lds + E_OFF + tok * 4 + 16) = (f32x4){ev[4], ev[5], ev[6], ev[7]};
      }
#pragma unroll
      for (int u = 0; u < 2; ++u) {
        const int gi = tid + 512 * u;
        if (gi < 515 + 66) {
          const bool smp = gi < 515; const int gq = smp ? gi : gi - 515;
          const u32x4 lo = fLo[u], hi = fHi[u];
          const unsigned d0 = lo.x, d1 = lo.y, d2 = lo.z, d3 = lo.w, d4 = hi.x, d5 = hi.y, d6 = hi.z, d7 = hi.w;
          LAS unsigned char* dstp = lds + (smp ? FK_S : FK_P) + gq * FKG;
#define AB(hi_, lo_) __builtin_amdgcn_alignbit(hi_, lo_, 16)
          *(LAS u32x4*)(dstp + 0) = (u32x4){d0, d1, d2, d3};
          *(LAS u32x4*)(dstp + 16) = (u32x4){AB(d1, d0), AB(d2, d1), AB(d3, d2), AB(d4, d3)};
          *(LAS u32x4*)(dstp + 32) = (u32x4){d1, d2, d3, d4};
          *(LAS u32x4*)(dstp + 48) = (u32x4){AB(d2, d1), AB(d3, d2), AB(d4, d3), AB(d5, d4)};
          *(LAS u32x4*)(dstp + 64) = (u32x4){d2, d3, d4, d5};
          *(LAS u32x4*)(dstp + 80) = (u32x4){AB(d3, d2), AB(d4, d3), AB(d5, d4), AB(d6, d5)};
          *(LAS u32x4*)(dstp + 96) = (u32x4){d3, d4, d5, d6};
          *(LAS u32x4*)(dstp + 112) = (u32x4){AB(d4, d3), AB(d5, d4), AB(d6, d5), AB(d7, d6)};
#undef AB
        }
      }
    }
    __syncthreads();
    PRB_E(2); PRB_S(3)
    if (c + G < 1024) HC_FETCH(c + G);
    f32x16 s0, s1, pr;
#pragma unroll
    for (int i = 0; i < 16; ++i) { s0[i] = 0.f; s1[i] = 0.f; pr[i] = 0.f; }
    {
      const int ahalf = wave & 1, dq = wave >> 1;
      const int a = ahalf * 32 + r;
      const int n0 = (ahalf ? -64 : -128) + 48 * dq;
      const int q0 = (8 * h - r - 16 * n0 - rho) >> 3;
      int aA = FK_S + (q0 + 256) * FKG + rho * 16 - 14 * FKG;
      const int qbase = 128 + h + 4 * a - 2 * n0;
      int bB[8];
#pragma unroll
      for (int i = 0; i < 8; ++i) { const int qb = qbase - 2 * i; bB[i] = VBS + (qb + (qb >> 4)) * 16; }
#pragma unroll 1
      for (int j = 0; j < 6; ++j) {
        bf16x8 af = *(LAS const bf16x8*)(lds + aA + 7 * 2 * FKG), b0 = *(LAS const bf16x8*)(lds + bB[0]), b1 = *(LAS const bf16x8*)(lds + bB[0] + 8704);
#pragma unroll
        for (int i = 0; i < 8; ++i) {
          bf16x8 naf = af, nb0 = b0, nb1 = b1;
          if (i < 7) {
            naf = *(LAS const bf16x8*)(lds + aA + (6 - i) * 2 * FKG);
            if (i == 6 && dq == 3 && j == 5) naf = (bf16x8){0, 0, 0, 0, 0, 0, 0, 0};
            nb0 = *(LAS const bf16x8*)(lds + bB[i + 1]); nb1 = *(LAS const bf16x8*)(lds + bB[i + 1] + 8704);
          }
          __builtin_amdgcn_sched_barrier(0);
          s0 = __builtin_amdgcn_mfma_f32_32x32x16_bf16(af, b0, s0, 0, 0, 0);
          s1 = __builtin_amdgcn_mfma_f32_32x32x16_bf16(af, b1, s1, 0, 0, 0);
          __builtin_amdgcn_sched_barrier(0);
          af = naf; b0 = nb0; b1 = nb1;
        }
        aA -= 16 * FKG;
#pragma unroll
        for (int i = 0; i < 8; ++i) bB[i] -= 17 * 16;
      }
    }
    {
      const int ntile = wave & 3, dh = wave >> 2;
      const int batch = 4 * ntile + (r >> 3), a = r & 7;
      const int n0 = dh ? 0 : -16;
      const int q0 = (8 * h - r - 16 * n0 - rho) >> 3;
      int aA = FK_P + (q0 + 32) * FKG + rho * 16 - 14 * FKG;
      const int qbase = 32 + h + 4 * a - 2 * n0;
      int bB[8];
#pragma unroll
      for (int i = 0; i < 8; ++i) { const int qb = qbase - 2 * i; bB[i] = VBP + batch * 1664 + (qb + (qb >> 4)) * 16; }
#pragma unroll 1
      for (int j = 0; j < 2; ++j) {
        bf16x8 af = *(LAS const bf16x8*)(lds + aA + 7 * 2 * FKG), b0 = *(LAS const bf16x8*)(lds + bB[0]);
#pragma unroll
        for (int i = 0; i < 8; ++i) {
          bf16x8 naf = af, nb0 = b0;
          if (i < 7) {
            naf = *(LAS const bf16x8*)(lds + aA + (6 - i) * 2 * FKG);
            if (i == 6 && dh == 1 && j == 1) naf = (bf16x8){0, 0, 0, 0, 0, 0, 0, 0};
            nb0 = *(LAS const bf16x8*)(lds + bB[i + 1]);
          }
          __builtin_amdgcn_sched_barrier(0);
          pr = __builtin_amdgcn_mfma_f32_32x32x16_bf16(af, b0, pr, 0, 0, 0);
          __builtin_amdgcn_sched_barrier(0);
          af = naf; b0 = nb0;
        }
        aA -= 16 * FKG;
#pragma unroll
        for (int i = 0; i < 8; ++i) bB[i] -= 17 * 16;
      }
    }
    __syncthreads();
    PRB_E(3); PRB_S(4)
    {
      const int ahalf = wave & 1, dq = wave >> 1;
#pragma unroll
      for (int g = 0; g < 4; ++g) {
        const int off = (r * 36 + 8 * g + 4 * h) * 4;
        *(LAS f32x4*)(lds + SCR_S + ((ahalf * 2 + 0) * 4 + dq) * SCR_SL + off) = (f32x4){s0[4 * g], s0[4 * g + 1], s0[4 * g + 2], s0[4 * g + 3]};
        *(LAS f32x4*)(lds + SCR_S + ((ahalf * 2 + 1) * 4 + dq) * SCR_SL + off) = (f32x4){s1[4 * g], s1[4 * g + 1], s1[4 * g + 2], s1[4 * g + 3]};
        *(LAS f32x4*)(lds + SCR_P + ((wave & 3) * 2 + (wave >> 2)) * SCR_SL + off) = (f32x4){pr[4 * g], pr[4 * g + 1], pr[4 * g + 2], pr[4 * g + 3]};
      }
    }
    __syncthreads();
    {
      {
        const int o = tid * 8; const int b = o >> 11, t = o & 2047; const int a = t >> 5, rr = t & 31; const int tile = (a >> 5) * 2 + b, col = a & 31;
        f32x4 y0 = (f32x4){0.f, 0.f, 0.f, 0.f}, y1 = y0;
#pragma unroll
        for (int dq = 0; dq < 4; ++dq) {
          LAS const unsigned char* sp = lds + SCR_S + (tile * 4 + dq) * SCR_SL + (col * 36 + rr) * 4;
          y0 += *(LAS const f32x4*)sp; y1 += *(LAS const f32x4*)(sp + 16);
        }
        const int token = NPT + o;
        const f32x4 e0 = *(LAS const f32x4*)(lds + E_OFF + token * 4), e1 = *(LAS const f32x4*)(lds + E_OFF + token * 4 + 16);
        u32x4 ov; ov.x = pk2_(y0.x * e0.x, y0.y * e0.y); ov.y = pk2_(y0.z * e0.z, y0.w * e0.w); ov.z = pk2_(y1.x * e1.x, y1.y * e1.y); ov.w = pk2_(y1.z * e1.z, y1.w * e1.w);
        *(u32x4*)(GT + (size_t)c * 8192 + token) = ov;
      }
      {
        const int o = tid * 8; const int batch = o >> 8, t = o & 255; const int ntile = batch >> 2, col = (batch & 3) * 8 + (t >> 5), rr = t & 31;
        f32x4 y0 = (f32x4){0.f, 0.f, 0.f, 0.f}, y1 = y0;
#pragma unroll
        for (int dh = 0; dh < 2; ++dh) {
          LAS const unsigned char* sp = lds + SCR_P + (ntile * 2 + dh) * SCR_SL + (col * 36 + rr) * 4;
          y0 += *(LAS const f32x4*)sp; y1 += *(LAS const f32x4*)(sp + 16);
        }
        const int token = o;
        const f32x4 e0 = *(LAS const f32x4*)(lds + E_OFF + token * 4), e1 = *(LAS const f32x4*)(lds + E_OFF + token * 4 + 16);
        u32x4 ov; ov.x = pk2_(y0.x * e0.x, y0.y * e0.y); ov.y = pk2_(y0.z * e0.z, y0.w * e0.w); ov.z = pk2_(y1.x * e1.x, y1.y * e1.y); ov.w = pk2_(y1.z * e1.z, y1.w * e1.w);
        *(u32x4*)(GT + (size_t)c * 8192 + token) = ov;
      }
    }
    PRB_E(4); PRB_E(5);
  }
}

template <int MODE>
__device__ __forceinline__ void phase_out_ln(const LAS PG& p, unsigned char* ws, LAS unsigned char* lds, int layer, const bf16_t* Wf, int tid, int lane, int wave, int bid, int G) {
  const bf16_t* GA = (const bf16_t*)(ws + M_GB);
  const float* MODS = (const float*)(ws + M_MODS);
  const int h = lane >> 5;
  for (int tile = bid; tile < NTOK / 32; tile += G) {
    const int t0 = tile * 32;
    __syncthreads();
    constexpr bool CHM = (MODE == 1);
    if (MODE == 2) {
      const float* BON = (const float*)(ws + M_GB + 8 * MiB);
      const int sub = lane >> 4, c4 = lane & 15;
#pragma unroll 2
      for (int it = 0; it < 16; ++it) {
        const int pr = wave * 64 + it * 4 + sub; const int tok = pr >> 4, hd = pr & 15, m = t0 + tok;
        const unsigned gi = (unsigned)m * (unsigned)D + (unsigned)(hd * 64 + 4 * c4);
        const u32x2 yf = *(const u32x2*)((const bf16_t*)(ws + M_UT) + gi), yb = *(const u32x2*)((const bf16_t*)(ws + M_UT + 32 * MiB) + gi);
        const f32x4 y = (f32x4){bf2f(yf.x & 0xffffu) + bf2f(yb.x & 0xffffu), bf2f(yf.x >> 16) + bf2f(yb.x >> 16), bf2f(yf.y & 0xffffu) + bf2f(yb.y & 0xffffu), bf2f(yf.y >> 16) + bf2f(yb.y >> 16)};
        float s1 = (y.x + y.y) + (y.z + y.w);
        s1 += __builtin_bit_cast(float, __builtin_amdgcn_update_dpp(0, __builtin_bit_cast(int, s1), 0xB1, 0xF, 0xF, true));
        s1 += __builtin_bit_cast(float, __builtin_amdgcn_update_dpp(0, __builtin_bit_cast(int, s1), 0x4E, 0xF, 0xF, true));
        s1 += __builtin_bit_cast(float, __builtin_amdgcn_update_dpp(0, __builtin_bit_cast(int, s1), 0x141, 0xF, 0xF, true));
        s1 += __builtin_bit_cast(float, __builtin_amdgcn_update_dpp(0, __builtin_bit_cast(int, s1), 0x140, 0xF, 0xF, true));
        const float mu = s1 * (1.f / 64.f);
        const f32x4 d = y - mu;
        float s2 = (d.x * d.x + d.y * d.y) + (d.z * d.z + d.w * d.w);
        s2 += __builtin_bit_cast(float, __builtin_amdgcn_update_dpp(0, __builtin_bit_cast(int, s2), 0xB1, 0xF, 0xF, true));
        s2 += __builtin_bit_cast(float, __builtin_amdgcn_update_dpp(0, __builtin_bit_cast(int, s2), 0x4E, 0xF, 0xF, true));
        s2 += __builtin_bit_cast(float, __builtin_amdgcn_update_dpp(0, __builtin_bit_cast(int, s2), 0x141, 0xF, 0xF, true));
        s2 += __builtin_bit_cast(float, __builtin_amdgcn_update_dpp(0, __builtin_bit_cast(int, s2), 0x140, 0xF, 0xF, true));
        const float rstd = rsqrtf(s2 * (1.f / 64.f) + GN_EPS);
        const f32x4 bo0 = *(const f32x4*)(BON + ((unsigned)m * 16u + (unsigned)hd) * 4u), bo1 = *(const f32x4*)(BON + (((unsigned)NTOK + (unsigned)m) * 16u + (unsigned)hd) * 4u);
        const float bon = ((bo0.x + bo0.y) + (bo0.z + bo0.w)) + ((bo1.x + bo1.y) + (bo1.z + bo1.w));
        const u32x2 v2 = *(const u32x2*)((const bf16_t*)(ws + M_SCR2 + 32 * MiB) + gi), z2 = *(const u32x2*)((const bf16_t*)(ws + M_SCR2 + 48 * MiB) + gi);
        const f32x4 gg = *(const GAS f32x4*)(p.rw_gn_g + hd * 64 + 4 * c4), gb = *(const GAS f32x4*)(p.rw_gn_b + hd * 64 + 4 * c4);
        const f32x4 yn = d * rstd * gg + gb;
        u32x2 o;
        o.x = pk2_((yn.x + bon * bf2f(v2.x & 0xffffu)) * bf2f(z2.x & 0xffffu), (yn.y + bon * bf2f(v2.x >> 16)) * bf2f(z2.x >> 16));
        o.y = pk2_((yn.z + bon * bf2f(v2.y & 0xffffu)) * bf2f(z2.y & 0xffffu), (yn.w + bon * bf2f(v2.y >> 16)) * bf2f(z2.y >> 16));
        *(LAS u32x2*)(lds + ((hd * 8 + (c4 >> 1)) * 32 + tok) * 16 + (c4 & 1) * 8) = o;
      }
    } else {
#pragma unroll
    for (int i = 0; i < 8; ++i) {
      const int idx = tid + 512 * i;
      if (CHM) { const int c = idx >> 2, part = idx & 3; *(LAS u32x4*)(lds + c * 64 + part * 16) = *(const u32x4*)(GA + (size_t)c * 8192 + t0 + 8 * part); }
      else { const int tok = idx >> 7, k8 = idx & 127; *(LAS u32x4*)(lds + (k8 * 32 + tok) * 16) = *(const u32x4*)(GA + (size_t)(t0 + tok) * D + 8 * k8); }
    }
    }
    __syncthreads();
    f32x16 acc[4];
#pragma unroll
    for (int nt = 0; nt < 4; ++nt)
#pragma unroll
      for (int i = 0; i < 16; ++i) acc[nt][i] = 0.f;
    const bf16_t* wf = Wf + ((size_t)(wave * 4) * 64 * 64 + lane) * 8;
    const int aoffT = ((h * 32) + (lane & 31)) * 16;
    const int aoffC = (8 * h + ((lane & 15) >> 2)) * 64 + 32 * ((lane >> 4) & 1) + 8 * (lane & 3);
    if constexpr (MODE == 2) {
      const unsigned char* wfu = uni((const unsigned char*)Wf + (size_t)(wave * 4) * 64 * 1024);
      const unsigned wlo = (unsigned)lane * 16u;
      bf16x8 ring[4][4];
#pragma unroll
      for (int j = 0; j < 4; ++j)
#pragma unroll
        for (int nt = 0; nt < 4; ++nt) ring[j][nt] = *(const bf16x8*)(wfu + (size_t)(nt * 64 + j) * 1024 + wlo);
#define OL_STEP(KS, J, REFILL) do { const int ks = (KS); const bf16x8 af = *(LAS const bf16x8*)(lds + aoffT + ks * 1024); \
        _Pragma("unroll") for (int nt = 0; nt < 4; ++nt) acc[nt] = __builtin_amdgcn_mfma_f32_32x32x16_bf16(af, ring[J][nt], acc[nt], 0, 0, 0); \
        if (REFILL) { _Pragma("unroll") for (int nt = 0; nt < 4; ++nt) ring[J][nt] = *(const bf16x8*)(wfu + (size_t)(nt * 64 + ks + 4) * 1024 + wlo); } \
        __builtin_amdgcn_sched_barrier(0); } while (0)
#pragma unroll 1
      for (int ks0 = 0; ks0 < 60; ks0 += 4) { OL_STEP(ks0 + 0, 0, true); OL_STEP(ks0 + 1, 1, true); OL_STEP(ks0 + 2, 2, true); OL_STEP(ks0 + 3, 3, true); }
      OL_STEP(60, 0, false); OL_STEP(61, 1, false); OL_STEP(62, 2, false); OL_STEP(63, 3, false);
#undef OL_STEP
    } else {
#pragma unroll 4
      for (int ks = 0; ks < 64; ++ks) {
        bf16x8 af;
        if (CHM) {
          const v4i16_t lo = vtr(lds + aoffC + ks * 1024), hi = vtr(lds + aoffC + ks * 1024 + 256);
          af = (bf16x8){lo[0], lo[1], lo[2], lo[3], hi[0], hi[1], hi[2], hi[3]};
        } else {
          af = *(LAS const bf16x8*)(lds + aoffT + ks * 1024);
        }
  #pragma unroll
        for (int nt = 0; nt < 4; ++nt) {
          const bf16x8 bfr = *(const bf16x8*)(wf + ((size_t)(nt * 64 + ks) * 64) * 8);
          acc[nt] = __builtin_amdgcn_mfma_f32_32x32x16_bf16(af, bfr, acc[nt], 0, 0, 0);
        }
      }
    }
    __syncthreads();
#pragma unroll
    for (int nt = 0; nt < 4; ++nt)
#pragma unroll
      for (int i = 0; i < 16; ++i) {
        const int row = (i & 3) + 8 * (i >> 2) + 4 * h;
        *(LAS float*)(lds + (row * 1028 + (wave * 4 + nt) * 32 + (lane & 31)) * 4) = acc[nt][i];
      }
    __syncthreads();
    int l_, L_, cond, m0_; tokinfo(t0, l_, L_, cond, m0_);
    const float* gate = MODS + (size_t)(layer * 3 + cond) * 3072 + 2048;
    f32x4 v[4][4]; float red[8];
#pragma unroll
    for (int i = 0; i < 4; ++i) {
      const int row = wave * 4 + i, m = t0 + row;
      float s = 0.f, ss = 0.f;
#pragma unroll
      for (int q = 0; q < 4; ++q) {
        const int k = 4 * lane + 256 * q;
        const f32x4 o = *(LAS const f32x4*)(lds + (row * 1028 + k) * 4);
        const f32x4 x = xres_load(p, layer, ws, m, k); const f32x4 g = *(const f32x4*)(gate + k);
        const f32x4 vv = ALPHA * x + g * o; v[i][q] = vv;
        s += (vv.x + vv.y) + (vv.z + vv.w); ss += (vv.x * vv.x + vv.y * vv.y) + (vv.z * vv.z + vv.w * vv.w);
      }
      red[2 * i] = s; red[2 * i + 1] = ss;
    }
    wsum_n<8>(red);
    const float* nmod = MODS + (size_t)((layer + 1) * 3 + cond) * 3072;
#pragma unroll
    for (int q = 0; q < 4; ++q) {
      const int k = 4 * lane + 256 * q;
      const f32x4 lg = *(const f32x4*)(p.ln_g + layer * D + k), lb = *(const f32x4*)(p.ln_b + layer * D + k);
      f32x4 sh = (f32x4){0.f, 0.f, 0.f, 0.f}, sc = sh;
      if (layer < 3) { sh = *(const f32x4*)(nmod + k); sc = *(const f32x4*)(nmod + 1024 + k); }
#pragma unroll
      for (int i = 0; i < 4; ++i) {
        const int m = t0 + wave * 4 + i;
        const float mu = red[2 * i] * (1.f / D);
        const float rs = rsqrtf(fmaxf(red[2 * i + 1] * (1.f / D) - mu * mu, 0.f) + LN_EPS);
        const f32x4 y = (v[i][q] - mu) * rs * lg + lb;
        xres_store(p, layer, ws, m, k, y);
        if (layer < 3) {
          bf16_t* HB = (bf16_t*)(ws + M_HB) + (size_t)m * D;
          u32x2 o; o.x = pk2_(y.x * (1.f + sc.x) + sh.x, y.y * (1.f + sc.y) + sh.y); o.y = pk2_(y.z * (1.f + sc.z) + sh.z, y.w * (1.f + sc.w) + sh.w);
          *(u32x2*)(HB + k) = o;
        }
      }
    }
  }
}

constexpr size_t OP_FLAGS = 49152;
template <int MODE>
__device__ __forceinline__ void phase_out_ln_pair(const LAS PG& p, unsigned char* ws, LAS unsigned char* lds, int layer, const bf16_t* Wf, int tid, int lane, int wave, int bid) {
  const bf16_t* GA = (const bf16_t*)(ws + M_GB);
  const float* MODS = (const float*)(ws + M_MODS);
  const int h = lane >> 5;
  const int pair = (bid & 7) | ((bid >> 4) << 3), half = (bid >> 3) & 1;
  const int t0 = pair * 64;
  constexpr bool CHM = (MODE == 1);
  __syncthreads();
  PRB_S(31) PRB_S(30)
#pragma unroll
  for (int i = 0; i < 16; ++i) {
    const int idx = tid + 512 * i;
    if (CHM) { const int c = idx >> 3, part = idx & 7; *(LAS u32x4*)(lds + c * 128 + ((part * 16) ^ (((c >> 1) & 1) << 6))) = *(const u32x4*)(GA + (size_t)c * 8192 + t0 + 8 * part); }
    else { const int tok = idx >> 7, k8 = idx & 127; *(LAS u32x4*)(lds + (k8 * 64 + (tok ^ (k8 & 31))) * 16) = *(const u32x4*)(GA + (size_t)(t0 + tok) * D + 8 * k8); }
  }
  __syncthreads();
  PRB_E(31); PRB_S(32)
  f32x16 acc[2][2];
#pragma unroll
  for (int mt = 0; mt < 2; ++mt)
#pragma unroll
    for (int nt = 0; nt < 2; ++nt)
#pragma unroll
      for (int i = 0; i < 16; ++i) acc[mt][nt][i] = 0.f;
  const bf16_t* wf = Wf + ((size_t)((half * 16 + wave * 2) * 64) * 64 + lane) * 8;
  const int aoffT = h * 1024;
  const int aoffC = (8 * h + ((lane & 15) >> 2)) * 128 + ((32 * ((lane >> 4) & 1) + 8 * (lane & 3)) ^ ((((lane & 15) >> 3) & 1) << 6));
  bf16x8 ring[8][2];
#pragma unroll
  for (int j = 0; j < 8; ++j) { ring[j][0] = *(const bf16x8*)(wf + ((size_t)(0 * 64 + j) * 64) * 8); ring[j][1] = *(const bf16x8*)(wf + ((size_t)(1 * 64 + j) * 64) * 8); }
#define OP_STEP(KS, J, REFILL) do { const int ks = (KS); bf16x8 af[2]; \
    _Pragma("unroll") for (int mt = 0; mt < 2; ++mt) { \
      if (CHM) { const v4i16_t lo = vtr(lds + (aoffC ^ (mt * 64)) + ks * 2048), hi = vtr(lds + (aoffC ^ (mt * 64)) + ks * 2048 + 512); \
        af[mt] = (bf16x8){lo[0], lo[1], lo[2], lo[3], hi[0], hi[1], hi[2], hi[3]}; } \
      else af[mt] = *(LAS const bf16x8*)(lds + aoffT + mt * 512 + ks * 2048 + (((lane & 31) ^ ((2 * ks + h) & 31)) << 4)); } \
    const bf16x8 b0_ = ring[J][0], b1_ = ring[J][1]; \
    acc[0][0] = __builtin_amdgcn_mfma_f32_32x32x16_bf16(af[0], b0_, acc[0][0], 0, 0, 0); acc[1][0] = __builtin_amdgcn_mfma_f32_32x32x16_bf16(af[1], b0_, acc[1][0], 0, 0, 0); \
    acc[0][1] = __builtin_amdgcn_mfma_f32_32x32x16_bf16(af[0], b1_, acc[0][1], 0, 0, 0); acc[1][1] = __builtin_amdgcn_mfma_f32_32x32x16_bf16(af[1], b1_, acc[1][1], 0, 0, 0); \
    if (REFILL) { ring[J][0] = *(const bf16x8*)(wf + ((size_t)(0 * 64 + ks + 8) * 64) * 8); ring[J][1] = *(const bf16x8*)(wf + ((size_t)(1 * 64 + ks + 8) * 64) * 8); } \
    __builtin_amdgcn_sched_barrier(0); } while (0)
#pragma unroll 1
  for (int ks0 = 0; ks0 < 56; ks0 += 8) {
    OP_STEP(ks0 + 0, 0, true); OP_STEP(ks0 + 1, 1, true); OP_STEP(ks0 + 2, 2, true); OP_STEP(ks0 + 3, 3, true);
    OP_STEP(ks0 + 4, 4, true); OP_STEP(ks0 + 5, 5, true); OP_STEP(ks0 + 6, 6, true); OP_STEP(ks0 + 7, 7, true);
  }
  OP_STEP(56, 0, false); OP_STEP(57, 1, false); OP_STEP(58, 2, false); OP_STEP(59, 3, false);
  OP_STEP(60, 4, false); OP_STEP(61, 5, false); OP_STEP(62, 6, false); OP_STEP(63, 7, false);
#undef OP_STEP
  PRB_E(32); PRB_S(33)
  __syncthreads();
#pragma unroll
  for (int mt = 0; mt < 2; ++mt)
#pragma unroll
    for (int nt = 0; nt < 2; ++nt)
#pragma unroll
      for (int i = 0; i < 16; ++i) {
        const int row = mt * 32 + (i & 3) + 8 * (i >> 2) + 4 * h;
        *(LAS float*)(lds + (row * 516 + wave * 64 + nt * 32 + (lane & 31)) * 4) = acc[mt][nt][i];
      }
  __syncthreads();
  float* stat = (float*)(ws + M_MODP) + ((size_t)(layer * 128 + pair) * 2) * 128;
  f32x4 v[8][2];
  float red[16];
  int l_, L_, cond, m0_; tokinfo(t0, l_, L_, cond, m0_);
  const float* gate = MODS + (size_t)(layer * 3 + cond) * 3072 + 2048 + half * 512;
  const f32x4 gq[2] = {*(const f32x4*)(gate + 4 * lane), *(const f32x4*)(gate + 4 * lane + 256)};
#pragma unroll
  for (int i = 0; i < 8; ++i) {
    const int row = wave * 8 + i, m = t0 + row;
    float s = 0.f, ss = 0.f;
#pragma unroll
    for (int q = 0; q < 2; ++q) {
      const int k = 4 * lane + 256 * q;
      const f32x4 o = *(LAS const f32x4*)(lds + (row * 516 + k) * 4);
      const f32x4 x = xres_load(p, layer, ws, m, half * 512 + k); const f32x4 g = gq[q];
      const f32x4 vv = ALPHA * x + g * o; v[i][q] = vv;
      s += (vv.x + vv.y) + (vv.z + vv.w); ss += (vv.x * vv.x + vv.y * vv.y) + (vv.z * vv.z + vv.w * vv.w);
    }
    red[2 * i] = s; red[2 * i + 1] = ss;
  }
  wsum_n<16>(red);
  if (lane < 16) {
    float mine = red[0];
#pragma unroll
    for (int j = 1; j < 16; ++j) mine = (lane == j) ? red[j] : mine;
    __hip_atomic_store(stat + (half * 64 + wave * 8) * 2 + lane, mine, __ATOMIC_RELAXED, __HIP_MEMORY_SCOPE_AGENT);
  }
  PRB_E(33); PRB_S(34)
  unsigned* flg = (unsigned*)(ws + M_CTL + OP_FLAGS) + (layer * 128 + pair) * 2;
  asm volatile("s_waitcnt vmcnt(0)" ::: "memory");
  __syncthreads();
  if (tid == 0) {
    __hip_atomic_store(flg + half, 1u, __ATOMIC_RELAXED, __HIP_MEMORY_SCOPE_AGENT);
    unsigned sp = 0; while (__hip_atomic_load(flg + (half ^ 1), __ATOMIC_RELAXED, __HIP_MEMORY_SCOPE_AGENT) == 0u) { __builtin_amdgcn_s_sleep(1); if (++sp > (1u << 24)) break; }
  }
  __syncthreads();
  PRB_E(34); PRB_S(35)
  float os = 0.f, oss = 0.f;
  if (lane < 8) { const float* so = stat + ((half ^ 1) * 64 + wave * 8 + lane) * 2; os = __hip_atomic_load(so, __ATOMIC_RELAXED, __HIP_MEMORY_SCOPE_AGENT); oss = __hip_atomic_load(so + 1, __ATOMIC_RELAXED, __HIP_MEMORY_SCOPE_AGENT); }
  float ms = 0.f, mss = 0.f;
  if (lane < 8) { const float* sm = stat + (half * 64 + wave * 8 + lane) * 2; ms = __hip_atomic_load(sm, __ATOMIC_RELAXED, __HIP_MEMORY_SCOPE_AGENT); mss = __hip_atomic_load(sm + 1, __ATOMIC_RELAXED, __HIP_MEMORY_SCOPE_AGENT); }
  const float tsum = ms + os, tsq = mss + oss;
  const float* nmod = MODS + (size_t)((layer + 1) * 3 + cond) * 3072 + half * 512;
  f32x4 lgq[2], lbq[2], shq[2], scq[2];
#pragma unroll
  for (int q = 0; q < 2; ++q) {
    const int k = 4 * lane + 256 * q;
    lgq[q] = *(const f32x4*)(p.ln_g + layer * D + half * 512 + k); lbq[q] = *(const f32x4*)(p.ln_b + layer * D + half * 512 + k);
    shq[q] = (f32x4){0.f, 0.f, 0.f, 0.f}; scq[q] = shq[q];
    if (layer < 3) { shq[q] = *(const f32x4*)(nmod + k); scq[q] = *(const f32x4*)(nmod + 1024 + k); }
  }
#pragma unroll
  for (int i = 0; i < 8; ++i) {
    const int row = wave * 8 + i, m = t0 + row;
    const float S = rdlane(tsum, i), SS = rdlane(tsq, i);
    const float mu = S * (1.f / D);
    const float rs = rsqrtf(fmaxf(SS * (1.f / D) - mu * mu, 0.f) + LN_EPS);
    bf16_t* HB = (bf16_t*)(ws + M_HB) + (size_t)m * D + half * 512;
#pragma unroll
    for (int q = 0; q < 2; ++q) {
      const int k = 4 * lane + 256 * q;
      const f32x4 lg = lgq[q], lb = lbq[q];
      const f32x4 y = (v[i][q] - mu) * rs * lg + lb;
      xres_store(p, layer, ws, m, half * 512 + k, y);
      if (layer < 3) {
        const f32x4 sh = shq[q], sc = scq[q];
        u32x2 o; o.x = pk2_(y.x * (1.f + sc.x) + sh.x, y.y * (1.f + sc.y) + sh.y); o.y = pk2_(y.z * (1.f + sc.z) + sh.z, y.w * (1.f + sc.w) + sh.w);
        *(u32x2*)(HB + k) = o;
      }
    }
  }
  PRB_E(35); PRB_E(30);
}
__device__ __forceinline__ int kvrow_(int m) { if (m < NPT) return m; const int mm = m - NPT; return NPT + (mm >> 11) * 2560 + PAST + (mm & 2047); }

__device__ __forceinline__ float silu_f(float x) { return x * __builtin_amdgcn_rcpf(1.f + __expf(-x)); }
struct EpiSilu {
  static constexpr bool PERM = true, AFTER_DRAIN = false;
  bf16_t* O; int ldc;
  __device__ __forceinline__ void operator()(const f32x4 (&acc)[2][2][4][2], const pg8::Unit& u, int wr, int wc, int fr, int fq) const {
    const int row0 = u.pm * 256 + wr * 64 + fr, col0 = u.pn * 256 + wc * 32 + 8 * fq;
#pragma unroll
    for (int ai = 0; ai < 2; ++ai)
#pragma unroll
      for (int m = 0; m < 4; ++m) {
        bf16_t* rowp = O + (size_t)(row0 + ai * 128 + m * 16) * ldc + col0;
#pragma unroll
        for (int bj = 0; bj < 2; ++bj) {
          const f32x4 v0 = acc[ai][bj][m][0], v1 = acc[ai][bj][m][1];
          u32x4 w; w.x = pk2_(silu_f(v0[0]), silu_f(v0[1])); w.y = pk2_(silu_f(v0[2]), silu_f(v0[3])); w.z = pk2_(silu_f(v1[0]), silu_f(v1[1])); w.w = pk2_(silu_f(v1[2]), silu_f(v1[3]));
          *(u32x4*)(rowp + bj * 128) = w;
        }
      }
  }
};
struct EpiF32 {
  static constexpr bool PERM = true, AFTER_DRAIN = false;
  float* O; int ldc;
  __device__ __forceinline__ void operator()(const f32x4 (&acc)[2][2][4][2], const pg8::Unit& u, int wr, int wc, int fr, int fq) const {
    const int row0 = u.pm * 256 + wr * 64 + fr, col0 = u.pn * 256 + wc * 32 + 8 * fq;
#pragma unroll
    for (int ai = 0; ai < 2; ++ai)
#pragma unroll
      for (int m = 0; m < 4; ++m) {
        float* rowp = O + (size_t)(row0 + ai * 128 + m * 16) * ldc + col0;
#pragma unroll
        for (int bj = 0; bj < 2; ++bj) { *(f32x4*)(rowp + bj * 128) = acc[ai][bj][m][0]; *(f32x4*)(rowp + bj * 128 + 4) = acc[ai][bj][m][1]; }
      }
  }
};
struct EpiKV {
  static constexpr bool PERM = true, AFTER_DRAIN = false;
  bf16_t* Kn; bf16_t* V;
  __device__ __forceinline__ void operator()(const f32x4 (&acc)[2][2][4][2], const pg8::Unit& u, int wr, int wc, int fr, int fq) const {
    const int row0 = u.pm * 256 + wr * 64 + fr;
    const int d = wc * 32 + 8 * fq;
    bf16_t* base = (d < 64 ? Kn : V) + (d & 63);
#pragma unroll
    for (int ai = 0; ai < 2; ++ai)
#pragma unroll
      for (int m = 0; m < 4; ++m) {
        const size_t row = (size_t)(row0 + ai * 128 + m * 16);
#pragma unroll
        for (int bj = 0; bj < 2; ++bj) {
          const int h = u.pn * 2 + bj;
          const f32x4 v0 = acc[ai][bj][m][0], v1 = acc[ai][bj][m][1];
          u32x4 w; w.x = pg8::cvt_pk_bf16(v0[0], v0[1]); w.y = pg8::cvt_pk_bf16(v0[2], v0[3]); w.z = pg8::cvt_pk_bf16(v1[0], v1[1]); w.w = pg8::cvt_pk_bf16(v1[2], v1[3]);
          *(u32x4*)(base + row * 1024 + h * 64) = w;
        }
      }
  }
};

__device__ __forceinline__ void phase_mla_rows(const LAS PG& p, unsigned char* ws, int lane, int wave, int bid, int G) {
  const float* U2S = (const float*)(ws + M_U2S);
  for (int m = bid * 8 + wave; m < NTOK; m += G * 8) {
    int l, L, cond, m0; tokinfo(m, l, L, cond, m0);
    const float* rb = U2S + (size_t)m * 512;
    const f32x4 q = *(const f32x4*)(rb + 4 * lane);
    const float k0 = rb[256 + 2 * lane], k1 = rb[256 + 2 * lane + 1];
    float red[2] = {q.x * q.x + q.y * q.y + q.z * q.z + q.w * q.w, k0 * k0 + k1 * k1};
    wsum_n<2>(red);
    const float rs = rsqrtf(red[0] * (1.f / 256.f) + RMS_EPS);
    const f32x4 g = *(const GAS f32x4*)(p.mla_q_norm + 4 * lane);
    u32x2 qo; qo.x = pk2_(q.x * rs * g.x, q.y * rs * g.y); qo.y = pk2_(q.z * rs * g.z, q.w * rs * g.w);
    *(u32x2*)((bf16_t*)(ws + M_QN) + (size_t)m * 256 + 4 * lane) = qo;
    const float rs2 = rsqrtf(red[1] * (1.f / 128.f) + RMS_EPS);
    const float c0 = k0 * rs2 * p.mla_kv_norm[2 * lane], c1 = k1 * rs2 * p.mla_kv_norm[2 * lane + 1];
    const int kr = kvrow_(m);
    *(unsigned*)((bf16_t*)(ws + M_CKVALL) + (size_t)kr * 128 + 2 * lane) = pk2_(c0, c1);
    if (m < NPT) { p.out[OUT_CKV + (size_t)m * 128 + 2 * lane] = c0; p.out[OUT_CKV + (size_t)m * 128 + 2 * lane + 1] = c1; }
    const float x = rb[384 + (lane & 31)];
    const float partner = __shfl_xor(x, 8);
    float o = x;
    if (m >= NPT) {
      const int d = lane & 31, jj = d & 7;
      const float inv = exp2f(-(float)(2 * jj) * (13.287712379549449f / 16.f));
      const float pos = (d < 16) ? (float)(l >> 6) : (float)(l & 63);
      const float rev = pos * inv * 0.15915494309189535f; const float fr = rev - floorf(rev);
      const float cs = __builtin_amdgcn_cosf(fr), sn = __builtin_amdgcn_sinf(fr);
      o = (d & 8) ? x * cs + partner * sn : x * cs - partner * sn;
    }
    if (lane < 32) {
      ((bf16_t*)(ws + M_KPEB))[(size_t)kr * 32 + lane] = (bf16_t)f2bf_(o);
      if (m < NPT) p.out[OUT_KPE + (size_t)m * 32 + lane] = x;
    }
  }
}

constexpr int AT_KB = 12288, AT_VB = 8192, AT_BUF = AT_KB + AT_VB, AT_WS = 2 * AT_BUF, AT_ST = AT_WS + 8 * 256;
__device__ __forceinline__ int crow_(int r, int hi) { return (r & 3) + 8 * (r >> 2) + 4 * hi; }
__device__ __forceinline__ unsigned cvtpk(float lo, float hi) { return pk2_(lo, hi); }

__device__ __forceinline__ void attn_unit(const unsigned char* ws, LAS unsigned char* lds, int seq, int hd, int qb, bf16_t* Gout, int tid, int lane, int wave) {
  const bf16_t* Q = (const bf16_t*)(ws + M_Q); const bf16_t* Kn = (const bf16_t*)(ws + M_KN); const bf16_t* Vv = (const bf16_t*)(ws + M_V);
  const bf16_t* KP = (const bf16_t*)(ws + M_KPEB); const bf16_t* SZ = (const bf16_t*)(ws + M_SZB);
  const int r32 = lane & 31, hi = lane >> 5;
  const bool smp = seq >= 16;
  const int mq0 = smp ? NPT + (seq - 16) * 2048 + qb * 256 : seq * 256;
  const int kbase = smp ? NPT + (seq - 16) * 2560 : seq * 256;
  const int NT = smp ? 40 : 4;
  const float C2 = 0.10206207261596575f * 1.4426950408889634f;
  bf16x8 qr[6];
  {
    const int m = mq0 + wave * 32 + r32;
    const bf16_t* qp = Q + (size_t)m * 1536 + hd * 96;
    const int l = smp ? ((m - NPT) & 2047) : 0;
#pragma unroll
    for (int d0 = 0; d0 < 6; ++d0) {
      const u32x4 own = *(const u32x4*)(qp + 16 * d0 + 8 * hi);
      float f[8];
#pragma unroll
      for (int e = 0; e < 4; ++e) { f[2 * e] = bf2f(own[e] & 0xffffu); f[2 * e + 1] = bf2f(own[e] >> 16); }
      if (d0 >= 4 && smp) {
        const u32x4 oth = *(const u32x4*)(qp + 16 * d0 + 8 * (1 - hi));
        const float pos = (d0 == 4) ? (float)(l >> 6) : (float)(l & 63);
#pragma unroll
        for (int e = 0; e < 8; ++e) {
          const float pf = bf2f((e & 1) ? (oth[e >> 1] >> 16) : (oth[e >> 1] & 0xffffu));
          const float inv = exp2f(-(float)(2 * e) * (13.287712379549449f / 16.f));
          const float rev = pos * inv * 0.15915494309189535f; const float fr = rev - floorf(rev);
          const float cs = __builtin_amdgcn_cosf(fr), sn = __builtin_amdgcn_sinf(fr);
          f[e] = hi ? f[e] * cs + pf * sn : f[e] * cs - pf * sn;
        }
      }
      u32x4 o; o.x = pk2_(f[0] * C2, f[1] * C2); o.y = pk2_(f[2] * C2, f[3] * C2); o.z = pk2_(f[4] * C2, f[5] * C2); o.w = pk2_(f[6] * C2, f[7] * C2);
      qr[d0] = __builtin_bit_cast(bf16x8, o);
    }
  }
  const bf16_t* vsrc = Vv + (size_t)(kbase + 16 * (wave & 3) + (lane >> 2)) * 1024 + hd * 64 + (wave >> 2) * 32 + (lane & 3) * 8;
  const int kc0 = tid >> 6, key0 = tid & 63;
  const bf16_t* ksrc0 = Kn + (size_t)(kbase + key0) * 1024 + hd * 64 + 8 * kc0;
  const bool k2 = tid < 256;
  const bf16_t* ksrc1 = KP + (size_t)(kbase + key0) * 32 + 8 * (tid >> 6);
  u32x4 rv, rk0, rk1 = (u32x4){0u, 0u, 0u, 0u};
#define AT_LOAD(t) do { rv = *(const u32x4*)(vsrc + (size_t)(t) * 64 * 1024); rk0 = *(const u32x4*)(ksrc0 + (size_t)(t) * 64 * 1024); if (k2) rk1 = *(const u32x4*)(ksrc1 + (size_t)(t) * 64 * 32); } while (0)
#define AT_STORE(b) do { LAS unsigned char* bb = lds + (b) * AT_BUF; *(LAS u32x4*)(bb + tid * 16) = rk0; if (k2) *(LAS u32x4*)(bb + 8192 + tid * 16) = rk1; *(LAS u32x4*)(bb + AT_KB + tid * 16) = rv; } while (0)
  __syncthreads();
  AT_LOAD(0); AT_STORE(0);
  __syncthreads();
  LAS float* wsf = (LAS float*)(lds + AT_WS + wave * 256);
  f32x16 o0, o1;
#pragma unroll
  for (int i = 0; i < 16; ++i) { o0[i] = 0.f; o1[i] = 0.f; }
  float mref = 0.f, lrun = 0.f;
  f32x16 negm;
#pragma unroll
  for (int i = 0; i < 16; ++i) negm[i] = 0.f;
  const int vboff = ((lane >> 4) & 1) * 32 + (lane & 3) * 8 + (4 * hi + ((lane & 15) >> 2)) * 64;
  for (int t = 0; t < NT; ++t) {
    const int cur = t & 1;
    if (t + 1 < NT) AT_LOAD(t + 1);
    LAS const unsigned char* kb = lds + cur * AT_BUF + hi * 1024 + r32 * 16;
    f32x16 p0 = negm, p1 = negm;
    {
      bf16x8 ka[6], kc[6];
#pragma unroll
      for (int d0 = 0; d0 < 6; ++d0) { ka[d0] = *(LAS const bf16x8*)(kb + d0 * 2048); kc[d0] = *(LAS const bf16x8*)(kb + d0 * 2048 + 512); }
      __builtin_amdgcn_sched_barrier(0);
#pragma unroll
      for (int d0 = 0; d0 < 6; ++d0) {
        p0 = __builtin_amdgcn_mfma_f32_32x32x16_bf16(ka[d0], qr[d0], p0, 0, 0, 0);
        p1 = __builtin_amdgcn_mfma_f32_32x32x16_bf16(kc[d0], qr[d0], p1, 0, 0, 0);
      }
    }
    LAS const unsigned char* vb = lds + cur * AT_BUF + AT_KB + vboff;
    v4i16_t vf[16];
#pragma unroll
    for (int j = 0; j < 16; ++j) vf[j] = vtr(vb + (j >> 3) * 4096 + ((j >> 1) & 3) * 1024 + (j & 1) * 512);
    __builtin_amdgcn_sched_barrier(0);
    float rm = fmaxf(fmaxf(p0[0], p0[1]), fmaxf(p1[0], p1[1]));
#pragma unroll
    for (int i = 2; i < 16; i += 2) rm = fmaxf(rm, fmaxf(fmaxf(p0[i], p0[i + 1]), fmaxf(p1[i], p1[i + 1])));
    rm = fmaxf(rm, __shfl_xor(rm, 32));
    if (t == 0 || __any(rm > 8.f)) {
      const float dl = (t == 0) ? rm : fmaxf(rm, 0.f);
      mref += dl;
      const float alpha = __builtin_amdgcn_exp2f(-dl);
      lrun *= alpha;
#pragma unroll
      for (int i = 0; i < 16; ++i) { p0[i] -= dl; p1[i] -= dl; negm[i] = -mref; }
      if (hi == 0) wsf[r32] = alpha;
      asm volatile("s_waitcnt lgkmcnt(0)" ::: "memory");
#pragma unroll
      for (int i = 0; i < 16; ++i) { const float al = wsf[crow_(i, hi)]; o0[i] *= al; o1[i] *= al; }
    }
    float ps0 = 0.f, ps1 = 0.f;
#pragma unroll
    for (int i = 0; i < 16; ++i) { p0[i] = __builtin_amdgcn_exp2f(p0[i]); p1[i] = __builtin_amdgcn_exp2f(p1[i]); ps0 += p0[i]; ps1 += p1[i]; }
    lrun += ps0 + ps1;
    u32x4 w0, w1, w2, w3;
    w0.x = cvtpk(p0[0], p0[1]); w0.y = cvtpk(p0[2], p0[3]); w0.z = cvtpk(p0[4], p0[5]); w0.w = cvtpk(p0[6], p0[7]);
    w1.x = cvtpk(p0[8], p0[9]); w1.y = cvtpk(p0[10], p0[11]); w1.z = cvtpk(p0[12], p0[13]); w1.w = cvtpk(p0[14], p0[15]);
    w2.x = cvtpk(p1[0], p1[1]); w2.y = cvtpk(p1[2], p1[3]); w2.z = cvtpk(p1[4], p1[5]); w2.w = cvtpk(p1[6], p1[7]);
    w3.x = cvtpk(p1[8], p1[9]); w3.y = cvtpk(p1[10], p1[11]); w3.z = cvtpk(p1[12], p1[13]); w3.w = cvtpk(p1[14], p1[15]);
    const bf16x8 pa0 = __builtin_bit_cast(bf16x8, w0), pa1 = __builtin_bit_cast(bf16x8, w1), pa2 = __builtin_bit_cast(bf16x8, w2), pa3 = __builtin_bit_cast(bf16x8, w3);
#define AT_PV(O_, D0) do { \
      O_ = __builtin_amdgcn_mfma_f32_32x32x16_bf16(pa0, ((bf16x8){vf[8 * (D0) + 0][0], vf[8 * (D0) + 0][1], vf[8 * (D0) + 0][2], vf[8 * (D0) + 0][3], vf[8 * (D0) + 1][0], vf[8 * (D0) + 1][1], vf[8 * (D0) + 1][2], vf[8 * (D0) + 1][3]}), O_, 0, 0, 0); \
      O_ = __builtin_amdgcn_mfma_f32_32x32x16_bf16(pa1, ((bf16x8){vf[8 * (D0) + 2][0], vf[8 * (D0) + 2][1], vf[8 * (D0) + 2][2], vf[8 * (D0) + 2][3], vf[8 * (D0) + 3][0], vf[8 * (D0) + 3][1], vf[8 * (D0) + 3][2], vf[8 * (D0) + 3][3]}), O_, 0, 0, 0); \
      O_ = __builtin_amdgcn_mfma_f32_32x32x16_bf16(pa2, ((bf16x8){vf[8 * (D0) + 4][0], vf[8 * (D0) + 4][1], vf[8 * (D0) + 4][2], vf[8 * (D0) + 4][3], vf[8 * (D0) + 5][0], vf[8 * (D0) + 5][1], vf[8 * (D0) + 5][2], vf[8 * (D0) + 5][3]}), O_, 0, 0, 0); \
      O_ = __builtin_amdgcn_mfma_f32_32x32x16_bf16(pa3, ((bf16x8){vf[8 * (D0) + 6][0], vf[8 * (D0) + 6][1], vf[8 * (D0) + 6][2], vf[8 * (D0) + 6][3], vf[8 * (D0) + 7][0], vf[8 * (D0) + 7][1], vf[8 * (D0) + 7][2], vf[8 * (D0) + 7][3]}), O_, 0, 0, 0); } while (0)
    AT_PV(o0, 0); AT_PV(o1, 1);
#undef AT_PV
    if (t + 1 < NT) AT_STORE(cur ^ 1);
    __syncthreads();
  }
#undef AT_LOAD
#undef AT_STORE
  lrun += __shfl_xor(lrun, 32);
  if (hi == 0) wsf[32 + r32] = 1.f / lrun;
  asm volatile("s_waitcnt lgkmcnt(0)" ::: "memory");
  LAS bf16_t* stg = (LAS bf16_t*)(lds + AT_ST + wave * 4096);
#pragma unroll
  for (int i = 0; i < 16; ++i) {
    const int orow = crow_(i, hi); const float rl = wsf[32 + orow];
    stg[orow * 64 + r32] = (bf16_t)f2bf_(o0[i] * rl);
    stg[orow * 64 + 32 + r32] = (bf16_t)f2bf_(o1[i] * rl);
  }
  asm volatile("s_waitcnt lgkmcnt(0)" ::: "memory");
#pragma unroll
  for (int i = 0; i < 4; ++i) {
    const int row = i * 8 + (lane >> 3), ch = lane & 7;
    const u32x4 ov = *(LAS const u32x4*)(stg + row * 64 + ch * 8);
    const size_t gi = (size_t)(mq0 + wave * 32 + row) * D + hd * 64 + ch * 8;
    const u32x4 zv = *(const u32x4*)(SZ + gi);
    u32x4 res;
#pragma unroll
    for (int e = 0; e < 4; ++e) res[e] = pk2_(bf2f(ov[e] & 0xffffu) * bf2f(zv[e] & 0xffffu), bf2f(ov[e] >> 16) * bf2f(zv[e] >> 16));
    *(u32x4*)(Gout + gi) = res;
  }
}
constexpr size_t M_XMIX = M_UT;
constexpr size_t M_YF = M_UT, M_YB = M_UT + 32 * MiB;
constexpr size_t M_RB = M_SCR2, M_KB = M_SCR2 + 16 * MiB, M_VB = M_SCR2 + 32 * MiB, M_SZR = M_SCR2 + 48 * MiB;
constexpr size_t M_HWA = M_GB;
constexpr size_t M_BON = M_GB + 8 * MiB;

__device__ __forceinline__ void phase_rw_mix(const LAS PG& p, unsigned char* ws, int tid, int bid, int G) {
  const bf16_t* HB = (const bf16_t*)(ws + M_HB);
  bf16_t* XM = (bf16_t*)(ws + M_XMIX);
  for (int i = bid * 512 + tid; i < NTOK * 128; i += G * 512) {
    const int m = i >> 7, k8 = i & 127;
    int l, L, cond, m0; tokinfo(m, l, L, cond, m0);
    const u32x4 hc = *(const u32x4*)(HB + (size_t)m * D + 8 * k8);
    u32x4 hp = (u32x4){0u, 0u, 0u, 0u}, hn = hp;
    if (l > 0) hp = *(const u32x4*)(HB + (size_t)(m - 1) * D + 8 * k8);
    if (l < L - 1) hn = *(const u32x4*)(HB + (size_t)(m + 1) * D + 8 * k8);
    float h[8], d[8];
#pragma unroll
    for (int e = 0; e < 4; ++e) {
      h[2 * e] = bf2f(hc[e] & 0xffffu); h[2 * e + 1] = bf2f(hc[e] >> 16);
      d[2 * e] = 0.5f * (bf2f(hp[e] & 0xffffu) + bf2f(hn[e] & 0xffffu)) - h[2 * e];
      d[2 * e + 1] = 0.5f * (bf2f(hp[e] >> 16) + bf2f(hn[e] >> 16)) - h[2 * e + 1];
    }
#pragma unroll
    for (int q = 0; q < 4; ++q) {
      const int mi = (q == 0) ? 0 : (q == 1) ? 2 : (q == 2) ? 3 : 5;
      const f32x4 u0 = *(const f32x4*)(p.rw_mu + mi * D + 8 * k8), u1 = *(const f32x4*)(p.rw_mu + mi * D + 8 * k8 + 4);
      u32x4 o; o.x = pk2_(h[0] + d[0] * u0.x, h[1] + d[1] * u0.y); o.y = pk2_(h[2] + d[2] * u0.z, h[3] + d[3] * u0.w);
      o.z = pk2_(h[4] + d[4] * u1.x, h[5] + d[5] * u1.y); o.w = pk2_(h[6] + d[6] * u1.z, h[7] + d[7] * u1.w);
      *(u32x4*)(XM + (size_t)q * NTOK * D + (size_t)m * D + 8 * k8) = o;
    }
  }
}

__device__ __forceinline__ void rw_lora_tile(const LAS PG& p, unsigned char* ws, LAS unsigned char* lds, int tile, int tid, int lane, int wave) {
  const bf16_t* HB = (const bf16_t*)(ws + M_HB);
  const bf16_t* Wf = (const bf16_t*)(ws + W_LORA1);
  const int h = lane >> 5, t0 = tile * 32;
  PRB_S(44)
  __syncthreads();
  PRB_E(44); PRB_S(41)
  f32x4 mu0[2], mu1[2];
#pragma unroll
  for (int q = 0; q < 2; ++q) { const int mi = q ? 4 : 1; mu0[q] = *(const f32x4*)(p.rw_mu + mi * D + 8 * (tid & 127)); mu1[q] = *(const f32x4*)(p.rw_mu + mi * D + 8 * (tid & 127) + 4); }
#pragma unroll
  for (int i = 0; i < 8; ++i) {
    const int idx = tid + 512 * i; const int tok = idx >> 7, k8 = idx & 127; const int m = t0 + tok;
    int l, L, cond, m0; tokinfo(m, l, L, cond, m0);
    const u32x4 hc = *(const u32x4*)(HB + (size_t)m * D + 8 * k8);
    u32x4 hp = (u32x4){0u, 0u, 0u, 0u}, hn = hp;
    if (l > 0) hp = *(const u32x4*)(HB + (size_t)(m - 1) * D + 8 * k8);
    if (l < L - 1) hn = *(const u32x4*)(HB + (size_t)(m + 1) * D + 8 * k8);
    float hh[8], d[8];
#pragma unroll
    for (int e = 0; e < 4; ++e) {
      hh[2 * e] = bf2f(hc[e] & 0xffffu); hh[2 * e + 1] = bf2f(hc[e] >> 16);
      d[2 * e] = 0.5f * (bf2f(hp[e] & 0xffffu) + bf2f(hn[e] & 0xffffu)) - hh[2 * e];
      d[2 * e + 1] = 0.5f * (bf2f(hp[e] >> 16) + bf2f(hn[e] >> 16)) - hh[2 * e + 1];
    }
#pragma unroll
    for (int q = 0; q < 2; ++q) {
      const f32x4 u0 = mu0[q], u1 = mu1[q];
      u32x4 o; o.x = pk2_(hh[0] + d[0] * u0.x, hh[1] + d[1] * u0.y); o.y = pk2_(hh[2] + d[2] * u0.z, hh[3] + d[3] * u0.w);
      o.z = pk2_(hh[4] + d[4] * u1.x, hh[5] + d[5] * u1.y); o.w = pk2_(hh[6] + d[6] * u1.z, hh[7] + d[7] * u1.w);
      *(LAS u32x4*)(lds + q * 65536 + (k8 * 32 + (tok ^ (k8 & 31))) * 16) = o;
    }
  }
  __syncthreads();
  PRB_E(41); PRB_S(42)
  f32x16 acc, acc2;
#pragma unroll
  for (int i = 0; i < 16; ++i) { acc[i] = 0.f; acc2[i] = 0.f; }
  const int aoff = (wave >> 2) * 65536 + h * 512;
  const bf16_t* wf = Wf + ((size_t)wave * 64 * 64 + lane) * 8;
  bf16x8 ring[16];
#pragma unroll
  for (int j = 0; j < 16; ++j) ring[j] = *(const bf16x8*)(wf + ((size_t)j * 64) * 8);
#define LT_STEP(KS, J, REFILL) do { const int ks = (KS); const bf16x8 af = *(LAS const bf16x8*)(lds + aoff + ks * 1024 + (((lane & 31) ^ ((2 * ks + h) & 31)) << 4)); \
    if ((J) & 1) acc2 = __builtin_amdgcn_mfma_f32_32x32x16_bf16(af, ring[J], acc2, 0, 0, 0); else acc = __builtin_amdgcn_mfma_f32_32x32x16_bf16(af, ring[J], acc, 0, 0, 0); \
    if (REFILL) ring[J] = *(const bf16x8*)(wf + ((size_t)(ks + 16) * 64) * 8); \
    __builtin_amdgcn_sched_barrier(0); } while (0)
#pragma unroll 1
  for (int ks0 = 0; ks0 < 48; ks0 += 16) {
    LT_STEP(ks0 + 0, 0, true); LT_STEP(ks0 + 1, 1, true); LT_STEP(ks0 + 2, 2, true); LT_STEP(ks0 + 3, 3, true); LT_STEP(ks0 + 4, 4, true); LT_STEP(ks0 + 5, 5, true); LT_STEP(ks0 + 6, 6, true); LT_STEP(ks0 + 7, 7, true);
    LT_STEP(ks0 + 8, 8, true); LT_STEP(ks0 + 9, 9, true); LT_STEP(ks0 + 10, 10, true); LT_STEP(ks0 + 11, 11, true); LT_STEP(ks0 + 12, 12, true); LT_STEP(ks0 + 13, 13, true); LT_STEP(ks0 + 14, 14, true); LT_STEP(ks0 + 15, 15, true);
  }
  LT_STEP(48, 0, false); LT_STEP(49, 1, false); LT_STEP(50, 2, false); LT_STEP(51, 3, false); LT_STEP(52, 4, false); LT_STEP(53, 5, false); LT_STEP(54, 6, false); LT_STEP(55, 7, false);
  LT_STEP(56, 8, false); LT_STEP(57, 9, false); LT_STEP(58, 10, false); LT_STEP(59, 11, false); LT_STEP(60, 12, false); LT_STEP(61, 13, false); LT_STEP(62, 14, false); LT_STEP(63, 15, false);
#undef LT_STEP
#pragma unroll
  for (int i = 0; i < 16; ++i) acc[i] += acc2[i];
  PRB_E(42); PRB_S(43)
  bf16_t* HWA = (bf16_t*)(ws + M_HWA);
#pragma unroll
  for (int i = 0; i < 16; ++i) {
    const int row = (i & 3) + 8 * (i >> 2) + 4 * h;
    const float v = (wave < 4) ? (1.f - 2.f * __builtin_amdgcn_rcpf(__expf(2.f * acc[i]) + 1.f)) : acc[i];
    HWA[(size_t)(t0 + row) * 256 + wave * 32 + (lane & 31)] = (bf16_t)f2bf_(v);
  }
  PRB_E(43);
}

#define DPP_ADD(v, CTRL) ((v) + __builtin_bit_cast(float, __builtin_amdgcn_mov_dpp(__builtin_bit_cast(int, (v)), (CTRL), 0xF, 0xF, true)))
__device__ __forceinline__ float allred4(float v) { v = DPP_ADD(v, 0xB1); v = DPP_ADD(v, 0x4E); return v; }
__device__ __forceinline__ float allred16(float v) { v = DPP_ADD(v, 0xB1); v = DPP_ADD(v, 0x4E); v = DPP_ADD(v, 0x141); v = DPP_ADD(v, 0x140); return v; }

__device__ __forceinline__ float fma_s(float a, float b, float c) { float d; asm("v_fma_f32 %0, %1, %2, %3" : "=v"(d) : "v"(a), "v"(b), "v"(c)); return d; }
__device__ __forceinline__ float mul_s(float a, float b) { float d; asm("v_mul_f32_e32 %0, %1, %2" : "=v"(d) : "v"(a), "v"(b)); return d; }
__device__ __forceinline__ float add_s(float a, float b) { float d; asm("v_add_f32_e32 %0, %1, %2" : "=v"(d) : "v"(a), "v"(b)); return d; }
#define DPPADD_(NAME, CTRL) __device__ __forceinline__ float NAME(float s) { float d; asm("s_nop 1\n\tv_add_f32_dpp %0, %1, %1 " CTRL " row_mask:0xf bank_mask:0xf bound_ctrl:1" : "=v"(d) : "v"(s)); return d; }
DPPADD_(dpp_x1, "quad_perm:[1,0,3,2]")
DPPADD_(dpp_x2, "quad_perm:[2,3,0,1]")
DPPADD_(dpp_hm, "row_half_mirror")
DPPADD_(dpp_rm, "row_mirror")
__device__ __forceinline__ float ar4(float v) { return dpp_x2(dpp_x1(v)); }
__device__ __forceinline__ float ar16(float v) { return dpp_rm(dpp_hm(dpp_x2(dpp_x1(v)))); }
__device__ __forceinline__ float dot4_s(const f32x4& s, const f32x4& a) { return add_s(fma_s(s.y, a.y, mul_s(s.x, a.x)), fma_s(s.w, a.w, mul_s(s.z, a.z))); }
__device__ __forceinline__ void upd4_s(f32x4& s, const f32x4& w, const f32x4& b, const f32x4& k, float sa, float vi) {
  s.x = fma_s(s.x, w.x, fma_s(sa, b.x, mul_s(vi, k.x))); s.y = fma_s(s.y, w.y, fma_s(sa, b.y, mul_s(vi, k.y)));
  s.z = fma_s(s.z, w.z, fma_s(sa, b.z, mul_s(vi, k.z))); s.w = fma_s(s.w, w.w, fma_s(sa, b.w, mul_s(vi, k.w)));
}
constexpr int PB_BYTES = 24832;
constexpr int SC_PS0 = 0, SC_PP0 = 2 * PB_BYTES;

constexpr int SC_FR = 4 * PB_BYTES;
__device__ __forceinline__ u32x4 ld_bfrag(const GASF* W2, int ks, int lane) {
  const int k0 = 32 * ks + 8 * (lane >> 4);
  u32x4 o; o.x = pk2_(W2[(size_t)(k0 + 0) * D], W2[(size_t)(k0 + 1) * D]); o.y = pk2_(W2[(size_t)(k0 + 2) * D], W2[(size_t)(k0 + 3) * D]);
  o.z = pk2_(W2[(size_t)(k0 + 4) * D], W2[(size_t)(k0 + 5) * D]); o.w = pk2_(W2[(size_t)(k0 + 6) * D], W2[(size_t)(k0 + 7) * D]);
  return o;
}
struct ChId { int dir, hd, m0, L, froff; };
__device__ __forceinline__ ChId chid(int slot, int seq, int dir, int hd, int lane, int ntile) {
  ChId c; c.dir = dir; c.hd = hd; c.L = seq < 16 ? 256 : 2048; c.m0 = seq < 16 ? seq * 256 : NPT + (seq - 16) * 2048;
  c.froff = SC_FR + ((slot * 4 + ntile) * 6) * 1024 + lane * 16; return c;
}
__device__ __forceinline__ void prepc_load(const LAS PG& p, LAS unsigned char* lds, int froff, int dir, int hd, int lane, int ntile) {
  const int ch = hd * 64 + 16 * ntile + (lane & 15);
  const GASF* W2 = p.rw_w2 + (size_t)dir * 64 * D + ch; const GASF* A2 = p.rw_a2 + (size_t)dir * 64 * D + ch;
  *(LAS u32x4*)(lds + froff) = ld_bfrag(W2, 0, lane); __builtin_amdgcn_sched_barrier(0);
  *(LAS u32x4*)(lds + froff + 1024) = ld_bfrag(W2, 1, lane); __builtin_amdgcn_sched_barrier(0);
  *(LAS u32x4*)(lds + froff + 2048) = ld_bfrag(A2, 0, lane); __builtin_amdgcn_sched_barrier(0);
  *(LAS u32x4*)(lds + froff + 3072) = ld_bfrag(A2, 1, lane); __builtin_amdgcn_sched_barrier(0);
  LAS float* cn = (LAS float*)(lds + (froff - lane * 16) + 4096) + lane;
  cn[0] = p.rw_w0[dir * D + ch]; cn[64] = p.rw_a0[dir * D + ch]; cn[128] = p.rw_k_k[ch]; cn[192] = p.rw_k_a[ch]; cn[256] = p.rw_r_k[ch];
}
struct PrepIn { u32x4 hw[2], ha[2]; unsigned kr[4], rr[4], vr[4]; };
__device__ __forceinline__ int ctok(int m0, int L, int dir, int step) { return m0 + (dir ? (L - 1 - step) : step); }
__device__ __forceinline__ void prep_fetch(const unsigned char* ws, int c_m0, int c_L, int c_dir, int c_hd, int s0, int lane, int ntile, PrepIn& in) {
  const bf16_t* HWA = (const bf16_t*)(ws + M_HWA);
  const int m = ctok(c_m0, c_L, c_dir, s0 + (lane & 15));
  const bf16_t* src = HWA + (size_t)m * 256 + c_dir * 64 + 8 * (lane >> 4);
  in.hw[0] = *(const u32x4*)(src); in.hw[1] = *(const u32x4*)(src + 32);
  in.ha[0] = *(const u32x4*)(src + 128); in.ha[1] = *(const u32x4*)(src + 160);
#pragma unroll
  for (int r = 0; r < 4; ++r) {
    const int mt = ctok(c_m0, c_L, c_dir, s0 + 4 * (lane >> 4) + r);
    const size_t gi = (size_t)mt * D + c_hd * 64 + 16 * ntile + (lane & 15);
    in.kr[r] = ((const bf16_t*)(ws + M_KB))[gi]; in.rr[r] = ((const bf16_t*)(ws + M_RB))[gi]; in.vr[r] = ((const bf16_t*)(ws + M_VB))[gi];
  }
}
__device__ __forceinline__ bf16x8 pack8(const f32x4& a, const f32x4& b) { u32x4 o; o.x = pk2_(a.x, a.y); o.y = pk2_(a.z, a.w); o.z = pk2_(b.x, b.y); o.w = pk2_(b.z, b.w); return __builtin_bit_cast(bf16x8, o); }
__device__ __forceinline__ void prep_finish(unsigned char* ws, LAS unsigned char* lds, int c_m0, int c_L, int c_dir, int c_hd, int c_froff, int s0, int pboff, int lane, int ntile, const PrepIn& in) {
  LAS const float* cn = (LAS const float*)(lds + (c_froff - lane * 16) + 4096) + lane;
  const float c_biasw = cn[0], c_biasa = cn[64], c_kkc = cn[128], c_kac = cn[192], c_rkc = cn[256];
  f32x4 aw = (f32x4){c_biasw, c_biasw, c_biasw, c_biasw}, aa = (f32x4){c_biasa, c_biasa, c_biasa, c_biasa};
  aw = __builtin_amdgcn_mfma_f32_16x16x32_bf16(__builtin_bit_cast(bf16x8, in.hw[0]), *(LAS const bf16x8*)(lds + c_froff), aw, 0, 0, 0);
  aw = __builtin_amdgcn_mfma_f32_16x16x32_bf16(__builtin_bit_cast(bf16x8, in.hw[1]), *(LAS const bf16x8*)(lds + c_froff + 1024), aw, 0, 0, 0);
  aa = __builtin_amdgcn_mfma_f32_16x16x32_bf16(__builtin_bit_cast(bf16x8, in.ha[0]), *(LAS const bf16x8*)(lds + c_froff + 2048), aa, 0, 0, 0);
  aa = __builtin_amdgcn_mfma_f32_16x16x32_bf16(__builtin_bit_cast(bf16x8, in.ha[1]), *(LAS const bf16x8*)(lds + c_froff + 3072), aa, 0, 0, 0);
  LAS float* pb = (LAS float*)(lds + pboff);
  const int col = lane & 15, rg = lane >> 4, chl = 16 * ntile + col;
#pragma unroll
  for (int r = 0; r < 4; ++r) {
    const int t = 4 * rg + r;
    const float sig = __builtin_amdgcn_rcpf(1.f + __expf(-aw[r]));
    const float dec = __expf(-0.6065306597126334f * sig);
    const float a = __builtin_amdgcn_rcpf(1.f + __expf(-aa[r]));
    const float k = bf2f(in.kr[r]), rv = bf2f(in.rr[r]), v = bf2f(in.vr[r]);
    const float kq = k * c_kkc;
    const float ssq = ar16(kq * kq);
    const float kd = k * (1.f + (a - 1.f) * c_kac);
    const float bon = ar16(rv * kd * c_rkc);
    pb[t * 64 + chl] = dec; pb[1024 + t * 64 + chl] = -kq; pb[2048 + t * 64 + chl] = kq * a; pb[3072 + t * 64 + chl] = kd; pb[4096 + t * 64 + chl] = rv; pb[5120 + t * 64 + chl] = v;
    if (col == 0) {
      pb[6144 + t * 4 + ntile] = ssq;
      const int mt = ctok(c_m0, c_L, c_dir, s0 + t);
      ((float*)(ws + M_BON))[(((size_t)c_dir * NTOK + mt) * 16 + c_hd) * 4 + ntile] = bon;
    }
  }
}

#define LDS_BARRIER() asm volatile("s_waitcnt lgkmcnt(0)\n\ts_barrier" ::: "memory")
__device__ __forceinline__ void phase_rw_scan(const LAS PG& p, unsigned char* ws, LAS unsigned char* lds, int tid, int lane, int wave, int bid, int G) {
  for (int item = bid; item < 256; item += G) {
    const int sc = item >> 2, qt = item & 3;
    const int s_seq = 16 + (sc >> 5), s_dir = (sc >> 4) & 1, s_hd = sc & 15, s_m0 = NPT + (s_seq - 16) * 2048;
    __syncthreads();
    if (wave < 4) {
      __builtin_amdgcn_s_setprio(2);
      float* Yo = (float*)(ws + (s_dir ? M_YB : M_YF));
      const int srow = 16 * qt + 4 * wave + (lane >> 4), scg = lane & 15;
      f32x4 Ss = *(const GAS f32x4*)(p.state_rwkv + ((((size_t)(s_seq - 16)) * 2 + s_dir) * 16 + s_hd) * 4096 + (size_t)srow * 64 + 4 * scg);
      __syncthreads();
      for (int c = 0; c < 128; ++c) {
        LAS const float* ps = (LAS const float*)(lds + SC_PS0 + (c & 1) * PB_BYTES);
        float rn2v;
        { const f32x4 q4 = *(LAS const f32x4*)(ps + 6144 + (lane & 15) * 4); rn2v = __builtin_amdgcn_rcpf((q4.x + q4.y) + (q4.z + q4.w) + 1e-12f); }
        float yk[16];
#pragma unroll
        for (int t = 0; t < 16; ++t) {
          const f32x4 w4 = *(LAS const f32x4*)(ps + t * 64 + 4 * scg), a4 = *(LAS const f32x4*)(ps + 1024 + t * 64 + 4 * scg);
          const f32x4 b4 = *(LAS const f32x4*)(ps + 2048 + t * 64 + 4 * scg), k4 = *(LAS const f32x4*)(ps + 3072 + t * 64 + 4 * scg);
          const f32x4 r4 = *(LAS const f32x4*)(ps + 4096 + t * 64 + 4 * scg);
          const float vi = ps[5120 + t * 64 + srow];
          const float rn2 = __builtin_bit_cast(float, __builtin_amdgcn_readlane(__builtin_bit_cast(int, rn2v), t));
          const float sa = ar16(dot4_s(Ss, a4)) * rn2;
          upd4_s(Ss, w4, b4, k4, sa, vi);
          yk[t] = ar16(dot4_s(Ss, r4));
        }
        if (scg == 0) {
          const int mfirst = ctok(s_m0, 2048, s_dir, 16 * c);
          float* yp = Yo + (size_t)mfirst * D + s_hd * 64 + srow;
          const long stride = s_dir ? -(long)D : (long)D;
#pragma unroll
          for (int t = 0; t < 16; ++t) yp[t * stride] = yk[t];
        }
        LDS_BARRIER();
      }
      __builtin_amdgcn_s_setprio(0);
    } else {
      const int nt = wave - 4;
      const int s_fr = SC_FR + ((0 * 4 + nt) * 6) * 1024 + lane * 16;
      prepc_load(p, lds, s_fr, s_dir, s_hd, lane, nt);
      int pc = 2 * item;
      const int q_fr = SC_FR + ((1 * 4 + nt) * 6) * 1024 + lane * 16;
      prepc_load(p, lds, q_fr, (pc >> 4) & 1, pc & 15, lane, nt);
      int r_seq = pc >> 5, r_dir = (pc >> 4) & 1, r_hd = pc & 15;
      int q_seq = pc >> 5, q_dir = (pc >> 4) & 1, q_hd = pc & 15;
      PrepIn in_s, in_p;
      prep_fetch(ws, s_m0, 2048, s_dir, s_hd, 0, lane, nt, in_s); prep_fetch(ws, r_seq * 256, 256, r_dir, r_hd, 0, lane, nt, in_p);
      prep_finish(ws, lds, s_m0, 2048, s_dir, s_hd, s_fr, 0, SC_PS0, lane, nt, in_s); prep_finish(ws, lds, r_seq * 256, 256, r_dir, r_hd, q_fr, 0, SC_PP0, lane, nt, in_p);
      const int prow = 16 * nt + (lane >> 2), pcq = lane & 3;
      f32x4 Sp0 = (f32x4){0.f, 0.f, 0.f, 0.f}, Sp1 = Sp0, Sp2 = Sp0, Sp3 = Sp0;
      __syncthreads();
      for (int c = 0; c < 128; ++c) {
        const bool more_s = (c + 1) < 128;
        const bool pgrp = ((c & 3) == 0) && (c + 4 < 128);
        if (more_s) prep_fetch(ws, s_m0, 2048, s_dir, s_hd, 16 * (c + 1), lane, nt, in_s);
        if (pgrp) {
          if (c == 60) { pc = 2 * item + 1; r_seq = pc >> 5; r_dir = (pc >> 4) & 1; r_hd = pc & 15; prepc_load(p, lds, q_fr, r_dir, r_hd, lane, nt); }
          prep_fetch(ws, r_seq * 256, 256, r_dir, r_hd, 4 * ((c + 4) & 63), lane, nt, in_p);
        }
        if (c == 64) { q_seq = r_seq; q_dir = r_dir; q_hd = r_hd; Sp0 = (f32x4){0.f, 0.f, 0.f, 0.f}; Sp1 = Sp0; Sp2 = Sp0; Sp3 = Sp0; }
        {
          LAS const float* pp = (LAS const float*)(lds + SC_PP0 + ((c >> 2) & 1) * PB_BYTES);
          float* Yp = (float*)(ws + (q_dir ? M_YB : M_YF));
          float rn2v;
          { const f32x4 q4 = *(LAS const f32x4*)(pp + 6144 + (lane & 15) * 4); rn2v = __builtin_amdgcn_rcpf((q4.x + q4.y) + (q4.z + q4.w) + 1e-12f); }
#pragma unroll 2
          for (int s = 0; s < 4; ++s) {
            const int t = 4 * (c & 3) + s;
            const float vi = pp[5120 + t * 64 + prow];
            const float rn2 = __builtin_bit_cast(float, __builtin_amdgcn_readlane(__builtin_bit_cast(int, rn2v), t));
            LAS const float* q = pp + t * 64 + 16 * pcq;
            const f32x4 a0 = *(LAS const f32x4*)(q + 1024), a1 = *(LAS const f32x4*)(q + 1028), a2 = *(LAS const f32x4*)(q + 1032), a3 = *(LAS const f32x4*)(q + 1036);
            const float sa = ar4(add_s(add_s(dot4_s(Sp0, a0), dot4_s(Sp1, a1)), add_s(dot4_s(Sp2, a2), dot4_s(Sp3, a3)))) * rn2;
            float y0, y1, y2, y3;
#define UP4(S_, O_, Y_) { const f32x4 w4 = *(LAS const f32x4*)(q + (O_)), b4 = *(LAS const f32x4*)(q + 2048 + (O_)), k4 = *(LAS const f32x4*)(q + 3072 + (O_)), r4 = *(LAS const f32x4*)(q + 4096 + (O_)); \
              upd4_s(S_, w4, b4, k4, sa, vi); Y_ = dot4_s(S_, r4); }
            UP4(Sp0, 0, y0) UP4(Sp1, 4, y1) UP4(Sp2, 8, y2) UP4(Sp3, 12, y3)
#undef UP4
            const float y = ar4(add_s(add_s(y0, y1), add_s(y2, y3)));
            if (pcq == 0) Yp[(size_t)ctok(q_seq * 256, 256, q_dir, 4 * (c & 63) + s) * D + q_hd * 64 + prow] = y;
          }
          if ((c & 63) == 63) {
            GASF* so = p.out + OUT_ST + ((((size_t)q_seq) * 2 + q_dir) * 16 + q_hd) * 4096 + (size_t)prow * 64 + 16 * pcq;
            *(GAS f32x4*)so = Sp0; *(GAS f32x4*)(so + 4) = Sp1; *(GAS f32x4*)(so + 8) = Sp2; *(GAS f32x4*)(so + 12) = Sp3;
          }
        }
        if (more_s) prep_finish(ws, lds, s_m0, 2048, s_dir, s_hd, s_fr, 16 * (c + 1), SC_PS0 + ((c + 1) & 1) * PB_BYTES, lane, nt, in_s);
        if (pgrp) prep_finish(ws, lds, r_seq * 256, 256, r_dir, r_hd, q_fr, 4 * ((c + 4) & 63), SC_PP0 + (((c >> 2) + 1) & 1) * PB_BYTES, lane, nt, in_p);
        LDS_BARRIER();
      }
    }
  }
}
constexpr int LDO = 68, OSZ = 32 * LDO * 2;
constexpr int O_B = OSZ, O_K = 2 * OSZ, O_R = 3 * OSZ, O_V = 4 * OSZ, O_W = 5 * OSZ;
constexpr int LDM = 36, MSZ = 32 * LDM * 2;
constexpr int CK_OPS = 5 * OSZ + 256;
constexpr int CK_MX = 3 * CK_OPS;
constexpr int CK_MXS = 4 * MSZ;
constexpr int CK_SCR = CK_MX + 2 * CK_MXS;
constexpr int CK_SSQ = CK_SCR + 3 * MSZ;
constexpr int CK_FR = CK_SSQ + 1024;
constexpr int CK_IN = CK_FR + 4 * 6144;
constexpr int CK_INS = 3 * OSZ + 32 * 272;
static_assert(CK_IN + 2 * CK_INS <= PTAB_OFF, "scan LDS map overflows");

__device__ __forceinline__ unsigned short bfr(float f) { return (unsigned short)f2bf_(f); }
__device__ __forceinline__ bf16x8 cvt8(const f32x16& a, int s) {
  u32x4 o; o.x = pk2_(a[8 * s + 0], a[8 * s + 1]); o.y = pk2_(a[8 * s + 2], a[8 * s + 3]); o.z = pk2_(a[8 * s + 4], a[8 * s + 5]); o.w = pk2_(a[8 * s + 6], a[8 * s + 7]);
  return __builtin_bit_cast(bf16x8, o);
}
__device__ __forceinline__ bf16x8 ldA_perm(LAS const unsigned char* base, int ld, int row, int k0, int hi) {
  const u32x2 lo = *(LAS const u32x2*)(base + (row * ld + k0 + 4 * hi) * 2), hh = *(LAS const u32x2*)(base + (row * ld + k0 + 8 + 4 * hi) * 2);
  u32x4 o; o.x = lo.x; o.y = lo.y; o.z = hh.x; o.w = hh.y; return __builtin_bit_cast(bf16x8, o);
}
__device__ __forceinline__ bf16x8 ldT_perm(LAS const unsigned char* base, int ld, int k0, int c0, int lane) {
  const int hi = lane >> 5;
  LAS const unsigned char* a = base + ((k0 + 4 * hi + ((lane & 15) >> 2)) * ld + c0 + 16 * ((lane >> 4) & 1) + 4 * (lane & 3)) * 2;
  const v4i16_t lo = vtr(a), hh = vtr(a + 8 * ld * 2);
  return (bf16x8){lo[0], lo[1], lo[2], lo[3], hh[0], hh[1], hh[2], hh[3]};
}
__device__ __forceinline__ bf16x8 ldT_nat(LAS const unsigned char* base, int ld, int k0, int c0, int lane) {
  const int hi = lane >> 5;
  LAS const unsigned char* a = base + ((k0 + 8 * hi + ((lane & 15) >> 2)) * ld + c0 + 16 * ((lane >> 4) & 1) + 4 * (lane & 3)) * 2;
  const v4i16_t lo = vtr(a), hh = vtr(a + 4 * ld * 2);
  return (bf16x8){lo[0], lo[1], lo[2], lo[3], hh[0], hh[1], hh[2], hh[3]};
}
__device__ __forceinline__ bf16x8 ld16_(LAS const unsigned char* a) {
  const u32x2 lo = *(LAS const u32x2*)a, hh = *(LAS const u32x2*)(a + 8); u32x4 o; o.x = lo.x; o.y = lo.y; o.z = hh.x; o.w = hh.y; return __builtin_bit_cast(bf16x8, o);
}
__device__ __forceinline__ void st16_(LAS unsigned char* a, const u32x4 v) { *(LAS u32x2*)a = (u32x2){v.x, v.y}; *(LAS u32x2*)(a + 8) = (u32x2){v.z, v.w}; }
__device__ __forceinline__ int opq5(int x) { asm volatile("" : "+v"(x)); return x; }
#define MFMA32(A_, B_, C_) __builtin_amdgcn_mfma_f32_32x32x16_bf16((A_), (B_), (C_), 0, 0, 0)

__device__ __forceinline__ float ck_ar16(float x) {
  unsigned a = __builtin_bit_cast(unsigned, x), b = a;
  asm volatile("s_nop 1\n\tv_permlane16_swap_b32 %0, %1" : "+v"(a), "+v"(b));
  return __builtin_bit_cast(float, a) + __builtin_bit_cast(float, b);
}
__device__ __forceinline__ float ck_ar32(float x) {
  unsigned a = __builtin_bit_cast(unsigned, x), b = a;
  asm volatile("s_nop 1\n\tv_permlane32_swap_b32 %0, %1" : "+v"(a), "+v"(b));
  return __builtin_bit_cast(float, a) + __builtin_bit_cast(float, b);
}
#ifdef CKT_WAVE
#ifndef CKT_SEC
#define CKT_SEC 0
#endif
#define CKT_S(n) unsigned long long ckt##n##_ = 0ull; if (CKT_SEC == (n)) { asm volatile("s_waitcnt lgkmcnt(0)" ::: "memory"); ckt##n##_ = __builtin_amdgcn_s_memrealtime(); }
#define CKT_E(n) do { if (CKT_SEC == (n) && blockIdx.x == 0 && wave == (CKT_WAVE) && (threadIdx.x & 63) == 0) { asm volatile("s_waitcnt lgkmcnt(0)" ::: "memory"); ((volatile LAS unsigned*)(lds + MISC_OFF))[40] += (unsigned)(__builtin_amdgcn_s_memrealtime() - ckt##n##_); } } while (0)
#else
#define CKT_S(n)
#define CKT_E(n) do {} while (0)
#endif
#define CKT_BEGIN() CKT_S(0)
#define CKT_END() CKT_E(0)
struct CkChain { int seq, dir, hd, m0, L, nch, kofs; };
__device__ __forceinline__ CkChain ck_chain(int id) {
  CkChain c;
  if (id < 64) { c.seq = 16 + (id >> 5); c.dir = (id >> 4) & 1; c.hd = id & 15; c.L = 2048; c.m0 = NPT + (c.seq - 16) * 2048; }
  else { const int p = id - 64; c.seq = p >> 5; c.dir = (p >> 4) & 1; c.hd = p & 15; c.L = 256; c.m0 = c.seq * 256; }
  c.nch = c.L / 32; c.kofs = 0; return c;
}

constexpr int CK_K0 = 32, CK_NREC = 32;
constexpr int CK_REC = 4 * OSZ + 256 + CK_MXS;
constexpr size_t M_REC = 0;
constexpr unsigned CK_R0N = (unsigned)((48 * MiB) / CK_REC);
constexpr size_t M_REC1 = M_WTS + 20 * MiB;
static_assert((64u * CK_NREC - CK_R0N) * (size_t)CK_REC <= 15 * MiB, "record overflow region");
__device__ __forceinline__ unsigned char* ck_rec(unsigned char* ws, unsigned rec) { return rec < CK_R0N ? ws + M_REC + (size_t)rec * CK_REC : ws + M_REC1 + (size_t)(rec - CK_R0N) * CK_REC; }
constexpr size_t CK_FLAGS = 32768;
__device__ __forceinline__ void ck_run_chain(const LAS PG& p, unsigned char* ws, LAS unsigned char* lds, const CkChain ch, int lane_in, int wave, const int mode, const int nprep, const int cidx) {
  const int lane = lane_in;
  const int hi = lane >> 5, r32 = lane & 31;
  bf16_t* Yo = (bf16_t*)(ws + (ch.dir ? M_YB : M_YF));
  const int NK = ch.nch + 3;
  const int sb0 = 32 * ch.kofs;
#define CK_PROD(ACC, AOFF, BOFF) do { _Pragma("unroll") for (int i_ = 0; i_ < 16; ++i_) ACC[i_] = 0.f; \
          _Pragma("unroll") for (int ks = 0; ks < 4; ++ks) { \
            const bf16x8 af_ = ld16_(ob + (AOFF) + (r32 * LDO + 16 * ks + 8 * hi) * 2), bf_ = ld16_(ob + (BOFF) + (r32 * LDO + 16 * ks + 8 * hi) * 2); \
            ACC = MFMA32(af_, bf_, ACC); } } while (0)
#define CK_STORE_T(ACC, DST, STRICT) do { _Pragma("unroll") for (int q_ = 0; q_ < 4; ++q_) { \
            float v_[4]; _Pragma("unroll") for (int x_ = 0; x_ < 4; ++x_) { const int s_ = 8 * q_ + 4 * hi + x_; const bool keep_ = (STRICT) ? (s_ < r32) : (s_ <= r32); v_[x_] = keep_ ? ACC[4 * q_ + x_] : 0.f; ACC[4 * q_ + x_] = v_[x_]; } \
            u32x2 w_; w_.x = pk2_(v_[0], v_[1]); w_.y = pk2_(v_[2], v_[3]); *(LAS u32x2*)((DST) + (r32 * LDM + 8 * q_ + 4 * hi) * 2) = w_; } } while (0)
#define CK_STORE_TN(ACC, DST) do { _Pragma("unroll") for (int q_ = 0; q_ < 4; ++q_) { u32x2 w_; w_.x = pk2_(ACC[4 * q_], ACC[4 * q_ + 1]); w_.y = pk2_(ACC[4 * q_ + 2], ACC[4 * q_ + 3]); \
            *(LAS u32x2*)((DST) + (r32 * LDM + 8 * q_ + 4 * hi) * 2) = w_; } } while (0)
  if (wave >= 4) {
    float rw_dec[8], rw_al[8], rw_kq[8], rw_kd[8], rw_r[8];
    u32x2 rw_vp[2];
    u32x4 cr[16];
#pragma unroll
    for (int i = 0; i < 16; ++i) cr[i] = (u32x4){0u, 0u, 0u, 0u};
    const int nt = wave - 4, col = lane & 15, g = lane >> 4;
    const int froff = CK_FR + nt * 6144 + lane * 16;
#pragma unroll
    for (int i = 0; i < 8; ++i) { rw_dec[i] = 1.f; rw_al[i] = 0.f; rw_kq[i] = 0.f; rw_kd[i] = 0.f; rw_r[i] = 0.f; }
    rw_vp[0] = (u32x2){0u, 0u}; rw_vp[1] = rw_vp[0];
    prepc_load(p, lds, froff, ch.dir, ch.hd, lane, nt);
    const int pb_x = col * (LDO * 2) + (16 * nt + 4 * g) * 2;
    const int pb_h = col * 272 + 16 * g;
    LDS_BARRIER();
#define CK_DPPF(OLD, V, CTRL) __builtin_bit_cast(float, __builtin_amdgcn_update_dpp(__builtin_bit_cast(int, (float)(OLD)), __builtin_bit_cast(int, (float)(V)), (CTRL), 0xF, 0xF, false))
    for (int k = 0; k < NK; ++k) {
      CKT_BEGIN();
      CKT_S(1)
      if (k >= 1 && k <= nprep) {
        LAS unsigned char* ob = lds + ((k - 1) % 3) * CK_OPS;
        LAS const unsigned char* sq = lds + CK_SSQ + ((k - 1) & 1) * 512;
        float wt[8], wp[8], T0[4];
#pragma unroll
        for (int e = 0; e < 8; ++e) wt[e] = rw_dec[e];
#pragma unroll
        for (int e = 0; e < 8; ++e) wt[e] *= CK_DPPF(1.f, wt[e], 0x111);
#pragma unroll
        for (int e = 0; e < 8; ++e) wt[e] *= CK_DPPF(1.f, wt[e], 0x112);
#pragma unroll
        for (int e = 0; e < 8; ++e) wt[e] *= CK_DPPF(1.f, wt[e], 0x114);
#pragma unroll
        for (int e = 0; e < 8; ++e) wt[e] *= CK_DPPF(1.f, wt[e], 0x118);
#pragma unroll
        for (int r = 0; r < 4; ++r) { T0[r] = CK_DPPF(0.f, wt[r], 0x15F); wt[4 + r] *= T0[r]; }
#pragma unroll
        for (int r = 0; r < 4; ++r) { wp[r] = CK_DPPF(1.f, wt[r], 0x111); wp[4 + r] = CK_DPPF(T0[r], wt[4 + r], 0x111); }
#pragma unroll
        for (int mt = 0; mt < 2; ++mt) {
          const f32x4 q4 = *(LAS const f32x4*)(sq + (16 * mt + col) * 16);
          const float rn = rsqrtf((q4.x + q4.y) + (q4.z + q4.w) + 1e-12f);
          float oa[4], obb[4], ok[4], orr[4];
#pragma unroll
          for (int r = 0; r < 4; ++r) {
            const int e = 4 * mt + r;
            const float iw = __builtin_amdgcn_rcpf(wt[e]);
            const float kqn = rw_kq[e] * rn;
            oa[r] = -wp[e] * kqn;
            obb[r] = kqn * rw_al[e] * iw;
            ok[r] = rw_kd[e] * iw;
            orr[r] = wt[e] * rw_r[e];
          }
          LAS unsigned char* o8 = ob + pb_x + 16 * mt * (LDO * 2);
          *(LAS u32x2*)(o8) = (u32x2){pk2_(oa[0], oa[1]), pk2_(oa[2], oa[3])};
          *(LAS u32x2*)(o8 + O_B) = (u32x2){pk2_(obb[0], obb[1]), pk2_(obb[2], obb[3])};
          *(LAS u32x2*)(o8 + O_K) = (u32x2){pk2_(ok[0], ok[1]), pk2_(ok[2], ok[3])};
          *(LAS u32x2*)(o8 + O_R) = (u32x2){pk2_(orr[0], orr[1]), pk2_(orr[2], orr[3])};
          *(LAS u32x2*)(o8 + O_V) = rw_vp[mt];
        }
        if (col == 15) *(LAS f32x4*)(ob + O_W + (16 * nt + 4 * g) * 4) = (f32x4){wt[4], wt[5], wt[6], wt[7]};
      }
      CKT_E(1);
      CKT_S(2)
      if (k < nprep) {
        LAS const f32x4* cn4 = (LAS const f32x4*)(lds + (froff - lane * 16) + 4096 + 16 * g);
        const f32x4 c_biasw = cn4[0], c_biasa = cn4[16], c_kkc = cn4[32], c_kac = cn4[48], c_rkc = cn4[64];
        LAS unsigned char* sq = lds + CK_SSQ + (k & 1) * 512;
        LAS const unsigned char* in = lds + CK_IN + (k & 1) * CK_INS;
#pragma unroll
        for (int mt = 0; mt < 2; ++mt) {
          f32x4 aw = c_biasw, aa = c_biasa;
          LAS const unsigned char* hrow = in + 3 * OSZ + pb_h + 16 * mt * 272;
          aw = __builtin_amdgcn_mfma_f32_16x16x32_bf16(*(LAS const bf16x8*)(lds + froff), *(LAS const bf16x8*)(hrow), aw, 0, 0, 0);
          aw = __builtin_amdgcn_mfma_f32_16x16x32_bf16(*(LAS const bf16x8*)(lds + froff + 1024), *(LAS const bf16x8*)(hrow + 64), aw, 0, 0, 0);
          aa = __builtin_amdgcn_mfma_f32_16x16x32_bf16(*(LAS const bf16x8*)(lds + froff + 2048), *(LAS const bf16x8*)(hrow + 128), aa, 0, 0, 0);
          aa = __builtin_amdgcn_mfma_f32_16x16x32_bf16(*(LAS const bf16x8*)(lds + froff + 3072), *(LAS const bf16x8*)(hrow + 192), aa, 0, 0, 0);
          LAS const unsigned char* i8 = in + pb_x + 16 * mt * (LDO * 2);
          const u32x2 pk = *(LAS const u32x2*)(i8), pr = *(LAS const u32x2*)(i8 + OSZ);
          rw_vp[mt] = *(LAS const u32x2*)(i8 + 2 * OSZ);
          float sqs = 0.f, bns = 0.f;
#pragma unroll
          for (int r = 0; r < 4; ++r) {
            const int e = 4 * mt + r;
            const float sig = __builtin_amdgcn_rcpf(1.f + __expf(-aw[r]));
            rw_dec[e] = __expf(-0.6065306597126334f * sig);
            const float a = __builtin_amdgcn_rcpf(1.f + __expf(-aa[r]));
            rw_al[e] = a;
            const unsigned kw = (r < 2) ? pk.x : pk.y, rww = (r < 2) ? pr.x : pr.y;
            const float kv = (r & 1) ? __builtin_bit_cast(float, kw & 0xffff0000u) : __builtin_bit_cast(float, kw << 16);
            const float rv = (r & 1) ? __builtin_bit_cast(float, rww & 0xffff0000u) : __builtin_bit_cast(float, rww << 16);
            rw_r[e] = rv;
            const float kq = kv * c_kkc[r]; rw_kq[e] = kq;
            const float kd = kv * (1.f + (a - 1.f) * c_kac[r]); rw_kd[e] = kd;
            sqs += kq * kq; bns += rv * kd * c_rkc[r];
          }
          sqs = ck_ar16(sqs); bns = ck_ar16(bns); sqs = ck_ar32(sqs); bns = ck_ar32(bns);
          if (g == 0) {
            *(LAS float*)(sq + (16 * mt + col) * 16 + nt * 4) = sqs;
            float* bo = (float*)(ws + M_BON) + ((((unsigned)ch.dir * NTOK + (unsigned)ctok(ch.m0, ch.L, ch.dir, sb0 + 32 * k + 16 * mt + col)) * 16u + (unsigned)ch.hd) * 4u + (unsigned)nt);
            *bo = bns;
          }
        }
      }
      CKT_E(2);
      CKT_S(3)
      if (mode == 1) {
        const int l2 = (nt & 1) * 64 + lane;
        if ((((k ^ (nt >> 1)) & 1) == 0)) {
          if (k - 2 >= nprep && k - 2 < ch.nch) {
            const int kc = k - 2;
            LAS unsigned char* ob = lds + (kc % 3) * CK_OPS;
            LAS unsigned char* mxb = lds + CK_MX + (kc & 1) * CK_MXS;
#pragma unroll
            for (int i = 0; i < 8; ++i) *(LAS u32x4*)(ob + (l2 + 128 * i) * 16) = cr[i];
            if (l2 < 64) *(LAS u32x4*)(ob + (1024 + l2) * 16) = cr[8];
            else if (l2 < 80) *(LAS u32x4*)(ob + O_W + (l2 - 64) * 16) = cr[8];
#pragma unroll
            for (int i = 0; i < 4; ++i) *(LAS u32x4*)(mxb + (l2 + 128 * i) * 16) = cr[9 + i];
            if (l2 < 64) *(LAS u32x4*)(mxb + (512 + l2) * 16) = cr[13];
#pragma unroll
            for (int i = 0; i < 2; ++i) { const int id = l2 + 128 * i; st16_(ob + O_V + (id >> 3) * (LDO * 2) + (id & 7) * 16, cr[14 + i]); }
          }
          if (k >= nprep && k < ch.nch) {
            const int kc = k;
            const unsigned rec = (unsigned)(cidx * CK_NREC + (kc - CK_K0));
            if (((kc - CK_K0) & 7) < 2) {
              unsigned* flag = (unsigned*)(ws + M_CTL + CK_FLAGS) + (rec | 7u);
              { unsigned sp = 0; while (__hip_atomic_load(flag, __ATOMIC_RELAXED, __HIP_MEMORY_SCOPE_AGENT) == 0u) { __builtin_amdgcn_s_sleep(2); if (++sp > (1u << 22)) break; } }
              __builtin_amdgcn_fence(__ATOMIC_ACQUIRE, "agent");
              asm volatile("s_waitcnt vmcnt(0)" ::: "memory");
            }
            const unsigned char* rp = ck_rec(ws, rec);
#pragma unroll
            for (int i = 0; i < 8; ++i) cr[i] = *(const u32x4*)(rp + (l2 + 128 * i) * 16);
            if (l2 < 80) cr[8] = *(const u32x4*)(rp + (1024 + l2) * 16);
#pragma unroll
            for (int i = 0; i < 4; ++i) cr[9 + i] = *(const u32x4*)(rp + 4 * OSZ + 256 + (l2 + 128 * i) * 16);
            if (l2 < 64) cr[13] = *(const u32x4*)(rp + 4 * OSZ + 256 + (512 + l2) * 16);
#pragma unroll
            for (int i = 0; i < 2; ++i) { const int id = l2 + 128 * i; const int t = id >> 3, c8 = id & 7;
              const unsigned gi = (unsigned)ctok(ch.m0, ch.L, ch.dir, sb0 + 32 * kc + t) * (unsigned)D + (unsigned)(ch.hd * 64 + 8 * c8);
              cr[14 + i] = *(const u32x4*)((const bf16_t*)(ws + M_VB) + gi); }
          }
        }
      }
      CKT_E(3);
      CKT_END();
      LDS_BARRIER();
    }
  } else if (wave == 3) {
    u32x4 ld_k[4], ld_r[4], ld_v[4], ld_h[8];
#define CK_LOAD(KC) do { const int s0_ = sb0 + 32 * (KC); \
      _Pragma("unroll") for (int i_ = 0; i_ < 4; ++i_) { const int id_ = lane + 64 * i_; const int t_ = id_ >> 3, c8_ = id_ & 7; \
        const unsigned gi_ = (unsigned)ctok(ch.m0, ch.L, ch.dir, s0_ + t_) * (unsigned)D + (unsigned)(ch.hd * 64 + 8 * c8_); \
        ld_k[i_] = *(const u32x4*)((const bf16_t*)(ws + M_KB) + gi_); ld_r[i_] = *(const u32x4*)((const bf16_t*)(ws + M_RB) + gi_); ld_v[i_] = *(const u32x4*)((const bf16_t*)(ws + M_VB) + gi_); } \
      _Pragma("unroll") for (int i_ = 0; i_ < 8; ++i_) { const int id_ = lane + 64 * i_; const int t_ = id_ >> 4, c8_ = id_ & 15; \
        const unsigned go_ = (unsigned)ctok(ch.m0, ch.L, ch.dir, s0_ + t_) * 256u + (unsigned)((c8_ >> 3) * 128 + ch.dir * 64 + 8 * (c8_ & 7)); \
        ld_h[i_] = *(const u32x4*)((const bf16_t*)(ws + M_HWA) + go_); } } while (0)
#define CK_PUT(BUF) do { LAS unsigned char* in_ = lds + CK_IN + (BUF) * CK_INS; \
      _Pragma("unroll") for (int i_ = 0; i_ < 4; ++i_) { const int id_ = lane + 64 * i_; \
        LAS unsigned char* d_ = in_ + (id_ >> 3) * (LDO * 2) + (id_ & 7) * 16; st16_(d_, ld_k[i_]); st16_(d_ + OSZ, ld_r[i_]); st16_(d_ + 2 * OSZ, ld_v[i_]); } \
      _Pragma("unroll") for (int i_ = 0; i_ < 8; ++i_) { const int id_ = lane + 64 * i_; const int t_ = id_ >> 4, c8_ = id_ & 15; \
        *(LAS u32x4*)(in_ + 3 * OSZ + t_ * 272 + c8_ * 16) = ld_h[i_]; } } while (0)
    CK_LOAD(0); CK_PUT(0);
    if (nprep > 1) CK_LOAD(1);
    LDS_BARRIER();
    for (int k = 0; k < NK; ++k) {
      CKT_BEGIN();
      if (k + 1 < nprep) CK_PUT((k + 1) & 1);
      if (k + 2 < nprep) CK_LOAD(k + 2);
      if (k >= 2 && k <= nprep + 1) {
        const int lane_o = opq5(lane); const int r32 = lane_o & 31, hi = lane_o >> 5;
        LAS const unsigned char* ob = lds + ((k - 2) % 3) * CK_OPS;
        LAS unsigned char* mx = lds + CK_MX + ((k - 2) & 1) * CK_MXS;
        f32x16 acc;
        CK_PROD(acc, O_K, 0);     CK_STORE_T(acc, mx + 0, true);
        CK_PROD(acc, O_B, O_R); CK_STORE_T(acc, mx + MSZ, false);
        CK_PROD(acc, O_K, O_R); CK_STORE_T(acc, mx + 2 * MSZ, false);
      }
      CKT_END();
      LDS_BARRIER();
    }
#undef CK_LOAD
#undef CK_PUT
  } else if (wave == 2) {
    LDS_BARRIER();
    for (int k = 0; k < NK; ++k) {
      CKT_BEGIN();
      if (k >= 2 && k <= nprep + 1) {
        const int lane_o = opq5(lane); const int r32 = lane_o & 31, hi = lane_o >> 5;
        LAS const unsigned char* ob = lds + ((k - 2) % 3) * CK_OPS;
        LAS unsigned char* mx = lds + CK_MX + ((k - 2) & 1) * CK_MXS;
        LAS unsigned char* sc = lds + CK_SCR;
        f32x16 Q, Pm;
        CK_PROD(Q, O_B, 0);
        CK_STORE_T(Q, sc + MSZ, true);
#pragma unroll
        for (int i = 0; i < 16; ++i) Pm[i] = Q[i] + ((crow_(i, hi) == r32) ? 1.f : 0.f);
        CK_STORE_TN(Pm, sc + 2 * MSZ);
        asm volatile("s_waitcnt lgkmcnt(0)" ::: "memory");
#define CK_MM(ACC, Z1T, Z2T) do { _Pragma("unroll") for (int ks = 0; ks < 2; ++ks) { \
          const bf16x8 af_ = ldT_nat(sc + (Z1T), LDM, 16 * ks, 0, lane_o), bf_ = ld16_(sc + (Z2T) + (r32 * LDM + 16 * ks + 8 * hi) * 2); \
          ACC = MFMA32(af_, bf_, ACC); } } while (0)
#pragma unroll 1
        for (int it = 0; it < 4; ++it) {
          f32x16 Q2;
#pragma unroll
          for (int i = 0; i < 16; ++i) Q2[i] = 0.f;
          CK_MM(Q2, MSZ, MSZ);
          asm volatile("s_waitcnt lgkmcnt(0)" ::: "memory");
          CK_STORE_TN(Q2, sc + MSZ);
          asm volatile("s_waitcnt lgkmcnt(0)" ::: "memory");
          CK_MM(Pm, 2 * MSZ, MSZ);
          asm volatile("s_waitcnt lgkmcnt(0)" ::: "memory");
          if (it < 3) { CK_STORE_TN(Pm, sc + 2 * MSZ); asm volatile("s_waitcnt lgkmcnt(0)" ::: "memory"); }
        }
        CK_STORE_TN(Pm, mx + 3 * MSZ);
#undef CK_MM
      }
      CKT_END();
      LDS_BARRIER();
    }
  } else {
    f32x16 St0, St1;
#pragma unroll
    for (int i = 0; i < 16; ++i) { St0[i] = 0.f; St1[i] = 0.f; }
    if (mode != 2 && ch.L == 2048) {
      const GASF* s0 = p.state_rwkv + ((((size_t)(ch.seq - 16)) * 2 + ch.dir) * 16 + ch.hd) * 4096 + (size_t)(32 * wave + r32) * 64;
#pragma unroll
      for (int q = 0; q < 4; ++q) {
        const f32x4 a = *(const GAS f32x4*)(s0 + 8 * q + 4 * hi), b = *(const GAS f32x4*)(s0 + 32 + 8 * q + 4 * hi);
        St0[4 * q] = a.x; St0[4 * q + 1] = a.y; St0[4 * q + 2] = a.z; St0[4 * q + 3] = a.w;
        St1[4 * q] = b.x; St1[4 * q + 1] = b.y; St1[4 * q + 2] = b.z; St1[4 * q + 3] = b.w;
      }
    }
    LDS_BARRIER();
#ifdef CKT_WAVE
    unsigned long long ckt_prev_ = 0ull;
#endif
    for (int k = 0; k < NK; ++k) {
      CKT_BEGIN();
      const int lane = opq5(lane_in); const int hi = lane >> 5, r32 = lane & 31;
#ifdef CKT_WAVE
      if (CKT_SEC == 8 || CKT_SEC == 9) { static_assert(true, ""); const unsigned long long tn_ = __builtin_amdgcn_s_memrealtime(); if (k > 0 && blockIdx.x == 0 && wave == (CKT_WAVE) && lane == 0 && ((CKT_SEC == 8) == (k <= nprep + 2))) ((volatile LAS unsigned*)(lds + MISC_OFF))[40] += (unsigned)(tn_ - ckt_prev_); ckt_prev_ = tn_; }
#endif
      if (mode == 2) {
        if (k >= 4 && wave == 0 && lane == 0) {
          __builtin_amdgcn_fence(__ATOMIC_RELEASE, "agent");
          asm volatile("s_waitcnt vmcnt(0)" ::: "memory");
          __hip_atomic_store((unsigned*)(ws + M_CTL + CK_FLAGS) + (unsigned)(cidx * CK_NREC + (ch.kofs + (k - 4) - CK_K0)), 1u, __ATOMIC_RELAXED, __HIP_MEMORY_SCOPE_AGENT);
        }
        if (k >= 3) {
          const int kc = k - 3;
          unsigned char* rp = ck_rec(ws, (unsigned)(cidx * CK_NREC + (ch.kofs + kc - CK_K0)));
          LAS const unsigned char* ob = lds + (kc % 3) * CK_OPS;
          LAS const unsigned char* mxb = lds + CK_MX + (kc & 1) * CK_MXS;
          const int l2 = wave * 64 + lane;
#pragma unroll 4
          for (int i = 0; i < 8; ++i) *(u32x4*)(rp + (l2 + 128 * i) * 16) = *(LAS const u32x4*)(ob + (l2 + 128 * i) * 16);
          if (l2 < 64) *(u32x4*)(rp + (1024 + l2) * 16) = *(LAS const u32x4*)(ob + (1024 + l2) * 16);
          else if (l2 < 80) *(u32x4*)(rp + (1024 + l2) * 16) = *(LAS const u32x4*)(ob + O_W + (l2 - 64) * 16);
#pragma unroll 4
          for (int i = 0; i < 4; ++i) *(u32x4*)(rp + 4 * OSZ + 256 + (l2 + 128 * i) * 16) = *(LAS const u32x4*)(mxb + (l2 + 128 * i) * 16);
          if (l2 < 64) *(u32x4*)(rp + 4 * OSZ + 256 + (512 + l2) * 16) = *(LAS const u32x4*)(mxb + (512 + l2) * 16);
          asm volatile("s_waitcnt vmcnt(0)" ::: "memory");
        }
      } else if (k >= 3) {
        const int kc = k - 3, ih = wave;
        LAS const unsigned char* ob = lds + (kc % 3) * CK_OPS;
        LAS const unsigned char* mx = lds + CK_MX + (kc & 1) * CK_MXS;
        CKT_S(5)
        const bf16x8 s00 = cvt8(St0, 0), s01 = cvt8(St0, 1), s10 = cvt8(St1, 0), s11 = cvt8(St1, 1);
        const bf16x8 fa0 = ldA_perm(ob + 0, LDO, r32, 0, hi), fr0 = ldA_perm(ob + O_R, LDO, r32, 0, hi), fa1 = ldA_perm(ob + 0, LDO, r32, 16, hi), fr1 = ldA_perm(ob + O_R, LDO, r32, 16, hi);
        const bf16x8 fa2 = ldA_perm(ob + 0, LDO, r32, 32, hi), fr2 = ldA_perm(ob + O_R, LDO, r32, 32, hi), fa3 = ldA_perm(ob + 0, LDO, r32, 48, hi), fr3 = ldA_perm(ob + O_R, LDO, r32, 48, hi);
        const bf16x8 v0 = ldT_perm(ob + O_V, LDO, 0, 32 * ih, lane), v1 = ldT_perm(ob + O_V, LDO, 16, 32 * ih, lane);
        const bf16x8 fn0 = ldA_perm(mx + 0, LDM, r32, 0, hi), fm0 = ldA_perm(mx + 2 * MSZ, LDM, r32, 0, hi), fn1 = ldA_perm(mx + 0, LDM, r32, 16, hi), fm1 = ldA_perm(mx + 2 * MSZ, LDM, r32, 16, hi);
        const bf16x8 fk00 = ldT_perm(ob + O_K, LDO, 0, 0, lane), fk01 = ldT_perm(ob + O_K, LDO, 0, 32, lane), fk10 = ldT_perm(ob + O_K, LDO, 16, 0, lane), fk11 = ldT_perm(ob + O_K, LDO, 16, 32, lane);
        const bf16x8 fx0 = ldA_perm(mx + 3 * MSZ, LDM, r32, 0, hi), fx1 = ldA_perm(mx + 3 * MSZ, LDM, r32, 16, hi);
        __builtin_amdgcn_sched_barrier(0);
        const bf16x8 fq0 = ldA_perm(mx + MSZ, LDM, r32, 0, hi), fq1 = ldA_perm(mx + MSZ, LDM, r32, 16, hi);
        const bf16x8 fb00 = ldT_perm(ob + O_B, LDO, 0, 0, lane), fb01 = ldT_perm(ob + O_B, LDO, 0, 32, lane), fb10 = ldT_perm(ob + O_B, LDO, 16, 0, lane), fb11 = ldT_perm(ob + O_B, LDO, 16, 32, lane);
        __builtin_amdgcn_sched_barrier(0);
        CKT_E(5);
        CKT_S(6)
        f32x16 G, U, Y;
#pragma unroll
        for (int i = 0; i < 16; ++i) { G[i] = 0.f; U[i] = 0.f; Y[i] = 0.f; }
        G = MFMA32(fa0, s00, G); Y = MFMA32(fr0, s00, Y); G = MFMA32(fa1, s01, G); Y = MFMA32(fr1, s01, Y);
        G = MFMA32(fa2, s10, G); Y = MFMA32(fr2, s10, Y); G = MFMA32(fa3, s11, G); Y = MFMA32(fr3, s11, Y);
        G = MFMA32(fn0, v0, G);  Y = MFMA32(fm0, v0, Y);  G = MFMA32(fn1, v1, G);  Y = MFMA32(fm1, v1, Y);
        St0 = MFMA32(fk00, v0, St0); St1 = MFMA32(fk01, v0, St1); St0 = MFMA32(fk10, v1, St0); St1 = MFMA32(fk11, v1, St1);
        const bf16x8 g0 = cvt8(G, 0), g1 = cvt8(G, 1);
        U = MFMA32(fx0, g0, U); U = MFMA32(fx1, g1, U);
        LAS const float* wt = (LAS const float*)(ob + O_W);
        f32x4 w0q[4], w1q[4];
#pragma unroll
        for (int q = 0; q < 4; ++q) { w0q[q] = *(LAS const f32x4*)(wt + 8 * q + 4 * hi); w1q[q] = *(LAS const f32x4*)(wt + 32 + 8 * q + 4 * hi); }
        const bf16x8 u0 = cvt8(U, 0), u1 = cvt8(U, 1);
        Y = MFMA32(fq0, u0, Y); St0 = MFMA32(fb00, u0, St0); St1 = MFMA32(fb01, u0, St1);
        Y = MFMA32(fq1, u1, Y); St0 = MFMA32(fb10, u1, St0); St1 = MFMA32(fb11, u1, St1);
#pragma unroll
        for (int q = 0; q < 4; ++q) {
          const f32x4 w0 = w0q[q], w1 = w1q[q];
          St0[4 * q] *= w0.x; St0[4 * q + 1] *= w0.y; St0[4 * q + 2] *= w0.z; St0[4 * q + 3] *= w0.w;
          St1[4 * q] *= w1.x; St1[4 * q + 1] *= w1.y; St1[4 * q + 2] *= w1.z; St1[4 * q + 3] *= w1.w;
        }
        CKT_E(6);
        CKT_S(7)
        {
          const int tk0 = ctok(ch.m0, ch.L, ch.dir, sb0 + 32 * kc); const int dstep = ch.dir ? -1 : 1;
          const unsigned cb = (unsigned)(ch.hd * 64 + 32 * ih + r32);
#pragma unroll
          for (int i = 0; i < 16; ++i) Yo[(unsigned)(tk0 + crow_(i, hi) * dstep) * (unsigned)D + cb] = (bf16_t)f2bf_(Y[i]);
        }
        CKT_E(7);
      }
      CKT_END();
      LDS_BARRIER();
    }
    if (mode == 2 && wave == 0 && lane == 0) {
      __builtin_amdgcn_fence(__ATOMIC_RELEASE, "agent");
      asm volatile("s_waitcnt vmcnt(0)" ::: "memory");
      __hip_atomic_store((unsigned*)(ws + M_CTL + CK_FLAGS) + (unsigned)(cidx * CK_NREC + (ch.kofs + ch.nch - 1 - CK_K0)), 1u, __ATOMIC_RELAXED, __HIP_MEMORY_SCOPE_AGENT);
    }
    if (mode != 2 && ch.L == 256) {
    GASF* so = p.out + OUT_ST + ((((size_t)ch.seq) * 2 + ch.dir) * 16 + ch.hd) * 4096 + (size_t)(32 * wave + r32) * 64;
#pragma unroll
    for (int q = 0; q < 4; ++q) {
      *(GAS f32x4*)(so + 8 * q + 4 * hi) = (f32x4){St0[4 * q], St0[4 * q + 1], St0[4 * q + 2], St0[4 * q + 3]};
      *(GAS f32x4*)(so + 32 + 8 * q + 4 * hi) = (f32x4){St1[4 * q], St1[4 * q + 1], St1[4 * q + 2], St1[4 * q + 3]};
    }
  }
  }
}

__device__ __forceinline__ void phase_rw_scan_ck(const LAS PG& p, unsigned char* ws, LAS unsigned char* lds, int tid, int lane, int wave, int bid, int G) {
  int dfirst = bid * 8 + wave, dstride = G * 8;
  if (G == 256) {
    if (bid < 64) { __syncthreads(); ck_run_chain(p, ws, lds, ck_chain(bid), lane, wave, 1, CK_K0, bid); dfirst = NTR_DEF; }
    else {
      const int pb = bid - 64;
      const int px = pb & 7, pk = pb >> 3;
      {
        const int c1 = (pk / 3) * 8 + px;
        CkChain pch = ck_chain(c1); pch.kofs = CK_K0 + 8 * (pk % 3); pch.nch = 8;
        __syncthreads(); ck_run_chain(p, ws, lds, pch, lane, wave, 2, 8, c1);
      }
      if (pb >= 128) {
        const int c2 = (pk - 16) * 8 + px;
        CkChain pch = ck_chain(c2); pch.kofs = CK_K0 + 24; pch.nch = 8;
        __syncthreads(); ck_run_chain(p, ws, lds, pch, lane, wave, 2, 8, c2);
      }
      for (int pc = pb; pc < 512; pc += 192) { __syncthreads(); ck_run_chain(p, ws, lds, ck_chain(64 + pc), lane, wave, 0, 8, 0); }
      dfirst = (bid - 64) * 8 + wave; dstride = 192 * 8;
    }
  } else {
    for (int id = bid; id < 576; id += G) { __syncthreads(); const CkChain cc = ck_chain(id); ck_run_chain(p, ws, lds, cc, lane, wave, 0, cc.nch, 0); }
  }
  __syncthreads();
  tr_run<1>(p, ws, (LAS float*)(lds + wave * 16384), lane, dfirst, dstride, NTR_DEF);
}
__device__ __forceinline__ int opq(int x) { asm volatile("" : "+v"(x)); return x; }
#ifndef RPT_MASK
#define RPT_MASK 0u
#endif
struct MArgs { P p; int ph_lo, ph_hi; };
__global__ void __launch_bounds__(512, 2) mega(MArgs a) {
  extern __shared__ __attribute__((aligned(16))) unsigned char lds_raw[];
  LAS unsigned char* lds = (LAS unsigned char*)lds_raw;
  const int tid = threadIdx.x, lane = tid & 63, wave = __builtin_amdgcn_readfirstlane(tid >> 6);
  const int G = gridDim.x, bid = blockIdx.x;
  unsigned char* ws = (unsigned char*)a.p.ws;
  if (tid == 0) {
    LAS PG* t = (LAS PG*)(lds + PTAB_OFF);
    t->x_prompt = (decltype(t->x_prompt))a.p.x_prompt;
    t->x_sample = (decltype(t->x_sample))a.p.x_sample;
    t->cache_ckv = (decltype(t->cache_ckv))a.p.cache_ckv;
    t->cache_kpe = (decltype(t->cache_kpe))a.p.cache_kpe;
    t->state_rwkv = (decltype(t->state_rwkv))a.p.state_rwkv;
    t->c = (decltype(t->c))a.p.c;
    t->c_ctx = (decltype(t->c_ctx))a.p.c_ctx;
    t->mod_w = (decltype(t->mod_w))a.p.mod_w;
    t->mod_b = (decltype(t->mod_b))a.p.mod_b;
    t->ln_g = (decltype(t->ln_g))a.p.ln_g;
    t->ln_b = (decltype(t->ln_b))a.p.ln_b;
    t->hy_w_in = (decltype(t->hy_w_in))a.p.hy_w_in;
    t->hy_conv_w = (decltype(t->hy_conv_w))a.p.hy_conv_w;
    t->hy_conv_b = (decltype(t->hy_conv_b))a.p.hy_conv_b;
    t->hy_w1 = (decltype(t->hy_w1))a.p.hy_w1;
    t->hy_b1 = (decltype(t->hy_b1))a.p.hy_b1;
    t->hy_w2 = (decltype(t->hy_w2))a.p.hy_w2;
    t->hy_b2 = (decltype(t->hy_b2))a.p.hy_b2;
    t->hy_w3 = (decltype(t->hy_w3))a.p.hy_w3;
    t->hy_b3 = (decltype(t->hy_b3))a.p.hy_b3;
    t->hy_freq = (decltype(t->hy_freq))a.p.hy_freq;
    t->hy_decay = (decltype(t->hy_decay))a.p.hy_decay;
    t->hy_skip = (decltype(t->hy_skip))a.p.hy_skip;
    t->hy_w_out = (decltype(t->hy_w_out))a.p.hy_w_out;
    t->mla_w_in = (decltype(t->mla_w_in))a.p.mla_w_in;
    t->mla_q_norm = (decltype(t->mla_q_norm))a.p.mla_q_norm;
    t->mla_kv_norm = (decltype(t->mla_kv_norm))a.p.mla_kv_norm;
    t->mla_w_q_up = (decltype(t->mla_w_q_up))a.p.mla_w_q_up;
    t->mla_w_kv_up = (decltype(t->mla_w_kv_up))a.p.mla_w_kv_up;
    t->mla_w_out = (decltype(t->mla_w_out))a.p.mla_w_out;
    t->rw_mu = (decltype(t->rw_mu))a.p.rw_mu;
    t->rw_w_in = (decltype(t->rw_w_in))a.p.rw_w_in;
    t->rw_w0 = (decltype(t->rw_w0))a.p.rw_w0;
    t->rw_w1 = (decltype(t->rw_w1))a.p.rw_w1;
    t->rw_w2 = (decltype(t->rw_w2))a.p.rw_w2;
    t->rw_a0 = (decltype(t->rw_a0))a.p.rw_a0;
    t->rw_a1 = (decltype(t->rw_a1))a.p.rw_a1;
    t->rw_a2 = (decltype(t->rw_a2))a.p.rw_a2;
    t->rw_k_k = (decltype(t->rw_k_k))a.p.rw_k_k;
    t->rw_k_a = (decltype(t->rw_k_a))a.p.rw_k_a;
    t->rw_r_k = (decltype(t->rw_r_k))a.p.rw_r_k;
    t->rw_gn_g = (decltype(t->rw_gn_g))a.p.rw_gn_g;
    t->rw_gn_b = (decltype(t->rw_gn_b))a.p.rw_gn_b;
    t->rw_w_out = (decltype(t->rw_w_out))a.p.rw_w_out;
    t->out = (decltype(t->out))a.p.out;
    t->ws = (decltype(t->ws))a.p.ws;
  }
  const LAS PG& p = *(const LAS PG*)(lds + PTAB_OFF);
  volatile LAS unsigned* MISC = (volatile LAS unsigned*)(lds + MISC_OFF);
  for (int u = tid; u < 128; u += 512) ((LAS unsigned*)(lds + MISC_OFF))[u] = 0u;
  __syncthreads();
  const int lo = a.ph_lo, hi = a.ph_hi;
  XcdBarrier bar; bar.bar = (unsigned*)(ws + M_CTL); bar.x = 0; bar.st = nullptr;
  if (hi - lo > 0 || RPT_MASK) bar = xcd_barrier_post((unsigned*)(ws + M_CTL), MISC + 8);
#ifndef PH_MASK
#define PH_MASK 0xffffffffu
#endif
#ifndef TP_PHASE
#define TP_PHASE -1
#endif
#ifndef TP_MULT
#define TP_MULT 4
#endif
  unsigned long long tp0 = (TP_PHASE == 0) ? __builtin_amdgcn_s_memrealtime() : 0ull, tp1 = 0ull;
#define IN(k) (((PH_MASK >> (k)) & 1u) && lo <= (k) && (k) < hi)
#define SEAM(k) do { if (IN(k) && IN((k) + 1)) xcd_barrier(bar); if ((k) + 1 == TP_PHASE) tp0 = __builtin_amdgcn_s_memrealtime(); if ((k) == TP_PHASE) tp1 = __builtin_amdgcn_s_memrealtime(); } while (0)
  if (IN(0)) { { phase_p0a(p, ws, lds, opq((int)threadIdx.x), (opq((int)threadIdx.x) & 63), wave, bid, G); } if ((RPT_MASK >> 0) & 1u) { xcd_barrier(bar); { phase_p0a(p, ws, lds, opq((int)threadIdx.x), (opq((int)threadIdx.x) & 63), wave, bid, G); } } } SEAM(0);
  if (IN(1)) { { phase_p0b(p, ws, lds, opq((int)threadIdx.x), (opq((int)threadIdx.x) & 63), wave, bid, G); } if ((RPT_MASK >> 1) & 1u) { xcd_barrier(bar); { phase_p0b(p, ws, lds, opq((int)threadIdx.x), (opq((int)threadIdx.x) & 63), wave, bid, G); } } } SEAM(1);
  if (IN(2)) { {
    pg8::Gemm g{(const pg8::bf16_t*)(ws + W_HYIN), (const pg8::bf16_t*)(ws + M_HB), 4096, 8192, 1024};
    pg8::StaticOrder S; S.init(4096, 8192, G, bid);
    pg8::EpiBf16<0> E{(pg8::bf16_t*)(ws + M_UT), 8192, nullptr, 0, 0, 1.f};
    pg8::gemm_phase<pg8::EpiBf16<0>, pg8::StaticOrder, true, true>(lds, g, S, E); } if ((RPT_MASK >> 2) & 1u) { xcd_barrier(bar); {
    pg8::Gemm g{(const pg8::bf16_t*)(ws + W_HYIN), (const pg8::bf16_t*)(ws + M_HB), 4096, 8192, 1024};
    pg8::StaticOrder S; S.init(4096, 8192, G, bid);
    pg8::EpiBf16<0> E{(pg8::bf16_t*)(ws + M_UT), 8192, nullptr, 0, 0, 1.f};
    pg8::gemm_phase<pg8::EpiBf16<0>, pg8::StaticOrder, true, true>(lds, g, S, E); } } } SEAM(2);
  if (IN(3)) { { phase_hy_conv(p, ws, lds, 0, opq((int)threadIdx.x), (opq((int)threadIdx.x) & 63), wave, bid, G); } if ((RPT_MASK >> 3) & 1u) { xcd_barrier(bar); { phase_hy_conv(p, ws, lds, 0, opq((int)threadIdx.x), (opq((int)threadIdx.x) & 63), wave, bid, G); } } } SEAM(3);
  if (IN(4)) { { if (G == 256) phase_out_ln_pair<1>(p, ws, lds, 0, (const bf16_t*)(ws + W_HYOUT), opq((int)threadIdx.x), (opq((int)threadIdx.x) & 63), wave, bid); else phase_out_ln<1>(p, ws, lds, 0, (const bf16_t*)(ws + W_HYOUT), opq((int)threadIdx.x), (opq((int)threadIdx.x) & 63), wave, bid, G); } if ((RPT_MASK >> 4) & 1u) { xcd_barrier(bar); { if (G == 256) phase_out_ln_pair<1>(p, ws, lds, 0, (const bf16_t*)(ws + W_HYOUT), opq((int)threadIdx.x), (opq((int)threadIdx.x) & 63), wave, bid); else phase_out_ln<1>(p, ws, lds, 0, (const bf16_t*)(ws + W_HYOUT), opq((int)threadIdx.x), (opq((int)threadIdx.x) & 63), wave, bid, G); } } } SEAM(4);
  if (IN(5)) { {
    pg8::Gemm g{(const pg8::bf16_t*)(ws + M_HB), (const pg8::bf16_t*)(ws + W_MLAIN + MiB), 8192, 1024, 1024};
    pg8::StaticOrder S; S.init(8192, 1024, G, bid);
    EpiSilu E{(bf16_t*)(ws + M_SZB), 1024};
    pg8::gemm_phase<EpiSilu, pg8::StaticOrder, true, true>(lds, g, S, E);
    { pg8::Gemm g2{(const pg8::bf16_t*)(ws + M_HB), (const pg8::bf16_t*)(ws + W_MLAIN), 8192, 512, 1024};
      pg8::StaticOrder S2; S2.init(8192, 512, G, (bid + G - 128 % G) % G);
      EpiF32 E2{(float*)(ws + M_U2S), 512};
      pg8::gemm_phase<EpiF32, pg8::StaticOrder, true, true>(lds, g2, S2, E2); }
    if (G == 256 && bid >= 192) { __syncthreads(); tr_run<2>(p, ws, (LAS float*)(lds + wave * 16384), (opq((int)threadIdx.x) & 63), (bid - 192) * 8 + wave, 64 * 8, NTR_DEF2); }
    else if (G != 256) { __syncthreads(); tr_run<2>(p, ws, (LAS float*)(lds + wave * 16384), (opq((int)threadIdx.x) & 63), bid * 8 + wave, G * 8, NTR_DEF2); } } if ((RPT_MASK >> 5) & 1u) { xcd_barrier(bar); {
    pg8::Gemm g{(const pg8::bf16_t*)(ws + M_HB), (const pg8::bf16_t*)(ws + W_MLAIN + MiB), 8192, 1024, 1024};
    pg8::StaticOrder S; S.init(8192, 1024, G, bid);
    EpiSilu E{(bf16_t*)(ws + M_SZB), 1024};
    pg8::gemm_phase<EpiSilu, pg8::StaticOrder, true, true>(lds, g, S, E);
    { pg8::Gemm g2{(const pg8::bf16_t*)(ws + M_HB), (const pg8::bf16_t*)(ws + W_MLAIN), 8192, 512, 1024};
      pg8::StaticOrder S2; S2.init(8192, 512, G, (bid + G - 128 % G) % G);
      EpiF32 E2{(float*)(ws + M_U2S), 512};
      pg8::gemm_phase<EpiF32, pg8::StaticOrder, true, true>(lds, g2, S2, E2); }
    if (G == 256 && bid >= 192) { __syncthreads(); tr_run<2>(p, ws, (LAS float*)(lds + wave * 16384), (opq((int)threadIdx.x) & 63), (bid - 192) * 8 + wave, 64 * 8, NTR_DEF2); }
    else if (G != 256) { __syncthreads(); tr_run<2>(p, ws, (LAS float*)(lds + wave * 16384), (opq((int)threadIdx.x) & 63), bid * 8 + wave, G * 8, NTR_DEF2); } } } } SEAM(5);
  if (IN(6)) { { phase_mla_rows(p, ws, (opq((int)threadIdx.x) & 63), wave, bid, G); xcd_barrier(bar); } {
    { pg8::Gemm g{(const pg8::bf16_t*)(ws + M_QN), (const pg8::bf16_t*)(ws + W_QUP), 8192, 1536, 256};
      pg8::StaticOrder S; S.init(8192, 1536, G, bid);
      pg8::EpiBf16<0> E{(pg8::bf16_t*)(ws + M_Q), 1536, nullptr, 0, 0, 1.f};
      pg8::gemm_phase<pg8::EpiBf16<0>, pg8::StaticOrder, true, true>(lds, g, S, E); }
    { pg8::Gemm g{(const pg8::bf16_t*)(ws + M_CKVALL), (const pg8::bf16_t*)(ws + W_KVUP), 9216, 2048, 128};
      pg8::StaticOrder S; S.init(9216, 2048, G, (bid + G - 192 % G) % G);
      EpiKV E{(bf16_t*)(ws + M_KN), (bf16_t*)(ws + M_V)};
      pg8::gemm_phase<EpiKV, pg8::StaticOrder, true, true>(lds, g, S, E); } } if ((RPT_MASK >> 6) & 1u) { xcd_barrier(bar); { phase_mla_rows(p, ws, (opq((int)threadIdx.x) & 63), wave, bid, G); xcd_barrier(bar); } {
    { pg8::Gemm g{(const pg8::bf16_t*)(ws + M_QN), (const pg8::bf16_t*)(ws + W_QUP), 8192, 1536, 256};
      pg8::StaticOrder S; S.init(8192, 1536, G, bid);
      pg8::EpiBf16<0> E{(pg8::bf16_t*)(ws + M_Q), 1536, nullptr, 0, 0, 1.f};
      pg8::gemm_phase<pg8::EpiBf16<0>, pg8::StaticOrder, true, true>(lds, g, S, E); }
    { pg8::Gemm g{(const pg8::bf16_t*)(ws + M_CKVALL), (const pg8::bf16_t*)(ws + W_KVUP), 9216, 2048, 128};
      pg8::StaticOrder S; S.init(9216, 2048, G, (bid + G - 192 % G) % G);
      EpiKV E{(bf16_t*)(ws + M_KN), (bf16_t*)(ws + M_V)};
      pg8::gemm_phase<EpiKV, pg8::StaticOrder, true, true>(lds, g, S, E); } } } } SEAM(6);
  if (IN(7)) { {
    for (int u = bid; u < 512; u += G) {
      int seq, hd, qb;
      if (u < 256) { seq = 16 + (u >> 7); hd = (u >> 3) & 15; qb = u & 7; } else { const int uu = u - 256; seq = uu >> 4; hd = uu & 15; qb = 0; }
      attn_unit(ws, lds, seq, hd, qb, (bf16_t*)(ws + M_GB), opq((int)threadIdx.x), (opq((int)threadIdx.x) & 63), wave);
    } } if ((RPT_MASK >> 7) & 1u) { xcd_barrier(bar); {
    for (int u = bid; u < 512; u += G) {
      int seq, hd, qb;
      if (u < 256) { seq = 16 + (u >> 7); hd = (u >> 3) & 15; qb = u & 7; } else { const int uu = u - 256; seq = uu >> 4; hd = uu & 15; qb = 0; }
      attn_unit(ws, lds, seq, hd, qb, (bf16_t*)(ws + M_GB), opq((int)threadIdx.x), (opq((int)threadIdx.x) & 63), wave);
    } } } } SEAM(7);
  if (IN(8)) { { if (G == 256) phase_out_ln_pair<0>(p, ws, lds, 1, (const bf16_t*)(ws + W_MLAOUT), opq((int)threadIdx.x), (opq((int)threadIdx.x) & 63), wave, bid); else phase_out_ln<0>(p, ws, lds, 1, (const bf16_t*)(ws + W_MLAOUT), opq((int)threadIdx.x), (opq((int)threadIdx.x) & 63), wave, bid, G); } if ((RPT_MASK >> 8) & 1u) { xcd_barrier(bar); { if (G == 256) phase_out_ln_pair<0>(p, ws, lds, 1, (const bf16_t*)(ws + W_MLAOUT), opq((int)threadIdx.x), (opq((int)threadIdx.x) & 63), wave, bid); else phase_out_ln<0>(p, ws, lds, 1, (const bf16_t*)(ws + W_MLAOUT), opq((int)threadIdx.x), (opq((int)threadIdx.x) & 63), wave, bid, G); } } } SEAM(8);
  if (IN(9)) { { phase_rw_mix(p, ws, opq((int)threadIdx.x), bid, G); } if ((RPT_MASK >> 9) & 1u) { xcd_barrier(bar); { phase_rw_mix(p, ws, opq((int)threadIdx.x), bid, G); } } } SEAM(9);
  if (IN(10)) { {
#pragma unroll 1
    for (int q = 0; q < 4; ++q) {
      pg8::Gemm g{(const pg8::bf16_t*)(ws + M_XMIX + (size_t)q * 16 * MiB), (const pg8::bf16_t*)(ws + W_RWIN + (size_t)q * 2 * MiB), 8192, 1024, 1024};
      pg8::StaticOrder S; S.init(8192, 1024, G, (bid + (q & 1) * (G / 2)) % G);
      if (q < 3) { pg8::EpiBf16<0> E{(pg8::bf16_t*)(ws + M_SCR2 + (size_t)q * 16 * MiB), 1024, nullptr, 0, 0, 1.f}; pg8::gemm_phase<pg8::EpiBf16<0>, pg8::StaticOrder, true, true>(lds, g, S, E); }
      else { EpiSilu E{(bf16_t*)(ws + M_SZR), 1024}; pg8::gemm_phase<EpiSilu, pg8::StaticOrder, true, true>(lds, g, S, E); }
    }
    { PRB_S(40) for (int tile = bid; tile < 256; tile += G) rw_lora_tile(p, ws, lds, tile, opq((int)threadIdx.x), (opq((int)threadIdx.x) & 63), wave); PRB_E(40); } } if ((RPT_MASK >> 10) & 1u) { xcd_barrier(bar); {
#pragma unroll 1
    for (int q = 0; q < 4; ++q) {
      pg8::Gemm g{(const pg8::bf16_t*)(ws + M_XMIX + (size_t)q * 16 * MiB), (const pg8::bf16_t*)(ws + W_RWIN + (size_t)q * 2 * MiB), 8192, 1024, 1024};
      pg8::StaticOrder S; S.init(8192, 1024, G, (bid + (q & 1) * (G / 2)) % G);
      if (q < 3) { pg8::EpiBf16<0> E{(pg8::bf16_t*)(ws + M_SCR2 + (size_t)q * 16 * MiB), 1024, nullptr, 0, 0, 1.f}; pg8::gemm_phase<pg8::EpiBf16<0>, pg8::StaticOrder, true, true>(lds, g, S, E); }
      else { EpiSilu E{(bf16_t*)(ws + M_SZR), 1024}; pg8::gemm_phase<EpiSilu, pg8::StaticOrder, true, true>(lds, g, S, E); }
    }
    for (int tile = bid; tile < 256; tile += G) rw_lora_tile(p, ws, lds, tile, opq((int)threadIdx.x), (opq((int)threadIdx.x) & 63), wave); } } } SEAM(10);
  if (IN(11)) { { phase_rw_scan_ck(p, ws, lds, opq((int)threadIdx.x), (opq((int)threadIdx.x) & 63), wave, bid, G); } if ((RPT_MASK >> 11) & 1u) { xcd_barrier(bar); { phase_rw_scan_ck(p, ws, lds, opq((int)threadIdx.x), (opq((int)threadIdx.x) & 63), wave, bid, G); } } } SEAM(11);
#if defined(CKT_WAVE) || defined(PRB_SEC)
#ifndef CKT_BLK
#define CKT_BLK 0
#endif
  if (bid == (CKT_BLK) && tid == 0) __hip_atomic_store((unsigned*)(ws + M_CTL + 60000), (unsigned)MISC[40], __ATOMIC_RELAXED, __HIP_MEMORY_SCOPE_AGENT);
#endif
  if (IN(12)) { { phase_out_ln<2>(p, ws, lds, 2, (const bf16_t*)(ws + W_RWOUT), opq((int)threadIdx.x), (opq((int)threadIdx.x) & 63), wave, bid, G); } if ((RPT_MASK >> 12) & 1u) { xcd_barrier(bar); { phase_out_ln<2>(p, ws, lds, 2, (const bf16_t*)(ws + W_RWOUT), opq((int)threadIdx.x), (opq((int)threadIdx.x) & 63), wave, bid, G); } } } SEAM(12);
  if (IN(13)) { {
    pg8::Gemm g{(const pg8::bf16_t*)(ws + W_HYIN + 8 * MiB), (const pg8::bf16_t*)(ws + M_HB), 4096, 8192, 1024};
    pg8::StaticOrder S; S.init(4096, 8192, G, bid);
    pg8::EpiBf16<0> E{(pg8::bf16_t*)(ws + M_UT), 8192, nullptr, 0, 0, 1.f};
    pg8::gemm_phase<pg8::EpiBf16<0>, pg8::StaticOrder, true, true>(lds, g, S, E); } if ((RPT_MASK >> 13) & 1u) { xcd_barrier(bar); {
    pg8::Gemm g{(const pg8::bf16_t*)(ws + W_HYIN + 8 * MiB), (const pg8::bf16_t*)(ws + M_HB), 4096, 8192, 1024};
    pg8::StaticOrder S; S.init(4096, 8192, G, bid);
    pg8::EpiBf16<0> E{(pg8::bf16_t*)(ws + M_UT), 8192, nullptr, 0, 0, 1.f};
    pg8::gemm_phase<pg8::EpiBf16<0>, pg8::StaticOrder, true, true>(lds, g, S, E); } } } SEAM(13);
  if (IN(14)) { { phase_hy_conv(p, ws, lds, 1, opq((int)threadIdx.x), (opq((int)threadIdx.x) & 63), wave, bid, G); } if ((RPT_MASK >> 14) & 1u) { xcd_barrier(bar); { phase_hy_conv(p, ws, lds, 1, opq((int)threadIdx.x), (opq((int)threadIdx.x) & 63), wave, bid, G); } } } SEAM(14);
  if (IN(15)) { { if (G == 256) phase_out_ln_pair<1>(p, ws, lds, 3, (const bf16_t*)(ws + W_HYOUT + 2 * MiB), opq((int)threadIdx.x), (opq((int)threadIdx.x) & 63), wave, bid); else phase_out_ln<1>(p, ws, lds, 3, (const bf16_t*)(ws + W_HYOUT + 2 * MiB), opq((int)threadIdx.x), (opq((int)threadIdx.x) & 63), wave, bid, G); } if ((RPT_MASK >> 15) & 1u) { xcd_barrier(bar); { if (G == 256) phase_out_ln_pair<1>(p, ws, lds, 3, (const bf16_t*)(ws + W_HYOUT + 2 * MiB), opq((int)threadIdx.x), (opq((int)threadIdx.x) & 63), wave, bid); else phase_out_ln<1>(p, ws, lds, 3, (const bf16_t*)(ws + W_HYOUT + 2 * MiB), opq((int)threadIdx.x), (opq((int)threadIdx.x) & 63), wave, bid, G); } } }
  if (TP_PHASE >= 0 && bid == 0) { if (TP_PHASE == 15) tp1 = __builtin_amdgcn_s_memrealtime(); if (TP_PHASE == 99) { tp0 = 0ull; tp1 = (unsigned long long)__hip_atomic_load((unsigned*)(ws + M_CTL + 60000), __ATOMIC_RELAXED, __HIP_MEMORY_SCOPE_AGENT); } const unsigned long long dl = (tp1 - tp0) * TP_MULT; const unsigned long long ts = __builtin_amdgcn_s_memrealtime(); while (__builtin_amdgcn_s_memrealtime() - ts < dl) __builtin_amdgcn_s_sleep(8); }
#undef IN
#undef SEAM
}
}
}

extern "C" void kernel_launch(void* const* d_in, const int* in_sizes, int n_in, void* d_out, int out_size, void* d_ws, size_t ws_size, hipStream_t stream) {
  P p{};
  const float** pp = (const float**)&p;
  for (int i = 0; i < 44; ++i) pp[i] = (const float*)d_in[i];
  p.out = (float*)d_out; p.ws = (float*)d_ws;
  float* ws = p.ws;
  static int grid = 0;
  if (grid == 0) {
    int dev = 0, cus = 0;
    (void)hipGetDevice(&dev); (void)hipDeviceGetAttribute(&cus, hipDeviceAttributeMultiprocessorCount, dev);
    (void)hipFuncSetAttribute((const void*)mk::mega, hipFuncAttributeMaxDynamicSharedMemorySize, mk::LDS_BYTES);
    grid = cus > 0 ? cus : 256;
  }
  (void)hipMemsetAsync((char*)d_ws + mk::M_CTL, 0, 65536, stream);
  mk::MArgs a{}; a.p = p; a.ph_lo = 0; a.ph_hi = MEGA_PHASES;
  hipLaunchKernelGGL(mk::mega, dim3(grid), dim3(512), mk::LDS_BYTES, stream, a);

  float* X = ws + WS_X; float* S1 = ws + WS_S1; float* S4 = ws + WS_S4; float* S2 = ws + WS_S2;
  const int EB = (int)((SZ + 255) / 256);
  if (NAIVE_FROM < 4) hipLaunchKernelGGL(k_mods, dim3((4 * 3 * 3072 + 255) / 256), dim3(256), 0, stream, p);
  for (int layer = NAIVE_FROM; layer < 4; ++layer) {
    const int kind = layer % 3, j = layer / 3;
    const float* xa = (layer == 0) ? p.x_prompt : X;
    const float* xb = (layer == 0) ? p.x_sample : X + (size_t)NPT * D;
    float* Xn = (layer == 3) ? p.out + OUT_Y : X;
    hipLaunchKernelGGL(k_modulate, dim3(EB), dim3(256), 0, stream, p, xa, xb, S1, layer);
    if (kind == 0) {
      hipLaunchKernelGGL(k_hy_filter, dim3(2304), dim3(256), 0, stream, p, j);
      gemm(stream, ALPlain{S1, D}, p.hy_w_in + (size_t)j * D * 4096, 4096, NTOK, 4096, D, EPPlain{S2, 4096});
      hipLaunchKernelGGL(k_hy_vv, dim3(EB), dim3(256), 0, stream, p, S2, S1, j);
      hipLaunchKernelGGL(k_hy_long, dim3(EB), dim3(256), 0, stream, p, S2, S1, S4, j);
      gemm(stream, ALPlain{S4, D}, p.hy_w_out + (size_t)j * D * D, D, NTOK, D, D, EPPlain{S1, D});
    } else if (kind == 1) {
      float* U2 = S2; float* QN = S1; float* CKVALL = S1 + (size_t)NTOK * 256; float* KPEALL = CKVALL + (size_t)9216 * 128;
      float* Q = S2; float* KV = S2 + (size_t)NTOK * 1536;
      gemm(stream, ALPlain{S1, D}, p.mla_w_in, 1440, NTOK, 1440, D, EPPlain{U2, 1440});
      hipLaunchKernelGGL(k_mla_extract, dim3(NTOK), dim3(64), 0, stream, p, U2, QN, CKVALL, KPEALL, S4);
      hipLaunchKernelGGL(k_mla_cache, dim3((2 * PAST * 128 + 255) / 256), dim3(256), 0, stream, p, CKVALL, KPEALL);
      gemm(stream, ALPlain{QN, 256}, p.mla_w_q_up, 1536, NTOK, 1536, 256, EPPlain{Q, 1536});
      hipLaunchKernelGGL(k_rope_q, dim3((4096 * 16 + 255) / 256), dim3(256), 0, stream, Q);
      gemm(stream, ALPlain{CKVALL, 128}, p.mla_w_kv_up, 2048, 9216, 2048, 128, EPPlain{KV, 2048});
      hipLaunchKernelGGL(k_attn, dim3(32, 18 * 16), dim3(64), 0, stream, Q, KV, KPEALL, S4);
      gemm(stream, ALPlain{S4, D}, p.mla_w_out, D, NTOK, D, D, EPPlain{S1, D});
    } else {
      float* R = S2; float* K = S2 + SZ; float* V = S2 + 2 * SZ; float* Z = S2 + 3 * SZ;
      float* HW = ws + WS_MISC + MISC_END; float* HA = HW + (size_t)NTOK * 128;
      const float* mu = p.rw_mu; const float* win = p.rw_w_in;
      gemm(stream, ALMix{S1, mu + 0 * D}, win + 0 * (size_t)D * D, D, NTOK, D, D, EPPlain{R, D});
      gemm(stream, ALMix{S1, mu + 2 * D}, win + 1 * (size_t)D * D, D, NTOK, D, D, EPPlain{K, D});
      gemm(stream, ALMix{S1, mu + 3 * D}, win + 2 * (size_t)D * D, D, NTOK, D, D, EPPlain{V, D});
      gemm(stream, ALMix{S1, mu + 5 * D}, win + 3 * (size_t)D * D, D, NTOK, D, D, EPPlain{Z, D});
      for (int dir = 0; dir < 2; ++dir) {
        gemm(stream, ALMix{S1, mu + 1 * D}, p.rw_w1 + (size_t)dir * D * 64, 64, NTOK, 64, D, EPTanh{HW + dir * 64, 128});
        gemm(stream, ALMix{S1, mu + 4 * D}, p.rw_a1 + (size_t)dir * D * 64, 64, NTOK, 64, D, EPPlain{HA + dir * 64, 128});
      }
      (void)hipMemsetAsync(S4, 0, SZ * sizeof(float), stream);
      hipLaunchKernelGGL(k_rw_scan, dim3(18 * 32), dim3(64), 0, stream, p, R, K, V, HW, HA, S4);
      hipLaunchKernelGGL(k_rw_post, dim3(NTOK * 16), dim3(64), 0, stream, p, R, K, V, Z, HA, S4, S4);
      gemm(stream, ALPlain{S4, D}, p.rw_w_out, D, NTOK, D, D, EPPlain{S1, D});
    }
    hipLaunchKernelGGL(k_ln, dim3(NTOK / 4), dim3(256), 0, stream, p, xa, xb, S1, Xn, layer);
  }
}
```
